# Optimizing an MI355X kernel written in HIP

```python
import jax, jax.numpy as jnp
from jax import lax
import numpy as np

D_MODEL = 1024
BATCH = 8
SEQ = 2048
DEPTH = 1
DEC_BATCH = 128
DEC_SEQ = 1
PAST_LEN = 2048
PAGE_SIZE = 128

D_MIX = D_MODEL
ATTN_WIDTH = D_MIX // 2
POOL_WIDTH = D_MIX - ATTN_WIDTH
HEAD_DIM = 64
N_HEADS = ATTN_WIDTH // HEAD_DIM
KV_HEADS = 2
IDX_HEADS = 8
IDX_DIM = 64
TOPK_MAX = 256
Q_BLOCK = 128
POOL_WINDOWS = (2, 4, 8, 16)
POOL_GROUPS = len(POOL_WINDOWS)
POOL_GC = POOL_WIDTH // POOL_GROUPS
POOL_HIST = max(POOL_WINDOWS) - 1
EPS = 1e-6
N_PAGES = PAST_LEN // PAGE_SIZE
N_PHYS_PAGES = (DEC_BATCH * N_PAGES * 5) // 4
COLS = (ATTN_WIDTH, KV_HEADS * HEAD_DIM, KV_HEADS * HEAD_DIM, IDX_HEADS * IDX_DIM, IDX_DIM, IDX_HEADS,
        ATTN_WIDTH, POOL_WIDTH, POOL_WIDTH)
N_IN = sum(COLS)
SPLITS = tuple(int(s) for s in np.cumsum(COLS)[:-1])

kernel_name = 'hymba_dsa_pool_adaln_step'


def rms_norm(x, w):
    xf = x.astype(jnp.float32)
    y = xf * lax.rsqrt(jnp.mean(xf * xf, axis=-1, keepdims=True) + EPS)
    return y.astype(x.dtype) * w


def _sparse_attend_block(q, qi, wi, k, v, ki, q_pos, topk):
    B, Q, H, Dh = q.shape
    L = k.shape[1]
    k_pos = jnp.arange(L)
    s = jnp.einsum('bqhd,bld->bqhl', qi, ki)
    score = jnp.einsum('bqh,bqhl->bql', wi, jax.nn.relu(s)).astype(jnp.float32)
    causal = k_pos[None, :] <= q_pos[:, None]
    score = jnp.where(causal[None], score, -jnp.inf)
    _, sel = lax.top_k(score, topk)
    valid = sel <= q_pos[None, :, None]
    gather = jax.vmap(lambda t, i: t[i])
    kg = gather(k, sel)
    vg = gather(v, sel)
    qg = q.reshape(B, Q, KV_HEADS, H // KV_HEADS, Dh)
    logits = jnp.einsum('bqgrd,bqkgd->bqgrk', qg, kg).astype(jnp.float32) * (Dh ** -0.5)
    logits = jnp.where(valid[:, :, None, None, :], logits, -jnp.inf)
    p = jax.nn.softmax(logits, axis=-1).astype(v.dtype)
    o = jnp.einsum('bqgrk,bqkgd->bqgrd', p, vg)
    return o.reshape(B, Q, H * Dh)


def sparse_attention(q, qi, wi, k, v, ki, q_pos, topk):
    B, T = q.shape[:2]
    if T <= Q_BLOCK or T % Q_BLOCK != 0:
        return _sparse_attend_block(q, qi, wi, k, v, ki, q_pos, topk)
    nb = T // Q_BLOCK

    def to_blocks(a):
        return jnp.moveaxis(a.reshape((B, nb, Q_BLOCK) + a.shape[2:]), 1, 0)

    def body(args):
        qb, qib, wib, pb = args
        return _sparse_attend_block(qb, qib, wib, k, v, ki, pb, topk)

    o = lax.map(body, (to_blocks(q), to_blocks(qi), to_blocks(wi), q_pos.reshape(nb, Q_BLOCK)))
    return jnp.moveaxis(o, 0, 1).reshape(B, T, -1)


def multi_scale_pool(u_ext, pos, w_pool, pool_scale):
    B, E, C = u_ext.shape
    T = E - POOL_HIST
    uf = u_ext.astype(jnp.float32)
    cs = jnp.concatenate([jnp.zeros((B, 1, C), jnp.float32), jnp.cumsum(uf, axis=1)], axis=1)
    u_new = uf[:, POOL_HIST:]
    outs = []
    for g, w in enumerate(POOL_WINDOWS):
        lo, hi = g * POOL_GC, (g + 1) * POOL_GC
        end = cs[:, POOL_HIST + 1:POOL_HIST + 1 + T, lo:hi]
        start = cs[:, POOL_HIST + 1 - w:POOL_HIST + 1 - w + T, lo:hi]
        cnt = jnp.minimum(pos + 1, w).astype(jnp.float32)[None, :, None]
        outs.append((end - start) / cnt - u_new[..., lo:hi])
    d = jnp.stack(outs, axis=2).astype(u_ext.dtype)
    y = jnp.einsum('btgc,gcd->btgd', d, w_pool).reshape(B, T, C)
    return y * pool_scale


def mixer_layer(x, c, u_hist, k_past, v_past, ki_past, pos, topk,
                norm_w, w_ada, b_ada, w_in, q_norm_w, k_norm_w, w_pool, pool_scale, w_out):
    B, T, _ = x.shape
    ada = jax.nn.silu(c) @ w_ada + b_ada
    shift, scale, gate = jnp.split(ada, 3, axis=-1)
    h = rms_norm(x, norm_w) * (1 + scale[:, None]) + shift[:, None]
    proj = h @ w_in
    q, k, v, qi, ki, wi, ga, u, gp = jnp.split(proj, SPLITS, axis=-1)
    q = rms_norm(q.reshape(B, T, N_HEADS, HEAD_DIM), q_norm_w)
    k = rms_norm(k.reshape(B, T, KV_HEADS, HEAD_DIM), k_norm_w)
    v = v.reshape(B, T, KV_HEADS, HEAD_DIM)
    qi = qi.reshape(B, T, IDX_HEADS, IDX_DIM)
    wi = wi * ((IDX_HEADS * IDX_DIM) ** -0.5)
    k_all = jnp.concatenate([k_past, k], axis=1)
    v_all = jnp.concatenate([v_past, v], axis=1)
    ki_all = jnp.concatenate([ki_past, ki], axis=1)
    a_out = sparse_attention(q, qi, wi, k_all, v_all, ki_all, pos, topk) * jax.nn.silu(ga)
    u_ext = jnp.concatenate([u_hist, u], axis=1)
    p_out = multi_scale_pool(u_ext, pos, w_pool, pool_scale) * jax.nn.silu(gp)
    y = jnp.concatenate([a_out, p_out], axis=-1) @ w_out
    return x + gate[:, None] * y, k, v, ki, u_ext[:, -POOL_HIST:]


def setup_inputs(seed: int = 0) -> dict:
    key = jax.random.key(seed)
    ks = jax.random.split(key, 20)
    f32 = jnp.float32
    nrm = lambda k, s, sc: jax.random.normal(k, s, f32) * sc
    perm = jax.random.permutation(ks[0], N_PHYS_PAGES)
    page_table = perm[:DEC_BATCH * N_PAGES].reshape(DEC_BATCH, N_PAGES).astype(jnp.int32)
    return {
        'x_prompt': nrm(ks[1], (BATCH, SEQ, D_MODEL), 1.0),
        'x_sample': nrm(ks[2], (DEC_BATCH, DEC_SEQ, D_MODEL), 1.0),
        'cache_k': nrm(ks[3], (DEPTH, N_PHYS_PAGES, PAGE_SIZE, KV_HEADS, HEAD_DIM), 1.0),
        'cache_v': nrm(ks[4], (DEPTH, N_PHYS_PAGES, PAGE_SIZE, KV_HEADS, HEAD_DIM), 1.0),
        'cache_kidx': nrm(ks[5], (DEPTH, N_PHYS_PAGES, PAGE_SIZE, IDX_DIM), 1.0),
        'state_pool': nrm(ks[6], (DEPTH, DEC_BATCH, POOL_HIST, POOL_WIDTH), 1.0),
        'page_table': page_table,
        'c_prompt': nrm(ks[7], (BATCH, D_MODEL), 1.0),
        'c_sample': nrm(ks[8], (DEC_BATCH, D_MODEL), 1.0),
        'norm_w': 1.0 + nrm(ks[9], (DEPTH, D_MODEL), 0.1),
        'w_ada': nrm(ks[10], (DEPTH, D_MODEL, 3 * D_MODEL), D_MODEL ** -0.5 * 0.5),
        'b_ada': nrm(ks[11], (DEPTH, 3 * D_MODEL), 0.02),
        'w_in': nrm(ks[12], (DEPTH, D_MODEL, N_IN), D_MODEL ** -0.5),
        'q_norm_w': 1.0 + nrm(ks[13], (DEPTH, HEAD_DIM), 0.1),
        'k_norm_w': 1.0 + nrm(ks[14], (DEPTH, HEAD_DIM), 0.1),
        'w_pool': nrm(ks[15], (DEPTH, POOL_GROUPS, POOL_GC, POOL_GC), POOL_GC ** -0.5),
        'pool_scale': 1.0 + nrm(ks[16], (DEPTH, POOL_WIDTH), 0.1),
        'w_out': nrm(ks[17], (DEPTH, D_MIX, D_MODEL), D_MIX ** -0.5),
    }


def reference(x_prompt, x_sample, cache_k, cache_v, cache_kidx, state_pool, page_table, c_prompt, c_sample,
              norm_w, w_ada, b_ada, w_in, q_norm_w, k_norm_w, w_pool, pool_scale, w_out):
    Bp, S, _ = x_prompt.shape
    Bs, T, _ = x_sample.shape
    n_pages = page_table.shape[1]
    past = n_pages * cache_k.shape[2]
    topk_p = min(TOPK_MAX, S // 4)
    topk_s = min(TOPK_MAX, (past + T) // 4)
    pos_p = jnp.arange(S)
    pos_s = past + jnp.arange(T)
    dt = x_prompt.dtype
    empty_kv = jnp.zeros((Bp, 0, KV_HEADS, HEAD_DIM), dt)
    empty_ki = jnp.zeros((Bp, 0, IDX_DIM), dt)
    zero_hist = jnp.zeros((Bp, POOL_HIST, POOL_WIDTH), dt)
    xp, xs = x_prompt, x_sample
    kp, vp, kip, up = [], [], [], []
    kss, vss, kiss, uss = [], [], [], []
    for l in range(DEPTH):
        params = (norm_w[l], w_ada[l], b_ada[l], w_in[l], q_norm_w[l], k_norm_w[l], w_pool[l], pool_scale[l], w_out[l])
        xp, k1, v1, ki1, u1 = mixer_layer(xp, c_prompt, zero_hist, empty_kv, empty_kv, empty_ki, pos_p, topk_p, *params)
        k_past = cache_k[l][page_table].reshape(Bs, past, KV_HEADS, HEAD_DIM)
        v_past = cache_v[l][page_table].reshape(Bs, past, KV_HEADS, HEAD_DIM)
        ki_past = cache_kidx[l][page_table].reshape(Bs, past, IDX_DIM)
        xs, k2, v2, ki2, u2 = mixer_layer(xs, c_sample, state_pool[l], k_past, v_past, ki_past, pos_s, topk_s, *params)
        kp.append(k1); vp.append(v1); kip.append(ki1); up.append(u1)
        kss.append(k2); vss.append(v2); kiss.append(ki2); uss.append(u2)
    return (xp, xs, jnp.stack(kp), jnp.stack(vp), jnp.stack(kip), jnp.stack(up),
            jnp.stack(kss), jnp.stack(vss), jnp.stack(kiss), jnp.stack(uss))
```

```cpp
#include <hip/hip_runtime.h>
#include <stdint.h>
#include <cstdio>

constexpr int DM = 1024, NB = 8, SEQ = 2048, DECB = 128, PAST = 2048, PAGE = 128, NPG = 16;
constexpr int NIN = 2888, MP = NB * SEQ, MT = MP + DECB, NR = NB + DECB;
constexpr int CQ = 0, CK = 512, CV = 640, CQI = 768, CKI = 1280, CWI = 1344, CGA = 1352, CU = 1864, CGP = 2376;
constexpr size_t O_YP = 0, O_YS = 16777216, O_KP = 16908288, O_VP = 19005440, O_KIP = 21102592, O_PP = 22151168,
                 O_KS = 22212608, O_VS = 22228992, O_KIS = 22245376, O_PS = 22253568, O_END = 23236608;
constexpr size_t W_ADA = 0, W_H = W_ADA + (size_t)NR * 3072, W_PROJ = W_H + (size_t)MT * 1024, W_SC = W_PROJ + (size_t)MT * NIN,
                 W_SCS = W_SC + (size_t)MP * 2048, W_SEL = W_SCS + (size_t)DECB * 2112, W_NSEL = W_SEL + (size_t)MT * 256,
                 W_MIX = W_NSEL + MT, W_DB = W_MIX + (size_t)MT * 1024, W_END = W_DB + (size_t)MT * 512;
constexpr size_t W_YT = W_H;

typedef float f32x16 __attribute__((ext_vector_type(16)));

__device__ __forceinline__ float wave_sum(float v) {
#pragma unroll
    for (int o = 1; o < 64; o <<= 1) v += __shfl_xor(v, o);
    return v;
}
__device__ __forceinline__ float wave_max(float v) {
#pragma unroll
    for (int o = 1; o < 64; o <<= 1) v = fmaxf(v, __shfl_xor(v, o));
    return v;
}
__device__ __forceinline__ float silu_f(float x) { return x / (1.f + expf(-x)); }

__global__ void __launch_bounds__(256) k_ada(const float* __restrict__ cp, const float* __restrict__ cs, const float* __restrict__ w_ada,
                                              const float* __restrict__ b_ada, float* __restrict__ ada) {
    const int j = blockIdx.x * 256 + threadIdx.x, r = blockIdx.y;
    const float* c = r < NB ? cp + (size_t)r * DM : cs + (size_t)(r - NB) * DM;
    float acc = 0.f;
    for (int k = 0; k < DM; ++k) { const float cv = c[k]; acc += silu_f(cv) * w_ada[(size_t)k * 3072 + j]; }
    ada[(size_t)r * 3072 + j] = acc + b_ada[j];
}

__global__ void __launch_bounds__(256) k_h(const float* __restrict__ xp, const float* __restrict__ xs, const float* __restrict__ norm_w,
                                            const float* __restrict__ ada, float* __restrict__ H) {
    const int m = blockIdx.x * 4 + (threadIdx.x >> 6), lane = threadIdx.x & 63;
    const float* x = m < MP ? xp + (size_t)m * DM : xs + (size_t)(m - MP) * DM;
    const int r = m < MP ? m / SEQ : NB + (m - MP);
    float v[16]; float ss = 0.f;
#pragma unroll
    for (int i = 0; i < 16; ++i) { v[i] = x[lane + 64 * i]; ss += v[i] * v[i]; }
    ss = wave_sum(ss);
    const float rstd = 1.0f / sqrtf(ss * (1.0f / DM) + 1e-6f);
#pragma unroll
    for (int i = 0; i < 16; ++i) { const int c = lane + 64 * i;
        H[(size_t)m * DM + c] = v[i] * rstd * norm_w[c] * (1.f + ada[(size_t)r * 3072 + 1024 + c]) + ada[(size_t)r * 3072 + c]; }
}

__global__ void __launch_bounds__(256) k_gemm(const float* __restrict__ A, const float* __restrict__ B, float* __restrict__ C,
                                               int M, int N, int K, int lda, int ldb, int ldc) {
    const int wave = threadIdx.x >> 6, lane = threadIdx.x & 63, r = lane & 31, h = lane >> 5;
    const int m0 = blockIdx.y * 128 + (wave >> 1) * 64, n0 = blockIdx.x * 128 + (wave & 1) * 64;
    f32x16 acc[2][2];
#pragma unroll
    for (int i = 0; i < 2; ++i)
#pragma unroll
        for (int j = 0; j < 2; ++j)
#pragma unroll
            for (int e = 0; e < 16; ++e) acc[i][j][e] = 0.f;
    const float* a0 = A + (size_t)(m0 + r) * lda + h;
    const float* a1 = a0 + (size_t)32 * lda;
    const int c0 = n0 + r, c1 = n0 + 32 + r; const bool v0 = c0 < N, v1 = c1 < N;
    const float* b0 = B + (size_t)h * ldb + (v0 ? c0 : 0);
    const float* b1 = B + (size_t)h * ldb + (v1 ? c1 : 0);
#pragma unroll 4
    for (int k = 0; k < K; k += 2) {
        const float x0 = a0[k], x1 = a1[k];
        float y0 = b0[(size_t)k * ldb], y1 = b1[(size_t)k * ldb];
        y0 = v0 ? y0 : 0.f; y1 = v1 ? y1 : 0.f;
        acc[0][0] = __builtin_amdgcn_mfma_f32_32x32x2f32(x0, y0, acc[0][0], 0, 0, 0);
        acc[0][1] = __builtin_amdgcn_mfma_f32_32x32x2f32(x0, y1, acc[0][1], 0, 0, 0);
        acc[1][0] = __builtin_amdgcn_mfma_f32_32x32x2f32(x1, y0, acc[1][0], 0, 0, 0);
        acc[1][1] = __builtin_amdgcn_mfma_f32_32x32x2f32(x1, y1, acc[1][1], 0, 0, 0);
    }
#pragma unroll
    for (int i = 0; i < 2; ++i)
#pragma unroll
        for (int j = 0; j < 2; ++j) { const int col = n0 + 32 * j + r;
            if (col < N) {
#pragma unroll
                for (int e = 0; e < 16; ++e) { const int row = m0 + 32 * i + (e & 3) + 8 * (e >> 2) + 4 * h; C[(size_t)row * ldc + col] = acc[i][j][e]; } } }
}

__global__ void __launch_bounds__(256) k_post(float* __restrict__ proj, const float* __restrict__ qnw, const float* __restrict__ knw,
                                               const float* __restrict__ state_pool, float* __restrict__ out) {
    const int m = blockIdx.x * 4 + (threadIdx.x >> 6), lane = threadIdx.x & 63;
    float* p = proj + (size_t)m * NIN;
    for (int hh = 0; hh < 8; ++hh) { const float v = p[CQ + hh * 64 + lane]; const float ss = wave_sum(v * v);
        p[CQ + hh * 64 + lane] = v * (1.0f / sqrtf(ss * (1.f / 64.f) + 1e-6f)) * qnw[lane]; }
    float* ko = m < MP ? out + O_KP + (size_t)m * 128 : out + O_KS + (size_t)(m - MP) * 128;
    float* vo = m < MP ? out + O_VP + (size_t)m * 128 : out + O_VS + (size_t)(m - MP) * 128;
    float* kio = m < MP ? out + O_KIP + (size_t)m * 64 : out + O_KIS + (size_t)(m - MP) * 64;
    for (int g = 0; g < 2; ++g) { const float v = p[CK + g * 64 + lane]; const float ss = wave_sum(v * v);
        const float kn = v * (1.0f / sqrtf(ss * (1.f / 64.f) + 1e-6f)) * knw[lane];
        p[CK + g * 64 + lane] = kn; ko[g * 64 + lane] = kn; vo[g * 64 + lane] = p[CV + g * 64 + lane]; }
    kio[lane] = p[CKI + lane];
    if (lane < 8) p[CWI + lane] *= 0.04419417382415922f;
    if (m < MP) { const int b = m / SEQ, t = m % SEQ;
        if (t >= SEQ - 15) { float* po = out + O_PP + ((size_t)b * 15 + (t - (SEQ - 15))) * 512;
            for (int c = lane; c < 512; c += 64) po[c] = p[CU + c]; }
    } else { const int s = m - MP; float* po = out + O_PS + (size_t)s * 15 * 512;
        for (int i = lane; i < 14 * 512; i += 64) po[i] = state_pool[(size_t)s * 15 * 512 + 512 + i];
        for (int c = lane; c < 512; c += 64) po[14 * 512 + c] = p[CU + c]; }
}

__global__ void __launch_bounds__(256) k_scores_p(const float* __restrict__ proj, float* __restrict__ SC) {
    __shared__ float qs[8][512]; __shared__ float wsm[8][8];
    const int b = blockIdx.y, t0 = blockIdx.x * 8, tid = threadIdx.x;
    for (int i = tid; i < 8 * 512; i += 256) qs[i >> 9][i & 511] = proj[(size_t)(b * SEQ + t0 + (i >> 9)) * NIN + CQI + (i & 511)];
    if (tid < 64) wsm[tid >> 3][tid & 7] = proj[(size_t)(b * SEQ + t0 + (tid >> 3)) * NIN + CWI + (tid & 7)];
    __syncthreads();
    for (int l = tid; l <= t0 + 7; l += 256) {
        float kr[64];
        const float4* kp = (const float4*)(proj + (size_t)(b * SEQ + l) * NIN + CKI);
#pragma unroll
        for (int i = 0; i < 16; ++i) { const float4 v = kp[i]; kr[4 * i] = v.x; kr[4 * i + 1] = v.y; kr[4 * i + 2] = v.z; kr[4 * i + 3] = v.w; }
        for (int q = 0; q < 8; ++q) {
            if (l > t0 + q) continue;
            float s = 0.f;
            for (int hh = 0; hh < 8; ++hh) { float d = 0.f;
#pragma unroll
                for (int e = 0; e < 64; ++e) d += qs[q][hh * 64 + e] * kr[e];
                s += wsm[q][hh] * fmaxf(d, 0.f); }
            SC[(size_t)(b * SEQ + t0 + q) * 2048 + l] = s;
        }
    }
}
__global__ void __launch_bounds__(256) k_scores_s(const float* __restrict__ proj, const float* __restrict__ cache_kidx, const int* __restrict__ page_table,
                                                   float* __restrict__ SCS) {
    __shared__ float qs[512]; __shared__ float wsm[8];
    const int s = blockIdx.x, tid = threadIdx.x; const float* prow = proj + (size_t)(MP + s) * NIN;
    for (int i = tid; i < 512; i += 256) qs[i] = prow[CQI + i];
    if (tid < 8) wsm[tid] = prow[CWI + tid];
    __syncthreads();
    for (int l = tid; l < PAST + 1; l += 256) {
        const float* kp_ = l < PAST ? cache_kidx + ((size_t)page_table[s * NPG + l / PAGE] * PAGE + (l % PAGE)) * 64 : prow + CKI;
        float kr[64];
#pragma unroll
        for (int i = 0; i < 64; ++i) kr[i] = kp_[i];
        float sc = 0.f;
        for (int hh = 0; hh < 8; ++hh) { float d = 0.f;
#pragma unroll
            for (int e = 0; e < 64; ++e) d += qs[hh * 64 + e] * kr[e];
            sc += wsm[hh] * fmaxf(d, 0.f); }
        SCS[(size_t)s * 2112 + l] = sc;
    }
}

__device__ __forceinline__ unsigned f2key(float f) { unsigned u = __float_as_uint(f); if (f == 0.0f) u = 0u; return (u & 0x80000000u) ? ~u : (u | 0x80000000u); }
__global__ void __launch_bounds__(256) k_topk(const float* __restrict__ SC, const float* __restrict__ SCS, int* __restrict__ SEL, int* __restrict__ NSEL) {
    const int m = blockIdx.x * 4 + (threadIdx.x >> 6), lane = threadIdx.x & 63;
    const float* src; int n;
    if (m < MP) { n = (m % SEQ) + 1; src = SC + (size_t)m * 2048; } else { n = PAST + 1; src = SCS + (size_t)(m - MP) * 2112; }
    int* sel = SEL + (size_t)m * 256;
    if (n <= 256) { for (int i = lane; i < n; i += 64) sel[i] = i; if (lane == 0) NSEL[m] = n; return; }
    unsigned key[33];
#pragma unroll
    for (int j = 0; j < 33; ++j) { const int l = j * 64 + lane; key[j] = l < n ? f2key(src[l]) : 0u; }
    unsigned T = 0u;
    for (int bit = 31; bit >= 0; --bit) { const unsigned cand = T | (1u << bit); int cnt = 0;
#pragma unroll
        for (int j = 0; j < 33; ++j) cnt += __popcll(__ballot(key[j] >= cand));
        if (cnt >= 256) T = cand; }
    int cgt = 0;
#pragma unroll
    for (int j = 0; j < 33; ++j) cgt += __popcll(__ballot(key[j] > T));
    const int need = 256 - cgt;
    const unsigned long long lt = (1ull << lane) - 1ull;
    int pos = 0, eq_seen = 0;
#pragma unroll
    for (int j = 0; j < 33; ++j) { const bool gt = key[j] > T, eq = key[j] == T;
        const unsigned long long meq = __ballot(eq); const int eqb = eq_seen + __popcll(meq & lt);
        const bool take = gt || (eq && eqb < need);
        const unsigned long long mt = __ballot(take);
        if (take) sel[pos + __popcll(mt & lt)] = j * 64 + lane;
        pos += __popcll(mt); eq_seen += __popcll(meq); }
    if (lane == 0) NSEL[m] = 256;
}

__global__ void __launch_bounds__(256) k_attn(const float* __restrict__ proj, const float* __restrict__ cache_k, const float* __restrict__ cache_v,
                                               const int* __restrict__ page_table, const int* __restrict__ SEL, const int* __restrict__ NSEL, float* __restrict__ MIX) {
    __shared__ float pl[4][8][256]; __shared__ int il[4][256]; __shared__ float ql[4][512];
    const int w = threadIdx.x >> 6, lane = threadIdx.x & 63, m = blockIdx.x * 4 + w;
    const int nsel = NSEL[m]; const float* prow = proj + (size_t)m * NIN;
    const bool prompt = m < MP; const int b = m / SEQ, s = m - MP;
    for (int i = lane; i < 512; i += 64) ql[w][i] = prow[CQ + i];
    for (int i = lane; i < 256; i += 64) {
        if (i < nsel) { const int l = SEL[(size_t)m * 256 + i]; il[w][i] = l;
            const float* krow = prompt ? proj + (size_t)(b * SEQ + l) * NIN + CK
                                       : (l < PAST ? cache_k + ((size_t)page_table[s * NPG + l / PAGE] * PAGE + (l % PAGE)) * 128 : prow + CK);
            for (int g = 0; g < 2; ++g) { float kr[64];
#pragma unroll
                for (int e = 0; e < 64; ++e) kr[e] = krow[g * 64 + e];
                for (int r = 0; r < 4; ++r) { float d = 0.f;
#pragma unroll
                    for (int e = 0; e < 64; ++e) d += ql[w][(g * 4 + r) * 64 + e] * kr[e];
                    pl[w][g * 4 + r][i] = d * 0.125f; } }
        } else { il[w][i] = 0; for (int hh = 0; hh < 8; ++hh) pl[w][hh][i] = -INFINITY; }
    }
    for (int hh = 0; hh < 8; ++hh) { float v[4]; float mx = -INFINITY;
#pragma unroll
        for (int i = 0; i < 4; ++i) { v[i] = pl[w][hh][lane + 64 * i]; mx = fmaxf(mx, v[i]); }
        mx = wave_max(mx); float sm = 0.f;
#pragma unroll
        for (int i = 0; i < 4; ++i) { v[i] = expf(v[i] - mx); sm += v[i]; }
        sm = wave_sum(sm); const float inv = 1.0f / sm;
#pragma unroll
        for (int i = 0; i < 4; ++i) pl[w][hh][lane + 64 * i] = v[i] * inv; }
    for (int g = 0; g < 2; ++g) { float acc[4] = {0.f, 0.f, 0.f, 0.f};
        for (int i = 0; i < nsel; ++i) { const int l = il[w][i];
            const float* vrow = prompt ? proj + (size_t)(b * SEQ + l) * NIN + CV
                                       : (l < PAST ? cache_v + ((size_t)page_table[s * NPG + l / PAGE] * PAGE + (l % PAGE)) * 128 : prow + CV);
            const float vv = vrow[g * 64 + lane];
#pragma unroll
            for (int r = 0; r < 4; ++r) acc[r] += pl[w][g * 4 + r][i] * vv; }
#pragma unroll
        for (int r = 0; r < 4; ++r) { const int c = (g * 4 + r) * 64 + lane; MIX[(size_t)m * 1024 + c] = acc[r] * silu_f(prow[CGA + c]); } }
}

__global__ void __launch_bounds__(256) k_pool_d(const float* __restrict__ proj, const float* __restrict__ state_pool, float* __restrict__ DB) {
    const size_t idx = (size_t)blockIdx.x * 256 + threadIdx.x; const int m = (int)(idx >> 9), c = (int)(idx & 511);
    const int g = c >> 7, w = 2 << g; const float un = proj[(size_t)m * NIN + CU + c]; float sum = un; float cnt;
    if (m < MP) { const int t = m % SEQ; for (int i = 1; i < w; ++i) if (t - i >= 0) sum += proj[(size_t)(m - i) * NIN + CU + c]; cnt = (float)(t + 1 < w ? t + 1 : w); }
    else { const int s = m - MP; for (int i = 1; i < w; ++i) sum += state_pool[((size_t)s * 15 + (15 - i)) * 512 + c]; cnt = (float)w; }
    DB[idx] = sum / cnt - un;
}
__global__ void __launch_bounds__(256) k_pool_out(const float* __restrict__ proj, const float* __restrict__ DB, const float* __restrict__ w_pool,
                                                   const float* __restrict__ pool_scale, float* __restrict__ MIX) {
    const size_t idx = (size_t)blockIdx.x * 256 + threadIdx.x; const int m = (int)(idx >> 9), col = (int)(idx & 511), g = col >> 7, j = col & 127;
    float acc = 0.f;
    for (int c = 0; c < 128; ++c) acc += DB[(size_t)m * 512 + g * 128 + c] * w_pool[((size_t)g * 128 + c) * 128 + j];
    MIX[(size_t)m * 1024 + 512 + col] = acc * pool_scale[col] * silu_f(proj[(size_t)m * NIN + CGP + col]);
}
__global__ void __launch_bounds__(256) k_final(const float* __restrict__ xp, const float* __restrict__ xs, const float* __restrict__ ada,
                                                const float* __restrict__ YT, float* __restrict__ out) {
    const size_t idx = (size_t)blockIdx.x * 256 + threadIdx.x; const int m = (int)(idx >> 10), c = (int)(idx & 1023);
    const int r = m < MP ? m / SEQ : NB + (m - MP);
    const float x = m < MP ? xp[idx] : xs[idx - (size_t)MP * 1024];
    float* o = m < MP ? out + O_YP + idx : out + O_YS + (idx - (size_t)MP * 1024);
    *o = x + ada[(size_t)r * 3072 + 2048 + c] * YT[idx];
}

extern "C" void kernel_launch(void* const* d_in, const int* in_sizes, int n_in, void* d_out, int out_size, void* d_ws, size_t ws_size, hipStream_t stream) {
    if (ws_size < W_END * 4 || out_size != (int)O_END) { fprintf(stderr, "kernel_launch: unexpected sizes ws %zu out %d\n", ws_size, out_size); return; }
    const float* xp = (const float*)d_in[0]; const float* xs = (const float*)d_in[1];
    const float* cache_k = (const float*)d_in[2]; const float* cache_v = (const float*)d_in[3]; const float* cache_kidx = (const float*)d_in[4];
    const float* state_pool = (const float*)d_in[5]; const int* page_table = (const int*)d_in[6];
    const float* cp = (const float*)d_in[7]; const float* cs = (const float*)d_in[8]; const float* norm_w = (const float*)d_in[9];
    const float* w_ada = (const float*)d_in[10]; const float* b_ada = (const float*)d_in[11]; const float* w_in = (const float*)d_in[12];
    const float* qnw = (const float*)d_in[13]; const float* knw = (const float*)d_in[14]; const float* w_pool = (const float*)d_in[15];
    const float* pool_scale = (const float*)d_in[16]; const float* w_out = (const float*)d_in[17];
    float* out = (float*)d_out; float* ws = (float*)d_ws;
    float *ADA = ws + W_ADA, *H = ws + W_H, *PROJ = ws + W_PROJ, *SC = ws + W_SC, *SCS = ws + W_SCS, *MIX = ws + W_MIX, *DB = ws + W_DB, *YT = ws + W_YT;
    int *SEL = (int*)(ws + W_SEL), *NSEL = (int*)(ws + W_NSEL);
    k_ada<<<dim3(12, NR), 256, 0, stream>>>(cp, cs, w_ada, b_ada, ADA);
    k_h<<<MT / 4, 256, 0, stream>>>(xp, xs, norm_w, ADA, H);
    k_gemm<<<dim3((NIN + 127) / 128, MT / 128), 256, 0, stream>>>(H, w_in, PROJ, MT, NIN, DM, DM, NIN, NIN);
    k_post<<<MT / 4, 256, 0, stream>>>(PROJ, qnw, knw, state_pool, out);
    k_scores_p<<<dim3(SEQ / 8, NB), 256, 0, stream>>>(PROJ, SC);
    k_scores_s<<<DECB, 256, 0, stream>>>(PROJ, cache_kidx, page_table, SCS);
    k_topk<<<MT / 4, 256, 0, stream>>>(SC, SCS, SEL, NSEL);
    k_attn<<<MT / 4, 256, 0, stream>>>(PROJ, cache_k, cache_v, page_table, SEL, NSEL, MIX);
    k_pool_d<<<(MT * 512) / 256, 256, 0, stream>>>(PROJ, state_pool, DB);
    k_pool_out<<<(MT * 512) / 256, 256, 0, stream>>>(PROJ, DB, w_pool, pool_scale, MIX);
    k_gemm<<<dim3(1024 / 128, MT / 128), 256, 0, stream>>>(MIX, w_out, YT, MT, 1024, 1024, 1024, 1024, 1024);
    k_final<<<(MT * 1024) / 256, 256, 0, stream>>>(xp, xs, ADA, YT, out);
}
```

```cpp
#define TEST_MODE 0
#define HAVE_P3 1
#define P3_TOL0 1e-2f
#define P3_TOL1 1e-4f
#define P3_TOL2 1e-2f
#define P3_TOL3 1e-4f
#define P3_TOL4 3e-2f
#include <hip/hip_runtime.h>
#include <cstdio>
#include <cstdint>

constexpr int DM = 1024, NB = 8, SEQ = 2048, DECB = 128, PAST = 2048, PAGE = 128, NPG = 16;
constexpr int NIN = 2888, MP = NB * SEQ, MT = MP + DECB, NR = NB + DECB;
constexpr int CQ = 0, CK = 512, CV = 640, CQI = 768, CKI = 1280, CWI = 1344, CGA = 1352, CU = 1864, CGP = 2376;
constexpr size_t O_YP = 0, O_YS = 16777216, O_KP = 16908288, O_VP = 19005440, O_KIP = 21102592, O_PP = 22151168,
                 O_KS = 22212608, O_VS = 22228992, O_KIS = 22245376, O_PS = 22253568, O_END = 23236608;
constexpr float C2 = 0.125f * 1.4426950408889634f;
constexpr float WI_SCALE = 0.04419417382415922f;
constexpr float EPS = 1e-6f;
constexpr size_t MiB = 1u << 20;
constexpr size_t WS_CTL = 0, CTL_ZERO_BYTES = 1 * MiB;
constexpr size_t WS_ADA = 1 * MiB, WS_WINT = 3 * MiB, WS_WOUTT = 9 * MiB, WS_WPOOLT = 11 * MiB, WS_HS = 12 * MiB, WS_HB = 24 * MiB,
                 WS_Q = 56 * MiB, WS_QI = 73 * MiB, WS_GA = 90 * MiB, WS_U = 107 * MiB, WS_GP = 124 * MiB, WS_KB = 141 * MiB, WS_VB = 146 * MiB,
                 WS_KI = 151 * MiB, WS_WI = 154 * MiB, WS_MIX = 155 * MiB, WS_DBG_BM = 188 * MiB, WS_MEGA_END = 192 * MiB;
namespace pg8 {
#define PG8_LAS __attribute__((address_space(3)))
typedef unsigned short bf16_t;
typedef short bf16x8 __attribute__((ext_vector_type(8)));
typedef float f32x4 __attribute__((ext_vector_type(4)));
typedef unsigned u32x4 __attribute__((ext_vector_type(4)));
constexpr int BM = 256, BK = 64, HALF = 128, HTB = HALF * BK * 2  , STAGE_BYTES = 8 * HTB, NXCD = 8, WGM = 8;

__host__ __device__ __forceinline__ int lds_byte(int r, int c) { const int st = (r >> 4) * 2 + (c >> 5), rr = r & 15, cc = c & 31, ob = rr * 64 + cc * 2; return st * 1024 + (ob ^ (((ob >> 9) & 1) << 5)); }
__host__ __device__ __forceinline__ void stage_rc(int b, int& R, int& C) { const int st = b / 1024, sb = b % 1024, swz = sb ^ (((sb >> 9) & 1) << 5); R = (st >> 1) * 16 + swz / 64; C = (st & 1) * 32 + (swz % 64) / 2; }
__host__ __device__ __forceinline__ int perm32(int rho) { const int n = rho >> 4, i = rho & 15; return 8 * (i >> 2) + 4 * n + (i & 3); }

struct Unit { int pm, pn; };
struct Gemm { const bf16_t* A; const bf16_t* Bt; int M, N, K; };

struct StaticOrder {
    int nM, nN, nwg, G, c;
    __host__ __device__ void init(int M, int N, int G_, int c_) { nM = M / BM; nN = N / BM; nwg = nM * nN; G = G_; c = c_; }
    __host__ __device__ bool next(int i, Unit& u) const {
        const long L = (long)i * G + c; if (L >= nwg) return false;
        int wgid = (int)L; { const int q = nwg / NXCD, r = nwg % NXCD, xcd = wgid % NXCD, off = wgid / NXCD; wgid = (xcd < r ? xcd * (q + 1) : r * (q + 1) + (xcd - r) * q) + off; }
        const int nig = WGM * nN, gid = wgid / nig, fm = gid * WGM, gsz = (nM - fm) < WGM ? (nM - fm) : WGM;
        u.pm = fm + ((wgid % nig) % gsz); u.pn = (wgid % nig) / gsz; return true;
    }
    __device__ __forceinline__ void a_ready(const Unit&) const {}
    __device__ __forceinline__ void done(const Unit&) const {}
};


typedef unsigned u32x4 __attribute__((ext_vector_type(4)));
__device__ __forceinline__ unsigned cvt_pk_bf16(float lo, float hi) { unsigned r; asm volatile("v_cvt_pk_bf16_f32 %0, %1, %2" : "=v"(r) : "v"(lo), "v"(hi)); return r; }
__device__ __forceinline__ void st_bf16x8(bf16_t* p, const f32x4 a, const f32x4 b) {
    u32x4 w; w.x = cvt_pk_bf16(a[0], a[1]); w.y = cvt_pk_bf16(a[2], a[3]); w.z = cvt_pk_bf16(b[0], b[1]); w.w = cvt_pk_bf16(b[2], b[3]); *(u32x4*)p = w; }
__device__ __forceinline__ float silu1(float x) { return x * __builtin_amdgcn_rcpf(1.0f + __builtin_amdgcn_exp2f(-1.4426950408889634f * x)); }
__device__ __forceinline__ f32x4 silu4(const f32x4 v) { f32x4 r; r[0] = silu1(v[0]); r[1] = silu1(v[1]); r[2] = silu1(v[2]); r[3] = silu1(v[3]); return r; }

struct EpiIn {
    static constexpr bool PERM = true, AFTER_DRAIN = false;
    unsigned char* ws; float* out; const float* qnw; const float* knw;
    __device__ __forceinline__ void operator()(const f32x4 (&acc)[2][2][4][2], const Unit& u, int wr, int wc, int fr, int fq) const {
        const int pn = u.pn;
        if (pn == 5 && wc >= 2) return;
        const int rowb = u.pm * 256 + wr * 64 + fr, dof = 8 * fq;
        if (pn <= 1 || (pn == 2 && wc < 2)) {
            const float* nwp = pn <= 1 ? qnw : knw; const float sc = pn <= 1 ? C2 : 1.0f;
            f32x4 wv[2][2];
#pragma unroll
            for (int bj = 0; bj < 2; ++bj)
#pragma unroll
                for (int n = 0; n < 2; ++n) wv[bj][n] = *(const f32x4*)(nwp + 32 * bj + dof + 4 * n) * sc;
#pragma unroll
            for (int ai = 0; ai < 2; ++ai)
#pragma unroll
                for (int m = 0; m < 4; ++m) { const size_t row = (size_t)(rowb + ai * 128 + m * 16); float ss = 0.f;
#pragma unroll
                    for (int bj = 0; bj < 2; ++bj)
#pragma unroll
                        for (int n = 0; n < 2; ++n) { const f32x4 x = acc[ai][bj][m][n]; ss += (x[0] * x[0] + x[1] * x[1]) + (x[2] * x[2] + x[3] * x[3]); }
                    ss += __shfl_xor(ss, 16); ss += __shfl_xor(ss, 32);
                    const float rstd = 1.0f / sqrtf(ss * (1.0f / 64.0f) + EPS);
                    f32x4 o[2][2];
#pragma unroll
                    for (int bj = 0; bj < 2; ++bj)
#pragma unroll
                        for (int n = 0; n < 2; ++n) o[bj][n] = acc[ai][bj][m][n] * rstd * wv[bj][n];
                    if (pn <= 1) { bf16_t* q = (bf16_t*)(ws + WS_Q) + row * 512 + (4 * pn + wc) * 64 + dof; st_bf16x8(q, o[0][0], o[0][1]); st_bf16x8(q + 32, o[1][0], o[1][1]); }
                    else { float* ko = out + O_KP + row * 128 + wc * 64 + dof; *(f32x4*)ko = o[0][0]; *(f32x4*)(ko + 4) = o[0][1]; *(f32x4*)(ko + 32) = o[1][0]; *(f32x4*)(ko + 36) = o[1][1];
                        bf16_t* kb = (bf16_t*)(ws + WS_KB) + row * 128 + wc * 64 + dof; st_bf16x8(kb, o[0][0], o[0][1]); st_bf16x8(kb + 32, o[1][0], o[1][1]); } }
            return;
        }
        if (pn == 5 && wc == 1) {
            if (fq == 0) {
#pragma unroll
                for (int ai = 0; ai < 2; ++ai)
#pragma unroll
                    for (int m = 0; m < 4; ++m) { const size_t row = (size_t)(rowb + ai * 128 + m * 16); float* wp = (float*)(ws + WS_WI) + row * 8;
                        *(f32x4*)wp = acc[ai][0][m][0] * WI_SCALE; *(f32x4*)(wp + 4) = acc[ai][0][m][1] * WI_SCALE; } }
            return;
        }
        bf16_t* dst; int ld, cb; float* fo = nullptr; int fld = 0; bool act = false;
        if (pn == 2) { dst = (bf16_t*)(ws + WS_VB); ld = 128; cb = (wc - 2) * 64; fo = out + O_VP + cb; fld = 128; }
        else if (pn <= 4) { dst = (bf16_t*)(ws + WS_QI); ld = 512; cb = (4 * (pn - 3) + wc) * 64; }
        else if (pn == 5) { dst = (bf16_t*)(ws + WS_KI); ld = 64; cb = 0; fo = out + O_KIP; fld = 64; }
        else if (pn <= 7) { dst = (bf16_t*)(ws + WS_GA); ld = 512; cb = (4 * (pn - 6) + wc) * 64; act = true; }
        else if (pn <= 9) { dst = (bf16_t*)(ws + WS_U); ld = 512; cb = (4 * (pn - 8) + wc) * 64; }
        else { dst = (bf16_t*)(ws + WS_GP); ld = 512; cb = (4 * (pn - 10) + wc) * 64; act = true; }
        const bool is_u = (pn == 8 || pn == 9);
#pragma unroll
        for (int ai = 0; ai < 2; ++ai)
#pragma unroll
            for (int m = 0; m < 4; ++m) { const int rowi = rowb + ai * 128 + m * 16; const size_t row = (size_t)rowi;
                f32x4 o00 = acc[ai][0][m][0], o01 = acc[ai][0][m][1], o10 = acc[ai][1][m][0], o11 = acc[ai][1][m][1];
                if (act) { o00 = silu4(o00); o01 = silu4(o01); o10 = silu4(o10); o11 = silu4(o11); }
                bf16_t* d = dst + row * ld + cb + dof; st_bf16x8(d, o00, o01); st_bf16x8(d + 32, o10, o11);
                if (fo) { float* f = fo + row * fld + dof; *(f32x4*)f = o00; *(f32x4*)(f + 4) = o01; *(f32x4*)(f + 32) = o10; *(f32x4*)(f + 36) = o11; }
                if (is_u) { const int t = rowi & (SEQ - 1);
                    if (t >= SEQ - 15) { float* f = out + O_PP + ((size_t)(rowi >> 11) * 15 + (t - (SEQ - 15))) * 512 + cb + dof;
                        *(f32x4*)f = o00; *(f32x4*)(f + 4) = o01; *(f32x4*)(f + 32) = o10; *(f32x4*)(f + 36) = o11; } } }
    }
};
struct EpiOut {
    static constexpr bool PERM = true, AFTER_DRAIN = false;
    const float* x; float* y; const float* ada;
    __device__ __forceinline__ void operator()(const f32x4 (&acc)[2][2][4][2], const Unit& u, int wr, int wc, int fr, int fq) const {
        const int col0 = u.pn * 256 + wc * 32 + 8 * fq; const float* gp = ada + (size_t)(u.pm >> 3) * 3072 + 2048 + col0;
        f32x4 g[2][2];
#pragma unroll
        for (int bj = 0; bj < 2; ++bj)
#pragma unroll
            for (int n = 0; n < 2; ++n) g[bj][n] = *(const f32x4*)(gp + 128 * bj + 4 * n);
#pragma unroll
        for (int ai = 0; ai < 2; ++ai)
#pragma unroll
            for (int m = 0; m < 4; ++m) { const size_t off = (size_t)(u.pm * 256 + ai * 128 + wr * 64 + m * 16 + fr) * 1024 + col0;
#pragma unroll
                for (int bj = 0; bj < 2; ++bj)
#pragma unroll
                    for (int n = 0; n < 2; ++n) { const f32x4 xv = *(const f32x4*)(x + off + 128 * bj + 4 * n); *(f32x4*)(y + off + 128 * bj + 4 * n) = xv + g[bj][n] * acc[ai][bj][m][n]; } }
    }
};
template <class Epi, class Sched, bool ALIGN_EPI = false, bool SP2 = false>
__device__ __forceinline__ void gemm_phase(PG8_LAS unsigned char* lds, const Gemm g, const Sched& S, const Epi& E) {
    const int tid = threadIdx.x, wid = __builtin_amdgcn_readfirstlane(tid >> 6), lane = tid & 63, wr = wid >> 2, wc = wid & 3, fr = lane & 15, fq = lane >> 4;
    const int K = g.K, nt = K / BK;
    unsigned voffA[2], voffB[2];
#pragma unroll
    for (int i = 0; i < 2; ++i) { int R, C; stage_rc(tid * 16 + i * 8192, R, C); const int Rb = Epi::PERM ? ((R & ~31) + perm32(R & 31)) : R;
        voffA[i] = (unsigned)(R * K + C) * 2u; voffB[i] = (unsigned)(Rb * K + C) * 2u; }
    const size_t kstep = (size_t)(BK * 2);
    const size_t hstep = (size_t)HALF * K * 2;
    const size_t tstep = 2 * hstep;
    const unsigned ldsw = (unsigned)wid * 1024u;
    const int aoff = lds_byte(wr * 64 + fr, fq * 8), boff = lds_byte(wc * 32 + fr, fq * 8);
#define PG8_SA(b, h) (((b) * 2 + (h)) * HTB)
#define PG8_SB(b, h) ((4 + (b) * 2 + (h)) * HTB)
#define PG8_STAGE(bufoff, gbase, voff) do { _Pragma("unroll") for (int _i = 0; _i < 2; ++_i) \
        __builtin_amdgcn_global_load_lds((const unsigned*)((const char*)(gbase) + (voff)[_i]), (PG8_LAS unsigned*)(lds + (bufoff) + ldsw + _i * 8192), 16, 0, 0); } while (0)
#define PG8_LDA(dst, b, h) do { _Pragma("unroll") for (int m = 0; m < 4; ++m) _Pragma("unroll") for (int k = 0; k < 2; ++k) dst[m][k] = *(const PG8_LAS bf16x8*)(lds + PG8_SA(b, h) + aoff + m * 2048 + k * 1024); } while (0)
#define PG8_LDB(dst, b, h) do { _Pragma("unroll") for (int n = 0; n < 2; ++n) _Pragma("unroll") for (int k = 0; k < 2; ++k) dst[n][k] = *(const PG8_LAS bf16x8*)(lds + PG8_SB(b, h) + boff + n * 2048 + k * 1024); } while (0)
#define PG8_MMA(ai, bj, At, Bt) do { __builtin_amdgcn_s_setprio(1); _Pragma("unroll") for (int m = 0; m < 4; ++m) _Pragma("unroll") for (int n = 0; n < 2; ++n) _Pragma("unroll") for (int k = 0; k < 2; ++k) \
        acc[ai][bj][m][n] = __builtin_amdgcn_mfma_f32_16x16x32_bf16(Bt[n][k], At[m][k], acc[ai][bj][m][n], 0, 0, 0); __builtin_amdgcn_s_setprio(0); } while (0)
#define PG8_WAIT_V(n) asm volatile("s_waitcnt vmcnt(" #n ")" ::: "memory")
#define PG8_WAIT_L(n) asm volatile("s_waitcnt lgkmcnt(" #n ")" ::: "memory")
#define PG8_BAR __builtin_amdgcn_s_barrier()
#define PG8_SCHED __builtin_amdgcn_sched_barrier(0)
    Unit cur, nxt; int ui = 0;
    if (!S.next(0, cur)) return;
    f32x4 acc[2][2][4][2];
#pragma unroll
    for (int a = 0; a < 2; ++a)
#pragma unroll
        for (int b = 0; b < 2; ++b)
#pragma unroll
            for (int m = 0; m < 4; ++m)
#pragma unroll
                for (int n = 0; n < 2; ++n) acc[a][b][m][n] = (f32x4){0.f, 0.f, 0.f, 0.f};
    bf16x8 At[4][2], B0[2][2], B1[2][2];
    const char* cA = (const char*)g.A + (size_t)cur.pm * tstep; const char* cB = (const char*)g.Bt + (size_t)cur.pn * tstep;
    S.a_ready(cur);
    if constexpr (SP2) {
        PG8_STAGE(PG8_SB(0, 0), cB, voffB); PG8_STAGE(PG8_SB(0, 1), cB + hstep, voffB); PG8_STAGE(PG8_SA(0, 0), cA, voffA); PG8_STAGE(PG8_SA(0, 1), cA + hstep, voffA);
        if (wr == 1) PG8_BAR;
        PG8_WAIT_V(2); PG8_BAR;
        PG8_STAGE(PG8_SB(1, 0), cB + kstep, voffB); PG8_STAGE(PG8_SA(1, 0), cA + kstep, voffA); PG8_STAGE(PG8_SB(1, 1), cB + hstep + kstep, voffB);
        PG8_WAIT_V(6); PG8_BAR;
    } else {
        PG8_STAGE(PG8_SB(0, 0), cB, voffB); PG8_STAGE(PG8_SA(0, 0), cA, voffA); PG8_STAGE(PG8_SB(0, 1), cB + hstep, voffB); PG8_STAGE(PG8_SA(0, 1), cA + hstep, voffA);
        if (wr == 1) PG8_BAR;
        PG8_WAIT_V(4); PG8_BAR;
        PG8_STAGE(PG8_SB(1, 0), cB + kstep, voffB); PG8_STAGE(PG8_SA(1, 0), cA + kstep, voffA); PG8_STAGE(PG8_SB(1, 1), cB + hstep + kstep, voffB);
        PG8_WAIT_V(6); PG8_BAR;
    }
    for (;;) {
        const bool has_next = S.next(ui + 1, nxt);
        const char* nA = has_next ? (const char*)g.A + (size_t)nxt.pm * tstep : cA; const char* nB = has_next ? (const char*)g.Bt + (size_t)nxt.pn * tstep : cB;
        for (int t = 0; t < nt; t += 2) {
            const bool last = (t == nt - 2);
            const char* a1 = cA + (size_t)(t + 1) * kstep;
            const char* a2 = last ? nA : cA + (size_t)(t + 2) * kstep; const char* b2 = last ? nB : cB + (size_t)(t + 2) * kstep;
            const char* a3 = a2 + kstep; const char* b3 = b2 + kstep;
            if (last && has_next) S.a_ready(nxt);
            if constexpr (SP2) {
            PG8_LDB(B0, 0, 0); PG8_LDB(B1, 0, 1); PG8_SCHED; PG8_LDA(At, 0, 0); PG8_STAGE(PG8_SA(1, 1), a1 + hstep, voffA);
            PG8_WAIT_V(8); PG8_WAIT_L(0); PG8_BAR; PG8_MMA(0, 0, At, B0); PG8_MMA(0, 1, At, B1); PG8_BAR; PG8_SCHED;
            PG8_LDA(At, 0, 1); PG8_STAGE(PG8_SB(0, 0), b2, voffB); PG8_STAGE(PG8_SB(0, 1), b2 + hstep, voffB); PG8_STAGE(PG8_SA(0, 0), a2, voffA);
            PG8_WAIT_V(8); PG8_WAIT_L(0); PG8_BAR; PG8_MMA(1, 0, At, B0); PG8_MMA(1, 1, At, B1); PG8_BAR; PG8_SCHED;
            PG8_LDB(B0, 1, 0); PG8_LDB(B1, 1, 1); PG8_SCHED; PG8_LDA(At, 1, 0); PG8_STAGE(PG8_SA(0, 1), a2 + hstep, voffA);
            PG8_WAIT_V(8); PG8_WAIT_L(0); PG8_BAR; PG8_MMA(0, 0, At, B0); PG8_MMA(0, 1, At, B1); PG8_BAR; PG8_SCHED;
            PG8_LDA(At, 1, 1); PG8_STAGE(PG8_SB(1, 0), b3, voffB); PG8_STAGE(PG8_SB(1, 1), b3 + hstep, voffB); PG8_STAGE(PG8_SA(1, 0), a3, voffA);
            PG8_WAIT_V(8); PG8_WAIT_L(0); PG8_BAR; PG8_MMA(1, 0, At, B0); PG8_MMA(1, 1, At, B1); PG8_BAR; PG8_SCHED;
            } else {
            PG8_LDB(B0, 0, 0); PG8_SCHED; PG8_LDA(At, 0, 0); PG8_STAGE(PG8_SA(1, 1), a1 + hstep, voffA);
            PG8_WAIT_L(8); PG8_BAR; PG8_WAIT_L(0); PG8_MMA(0, 0, At, B0); PG8_BAR; PG8_SCHED;
            PG8_LDB(B1, 0, 1); PG8_STAGE(PG8_SB(0, 0), b2, voffB);
            PG8_BAR; PG8_WAIT_L(0); PG8_MMA(0, 1, At, B1); PG8_BAR;
            PG8_LDA(At, 0, 1); PG8_STAGE(PG8_SA(0, 0), a2, voffA);
            PG8_BAR; PG8_WAIT_L(0); PG8_MMA(1, 0, At, B0); PG8_BAR; PG8_SCHED;
            PG8_STAGE(PG8_SB(0, 1), b2 + hstep, voffB);
            PG8_WAIT_V(6); PG8_BAR; PG8_MMA(1, 1, At, B1); PG8_BAR;
            PG8_LDB(B0, 1, 0); PG8_SCHED; PG8_LDA(At, 1, 0); PG8_STAGE(PG8_SA(0, 1), a2 + hstep, voffA);
            PG8_WAIT_L(8); PG8_BAR; PG8_WAIT_L(0); PG8_MMA(0, 0, At, B0); PG8_BAR; PG8_SCHED;
            PG8_LDB(B1, 1, 1); PG8_STAGE(PG8_SB(1, 0), b3, voffB);
            PG8_BAR; PG8_WAIT_L(0); PG8_MMA(0, 1, At, B1); PG8_BAR;
            PG8_LDA(At, 1, 1); PG8_STAGE(PG8_SA(1, 0), a3, voffA);
            PG8_BAR; PG8_WAIT_L(0); PG8_MMA(1, 0, At, B0); PG8_BAR; PG8_SCHED;
            PG8_STAGE(PG8_SB(1, 1), b3 + hstep, voffB);
            PG8_WAIT_V(6); PG8_BAR; PG8_MMA(1, 1, At, B1); PG8_BAR;
            }
        }
        if constexpr (ALIGN_EPI) { if (wr == 0) PG8_BAR; }
        if constexpr (!Epi::AFTER_DRAIN) { E(acc, cur, wr, wc, fr, fq); S.done(cur); }
        if (!has_next) break;
#pragma unroll
        for (int a = 0; a < 2; ++a)
#pragma unroll
            for (int b = 0; b < 2; ++b)
#pragma unroll
                for (int m = 0; m < 4; ++m)
#pragma unroll
                    for (int n = 0; n < 2; ++n) acc[a][b][m][n] = (f32x4){0.f, 0.f, 0.f, 0.f};
        cur = nxt; cA = nA; cB = nB; ++ui;
        if constexpr (ALIGN_EPI) { if (wr == 1) PG8_BAR; }
    }
    PG8_WAIT_V(0);
    if constexpr (!ALIGN_EPI) { if (wr == 0) PG8_BAR; }
    PG8_BAR;
    if constexpr (Epi::AFTER_DRAIN) { E.fused(acc, cur, wr, wc, fr, fq, lds, wid, lane); S.done(cur); }
#undef PG8_SA
#undef PG8_SB
#undef PG8_STAGE
#undef PG8_LDA
#undef PG8_LDB
#undef PG8_MMA
#undef PG8_WAIT_V
#undef PG8_WAIT_L
#undef PG8_BAR
#undef PG8_SCHED
}
}

constexpr int NWAVES = 8;
constexpr int RING_OFF = 0, RING_BYTES = 131072;
constexpr int LDSCTL_OFF = RING_BYTES, MISC_OFF = LDSCTL_OFF + 320;
constexpr int LDS_BYTES = 147456;
constexpr int CW_BAR = 4096;
#define GAS __attribute__((address_space(1)))
#define LAS __attribute__((address_space(3)))
typedef unsigned short bf16;
typedef unsigned v4u __attribute__((ext_vector_type(4)));
typedef unsigned v2u __attribute__((ext_vector_type(2)));
typedef float f32x4 __attribute__((ext_vector_type(4)));
typedef float f32x16 __attribute__((ext_vector_type(16)));
typedef short bf16x8 __attribute__((ext_vector_type(8)));
typedef GAS unsigned gu32;
#define LDS_WAIT() asm volatile("s_waitcnt lgkmcnt(0)" ::: "memory")
#define VM_WAIT() asm volatile("s_waitcnt vmcnt(0)" ::: "memory")
__device__ __forceinline__ unsigned f2bf(float f) { unsigned u = __builtin_bit_cast(unsigned, f); return (u + 0x7fffu + ((u >> 16) & 1u)) >> 16; }
__device__ __forceinline__ unsigned pk2(float lo, float hi) { return pg8::cvt_pk_bf16(lo, hi); }
__device__ __forceinline__ float bf2f(unsigned short b) { return __builtin_bit_cast(float, (unsigned)b << 16); }
__device__ __forceinline__ float wave_sum(float v) {
#pragma unroll
    for (int o = 1; o < 64; o <<= 1) v += __shfl_xor(v, o);
    return v;
}
__device__ __forceinline__ float wave_max(float v) {
#pragma unroll
    for (int o = 1; o < 64; o <<= 1) v = fmaxf(v, __shfl_xor(v, o));
    return v;
}
#define XB_TMO      128
#define XB_XCNT(j)  (256  + 64 * (j))
#define XB_XSUB(j)  (1280 + 64 * (j))
#define XB_XGEN(j)  (2304 + 64 * (j))
#define XB_TOP      3328
#define XB_TOPGEN   3392
#define XCD_BAR_WORDS 3456
#define XB_SPIN_CAP (1u << 18)

__device__ __forceinline__ unsigned xb_ld(unsigned* p)              { return __hip_atomic_load(p, __ATOMIC_RELAXED, __HIP_MEMORY_SCOPE_AGENT); }
__device__ __forceinline__ unsigned xb_add(unsigned* p, unsigned v) { return __hip_atomic_fetch_add(p, v, __ATOMIC_RELAXED, __HIP_MEMORY_SCOPE_AGENT); }
__device__ __forceinline__ unsigned xb_xcc_id() { return (unsigned)__builtin_amdgcn_s_getreg((3 << 11) | 20) & 0xFu; }
#define XB_SPIN(cond, bar) do { unsigned _sp = 0; while (cond) { __builtin_amdgcn_s_sleep(1); \
    if ((++_sp & 255u) == 0u) { if (xb_ld(&(bar)[XB_TMO])) break; if (_sp > XB_SPIN_CAP) { atomicAdd(&(bar)[XB_TMO], 1u); break; } } } } while (0)

struct XcdBarrier {
    unsigned* bar; unsigned x;
    volatile LAS unsigned* st;
};

__device__ __forceinline__ XcdBarrier xcd_barrier_post(unsigned* bar, volatile LAS unsigned* st) {
    XcdBarrier b; b.bar = bar; b.x = xb_xcc_id(); b.st = st;
    if (threadIdx.x == 0) (void)xb_add(&bar[XB_XCNT(b.x)], 1u);
    return b;
}
__device__ __forceinline__ void xcd_barrier_complete(unsigned* bar, unsigned x, unsigned& nloc, unsigned& nx) {
    const unsigned G = gridDim.x * gridDim.y * gridDim.z;
    unsigned sum, cnt, mine, sp = 0u;
    for (;;) {
        sum = 0u; cnt = 0u; mine = 0u;
#pragma unroll
        for (unsigned j = 0; j < 16; ++j) { const unsigned c = xb_ld(&bar[XB_XCNT(j)]); sum += c; cnt += (c > 0u) ? 1u : 0u; mine = (j == x) ? c : mine; }
        if (sum == G) break;
        __builtin_amdgcn_s_sleep(1);
        if ((++sp & 255u) == 0u) { if (xb_ld(&bar[XB_TMO])) break; if (sp > XB_SPIN_CAP) { atomicAdd(&bar[XB_TMO], 1u); break; } }
    }
    nloc = mine > 0u ? mine : 1u; nx = cnt > 0u ? cnt : 1u;
}

__device__ __forceinline__ void xcd_barrier(const XcdBarrier& b) {
    asm volatile("s_waitcnt vmcnt(0)" ::: "memory");
    __syncthreads();
    if (threadIdx.x == 0) {
        unsigned* bar = b.bar;
        __builtin_amdgcn_s_waitcnt(0);
        unsigned nloc = b.st[0], nx = b.st[1];
        if (nloc == 0u) { xcd_barrier_complete(bar, b.x, nloc, nx); b.st[0] = nloc; b.st[1] = nx; }
        const unsigned old = xb_add(&bar[XB_XSUB(b.x)], 1u);
        const unsigned gen = old / nloc;
        if (old + 1u == (gen + 1u) * nloc) {
            __builtin_amdgcn_fence(__ATOMIC_RELEASE, "agent");
            asm volatile("s_waitcnt vmcnt(0)" ::: "memory");
            const unsigned og = xb_add(&bar[XB_TOP], 1u);
            const unsigned tg = og / nx;
            if (og + 1u == (tg + 1u) * nx) xb_add(&bar[XB_TOPGEN], 1u);
            else XB_SPIN(xb_ld(&bar[XB_TOPGEN]) == tg, bar);
            __builtin_amdgcn_fence(__ATOMIC_ACQUIRE, "agent");
            xb_add(&bar[XB_XGEN(b.x)], 1u);
            asm volatile("s_waitcnt vmcnt(0)" ::: "memory");
        } else {
            XB_SPIN(xb_ld(&bar[XB_XGEN(b.x)]) == gen, bar);
            __builtin_amdgcn_fence(__ATOMIC_ACQUIRE, "agent");
            asm volatile("s_waitcnt vmcnt(0)" ::: "memory");
        }
    }
    __syncthreads();
}

struct Frame {
    LAS unsigned char* lds; volatile LAS unsigned* MISC; gu32* ctl;
    int tid, lane, wave, vcu, G, bid;
    const float *xp, *xs, *cache_k, *cache_v, *cache_kidx, *state_pool; const int* page_table;
    const float *cp, *cs, *norm_w, *w_ada, *b_ada, *w_in, *qnw, *knw, *w_pool, *pool_scale, *w_out;
    float* out; unsigned char* ws;
};

__device__ __forceinline__ void p0_ada(Frame& F, int task) {
    const int lane = F.lane, w = F.wave, rl = lane & 15, kq = lane >> 4, n0 = task * 16;
    f32x4 acc[9];
#pragma unroll
    for (int i = 0; i < 9; ++i) acc[i] = (f32x4){0.f, 0.f, 0.f, 0.f};
    const float* wp = F.w_ada + (size_t)(w * 128 + kq) * 3072 + n0 + rl;
    for (int ks = 0; ks < 32; ++ks) {
        const int k = w * 128 + ks * 4 + kq;
        const float bv = wp[(size_t)ks * 4 * 3072];
#pragma unroll
        for (int i = 0; i < 9; ++i) { const int row = 16 * i + rl;
            float c = 0.f;
            if (row < NB) c = F.cp[(size_t)row * DM + k]; else if (row < NR) c = F.cs[(size_t)(row - NB) * DM + k];
            const float a = pg8::silu1(c);
            acc[i] = __builtin_amdgcn_mfma_f32_16x16x4f32(a, bv, acc[i], 0, 0, 0); }
    }
    LAS float* red = (LAS float*)(F.lds + RING_OFF);
#pragma unroll
    for (int i = 0; i < 9; ++i)
#pragma unroll
        for (int e = 0; e < 4; ++e) red[(w * 144 + 16 * i + 4 * kq + e) * 16 + rl] = acc[i][e];
    __syncthreads();
    float* ada = (float*)(F.ws + WS_ADA);
    for (int o = F.tid; o < NR * 16; o += NWAVES * 64) { const int row = o >> 4, col = o & 15; float s = F.b_ada[n0 + col];
#pragma unroll
        for (int ww = 0; ww < 8; ++ww) s += red[(ww * 144 + row) * 16 + col];
        ada[(size_t)row * 3072 + n0 + col] = s; }
    __syncthreads();
}
__device__ __forceinline__ void transpose_item(const float* W, int ldn, int srccol0, int nvalid, bf16* WT, int K, int dstrow0, int k0, LAS float* scr, int lane) {
#pragma unroll 8
    for (int i = 0; i < 32; ++i) { const int kk = 2 * i + (lane >> 5), c = lane & 31; scr[kk * 33 + c] = c < nvalid ? W[(size_t)(k0 + kk) * ldn + srccol0 + c] : 0.f; }
    LDS_WAIT(); asm volatile("" ::: "memory");
    const int c = lane & 7;
#pragma unroll
    for (int j = 0; j < 4; ++j) { const int n = (lane >> 3) + 8 * j; const LAS float* s = scr + (8 * c) * 33 + n;
        v4u o; o.x = pk2(s[0 * 33], s[1 * 33]); o.y = pk2(s[2 * 33], s[3 * 33]); o.z = pk2(s[4 * 33], s[5 * 33]); o.w = pk2(s[6 * 33], s[7 * 33]);
        *(GAS v4u*)(WT + (size_t)(dstrow0 + n) * K + k0 + 8 * c) = o; }
    LDS_WAIT(); asm volatile("" ::: "memory");
}
__device__ __forceinline__ int win_col(int pn, int hd, int d) {
    if (pn <= 1) return CQ + (4 * pn + hd) * 64 + d;
    if (pn == 2) return hd < 2 ? CK + hd * 64 + d : CV + (hd - 2) * 64 + d;
    if (pn <= 4) return CQI + (4 * (pn - 3) + hd) * 64 + d;
    if (pn == 5) return hd == 0 ? CKI + d : ((hd == 1 && d < 8) ? CWI + d : -1);
    if (pn <= 7) return CGA + (4 * (pn - 6) + hd) * 64 + d;
    if (pn <= 9) return CU + (4 * (pn - 8) + hd) * 64 + d;
    return CGP + (4 * (pn - 10) + hd) * 64 + d;
}
__device__ __forceinline__ void p0_prologue(Frame& F) {
    if (F.bid < 192) p0_ada(F, F.bid);
    LAS float* scr = (LAS float*)(F.lds + RING_OFF + F.wave * 16384);
    const int gw = F.vcu * NWAVES + F.wave, NGW = F.G * NWAVES;
    bf16* WINT = (bf16*)(F.ws + WS_WINT); bf16* WOUTT = (bf16*)(F.ws + WS_WOUTT); bf16* WPOOLT = (bf16*)(F.ws + WS_WPOOLT);
    for (int it = gw; it < 2080; it += NGW) {
        if (it < 1536) { const int G = it >> 4, kb = it & 15, pn = G >> 3, bj = (G >> 2) & 1, hd = G & 3; const int src = win_col(pn, hd, 32 * bj);
            const int nvalid = src < 0 ? 0 : ((pn == 5 && hd == 1) ? 8 : 32);
            transpose_item(F.w_in, NIN, src < 0 ? 0 : src, nvalid, WINT, 1024, 32 * G, 64 * kb, scr, F.lane); }
        else if (it < 2048) { const int r = it - 1536, G = r >> 4, kb = r & 15; transpose_item(F.w_out, 1024, 32 * G, 32, WOUTT, 1024, 32 * G, 64 * kb, scr, F.lane); }
        else { const int r = it - 2048, g = r >> 3, kb = (r >> 2) & 1, G = r & 3; transpose_item(F.w_pool + (size_t)g * 16384, 128, 32 * G, 32, WPOOLT + (size_t)g * 16384, 128, 32 * G, 64 * kb, scr, F.lane); }
    }
}

__device__ __forceinline__ void norm_row(Frame& F, const float* xrow, const float* adarow, bf16* orow) {
    const GAS f32x4* xr = (const GAS f32x4*)xrow + F.lane;
    f32x4 v[4]; float s2 = 0.f;
#pragma unroll
    for (int j = 0; j < 4; ++j) { v[j] = xr[64 * j]; s2 += (v[j].x * v[j].x + v[j].y * v[j].y) + (v[j].z * v[j].z + v[j].w * v[j].w); }
    const float rstd = 1.0f / sqrtf(wave_sum(s2) * (1.0f / DM) + EPS);
    GAS unsigned long long* o8 = (GAS unsigned long long*)orow + F.lane;
#pragma unroll
    for (int j = 0; j < 4; ++j) { const int col = 4 * F.lane + 256 * j;
        const f32x4 nw = *(const f32x4*)(F.norm_w + col), sh = *(const f32x4*)(adarow + col), sc = *(const f32x4*)(adarow + 1024 + col);
        const f32x4 o = v[j] * rstd * nw * (sc + 1.0f) + sh;
        o8[64 * j] = (unsigned long long)pk2(o.x, o.y) | ((unsigned long long)pk2(o.z, o.w) << 32); }
}
__device__ __forceinline__ void skinny_core(const bf16* arow, const bf16* b0, const bf16* b1, const bf16* b2, const bf16* b3, f32x4 (&acc)[4]) {
#pragma unroll
    for (int j = 0; j < 4; ++j) acc[j] = (f32x4){0.f, 0.f, 0.f, 0.f};
#pragma unroll 4
    for (int ks = 0; ks < 32; ++ks) {
        const bf16x8 a = *(const bf16x8*)(arow + 32 * ks);
        const bf16x8 v0 = *(const bf16x8*)(b0 + 32 * ks), v1 = *(const bf16x8*)(b1 + 32 * ks), v2 = *(const bf16x8*)(b2 + 32 * ks), v3 = *(const bf16x8*)(b3 + 32 * ks);
        acc[0] = __builtin_amdgcn_mfma_f32_16x16x32_bf16(a, v0, acc[0], 0, 0, 0);
        acc[1] = __builtin_amdgcn_mfma_f32_16x16x32_bf16(a, v1, acc[1], 0, 0, 0);
        acc[2] = __builtin_amdgcn_mfma_f32_16x16x32_bf16(a, v2, acc[2], 0, 0, 0);
        acc[3] = __builtin_amdgcn_mfma_f32_16x16x32_bf16(a, v3, acc[3], 0, 0, 0);
    }
}
__device__ __forceinline__ void sample_inproj(Frame& F, int pn, int hd) {
    const int lane = F.lane, w = F.wave, rl = lane & 15, kq = lane >> 4;
    bf16* HS = (bf16*)(F.ws + WS_HS) + (size_t)F.bid * 131072;
    const float* ada = (const float*)(F.ws + WS_ADA);
    for (int i = 0; i < 16; ++i) { const int s = 16 * w + i; norm_row(F, F.xs + (size_t)s * DM, ada + (size_t)(NB + s) * 3072, HS + (size_t)s * DM); }
    VM_WAIT(); __builtin_amdgcn_fence(__ATOMIC_ACQUIRE, "agent"); VM_WAIT();
    const bf16* WINT = (const bf16*)(F.ws + WS_WINT);
    const bf16* bb = WINT + (size_t)(256 * pn + 32 * hd + rl) * 1024 + 8 * kq;
    f32x4 acc[4];
    skinny_core(HS + (size_t)(16 * w + rl) * 1024 + 8 * kq, bb, bb + 16 * 1024, bb + 128 * 1024, bb + 144 * 1024, acc);
    float* out = F.out;
    if (pn <= 1 || (pn == 2 && hd < 2)) {
        const float* nwp = pn <= 1 ? F.qnw : F.knw; const float sc = pn <= 1 ? C2 : 1.0f;
#pragma unroll
        for (int e = 0; e < 4; ++e) { float ss = 0.f;
#pragma unroll
            for (int j = 0; j < 4; ++j) ss += acc[j][e] * acc[j][e];
            ss += __shfl_xor(ss, 1); ss += __shfl_xor(ss, 2); ss += __shfl_xor(ss, 4); ss += __shfl_xor(ss, 8);
            const float rstd = 1.0f / sqrtf(ss * (1.0f / 64.0f) + EPS); const int s = 16 * w + 4 * kq + e; const size_t m = (size_t)(MP + s);
#pragma unroll
            for (int j = 0; j < 4; ++j) { const int d = 16 * j + rl; const float o = acc[j][e] * rstd * nwp[d] * sc;
                if (pn <= 1) ((bf16*)(F.ws + WS_Q))[m * 512 + (4 * pn + hd) * 64 + d] = (bf16)f2bf(o);
                else { out[O_KS + (size_t)s * 128 + hd * 64 + d] = o; ((bf16*)(F.ws + WS_KB))[m * 128 + hd * 64 + d] = (bf16)f2bf(o); } } }
        return;
    }
    if (pn == 5 && hd == 1) {
        if (rl < 8) {
#pragma unroll
            for (int e = 0; e < 4; ++e) { const int s = 16 * w + 4 * kq + e; ((float*)(F.ws + WS_WI))[(size_t)(MP + s) * 8 + rl] = acc[0][e] * WI_SCALE; } }
        return;
    }
    bf16* dst; int ld, cb; float* fo = nullptr; int fld = 0; bool act = false;
    if (pn == 2) { dst = (bf16*)(F.ws + WS_VB); ld = 128; cb = (hd - 2) * 64; fo = out + O_VS + cb; fld = 128; }
    else if (pn <= 4) { dst = (bf16*)(F.ws + WS_QI); ld = 512; cb = (4 * (pn - 3) + hd) * 64; }
    else if (pn == 5) { dst = (bf16*)(F.ws + WS_KI); ld = 64; cb = 0; fo = out + O_KIS; fld = 64; }
    else if (pn <= 7) { dst = (bf16*)(F.ws + WS_GA); ld = 512; cb = (4 * (pn - 6) + hd) * 64; act = true; }
    else if (pn <= 9) { dst = (bf16*)(F.ws + WS_U); ld = 512; cb = (4 * (pn - 8) + hd) * 64; fo = out + O_PS + 14 * 512 + cb; fld = 15 * 512; }
    else { dst = (bf16*)(F.ws + WS_GP); ld = 512; cb = (4 * (pn - 10) + hd) * 64; act = true; }
#pragma unroll
    for (int e = 0; e < 4; ++e) { const int s = 16 * w + 4 * kq + e; const size_t m = (size_t)(MP + s);
#pragma unroll
        for (int j = 0; j < 4; ++j) { const int d = 16 * j + rl; float o = acc[j][e]; if (act) o = pg8::silu1(o);
            dst[m * ld + cb + d] = (bf16)f2bf(o);
            if (fo) fo[(size_t)s * fld + d] = o; } }
    if (pn == 8 || pn == 9) {
        for (int i = F.tid; i < DECB * 14 * 64; i += NWAVES * 64) { const int c = i & 63, r = (i >> 6) % 14, s = i / (64 * 14);
            out[O_PS + ((size_t)s * 15 + r) * 512 + cb + c] = F.state_pool[((size_t)s * 15 + r + 1) * 512 + cb + c]; } }
}
__device__ __forceinline__ void p1_norm(Frame& F) {
    if (F.bid < 48) { const int pn = F.bid >> 2, hd = F.bid & 3; if (!(pn == 5 && hd >= 2)) sample_inproj(F, pn, hd); }
    const int gw = F.vcu * NWAVES + F.wave, NGW = F.G * NWAVES; const float* ada = (const float*)(F.ws + WS_ADA);
    bf16* HB = (bf16*)(F.ws + WS_HB);
    for (int m = gw; m < MP; m += NGW) norm_row(F, F.xp + (size_t)m * DM, ada + (size_t)(m >> 11) * 3072, HB + (size_t)m * DM);
}

constexpr int P3_BM = 0;
constexpr int P3_CNT = 4096;
constexpr int P3_WQ = 4608;
constexpr int P3_K = 8192;
constexpr int P3_V = P3_K + 32768;
constexpr int P3_VBUF = 18432;
constexpr int P3_END = P3_V + 2 * P3_VBUF;

__device__ __forceinline__ unsigned f2key(float f) { unsigned u = __float_as_uint(f); if (f == 0.0f) u = 0u; return (u & 0x80000000u) ? ~u : (u | 0x80000000u); }
__device__ __forceinline__ float key2f(unsigned k) { return __uint_as_float((k & 0x80000000u) ? (k ^ 0x80000000u) : ~k); }

#define P3_COUNT(mode, thr, Jv, cres, par) do { \
    unsigned pk_[4]; \
    _Pragma("unroll") for (int a_ = 0; a_ < 4; ++a_) { unsigned c0_ = 0u, c1_ = 0u; \
        _Pragma("unroll") for (int s_ = 0; s_ < 8; ++s_) { const int kidx_ = 32 * (w + 8 * s_) + r; \
            if (mode == 0) { c0_ += (sk[s_][a_][0] >= thr[a_][0]) ? 1u : 0u; c1_ += (sk[s_][a_][1] >= thr[a_][1]) ? 1u : 0u; } \
            else { c0_ += (sk[s_][a_][0] == thr[a_][0] && kidx_ <= Jv[a_][0]) ? 1u : 0u; c1_ += (sk[s_][a_][1] == thr[a_][1] && kidx_ <= Jv[a_][1]) ? 1u : 0u; } } \
        pk_[a_] = c0_ | (c1_ << 16); } \
    _Pragma("unroll") for (int o_ = 1; o_ < 32; o_ <<= 1) { _Pragma("unroll") for (int a_ = 0; a_ < 4; ++a_) pk_[a_] += __shfl_xor(pk_[a_], o_); } \
    LAS unsigned* cb_ = (LAS unsigned*)(F.lds + P3_CNT) + (par) * 64; \
    if (r == 0) { _Pragma("unroll") for (int a_ = 0; a_ < 4; ++a_) cb_[(hh * 4 + a_) * 8 + w] = pk_[a_]; } \
    __syncthreads(); \
    _Pragma("unroll") for (int a_ = 0; a_ < 4; ++a_) { const LAS v4u* p_ = (const LAS v4u*)(cb_ + (hh * 4 + a_) * 8); const v4u x_ = p_[0], y_ = p_[1]; \
        const unsigned t_ = (x_.x + x_.y) + (x_.z + x_.w) + (y_.x + y_.y) + (y_.z + y_.w); cres[a_][0] = (int)(t_ & 0xffffu); cres[a_][1] = (int)(t_ >> 16); } \
} while (0)

__device__ __forceinline__ void p3_prompt_item(Frame& F, int b, int qt) {
    const int tid = F.tid, lane = F.lane, w = F.wave, r = lane & 31, hh = lane >> 5;
    const int t0 = 16 * qt, L = t0 + 16, nkt32 = (L + 31) >> 5, nkt64 = (L + 63) >> 6;
    const size_t mb = (size_t)b * SEQ;
    LAS unsigned* bm = (LAS unsigned*)(F.lds + P3_BM);
    LAS float* wq = (LAS float*)(F.lds + P3_WQ);
    for (int i = tid; i < 1024; i += NWAVES * 64) bm[i] = 0u;
    if (tid < 128) wq[tid] = ((const float*)(F.ws + WS_WI))[(mb + t0 + (tid >> 3)) * 8 + (tid & 7)];
    __syncthreads();
    unsigned sk[8][4][2];
    {
        const bf16* QI = (const bf16*)(F.ws + WS_QI); const bf16* KI = (const bf16*)(F.ws + WS_KI);
#pragma unroll
        for (int ap = 0; ap < 2; ++ap) {
            bf16x8 af[2][4];
#pragma unroll
            for (int a2 = 0; a2 < 2; ++a2) { const int a = 2 * ap + a2; const int qq = 4 * a + 2 * ((r >> 2) & 1) + (r >> 4), h = (r & 3) + 4 * ((r >> 3) & 1);
                const bf16* p = QI + (mb + t0 + qq) * 512 + h * 64 + 8 * hh;
#pragma unroll
                for (int ks = 0; ks < 4; ++ks) af[a2][ks] = *(const bf16x8*)(p + 16 * ks); }
#pragma unroll
            for (int s = 0; s < 8; ++s) {
                const int kt = w + 8 * s;
                if (kt < nkt32) {
                    const bf16* kp = KI + (mb + 32 * kt + r) * 64 + 8 * hh;
                    bf16x8 bfr[4];
#pragma unroll
                    for (int ks = 0; ks < 4; ++ks) bfr[ks] = *(const bf16x8*)(kp + 16 * ks);
                    const int kidx = 32 * kt + r;
#pragma unroll
                    for (int a2 = 0; a2 < 2; ++a2) { const int a = 2 * ap + a2;
                        f32x16 acc;
#pragma unroll
                        for (int e = 0; e < 16; ++e) acc[e] = 0.f;
#pragma unroll
                        for (int ks = 0; ks < 4; ++ks) acc = __builtin_amdgcn_mfma_f32_32x32x16_bf16(af[a2][ks], bfr[ks], acc, 0, 0, 0);
#pragma unroll
                        for (int j2 = 0; j2 < 2; ++j2) { const int qq = 4 * a + 2 * hh + j2;
                            const LAS f32x4* wp = (const LAS f32x4*)(wq + qq * 8); const f32x4 w0 = wp[0], w1 = wp[1];
                            float sc = w0[0] * fmaxf(acc[8 * j2 + 0], 0.f);
                            sc += w0[1] * fmaxf(acc[8 * j2 + 1], 0.f); sc += w0[2] * fmaxf(acc[8 * j2 + 2], 0.f); sc += w0[3] * fmaxf(acc[8 * j2 + 3], 0.f);
                            sc += w1[0] * fmaxf(acc[8 * j2 + 4], 0.f); sc += w1[1] * fmaxf(acc[8 * j2 + 5], 0.f); sc += w1[2] * fmaxf(acc[8 * j2 + 6], 0.f); sc += w1[3] * fmaxf(acc[8 * j2 + 7], 0.f);
                            sk[s][a][j2] = (kidx <= t0 + qq) ? f2key(sc) : 0u; }
                    }
                } else {
#pragma unroll
                    for (int a2 = 0; a2 < 2; ++a2) { sk[s][2 * ap + a2][0] = 0u; sk[s][2 * ap + a2][1] = 0u; }
                }
            }
        }
    }
    unsigned T[4][2]; int J[4][2];
#pragma unroll
    for (int a = 0; a < 4; ++a) { T[a][0] = 1u; T[a][1] = 1u; J[a][0] = 4095; J[a][1] = 4095; }
    if (qt >= 16) {
        unsigned lo[4][2], hi[4][2]; int clo[4][2], chi[4][2]; int cres[4][2];
        {
            unsigned mn[4], mx[4];
            unsigned mn0[4], mn1[4], mx0[4], mx1[4];
#pragma unroll
            for (int a = 0; a < 4; ++a) { mn0[a] = 0xffffffffu; mn1[a] = 0xffffffffu; mx0[a] = 0u; mx1[a] = 0u;
#pragma unroll
                for (int s = 0; s < 8; ++s) { const unsigned k0 = sk[s][a][0], k1 = sk[s][a][1];
                    mn0[a] = min(mn0[a], k0 ? k0 : 0xffffffffu); mn1[a] = min(mn1[a], k1 ? k1 : 0xffffffffu); mx0[a] = max(mx0[a], k0); mx1[a] = max(mx1[a], k1); } }
#pragma unroll
            for (int o = 1; o < 32; o <<= 1) {
#pragma unroll
                for (int a = 0; a < 4; ++a) { mn0[a] = min(mn0[a], (unsigned)__shfl_xor((int)mn0[a], o)); mn1[a] = min(mn1[a], (unsigned)__shfl_xor((int)mn1[a], o));
                    mx0[a] = max(mx0[a], (unsigned)__shfl_xor((int)mx0[a], o)); mx1[a] = max(mx1[a], (unsigned)__shfl_xor((int)mx1[a], o)); } }
            LAS unsigned* xb = (LAS unsigned*)(F.lds + P3_K);
            if (r == 0) {
#pragma unroll
                for (int a = 0; a < 4; ++a) { xb[((0 * 2 + hh) * 4 + a) * 8 + w] = mn0[a]; xb[((1 * 2 + hh) * 4 + a) * 8 + w] = mn1[a]; xb[((2 * 2 + hh) * 4 + a) * 8 + w] = mx0[a]; xb[((3 * 2 + hh) * 4 + a) * 8 + w] = mx1[a]; } }
            __syncthreads();
#pragma unroll
            for (int a = 0; a < 4; ++a) { unsigned m0 = 0xffffffffu, m1 = 0xffffffffu, x0 = 0u, x1 = 0u;
#pragma unroll
                for (int ww = 0; ww < 8; ++ww) { m0 = min(m0, xb[((0 * 2 + hh) * 4 + a) * 8 + ww]); m1 = min(m1, xb[((1 * 2 + hh) * 4 + a) * 8 + ww]);
                    x0 = max(x0, xb[((2 * 2 + hh) * 4 + a) * 8 + ww]); x1 = max(x1, xb[((3 * 2 + hh) * 4 + a) * 8 + ww]); }
                lo[a][0] = m0; lo[a][1] = m1; hi[a][0] = x0 + 1u; hi[a][1] = x1 + 1u;
                clo[a][0] = t0 + 4 * a + 2 * hh + 0 + 1; clo[a][1] = t0 + 4 * a + 2 * hh + 1 + 1; chi[a][0] = 0; chi[a][1] = 0; }
            (void)mn; (void)mx;
            __syncthreads();
        }
        int pc = 0;
        unsigned done = 0u;
        unsigned tie = 0u;
        int it = 0;
        for (; it < 128; ++it) {
            unsigned mid[4][2];
#pragma unroll
            for (int a = 0; a < 4; ++a)
#pragma unroll
                for (int j2 = 0; j2 < 2; ++j2) {
                    const unsigned l_ = lo[a][j2], h_ = hi[a][j2]; unsigned m_;
                    if ((done >> (2 * a + j2)) & 1u) m_ = T[a][j2];
                    else if (h_ - l_ <= 1u) { T[a][j2] = l_; done |= 1u << (2 * a + j2); tie |= 1u << (2 * a + j2); m_ = l_; }
                    else if ((it % 3) == 2) m_ = l_ + ((h_ - l_) >> 1);
                    else { const float fl = key2f(l_), fh = key2f(h_ - 1u); const float frac = ((float)(clo[a][j2] - 256) + 0.5f) / (float)(clo[a][j2] - chi[a][j2]);
                        const float t_ = fl + (fh - fl) * frac; unsigned k_ = f2key(t_); if (!(k_ > l_)) k_ = l_ + 1u; if (!(k_ < h_)) k_ = h_ - 1u; m_ = k_; }
                    mid[a][j2] = m_; }
            if (!__any(done != 0xffu)) break;
            P3_COUNT(0, mid, J, cres, pc & 1); ++pc;
#pragma unroll
            for (int a = 0; a < 4; ++a)
#pragma unroll
                for (int j2 = 0; j2 < 2; ++j2) if (!((done >> (2 * a + j2)) & 1u)) {
                    const int c = cres[a][j2];
                    if (c == 256) { T[a][j2] = mid[a][j2]; done |= 1u << (2 * a + j2); }
                    else if (c > 256) { lo[a][j2] = mid[a][j2]; clo[a][j2] = c; }
                    else { hi[a][j2] = mid[a][j2]; chi[a][j2] = c; } }
        }
        if (__any(tie != 0u)) {
            unsigned tp1[4][2]; int cgt[4][2], need[4][2], jlo[4][2], jhi[4][2];
#pragma unroll
            for (int a = 0; a < 4; ++a) { tp1[a][0] = T[a][0] + 1u; tp1[a][1] = T[a][1] + 1u; }
            P3_COUNT(0, tp1, J, cgt, pc & 1); ++pc;
#pragma unroll
            for (int a = 0; a < 4; ++a)
#pragma unroll
                for (int j2 = 0; j2 < 2; ++j2) { need[a][j2] = 256 - cgt[a][j2]; jlo[a][j2] = -1; jhi[a][j2] = 2047; }
            for (int it2 = 0; it2 < 11; ++it2) { int jm[4][2], ce[4][2];
#pragma unroll
                for (int a = 0; a < 4; ++a) { jm[a][0] = (jlo[a][0] + jhi[a][0] + 1) >> 1; jm[a][1] = (jlo[a][1] + jhi[a][1] + 1) >> 1; }
                P3_COUNT(1, T, jm, ce, pc & 1); ++pc;
#pragma unroll
                for (int a = 0; a < 4; ++a)
#pragma unroll
                    for (int j2 = 0; j2 < 2; ++j2) { if (jhi[a][j2] - jlo[a][j2] > 1) { if (ce[a][j2] >= need[a][j2]) jhi[a][j2] = jm[a][j2]; else jlo[a][j2] = jm[a][j2]; } } }
#pragma unroll
            for (int a = 0; a < 4; ++a)
#pragma unroll
                for (int j2 = 0; j2 < 2; ++j2) if ((tie >> (2 * a + j2)) & 1u) J[a][j2] = jhi[a][j2];
        }
    }
#pragma unroll
    for (int s = 0; s < 8; ++s) { const int kt = w + 8 * s;
        if (kt < nkt32) { const int kidx = 32 * kt + r;
#pragma unroll
            for (int a = 0; a < 4; ++a)
#pragma unroll
                for (int j2 = 0; j2 < 2; ++j2) { const unsigned k = sk[s][a][j2]; const bool selv = (k > T[a][j2]) || (k == T[a][j2] && kidx <= J[a][j2]);
                    const unsigned long long bal = __ballot(selv && k != 0u);
                    if (lane == 0) { bm[(4 * a + j2) * 64 + kt] = (unsigned)bal; bm[(4 * a + 2 + j2) * 64 + kt] = (unsigned)(bal >> 32); } } } }
    __syncthreads();
#if TEST_MODE
    { unsigned* dbg = (unsigned*)(F.ws + WS_DBG_BM) + (mb + t0) * 64; for (int i = tid; i < 1024; i += NWAVES * 64) dbg[i] = bm[i]; }
#endif
    {
        const int g = w & 1, quad = w >> 1, j = lane & 15, kq = lane >> 4;
        const bf16* Q = (const bf16*)(F.ws + WS_Q); const bf16* KB = (const bf16*)(F.ws + WS_KB); const bf16* VB = (const bf16*)(F.ws + WS_VB);
        const int qq = 4 * quad + (j >> 2), hd = 4 * g + (j & 3);
        const size_t mrow = mb + t0 + qq;
        bf16x8 qf[2];
#pragma unroll
        for (int ks = 0; ks < 2; ++ks) qf[ks] = *(const bf16x8*)(Q + mrow * 512 + hd * 64 + 32 * ks + 8 * kq);
        f32x4 o[4];
#pragma unroll
        for (int dt = 0; dt < 4; ++dt) o[dt] = (f32x4){0.f, 0.f, 0.f, 0.f};
        float mrun = -INFINITY, lsum = 0.f;
        const int skey = tid >> 3, sc0 = 2 * (tid & 7);
        v4u kreg[2], vreg[2];
#define P3_STAGE_LOAD(t) do { const size_t row_ = (mb + 64 * (t) + skey) * 128; \
        kreg[0] = *(const v4u*)(KB + row_ + 8 * sc0); kreg[1] = *(const v4u*)(KB + row_ + 8 * sc0 + 8); \
        vreg[0] = *(const v4u*)(VB + row_ + 8 * sc0); vreg[1] = *(const v4u*)(VB + row_ + 8 * sc0 + 8); } while (0)
#define P3_STAGE_WRITE(bufi) do { LAS unsigned char* kb_ = F.lds + P3_K + (bufi) * 16384 + skey * 256; \
        *(LAS v4u*)(kb_ + ((sc0 ^ (skey & 15)) << 4)) = kreg[0]; *(LAS v4u*)(kb_ + (((sc0 + 1) ^ (skey & 15)) << 4)) = kreg[1]; \
        LAS unsigned char* vb_ = F.lds + P3_V + (bufi) * P3_VBUF + (sc0 >> 3) * 9216 + skey * 144 + ((sc0 & 7) << 4); \
        *(LAS v4u*)(vb_) = vreg[0]; *(LAS v4u*)(vb_ + 16) = vreg[1]; } while (0)
        P3_STAGE_LOAD(0); P3_STAGE_WRITE(0);
        __syncthreads();
        for (int t = 0; t < nkt64; ++t) {
            const int bufi = t & 1;
            if (t + 1 < nkt64) P3_STAGE_LOAD(t + 1);
            f32x4 sacc[4];
            const LAS unsigned char* kbase = F.lds + P3_K + bufi * 16384;
#pragma unroll
            for (int c = 0; c < 4; ++c) { sacc[c] = (f32x4){0.f, 0.f, 0.f, 0.f}; const int key = 16 * c + j;
#pragma unroll
                for (int ks = 0; ks < 2; ++ks) { const int ch = g * 8 + 4 * ks + kq;
                    const bf16x8 kf = *(const LAS bf16x8*)(kbase + key * 256 + ((ch ^ (key & 15)) << 4));
                    sacc[c] = __builtin_amdgcn_mfma_f32_16x16x32_bf16(kf, qf[ks], sacc[c], 0, 0, 0); } }
            const unsigned mw0 = bm[qq * 64 + 2 * t], mw1 = bm[qq * 64 + 2 * t + 1];
            float tmax = -INFINITY;
#pragma unroll
            for (int c = 0; c < 4; ++c)
#pragma unroll
                for (int e = 0; e < 4; ++e) { const unsigned mwd = (c >> 1) ? mw1 : mw0; const bool bit = (mwd >> (16 * (c & 1) + 4 * kq + e)) & 1u;
                    sacc[c][e] = bit ? sacc[c][e] : -INFINITY; tmax = fmaxf(tmax, sacc[c][e]); }
            tmax = fmaxf(tmax, __shfl_xor(tmax, 16)); tmax = fmaxf(tmax, __shfl_xor(tmax, 32));
            const float mnew = fmaxf(mrun, tmax), muse = (mnew == -INFINITY) ? 0.f : mnew;
            const float alpha = __builtin_amdgcn_exp2f(mrun - muse);
            mrun = mnew;
            float psum = 0.f;
#pragma unroll
            for (int c = 0; c < 4; ++c)
#pragma unroll
                for (int e = 0; e < 4; ++e) { const float p = __builtin_amdgcn_exp2f(sacc[c][e] - muse); sacc[c][e] = p; psum += p; }
            lsum = lsum * alpha + psum;
#pragma unroll
            for (int dt = 0; dt < 4; ++dt) o[dt] *= alpha;
            const LAS unsigned char* vbase = F.lds + P3_V + bufi * P3_VBUF + g * 9216;
#pragma unroll
            for (int ks = 0; ks < 2; ++ks) {
                v4u pw; pw.x = pk2(sacc[2 * ks][0], sacc[2 * ks][1]); pw.y = pk2(sacc[2 * ks][2], sacc[2 * ks][3]); pw.z = pk2(sacc[2 * ks + 1][0], sacc[2 * ks + 1][1]); pw.w = pk2(sacc[2 * ks + 1][2], sacc[2 * ks + 1][3]);
                const bf16x8 pf = __builtin_bit_cast(bf16x8, pw);
#pragma unroll
                for (int dt = 0; dt < 4; ++dt) {
                    const LAS unsigned char* va = vbase + (32 * ks + 4 * kq + (j >> 2)) * 144 + (16 * dt + 4 * (j & 3)) * 2;
                    typedef short v4i16_t __attribute__((ext_vector_type(4)));
                    const v4i16_t lo4 = __builtin_amdgcn_ds_read_tr16_b64_v4i16((LAS v4i16_t*)va);
                    const v4i16_t hi4 = __builtin_amdgcn_ds_read_tr16_b64_v4i16((LAS v4i16_t*)(va + 16 * 144));
                    const bf16x8 vf = (bf16x8){lo4[0], lo4[1], lo4[2], lo4[3], hi4[0], hi4[1], hi4[2], hi4[3]};
                    o[dt] = __builtin_amdgcn_mfma_f32_16x16x32_bf16(vf, pf, o[dt], 0, 0, 0); } }
            if (t + 1 < nkt64) P3_STAGE_WRITE(bufi ^ 1);
            __syncthreads();
        }
#undef P3_STAGE_LOAD
#undef P3_STAGE_WRITE
        lsum += __shfl_xor(lsum, 16); lsum += __shfl_xor(lsum, 32);
        const float inv = 1.0f / lsum;
        const bf16* GA = (const bf16*)(F.ws + WS_GA); bf16* MIX = (bf16*)(F.ws + WS_MIX);
#pragma unroll
        for (int dt = 0; dt < 4; ++dt) { const int d = 16 * dt + 4 * kq; const v2u gv = *(const v2u*)(GA + mrow * 512 + hd * 64 + d);
            const float g0 = bf2f((unsigned short)(gv.x & 0xffffu)), g1 = bf2f((unsigned short)(gv.x >> 16)), g2 = bf2f((unsigned short)(gv.y & 0xffffu)), g3 = bf2f((unsigned short)(gv.y >> 16));
            v2u ov; ov.x = pk2(o[dt][0] * inv * g0, o[dt][1] * inv * g1); ov.y = pk2(o[dt][2] * inv * g2, o[dt][3] * inv * g3);
            *(v2u*)(MIX + mrow * 1024 + hd * 64 + d) = ov; }
    }
}

constexpr int PL_U = 0, PL_W = 40960, PL_STRIDE = 272;
template <bool SAMPLE> __device__ __forceinline__ void p3_pool_item(Frame& F, int item) {
    const int tid = F.tid, lane = F.lane, w = F.wave, j = lane & 15, kq = lane >> 4;
    const bf16* U = (const bf16*)(F.ws + WS_U); const bf16* GP = (const bf16*)(F.ws + WS_GP); const bf16* WPT = (const bf16*)(F.ws + WS_WPOOLT); bf16* MIX = (bf16*)(F.ws + WS_MIX);
    const int tokb = SAMPLE ? 0 : (item & 15) * 128;
    const size_t m0 = SAMPLE ? (size_t)MP : (size_t)(item >> 4) * SEQ + tokb;
    const int tl = 16 * w + j;
    const size_t mrow = m0 + tl;
    for (int g = 0; g < 4; ++g) {
        const int win = 2 << g;
        for (int i = tid; i < 128 * 16; i += NWAVES * 64) { const int row = i >> 4, ch = i & 15;
            *(LAS v4u*)(F.lds + PL_W + row * PL_STRIDE + ch * 16) = *(const v4u*)(WPT + (size_t)g * 16384 + row * 128 + ch * 8); }
        if (!SAMPLE) {
            for (int i = tid; i < 143 * 16; i += NWAVES * 64) { const int row = i >> 4, ch = i & 15; const int tpos = tokb - 15 + row;
                v4u v = (v4u){0u, 0u, 0u, 0u};
                if (tpos >= 0) v = *(const v4u*)(U + (m0 - 15 + row) * 512 + g * 128 + ch * 8);
                *(LAS v4u*)(F.lds + PL_U + row * PL_STRIDE + ch * 16) = v; }
        }
        __syncthreads();
        bf16x8 df[4];
#pragma unroll
        for (int ks = 0; ks < 4; ++ks) {
            float sum[8], cur[8];
            if (!SAMPLE) {
                const LAS unsigned char* up = F.lds + PL_U + (15 + tl) * PL_STRIDE + (4 * ks + kq) * 16;
                { const v4u c = *(const LAS v4u*)up;
#pragma unroll
                  for (int u = 0; u < 4; ++u) { const unsigned x = c[u]; cur[2 * u] = bf2f((unsigned short)(x & 0xffffu)); cur[2 * u + 1] = bf2f((unsigned short)(x >> 16)); sum[2 * u] = cur[2 * u]; sum[2 * u + 1] = cur[2 * u + 1]; } }
                for (int i = 1; i < win; ++i) { const v4u c = *(const LAS v4u*)(up - i * PL_STRIDE);
#pragma unroll
                    for (int u = 0; u < 4; ++u) { const unsigned x = c[u]; sum[2 * u] += bf2f((unsigned short)(x & 0xffffu)); sum[2 * u + 1] += bf2f((unsigned short)(x >> 16)); } }
            } else {
                const int c0 = g * 128 + 32 * ks + 8 * kq;
                { const v4u c = *(const v4u*)(U + mrow * 512 + c0);
#pragma unroll
                  for (int u = 0; u < 4; ++u) { const unsigned x = c[u]; cur[2 * u] = bf2f((unsigned short)(x & 0xffffu)); cur[2 * u + 1] = bf2f((unsigned short)(x >> 16)); sum[2 * u] = cur[2 * u]; sum[2 * u + 1] = cur[2 * u + 1]; } }
                for (int i = 1; i < win; ++i) { const float* sp = F.state_pool + ((size_t)tl * 15 + (15 - i)) * 512 + c0; const f32x4 a = *(const f32x4*)sp, bq = *(const f32x4*)(sp + 4);
                    sum[0] += a[0]; sum[1] += a[1]; sum[2] += a[2]; sum[3] += a[3]; sum[4] += bq[0]; sum[5] += bq[1]; sum[6] += bq[2]; sum[7] += bq[3]; }
            }
            const int tpos = tokb + tl; const float rc = 1.0f / (float)(SAMPLE ? win : ((tpos + 1 < win) ? tpos + 1 : win));
            v4u pw; pw.x = pk2(sum[0] * rc - cur[0], sum[1] * rc - cur[1]); pw.y = pk2(sum[2] * rc - cur[2], sum[3] * rc - cur[3]);
            pw.z = pk2(sum[4] * rc - cur[4], sum[5] * rc - cur[5]); pw.w = pk2(sum[6] * rc - cur[6], sum[7] * rc - cur[7]);
            df[ks] = __builtin_bit_cast(bf16x8, pw);
        }
#pragma unroll
        for (int jt = 0; jt < 8; ++jt) {
            f32x4 acc = (f32x4){0.f, 0.f, 0.f, 0.f};
#pragma unroll
            for (int ks = 0; ks < 4; ++ks) { const bf16x8 wf = *(const LAS bf16x8*)(F.lds + PL_W + (16 * jt + j) * PL_STRIDE + (4 * ks + kq) * 16);
                acc = __builtin_amdgcn_mfma_f32_16x16x32_bf16(wf, df[ks], acc, 0, 0, 0); }
            const int col = g * 128 + 16 * jt + 4 * kq;
            const f32x4 ps = *(const f32x4*)(F.pool_scale + col); const v2u gv = *(const v2u*)(GP + mrow * 512 + col);
            const float g0 = bf2f((unsigned short)(gv.x & 0xffffu)), g1 = bf2f((unsigned short)(gv.x >> 16)), g2 = bf2f((unsigned short)(gv.y & 0xffffu)), g3 = bf2f((unsigned short)(gv.y >> 16));
            v2u ov; ov.x = pk2(acc[0] * ps[0] * g0, acc[1] * ps[1] * g1); ov.y = pk2(acc[2] * ps[2] * g2, acc[3] * ps[3] * g3);
            *(v2u*)(MIX + mrow * 1024 + 512 + col) = ov;
        }
        __syncthreads();
    }
}

constexpr int SM_SC = 0, SM_SEL = 8448, SM_Q = 9472, SM_P = 11520, SM_RED = 19712;
__device__ __forceinline__ void p3_sample_item(Frame& F, int s) {
    const int tid = F.tid, lane = F.lane, w = F.wave, r = lane & 31, hh = lane >> 5;
    const size_t m = (size_t)MP + s;
    LAS float* sc = (LAS float*)(F.lds + SM_SC); LAS int* sel = (LAS int*)(F.lds + SM_SEL); LAS float* ql = (LAS float*)(F.lds + SM_Q);
    LAS float* pl = (LAS float*)(F.lds + SM_P); LAS float* red = (LAS float*)(F.lds + SM_RED);
    const bf16* QI = (const bf16*)(F.ws + WS_QI) + m * 512; const float* WIp = (const float*)(F.ws + WS_WI) + m * 8;
    const int* pt = F.page_table + s * NPG;
    ql[tid] = bf2f(((const bf16*)(F.ws + WS_Q))[m * 512 + tid]);
    {
        bf16x8 af[4];
#pragma unroll
        for (int ks = 0; ks < 4; ++ks) { af[ks] = (bf16x8){0, 0, 0, 0, 0, 0, 0, 0}; if (r < 8) af[ks] = *(const bf16x8*)(QI + r * 64 + 16 * ks + 8 * hh); }
        float wv[4];
#pragma unroll
        for (int e = 0; e < 4; ++e) wv[e] = WIp[4 * hh + e];
        for (int kt = w; kt < 64; kt += 8) {
            const int page = pt[kt >> 2];
            const float* kp = F.cache_kidx + ((size_t)page * PAGE + (kt & 3) * 32 + r) * 64 + 8 * hh;
            f32x16 acc;
#pragma unroll
            for (int e = 0; e < 16; ++e) acc[e] = 0.f;
#pragma unroll
            for (int ks = 0; ks < 4; ++ks) { const f32x4 x0 = *(const f32x4*)(kp + 16 * ks), x1 = *(const f32x4*)(kp + 16 * ks + 4);
                v4u pw; pw.x = pk2(x0[0], x0[1]); pw.y = pk2(x0[2], x0[3]); pw.z = pk2(x1[0], x1[1]); pw.w = pk2(x1[2], x1[3]);
                acc = __builtin_amdgcn_mfma_f32_32x32x16_bf16(af[ks], __builtin_bit_cast(bf16x8, pw), acc, 0, 0, 0); }
            float part = wv[0] * fmaxf(acc[0], 0.f) + wv[1] * fmaxf(acc[1], 0.f) + wv[2] * fmaxf(acc[2], 0.f) + wv[3] * fmaxf(acc[3], 0.f);
            part += __shfl_xor(part, 32);
            if (hh == 0) sc[32 * kt + r] = part;
        }
        if (w == 0) {
            const float kv = bf2f(((const bf16*)(F.ws + WS_KI))[m * 64 + lane]); float tot = 0.f;
#pragma unroll
            for (int h = 0; h < 8; ++h) { const float d = wave_sum(bf2f(QI[h * 64 + lane]) * kv); tot += WIp[h] * fmaxf(d, 0.f); }
            if (lane == 0) sc[PAST] = tot;
        }
    }
    __syncthreads();
    if (w == 0) {
        unsigned key[33];
#pragma unroll
        for (int jj = 0; jj < 33; ++jj) { const int l = jj * 64 + lane; key[jj] = l < PAST + 1 ? f2key(sc[l]) : 0u; }
        unsigned Tk = 0u;
        for (int bit = 31; bit >= 0; --bit) { const unsigned cand = Tk | (1u << bit); int cnt = 0;
#pragma unroll
            for (int jj = 0; jj < 33; ++jj) cnt += __popcll(__ballot(key[jj] >= cand));
            if (cnt >= 256) Tk = cand; }
        int cgt = 0;
#pragma unroll
        for (int jj = 0; jj < 33; ++jj) cgt += __popcll(__ballot(key[jj] > Tk));
        const int need = 256 - cgt; const unsigned long long lt = (1ull << lane) - 1ull; int pos = 0, eq_seen = 0;
#pragma unroll
        for (int jj = 0; jj < 33; ++jj) { const bool gt = key[jj] > Tk, eq = key[jj] == Tk;
            const unsigned long long meq = __ballot(eq); const int eqb = eq_seen + __popcll(meq & lt);
            const bool take = gt || (eq && eqb < need); const unsigned long long mt = __ballot(take);
            if (take) sel[pos + __popcll(mt & lt)] = jj * 64 + lane;
            pos += __popcll(mt); eq_seen += __popcll(meq); }
    }
    __syncthreads();
    {
        const int jk = tid & 255, g = tid >> 8; const int l = sel[jk];
        const float* krow = l < PAST ? F.cache_k + ((size_t)pt[l >> 7] * PAGE + (l & 127)) * 128 + g * 64 : F.out + O_KS + (size_t)s * 128 + g * 64;
        float d4[4] = {0.f, 0.f, 0.f, 0.f};
#pragma unroll 4
        for (int c = 0; c < 16; ++c) { const f32x4 kv = *(const f32x4*)(krow + 4 * c);
#pragma unroll
            for (int rr = 0; rr < 4; ++rr) { const f32x4 qv = *(const LAS f32x4*)(ql + (4 * g + rr) * 64 + 4 * c); d4[rr] += (qv[0] * kv[0] + qv[1] * kv[1]) + (qv[2] * kv[2] + qv[3] * kv[3]); } }
#pragma unroll
        for (int rr = 0; rr < 4; ++rr) pl[(4 * g + rr) * 256 + jk] = d4[rr];
    }
    __syncthreads();
    {
        float v[4]; float mx = -INFINITY;
#pragma unroll
        for (int i = 0; i < 4; ++i) { v[i] = pl[w * 256 + lane + 64 * i]; mx = fmaxf(mx, v[i]); }
        mx = wave_max(mx); float sm = 0.f;
#pragma unroll
        for (int i = 0; i < 4; ++i) { v[i] = __builtin_amdgcn_exp2f(v[i] - mx); sm += v[i]; }
        sm = wave_sum(sm); const float inv = 1.0f / sm;
#pragma unroll
        for (int i = 0; i < 4; ++i) pl[w * 256 + lane + 64 * i] = v[i] * inv;
    }
    __syncthreads();
    {
        const int d = tid & 63, g = (tid >> 6) & 1, k4 = tid >> 7; float acc[4] = {0.f, 0.f, 0.f, 0.f};
        for (int jk = 64 * k4; jk < 64 * k4 + 64; ++jk) { const int l = sel[jk];
            const float* vrow = l < PAST ? F.cache_v + ((size_t)pt[l >> 7] * PAGE + (l & 127)) * 128 + g * 64 : F.out + O_VS + (size_t)s * 128 + g * 64;
            const float vv = vrow[d];
#pragma unroll
            for (int rr = 0; rr < 4; ++rr) acc[rr] += pl[(4 * g + rr) * 256 + jk] * vv; }
#pragma unroll
        for (int rr = 0; rr < 4; ++rr) red[((k4 * 2 + g) * 4 + rr) * 64 + d] = acc[rr];
    }
    __syncthreads();
    { const int h = tid >> 6, d = tid & 63; float a = 0.f;
#pragma unroll
        for (int k4 = 0; k4 < 4; ++k4) a += red[((k4 * 2 + (h >> 2)) * 4 + (h & 3)) * 64 + d];
        const float gate = bf2f(((const bf16*)(F.ws + WS_GA))[m * 512 + tid]);
        ((bf16*)(F.ws + WS_MIX))[m * 1024 + tid] = (bf16)f2bf(a * gate); }
    __syncthreads();
}

__device__ __forceinline__ void p3_mixer(Frame& F) {
    for (int p = F.bid; p < 512; p += F.G) { const int b = p >> 6, sidx = p & 63;
        p3_prompt_item(F, b, 127 - sidx); __syncthreads();
        p3_prompt_item(F, b, sidx); __syncthreads(); }
    for (int x = F.bid; x < 257; x += F.G) {
        if (x < 128) p3_sample_item(F, x);
        else if (x < 256) p3_pool_item<false>(F, x - 128);
        else p3_pool_item<true>(F, 0);
        __syncthreads();
    }
}
__device__ __forceinline__ void p4_sample_out(Frame& F) {
    if (F.bid >= 16) return;
    const int lane = F.lane, w = F.wave, rl = lane & 15, kq = lane >> 4, n0 = F.bid * 64;
    const bf16* MIXS = (const bf16*)(F.ws + WS_MIX) + (size_t)MP * 1024;
    const bf16* bb = (const bf16*)(F.ws + WS_WOUTT) + (size_t)(n0 + rl) * 1024 + 8 * kq;
    f32x4 acc[4];
    skinny_core(MIXS + (size_t)(16 * w + rl) * 1024 + 8 * kq, bb, bb + 16 * 1024, bb + 32 * 1024, bb + 48 * 1024, acc);
    const float* ada = (const float*)(F.ws + WS_ADA);
#pragma unroll
    for (int e = 0; e < 4; ++e) { const int s = 16 * w + 4 * kq + e;
#pragma unroll
        for (int j = 0; j < 4; ++j) { const int n = n0 + 16 * j + rl;
            F.out[O_YS + (size_t)s * 1024 + n] = F.xs[(size_t)s * 1024 + n] + ada[(size_t)(NB + s) * 3072 + 2048 + n] * acc[j][e]; } }
}

struct Args { const float* in[18]; float* out; unsigned char* ws; int ph_lo, ph_hi, li, pad; };
__global__ void __launch_bounds__(NWAVES * 64, 2) mk_fwd(Args args) {
    extern __shared__ __attribute__((aligned(16))) unsigned char lds[];
    Frame F;
    F.lds = (LAS unsigned char*)lds;
    F.MISC = (volatile LAS unsigned*)(F.lds + MISC_OFF);
    F.tid = threadIdx.x; F.lane = F.tid & 63; F.wave = __builtin_amdgcn_readfirstlane(F.tid >> 6);
    F.G = gridDim.x; F.bid = blockIdx.x; { const int bx = blockIdx.x; F.vcu = (F.G % 8 == 0) ? (bx % 8) * (F.G / 8) + bx / 8 : bx; }
    F.ws = args.ws; F.out = args.out; F.ctl = (gu32*)(args.ws + WS_CTL);
    F.xp = args.in[0]; F.xs = args.in[1]; F.cache_k = args.in[2]; F.cache_v = args.in[3]; F.cache_kidx = args.in[4]; F.state_pool = args.in[5];
    F.page_table = (const int*)args.in[6]; F.cp = args.in[7]; F.cs = args.in[8]; F.norm_w = args.in[9]; F.w_ada = args.in[10]; F.b_ada = args.in[11];
    F.w_in = args.in[12]; F.qnw = args.in[13]; F.knw = args.in[14]; F.w_pool = args.in[15]; F.pool_scale = args.in[16]; F.w_out = args.in[17];
    for (int u = F.tid; u < (LDS_BYTES - LDSCTL_OFF) / 4; u += NWAVES * 64) ((LAS unsigned*)(F.lds + LDSCTL_OFF))[u] = 0u;
    __syncthreads();
    XcdBarrier bar = xcd_barrier_post((unsigned*)(F.ctl + CW_BAR) + args.li * XCD_BAR_WORDS, F.MISC + 8);
    const int lo = args.ph_lo, hi = args.ph_hi;
#define IN(k) (lo <= (k) && (k) < hi)
#define BOTH(k) (IN(k) && IN((k) + 1))
    if (IN(0)) { p0_prologue(F); if (BOTH(0)) xcd_barrier(bar); }
    if (IN(1)) { p1_norm(F); if (BOTH(1)) xcd_barrier(bar); }
    if (IN(2)) {
        pg8::Gemm g{(const pg8::bf16_t*)(F.ws + WS_HB), (const pg8::bf16_t*)(F.ws + WS_WINT), MP, 3072, DM};
        pg8::StaticOrder S; S.init(MP, 3072, F.G, (int)blockIdx.x);
        pg8::EpiIn E{F.ws, F.out, F.qnw, F.knw};
        pg8::gemm_phase<pg8::EpiIn, pg8::StaticOrder, true, true>(F.lds + RING_OFF, g, S, E);
        if (BOTH(2)) xcd_barrier(bar);
    }
#if HAVE_P3
    if (IN(3)) { p3_mixer(F); if (BOTH(3)) xcd_barrier(bar); }
#endif
    if (IN(4)) {
        pg8::Gemm g{(const pg8::bf16_t*)(F.ws + WS_MIX), (const pg8::bf16_t*)(F.ws + WS_WOUTT), MP, DM, DM};
        pg8::StaticOrder S; S.init(MP, DM, F.G, (int)blockIdx.x);
        pg8::EpiOut E{F.xp, F.out + O_YP, (const float*)(F.ws + WS_ADA)};
        pg8::gemm_phase<pg8::EpiOut, pg8::StaticOrder, true, true>(F.lds + RING_OFF, g, S, E);
        p4_sample_out(F);
    }
#undef IN
#undef BOTH
}

#if TEST_MODE
namespace gold {
constexpr size_t W_ADA = 0, W_H = W_ADA + (size_t)NR * 3072, W_PROJ = W_H + (size_t)MT * 1024, W_SC = W_PROJ + (size_t)MT * NIN,
                 W_SCS = W_SC + (size_t)MP * 2048, W_SEL = W_SCS + (size_t)DECB * 2112, W_NSEL = W_SEL + (size_t)MT * 256, W_END = W_NSEL + MT;
constexpr size_t W_YT = W_H, W_MIX = W_SC, W_DB = W_SC + (size_t)MT * 1024;

__device__ __forceinline__ float wave_sum(float v) {
#pragma unroll
    for (int o = 1; o < 64; o <<= 1) v += __shfl_xor(v, o);
    return v;
}
__device__ __forceinline__ float wave_max(float v) {
#pragma unroll
    for (int o = 1; o < 64; o <<= 1) v = fmaxf(v, __shfl_xor(v, o));
    return v;
}
__device__ __forceinline__ float silu_f(float x) { return x / (1.f + expf(-x)); }

__global__ void __launch_bounds__(256) k_ada(const float* __restrict__ cp, const float* __restrict__ cs, const float* __restrict__ w_ada,
                                              const float* __restrict__ b_ada, float* __restrict__ ada) {
    const int j = blockIdx.x * 256 + threadIdx.x, r = blockIdx.y;
    const float* c = r < NB ? cp + (size_t)r * DM : cs + (size_t)(r - NB) * DM;
    float acc = 0.f;
    for (int k = 0; k < DM; ++k) { const float cv = c[k]; acc += silu_f(cv) * w_ada[(size_t)k * 3072 + j]; }
    ada[(size_t)r * 3072 + j] = acc + b_ada[j];
}

__global__ void __launch_bounds__(256) k_h(const float* __restrict__ xp, const float* __restrict__ xs, const float* __restrict__ norm_w,
                                            const float* __restrict__ ada, float* __restrict__ H) {
    const int m = blockIdx.x * 4 + (threadIdx.x >> 6), lane = threadIdx.x & 63;
    const float* x = m < MP ? xp + (size_t)m * DM : xs + (size_t)(m - MP) * DM;
    const int r = m < MP ? m / SEQ : NB + (m - MP);
    float v[16]; float ss = 0.f;
#pragma unroll
    for (int i = 0; i < 16; ++i) { v[i] = x[lane + 64 * i]; ss += v[i] * v[i]; }
    ss = wave_sum(ss);
    const float rstd = 1.0f / sqrtf(ss * (1.0f / DM) + 1e-6f);
#pragma unroll
    for (int i = 0; i < 16; ++i) { const int c = lane + 64 * i;
        H[(size_t)m * DM + c] = v[i] * rstd * norm_w[c] * (1.f + ada[(size_t)r * 3072 + 1024 + c]) + ada[(size_t)r * 3072 + c]; }
}

__global__ void __launch_bounds__(256) k_gemm(const float* __restrict__ A, const float* __restrict__ B, float* __restrict__ C,
                                               int M, int N, int K, int lda, int ldb, int ldc) {
    const int wave = threadIdx.x >> 6, lane = threadIdx.x & 63, r = lane & 31, h = lane >> 5;
    const int m0 = blockIdx.y * 128 + (wave >> 1) * 64, n0 = blockIdx.x * 128 + (wave & 1) * 64;
    f32x16 acc[2][2];
#pragma unroll
    for (int i = 0; i < 2; ++i)
#pragma unroll
        for (int j = 0; j < 2; ++j)
#pragma unroll
            for (int e = 0; e < 16; ++e) acc[i][j][e] = 0.f;
    const float* a0 = A + (size_t)(m0 + r) * lda + h;
    const float* a1 = a0 + (size_t)32 * lda;
    const int c0 = n0 + r, c1 = n0 + 32 + r; const bool v0 = c0 < N, v1 = c1 < N;
    const float* b0 = B + (size_t)h * ldb + (v0 ? c0 : 0);
    const float* b1 = B + (size_t)h * ldb + (v1 ? c1 : 0);
#pragma unroll 4
    for (int k = 0; k < K; k += 2) {
        const float x0 = a0[k], x1 = a1[k];
        float y0 = b0[(size_t)k * ldb], y1 = b1[(size_t)k * ldb];
        y0 = v0 ? y0 : 0.f; y1 = v1 ? y1 : 0.f;
        acc[0][0] = __builtin_amdgcn_mfma_f32_32x32x2f32(x0, y0, acc[0][0], 0, 0, 0);
        acc[0][1] = __builtin_amdgcn_mfma_f32_32x32x2f32(x0, y1, acc[0][1], 0, 0, 0);
        acc[1][0] = __builtin_amdgcn_mfma_f32_32x32x2f32(x1, y0, acc[1][0], 0, 0, 0);
        acc[1][1] = __builtin_amdgcn_mfma_f32_32x32x2f32(x1, y1, acc[1][1], 0, 0, 0);
    }
#pragma unroll
    for (int i = 0; i < 2; ++i)
#pragma unroll
        for (int j = 0; j < 2; ++j) { const int col = n0 + 32 * j + r;
            if (col < N) {
#pragma unroll
                for (int e = 0; e < 16; ++e) { const int row = m0 + 32 * i + (e & 3) + 8 * (e >> 2) + 4 * h; C[(size_t)row * ldc + col] = acc[i][j][e]; } } }
}

__global__ void __launch_bounds__(256) k_post(float* __restrict__ proj, const float* __restrict__ qnw, const float* __restrict__ knw,
                                               const float* __restrict__ state_pool, float* __restrict__ out) {
    const int m = blockIdx.x * 4 + (threadIdx.x >> 6), lane = threadIdx.x & 63;
    float* p = proj + (size_t)m * NIN;
    for (int hh = 0; hh < 8; ++hh) { const float v = p[CQ + hh * 64 + lane]; const float ss = wave_sum(v * v);
        p[CQ + hh * 64 + lane] = v * (1.0f / sqrtf(ss * (1.f / 64.f) + 1e-6f)) * qnw[lane]; }
    float* ko = m < MP ? out + O_KP + (size_t)m * 128 : out + O_KS + (size_t)(m - MP) * 128;
    float* vo = m < MP ? out + O_VP + (size_t)m * 128 : out + O_VS + (size_t)(m - MP) * 128;
    float* kio = m < MP ? out + O_KIP + (size_t)m * 64 : out + O_KIS + (size_t)(m - MP) * 64;
    for (int g = 0; g < 2; ++g) { const float v = p[CK + g * 64 + lane]; const float ss = wave_sum(v * v);
        const float kn = v * (1.0f / sqrtf(ss * (1.f / 64.f) + 1e-6f)) * knw[lane];
        p[CK + g * 64 + lane] = kn; ko[g * 64 + lane] = kn; vo[g * 64 + lane] = p[CV + g * 64 + lane]; }
    kio[lane] = p[CKI + lane];
    if (lane < 8) p[CWI + lane] *= 0.04419417382415922f;
    if (m < MP) { const int b = m / SEQ, t = m % SEQ;
        if (t >= SEQ - 15) { float* po = out + O_PP + ((size_t)b * 15 + (t - (SEQ - 15))) * 512;
            for (int c = lane; c < 512; c += 64) po[c] = p[CU + c]; }
    } else { const int s = m - MP; float* po = out + O_PS + (size_t)s * 15 * 512;
        for (int i = lane; i < 14 * 512; i += 64) po[i] = state_pool[(size_t)s * 15 * 512 + 512 + i];
        for (int c = lane; c < 512; c += 64) po[14 * 512 + c] = p[CU + c]; }
}

__global__ void __launch_bounds__(256) k_scores_p(const float* __restrict__ proj, float* __restrict__ SC) {
    __shared__ float qs[8][512]; __shared__ float wsm[8][8];
    const int b = blockIdx.y, t0 = blockIdx.x * 8, tid = threadIdx.x;
    for (int i = tid; i < 8 * 512; i += 256) qs[i >> 9][i & 511] = proj[(size_t)(b * SEQ + t0 + (i >> 9)) * NIN + CQI + (i & 511)];
    if (tid < 64) wsm[tid >> 3][tid & 7] = proj[(size_t)(b * SEQ + t0 + (tid >> 3)) * NIN + CWI + (tid & 7)];
    __syncthreads();
    for (int l = tid; l <= t0 + 7; l += 256) {
        float kr[64];
        const float4* kp = (const float4*)(proj + (size_t)(b * SEQ + l) * NIN + CKI);
#pragma unroll
        for (int i = 0; i < 16; ++i) { const float4 v = kp[i]; kr[4 * i] = v.x; kr[4 * i + 1] = v.y; kr[4 * i + 2] = v.z; kr[4 * i + 3] = v.w; }
        for (int q = 0; q < 8; ++q) {
            if (l > t0 + q) continue;
            float s = 0.f;
            for (int hh = 0; hh < 8; ++hh) { float d = 0.f;
#pragma unroll
                for (int e = 0; e < 64; ++e) d += qs[q][hh * 64 + e] * kr[e];
                s += wsm[q][hh] * fmaxf(d, 0.f); }
            SC[(size_t)(b * SEQ + t0 + q) * 2048 + l] = s;
        }
    }
}
__global__ void __launch_bounds__(256) k_scores_s(const float* __restrict__ proj, const float* __restrict__ cache_kidx, const int* __restrict__ page_table,
                                                   float* __restrict__ SCS) {
    __shared__ float qs[512]; __shared__ float wsm[8];
    const int s = blockIdx.x, tid = threadIdx.x; const float* prow = proj + (size_t)(MP + s) * NIN;
    for (int i = tid; i < 512; i += 256) qs[i] = prow[CQI + i];
    if (tid < 8) wsm[tid] = prow[CWI + tid];
    __syncthreads();
    for (int l = tid; l < PAST + 1; l += 256) {
        const float* kp_ = l < PAST ? cache_kidx + ((size_t)page_table[s * NPG + l / PAGE] * PAGE + (l % PAGE)) * 64 : prow + CKI;
        float kr[64];
#pragma unroll
        for (int i = 0; i < 64; ++i) kr[i] = kp_[i];
        float sc = 0.f;
        for (int hh = 0; hh < 8; ++hh) { float d = 0.f;
#pragma unroll
            for (int e = 0; e < 64; ++e) d += qs[hh * 64 + e] * kr[e];
            sc += wsm[hh] * fmaxf(d, 0.f); }
        SCS[(size_t)s * 2112 + l] = sc;
    }
}

__device__ __forceinline__ unsigned f2key(float f) { unsigned u = __float_as_uint(f); if (f == 0.0f) u = 0u; return (u & 0x80000000u) ? ~u : (u | 0x80000000u); }
__global__ void __launch_bounds__(256) k_topk(const float* __restrict__ SC, const float* __restrict__ SCS, int* __restrict__ SEL, int* __restrict__ NSEL) {
    const int m = blockIdx.x * 4 + (threadIdx.x >> 6), lane = threadIdx.x & 63;
    const float* src; int n;
    if (m < MP) { n = (m % SEQ) + 1; src = SC + (size_t)m * 2048; } else { n = PAST + 1; src = SCS + (size_t)(m - MP) * 2112; }
    int* sel = SEL + (size_t)m * 256;
    if (n <= 256) { for (int i = lane; i < n; i += 64) sel[i] = i; if (lane == 0) NSEL[m] = n; return; }
    unsigned key[33];
#pragma unroll
    for (int j = 0; j < 33; ++j) { const int l = j * 64 + lane; key[j] = l < n ? f2key(src[l]) : 0u; }
    unsigned T = 0u;
    for (int bit = 31; bit >= 0; --bit) { const unsigned cand = T | (1u << bit); int cnt = 0;
#pragma unroll
        for (int j = 0; j < 33; ++j) cnt += __popcll(__ballot(key[j] >= cand));
        if (cnt >= 256) T = cand; }
    int cgt = 0;
#pragma unroll
    for (int j = 0; j < 33; ++j) cgt += __popcll(__ballot(key[j] > T));
    const int need = 256 - cgt;
    const unsigned long long lt = (1ull << lane) - 1ull;
    int pos = 0, eq_seen = 0;
#pragma unroll
    for (int j = 0; j < 33; ++j) { const bool gt = key[j] > T, eq = key[j] == T;
        const unsigned long long meq = __ballot(eq); const int eqb = eq_seen + __popcll(meq & lt);
        const bool take = gt || (eq && eqb < need);
        const unsigned long long mt = __ballot(take);
        if (take) sel[pos + __popcll(mt & lt)] = j * 64 + lane;
        pos += __popcll(mt); eq_seen += __popcll(meq); }
    if (lane == 0) NSEL[m] = 256;
}

__global__ void __launch_bounds__(256) k_attn(const float* __restrict__ proj, const float* __restrict__ cache_k, const float* __restrict__ cache_v,
                                               const int* __restrict__ page_table, const int* __restrict__ SEL, const int* __restrict__ NSEL, float* __restrict__ MIX) {
    __shared__ float pl[4][8][256]; __shared__ int il[4][256]; __shared__ float ql[4][512];
    const int w = threadIdx.x >> 6, lane = threadIdx.x & 63, m = blockIdx.x * 4 + w;
    const int nsel = NSEL[m]; const float* prow = proj + (size_t)m * NIN;
    const bool prompt = m < MP; const int b = m / SEQ, s = m - MP;
    for (int i = lane; i < 512; i += 64) ql[w][i] = prow[CQ + i];
    for (int i = lane; i < 256; i += 64) {
        if (i < nsel) { const int l = SEL[(size_t)m * 256 + i]; il[w][i] = l;
            const float* krow = prompt ? proj + (size_t)(b * SEQ + l) * NIN + CK
                                       : (l < PAST ? cache_k + ((size_t)page_table[s * NPG + l / PAGE] * PAGE + (l % PAGE)) * 128 : prow + CK);
            for (int g = 0; g < 2; ++g) { float kr[64];
#pragma unroll
                for (int e = 0; e < 64; ++e) kr[e] = krow[g * 64 + e];
                for (int r = 0; r < 4; ++r) { float d = 0.f;
#pragma unroll
                    for (int e = 0; e < 64; ++e) d += ql[w][(g * 4 + r) * 64 + e] * kr[e];
                    pl[w][g * 4 + r][i] = d * 0.125f; } }
        } else { il[w][i] = 0; for (int hh = 0; hh < 8; ++hh) pl[w][hh][i] = -INFINITY; }
    }
    for (int hh = 0; hh < 8; ++hh) { float v[4]; float mx = -INFINITY;
#pragma unroll
        for (int i = 0; i < 4; ++i) { v[i] = pl[w][hh][lane + 64 * i]; mx = fmaxf(mx, v[i]); }
        mx = wave_max(mx); float sm = 0.f;
#pragma unroll
        for (int i = 0; i < 4; ++i) { v[i] = expf(v[i] - mx); sm += v[i]; }
        sm = wave_sum(sm); const float inv = 1.0f / sm;
#pragma unroll
        for (int i = 0; i < 4; ++i) pl[w][hh][lane + 64 * i] = v[i] * inv; }
    for (int g = 0; g < 2; ++g) { float acc[4] = {0.f, 0.f, 0.f, 0.f};
        for (int i = 0; i < nsel; ++i) { const int l = il[w][i];
            const float* vrow = prompt ? proj + (size_t)(b * SEQ + l) * NIN + CV
                                       : (l < PAST ? cache_v + ((size_t)page_table[s * NPG + l / PAGE] * PAGE + (l % PAGE)) * 128 : prow + CV);
            const float vv = vrow[g * 64 + lane];
#pragma unroll
            for (int r = 0; r < 4; ++r) acc[r] += pl[w][g * 4 + r][i] * vv; }
#pragma unroll
        for (int r = 0; r < 4; ++r) { const int c = (g * 4 + r) * 64 + lane; MIX[(size_t)m * 1024 + c] = acc[r] * silu_f(prow[CGA + c]); } }
}

__global__ void __launch_bounds__(256) k_pool_d(const float* __restrict__ proj, const float* __restrict__ state_pool, float* __restrict__ DB) {
    const size_t idx = (size_t)blockIdx.x * 256 + threadIdx.x; const int m = (int)(idx >> 9), c = (int)(idx & 511);
    const int g = c >> 7, w = 2 << g; const float un = proj[(size_t)m * NIN + CU + c]; float sum = un; float cnt;
    if (m < MP) { const int t = m % SEQ; for (int i = 1; i < w; ++i) if (t - i >= 0) sum += proj[(size_t)(m - i) * NIN + CU + c]; cnt = (float)(t + 1 < w ? t + 1 : w); }
    else { const int s = m - MP; for (int i = 1; i < w; ++i) sum += state_pool[((size_t)s * 15 + (15 - i)) * 512 + c]; cnt = (float)w; }
    DB[idx] = sum / cnt - un;
}
__global__ void __launch_bounds__(256) k_pool_out(const float* __restrict__ proj, const float* __restrict__ DB, const float* __restrict__ w_pool,
                                                   const float* __restrict__ pool_scale, float* __restrict__ MIX) {
    const size_t idx = (size_t)blockIdx.x * 256 + threadIdx.x; const int m = (int)(idx >> 9), col = (int)(idx & 511), g = col >> 7, j = col & 127;
    float acc = 0.f;
    for (int c = 0; c < 128; ++c) acc += DB[(size_t)m * 512 + g * 128 + c] * w_pool[((size_t)g * 128 + c) * 128 + j];
    MIX[(size_t)m * 1024 + 512 + col] = acc * pool_scale[col] * silu_f(proj[(size_t)m * NIN + CGP + col]);
}
__global__ void __launch_bounds__(256) k_final(const float* __restrict__ xp, const float* __restrict__ xs, const float* __restrict__ ada,
                                                const float* __restrict__ YT, float* __restrict__ out) {
    const size_t idx = (size_t)blockIdx.x * 256 + threadIdx.x; const int m = (int)(idx >> 10), c = (int)(idx & 1023);
    const int r = m < MP ? m / SEQ : NB + (m - MP);
    const float x = m < MP ? xp[idx] : xs[idx - (size_t)MP * 1024];
    float* o = m < MP ? out + O_YP + idx : out + O_YS + (idx - (size_t)MP * 1024);
    *o = x + ada[(size_t)r * 3072 + 2048 + c] * YT[idx];
}

}
#endif

#if TEST_MODE
__global__ void __launch_bounds__(256) k_cmp(const void* a, int a_bf16, int lda, const float* ref, int ldr, int rows, int cols, float scale, int act, float* accum) {
    __shared__ float sd[256], sr[256];
    const size_t idx = (size_t)blockIdx.x * 256 + threadIdx.x; float d2 = 0.f, r2 = 0.f;
    if (idx < (size_t)rows * cols) { const size_t r = idx / cols, c = idx % cols;
        const float av = a_bf16 ? bf2f(((const bf16*)a)[r * lda + c]) : ((const float*)a)[r * lda + c];
        float rv = ref[r * ldr + c]; if (act) rv = rv / (1.f + expf(-rv)); rv *= scale;
        d2 = (av - rv) * (av - rv); r2 = rv * rv; if (!(d2 == d2)) d2 = 1e30f; }
    sd[threadIdx.x] = d2; sr[threadIdx.x] = r2; __syncthreads();
    for (int s = 128; s > 0; s >>= 1) { if ((int)threadIdx.x < s) { sd[threadIdx.x] += sd[threadIdx.x + s]; sr[threadIdx.x] += sr[threadIdx.x + s]; } __syncthreads(); }
    if (threadIdx.x == 0) { atomicAdd(accum, sd[0]); atomicAdd(accum + 1, sr[0]); }
}
__global__ void __launch_bounds__(256) k_cmp_sel(const int* SEL, const int* NSEL, const unsigned* bmdump, float* accum) {
    __shared__ float sd[256], sr[256];
    const size_t idx = (size_t)blockIdx.x * 256 + threadIdx.x; const int m = (int)(idx >> 8), i = (int)(idx & 255); float miss = 0.f, tot = 0.f;
    if (m < MP && i < NSEL[m]) { const int l = SEL[(size_t)m * 256 + i]; tot = 1.f; if (!((bmdump[(size_t)m * 64 + (l >> 5)] >> (l & 31)) & 1u)) miss = 1.f; }
    sd[threadIdx.x] = miss; sr[threadIdx.x] = tot; __syncthreads();
    for (int s = 128; s > 0; s >>= 1) { if ((int)threadIdx.x < s) { sd[threadIdx.x] += sd[threadIdx.x + s]; sr[threadIdx.x] += sr[threadIdx.x + s]; } __syncthreads(); }
    if (threadIdx.x == 0) { atomicAdd(accum, sd[0]); atomicAdd(accum + 1, sr[0]); }
}
__global__ void k_cmp_fin2(float* accum, int n, float amp) {
    float best = -1.f; int bi = 0;
    for (int k = 0; k < n; ++k) { const float rel = accum[2 * k] / fmaxf(accum[2 * k + 1], 1e-30f) / accum[32 + k]; if (rel > best) { best = rel; bi = k; } }
    accum[64] = sqrtf(amp * best); accum[65] = (float)bi;
}
__global__ void k_set(float* p, float a, float b, float c, float d, float e) { p[0] = a; p[1] = b; p[2] = c; p[3] = d; p[4] = e; }
__global__ void k_cmp_fin(float* accum, int n, float amp) {
    float best = -1.f; int bi = 0;
    for (int k = 0; k < n; ++k) { const float rel = accum[2 * k] / fmaxf(accum[2 * k + 1], 1e-30f); if (rel > best) { best = rel; bi = k; } }
    accum[64] = sqrtf(amp * best); accum[65] = (float)bi;
}
__global__ void __launch_bounds__(256) k_perturb(float* out, const float* accum) {
    const size_t offs[11] = {O_YP, O_YS, O_KP, O_VP, O_KIP, O_PP, O_KS, O_VS, O_KIS, O_PS, O_END};
    const int k = (int)accum[65] % 10; const float f = 1.0f + accum[64];
    for (size_t i = offs[k] + (size_t)blockIdx.x * 256 + threadIdx.x; i < offs[k + 1]; i += (size_t)gridDim.x * 256) out[i] *= f;
}
__global__ void __launch_bounds__(256) k_f32_to_bf16(const float* src, bf16* dst, size_t n) {
    for (size_t i = (size_t)blockIdx.x * 256 + threadIdx.x; i < n; i += (size_t)gridDim.x * 256) dst[i] = (bf16)f2bf(src[i]);
}
#endif

extern "C" void kernel_launch(void* const* d_in, const int* in_sizes, int n_in, void* d_out, int out_size, void* d_ws, size_t ws_size, hipStream_t stream) {
    static int grid = 0;
    if (grid == 0) {
        size_t need = WS_MEGA_END;
#if TEST_MODE
        need = 192 * MiB + gold::W_END * 4;
#endif
        if (n_in != 18 || out_size != (int)O_END || ws_size < need) { fprintf(stderr, "kernel_launch: unexpected sizes: n_in %d out %d ws %zu (need %zu)\n", n_in, out_size, ws_size, need); grid = -1; return; }
        int dev = 0, cus = 0, per_cu = 0;
        if (hipGetDevice(&dev) != hipSuccess || hipDeviceGetAttribute(&cus, hipDeviceAttributeMultiprocessorCount, dev) != hipSuccess) { grid = -1; return; }
        if (hipFuncSetAttribute((const void*)mk_fwd, hipFuncAttributeMaxDynamicSharedMemorySize, LDS_BYTES) != hipSuccess) { fprintf(stderr, "kernel_launch: hipFuncSetAttribute failed\n"); grid = -1; return; }
        if (hipOccupancyMaxActiveBlocksPerMultiprocessor(&per_cu, (const void*)mk_fwd, NWAVES * 64, LDS_BYTES) != hipSuccess || per_cu < 1) { fprintf(stderr, "kernel_launch: occupancy query says %d blocks/CU\n", per_cu); (void)hipGetLastError(); grid = -1; return; }
        grid = cus;
    }
    if (grid < 0) return;
    (void)hipMemsetAsync((char*)d_ws + WS_CTL, 0, CTL_ZERO_BYTES, stream);
    Args a{};
    for (int i = 0; i < 18; ++i) a.in[i] = (const float*)d_in[i];
    a.out = (float*)d_out; a.ws = (unsigned char*)d_ws;
#if TEST_MODE
    {
        using namespace gold;
        const float* xp = (const float*)d_in[0]; const float* xs = (const float*)d_in[1];
        const float* cache_k = (const float*)d_in[2]; const float* cache_v = (const float*)d_in[3]; const float* cache_kidx = (const float*)d_in[4];
        const float* state_pool = (const float*)d_in[5]; const int* page_table = (const int*)d_in[6];
        const float* cp = (const float*)d_in[7]; const float* cs = (const float*)d_in[8]; const float* norm_w = (const float*)d_in[9];
        const float* w_ada = (const float*)d_in[10]; const float* b_ada = (const float*)d_in[11]; const float* w_in = (const float*)d_in[12];
        const float* qnw = (const float*)d_in[13]; const float* knw = (const float*)d_in[14]; const float* w_pool = (const float*)d_in[15];
        const float* pool_scale = (const float*)d_in[16]; const float* w_out = (const float*)d_in[17];
        float* out = (float*)d_out; float* ws = (float*)((char*)d_ws + 192 * MiB);
        float *ADA = ws + W_ADA, *H = ws + W_H, *PROJ = ws + W_PROJ, *SC = ws + W_SC, *SCS = ws + W_SCS, *MIX = ws + W_MIX, *DB = ws + W_DB, *YT = ws + W_YT;
        int *SEL = (int*)(ws + W_SEL), *NSEL = (int*)(ws + W_NSEL);
        k_ada<<<dim3(12, NR), 256, 0, stream>>>(cp, cs, w_ada, b_ada, ADA);
        k_h<<<MT / 4, 256, 0, stream>>>(xp, xs, norm_w, ADA, H);
        k_gemm<<<dim3((NIN + 127) / 128, MT / 128), 256, 0, stream>>>(H, w_in, PROJ, MT, NIN, DM, DM, NIN, NIN);
        k_post<<<MT / 4, 256, 0, stream>>>(PROJ, qnw, knw, state_pool, out);
        k_scores_p<<<dim3(SEQ / 8, NB), 256, 0, stream>>>(PROJ, SC);
        k_scores_s<<<DECB, 256, 0, stream>>>(PROJ, cache_kidx, page_table, SCS);
        k_topk<<<MT / 4, 256, 0, stream>>>(SC, SCS, SEL, NSEL);
        k_attn<<<MT / 4, 256, 0, stream>>>(PROJ, cache_k, cache_v, page_table, SEL, NSEL, MIX);
        k_pool_d<<<(MT * 512) / 256, 256, 0, stream>>>(PROJ, state_pool, DB);
        k_pool_out<<<(MT * 512) / 256, 256, 0, stream>>>(PROJ, DB, w_pool, pool_scale, MIX);
        k_gemm<<<dim3(1024 / 128, MT / 128), 256, 0, stream>>>(MIX, w_out, YT, MT, 1024, 1024, 1024, 1024, 1024);
        k_final<<<(MT * 1024) / 256, 256, 0, stream>>>(xp, xs, ADA, YT, out);
        unsigned char* mws = (unsigned char*)d_ws;
#if TEST_MODE == 1
        a.ph_lo = 0; a.ph_hi = 3; a.li = 0;
        hipLaunchKernelGGL(mk_fwd, dim3(grid), dim3(NWAVES * 64), LDS_BYTES, stream, a);
        float* accum = (float*)(mws + WS_CTL + 512 * 1024);
        struct { const void* a; int bf; int lda; int refcol; int cols; float scale; int act; } L[9] = {
            {mws + WS_Q, 1, 512, CQ, 512, C2, 0}, {mws + WS_QI, 1, 512, CQI, 512, 1.f, 0}, {mws + WS_GA, 1, 512, CGA, 512, 1.f, 1}, {mws + WS_U, 1, 512, CU, 512, 1.f, 0},
            {mws + WS_GP, 1, 512, CGP, 512, 1.f, 1}, {mws + WS_KB, 1, 128, CK, 128, 1.f, 0}, {mws + WS_VB, 1, 128, CV, 128, 1.f, 0}, {mws + WS_KI, 1, 64, CKI, 64, 1.f, 0},
            {mws + WS_WI, 0, 8, CWI, 8, 1.f, 0} };
        for (int k = 0; k < 9; ++k) k_cmp<<<(unsigned)(((size_t)MT * L[k].cols + 255) / 256), 256, 0, stream>>>(L[k].a, L[k].bf, L[k].lda, PROJ + L[k].refcol, NIN, MT, L[k].cols, L[k].scale, L[k].act, accum + 2 * k);
        k_cmp<<<(NR * 3072 + 255) / 256, 256, 0, stream>>>(mws + WS_ADA, 0, 3072, ADA, 3072, NR, 3072, 1.f, 0, accum + 18);
        k_cmp_fin<<<1, 1, 0, stream>>>(accum, 10, 5.0f);
        k_perturb<<<1024, 256, 0, stream>>>(out, accum);
#elif TEST_MODE == 3
        a.ph_lo = 0; a.ph_hi = 5; a.li = 0;
        hipLaunchKernelGGL(mk_fwd, dim3(grid), dim3(NWAVES * 64), LDS_BYTES, stream, a);
        float* accum = (float*)(mws + WS_CTL + 512 * 1024);
        const bf16* MB = (const bf16*)(mws + WS_MIX);
        k_cmp<<<(unsigned)(((size_t)MP * 512 + 255) / 256), 256, 0, stream>>>(MB, 1, 1024, MIX, 1024, MP, 512, 1.f, 0, accum + 0);
        k_cmp<<<(unsigned)(((size_t)MP * 512 + 255) / 256), 256, 0, stream>>>(MB + 512, 1, 1024, MIX + 512, 1024, MP, 512, 1.f, 0, accum + 2);
        k_cmp<<<(DECB * 512 + 255) / 256, 256, 0, stream>>>(MB + (size_t)MP * 1024, 1, 1024, MIX + (size_t)MP * 1024, 1024, DECB, 512, 1.f, 0, accum + 4);
        k_cmp<<<(DECB * 512 + 255) / 256, 256, 0, stream>>>(MB + (size_t)MP * 1024 + 512, 1, 1024, MIX + (size_t)MP * 1024 + 512, 1024, DECB, 512, 1.f, 0, accum + 6);
        k_cmp_sel<<<MP, 256, 0, stream>>>(SEL, NSEL, (const unsigned*)(mws + WS_DBG_BM), accum + 8);
        k_set<<<1, 1, 0, stream>>>(accum + 32, P3_TOL0, P3_TOL1, P3_TOL2, P3_TOL3, P3_TOL4);
        k_cmp_fin2<<<1, 1, 0, stream>>>(accum, 5, 1e-5f);
        k_perturb<<<1024, 256, 0, stream>>>(out, accum);
#elif TEST_MODE == 2
        a.ph_lo = 0; a.ph_hi = 3; a.li = 0;
        hipLaunchKernelGGL(mk_fwd, dim3(grid), dim3(NWAVES * 64), LDS_BYTES, stream, a);
        k_f32_to_bf16<<<2048, 256, 0, stream>>>(MIX, (bf16*)(mws + WS_MIX), (size_t)MT * 1024);
        a.ph_lo = 4; a.ph_hi = 5; a.li = 1;
        hipLaunchKernelGGL(mk_fwd, dim3(grid), dim3(NWAVES * 64), LDS_BYTES, stream, a);
#endif
    }
#else
    a.ph_lo = 0; a.ph_hi = 5; a.li = 0;
    hipLaunchKernelGGL(mk_fwd, dim3(grid), dim3(NWAVES * 64), LDS_BYTES, stream, a);
#endif
}
```

```cpp
#define TEST_MODE 0
#define HAVE_P3 1
#define STAMP_BLK 0
#define TS0 0
#define TS1 1
#define P3_TOL0 1e-2f
#define P3_TOL1 1e-4f
#define P3_TOL2 1e-2f
#define P3_TOL3 1e-4f
#define P3_TOL4 3e-2f
#include <hip/hip_runtime.h>
#include <cstdio>
#include <cstdint>

constexpr int DM = 1024, NB = 8, SEQ = 2048, DECB = 128, PAST = 2048, PAGE = 128, NPG = 16;
constexpr int NIN = 2888, MP = NB * SEQ, MT = MP + DECB, NR = NB + DECB;
constexpr int CQ = 0, CK = 512, CV = 640, CQI = 768, CKI = 1280, CWI = 1344, CGA = 1352, CU = 1864, CGP = 2376;
constexpr size_t O_YP = 0, O_YS = 16777216, O_KP = 16908288, O_VP = 19005440, O_KIP = 21102592, O_PP = 22151168,
                 O_KS = 22212608, O_VS = 22228992, O_KIS = 22245376, O_PS = 22253568, O_END = 23236608;
constexpr float C2 = 0.125f * 1.4426950408889634f;
constexpr float WI_SCALE = 0.04419417382415922f;
constexpr float EPS = 1e-6f;
constexpr size_t MiB = 1u << 20;
constexpr size_t WS_CTL = 0, CTL_ZERO_BYTES = 1 * MiB;
constexpr size_t WS_ADA = 1 * MiB, WS_WINT = 3 * MiB, WS_WOUTT = 9 * MiB, WS_WPOOLT = 11 * MiB, WS_HS = 12 * MiB, WS_HB = 24 * MiB,
                 WS_Q = 56 * MiB, WS_QI = 73 * MiB, WS_GA = 90 * MiB, WS_U = 107 * MiB, WS_GP = 124 * MiB, WS_KB = 141 * MiB, WS_VB = 146 * MiB,
                 WS_KI = 151 * MiB, WS_WI = 154 * MiB, WS_MIX = 155 * MiB, WS_DBG_BM = 188 * MiB, WS_MEGA_END = 192 * MiB;
namespace pg8 {
#define PG8_LAS __attribute__((address_space(3)))
typedef unsigned short bf16_t;
typedef short bf16x8 __attribute__((ext_vector_type(8)));
typedef float f32x4 __attribute__((ext_vector_type(4)));
typedef unsigned u32x4 __attribute__((ext_vector_type(4)));
constexpr int BM = 256, BK = 64, HALF = 128, HTB = HALF * BK * 2  , STAGE_BYTES = 8 * HTB, NXCD = 8, WGM = 8;

__host__ __device__ __forceinline__ int lds_byte(int r, int c) { const int st = (r >> 4) * 2 + (c >> 5), rr = r & 15, cc = c & 31, ob = rr * 64 + cc * 2; return st * 1024 + (ob ^ (((ob >> 9) & 1) << 5)); }
__host__ __device__ __forceinline__ void stage_rc(int b, int& R, int& C) { const int st = b / 1024, sb = b % 1024, swz = sb ^ (((sb >> 9) & 1) << 5); R = (st >> 1) * 16 + swz / 64; C = (st & 1) * 32 + (swz % 64) / 2; }
__host__ __device__ __forceinline__ int perm32(int rho) { const int n = rho >> 4, i = rho & 15; return 8 * (i >> 2) + 4 * n + (i & 3); }

struct Unit { int pm, pn; };
struct Gemm { const bf16_t* A; const bf16_t* Bt; int M, N, K; };

struct StaticOrder {
    int nM, nN, nwg, G, c;
    __host__ __device__ void init(int M, int N, int G_, int c_) { nM = M / BM; nN = N / BM; nwg = nM * nN; G = G_; c = c_; }
    __host__ __device__ bool next(int i, Unit& u) const {
        const long L = (long)i * G + c; if (L >= nwg) return false;
        int wgid = (int)L; { const int q = nwg / NXCD, r = nwg % NXCD, xcd = wgid % NXCD, off = wgid / NXCD; wgid = (xcd < r ? xcd * (q + 1) : r * (q + 1) + (xcd - r) * q) + off; }
        const int nig = WGM * nN, gid = wgid / nig, fm = gid * WGM, gsz = (nM - fm) < WGM ? (nM - fm) : WGM;
        u.pm = fm + ((wgid % nig) % gsz); u.pn = (wgid % nig) / gsz; return true;
    }
    __device__ __forceinline__ void a_ready(const Unit&) const {}
    __device__ __forceinline__ void done(const Unit&) const {}
};


typedef unsigned u32x4 __attribute__((ext_vector_type(4)));
__device__ __forceinline__ unsigned cvt_pk_bf16(float lo, float hi) { unsigned r; asm volatile("v_cvt_pk_bf16_f32 %0, %1, %2" : "=v"(r) : "v"(lo), "v"(hi)); return r; }
__device__ __forceinline__ void st_bf16x8(bf16_t* p, const f32x4 a, const f32x4 b) {
    u32x4 w; w.x = cvt_pk_bf16(a[0], a[1]); w.y = cvt_pk_bf16(a[2], a[3]); w.z = cvt_pk_bf16(b[0], b[1]); w.w = cvt_pk_bf16(b[2], b[3]); *(u32x4*)p = w; }
__device__ __forceinline__ float silu1(float x) { return x * __builtin_amdgcn_rcpf(1.0f + __builtin_amdgcn_exp2f(-1.4426950408889634f * x)); }
__device__ __forceinline__ f32x4 silu4(const f32x4 v) { f32x4 r; r[0] = silu1(v[0]); r[1] = silu1(v[1]); r[2] = silu1(v[2]); r[3] = silu1(v[3]); return r; }

struct EpiIn {
    static constexpr bool PERM = true, AFTER_DRAIN = false;
    unsigned char* ws; float* out; const float* qnw; const float* knw;
    __device__ __forceinline__ void operator()(const f32x4 (&acc)[2][2][4][2], const Unit& u, int wr, int wc, int fr, int fq) const {
        const int pn = u.pn;
        if (pn == 5 && wc >= 2) return;
        const int rowb = u.pm * 256 + wr * 64 + fr, dof = 8 * fq;
        if (pn <= 1 || (pn == 2 && wc < 2)) {
            const float* nwp = pn <= 1 ? qnw : knw; const float sc = pn <= 1 ? C2 : 1.0f;
            f32x4 wv[2][2];
#pragma unroll
            for (int bj = 0; bj < 2; ++bj)
#pragma unroll
                for (int n = 0; n < 2; ++n) wv[bj][n] = *(const f32x4*)(nwp + 32 * bj + dof + 4 * n) * sc;
#pragma unroll
            for (int ai = 0; ai < 2; ++ai)
#pragma unroll
                for (int m = 0; m < 4; ++m) { const size_t row = (size_t)(rowb + ai * 128 + m * 16); float ss = 0.f;
#pragma unroll
                    for (int bj = 0; bj < 2; ++bj)
#pragma unroll
                        for (int n = 0; n < 2; ++n) { const f32x4 x = acc[ai][bj][m][n]; ss += (x[0] * x[0] + x[1] * x[1]) + (x[2] * x[2] + x[3] * x[3]); }
                    ss += __shfl_xor(ss, 16); ss += __shfl_xor(ss, 32);
                    const float rstd = 1.0f / sqrtf(ss * (1.0f / 64.0f) + EPS);
                    f32x4 o[2][2];
#pragma unroll
                    for (int bj = 0; bj < 2; ++bj)
#pragma unroll
                        for (int n = 0; n < 2; ++n) o[bj][n] = acc[ai][bj][m][n] * rstd * wv[bj][n];
                    if (pn <= 1) { bf16_t* q = (bf16_t*)(ws + WS_Q) + row * 512 + (4 * pn + wc) * 64 + dof; st_bf16x8(q, o[0][0], o[0][1]); st_bf16x8(q + 32, o[1][0], o[1][1]); }
                    else { float* ko = out + O_KP + row * 128 + wc * 64 + dof; *(f32x4*)ko = o[0][0]; *(f32x4*)(ko + 4) = o[0][1]; *(f32x4*)(ko + 32) = o[1][0]; *(f32x4*)(ko + 36) = o[1][1];
                        bf16_t* kb = (bf16_t*)(ws + WS_KB) + row * 128 + wc * 64 + dof; st_bf16x8(kb, o[0][0], o[0][1]); st_bf16x8(kb + 32, o[1][0], o[1][1]); } }
            return;
        }
        if (pn == 5 && wc == 1) {
            if (fq == 0) {
#pragma unroll
                for (int ai = 0; ai < 2; ++ai)
#pragma unroll
                    for (int m = 0; m < 4; ++m) { const size_t row = (size_t)(rowb + ai * 128 + m * 16); float* wp = (float*)(ws + WS_WI) + row * 8;
                        *(f32x4*)wp = acc[ai][0][m][0] * WI_SCALE; *(f32x4*)(wp + 4) = acc[ai][0][m][1] * WI_SCALE; } }
            return;
        }
        bf16_t* dst; int ld, cb; float* fo = nullptr; int fld = 0; bool act = false;
        if (pn == 2) { dst = (bf16_t*)(ws + WS_VB); ld = 128; cb = (wc - 2) * 64; fo = out + O_VP + cb; fld = 128; }
        else if (pn <= 4) { dst = (bf16_t*)(ws + WS_QI); ld = 512; cb = (4 * (pn - 3) + wc) * 64; }
        else if (pn == 5) { dst = (bf16_t*)(ws + WS_KI); ld = 64; cb = 0; fo = out + O_KIP; fld = 64; }
        else if (pn <= 7) { dst = (bf16_t*)(ws + WS_GA); ld = 512; cb = (4 * (pn - 6) + wc) * 64; act = true; }
        else if (pn <= 9) { dst = (bf16_t*)(ws + WS_U); ld = 512; cb = (4 * (pn - 8) + wc) * 64; }
        else { dst = (bf16_t*)(ws + WS_GP); ld = 512; cb = (4 * (pn - 10) + wc) * 64; act = true; }
        const bool is_u = (pn == 8 || pn == 9);
#pragma unroll
        for (int ai = 0; ai < 2; ++ai)
#pragma unroll
            for (int m = 0; m < 4; ++m) { const int rowi = rowb + ai * 128 + m * 16; const size_t row = (size_t)rowi;
                f32x4 o00 = acc[ai][0][m][0], o01 = acc[ai][0][m][1], o10 = acc[ai][1][m][0], o11 = acc[ai][1][m][1];
                if (act) { o00 = silu4(o00); o01 = silu4(o01); o10 = silu4(o10); o11 = silu4(o11); }
                bf16_t* d = dst + row * ld + cb + dof; st_bf16x8(d, o00, o01); st_bf16x8(d + 32, o10, o11);
                if (fo) { float* f = fo + row * fld + dof; *(f32x4*)f = o00; *(f32x4*)(f + 4) = o01; *(f32x4*)(f + 32) = o10; *(f32x4*)(f + 36) = o11; }
                if (is_u) { const int t = rowi & (SEQ - 1);
                    if (t >= SEQ - 15) { float* f = out + O_PP + ((size_t)(rowi >> 11) * 15 + (t - (SEQ - 15))) * 512 + cb + dof;
                        *(f32x4*)f = o00; *(f32x4*)(f + 4) = o01; *(f32x4*)(f + 32) = o10; *(f32x4*)(f + 36) = o11; } } }
    }
};
struct EpiOut {
    static constexpr bool PERM = true, AFTER_DRAIN = false;
    const float* x; float* y; const float* ada;
    __device__ __forceinline__ void operator()(const f32x4 (&acc)[2][2][4][2], const Unit& u, int wr, int wc, int fr, int fq) const {
        const int col0 = u.pn * 256 + wc * 32 + 8 * fq; const float* gp = ada + (size_t)(u.pm >> 3) * 3072 + 2048 + col0;
        f32x4 g[2][2];
#pragma unroll
        for (int bj = 0; bj < 2; ++bj)
#pragma unroll
            for (int n = 0; n < 2; ++n) g[bj][n] = *(const f32x4*)(gp + 128 * bj + 4 * n);
#pragma unroll
        for (int ai = 0; ai < 2; ++ai)
#pragma unroll
            for (int m = 0; m < 4; ++m) { const size_t off = (size_t)(u.pm * 256 + ai * 128 + wr * 64 + m * 16 + fr) * 1024 + col0;
#pragma unroll
                for (int bj = 0; bj < 2; ++bj)
#pragma unroll
                    for (int n = 0; n < 2; ++n) { const f32x4 xv = *(const f32x4*)(x + off + 128 * bj + 4 * n); *(f32x4*)(y + off + 128 * bj + 4 * n) = xv + g[bj][n] * acc[ai][bj][m][n]; } }
    }
};
template <class Epi, class Sched, bool ALIGN_EPI = false, bool SP2 = false>
__device__ __forceinline__ void gemm_phase(PG8_LAS unsigned char* lds, const Gemm g, const Sched& S, const Epi& E) {
    const int tid = threadIdx.x, wid = __builtin_amdgcn_readfirstlane(tid >> 6), lane = tid & 63, wr = wid >> 2, wc = wid & 3, fr = lane & 15, fq = lane >> 4;
    const int K = g.K, nt = K / BK;
    unsigned voffA[2], voffB[2];
#pragma unroll
    for (int i = 0; i < 2; ++i) { int R, C; stage_rc(tid * 16 + i * 8192, R, C); const int Rb = Epi::PERM ? ((R & ~31) + perm32(R & 31)) : R;
        voffA[i] = (unsigned)(R * K + C) * 2u; voffB[i] = (unsigned)(Rb * K + C) * 2u; }
    const size_t kstep = (size_t)(BK * 2);
    const size_t hstep = (size_t)HALF * K * 2;
    const size_t tstep = 2 * hstep;
    const unsigned ldsw = (unsigned)wid * 1024u;
    const int aoff = lds_byte(wr * 64 + fr, fq * 8), boff = lds_byte(wc * 32 + fr, fq * 8);
#define PG8_SA(b, h) (((b) * 2 + (h)) * HTB)
#define PG8_SB(b, h) ((4 + (b) * 2 + (h)) * HTB)
#define PG8_STAGE(bufoff, gbase, voff) do { _Pragma("unroll") for (int _i = 0; _i < 2; ++_i) \
        __builtin_amdgcn_global_load_lds((const unsigned*)((const char*)(gbase) + (voff)[_i]), (PG8_LAS unsigned*)(lds + (bufoff) + ldsw + _i * 8192), 16, 0, 0); } while (0)
#define PG8_LDA(dst, b, h) do { _Pragma("unroll") for (int m = 0; m < 4; ++m) _Pragma("unroll") for (int k = 0; k < 2; ++k) dst[m][k] = *(const PG8_LAS bf16x8*)(lds + PG8_SA(b, h) + aoff + m * 2048 + k * 1024); } while (0)
#define PG8_LDB(dst, b, h) do { _Pragma("unroll") for (int n = 0; n < 2; ++n) _Pragma("unroll") for (int k = 0; k < 2; ++k) dst[n][k] = *(const PG8_LAS bf16x8*)(lds + PG8_SB(b, h) + boff + n * 2048 + k * 1024); } while (0)
#define PG8_MMA(ai, bj, At, Bt) do { __builtin_amdgcn_s_setprio(1); _Pragma("unroll") for (int m = 0; m < 4; ++m) _Pragma("unroll") for (int n = 0; n < 2; ++n) _Pragma("unroll") for (int k = 0; k < 2; ++k) \
        acc[ai][bj][m][n] = __builtin_amdgcn_mfma_f32_16x16x32_bf16(Bt[n][k], At[m][k], acc[ai][bj][m][n], 0, 0, 0); __builtin_amdgcn_s_setprio(0); } while (0)
#define PG8_WAIT_V(n) asm volatile("s_waitcnt vmcnt(" #n ")" ::: "memory")
#define PG8_WAIT_L(n) asm volatile("s_waitcnt lgkmcnt(" #n ")" ::: "memory")
#define PG8_BAR __builtin_amdgcn_s_barrier()
#define PG8_SCHED __builtin_amdgcn_sched_barrier(0)
    Unit cur, nxt; int ui = 0;
    if (!S.next(0, cur)) return;
    f32x4 acc[2][2][4][2];
#pragma unroll
    for (int a = 0; a < 2; ++a)
#pragma unroll
        for (int b = 0; b < 2; ++b)
#pragma unroll
            for (int m = 0; m < 4; ++m)
#pragma unroll
                for (int n = 0; n < 2; ++n) acc[a][b][m][n] = (f32x4){0.f, 0.f, 0.f, 0.f};
    bf16x8 At[4][2], B0[2][2], B1[2][2];
    const char* cA = (const char*)g.A + (size_t)cur.pm * tstep; const char* cB = (const char*)g.Bt + (size_t)cur.pn * tstep;
    S.a_ready(cur);
    if constexpr (SP2) {
        PG8_STAGE(PG8_SB(0, 0), cB, voffB); PG8_STAGE(PG8_SB(0, 1), cB + hstep, voffB); PG8_STAGE(PG8_SA(0, 0), cA, voffA); PG8_STAGE(PG8_SA(0, 1), cA + hstep, voffA);
        if (wr == 1) PG8_BAR;
        PG8_WAIT_V(2); PG8_BAR;
        PG8_STAGE(PG8_SB(1, 0), cB + kstep, voffB); PG8_STAGE(PG8_SA(1, 0), cA + kstep, voffA); PG8_STAGE(PG8_SB(1, 1), cB + hstep + kstep, voffB);
        PG8_WAIT_V(6); PG8_BAR;
    } else {
        PG8_STAGE(PG8_SB(0, 0), cB, voffB); PG8_STAGE(PG8_SA(0, 0), cA, voffA); PG8_STAGE(PG8_SB(0, 1), cB + hstep, voffB); PG8_STAGE(PG8_SA(0, 1), cA + hstep, voffA);
        if (wr == 1) PG8_BAR;
        PG8_WAIT_V(4); PG8_BAR;
        PG8_STAGE(PG8_SB(1, 0), cB + kstep, voffB); PG8_STAGE(PG8_SA(1, 0), cA + kstep, voffA); PG8_STAGE(PG8_SB(1, 1), cB + hstep + kstep, voffB);
        PG8_WAIT_V(6); PG8_BAR;
    }
    for (;;) {
        const bool has_next = S.next(ui + 1, nxt);
        const char* nA = has_next ? (const char*)g.A + (size_t)nxt.pm * tstep : cA; const char* nB = has_next ? (const char*)g.Bt + (size_t)nxt.pn * tstep : cB;
        for (int t = 0; t < nt; t += 2) {
            const bool last = (t == nt - 2);
            const char* a1 = cA + (size_t)(t + 1) * kstep;
            const char* a2 = last ? nA : cA + (size_t)(t + 2) * kstep; const char* b2 = last ? nB : cB + (size_t)(t + 2) * kstep;
            const char* a3 = a2 + kstep; const char* b3 = b2 + kstep;
            if (last && has_next) S.a_ready(nxt);
            if constexpr (SP2) {
            PG8_LDB(B0, 0, 0); PG8_LDB(B1, 0, 1); PG8_SCHED; PG8_LDA(At, 0, 0); PG8_STAGE(PG8_SA(1, 1), a1 + hstep, voffA);
            PG8_WAIT_V(8); PG8_WAIT_L(0); PG8_BAR; PG8_MMA(0, 0, At, B0); PG8_MMA(0, 1, At, B1); PG8_BAR; PG8_SCHED;
            PG8_LDA(At, 0, 1); PG8_STAGE(PG8_SB(0, 0), b2, voffB); PG8_STAGE(PG8_SB(0, 1), b2 + hstep, voffB); PG8_STAGE(PG8_SA(0, 0), a2, voffA);
            PG8_WAIT_V(8); PG8_WAIT_L(0); PG8_BAR; PG8_MMA(1, 0, At, B0); PG8_MMA(1, 1, At, B1); PG8_BAR; PG8_SCHED;
            PG8_LDB(B0, 1, 0); PG8_LDB(B1, 1, 1); PG8_SCHED; PG8_LDA(At, 1, 0); PG8_STAGE(PG8_SA(0, 1), a2 + hstep, voffA);
            PG8_WAIT_V(8); PG8_WAIT_L(0); PG8_BAR; PG8_MMA(0, 0, At, B0); PG8_MMA(0, 1, At, B1); PG8_BAR; PG8_SCHED;
            PG8_LDA(At, 1, 1); PG8_STAGE(PG8_SB(1, 0), b3, voffB); PG8_STAGE(PG8_SB(1, 1), b3 + hstep, voffB); PG8_STAGE(PG8_SA(1, 0), a3, voffA);
            PG8_WAIT_V(8); PG8_WAIT_L(0); PG8_BAR; PG8_MMA(1, 0, At, B0); PG8_MMA(1, 1, At, B1); PG8_BAR; PG8_SCHED;
            } else {
            PG8_LDB(B0, 0, 0); PG8_SCHED; PG8_LDA(At, 0, 0); PG8_STAGE(PG8_SA(1, 1), a1 + hstep, voffA);
            PG8_WAIT_L(8); PG8_BAR; PG8_WAIT_L(0); PG8_MMA(0, 0, At, B0); PG8_BAR; PG8_SCHED;
            PG8_LDB(B1, 0, 1); PG8_STAGE(PG8_SB(0, 0), b2, voffB);
            PG8_BAR; PG8_WAIT_L(0); PG8_MMA(0, 1, At, B1); PG8_BAR;
            PG8_LDA(At, 0, 1); PG8_STAGE(PG8_SA(0, 0), a2, voffA);
            PG8_BAR; PG8_WAIT_L(0); PG8_MMA(1, 0, At, B0); PG8_BAR; PG8_SCHED;
            PG8_STAGE(PG8_SB(0, 1), b2 + hstep, voffB);
            PG8_WAIT_V(6); PG8_BAR; PG8_MMA(1, 1, At, B1); PG8_BAR;
            PG8_LDB(B0, 1, 0); PG8_SCHED; PG8_LDA(At, 1, 0); PG8_STAGE(PG8_SA(0, 1), a2 + hstep, voffA);
            PG8_WAIT_L(8); PG8_BAR; PG8_WAIT_L(0); PG8_MMA(0, 0, At, B0); PG8_BAR; PG8_SCHED;
            PG8_LDB(B1, 1, 1); PG8_STAGE(PG8_SB(1, 0), b3, voffB);
            PG8_BAR; PG8_WAIT_L(0); PG8_MMA(0, 1, At, B1); PG8_BAR;
            PG8_LDA(At, 1, 1); PG8_STAGE(PG8_SA(1, 0), a3, voffA);
            PG8_BAR; PG8_WAIT_L(0); PG8_MMA(1, 0, At, B0); PG8_BAR; PG8_SCHED;
            PG8_STAGE(PG8_SB(1, 1), b3 + hstep, voffB);
            PG8_WAIT_V(6); PG8_BAR; PG8_MMA(1, 1, At, B1); PG8_BAR;
            }
        }
        if constexpr (ALIGN_EPI) { if (wr == 0) PG8_BAR; }
        if constexpr (!Epi::AFTER_DRAIN) { E(acc, cur, wr, wc, fr, fq); S.done(cur); }
        if (!has_next) break;
#pragma unroll
        for (int a = 0; a < 2; ++a)
#pragma unroll
            for (int b = 0; b < 2; ++b)
#pragma unroll
                for (int m = 0; m < 4; ++m)
#pragma unroll
                    for (int n = 0; n < 2; ++n) acc[a][b][m][n] = (f32x4){0.f, 0.f, 0.f, 0.f};
        cur = nxt; cA = nA; cB = nB; ++ui;
        if constexpr (ALIGN_EPI) { if (wr == 1) PG8_BAR; }
    }
    PG8_WAIT_V(0);
    if constexpr (!ALIGN_EPI) { if (wr == 0) PG8_BAR; }
    PG8_BAR;
    if constexpr (Epi::AFTER_DRAIN) { E.fused(acc, cur, wr, wc, fr, fq, lds, wid, lane); S.done(cur); }
#undef PG8_SA
#undef PG8_SB
#undef PG8_STAGE
#undef PG8_LDA
#undef PG8_LDB
#undef PG8_MMA
#undef PG8_WAIT_V
#undef PG8_WAIT_L
#undef PG8_BAR
#undef PG8_SCHED
}
}

constexpr int NWAVES = 8;
constexpr int RING_OFF = 0, RING_BYTES = 131072;
constexpr int LDSCTL_OFF = RING_BYTES, MISC_OFF = LDSCTL_OFF + 320;
constexpr int LDS_BYTES = 147456;
constexpr int CW_BAR = 4096;
#define GAS __attribute__((address_space(1)))
#define LAS __attribute__((address_space(3)))
typedef unsigned short bf16;
typedef unsigned v4u __attribute__((ext_vector_type(4)));
typedef unsigned v2u __attribute__((ext_vector_type(2)));
typedef float f32x4 __attribute__((ext_vector_type(4)));
typedef float f32x16 __attribute__((ext_vector_type(16)));
typedef short bf16x8 __attribute__((ext_vector_type(8)));
typedef GAS unsigned gu32;
#define LDS_WAIT() asm volatile("s_waitcnt lgkmcnt(0)" ::: "memory")
#define VM_WAIT() asm volatile("s_waitcnt vmcnt(0)" ::: "memory")
__device__ __forceinline__ unsigned f2bf(float f) { unsigned u = __builtin_bit_cast(unsigned, f); return (u + 0x7fffu + ((u >> 16) & 1u)) >> 16; }
__device__ __forceinline__ unsigned pk2(float lo, float hi) { return pg8::cvt_pk_bf16(lo, hi); }
__device__ __forceinline__ float bf2f(unsigned short b) { return __builtin_bit_cast(float, (unsigned)b << 16); }
__device__ __forceinline__ float wave_sum(float v) {
#pragma unroll
    for (int o = 1; o < 64; o <<= 1) v += __shfl_xor(v, o);
    return v;
}
__device__ __forceinline__ float wave_max(float v) {
#pragma unroll
    for (int o = 1; o < 64; o <<= 1) v = fmaxf(v, __shfl_xor(v, o));
    return v;
}
#define XB_TMO      128
#define XB_XCNT(j)  (256  + 64 * (j))
#define XB_XSUB(j)  (1280 + 64 * (j))
#define XB_XGEN(j)  (2304 + 64 * (j))
#define XB_TOP      3328
#define XB_TOPGEN   3392
#define XCD_BAR_WORDS 3456
#define XB_SPIN_CAP (1u << 18)

__device__ __forceinline__ unsigned xb_ld(unsigned* p)              { return __hip_atomic_load(p, __ATOMIC_RELAXED, __HIP_MEMORY_SCOPE_AGENT); }
__device__ __forceinline__ unsigned xb_add(unsigned* p, unsigned v) { return __hip_atomic_fetch_add(p, v, __ATOMIC_RELAXED, __HIP_MEMORY_SCOPE_AGENT); }
__device__ __forceinline__ unsigned xb_xcc_id() { return (unsigned)__builtin_amdgcn_s_getreg((3 << 11) | 20) & 0xFu; }
#define XB_SPIN(cond, bar) do { unsigned _sp = 0; while (cond) { __builtin_amdgcn_s_sleep(1); \
    if ((++_sp & 255u) == 0u) { if (xb_ld(&(bar)[XB_TMO])) break; if (_sp > XB_SPIN_CAP) { atomicAdd(&(bar)[XB_TMO], 1u); break; } } } } while (0)

struct XcdBarrier {
    unsigned* bar; unsigned x;
    volatile LAS unsigned* st;
};

__device__ __forceinline__ XcdBarrier xcd_barrier_post(unsigned* bar, volatile LAS unsigned* st) {
    XcdBarrier b; b.bar = bar; b.x = xb_xcc_id(); b.st = st;
    if (threadIdx.x == 0) (void)xb_add(&bar[XB_XCNT(b.x)], 1u);
    return b;
}
__device__ __forceinline__ void xcd_barrier_complete(unsigned* bar, unsigned x, unsigned& nloc, unsigned& nx) {
    const unsigned G = gridDim.x * gridDim.y * gridDim.z;
    unsigned sum, cnt, mine, sp = 0u;
    for (;;) {
        sum = 0u; cnt = 0u; mine = 0u;
#pragma unroll
        for (unsigned j = 0; j < 16; ++j) { const unsigned c = xb_ld(&bar[XB_XCNT(j)]); sum += c; cnt += (c > 0u) ? 1u : 0u; mine = (j == x) ? c : mine; }
        if (sum == G) break;
        __builtin_amdgcn_s_sleep(1);
        if ((++sp & 255u) == 0u) { if (xb_ld(&bar[XB_TMO])) break; if (sp > XB_SPIN_CAP) { atomicAdd(&bar[XB_TMO], 1u); break; } }
    }
    nloc = mine > 0u ? mine : 1u; nx = cnt > 0u ? cnt : 1u;
}

__device__ __forceinline__ void xcd_barrier(const XcdBarrier& b) {
    asm volatile("s_waitcnt vmcnt(0)" ::: "memory");
    __syncthreads();
    if (threadIdx.x == 0) {
        unsigned* bar = b.bar;
        __builtin_amdgcn_s_waitcnt(0);
        unsigned nloc = b.st[0], nx = b.st[1];
        if (nloc == 0u) { xcd_barrier_complete(bar, b.x, nloc, nx); b.st[0] = nloc; b.st[1] = nx; }
        const unsigned old = xb_add(&bar[XB_XSUB(b.x)], 1u);
        const unsigned gen = old / nloc;
        if (old + 1u == (gen + 1u) * nloc) {
            __builtin_amdgcn_fence(__ATOMIC_RELEASE, "agent");
            asm volatile("s_waitcnt vmcnt(0)" ::: "memory");
            const unsigned og = xb_add(&bar[XB_TOP], 1u);
            const unsigned tg = og / nx;
            if (og + 1u == (tg + 1u) * nx) xb_add(&bar[XB_TOPGEN], 1u);
            else XB_SPIN(xb_ld(&bar[XB_TOPGEN]) == tg, bar);
            __builtin_amdgcn_fence(__ATOMIC_ACQUIRE, "agent");
            xb_add(&bar[XB_XGEN(b.x)], 1u);
            asm volatile("s_waitcnt vmcnt(0)" ::: "memory");
        } else {
            XB_SPIN(xb_ld(&bar[XB_XGEN(b.x)]) == gen, bar);
            __builtin_amdgcn_fence(__ATOMIC_ACQUIRE, "agent");
            asm volatile("s_waitcnt vmcnt(0)" ::: "memory");
        }
    }
    __syncthreads();
}

struct Frame {
    LAS unsigned char* lds; volatile LAS unsigned* MISC; gu32* ctl;
    int tid, lane, wave, vcu, G, bid;
    const float *xp, *xs, *cache_k, *cache_v, *cache_kidx, *state_pool; const int* page_table;
    const float *cp, *cs, *norm_w, *w_ada, *b_ada, *w_in, *qnw, *knw, *w_pool, *pool_scale, *w_out;
    float* out; unsigned char* ws;
#if TEST_MODE == 4
    unsigned long long* ts; int nst;
#endif
};
#if TEST_MODE == 4
#define FSTAMP() do { if (blockIdx.x == STAMP_BLK && threadIdx.x == 0) F.ts[F.nst] = __builtin_amdgcn_s_memrealtime(); ++F.nst; } while (0)
#else
#define FSTAMP() do { } while (0)
#endif

__device__ __forceinline__ void p0_ada(Frame& F, int task) {
    const int lane = F.lane, w = F.wave, rl = lane & 15, kq = lane >> 4, n0 = task * 16;
    float bv[32];
    { const float* wp = F.w_ada + (size_t)(w * 128 + 4 * kq) * 3072 + n0 + rl;
#pragma unroll
      for (int i4 = 0; i4 < 8; ++i4)
#pragma unroll
          for (int u = 0; u < 4; ++u) bv[i4 * 4 + u] = wp[(size_t)(16 * i4 + u) * 3072]; }
    f32x4 acc[9];
#pragma unroll
    for (int i3 = 0; i3 < 3; ++i3) {
        f32x4 cv[3][8]; bool valid[3];
#pragma unroll
        for (int ii = 0; ii < 3; ++ii) { const int row = 16 * (3 * i3 + ii) + rl; valid[ii] = row < NR;
            const float* cptr = (row < NB ? F.cp + (size_t)row * DM : F.cs + (size_t)((valid[ii] ? row : NB) - NB) * DM) + w * 128 + 4 * kq;
#pragma unroll
            for (int i4 = 0; i4 < 8; ++i4) cv[ii][i4] = *(const f32x4*)(cptr + 16 * i4); }
#pragma unroll
        for (int ii = 0; ii < 3; ++ii) { const int i = 3 * i3 + ii;
            acc[i] = (f32x4){0.f, 0.f, 0.f, 0.f};
#pragma unroll
            for (int i4 = 0; i4 < 8; ++i4)
#pragma unroll
                for (int u = 0; u < 4; ++u) { const float a = valid[ii] ? pg8::silu1(cv[ii][i4][u]) : 0.f; acc[i] = __builtin_amdgcn_mfma_f32_16x16x4f32(a, bv[i4 * 4 + u], acc[i], 0, 0, 0); } } }
    LAS float* red = (LAS float*)(F.lds + RING_OFF);
#pragma unroll
    for (int i = 0; i < 9; ++i)
#pragma unroll
        for (int e = 0; e < 4; ++e) red[(w * 144 + 16 * i + 4 * kq + e) * 16 + rl] = acc[i][e];
    __syncthreads();
    float* ada = (float*)(F.ws + WS_ADA);
    for (int o = F.tid; o < NR * 16; o += NWAVES * 64) { const int row = o >> 4, col = o & 15; float s = F.b_ada[n0 + col];
#pragma unroll
        for (int ww = 0; ww < 8; ++ww) s += red[(ww * 144 + row) * 16 + col];
        ada[(size_t)row * 3072 + n0 + col] = s; }
    __syncthreads();
}
__device__ __forceinline__ void transpose_item(const float* W, int ldn, int srccol0, int nvalid, bf16* WT, int K, int dstrow0, int k0, LAS float* scr, int lane) {
    float tv[32];
#pragma unroll
    for (int i = 0; i < 32; ++i) { const int kk = 2 * i + (lane >> 5), c = lane & 31; tv[i] = c < nvalid ? W[(size_t)(k0 + kk) * ldn + srccol0 + c] : 0.f; }
#pragma unroll
    for (int i = 0; i < 32; ++i) { const int kk = 2 * i + (lane >> 5), c = lane & 31; scr[kk * 33 + c] = tv[i]; }
    LDS_WAIT(); asm volatile("" ::: "memory");
    const int c = lane & 7;
#pragma unroll
    for (int j = 0; j < 4; ++j) { const int n = (lane >> 3) + 8 * j; const LAS float* s = scr + (8 * c) * 33 + n;
        v4u o; o.x = pk2(s[0 * 33], s[1 * 33]); o.y = pk2(s[2 * 33], s[3 * 33]); o.z = pk2(s[4 * 33], s[5 * 33]); o.w = pk2(s[6 * 33], s[7 * 33]);
        *(GAS v4u*)(WT + (size_t)(dstrow0 + n) * K + k0 + 8 * c) = o; }
    LDS_WAIT(); asm volatile("" ::: "memory");
}
__device__ __forceinline__ int win_col(int pn, int hd, int d) {
    if (pn <= 1) return CQ + (4 * pn + hd) * 64 + d;
    if (pn == 2) return hd < 2 ? CK + hd * 64 + d : CV + (hd - 2) * 64 + d;
    if (pn <= 4) return CQI + (4 * (pn - 3) + hd) * 64 + d;
    if (pn == 5) return hd == 0 ? CKI + d : ((hd == 1 && d < 8) ? CWI + d : -1);
    if (pn <= 7) return CGA + (4 * (pn - 6) + hd) * 64 + d;
    if (pn <= 9) return CU + (4 * (pn - 8) + hd) * 64 + d;
    return CGP + (4 * (pn - 10) + hd) * 64 + d;
}
__device__ __forceinline__ void p0_prologue(Frame& F) {
    if (F.bid < 192) p0_ada(F, F.bid);
    LAS float* scr = (LAS float*)(F.lds + RING_OFF + F.wave * 16384);
    const int gw = F.vcu * NWAVES + F.wave, NGW = F.G * NWAVES;
    bf16* WINT = (bf16*)(F.ws + WS_WINT); bf16* WOUTT = (bf16*)(F.ws + WS_WOUTT); bf16* WPOOLT = (bf16*)(F.ws + WS_WPOOLT);
    for (int it = gw; it < 2080; it += NGW) {
        if (it < 1536) { const int G = it >> 4, kb = it & 15, pn = G >> 3, bj = (G >> 2) & 1, hd = G & 3; const int src = win_col(pn, hd, 32 * bj);
            const int nvalid = src < 0 ? 0 : ((pn == 5 && hd == 1) ? 8 : 32);
            transpose_item(F.w_in, NIN, src < 0 ? 0 : src, nvalid, WINT, 1024, 32 * G, 64 * kb, scr, F.lane); }
        else if (it < 2048) { const int r = it - 1536, G = r >> 4, kb = r & 15; transpose_item(F.w_out, 1024, 32 * G, 32, WOUTT, 1024, 32 * G, 64 * kb, scr, F.lane); }
        else { const int r = it - 2048, g = r >> 3, kb = (r >> 2) & 1, G = r & 3; transpose_item(F.w_pool + (size_t)g * 16384, 128, 32 * G, 32, WPOOLT + (size_t)g * 16384, 128, 32 * G, 64 * kb, scr, F.lane); }
    }
    { const int nf4 = DECB * 1792; f32x4 t4[2]; int ix[2];
#pragma unroll
      for (int k = 0; k < 2; ++k) { ix[k] = gw * 64 + F.lane + k * NGW * 64; if (ix[k] < nf4) { const int s = ix[k] / 1792, i = ix[k] - s * 1792; t4[k] = *(const f32x4*)(F.state_pool + (size_t)s * 7680 + 512 + 4 * i); } }
#pragma unroll
      for (int k = 0; k < 2; ++k) { if (ix[k] < nf4) { const int s = ix[k] / 1792, i = ix[k] - s * 1792; *(f32x4*)(F.out + O_PS + (size_t)s * 7680 + 4 * i) = t4[k]; } }
      for (int ixx = gw * 64 + F.lane + 2 * NGW * 64; ixx < nf4; ixx += NGW * 64) { const int s = ixx / 1792, i = ixx - s * 1792; *(f32x4*)(F.out + O_PS + (size_t)s * 7680 + 4 * i) = *(const f32x4*)(F.state_pool + (size_t)s * 7680 + 512 + 4 * i); } }
}

template <int N, bool SAME_ADA> __device__ __forceinline__ void norm_rows(Frame& F, const float* x0, const float* adarow0, int adastride, bf16* o0) {
    f32x4 v[N][4]; float s2[N];
#pragma unroll
    for (int i = 0; i < N; ++i) { const GAS f32x4* xr = (const GAS f32x4*)(x0 + (size_t)i * DM) + F.lane;
#pragma unroll
        for (int j = 0; j < 4; ++j) v[i][j] = xr[64 * j]; }
#pragma unroll
    for (int i = 0; i < N; ++i) { s2[i] = 0.f;
#pragma unroll
        for (int j = 0; j < 4; ++j) s2[i] += (v[i][j].x * v[i][j].x + v[i][j].y * v[i][j].y) + (v[i][j].z * v[i][j].z + v[i][j].w * v[i][j].w); }
#pragma unroll
    for (int o = 1; o < 64; o <<= 1) {
#pragma unroll
        for (int i = 0; i < N; ++i) s2[i] += __shfl_xor(s2[i], o); }
#pragma unroll
    for (int j = 0; j < 4; ++j) { const int col = 4 * F.lane + 256 * j; const f32x4 nw = *(const f32x4*)(F.norm_w + col);
        f32x4 gq, sh;
        if (SAME_ADA) { sh = *(const f32x4*)(adarow0 + col); gq = nw * (*(const f32x4*)(adarow0 + 1024 + col) + 1.0f); }
#pragma unroll
        for (int i = 0; i < N; ++i) {
            if (!SAME_ADA) { const float* ar = adarow0 + (size_t)i * adastride; sh = *(const f32x4*)(ar + col); gq = nw * (*(const f32x4*)(ar + 1024 + col) + 1.0f); }
            const float rstd = 1.0f / sqrtf(s2[i] * (1.0f / DM) + EPS);
            const f32x4 o = v[i][j] * rstd * gq + sh;
            ((GAS unsigned long long*)(o0 + (size_t)i * DM))[F.lane + 64 * j] = (unsigned long long)pk2(o.x, o.y) | ((unsigned long long)pk2(o.z, o.w) << 32); } }
}
__device__ __forceinline__ void skinny_core(const bf16* arow, const bf16* b0, const bf16* b1, const bf16* b2, const bf16* b3, f32x4 (&acc)[4]) {
#pragma unroll
    for (int j = 0; j < 4; ++j) acc[j] = (f32x4){0.f, 0.f, 0.f, 0.f};
    bf16x8 fa[2][4], fb[2][4][4];
#define SK_LOAD(buf, kb) do { _Pragma("unroll") for (int q_ = 0; q_ < 4; ++q_) { const int ko_ = 32 * (4 * (kb) + q_); fa[buf][q_] = *(const bf16x8*)(arow + ko_); \
        fb[buf][q_][0] = *(const bf16x8*)(b0 + ko_); fb[buf][q_][1] = *(const bf16x8*)(b1 + ko_); fb[buf][q_][2] = *(const bf16x8*)(b2 + ko_); fb[buf][q_][3] = *(const bf16x8*)(b3 + ko_); } } while (0)
#define SK_MMA(buf) do { _Pragma("unroll") for (int q_ = 0; q_ < 4; ++q_) { _Pragma("unroll") for (int j_ = 0; j_ < 4; ++j_) acc[j_] = __builtin_amdgcn_mfma_f32_16x16x32_bf16(fa[buf][q_], fb[buf][q_][j_], acc[j_], 0, 0, 0); } } while (0)
    SK_LOAD(0, 0);
#pragma unroll
    for (int kb = 0; kb < 8; kb += 2) {
        SK_LOAD(1, kb + 1); SK_MMA(0);
        if (kb + 2 < 8) SK_LOAD(0, kb + 2);
        SK_MMA(1);
    }
#undef SK_LOAD
#undef SK_MMA
}
__device__ __forceinline__ void sample_inproj(Frame& F, int pn, int hd) {
    const int lane = F.lane, w = F.wave, rl = lane & 15, kq = lane >> 4;
    const bf16* HS = (const bf16*)(F.ws + WS_HS);
    const bf16* WINT = (const bf16*)(F.ws + WS_WINT);
    const bf16* bb = WINT + (size_t)(256 * pn + 32 * hd + rl) * 1024 + 8 * kq;
    f32x4 acc[4];
    skinny_core(HS + (size_t)(16 * w + rl) * 1024 + 8 * kq, bb, bb + 16 * 1024, bb + 128 * 1024, bb + 144 * 1024, acc);
    float* out = F.out;
    if (pn <= 1 || (pn == 2 && hd < 2)) {
        const float* nwp = pn <= 1 ? F.qnw : F.knw; const float sc = pn <= 1 ? C2 : 1.0f;
#pragma unroll
        for (int e = 0; e < 4; ++e) { float ss = 0.f;
#pragma unroll
            for (int j = 0; j < 4; ++j) ss += acc[j][e] * acc[j][e];
            ss += __shfl_xor(ss, 1); ss += __shfl_xor(ss, 2); ss += __shfl_xor(ss, 4); ss += __shfl_xor(ss, 8);
            const float rstd = 1.0f / sqrtf(ss * (1.0f / 64.0f) + EPS); const int s = 16 * w + 4 * kq + e; const size_t m = (size_t)(MP + s);
#pragma unroll
            for (int j = 0; j < 4; ++j) { const int d = 16 * j + rl; const float o = acc[j][e] * rstd * nwp[d] * sc;
                if (pn <= 1) ((bf16*)(F.ws + WS_Q))[m * 512 + (4 * pn + hd) * 64 + d] = (bf16)f2bf(o);
                else { out[O_KS + (size_t)s * 128 + hd * 64 + d] = o; ((bf16*)(F.ws + WS_KB))[m * 128 + hd * 64 + d] = (bf16)f2bf(o); } } }
        return;
    }
    if (pn == 5 && hd == 1) {
        if (rl < 8) {
#pragma unroll
            for (int e = 0; e < 4; ++e) { const int s = 16 * w + 4 * kq + e; ((float*)(F.ws + WS_WI))[(size_t)(MP + s) * 8 + rl] = acc[0][e] * WI_SCALE; } }
        return;
    }
    bf16* dst; int ld, cb; float* fo = nullptr; int fld = 0; bool act = false;
    if (pn == 2) { dst = (bf16*)(F.ws + WS_VB); ld = 128; cb = (hd - 2) * 64; fo = out + O_VS + cb; fld = 128; }
    else if (pn <= 4) { dst = (bf16*)(F.ws + WS_QI); ld = 512; cb = (4 * (pn - 3) + hd) * 64; }
    else if (pn == 5) { dst = (bf16*)(F.ws + WS_KI); ld = 64; cb = 0; fo = out + O_KIS; fld = 64; }
    else if (pn <= 7) { dst = (bf16*)(F.ws + WS_GA); ld = 512; cb = (4 * (pn - 6) + hd) * 64; act = true; }
    else if (pn <= 9) { dst = (bf16*)(F.ws + WS_U); ld = 512; cb = (4 * (pn - 8) + hd) * 64; fo = out + O_PS + 14 * 512 + cb; fld = 15 * 512; }
    else { dst = (bf16*)(F.ws + WS_GP); ld = 512; cb = (4 * (pn - 10) + hd) * 64; act = true; }
#pragma unroll
    for (int e = 0; e < 4; ++e) { const int s = 16 * w + 4 * kq + e; const size_t m = (size_t)(MP + s);
#pragma unroll
        for (int j = 0; j < 4; ++j) { const int d = 16 * j + rl; float o = acc[j][e]; if (act) o = pg8::silu1(o);
            dst[m * ld + cb + d] = (bf16)f2bf(o);
            if (fo) fo[(size_t)s * fld + d] = o; } }
}
__device__ __forceinline__ void p1_norm(Frame& F) {
    const float* ada = (const float*)(F.ws + WS_ADA); bf16* HB = (bf16*)(F.ws + WS_HB); bf16* HS = (bf16*)(F.ws + WS_HS);
    const int gw = F.vcu * NWAVES + F.wave, NGW = F.G * NWAVES;
    for (int ch = gw; ch < MP / 4 + DECB / 2; ch += NGW) {
        if (ch < MP / 4) { const int m = 4 * ch; norm_rows<4, true>(F, F.xp + (size_t)m * DM, ada + (size_t)(m >> 11) * 3072, 0, HB + (size_t)m * DM); }
        else { const int s = 2 * (ch - MP / 4); norm_rows<2, false>(F, F.xs + (size_t)s * DM, ada + (size_t)(NB + s) * 3072, 3072, HS + (size_t)s * DM); } }
}
__device__ __forceinline__ void p2_sample(Frame& F) {
    const int pn = F.bid >> 2, hd = F.bid & 3;
    if (F.bid < 48 && !(pn == 5 && hd >= 2)) sample_inproj(F, pn, hd);
}

constexpr int P3_BM = 0;
constexpr int P3_CNT = 4096;
constexpr int P3_WQ = 4608;
constexpr int P3_MID = 5120;
constexpr int P3_K = 8192;
constexpr int P3_V = P3_K + 32768;
constexpr int P3_VBUF = 18432;
constexpr int P3_END = P3_V + 2 * P3_VBUF;

__device__ __forceinline__ unsigned f2key(float f) { unsigned u = __float_as_uint(f); if (f == 0.0f) u = 0u; return (u & 0x80000000u) ? ~u : (u | 0x80000000u); }
__device__ __forceinline__ float key2f(unsigned k) { return __uint_as_float((k & 0x80000000u) ? (k ^ 0x80000000u) : ~k); }

__device__ __forceinline__ unsigned half_reduce_add(unsigned v) {
    v += (unsigned)__builtin_amdgcn_update_dpp(0, (int)v, 0xB1, 0xF, 0xF, true);
    v += (unsigned)__builtin_amdgcn_update_dpp(0, (int)v, 0x4E, 0xF, 0xF, true);
    v += (unsigned)__builtin_amdgcn_update_dpp(0, (int)v, 0x141, 0xF, 0xF, true);
    v += (unsigned)__builtin_amdgcn_update_dpp(0, (int)v, 0x140, 0xF, 0xF, true);
    v += (unsigned)__builtin_amdgcn_ds_swizzle((int)v, 0x401F);
    return v;
}
__device__ __forceinline__ unsigned half_reduce_min(unsigned v) {
    v = min(v, (unsigned)__builtin_amdgcn_update_dpp(0, (int)v, 0xB1, 0xF, 0xF, true)); v = min(v, (unsigned)__builtin_amdgcn_update_dpp(0, (int)v, 0x4E, 0xF, 0xF, true));
    v = min(v, (unsigned)__builtin_amdgcn_update_dpp(0, (int)v, 0x141, 0xF, 0xF, true)); v = min(v, (unsigned)__builtin_amdgcn_update_dpp(0, (int)v, 0x140, 0xF, 0xF, true));
    v = min(v, (unsigned)__builtin_amdgcn_ds_swizzle((int)v, 0x401F)); return v; }
__device__ __forceinline__ unsigned half_reduce_max(unsigned v) {
    v = max(v, (unsigned)__builtin_amdgcn_update_dpp(0, (int)v, 0xB1, 0xF, 0xF, true)); v = max(v, (unsigned)__builtin_amdgcn_update_dpp(0, (int)v, 0x4E, 0xF, 0xF, true));
    v = max(v, (unsigned)__builtin_amdgcn_update_dpp(0, (int)v, 0x141, 0xF, 0xF, true)); v = max(v, (unsigned)__builtin_amdgcn_update_dpp(0, (int)v, 0x140, 0xF, 0xF, true));
    v = max(v, (unsigned)__builtin_amdgcn_ds_swizzle((int)v, 0x401F)); return v; }
#define P3_COUNT(mode, thr, Jv, cown, par) do { \
    unsigned pk_[4]; \
    _Pragma("unroll") for (int a_ = 0; a_ < 4; ++a_) { unsigned c0_ = 0u, c1_ = 0u; \
        _Pragma("unroll") for (int s_ = 0; s_ < 8; ++s_) { const int kidx_ = 32 * (w + 8 * s_) + r; \
            if (mode == 0) { c0_ += (sk[s_][a_][0] >= thr[a_][0]) ? 1u : 0u; c1_ += (sk[s_][a_][1] >= thr[a_][1]) ? 1u : 0u; } \
            else { c0_ += (sk[s_][a_][0] == thr[a_][0] && kidx_ <= Jv[a_][0]) ? 1u : 0u; c1_ += (sk[s_][a_][1] == thr[a_][1] && kidx_ <= Jv[a_][1]) ? 1u : 0u; } } \
        pk_[a_] = c0_ | (c1_ << 16); } \
    _Pragma("unroll") for (int a_ = 0; a_ < 4; ++a_) pk_[a_] = half_reduce_add(pk_[a_]); \
    LAS unsigned* cb_ = (LAS unsigned*)(F.lds + P3_CNT) + (par) * 64; \
    if (r == 0) { _Pragma("unroll") for (int a_ = 0; a_ < 4; ++a_) cb_[(hh * 4 + a_) * 8 + w] = pk_[a_]; } \
    __syncthreads(); \
    { const LAS v4u* p_ = (const LAS v4u*)(cb_ + (qh * 4 + qa) * 8); const v4u x_ = p_[0], y_ = p_[1]; \
      const unsigned t_ = (x_.x + x_.y) + (x_.z + x_.w) + (y_.x + y_.y) + (y_.z + y_.w); cown = qj ? (int)(t_ >> 16) : (int)(t_ & 0xffffu); } \
} while (0)

__device__ __forceinline__ void p3_prompt_item(Frame& F, int b, int qt) {
    const int tid = F.tid, lane = F.lane, w = F.wave, r = lane & 31, hh = lane >> 5;
    const int t0 = 16 * qt, L = t0 + 16, nkt32 = (L + 31) >> 5, nkt64 = (L + 63) >> 6;
    const size_t mb = (size_t)b * SEQ;
    LAS unsigned* bm = (LAS unsigned*)(F.lds + P3_BM);
    LAS float* wq = (LAS float*)(F.lds + P3_WQ);
    for (int i = tid; i < 1024; i += NWAVES * 64) bm[i] = 0u;
    if (tid < 128) wq[tid] = ((const float*)(F.ws + WS_WI))[(mb + t0 + (tid >> 3)) * 8 + (tid & 7)];
    __syncthreads();
    FSTAMP();
    unsigned sk[8][4][2];
    {
        const bf16* QI = (const bf16*)(F.ws + WS_QI); const bf16* KI = (const bf16*)(F.ws + WS_KI);
#pragma unroll
        for (int ap = 0; ap < 2; ++ap) {
            bf16x8 af[2][4];
#pragma unroll
            for (int a2 = 0; a2 < 2; ++a2) { const int a = 2 * ap + a2; const int qq = 4 * a + 2 * ((r >> 2) & 1) + (r >> 4), h = (r & 3) + 4 * ((r >> 3) & 1);
                const bf16* p = QI + (mb + t0 + qq) * 512 + h * 64 + 8 * hh;
#pragma unroll
                for (int ks = 0; ks < 4; ++ks) af[a2][ks] = *(const bf16x8*)(p + 16 * ks); }
#pragma unroll
            for (int s = 0; s < 8; ++s) {
                const int kt = w + 8 * s;
                if (kt < nkt32) {
                    const bf16* kp = KI + (mb + 32 * kt + r) * 64 + 8 * hh;
                    bf16x8 bfr[4];
#pragma unroll
                    for (int ks = 0; ks < 4; ++ks) bfr[ks] = *(const bf16x8*)(kp + 16 * ks);
                    const int kidx = 32 * kt + r;
#pragma unroll
                    for (int a2 = 0; a2 < 2; ++a2) { const int a = 2 * ap + a2;
                        f32x16 acc;
#pragma unroll
                        for (int e = 0; e < 16; ++e) acc[e] = 0.f;
#pragma unroll
                        for (int ks = 0; ks < 4; ++ks) acc = __builtin_amdgcn_mfma_f32_32x32x16_bf16(af[a2][ks], bfr[ks], acc, 0, 0, 0);
#pragma unroll
                        for (int j2 = 0; j2 < 2; ++j2) { const int qq = 4 * a + 2 * hh + j2;
                            const LAS f32x4* wp = (const LAS f32x4*)(wq + qq * 8); const f32x4 w0 = wp[0], w1 = wp[1];
                            float sc = w0[0] * fmaxf(acc[8 * j2 + 0], 0.f);
                            sc += w0[1] * fmaxf(acc[8 * j2 + 1], 0.f); sc += w0[2] * fmaxf(acc[8 * j2 + 2], 0.f); sc += w0[3] * fmaxf(acc[8 * j2 + 3], 0.f);
                            sc += w1[0] * fmaxf(acc[8 * j2 + 4], 0.f); sc += w1[1] * fmaxf(acc[8 * j2 + 5], 0.f); sc += w1[2] * fmaxf(acc[8 * j2 + 6], 0.f); sc += w1[3] * fmaxf(acc[8 * j2 + 7], 0.f);
                            sk[s][a][j2] = (kidx <= t0 + qq) ? f2key(sc) : 0u; }
                    }
                } else {
#pragma unroll
                    for (int a2 = 0; a2 < 2; ++a2) { sk[s][2 * ap + a2][0] = 0u; sk[s][2 * ap + a2][1] = 0u; }
                }
            }
        }
    }
    FSTAMP();
    unsigned T[4][2]; int J[4][2];
#pragma unroll
    for (int a = 0; a < 4; ++a) { T[a][0] = 1u; T[a][1] = 1u; J[a][0] = 4095; J[a][1] = 4095; }
    if (qt >= 16) {
        const int myq = lane & 15, qa = myq >> 2, qh = (myq >> 1) & 1, qj = myq & 1;
        LAS unsigned* midb = (LAS unsigned*)(F.lds + P3_MID) + w * 16;
        unsigned lo, hi;
        {
            unsigned mn0[4], mn1[4], mx0[4], mx1[4];
#pragma unroll
            for (int a = 0; a < 4; ++a) { mn0[a] = 0xffffffffu; mn1[a] = 0xffffffffu; mx0[a] = 0u; mx1[a] = 0u;
#pragma unroll
                for (int s = 0; s < 8; ++s) { const unsigned k0 = sk[s][a][0], k1 = sk[s][a][1];
                    mn0[a] = min(mn0[a], k0 ? k0 : 0xffffffffu); mn1[a] = min(mn1[a], k1 ? k1 : 0xffffffffu); mx0[a] = max(mx0[a], k0); mx1[a] = max(mx1[a], k1); } }
#pragma unroll
            for (int a = 0; a < 4; ++a) { mn0[a] = half_reduce_min(mn0[a]); mn1[a] = half_reduce_min(mn1[a]); mx0[a] = half_reduce_max(mx0[a]); mx1[a] = half_reduce_max(mx1[a]); }
            LAS unsigned* xb = (LAS unsigned*)(F.lds + P3_K);
            if (r == 0) {
#pragma unroll
                for (int a = 0; a < 4; ++a) { xb[((0 * 2 + hh) * 4 + a) * 8 + w] = mn0[a]; xb[((1 * 2 + hh) * 4 + a) * 8 + w] = mn1[a]; xb[((2 * 2 + hh) * 4 + a) * 8 + w] = mx0[a]; xb[((3 * 2 + hh) * 4 + a) * 8 + w] = mx1[a]; } }
            __syncthreads();
            unsigned m0 = 0xffffffffu, x0 = 0u;
#pragma unroll
            for (int ww = 0; ww < 8; ++ww) { m0 = min(m0, xb[((qj * 2 + qh) * 4 + qa) * 8 + ww]); x0 = max(x0, xb[(((2 + qj) * 2 + qh) * 4 + qa) * 8 + ww]); }
            lo = m0; hi = x0 + 1u;
            __syncthreads();
        }
        int pc = 0;
        unsigned Tq = 1u; int Jq = 4095; bool done = false, tie = false; int side = 0;
        float glo = (float)(t0 + myq + 1 - 256), ghi = -256.f;
        unsigned thr[4][2]; int cq;
#define P3_BCAST(val) do { if (lane < 16) midb[qh * 8 + qa * 2 + qj] = (val); asm volatile("" ::: "memory"); \
        { const LAS v4u* mp_ = (const LAS v4u*)(midb + hh * 8); const v4u t0_ = mp_[0], t1_ = mp_[1]; \
          thr[0][0] = t0_.x; thr[0][1] = t0_.y; thr[1][0] = t0_.z; thr[1][1] = t0_.w; thr[2][0] = t1_.x; thr[2][1] = t1_.y; thr[3][0] = t1_.z; thr[3][1] = t1_.w; } asm volatile("" ::: "memory"); } while (0)
        int it = 0;
        for (; it < 200; ++it) {
            unsigned m_;
            if (done) m_ = Tq;
            else if (hi - lo <= 1u) { Tq = lo; done = true; tie = true; m_ = lo; }
            else if ((it & 7) == 7) m_ = lo + ((hi - lo) >> 1);
            else { const float fl = key2f(lo), fh = key2f(hi); const float t_ = fl + (fh - fl) * (glo * __builtin_amdgcn_rcpf(glo - ghi));
                unsigned k_ = f2key(t_); if (!(k_ > lo)) k_ = lo + 1u; if (!(k_ < hi)) k_ = hi - 1u; m_ = k_; }
            if (!__any(!done)) break;
            P3_BCAST(m_);
            P3_COUNT(0, thr, J, cq, pc & 1); ++pc;
            if (!done) {
                if (cq == 256) { Tq = m_; done = true; }
                else if (cq > 256) { lo = m_; glo = (float)(cq - 256); if (side == 1) ghi *= 0.5f; side = 1; }
                else { hi = m_; ghi = (float)(cq - 256); if (side == 2) glo *= 0.5f; side = 2; } }
        }
#if TEST_MODE == 4
        if (blockIdx.x == STAMP_BLK && threadIdx.x == 0 && F.nst < 8) { F.ts[40] = 0; F.ts[41] = (unsigned long long)it * 100ull; }
#endif
        if (__any(tie)) {
            int cgt;
            P3_BCAST(Tq + 1u);
            P3_COUNT(0, thr, J, cgt, pc & 1); ++pc;
            const int need = 256 - cgt; int jlo = -1, jhi = 2047;
            unsigned Tt[4][2];
            P3_BCAST(Tq);
#pragma unroll
            for (int a = 0; a < 4; ++a) { Tt[a][0] = thr[a][0]; Tt[a][1] = thr[a][1]; }
            for (int it2 = 0; it2 < 11; ++it2) { const int jm = (jlo + jhi + 1) >> 1; int ce; int jmv[4][2];
                P3_BCAST((unsigned)jm);
#pragma unroll
                for (int a = 0; a < 4; ++a) { jmv[a][0] = (int)thr[a][0]; jmv[a][1] = (int)thr[a][1]; }
                P3_COUNT(1, Tt, jmv, ce, pc & 1); ++pc;
                if (jhi - jlo > 1) { if (ce >= need) jhi = jm; else jlo = jm; } }
            if (tie) Jq = jhi;
        }
        P3_BCAST(Tq);
#pragma unroll
        for (int a = 0; a < 4; ++a) { T[a][0] = thr[a][0]; T[a][1] = thr[a][1]; }
        P3_BCAST((unsigned)Jq);
#pragma unroll
        for (int a = 0; a < 4; ++a) { J[a][0] = (int)thr[a][0]; J[a][1] = (int)thr[a][1]; }
#undef P3_BCAST
    }
    FSTAMP();
#pragma unroll
    for (int s = 0; s < 8; ++s) { const int kt = w + 8 * s;
        if (kt < nkt32) { const int kidx = 32 * kt + r;
#pragma unroll
            for (int a = 0; a < 4; ++a)
#pragma unroll
                for (int j2 = 0; j2 < 2; ++j2) { const unsigned k = sk[s][a][j2]; const bool selv = (k > T[a][j2]) || (k == T[a][j2] && kidx <= J[a][j2]);
                    const unsigned long long bal = __ballot(selv && k != 0u);
                    if (lane == 0) { bm[(4 * a + j2) * 64 + kt] = (unsigned)bal; bm[(4 * a + 2 + j2) * 64 + kt] = (unsigned)(bal >> 32); } } } }
    __syncthreads();
#if TEST_MODE
    { unsigned* dbg = (unsigned*)(F.ws + WS_DBG_BM) + (mb + t0) * 64; for (int i = tid; i < 1024; i += NWAVES * 64) dbg[i] = bm[i]; }
#endif
    FSTAMP();
    {
        const int g = w & 1, quad = w >> 1, j = lane & 15, kq = lane >> 4;
        const bf16* Q = (const bf16*)(F.ws + WS_Q); const bf16* KB = (const bf16*)(F.ws + WS_KB); const bf16* VB = (const bf16*)(F.ws + WS_VB);
        const int qq = 4 * quad + (j >> 2), hd = 4 * g + (j & 3);
        const size_t mrow = mb + t0 + qq;
        bf16x8 qf[2];
#pragma unroll
        for (int ks = 0; ks < 2; ++ks) qf[ks] = *(const bf16x8*)(Q + mrow * 512 + hd * 64 + 32 * ks + 8 * kq);
        f32x4 o[4];
#pragma unroll
        for (int dt = 0; dt < 4; ++dt) o[dt] = (f32x4){0.f, 0.f, 0.f, 0.f};
        float mrun = -INFINITY, lsum = 0.f;
        const int skey = tid >> 3, sc0 = 2 * (tid & 7);
        v4u kreg[2], vreg[2];
#define P3_STAGE_LOAD(t) do { const size_t row_ = (mb + 64 * (t) + skey) * 128; \
        kreg[0] = *(const v4u*)(KB + row_ + 8 * sc0); kreg[1] = *(const v4u*)(KB + row_ + 8 * sc0 + 8); \
        vreg[0] = *(const v4u*)(VB + row_ + 8 * sc0); vreg[1] = *(const v4u*)(VB + row_ + 8 * sc0 + 8); } while (0)
#define P3_STAGE_WRITE(bufi) do { LAS unsigned char* kb_ = F.lds + P3_K + (bufi) * 16384 + skey * 256; \
        *(LAS v4u*)(kb_ + ((sc0 ^ (skey & 15)) << 4)) = kreg[0]; *(LAS v4u*)(kb_ + (((sc0 + 1) ^ (skey & 15)) << 4)) = kreg[1]; \
        LAS unsigned char* vb_ = F.lds + P3_V + (bufi) * P3_VBUF + (sc0 >> 3) * 9216 + skey * 144 + ((sc0 & 7) << 4); \
        *(LAS v4u*)(vb_) = vreg[0]; *(LAS v4u*)(vb_ + 16) = vreg[1]; } while (0)
        P3_STAGE_LOAD(0); P3_STAGE_WRITE(0);
        __syncthreads();
        for (int t = 0; t < nkt64; ++t) {
            const int bufi = t & 1;
            if (t + 1 < nkt64) P3_STAGE_LOAD(t + 1);
            f32x4 sacc[4];
            const LAS unsigned char* kbase = F.lds + P3_K + bufi * 16384;
#pragma unroll
            for (int c = 0; c < 4; ++c) { sacc[c] = (f32x4){0.f, 0.f, 0.f, 0.f}; const int key = 16 * c + j;
#pragma unroll
                for (int ks = 0; ks < 2; ++ks) { const int ch = g * 8 + 4 * ks + kq;
                    const bf16x8 kf = *(const LAS bf16x8*)(kbase + key * 256 + ((ch ^ (key & 15)) << 4));
                    sacc[c] = __builtin_amdgcn_mfma_f32_16x16x32_bf16(kf, qf[ks], sacc[c], 0, 0, 0); } }
            const unsigned mw0 = bm[qq * 64 + 2 * t], mw1 = bm[qq * 64 + 2 * t + 1];
            float tmax = -INFINITY;
#pragma unroll
            for (int c = 0; c < 4; ++c)
#pragma unroll
                for (int e = 0; e < 4; ++e) { const unsigned mwd = (c >> 1) ? mw1 : mw0; const bool bit = (mwd >> (16 * (c & 1) + 4 * kq + e)) & 1u;
                    sacc[c][e] = bit ? sacc[c][e] : -INFINITY; tmax = fmaxf(tmax, sacc[c][e]); }
            tmax = fmaxf(tmax, __shfl_xor(tmax, 16)); tmax = fmaxf(tmax, __shfl_xor(tmax, 32));
            const float mnew = fmaxf(mrun, tmax), muse = (mnew == -INFINITY) ? 0.f : mnew;
            const float alpha = __builtin_amdgcn_exp2f(mrun - muse);
            mrun = mnew;
            float psum = 0.f;
#pragma unroll
            for (int c = 0; c < 4; ++c)
#pragma unroll
                for (int e = 0; e < 4; ++e) { const float p = __builtin_amdgcn_exp2f(sacc[c][e] - muse); sacc[c][e] = p; psum += p; }
            lsum = lsum * alpha + psum;
#pragma unroll
            for (int dt = 0; dt < 4; ++dt) o[dt] *= alpha;
            const LAS unsigned char* vbase = F.lds + P3_V + bufi * P3_VBUF + g * 9216;
#pragma unroll
            for (int ks = 0; ks < 2; ++ks) {
                v4u pw; pw.x = pk2(sacc[2 * ks][0], sacc[2 * ks][1]); pw.y = pk2(sacc[2 * ks][2], sacc[2 * ks][3]); pw.z = pk2(sacc[2 * ks + 1][0], sacc[2 * ks + 1][1]); pw.w = pk2(sacc[2 * ks + 1][2], sacc[2 * ks + 1][3]);
                const bf16x8 pf = __builtin_bit_cast(bf16x8, pw);
#pragma unroll
                for (int dt = 0; dt < 4; ++dt) {
                    const LAS unsigned char* va = vbase + (32 * ks + 4 * kq + (j >> 2)) * 144 + (16 * dt + 4 * (j & 3)) * 2;
                    typedef short v4i16_t __attribute__((ext_vector_type(4)));
                    const v4i16_t lo4 = __builtin_amdgcn_ds_read_tr16_b64_v4i16((LAS v4i16_t*)va);
                    const v4i16_t hi4 = __builtin_amdgcn_ds_read_tr16_b64_v4i16((LAS v4i16_t*)(va + 16 * 144));
                    const bf16x8 vf = (bf16x8){lo4[0], lo4[1], lo4[2], lo4[3], hi4[0], hi4[1], hi4[2], hi4[3]};
                    o[dt] = __builtin_amdgcn_mfma_f32_16x16x32_bf16(vf, pf, o[dt], 0, 0, 0); } }
            if (t + 1 < nkt64) P3_STAGE_WRITE(bufi ^ 1);
            __syncthreads();
        }
#undef P3_STAGE_LOAD
#undef P3_STAGE_WRITE
        lsum += __shfl_xor(lsum, 16); lsum += __shfl_xor(lsum, 32);
        const float inv = 1.0f / lsum;
        const bf16* GA = (const bf16*)(F.ws + WS_GA); bf16* MIX = (bf16*)(F.ws + WS_MIX);
#pragma unroll
        for (int dt = 0; dt < 4; ++dt) { const int d = 16 * dt + 4 * kq; const v2u gv = *(const v2u*)(GA + mrow * 512 + hd * 64 + d);
            const float g0 = bf2f((unsigned short)(gv.x & 0xffffu)), g1 = bf2f((unsigned short)(gv.x >> 16)), g2 = bf2f((unsigned short)(gv.y & 0xffffu)), g3 = bf2f((unsigned short)(gv.y >> 16));
            v2u ov; ov.x = pk2(o[dt][0] * inv * g0, o[dt][1] * inv * g1); ov.y = pk2(o[dt][2] * inv * g2, o[dt][3] * inv * g3);
            *(v2u*)(MIX + mrow * 1024 + hd * 64 + d) = ov; }
    }
}

constexpr int PL_U = 0, PL_W = 40960, PL_STRIDE = 272;
template <bool SAMPLE> __device__ __forceinline__ void p3_pool_item(Frame& F, int item) {
    const int tid = F.tid, lane = F.lane, w = F.wave, j = lane & 15, kq = lane >> 4;
    const bf16* U = (const bf16*)(F.ws + WS_U); const bf16* GP = (const bf16*)(F.ws + WS_GP); const bf16* WPT = (const bf16*)(F.ws + WS_WPOOLT); bf16* MIX = (bf16*)(F.ws + WS_MIX);
    const int tokb = SAMPLE ? 0 : (item & 15) * 128;
    const size_t m0 = SAMPLE ? (size_t)MP : (size_t)(item >> 4) * SEQ + tokb;
    const int tl = 16 * w + j;
    const size_t mrow = m0 + tl;
    v4u wr_[4], ur_[5];
#define PL_LOAD(gg) do { _Pragma("unroll") for (int k_ = 0; k_ < 4; ++k_) { const int i_ = tid + 512 * k_; wr_[k_] = *(const v4u*)(WPT + (size_t)(gg) * 16384 + (i_ >> 4) * 128 + (i_ & 15) * 8); } \
        if (!SAMPLE) { _Pragma("unroll") for (int k_ = 0; k_ < 5; ++k_) { const int i_ = tid + 512 * k_; const int row_ = i_ >> 4, ch_ = i_ & 15; ur_[k_] = (v4u){0u, 0u, 0u, 0u}; \
            if (i_ < 143 * 16 && tokb - 15 + row_ >= 0) ur_[k_] = *(const v4u*)(U + (m0 - 15 + row_) * 512 + (gg) * 128 + ch_ * 8); } } } while (0)
#define PL_STORE() do { _Pragma("unroll") for (int k_ = 0; k_ < 4; ++k_) { const int i_ = tid + 512 * k_; *(LAS v4u*)(F.lds + PL_W + (i_ >> 4) * PL_STRIDE + (i_ & 15) * 16) = wr_[k_]; } \
        if (!SAMPLE) { _Pragma("unroll") for (int k_ = 0; k_ < 5; ++k_) { const int i_ = tid + 512 * k_; if (i_ < 143 * 16) *(LAS v4u*)(F.lds + PL_U + (i_ >> 4) * PL_STRIDE + (i_ & 15) * 16) = ur_[k_]; } } } while (0)
    PL_LOAD(0);
#pragma unroll
    for (int g = 0; g < 4; ++g) {
        const int win = 2 << g;
        PL_STORE();
        __syncthreads();
        if (g + 1 < 4) PL_LOAD(g + 1);
        bf16x8 df[4];
#pragma unroll
        for (int ks = 0; ks < 4; ++ks) {
            float sum[8], cur[8];
            if (!SAMPLE) {
                const LAS unsigned char* up = F.lds + PL_U + (15 + tl) * PL_STRIDE + (4 * ks + kq) * 16;
                { const v4u c = *(const LAS v4u*)up;
#pragma unroll
                  for (int u = 0; u < 4; ++u) { const unsigned x = c[u]; cur[2 * u] = bf2f((unsigned short)(x & 0xffffu)); cur[2 * u + 1] = bf2f((unsigned short)(x >> 16)); sum[2 * u] = cur[2 * u]; sum[2 * u + 1] = cur[2 * u + 1]; } }
#pragma unroll
                for (int i = 1; i < win; ++i) { const v4u c = *(const LAS v4u*)(up - i * PL_STRIDE);
#pragma unroll
                    for (int u = 0; u < 4; ++u) { const unsigned x = c[u]; sum[2 * u] += bf2f((unsigned short)(x & 0xffffu)); sum[2 * u + 1] += bf2f((unsigned short)(x >> 16)); } }
            } else {
                const int c0 = g * 128 + 32 * ks + 8 * kq;
                { const v4u c = *(const v4u*)(U + mrow * 512 + c0);
#pragma unroll
                  for (int u = 0; u < 4; ++u) { const unsigned x = c[u]; cur[2 * u] = bf2f((unsigned short)(x & 0xffffu)); cur[2 * u + 1] = bf2f((unsigned short)(x >> 16)); sum[2 * u] = cur[2 * u]; sum[2 * u + 1] = cur[2 * u + 1]; } }
#pragma unroll
                for (int i = 1; i < win; ++i) { const float* sp = F.state_pool + ((size_t)tl * 15 + (15 - i)) * 512 + c0; const f32x4 a = *(const f32x4*)sp, bq = *(const f32x4*)(sp + 4);
                    sum[0] += a[0]; sum[1] += a[1]; sum[2] += a[2]; sum[3] += a[3]; sum[4] += bq[0]; sum[5] += bq[1]; sum[6] += bq[2]; sum[7] += bq[3]; }
            }
            const int tpos = tokb + tl; const float rc = 1.0f / (float)(SAMPLE ? win : ((tpos + 1 < win) ? tpos + 1 : win));
            v4u pw; pw.x = pk2(sum[0] * rc - cur[0], sum[1] * rc - cur[1]); pw.y = pk2(sum[2] * rc - cur[2], sum[3] * rc - cur[3]);
            pw.z = pk2(sum[4] * rc - cur[4], sum[5] * rc - cur[5]); pw.w = pk2(sum[6] * rc - cur[6], sum[7] * rc - cur[7]);
            df[ks] = __builtin_bit_cast(bf16x8, pw);
        }
#pragma unroll
        for (int jt = 0; jt < 8; ++jt) {
            f32x4 acc = (f32x4){0.f, 0.f, 0.f, 0.f};
#pragma unroll
            for (int ks = 0; ks < 4; ++ks) { const bf16x8 wf = *(const LAS bf16x8*)(F.lds + PL_W + (16 * jt + j) * PL_STRIDE + (4 * ks + kq) * 16);
                acc = __builtin_amdgcn_mfma_f32_16x16x32_bf16(wf, df[ks], acc, 0, 0, 0); }
            const int col = g * 128 + 16 * jt + 4 * kq;
            const f32x4 ps = *(const f32x4*)(F.pool_scale + col); const v2u gv = *(const v2u*)(GP + mrow * 512 + col);
            const float g0 = bf2f((unsigned short)(gv.x & 0xffffu)), g1 = bf2f((unsigned short)(gv.x >> 16)), g2 = bf2f((unsigned short)(gv.y & 0xffffu)), g3 = bf2f((unsigned short)(gv.y >> 16));
            v2u ov; ov.x = pk2(acc[0] * ps[0] * g0, acc[1] * ps[1] * g1); ov.y = pk2(acc[2] * ps[2] * g2, acc[3] * ps[3] * g3);
            *(v2u*)(MIX + mrow * 1024 + 512 + col) = ov;
        }
        __syncthreads();
    }
#undef PL_LOAD
#undef PL_STORE
}

constexpr int SM_SC = 0, SM_SEL = 8448, SM_Q = 9472, SM_P = 11520, SM_RED = 19712, SM_PT = 27904;
__device__ __forceinline__ void p3_sample_item(Frame& F, int s) {
    const int tid = F.tid, lane = F.lane, w = F.wave, r = lane & 31, hh = lane >> 5;
    const size_t m = (size_t)MP + s;
    LAS float* sc = (LAS float*)(F.lds + SM_SC); LAS int* sel = (LAS int*)(F.lds + SM_SEL); LAS float* ql = (LAS float*)(F.lds + SM_Q);
    LAS float* pl = (LAS float*)(F.lds + SM_P); LAS float* red = (LAS float*)(F.lds + SM_RED); LAS int* ptl = (LAS int*)(F.lds + SM_PT);
    const bf16* QI = (const bf16*)(F.ws + WS_QI) + m * 512; const float* WIp = (const float*)(F.ws + WS_WI) + m * 8;
    const int* pt = F.page_table + s * NPG;
    ql[tid] = bf2f(((const bf16*)(F.ws + WS_Q))[m * 512 + tid]);
    if (tid < NPG) ptl[tid] = pt[tid];
    {
        bf16x8 af[4];
#pragma unroll
        for (int ks = 0; ks < 4; ++ks) { af[ks] = (bf16x8){0, 0, 0, 0, 0, 0, 0, 0}; if (r < 8) af[ks] = *(const bf16x8*)(QI + r * 64 + 16 * ks + 8 * hh); }
        float wv[4];
#pragma unroll
        for (int e = 0; e < 4; ++e) wv[e] = WIp[4 * hh + e];
        int pg[8];
#pragma unroll
        for (int it = 0; it < 8; ++it) pg[it] = pt[(w + 8 * it) >> 2];
#pragma unroll
        for (int hf = 0; hf < 4; ++hf) {
            f32x4 x0[2][4], x1[2][4];
#pragma unroll
            for (int i4 = 0; i4 < 2; ++i4) { const int kt = w + 8 * (2 * hf + i4);
                const float* kp = F.cache_kidx + ((size_t)pg[2 * hf + i4] * PAGE + (kt & 3) * 32 + r) * 64 + 8 * hh;
#pragma unroll
                for (int ks = 0; ks < 4; ++ks) { x0[i4][ks] = *(const f32x4*)(kp + 16 * ks); x1[i4][ks] = *(const f32x4*)(kp + 16 * ks + 4); } }
#pragma unroll
            for (int i4 = 0; i4 < 2; ++i4) { const int kt = w + 8 * (2 * hf + i4);
                f32x16 acc;
#pragma unroll
                for (int e = 0; e < 16; ++e) acc[e] = 0.f;
#pragma unroll
                for (int ks = 0; ks < 4; ++ks) {
                    v4u pw; pw.x = pk2(x0[i4][ks][0], x0[i4][ks][1]); pw.y = pk2(x0[i4][ks][2], x0[i4][ks][3]); pw.z = pk2(x1[i4][ks][0], x1[i4][ks][1]); pw.w = pk2(x1[i4][ks][2], x1[i4][ks][3]);
                    acc = __builtin_amdgcn_mfma_f32_32x32x16_bf16(af[ks], __builtin_bit_cast(bf16x8, pw), acc, 0, 0, 0); }
                float part = wv[0] * fmaxf(acc[0], 0.f) + wv[1] * fmaxf(acc[1], 0.f) + wv[2] * fmaxf(acc[2], 0.f) + wv[3] * fmaxf(acc[3], 0.f);
                part += __shfl_xor(part, 32);
                if (hh == 0) sc[32 * kt + r] = part; }
        }
        if (w == 0) {
            const float kv = bf2f(((const bf16*)(F.ws + WS_KI))[m * 64 + lane]); float tot = 0.f;
#pragma unroll
            for (int h = 0; h < 8; ++h) { const float d = wave_sum(bf2f(QI[h * 64 + lane]) * kv); tot += WIp[h] * fmaxf(d, 0.f); }
            if (lane == 0) sc[PAST] = tot;
        }
    }
    __syncthreads();
    if (w == 0) {
        unsigned key[33];
#pragma unroll
        for (int jj = 0; jj < 33; ++jj) { const int l = jj * 64 + lane; key[jj] = l < PAST + 1 ? f2key(sc[l]) : 0u; }
        unsigned Tk = 0u;
        for (int bit = 31; bit >= 0; --bit) { const unsigned cand = Tk | (1u << bit); int cnt = 0;
#pragma unroll
            for (int jj = 0; jj < 33; ++jj) cnt += __popcll(__ballot(key[jj] >= cand));
            if (cnt >= 256) Tk = cand; }
        int cgt = 0;
#pragma unroll
        for (int jj = 0; jj < 33; ++jj) cgt += __popcll(__ballot(key[jj] > Tk));
        const int need = 256 - cgt; const unsigned long long lt = (1ull << lane) - 1ull; int pos = 0, eq_seen = 0;
#pragma unroll
        for (int jj = 0; jj < 33; ++jj) { const bool gt = key[jj] > Tk, eq = key[jj] == Tk;
            const unsigned long long meq = __ballot(eq); const int eqb = eq_seen + __popcll(meq & lt);
            const bool take = gt || (eq && eqb < need); const unsigned long long mt = __ballot(take);
            const int l = jj * 64 + lane;
            if (take) sel[pos + __popcll(mt & lt)] = l < PAST ? ptl[l >> 7] * PAGE + (l & 127) : -1;
            pos += __popcll(mt); eq_seen += __popcll(meq); }
    }
    __syncthreads();
    {
        const int jk = tid & 255, g = tid >> 8; const int pr = sel[jk];
        const float* krow = pr >= 0 ? F.cache_k + (size_t)pr * 128 + g * 64 : F.out + O_KS + (size_t)s * 128 + g * 64;
        f32x4 kv[16];
#pragma unroll
        for (int c = 0; c < 16; ++c) kv[c] = *(const f32x4*)(krow + 4 * c);
        float d4[4] = {0.f, 0.f, 0.f, 0.f};
#pragma unroll
        for (int c = 0; c < 16; ++c) {
#pragma unroll
            for (int rr = 0; rr < 4; ++rr) { const f32x4 qv = *(const LAS f32x4*)(ql + (4 * g + rr) * 64 + 4 * c); d4[rr] += (qv[0] * kv[c][0] + qv[1] * kv[c][1]) + (qv[2] * kv[c][2] + qv[3] * kv[c][3]); } }
#pragma unroll
        for (int rr = 0; rr < 4; ++rr) pl[(4 * g + rr) * 256 + jk] = d4[rr];
    }
    __syncthreads();
    {
        float v[4]; float mx = -INFINITY;
#pragma unroll
        for (int i = 0; i < 4; ++i) { v[i] = pl[w * 256 + lane + 64 * i]; mx = fmaxf(mx, v[i]); }
        mx = wave_max(mx); float sm = 0.f;
#pragma unroll
        for (int i = 0; i < 4; ++i) { v[i] = __builtin_amdgcn_exp2f(v[i] - mx); sm += v[i]; }
        sm = wave_sum(sm); const float inv = 1.0f / sm;
#pragma unroll
        for (int i = 0; i < 4; ++i) pl[w * 256 + lane + 64 * i] = v[i] * inv;
    }
    __syncthreads();
    {
        const int d = tid & 63, g = (tid >> 6) & 1, k4 = tid >> 7; float acc[4] = {0.f, 0.f, 0.f, 0.f};
#pragma unroll
        for (int hb = 0; hb < 2; ++hb) { float vv[32];
#pragma unroll
            for (int i = 0; i < 32; ++i) { const int pr = sel[64 * k4 + 32 * hb + i];
                const float* vrow = pr >= 0 ? F.cache_v + (size_t)pr * 128 + g * 64 : F.out + O_VS + (size_t)s * 128 + g * 64; vv[i] = vrow[d]; }
#pragma unroll
            for (int i = 0; i < 32; ++i) {
#pragma unroll
                for (int rr = 0; rr < 4; ++rr) acc[rr] += pl[(4 * g + rr) * 256 + 64 * k4 + 32 * hb + i] * vv[i]; } }
#pragma unroll
        for (int rr = 0; rr < 4; ++rr) red[((k4 * 2 + g) * 4 + rr) * 64 + d] = acc[rr];
    }
    __syncthreads();
    { const int h = tid >> 6, d = tid & 63; float a = 0.f;
#pragma unroll
        for (int k4 = 0; k4 < 4; ++k4) a += red[((k4 * 2 + (h >> 2)) * 4 + (h & 3)) * 64 + d];
        const float gate = bf2f(((const bf16*)(F.ws + WS_GA))[m * 512 + tid]);
        ((bf16*)(F.ws + WS_MIX))[m * 1024 + tid] = (bf16)f2bf(a * gate); }
    { const int c = tid, g = c >> 7, win = 2 << g; const float un = bf2f(((const bf16*)(F.ws + WS_U))[m * 512 + c]); float sum = un;
      const float* sp = F.state_pool + (size_t)s * 15 * 512 + c;
      float hv[15];
#pragma unroll
      for (int i = 1; i < 16; ++i) hv[i - 1] = sp[(size_t)(15 - i) * 512];
#pragma unroll
      for (int i = 1; i < 16; ++i) sum += (i < win) ? hv[i - 1] : 0.f;
      ql[c] = bf2f((unsigned short)f2bf(sum / (float)win - un)); }
    __syncthreads();
    { const int col = tid, g = col >> 7, j = col & 127; const bf16* wr = (const bf16*)(F.ws + WS_WPOOLT) + (size_t)g * 16384 + j * 128;
      v4u wv4[16];
#pragma unroll
      for (int i = 0; i < 16; ++i) wv4[i] = *(const v4u*)(wr + 8 * i);
      float acc = 0.f;
#pragma unroll
      for (int i = 0; i < 16; ++i) { const LAS f32x4* dp = (const LAS f32x4*)(ql + g * 128 + 8 * i); const f32x4 d0 = dp[0], d1 = dp[1];
          acc += d0[0] * bf2f((unsigned short)(wv4[i].x & 0xffffu)) + d0[1] * bf2f((unsigned short)(wv4[i].x >> 16)) + d0[2] * bf2f((unsigned short)(wv4[i].y & 0xffffu)) + d0[3] * bf2f((unsigned short)(wv4[i].y >> 16));
          acc += d1[0] * bf2f((unsigned short)(wv4[i].z & 0xffffu)) + d1[1] * bf2f((unsigned short)(wv4[i].z >> 16)) + d1[2] * bf2f((unsigned short)(wv4[i].w & 0xffffu)) + d1[3] * bf2f((unsigned short)(wv4[i].w >> 16)); }
      const float gp = bf2f(((const bf16*)(F.ws + WS_GP))[m * 512 + col]);
      ((bf16*)(F.ws + WS_MIX))[m * 1024 + 512 + col] = (bf16)f2bf(acc * F.pool_scale[col] * gp); }
    __syncthreads();
}

__device__ __forceinline__ void p3_mixer(Frame& F) {
    for (int p = F.bid; p < 512; p += F.G) { const int b = p >> 6, sidx = p & 63;
        p3_prompt_item(F, b, 127 - sidx); __syncthreads(); FSTAMP();
        p3_prompt_item(F, b, sidx); __syncthreads(); FSTAMP(); }
    for (int x = F.bid; x < 128; x += F.G) { p3_sample_item(F, x); __syncthreads(); FSTAMP(); }
    for (int x = F.bid + ((F.bid < 128) ? ((128 - F.bid + F.G - 1) / F.G) * F.G : 0); x < 256; x += F.G) { p3_pool_item<false>(F, x - 128); __syncthreads(); FSTAMP(); }
}
__device__ __forceinline__ void p4_sample_out(Frame& F) {
    if (F.bid >= 64) return;
    const int lane = F.lane, w = F.wave, rl = lane & 15, kq = lane >> 4, n0 = F.bid * 16;
    const bf16* ap = (const bf16*)(F.ws + WS_MIX) + (size_t)(MP + 16 * w + rl) * 1024 + 8 * kq;
    const bf16* bp = (const bf16*)(F.ws + WS_WOUTT) + (size_t)(n0 + rl) * 1024 + 8 * kq;
    f32x4 acc = (f32x4){0.f, 0.f, 0.f, 0.f};
#pragma unroll
    for (int hb = 0; hb < 2; ++hb) { bf16x8 fa[16], fb[16];
#pragma unroll
        for (int i = 0; i < 16; ++i) { fa[i] = *(const bf16x8*)(ap + 32 * (16 * hb + i)); fb[i] = *(const bf16x8*)(bp + 32 * (16 * hb + i)); }
#pragma unroll
        for (int i = 0; i < 16; ++i) acc = __builtin_amdgcn_mfma_f32_16x16x32_bf16(fa[i], fb[i], acc, 0, 0, 0); }
    const float* ada = (const float*)(F.ws + WS_ADA);
#pragma unroll
    for (int e = 0; e < 4; ++e) { const int s = 16 * w + 4 * kq + e, n = n0 + rl;
        F.out[O_YS + (size_t)s * 1024 + n] = F.xs[(size_t)s * 1024 + n] + ada[(size_t)(NB + s) * 3072 + 2048 + n] * acc[e]; }
}

struct Args { const float* in[18]; float* out; unsigned char* ws; int ph_lo, ph_hi, li, pad; };
__global__ void __launch_bounds__(NWAVES * 64, 2) mk_fwd(Args args) {
    extern __shared__ __attribute__((aligned(16))) unsigned char lds[];
    Frame F;
    F.lds = (LAS unsigned char*)lds;
    F.MISC = (volatile LAS unsigned*)(F.lds + MISC_OFF);
    F.tid = threadIdx.x; F.lane = F.tid & 63; F.wave = __builtin_amdgcn_readfirstlane(F.tid >> 6);
    F.G = gridDim.x; F.bid = blockIdx.x; { const int bx = blockIdx.x; F.vcu = (F.G % 8 == 0) ? (bx % 8) * (F.G / 8) + bx / 8 : bx; }
    F.ws = args.ws; F.out = args.out; F.ctl = (gu32*)(args.ws + WS_CTL);
    F.xp = args.in[0]; F.xs = args.in[1]; F.cache_k = args.in[2]; F.cache_v = args.in[3]; F.cache_kidx = args.in[4]; F.state_pool = args.in[5];
    F.page_table = (const int*)args.in[6]; F.cp = args.in[7]; F.cs = args.in[8]; F.norm_w = args.in[9]; F.w_ada = args.in[10]; F.b_ada = args.in[11];
    F.w_in = args.in[12]; F.qnw = args.in[13]; F.knw = args.in[14]; F.w_pool = args.in[15]; F.pool_scale = args.in[16]; F.w_out = args.in[17];
    for (int u = F.tid; u < (LDS_BYTES - LDSCTL_OFF) / 4; u += NWAVES * 64) ((LAS unsigned*)(F.lds + LDSCTL_OFF))[u] = 0u;
    __syncthreads();
    XcdBarrier bar = xcd_barrier_post((unsigned*)(F.ctl + CW_BAR) + args.li * XCD_BAR_WORDS, F.MISC + 8);
    const int lo = args.ph_lo, hi = args.ph_hi;
#if TEST_MODE == 4
    unsigned long long* ts = (unsigned long long*)(args.ws + WS_CTL + 768 * 1024); int nst = 0;
#define STAMP() do { if (blockIdx.x == STAMP_BLK && threadIdx.x == 0) ts[nst] = __builtin_amdgcn_s_memrealtime(); ++nst; } while (0)
    F.ts = ts + 16; F.nst = 0;
#else
#define STAMP() do { } while (0)
#endif
    STAMP();
#define IN(k) (lo <= (k) && (k) < hi)
#define BOTH(k) (IN(k) && IN((k) + 1))
    if (IN(0)) { p0_prologue(F); STAMP(); if (BOTH(0)) xcd_barrier(bar); STAMP(); }
    if (IN(1)) { p1_norm(F); STAMP(); if (BOTH(1)) xcd_barrier(bar); STAMP(); }
    if (IN(2)) {
        p2_sample(F);
        pg8::Gemm g{(const pg8::bf16_t*)(F.ws + WS_HB), (const pg8::bf16_t*)(F.ws + WS_WINT), MP, 3072, DM};
        pg8::StaticOrder S; S.init(MP, 3072, F.G, (int)blockIdx.x);
        pg8::EpiIn E{F.ws, F.out, F.qnw, F.knw};
        pg8::gemm_phase<pg8::EpiIn, pg8::StaticOrder, true, true>(F.lds + RING_OFF, g, S, E);
        STAMP(); if (BOTH(2)) xcd_barrier(bar); STAMP();
    }
#if HAVE_P3
    if (IN(3)) { p3_mixer(F); STAMP(); if (BOTH(3)) xcd_barrier(bar); STAMP(); }
#endif
    if (IN(4)) {
        pg8::Gemm g{(const pg8::bf16_t*)(F.ws + WS_MIX), (const pg8::bf16_t*)(F.ws + WS_WOUTT), MP, DM, DM};
        pg8::StaticOrder S; S.init(MP, DM, F.G, (int)blockIdx.x);
        pg8::EpiOut E{F.xp, F.out + O_YP, (const float*)(F.ws + WS_ADA)};
        pg8::gemm_phase<pg8::EpiOut, pg8::StaticOrder, true, true>(F.lds + RING_OFF, g, S, E);
        STAMP(); p4_sample_out(F); STAMP();
    }
#undef IN
#undef BOTH
}

#if TEST_MODE && TEST_MODE != 4
namespace gold {
constexpr size_t W_ADA = 0, W_H = W_ADA + (size_t)NR * 3072, W_PROJ = W_H + (size_t)MT * 1024, W_SC = W_PROJ + (size_t)MT * NIN,
                 W_SCS = W_SC + (size_t)MP * 2048, W_SEL = W_SCS + (size_t)DECB * 2112, W_NSEL = W_SEL + (size_t)MT * 256, W_END = W_NSEL + MT;
constexpr size_t W_YT = W_H, W_MIX = W_SC, W_DB = W_SC + (size_t)MT * 1024;

__device__ __forceinline__ float wave_sum(float v) {
#pragma unroll
    for (int o = 1; o < 64; o <<= 1) v += __shfl_xor(v, o);
    return v;
}
__device__ __forceinline__ float wave_max(float v) {
#pragma unroll
    for (int o = 1; o < 64; o <<= 1) v = fmaxf(v, __shfl_xor(v, o));
    return v;
}
__device__ __forceinline__ float silu_f(float x) { return x / (1.f + expf(-x)); }

__global__ void __launch_bounds__(256) k_ada(const float* __restrict__ cp, const float* __restrict__ cs, const float* __restrict__ w_ada,
                                              const float* __restrict__ b_ada, float* __restrict__ ada) {
    const int j = blockIdx.x * 256 + threadIdx.x, r = blockIdx.y;
    const float* c = r < NB ? cp + (size_t)r * DM : cs + (size_t)(r - NB) * DM;
    float acc = 0.f;
    for (int k = 0; k < DM; ++k) { const float cv = c[k]; acc += silu_f(cv) * w_ada[(size_t)k * 3072 + j]; }
    ada[(size_t)r * 3072 + j] = acc + b_ada[j];
}

__global__ void __launch_bounds__(256) k_h(const float* __restrict__ xp, const float* __restrict__ xs, const float* __restrict__ norm_w,
                                            const float* __restrict__ ada, float* __restrict__ H) {
    const int m = blockIdx.x * 4 + (threadIdx.x >> 6), lane = threadIdx.x & 63;
    const float* x = m < MP ? xp + (size_t)m * DM : xs + (size_t)(m - MP) * DM;
    const int r = m < MP ? m / SEQ : NB + (m - MP);
    float v[16]; float ss = 0.f;
#pragma unroll
    for (int i = 0; i < 16; ++i) { v[i] = x[lane + 64 * i]; ss += v[i] * v[i]; }
    ss = wave_sum(ss);
    const float rstd = 1.0f / sqrtf(ss * (1.0f / DM) + 1e-6f);
#pragma unroll
    for (int i = 0; i < 16; ++i) { const int c = lane + 64 * i;
        H[(size_t)m * DM + c] = v[i] * rstd * norm_w[c] * (1.f + ada[(size_t)r * 3072 + 1024 + c]) + ada[(size_t)r * 3072 + c]; }
}

__global__ void __launch_bounds__(256) k_gemm(const float* __restrict__ A, const float* __restrict__ B, float* __restrict__ C,
                                               int M, int N, int K, int lda, int ldb, int ldc) {
    const int wave = threadIdx.x >> 6, lane = threadIdx.x & 63, r = lane & 31, h = lane >> 5;
    const int m0 = blockIdx.y * 128 + (wave >> 1) * 64, n0 = blockIdx.x * 128 + (wave & 1) * 64;
    f32x16 acc[2][2];
#pragma unroll
    for (int i = 0; i < 2; ++i)
#pragma unroll
        for (int j = 0; j < 2; ++j)
#pragma unroll
            for (int e = 0; e < 16; ++e) acc[i][j][e] = 0.f;
    const float* a0 = A + (size_t)(m0 + r) * lda + h;
    const float* a1 = a0 + (size_t)32 * lda;
    const int c0 = n0 + r, c1 = n0 + 32 + r; const bool v0 = c0 < N, v1 = c1 < N;
    const float* b0 = B + (size_t)h * ldb + (v0 ? c0 : 0);
    const float* b1 = B + (size_t)h * ldb + (v1 ? c1 : 0);
#pragma unroll 4
    for (int k = 0; k < K; k += 2) {
        const float x0 = a0[k], x1 = a1[k];
        float y0 = b0[(size_t)k * ldb], y1 = b1[(size_t)k * ldb];
        y0 = v0 ? y0 : 0.f; y1 = v1 ? y1 : 0.f;
        acc[0][0] = __builtin_amdgcn_mfma_f32_32x32x2f32(x0, y0, acc[0][0], 0, 0, 0);
        acc[0][1] = __builtin_amdgcn_mfma_f32_32x32x2f32(x0, y1, acc[0][1], 0, 0, 0);
        acc[1][0] = __builtin_amdgcn_mfma_f32_32x32x2f32(x1, y0, acc[1][0], 0, 0, 0);
        acc[1][1] = __builtin_amdgcn_mfma_f32_32x32x2f32(x1, y1, acc[1][1], 0, 0, 0);
    }
#pragma unroll
    for (int i = 0; i < 2; ++i)
#pragma unroll
        for (int j = 0; j < 2; ++j) { const int col = n0 + 32 * j + r;
            if (col < N) {
#pragma unroll
                for (int e = 0; e < 16; ++e) { const int row = m0 + 32 * i + (e & 3) + 8 * (e >> 2) + 4 * h; C[(size_t)row * ldc + col] = acc[i][j][e]; } } }
}

__global__ void __launch_bounds__(256) k_post(float* __restrict__ proj, const float* __restrict__ qnw, const float* __restrict__ knw,
                                               const float* __restrict__ state_pool, float* __restrict__ out) {
    const int m = blockIdx.x * 4 + (threadIdx.x >> 6), lane = threadIdx.x & 63;
    float* p = proj + (size_t)m * NIN;
    for (int hh = 0; hh < 8; ++hh) { const float v = p[CQ + hh * 64 + lane]; const float ss = wave_sum(v * v);
        p[CQ + hh * 64 + lane] = v * (1.0f / sqrtf(ss * (1.f / 64.f) + 1e-6f)) * qnw[lane]; }
    float* ko = m < MP ? out + O_KP + (size_t)m * 128 : out + O_KS + (size_t)(m - MP) * 128;
    float* vo = m < MP ? out + O_VP + (size_t)m * 128 : out + O_VS + (size_t)(m - MP) * 128;
    float* kio = m < MP ? out + O_KIP + (size_t)m * 64 : out + O_KIS + (size_t)(m - MP) * 64;
    for (int g = 0; g < 2; ++g) { const float v = p[CK + g * 64 + lane]; const float ss = wave_sum(v * v);
        const float kn = v * (1.0f / sqrtf(ss * (1.f / 64.f) + 1e-6f)) * knw[lane];
        p[CK + g * 64 + lane] = kn; ko[g * 64 + lane] = kn; vo[g * 64 + lane] = p[CV + g * 64 + lane]; }
    kio[lane] = p[CKI + lane];
    if (lane < 8) p[CWI + lane] *= 0.04419417382415922f;
    if (m < MP) { const int b = m / SEQ, t = m % SEQ;
        if (t >= SEQ - 15) { float* po = out + O_PP + ((size_t)b * 15 + (t - (SEQ - 15))) * 512;
            for (int c = lane; c < 512; c += 64) po[c] = p[CU + c]; }
    } else { const int s = m - MP; float* po = out + O_PS + (size_t)s * 15 * 512;
        for (int i = lane; i < 14 * 512; i += 64) po[i] = state_pool[(size_t)s * 15 * 512 + 512 + i];
        for (int c = lane; c < 512; c += 64) po[14 * 512 + c] = p[CU + c]; }
}

__global__ void __launch_bounds__(256) k_scores_p(const float* __restrict__ proj, float* __restrict__ SC) {
    __shared__ float qs[8][512]; __shared__ float wsm[8][8];
    const int b = blockIdx.y, t0 = blockIdx.x * 8, tid = threadIdx.x;
    for (int i = tid; i < 8 * 512; i += 256) qs[i >> 9][i & 511] = proj[(size_t)(b * SEQ + t0 + (i >> 9)) * NIN + CQI + (i & 511)];
    if (tid < 64) wsm[tid >> 3][tid & 7] = proj[(size_t)(b * SEQ + t0 + (tid >> 3)) * NIN + CWI + (tid & 7)];
    __syncthreads();
    for (int l = tid; l <= t0 + 7; l += 256) {
        float kr[64];
        const float4* kp = (const float4*)(proj + (size_t)(b * SEQ + l) * NIN + CKI);
#pragma unroll
        for (int i = 0; i < 16; ++i) { const float4 v = kp[i]; kr[4 * i] = v.x; kr[4 * i + 1] = v.y; kr[4 * i + 2] = v.z; kr[4 * i + 3] = v.w; }
        for (int q = 0; q < 8; ++q) {
            if (l > t0 + q) continue;
            float s = 0.f;
            for (int hh = 0; hh < 8; ++hh) { float d = 0.f;
#pragma unroll
                for (int e = 0; e < 64; ++e) d += qs[q][hh * 64 + e] * kr[e];
                s += wsm[q][hh] * fmaxf(d, 0.f); }
            SC[(size_t)(b * SEQ + t0 + q) * 2048 + l] = s;
        }
    }
}
__global__ void __launch_bounds__(256) k_scores_s(const float* __restrict__ proj, const float* __restrict__ cache_kidx, const int* __restrict__ page_table,
                                                   float* __restrict__ SCS) {
    __shared__ float qs[512]; __shared__ float wsm[8];
    const int s = blockIdx.x, tid = threadIdx.x; const float* prow = proj + (size_t)(MP + s) * NIN;
    for (int i = tid; i < 512; i += 256) qs[i] = prow[CQI + i];
    if (tid < 8) wsm[tid] = prow[CWI + tid];
    __syncthreads();
    for (int l = tid; l < PAST + 1; l += 256) {
        const float* kp_ = l < PAST ? cache_kidx + ((size_t)page_table[s * NPG + l / PAGE] * PAGE + (l % PAGE)) * 64 : prow + CKI;
        float kr[64];
#pragma unroll
        for (int i = 0; i < 64; ++i) kr[i] = kp_[i];
        float sc = 0.f;
        for (int hh = 0; hh < 8; ++hh) { float d = 0.f;
#pragma unroll
            for (int e = 0; e < 64; ++e) d += qs[hh * 64 + e] * kr[e];
            sc += wsm[hh] * fmaxf(d, 0.f); }
        SCS[(size_t)s * 2112 + l] = sc;
    }
}

__device__ __forceinline__ unsigned f2key(float f) { unsigned u = __float_as_uint(f); if (f == 0.0f) u = 0u; return (u & 0x80000000u) ? ~u : (u | 0x80000000u); }
__global__ void __launch_bounds__(256) k_topk(const float* __restrict__ SC, const float* __restrict__ SCS, int* __restrict__ SEL, int* __restrict__ NSEL) {
    const int m = blockIdx.x * 4 + (threadIdx.x >> 6), lane = threadIdx.x & 63;
    const float* src; int n;
    if (m < MP) { n = (m % SEQ) + 1; src = SC + (size_t)m * 2048; } else { n = PAST + 1; src = SCS + (size_t)(m - MP) * 2112; }
    int* sel = SEL + (size_t)m * 256;
    if (n <= 256) { for (int i = lane; i < n; i += 64) sel[i] = i; if (lane == 0) NSEL[m] = n; return; }
    unsigned key[33];
#pragma unroll
    for (int j = 0; j < 33; ++j) { const int l = j * 64 + lane; key[j] = l < n ? f2key(src[l]) : 0u; }
    unsigned T = 0u;
    for (int bit = 31; bit >= 0; --bit) { const unsigned cand = T | (1u << bit); int cnt = 0;
#pragma unroll
        for (int j = 0; j < 33; ++j) cnt += __popcll(__ballot(key[j] >= cand));
        if (cnt >= 256) T = cand; }
    int cgt = 0;
#pragma unroll
    for (int j = 0; j < 33; ++j) cgt += __popcll(__ballot(key[j] > T));
    const int need = 256 - cgt;
    const unsigned long long lt = (1ull << lane) - 1ull;
    int pos = 0, eq_seen = 0;
#pragma unroll
    for (int j = 0; j < 33; ++j) { const bool gt = key[j] > T, eq = key[j] == T;
        const unsigned long long meq = __ballot(eq); const int eqb = eq_seen + __popcll(meq & lt);
        const bool take = gt || (eq && eqb < need);
        const unsigned long long mt = __ballot(take);
        if (take) sel[pos + __popcll(mt & lt)] = j * 64 + lane;
        pos += __popcll(mt); eq_seen += __popcll(meq); }
    if (lane == 0) NSEL[m] = 256;
}

__global__ void __launch_bounds__(256) k_attn(const float* __restrict__ proj, const float* __restrict__ cache_k, const float* __restrict__ cache_v,
                                               const int* __restrict__ page_table, const int* __restrict__ SEL, const int* __restrict__ NSEL, float* __restrict__ MIX) {
    __shared__ float pl[4][8][256]; __shared__ int il[4][256]; __shared__ float ql[4][512];
    const int w = threadIdx.x >> 6, lane = threadIdx.x & 63, m = blockIdx.x * 4 + w;
    const int nsel = NSEL[m]; const float* prow = proj + (size_t)m * NIN;
    const bool prompt = m < MP; const int b = m / SEQ, s = m - MP;
    for (int i = lane; i < 512; i += 64) ql[w][i] = prow[CQ + i];
    for (int i = lane; i < 256; i += 64) {
        if (i < nsel) { const int l = SEL[(size_t)m * 256 + i]; il[w][i] = l;
            const float* krow = prompt ? proj + (size_t)(b * SEQ + l) * NIN + CK
                                       : (l < PAST ? cache_k + ((size_t)page_table[s * NPG + l / PAGE] * PAGE + (l % PAGE)) * 128 : prow + CK);
            for (int g = 0; g < 2; ++g) { float kr[64];
#pragma unroll
                for (int e = 0; e < 64; ++e) kr[e] = krow[g * 64 + e];
                for (int r = 0; r < 4; ++r) { float d = 0.f;
#pragma unroll
                    for (int e = 0; e < 64; ++e) d += ql[w][(g * 4 + r) * 64 + e] * kr[e];
                    pl[w][g * 4 + r][i] = d * 0.125f; } }
        } else { il[w][i] = 0; for (int hh = 0; hh < 8; ++hh) pl[w][hh][i] = -INFINITY; }
    }
    for (int hh = 0; hh < 8; ++hh) { float v[4]; float mx = -INFINITY;
#pragma unroll
        for (int i = 0; i < 4; ++i) { v[i] = pl[w][hh][lane + 64 * i]; mx = fmaxf(mx, v[i]); }
        mx = wave_max(mx); float sm = 0.f;
#pragma unroll
        for (int i = 0; i < 4; ++i) { v[i] = expf(v[i] - mx); sm += v[i]; }
        sm = wave_sum(sm); const float inv = 1.0f / sm;
#pragma unroll
        for (int i = 0; i < 4; ++i) pl[w][hh][lane + 64 * i] = v[i] * inv; }
    for (int g = 0; g < 2; ++g) { float acc[4] = {0.f, 0.f, 0.f, 0.f};
        for (int i = 0; i < nsel; ++i) { const int l = il[w][i];
            const float* vrow = prompt ? proj + (size_t)(b * SEQ + l) * NIN + CV
                                       : (l < PAST ? cache_v + ((size_t)page_table[s * NPG + l / PAGE] * PAGE + (l % PAGE)) * 128 : prow + CV);
            const float vv = vrow[g * 64 + lane];
#pragma unroll
            for (int r = 0; r < 4; ++r) acc[r] += pl[w][g * 4 + r][i] * vv; }
#pragma unroll
        for (int r = 0; r < 4; ++r) { const int c = (g * 4 + r) * 64 + lane; MIX[(size_t)m * 1024 + c] = acc[r] * silu_f(prow[CGA + c]); } }
}

__global__ void __launch_bounds__(256) k_pool_d(const float* __restrict__ proj, const float* __restrict__ state_pool, float* __restrict__ DB) {
    const size_t idx = (size_t)blockIdx.x * 256 + threadIdx.x; const int m = (int)(idx >> 9), c = (int)(idx & 511);
    const int g = c >> 7, w = 2 << g; const float un = proj[(size_t)m * NIN + CU + c]; float sum = un; float cnt;
    if (m < MP) { const int t = m % SEQ; for (int i = 1; i < w; ++i) if (t - i >= 0) sum += proj[(size_t)(m - i) * NIN + CU + c]; cnt = (float)(t + 1 < w ? t + 1 : w); }
    else { const int s = m - MP; for (int i = 1; i < w; ++i) sum += state_pool[((size_t)s * 15 + (15 - i)) * 512 + c]; cnt = (float)w; }
    DB[idx] = sum / cnt - un;
}
__global__ void __launch_bounds__(256) k_pool_out(const float* __restrict__ proj, const float* __restrict__ DB, const float* __restrict__ w_pool,
                                                   const float* __restrict__ pool_scale, float* __restrict__ MIX) {
    const size_t idx = (size_t)blockIdx.x * 256 + threadIdx.x; const int m = (int)(idx >> 9), col = (int)(idx & 511), g = col >> 7, j = col & 127;
    float acc = 0.f;
    for (int c = 0; c < 128; ++c) acc += DB[(size_t)m * 512 + g * 128 + c] * w_pool[((size_t)g * 128 + c) * 128 + j];
    MIX[(size_t)m * 1024 + 512 + col] = acc * pool_scale[col] * silu_f(proj[(size_t)m * NIN + CGP + col]);
}
__global__ void __launch_bounds__(256) k_final(const float* __restrict__ xp, const float* __restrict__ xs, const float* __restrict__ ada,
                                                const float* __restrict__ YT, float* __restrict__ out) {
    const size_t idx = (size_t)blockIdx.x * 256 + threadIdx.x; const int m = (int)(idx >> 10), c = (int)(idx & 1023);
    const int r = m < MP ? m / SEQ : NB + (m - MP);
    const float x = m < MP ? xp[idx] : xs[idx - (size_t)MP * 1024];
    float* o = m < MP ? out + O_YP + idx : out + O_YS + (idx - (size_t)MP * 1024);
    *o = x + ada[(size_t)r * 3072 + 2048 + c] * YT[idx];
}

}
#endif

#if TEST_MODE
__global__ void __launch_bounds__(256) k_cmp(const void* a, int a_bf16, int lda, const float* ref, int ldr, int rows, int cols, float scale, int act, float* accum) {
    __shared__ float sd[256], sr[256];
    const size_t idx = (size_t)blockIdx.x * 256 + threadIdx.x; float d2 = 0.f, r2 = 0.f;
    if (idx < (size_t)rows * cols) { const size_t r = idx / cols, c = idx % cols;
        const float av = a_bf16 ? bf2f(((const bf16*)a)[r * lda + c]) : ((const float*)a)[r * lda + c];
        float rv = ref[r * ldr + c]; if (act) rv = rv / (1.f + expf(-rv)); rv *= scale;
        d2 = (av - rv) * (av - rv); r2 = rv * rv; if (!(d2 == d2)) d2 = 1e30f; }
    sd[threadIdx.x] = d2; sr[threadIdx.x] = r2; __syncthreads();
    for (int s = 128; s > 0; s >>= 1) { if ((int)threadIdx.x < s) { sd[threadIdx.x] += sd[threadIdx.x + s]; sr[threadIdx.x] += sr[threadIdx.x + s]; } __syncthreads(); }
    if (threadIdx.x == 0) { atomicAdd(accum, sd[0]); atomicAdd(accum + 1, sr[0]); }
}
__global__ void __launch_bounds__(256) k_cmp_sel(const int* SEL, const int* NSEL, const unsigned* bmdump, float* accum) {
    __shared__ float sd[256], sr[256];
    const size_t idx = (size_t)blockIdx.x * 256 + threadIdx.x; const int m = (int)(idx >> 8), i = (int)(idx & 255); float miss = 0.f, tot = 0.f;
    if (m < MP && i < NSEL[m]) { const int l = SEL[(size_t)m * 256 + i]; tot = 1.f; if (!((bmdump[(size_t)m * 64 + (l >> 5)] >> (l & 31)) & 1u)) miss = 1.f; }
    sd[threadIdx.x] = miss; sr[threadIdx.x] = tot; __syncthreads();
    for (int s = 128; s > 0; s >>= 1) { if ((int)threadIdx.x < s) { sd[threadIdx.x] += sd[threadIdx.x + s]; sr[threadIdx.x] += sr[threadIdx.x + s]; } __syncthreads(); }
    if (threadIdx.x == 0) { atomicAdd(accum, sd[0]); atomicAdd(accum + 1, sr[0]); }
}
__global__ void k_cmp_fin2(float* accum, int n, float amp) {
    float best = -1.f; int bi = 0;
    for (int k = 0; k < n; ++k) { const float rel = accum[2 * k] / fmaxf(accum[2 * k + 1], 1e-30f) / accum[32 + k]; if (rel > best) { best = rel; bi = k; } }
    accum[64] = sqrtf(amp * best); accum[65] = (float)bi;
}
__global__ void k_set(float* p, float a, float b, float c, float d, float e) { p[0] = a; p[1] = b; p[2] = c; p[3] = d; p[4] = e; }
__global__ void k_cmp_fin(float* accum, int n, float amp) {
    float best = -1.f; int bi = 0;
    for (int k = 0; k < n; ++k) { const float rel = accum[2 * k] / fmaxf(accum[2 * k + 1], 1e-30f); if (rel > best) { best = rel; bi = k; } }
    accum[64] = sqrtf(amp * best); accum[65] = (float)bi;
}
__global__ void __launch_bounds__(256) k_perturb(float* out, const float* accum) {
    const size_t offs[11] = {O_YP, O_YS, O_KP, O_VP, O_KIP, O_PP, O_KS, O_VS, O_KIS, O_PS, O_END};
    const int k = (int)accum[65] % 10; const float f = 1.0f + accum[64];
    for (size_t i = offs[k] + (size_t)blockIdx.x * 256 + threadIdx.x; i < offs[k + 1]; i += (size_t)gridDim.x * 256) out[i] *= f;
}
__global__ void __launch_bounds__(256) k_f32_to_bf16(const float* src, bf16* dst, size_t n) {
    for (size_t i = (size_t)blockIdx.x * 256 + threadIdx.x; i < n; i += (size_t)gridDim.x * 256) dst[i] = (bf16)f2bf(src[i]);
}
#endif

#if TEST_MODE == 4
__global__ void __launch_bounds__(256) k_time(float* out, const unsigned long long* ts, int i0, int i1, float scale) {
    const float us = (float)(ts[i1] - ts[i0]) * 0.01f; const float f = 1.0f + sqrtf(us * scale);
    for (size_t i = O_KS + (size_t)blockIdx.x * 256 + threadIdx.x; i < O_VS; i += (size_t)gridDim.x * 256) out[i] *= f;
}
#endif
extern "C" void kernel_launch(void* const* d_in, const int* in_sizes, int n_in, void* d_out, int out_size, void* d_ws, size_t ws_size, hipStream_t stream) {
    static int grid = 0;
    if (grid == 0) {
        size_t need = WS_MEGA_END;
#if TEST_MODE && TEST_MODE != 4
        need = 192 * MiB + gold::W_END * 4;
#endif
        if (n_in != 18 || out_size != (int)O_END || ws_size < need) { fprintf(stderr, "kernel_launch: unexpected sizes: n_in %d out %d ws %zu (need %zu)\n", n_in, out_size, ws_size, need); grid = -1; return; }
        int dev = 0, cus = 0, per_cu = 0;
        if (hipGetDevice(&dev) != hipSuccess || hipDeviceGetAttribute(&cus, hipDeviceAttributeMultiprocessorCount, dev) != hipSuccess) { grid = -1; return; }
        if (hipFuncSetAttribute((const void*)mk_fwd, hipFuncAttributeMaxDynamicSharedMemorySize, LDS_BYTES) != hipSuccess) { fprintf(stderr, "kernel_launch: hipFuncSetAttribute failed\n"); grid = -1; return; }
        if (hipOccupancyMaxActiveBlocksPerMultiprocessor(&per_cu, (const void*)mk_fwd, NWAVES * 64, LDS_BYTES) != hipSuccess || per_cu < 1) { fprintf(stderr, "kernel_launch: occupancy query says %d blocks/CU\n", per_cu); (void)hipGetLastError(); grid = -1; return; }
        if (cus < 64) { fprintf(stderr, "kernel_launch: needs >= 64 CUs\n"); grid = -1; return; }
        grid = cus;
    }
    if (grid < 0) return;
    (void)hipMemsetAsync((char*)d_ws + WS_CTL, 0, CTL_ZERO_BYTES, stream);
    Args a{};
    for (int i = 0; i < 18; ++i) a.in[i] = (const float*)d_in[i];
    a.out = (float*)d_out; a.ws = (unsigned char*)d_ws;
#if TEST_MODE == 4
    a.ph_lo = 0; a.ph_hi = 5; a.li = 0;
    hipLaunchKernelGGL(mk_fwd, dim3(grid), dim3(NWAVES * 64), LDS_BYTES, stream, a);
    k_time<<<16, 256, 0, stream>>>((float*)d_out, (const unsigned long long*)((char*)d_ws + WS_CTL + 768 * 1024), TS0, TS1, 1e-5f);
#elif TEST_MODE
    {
        using namespace gold;
        const float* xp = (const float*)d_in[0]; const float* xs = (const float*)d_in[1];
        const float* cache_k = (const float*)d_in[2]; const float* cache_v = (const float*)d_in[3]; const float* cache_kidx = (const float*)d_in[4];
        const float* state_pool = (const float*)d_in[5]; const int* page_table = (const int*)d_in[6];
        const float* cp = (const float*)d_in[7]; const float* cs = (const float*)d_in[8]; const float* norm_w = (const float*)d_in[9];
        const float* w_ada = (const float*)d_in[10]; const float* b_ada = (const float*)d_in[11]; const float* w_in = (const float*)d_in[12];
        const float* qnw = (const float*)d_in[13]; const float* knw = (const float*)d_in[14]; const float* w_pool = (const float*)d_in[15];
        const float* pool_scale = (const float*)d_in[16]; const float* w_out = (const float*)d_in[17];
        float* out = (float*)d_out; float* ws = (float*)((char*)d_ws + 192 * MiB);
        float *ADA = ws + W_ADA, *H = ws + W_H, *PROJ = ws + W_PROJ, *SC = ws + W_SC, *SCS = ws + W_SCS, *MIX = ws + W_MIX, *DB = ws + W_DB, *YT = ws + W_YT;
        int *SEL = (int*)(ws + W_SEL), *NSEL = (int*)(ws + W_NSEL);
        k_ada<<<dim3(12, NR), 256, 0, stream>>>(cp, cs, w_ada, b_ada, ADA);
        k_h<<<MT / 4, 256, 0, stream>>>(xp, xs, norm_w, ADA, H);
        k_gemm<<<dim3((NIN + 127) / 128, MT / 128), 256, 0, stream>>>(H, w_in, PROJ, MT, NIN, DM, DM, NIN, NIN);
        k_post<<<MT / 4, 256, 0, stream>>>(PROJ, qnw, knw, state_pool, out);
        k_scores_p<<<dim3(SEQ / 8, NB), 256, 0, stream>>>(PROJ, SC);
        k_scores_s<<<DECB, 256, 0, stream>>>(PROJ, cache_kidx, page_table, SCS);
        k_topk<<<MT / 4, 256, 0, stream>>>(SC, SCS, SEL, NSEL);
        k_attn<<<MT / 4, 256, 0, stream>>>(PROJ, cache_k, cache_v, page_table, SEL, NSEL, MIX);
        k_pool_d<<<(MT * 512) / 256, 256, 0, stream>>>(PROJ, state_pool, DB);
        k_pool_out<<<(MT * 512) / 256, 256, 0, stream>>>(PROJ, DB, w_pool, pool_scale, MIX);
        k_gemm<<<dim3(1024 / 128, MT / 128), 256, 0, stream>>>(MIX, w_out, YT, MT, 1024, 1024, 1024, 1024, 1024);
        k_final<<<(MT * 1024) / 256, 256, 0, stream>>>(xp, xs, ADA, YT, out);
        unsigned char* mws = (unsigned char*)d_ws;
#if TEST_MODE == 1
        a.ph_lo = 0; a.ph_hi = 3; a.li = 0;
        hipLaunchKernelGGL(mk_fwd, dim3(grid), dim3(NWAVES * 64), LDS_BYTES, stream, a);
        float* accum = (float*)(mws + WS_CTL + 512 * 1024);
        struct { const void* a; int bf; int lda; int refcol; int cols; float scale; int act; } L[9] = {
            {mws + WS_Q, 1, 512, CQ, 512, C2, 0}, {mws + WS_QI, 1, 512, CQI, 512, 1.f, 0}, {mws + WS_GA, 1, 512, CGA, 512, 1.f, 1}, {mws + WS_U, 1, 512, CU, 512, 1.f, 0},
            {mws + WS_GP, 1, 512, CGP, 512, 1.f, 1}, {mws + WS_KB, 1, 128, CK, 128, 1.f, 0}, {mws + WS_VB, 1, 128, CV, 128, 1.f, 0}, {mws + WS_KI, 1, 64, CKI, 64, 1.f, 0},
            {mws + WS_WI, 0, 8, CWI, 8, 1.f, 0} };
        for (int k = 0; k < 9; ++k) k_cmp<<<(unsigned)(((size_t)MT * L[k].cols + 255) / 256), 256, 0, stream>>>(L[k].a, L[k].bf, L[k].lda, PROJ + L[k].refcol, NIN, MT, L[k].cols, L[k].scale, L[k].act, accum + 2 * k);
        k_cmp<<<(NR * 3072 + 255) / 256, 256, 0, stream>>>(mws + WS_ADA, 0, 3072, ADA, 3072, NR, 3072, 1.f, 0, accum + 18);
        k_cmp_fin<<<1, 1, 0, stream>>>(accum, 10, 5.0f);
        k_perturb<<<1024, 256, 0, stream>>>(out, accum);
#elif TEST_MODE == 3
        a.ph_lo = 0; a.ph_hi = 5; a.li = 0;
        hipLaunchKernelGGL(mk_fwd, dim3(grid), dim3(NWAVES * 64), LDS_BYTES, stream, a);
        float* accum = (float*)(mws + WS_CTL + 512 * 1024);
        const bf16* MB = (const bf16*)(mws + WS_MIX);
        k_cmp<<<(unsigned)(((size_t)MP * 512 + 255) / 256), 256, 0, stream>>>(MB, 1, 1024, MIX, 1024, MP, 512, 1.f, 0, accum + 0);
        k_cmp<<<(unsigned)(((size_t)MP * 512 + 255) / 256), 256, 0, stream>>>(MB + 512, 1, 1024, MIX + 512, 1024, MP, 512, 1.f, 0, accum + 2);
        k_cmp<<<(DECB * 512 + 255) / 256, 256, 0, stream>>>(MB + (size_t)MP * 1024, 1, 1024, MIX + (size_t)MP * 1024, 1024, DECB, 512, 1.f, 0, accum + 4);
        k_cmp<<<(DECB * 512 + 255) / 256, 256, 0, stream>>>(MB + (size_t)MP * 1024 + 512, 1, 1024, MIX + (size_t)MP * 1024 + 512, 1024, DECB, 512, 1.f, 0, accum + 6);
        k_cmp_sel<<<MP, 256, 0, stream>>>(SEL, NSEL, (const unsigned*)(mws + WS_DBG_BM), accum + 8);
        k_set<<<1, 1, 0, stream>>>(accum + 32, P3_TOL0, P3_TOL1, P3_TOL2, P3_TOL3, P3_TOL4);
        k_cmp_fin2<<<1, 1, 0, stream>>>(accum, 5, 1e-5f);
        k_perturb<<<1024, 256, 0, stream>>>(out, accum);
#elif TEST_MODE == 2
        a.ph_lo = 0; a.ph_hi = 3; a.li = 0;
        hipLaunchKernelGGL(mk_fwd, dim3(grid), dim3(NWAVES * 64), LDS_BYTES, stream, a);
        k_f32_to_bf16<<<2048, 256, 0, stream>>>(MIX, (bf16*)(mws + WS_MIX), (size_t)MT * 1024);
        a.ph_lo = 4; a.ph_hi = 5; a.li = 1;
        hipLaunchKernelGGL(mk_fwd, dim3(grid), dim3(NWAVES * 64), LDS_BYTES, stream, a);
#endif
    }
#else
    a.ph_lo = 0; a.ph_hi = 5; a.li = 0;
    hipLaunchKernelGGL(mk_fwd, dim3(grid), dim3(NWAVES * 64), LDS_BYTES, stream, a);
#endif
}
```

```cpp
#define TEST_MODE 0
#define HAVE_P3 1
#define REP_S1 1
#define REP_S2 1
#define REP_S4 1
#define REP_P0 1
#define REP_P1 1
#define REP_P4S 1
#define STATSEL 0
#define STAMP_BLK 0
#define P3FINE 0
#define TS0 0
#define TS1 1
#define P3_TOL0 1e-2f
#define P3_TOL1 1e-4f
#define P3_TOL2 1e-2f
#define P3_TOL3 1e-4f
#define P3_TOL4 3e-2f
#include <hip/hip_runtime.h>
#include <cstdio>
#include <cstdint>

constexpr int DM = 1024, NB = 8, SEQ = 2048, DECB = 128, PAST = 2048, PAGE = 128, NPG = 16;
constexpr int NIN = 2888, MP = NB * SEQ, MT = MP + DECB, NR = NB + DECB;
constexpr int CQ = 0, CK = 512, CV = 640, CQI = 768, CKI = 1280, CWI = 1344, CGA = 1352, CU = 1864, CGP = 2376;
constexpr size_t O_YP = 0, O_YS = 16777216, O_KP = 16908288, O_VP = 19005440, O_KIP = 21102592, O_PP = 22151168,
                 O_KS = 22212608, O_VS = 22228992, O_KIS = 22245376, O_PS = 22253568, O_END = 23236608;
constexpr float C2 = 0.125f * 1.4426950408889634f;
constexpr float WI_SCALE = 0.04419417382415922f;
constexpr float EPS = 1e-6f;
constexpr size_t MiB = 1u << 20;
constexpr size_t WS_CTL = 0, CTL_ZERO_BYTES = 1 * MiB;
constexpr size_t WS_ADA = 1 * MiB, WS_WINT = 3 * MiB, WS_WOUTT = 9 * MiB, WS_WPOOLT = 11 * MiB, WS_HS = 12 * MiB, WS_HB = 24 * MiB,
                 WS_Q = 56 * MiB, WS_QI = 73 * MiB, WS_GA = 90 * MiB, WS_U = 107 * MiB, WS_GP = 124 * MiB, WS_KB = 141 * MiB, WS_VB = 146 * MiB,
                 WS_KI = 151 * MiB, WS_WI = 154 * MiB, WS_MIX = 155 * MiB, WS_DBG_BM = 188 * MiB, WS_MEGA_END = 192 * MiB;
namespace pg8 {
#define PG8_LAS __attribute__((address_space(3)))
typedef unsigned short bf16_t;
typedef short bf16x8 __attribute__((ext_vector_type(8)));
typedef float f32x4 __attribute__((ext_vector_type(4)));
typedef unsigned u32x4 __attribute__((ext_vector_type(4)));
constexpr int BM = 256, BK = 64, HALF = 128, HTB = HALF * BK * 2  , STAGE_BYTES = 8 * HTB, NXCD = 8, WGM = 8;

__host__ __device__ __forceinline__ int lds_byte(int r, int c) { const int st = (r >> 4) * 2 + (c >> 5), rr = r & 15, cc = c & 31, ob = rr * 64 + cc * 2; return st * 1024 + (ob ^ (((ob >> 9) & 1) << 5)); }
__host__ __device__ __forceinline__ void stage_rc(int b, int& R, int& C) { const int st = b / 1024, sb = b % 1024, swz = sb ^ (((sb >> 9) & 1) << 5); R = (st >> 1) * 16 + swz / 64; C = (st & 1) * 32 + (swz % 64) / 2; }
__host__ __device__ __forceinline__ int perm32(int rho) { const int n = rho >> 4, i = rho & 15; return 8 * (i >> 2) + 4 * n + (i & 3); }

struct Unit { int pm, pn; };
struct Gemm { const bf16_t* A; const bf16_t* Bt; int M, N, K; };

struct StaticOrder {
    int nM, nN, nwg, G, c;
    __host__ __device__ void init(int M, int N, int G_, int c_) { nM = M / BM; nN = N / BM; nwg = nM * nN; G = G_; c = c_; }
    __host__ __device__ bool next(int i, Unit& u) const {
        const long L = (long)i * G + c; if (L >= nwg) return false;
        int wgid = (int)L; { const int q = nwg / NXCD, r = nwg % NXCD, xcd = wgid % NXCD, off = wgid / NXCD; wgid = (xcd < r ? xcd * (q + 1) : r * (q + 1) + (xcd - r) * q) + off; }
        const int nig = WGM * nN, gid = wgid / nig, fm = gid * WGM, gsz = (nM - fm) < WGM ? (nM - fm) : WGM;
        u.pm = fm + ((wgid % nig) % gsz); u.pn = (wgid % nig) / gsz; return true;
    }
    __device__ __forceinline__ void a_ready(const Unit&) const {}
    __device__ __forceinline__ void done(const Unit&) const {}
};


typedef unsigned u32x4 __attribute__((ext_vector_type(4)));
__device__ __forceinline__ unsigned cvt_pk_bf16(float lo, float hi) { unsigned r; asm volatile("v_cvt_pk_bf16_f32 %0, %1, %2" : "=v"(r) : "v"(lo), "v"(hi)); return r; }
__device__ __forceinline__ void st_bf16x8(bf16_t* p, const f32x4 a, const f32x4 b) {
    u32x4 w; w.x = cvt_pk_bf16(a[0], a[1]); w.y = cvt_pk_bf16(a[2], a[3]); w.z = cvt_pk_bf16(b[0], b[1]); w.w = cvt_pk_bf16(b[2], b[3]); *(u32x4*)p = w; }
__device__ __forceinline__ float silu1(float x) { return x * __builtin_amdgcn_rcpf(1.0f + __builtin_amdgcn_exp2f(-1.4426950408889634f * x)); }
__device__ __forceinline__ f32x4 silu4(const f32x4 v) { f32x4 r; r[0] = silu1(v[0]); r[1] = silu1(v[1]); r[2] = silu1(v[2]); r[3] = silu1(v[3]); return r; }

struct EpiIn {
    static constexpr bool PERM = true, AFTER_DRAIN = false;
    unsigned char* ws; float* out; const float* qnw; const float* knw;
    __device__ __forceinline__ void operator()(const f32x4 (&acc)[2][2][4][2], const Unit& u, int wr, int wc, int fr, int fq) const {
        const int pn = u.pn;
        if (pn == 5 && wc >= 2) return;
        const int rowb = u.pm * 256 + wr * 64 + fr, dof = 8 * fq;
        if (pn <= 1 || (pn == 2 && wc < 2)) {
            const float* nwp = pn <= 1 ? qnw : knw; const float sc = pn <= 1 ? C2 : 1.0f;
            f32x4 wv[2][2];
#pragma unroll
            for (int bj = 0; bj < 2; ++bj)
#pragma unroll
                for (int n = 0; n < 2; ++n) wv[bj][n] = *(const f32x4*)(nwp + 32 * bj + dof + 4 * n) * sc;
#pragma unroll
            for (int ai = 0; ai < 2; ++ai)
#pragma unroll
                for (int m = 0; m < 4; ++m) { const size_t row = (size_t)(rowb + ai * 128 + m * 16); float ss = 0.f;
#pragma unroll
                    for (int bj = 0; bj < 2; ++bj)
#pragma unroll
                        for (int n = 0; n < 2; ++n) { const f32x4 x = acc[ai][bj][m][n]; ss += (x[0] * x[0] + x[1] * x[1]) + (x[2] * x[2] + x[3] * x[3]); }
                    ss += __shfl_xor(ss, 16); ss += __shfl_xor(ss, 32);
                    const float rstd = 1.0f / sqrtf(ss * (1.0f / 64.0f) + EPS);
                    f32x4 o[2][2];
#pragma unroll
                    for (int bj = 0; bj < 2; ++bj)
#pragma unroll
                        for (int n = 0; n < 2; ++n) o[bj][n] = acc[ai][bj][m][n] * rstd * wv[bj][n];
                    if (pn <= 1) { bf16_t* q = (bf16_t*)(ws + WS_Q) + row * 512 + (4 * pn + wc) * 64 + dof; st_bf16x8(q, o[0][0], o[0][1]); st_bf16x8(q + 32, o[1][0], o[1][1]); }
                    else { float* ko = out + O_KP + row * 128 + wc * 64 + dof; *(f32x4*)ko = o[0][0]; *(f32x4*)(ko + 4) = o[0][1]; *(f32x4*)(ko + 32) = o[1][0]; *(f32x4*)(ko + 36) = o[1][1];
                        bf16_t* kb = (bf16_t*)(ws + WS_KB) + row * 128 + wc * 64 + dof; st_bf16x8(kb, o[0][0], o[0][1]); st_bf16x8(kb + 32, o[1][0], o[1][1]); } }
            return;
        }
        if (pn == 5 && wc == 1) {
            if (fq == 0) {
#pragma unroll
                for (int ai = 0; ai < 2; ++ai)
#pragma unroll
                    for (int m = 0; m < 4; ++m) { const size_t row = (size_t)(rowb + ai * 128 + m * 16); float* wp = (float*)(ws + WS_WI) + row * 8;
                        *(f32x4*)wp = acc[ai][0][m][0] * WI_SCALE; *(f32x4*)(wp + 4) = acc[ai][0][m][1] * WI_SCALE; } }
            return;
        }
        bf16_t* dst; int ld, cb; float* fo = nullptr; int fld = 0; bool act = false;
        if (pn == 2) { dst = (bf16_t*)(ws + WS_VB); ld = 128; cb = (wc - 2) * 64; fo = out + O_VP + cb; fld = 128; }
        else if (pn <= 4) { dst = (bf16_t*)(ws + WS_QI); ld = 512; cb = (4 * (pn - 3) + wc) * 64; }
        else if (pn == 5) { dst = (bf16_t*)(ws + WS_KI); ld = 64; cb = 0; fo = out + O_KIP; fld = 64; }
        else if (pn <= 7) { dst = (bf16_t*)(ws + WS_GA); ld = 512; cb = (4 * (pn - 6) + wc) * 64; act = true; }
        else if (pn <= 9) { dst = (bf16_t*)(ws + WS_U); ld = 512; cb = (4 * (pn - 8) + wc) * 64; }
        else { dst = (bf16_t*)(ws + WS_GP); ld = 512; cb = (4 * (pn - 10) + wc) * 64; act = true; }
        const bool is_u = (pn == 8 || pn == 9);
#pragma unroll
        for (int ai = 0; ai < 2; ++ai)
#pragma unroll
            for (int m = 0; m < 4; ++m) { const int rowi = rowb + ai * 128 + m * 16; const size_t row = (size_t)rowi;
                f32x4 o00 = acc[ai][0][m][0], o01 = acc[ai][0][m][1], o10 = acc[ai][1][m][0], o11 = acc[ai][1][m][1];
                if (act) { o00 = silu4(o00); o01 = silu4(o01); o10 = silu4(o10); o11 = silu4(o11); }
                bf16_t* d = dst + row * ld + cb + dof; st_bf16x8(d, o00, o01); st_bf16x8(d + 32, o10, o11);
                if (fo) { float* f = fo + row * fld + dof; *(f32x4*)f = o00; *(f32x4*)(f + 4) = o01; *(f32x4*)(f + 32) = o10; *(f32x4*)(f + 36) = o11; }
                if (is_u) { const int t = rowi & (SEQ - 1);
                    if (t >= SEQ - 15) { float* f = out + O_PP + ((size_t)(rowi >> 11) * 15 + (t - (SEQ - 15))) * 512 + cb + dof;
                        *(f32x4*)f = o00; *(f32x4*)(f + 4) = o01; *(f32x4*)(f + 32) = o10; *(f32x4*)(f + 36) = o11; } } }
    }
};
struct EpiOut {
    static constexpr bool PERM = true, AFTER_DRAIN = false;
    const float* x; float* y; const float* ada;
    __device__ __forceinline__ void operator()(const f32x4 (&acc)[2][2][4][2], const Unit& u, int wr, int wc, int fr, int fq) const {
        const int col0 = u.pn * 256 + wc * 32 + 8 * fq; const float* gp = ada + (size_t)(u.pm >> 3) * 3072 + 2048 + col0;
        f32x4 g[2][2];
#pragma unroll
        for (int bj = 0; bj < 2; ++bj)
#pragma unroll
            for (int n = 0; n < 2; ++n) g[bj][n] = *(const f32x4*)(gp + 128 * bj + 4 * n);
#pragma unroll
        for (int ai = 0; ai < 2; ++ai)
#pragma unroll
            for (int m = 0; m < 4; ++m) { const size_t off = (size_t)(u.pm * 256 + ai * 128 + wr * 64 + m * 16 + fr) * 1024 + col0;
#pragma unroll
                for (int bj = 0; bj < 2; ++bj)
#pragma unroll
                    for (int n = 0; n < 2; ++n) { const f32x4 xv = *(const f32x4*)(x + off + 128 * bj + 4 * n); *(f32x4*)(y + off + 128 * bj + 4 * n) = xv + g[bj][n] * acc[ai][bj][m][n]; } }
    }
};
template <class Epi, class Sched, bool ALIGN_EPI = false, bool SP2 = false>
__device__ __forceinline__ void gemm_phase(PG8_LAS unsigned char* lds, const Gemm g, const Sched& S, const Epi& E) {
    const int tid = threadIdx.x, wid = __builtin_amdgcn_readfirstlane(tid >> 6), lane = tid & 63, wr = wid >> 2, wc = wid & 3, fr = lane & 15, fq = lane >> 4;
    const int K = g.K, nt = K / BK;
    unsigned voffA[2], voffB[2];
#pragma unroll
    for (int i = 0; i < 2; ++i) { int R, C; stage_rc(tid * 16 + i * 8192, R, C); const int Rb = Epi::PERM ? ((R & ~31) + perm32(R & 31)) : R;
        voffA[i] = (unsigned)(R * K + C) * 2u; voffB[i] = (unsigned)(Rb * K + C) * 2u; }
    const size_t kstep = (size_t)(BK * 2);
    const size_t hstep = (size_t)HALF * K * 2;
    const size_t tstep = 2 * hstep;
    const unsigned ldsw = (unsigned)wid * 1024u;
    const int aoff = lds_byte(wr * 64 + fr, fq * 8), boff = lds_byte(wc * 32 + fr, fq * 8);
#define PG8_SA(b, h) (((b) * 2 + (h)) * HTB)
#define PG8_SB(b, h) ((4 + (b) * 2 + (h)) * HTB)
#define PG8_STAGE(bufoff, gbase, voff) do { _Pragma("unroll") for (int _i = 0; _i < 2; ++_i) \
        __builtin_amdgcn_global_load_lds((const unsigned*)((const char*)(gbase) + (voff)[_i]), (PG8_LAS unsigned*)(lds + (bufoff) + ldsw + _i * 8192), 16, 0, 0); } while (0)
#define PG8_LDA(dst, b, h) do { _Pragma("unroll") for (int m = 0; m < 4; ++m) _Pragma("unroll") for (int k = 0; k < 2; ++k) dst[m][k] = *(const PG8_LAS bf16x8*)(lds + PG8_SA(b, h) + aoff + m * 2048 + k * 1024); } while (0)
#define PG8_LDB(dst, b, h) do { _Pragma("unroll") for (int n = 0; n < 2; ++n) _Pragma("unroll") for (int k = 0; k < 2; ++k) dst[n][k] = *(const PG8_LAS bf16x8*)(lds + PG8_SB(b, h) + boff + n * 2048 + k * 1024); } while (0)
#define PG8_MMA(ai, bj, At, Bt) do { __builtin_amdgcn_s_setprio(1); _Pragma("unroll") for (int m = 0; m < 4; ++m) _Pragma("unroll") for (int n = 0; n < 2; ++n) _Pragma("unroll") for (int k = 0; k < 2; ++k) \
        acc[ai][bj][m][n] = __builtin_amdgcn_mfma_f32_16x16x32_bf16(Bt[n][k], At[m][k], acc[ai][bj][m][n], 0, 0, 0); __builtin_amdgcn_s_setprio(0); } while (0)
#define PG8_WAIT_V(n) asm volatile("s_waitcnt vmcnt(" #n ")" ::: "memory")
#define PG8_WAIT_L(n) asm volatile("s_waitcnt lgkmcnt(" #n ")" ::: "memory")
#define PG8_BAR __builtin_amdgcn_s_barrier()
#define PG8_SCHED __builtin_amdgcn_sched_barrier(0)
    Unit cur, nxt; int ui = 0;
    if (!S.next(0, cur)) return;
    f32x4 acc[2][2][4][2];
#pragma unroll
    for (int a = 0; a < 2; ++a)
#pragma unroll
        for (int b = 0; b < 2; ++b)
#pragma unroll
            for (int m = 0; m < 4; ++m)
#pragma unroll
                for (int n = 0; n < 2; ++n) acc[a][b][m][n] = (f32x4){0.f, 0.f, 0.f, 0.f};
    bf16x8 At[4][2], B0[2][2], B1[2][2];
    const char* cA = (const char*)g.A + (size_t)cur.pm * tstep; const char* cB = (const char*)g.Bt + (size_t)cur.pn * tstep;
    S.a_ready(cur);
    if constexpr (SP2) {
        PG8_STAGE(PG8_SB(0, 0), cB, voffB); PG8_STAGE(PG8_SB(0, 1), cB + hstep, voffB); PG8_STAGE(PG8_SA(0, 0), cA, voffA); PG8_STAGE(PG8_SA(0, 1), cA + hstep, voffA);
        if (wr == 1) PG8_BAR;
        PG8_WAIT_V(2); PG8_BAR;
        PG8_STAGE(PG8_SB(1, 0), cB + kstep, voffB); PG8_STAGE(PG8_SA(1, 0), cA + kstep, voffA); PG8_STAGE(PG8_SB(1, 1), cB + hstep + kstep, voffB);
        PG8_WAIT_V(6); PG8_BAR;
    } else {
        PG8_STAGE(PG8_SB(0, 0), cB, voffB); PG8_STAGE(PG8_SA(0, 0), cA, voffA); PG8_STAGE(PG8_SB(0, 1), cB + hstep, voffB); PG8_STAGE(PG8_SA(0, 1), cA + hstep, voffA);
        if (wr == 1) PG8_BAR;
        PG8_WAIT_V(4); PG8_BAR;
        PG8_STAGE(PG8_SB(1, 0), cB + kstep, voffB); PG8_STAGE(PG8_SA(1, 0), cA + kstep, voffA); PG8_STAGE(PG8_SB(1, 1), cB + hstep + kstep, voffB);
        PG8_WAIT_V(6); PG8_BAR;
    }
    for (;;) {
        const bool has_next = S.next(ui + 1, nxt);
        const char* nA = has_next ? (const char*)g.A + (size_t)nxt.pm * tstep : cA; const char* nB = has_next ? (const char*)g.Bt + (size_t)nxt.pn * tstep : cB;
        for (int t = 0; t < nt; t += 2) {
            const bool last = (t == nt - 2);
            const char* a1 = cA + (size_t)(t + 1) * kstep;
            const char* a2 = last ? nA : cA + (size_t)(t + 2) * kstep; const char* b2 = last ? nB : cB + (size_t)(t + 2) * kstep;
            const char* a3 = a2 + kstep; const char* b3 = b2 + kstep;
            if (last && has_next) S.a_ready(nxt);
            if constexpr (SP2) {
            PG8_LDB(B0, 0, 0); PG8_LDB(B1, 0, 1); PG8_SCHED; PG8_LDA(At, 0, 0); PG8_STAGE(PG8_SA(1, 1), a1 + hstep, voffA);
            PG8_WAIT_V(8); PG8_WAIT_L(0); PG8_BAR; PG8_MMA(0, 0, At, B0); PG8_MMA(0, 1, At, B1); PG8_BAR; PG8_SCHED;
            PG8_LDA(At, 0, 1); PG8_STAGE(PG8_SB(0, 0), b2, voffB); PG8_STAGE(PG8_SB(0, 1), b2 + hstep, voffB); PG8_STAGE(PG8_SA(0, 0), a2, voffA);
            PG8_WAIT_V(8); PG8_WAIT_L(0); PG8_BAR; PG8_MMA(1, 0, At, B0); PG8_MMA(1, 1, At, B1); PG8_BAR; PG8_SCHED;
            PG8_LDB(B0, 1, 0); PG8_LDB(B1, 1, 1); PG8_SCHED; PG8_LDA(At, 1, 0); PG8_STAGE(PG8_SA(0, 1), a2 + hstep, voffA);
            PG8_WAIT_V(8); PG8_WAIT_L(0); PG8_BAR; PG8_MMA(0, 0, At, B0); PG8_MMA(0, 1, At, B1); PG8_BAR; PG8_SCHED;
            PG8_LDA(At, 1, 1); PG8_STAGE(PG8_SB(1, 0), b3, voffB); PG8_STAGE(PG8_SB(1, 1), b3 + hstep, voffB); PG8_STAGE(PG8_SA(1, 0), a3, voffA);
            PG8_WAIT_V(8); PG8_WAIT_L(0); PG8_BAR; PG8_MMA(1, 0, At, B0); PG8_MMA(1, 1, At, B1); PG8_BAR; PG8_SCHED;
            } else {
            PG8_LDB(B0, 0, 0); PG8_SCHED; PG8_LDA(At, 0, 0); PG8_STAGE(PG8_SA(1, 1), a1 + hstep, voffA);
            PG8_WAIT_L(8); PG8_BAR; PG8_WAIT_L(0); PG8_MMA(0, 0, At, B0); PG8_BAR; PG8_SCHED;
            PG8_LDB(B1, 0, 1); PG8_STAGE(PG8_SB(0, 0), b2, voffB);
            PG8_BAR; PG8_WAIT_L(0); PG8_MMA(0, 1, At, B1); PG8_BAR;
            PG8_LDA(At, 0, 1); PG8_STAGE(PG8_SA(0, 0), a2, voffA);
            PG8_BAR; PG8_WAIT_L(0); PG8_MMA(1, 0, At, B0); PG8_BAR; PG8_SCHED;
            PG8_STAGE(PG8_SB(0, 1), b2 + hstep, voffB);
            PG8_WAIT_V(6); PG8_BAR; PG8_MMA(1, 1, At, B1); PG8_BAR;
            PG8_LDB(B0, 1, 0); PG8_SCHED; PG8_LDA(At, 1, 0); PG8_STAGE(PG8_SA(0, 1), a2 + hstep, voffA);
            PG8_WAIT_L(8); PG8_BAR; PG8_WAIT_L(0); PG8_MMA(0, 0, At, B0); PG8_BAR; PG8_SCHED;
            PG8_LDB(B1, 1, 1); PG8_STAGE(PG8_SB(1, 0), b3, voffB);
            PG8_BAR; PG8_WAIT_L(0); PG8_MMA(0, 1, At, B1); PG8_BAR;
            PG8_LDA(At, 1, 1); PG8_STAGE(PG8_SA(1, 0), a3, voffA);
            PG8_BAR; PG8_WAIT_L(0); PG8_MMA(1, 0, At, B0); PG8_BAR; PG8_SCHED;
            PG8_STAGE(PG8_SB(1, 1), b3 + hstep, voffB);
            PG8_WAIT_V(6); PG8_BAR; PG8_MMA(1, 1, At, B1); PG8_BAR;
            }
        }
        if constexpr (ALIGN_EPI) { if (wr == 0) PG8_BAR; }
        if constexpr (!Epi::AFTER_DRAIN) { E(acc, cur, wr, wc, fr, fq); S.done(cur); }
        if (!has_next) break;
#pragma unroll
        for (int a = 0; a < 2; ++a)
#pragma unroll
            for (int b = 0; b < 2; ++b)
#pragma unroll
                for (int m = 0; m < 4; ++m)
#pragma unroll
                    for (int n = 0; n < 2; ++n) acc[a][b][m][n] = (f32x4){0.f, 0.f, 0.f, 0.f};
        cur = nxt; cA = nA; cB = nB; ++ui;
        if constexpr (ALIGN_EPI) { if (wr == 1) PG8_BAR; }
    }
    PG8_WAIT_V(0);
    if constexpr (!ALIGN_EPI) { if (wr == 0) PG8_BAR; }
    PG8_BAR;
    if constexpr (Epi::AFTER_DRAIN) { E.fused(acc, cur, wr, wc, fr, fq, lds, wid, lane); S.done(cur); }
#undef PG8_SA
#undef PG8_SB
#undef PG8_STAGE
#undef PG8_LDA
#undef PG8_LDB
#undef PG8_MMA
#undef PG8_WAIT_V
#undef PG8_WAIT_L
#undef PG8_BAR
#undef PG8_SCHED
}
}

constexpr int NWAVES = 8;
constexpr int RING_OFF = 0, RING_BYTES = 131072;
constexpr int LDSCTL_OFF = RING_BYTES, MISC_OFF = LDSCTL_OFF + 320;
constexpr int LDS_BYTES = 147456;
constexpr int CW_BAR = 4096;
#define GAS __attribute__((address_space(1)))
#define LAS __attribute__((address_space(3)))
typedef unsigned short bf16;
typedef unsigned v4u __attribute__((ext_vector_type(4)));
typedef unsigned v2u __attribute__((ext_vector_type(2)));
typedef float f32x4 __attribute__((ext_vector_type(4)));
typedef float f32x16 __attribute__((ext_vector_type(16)));
typedef short bf16x8 __attribute__((ext_vector_type(8)));
typedef GAS unsigned gu32;
#define LDS_WAIT() asm volatile("s_waitcnt lgkmcnt(0)" ::: "memory")
#define VM_WAIT() asm volatile("s_waitcnt vmcnt(0)" ::: "memory")
__device__ __forceinline__ unsigned f2bf(float f) { unsigned u = __builtin_bit_cast(unsigned, f); return (u + 0x7fffu + ((u >> 16) & 1u)) >> 16; }
__device__ __forceinline__ unsigned pk2(float lo, float hi) { return pg8::cvt_pk_bf16(lo, hi); }
__device__ __forceinline__ float bf2f(unsigned short b) { return __builtin_bit_cast(float, (unsigned)b << 16); }
__device__ __forceinline__ float wave_sum(float v) {
#pragma unroll
    for (int o = 1; o < 64; o <<= 1) v += __shfl_xor(v, o);
    return v;
}
__device__ __forceinline__ float wave_max(float v) {
#pragma unroll
    for (int o = 1; o < 64; o <<= 1) v = fmaxf(v, __shfl_xor(v, o));
    return v;
}
#define XB_TMO      128
#define XB_XCNT(j)  (256  + 64 * (j))
#define XB_XSUB(j)  (1280 + 64 * (j))
#define XB_XGEN(j)  (2304 + 64 * (j))
#define XB_TOP      3328
#define XB_TOPGEN   3392
#define XCD_BAR_WORDS 3456
#define XB_SPIN_CAP (1u << 18)

__device__ __forceinline__ unsigned xb_ld(unsigned* p)              { return __hip_atomic_load(p, __ATOMIC_RELAXED, __HIP_MEMORY_SCOPE_AGENT); }
__device__ __forceinline__ unsigned xb_add(unsigned* p, unsigned v) { return __hip_atomic_fetch_add(p, v, __ATOMIC_RELAXED, __HIP_MEMORY_SCOPE_AGENT); }
__device__ __forceinline__ unsigned xb_xcc_id() { return (unsigned)__builtin_amdgcn_s_getreg((3 << 11) | 20) & 0xFu; }
#define XB_SPIN(cond, bar) do { unsigned _sp = 0; while (cond) { __builtin_amdgcn_s_sleep(1); \
    if ((++_sp & 255u) == 0u) { if (xb_ld(&(bar)[XB_TMO])) break; if (_sp > XB_SPIN_CAP) { atomicAdd(&(bar)[XB_TMO], 1u); break; } } } } while (0)

struct XcdBarrier {
    unsigned* bar; unsigned x;
    volatile LAS unsigned* st;
};

__device__ __forceinline__ XcdBarrier xcd_barrier_post(unsigned* bar, volatile LAS unsigned* st) {
    XcdBarrier b; b.bar = bar; b.x = xb_xcc_id(); b.st = st;
    if (threadIdx.x == 0) (void)xb_add(&bar[XB_XCNT(b.x)], 1u);
    return b;
}
__device__ __forceinline__ void xcd_barrier_complete(unsigned* bar, unsigned x, unsigned& nloc, unsigned& nx) {
    const unsigned G = gridDim.x * gridDim.y * gridDim.z;
    unsigned sum, cnt, mine, sp = 0u;
    for (;;) {
        sum = 0u; cnt = 0u; mine = 0u;
#pragma unroll
        for (unsigned j = 0; j < 16; ++j) { const unsigned c = xb_ld(&bar[XB_XCNT(j)]); sum += c; cnt += (c > 0u) ? 1u : 0u; mine = (j == x) ? c : mine; }
        if (sum == G) break;
        __builtin_amdgcn_s_sleep(1);
        if ((++sp & 255u) == 0u) { if (xb_ld(&bar[XB_TMO])) break; if (sp > XB_SPIN_CAP) { atomicAdd(&bar[XB_TMO], 1u); break; } }
    }
    nloc = mine > 0u ? mine : 1u; nx = cnt > 0u ? cnt : 1u;
}

__device__ __forceinline__ void xcd_barrier(const XcdBarrier& b) {
    asm volatile("s_waitcnt vmcnt(0)" ::: "memory");
    __syncthreads();
    if (threadIdx.x == 0) {
        unsigned* bar = b.bar;
        __builtin_amdgcn_s_waitcnt(0);
        unsigned nloc = b.st[0], nx = b.st[1];
        if (nloc == 0u) { xcd_barrier_complete(bar, b.x, nloc, nx); b.st[0] = nloc; b.st[1] = nx; }
        const unsigned old = xb_add(&bar[XB_XSUB(b.x)], 1u);
        const unsigned gen = old / nloc;
        if (old + 1u == (gen + 1u) * nloc) {
            __builtin_amdgcn_fence(__ATOMIC_RELEASE, "agent");
            asm volatile("s_waitcnt vmcnt(0)" ::: "memory");
            const unsigned og = xb_add(&bar[XB_TOP], 1u);
            const unsigned tg = og / nx;
            if (og + 1u == (tg + 1u) * nx) xb_add(&bar[XB_TOPGEN], 1u);
            else XB_SPIN(xb_ld(&bar[XB_TOPGEN]) == tg, bar);
            __builtin_amdgcn_fence(__ATOMIC_ACQUIRE, "agent");
            xb_add(&bar[XB_XGEN(b.x)], 1u);
            asm volatile("s_waitcnt vmcnt(0)" ::: "memory");
        } else {
            XB_SPIN(xb_ld(&bar[XB_XGEN(b.x)]) == gen, bar);
            __builtin_amdgcn_fence(__ATOMIC_ACQUIRE, "agent");
            asm volatile("s_waitcnt vmcnt(0)" ::: "memory");
        }
    }
    __syncthreads();
}

struct Frame {
    LAS unsigned char* lds; volatile LAS unsigned* MISC; gu32* ctl;
    int tid, lane, wave, vcu, G, bid;
    const float *xp, *xs, *cache_k, *cache_v, *cache_kidx, *state_pool; const int* page_table;
    const float *cp, *cs, *norm_w, *w_ada, *b_ada, *w_in, *qnw, *knw, *w_pool, *pool_scale, *w_out;
    float* out; unsigned char* ws;
#if TEST_MODE == 4 && P3FINE
    unsigned long long* ts; int nst;
#endif
};
#if TEST_MODE == 4 && P3FINE
#define FSTAMP() do { if (blockIdx.x == STAMP_BLK && threadIdx.x == 0) F.ts[F.nst] = __builtin_amdgcn_s_memrealtime(); ++F.nst; } while (0)
#else
#define FSTAMP() do { } while (0)
#endif

__device__ __forceinline__ void p0_ada(Frame& F, int task) {
    const int lane = F.lane, w = F.wave, rl = lane & 15, kq = lane >> 4, n0 = task * 16;
    float bv[32];
    { const float* wp = F.w_ada + (size_t)(w * 128 + 4 * kq) * 3072 + n0 + rl;
#pragma unroll
      for (int i4 = 0; i4 < 8; ++i4)
#pragma unroll
          for (int u = 0; u < 4; ++u) bv[i4 * 4 + u] = wp[(size_t)(16 * i4 + u) * 3072]; }
    f32x4 acc[9];
#pragma unroll
    for (int i3 = 0; i3 < 3; ++i3) {
        f32x4 cv[3][8]; bool valid[3];
#pragma unroll
        for (int ii = 0; ii < 3; ++ii) { const int row = 16 * (3 * i3 + ii) + rl; valid[ii] = row < NR;
            const float* cptr = (row < NB ? F.cp + (size_t)row * DM : F.cs + (size_t)((valid[ii] ? row : NB) - NB) * DM) + w * 128 + 4 * kq;
#pragma unroll
            for (int i4 = 0; i4 < 8; ++i4) cv[ii][i4] = *(const f32x4*)(cptr + 16 * i4); }
#pragma unroll
        for (int ii = 0; ii < 3; ++ii) { const int i = 3 * i3 + ii;
            acc[i] = (f32x4){0.f, 0.f, 0.f, 0.f};
#pragma unroll
            for (int i4 = 0; i4 < 8; ++i4)
#pragma unroll
                for (int u = 0; u < 4; ++u) { const float a = valid[ii] ? pg8::silu1(cv[ii][i4][u]) : 0.f; acc[i] = __builtin_amdgcn_mfma_f32_16x16x4f32(a, bv[i4 * 4 + u], acc[i], 0, 0, 0); } } }
    LAS float* red = (LAS float*)(F.lds + RING_OFF);
#pragma unroll
    for (int i = 0; i < 9; ++i)
#pragma unroll
        for (int e = 0; e < 4; ++e) red[(w * 144 + 16 * i + 4 * kq + e) * 16 + rl] = acc[i][e];
    __syncthreads();
    float* ada = (float*)(F.ws + WS_ADA);
    for (int o = F.tid; o < NR * 16; o += NWAVES * 64) { const int row = o >> 4, col = o & 15; float s = F.b_ada[n0 + col];
#pragma unroll
        for (int ww = 0; ww < 8; ++ww) s += red[(ww * 144 + row) * 16 + col];
        ada[(size_t)row * 3072 + n0 + col] = s; }
    __syncthreads();
}
__device__ __forceinline__ void transpose_item(const float* W, int ldn, int srccol0, int nvalid, bf16* WT, int K, int dstrow0, int k0, LAS float* scr, int lane) {
    float tv[32];
#pragma unroll
    for (int i = 0; i < 32; ++i) { const int kk = 2 * i + (lane >> 5), c = lane & 31; tv[i] = c < nvalid ? W[(size_t)(k0 + kk) * ldn + srccol0 + c] : 0.f; }
#pragma unroll
    for (int i = 0; i < 32; ++i) { const int kk = 2 * i + (lane >> 5), c = lane & 31; scr[kk * 33 + c] = tv[i]; }
    LDS_WAIT(); asm volatile("" ::: "memory");
    const int c = lane & 7;
#pragma unroll
    for (int j = 0; j < 4; ++j) { const int n = (lane >> 3) + 8 * j; const LAS float* s = scr + (8 * c) * 33 + n;
        v4u o; o.x = pk2(s[0 * 33], s[1 * 33]); o.y = pk2(s[2 * 33], s[3 * 33]); o.z = pk2(s[4 * 33], s[5 * 33]); o.w = pk2(s[6 * 33], s[7 * 33]);
        *(GAS v4u*)(WT + (size_t)(dstrow0 + n) * K + k0 + 8 * c) = o; }
    LDS_WAIT(); asm volatile("" ::: "memory");
}
__device__ __forceinline__ int win_col(int pn, int hd, int d) {
    if (pn <= 1) return CQ + (4 * pn + hd) * 64 + d;
    if (pn == 2) return hd < 2 ? CK + hd * 64 + d : CV + (hd - 2) * 64 + d;
    if (pn <= 4) return CQI + (4 * (pn - 3) + hd) * 64 + d;
    if (pn == 5) return hd == 0 ? CKI + d : ((hd == 1 && d < 8) ? CWI + d : -1);
    if (pn <= 7) return CGA + (4 * (pn - 6) + hd) * 64 + d;
    if (pn <= 9) return CU + (4 * (pn - 8) + hd) * 64 + d;
    return CGP + (4 * (pn - 10) + hd) * 64 + d;
}
__device__ __forceinline__ void p0_prologue(Frame& F) {
    if (F.bid < 192) p0_ada(F, F.bid);
    LAS float* scr = (LAS float*)(F.lds + RING_OFF + F.wave * 16384);
    const int gw = F.vcu * NWAVES + F.wave, NGW = F.G * NWAVES;
    bf16* WINT = (bf16*)(F.ws + WS_WINT); bf16* WOUTT = (bf16*)(F.ws + WS_WOUTT); bf16* WPOOLT = (bf16*)(F.ws + WS_WPOOLT);
    for (int it = gw; it < 2080; it += NGW) {
        if (it < 1536) { const int G = it >> 4, kb = it & 15, pn = G >> 3, bj = (G >> 2) & 1, hd = G & 3; const int src = win_col(pn, hd, 32 * bj);
            const int nvalid = src < 0 ? 0 : ((pn == 5 && hd == 1) ? 8 : 32);
            transpose_item(F.w_in, NIN, src < 0 ? 0 : src, nvalid, WINT, 1024, 32 * G, 64 * kb, scr, F.lane); }
        else if (it < 2048) { const int r = it - 1536, G = r >> 4, kb = r & 15; transpose_item(F.w_out, 1024, 32 * G, 32, WOUTT, 1024, 32 * G, 64 * kb, scr, F.lane); }
        else { const int r = it - 2048, g = r >> 3, kb = (r >> 2) & 1, G = r & 3; transpose_item(F.w_pool + (size_t)g * 16384, 128, 32 * G, 32, WPOOLT + (size_t)g * 16384, 128, 32 * G, 64 * kb, scr, F.lane); }
    }
    { const int nf4 = DECB * 1792; f32x4 t4[2]; int ix[2];
#pragma unroll
      for (int k = 0; k < 2; ++k) { ix[k] = gw * 64 + F.lane + k * NGW * 64; if (ix[k] < nf4) { const int s = ix[k] / 1792, i = ix[k] - s * 1792; t4[k] = *(const f32x4*)(F.state_pool + (size_t)s * 7680 + 512 + 4 * i); } }
#pragma unroll
      for (int k = 0; k < 2; ++k) { if (ix[k] < nf4) { const int s = ix[k] / 1792, i = ix[k] - s * 1792; *(f32x4*)(F.out + O_PS + (size_t)s * 7680 + 4 * i) = t4[k]; } }
      for (int ixx = gw * 64 + F.lane + 2 * NGW * 64; ixx < nf4; ixx += NGW * 64) { const int s = ixx / 1792, i = ixx - s * 1792; *(f32x4*)(F.out + O_PS + (size_t)s * 7680 + 4 * i) = *(const f32x4*)(F.state_pool + (size_t)s * 7680 + 512 + 4 * i); } }
}

template <int N, bool SAME_ADA> __device__ __forceinline__ void norm_rows(Frame& F, const float* x0, const float* adarow0, int adastride, bf16* o0) {
    f32x4 v[N][4]; float s2[N];
#pragma unroll
    for (int i = 0; i < N; ++i) { const GAS f32x4* xr = (const GAS f32x4*)(x0 + (size_t)i * DM) + F.lane;
#pragma unroll
        for (int j = 0; j < 4; ++j) v[i][j] = xr[64 * j]; }
#pragma unroll
    for (int i = 0; i < N; ++i) { s2[i] = 0.f;
#pragma unroll
        for (int j = 0; j < 4; ++j) s2[i] += (v[i][j].x * v[i][j].x + v[i][j].y * v[i][j].y) + (v[i][j].z * v[i][j].z + v[i][j].w * v[i][j].w); }
#pragma unroll
    for (int o = 1; o < 64; o <<= 1) {
#pragma unroll
        for (int i = 0; i < N; ++i) s2[i] += __shfl_xor(s2[i], o); }
#pragma unroll
    for (int j = 0; j < 4; ++j) { const int col = 4 * F.lane + 256 * j; const f32x4 nw = *(const f32x4*)(F.norm_w + col);
        f32x4 gq, sh;
        if (SAME_ADA) { sh = *(const f32x4*)(adarow0 + col); gq = nw * (*(const f32x4*)(adarow0 + 1024 + col) + 1.0f); }
#pragma unroll
        for (int i = 0; i < N; ++i) {
            if (!SAME_ADA) { const float* ar = adarow0 + (size_t)i * adastride; sh = *(const f32x4*)(ar + col); gq = nw * (*(const f32x4*)(ar + 1024 + col) + 1.0f); }
            const float rstd = 1.0f / sqrtf(s2[i] * (1.0f / DM) + EPS);
            const f32x4 o = v[i][j] * rstd * gq + sh;
            ((GAS unsigned long long*)(o0 + (size_t)i * DM))[F.lane + 64 * j] = (unsigned long long)pk2(o.x, o.y) | ((unsigned long long)pk2(o.z, o.w) << 32); } }
}
__device__ __forceinline__ void skinny_core(const bf16* arow, const bf16* b0, const bf16* b1, const bf16* b2, const bf16* b3, f32x4 (&acc)[4]) {
#pragma unroll
    for (int j = 0; j < 4; ++j) acc[j] = (f32x4){0.f, 0.f, 0.f, 0.f};
    bf16x8 fa[2][4], fb[2][4][4];
#define SK_LOAD(buf, kb) do { _Pragma("unroll") for (int q_ = 0; q_ < 4; ++q_) { const int ko_ = 32 * (4 * (kb) + q_); fa[buf][q_] = *(const bf16x8*)(arow + ko_); \
        fb[buf][q_][0] = *(const bf16x8*)(b0 + ko_); fb[buf][q_][1] = *(const bf16x8*)(b1 + ko_); fb[buf][q_][2] = *(const bf16x8*)(b2 + ko_); fb[buf][q_][3] = *(const bf16x8*)(b3 + ko_); } } while (0)
#define SK_MMA(buf) do { _Pragma("unroll") for (int q_ = 0; q_ < 4; ++q_) { _Pragma("unroll") for (int j_ = 0; j_ < 4; ++j_) acc[j_] = __builtin_amdgcn_mfma_f32_16x16x32_bf16(fa[buf][q_], fb[buf][q_][j_], acc[j_], 0, 0, 0); } } while (0)
    SK_LOAD(0, 0);
#pragma unroll
    for (int kb = 0; kb < 8; kb += 2) {
        SK_LOAD(1, kb + 1); SK_MMA(0);
        if (kb + 2 < 8) SK_LOAD(0, kb + 2);
        SK_MMA(1);
    }
#undef SK_LOAD
#undef SK_MMA
}
__device__ __forceinline__ void sample_inproj(Frame& F, int pn, int hd) {
    const int lane = F.lane, w = F.wave, rl = lane & 15, kq = lane >> 4;
    const bf16* HS = (const bf16*)(F.ws + WS_HS);
    const bf16* WINT = (const bf16*)(F.ws + WS_WINT);
    const bf16* bb = WINT + (size_t)(256 * pn + 32 * hd + rl) * 1024 + 8 * kq;
    f32x4 acc[4];
    skinny_core(HS + (size_t)(16 * w + rl) * 1024 + 8 * kq, bb, bb + 16 * 1024, bb + 128 * 1024, bb + 144 * 1024, acc);
    float* out = F.out;
    if (pn <= 1 || (pn == 2 && hd < 2)) {
        const float* nwp = pn <= 1 ? F.qnw : F.knw; const float sc = pn <= 1 ? C2 : 1.0f;
#pragma unroll
        for (int e = 0; e < 4; ++e) { float ss = 0.f;
#pragma unroll
            for (int j = 0; j < 4; ++j) ss += acc[j][e] * acc[j][e];
            ss += __shfl_xor(ss, 1); ss += __shfl_xor(ss, 2); ss += __shfl_xor(ss, 4); ss += __shfl_xor(ss, 8);
            const float rstd = 1.0f / sqrtf(ss * (1.0f / 64.0f) + EPS); const int s = 16 * w + 4 * kq + e; const size_t m = (size_t)(MP + s);
#pragma unroll
            for (int j = 0; j < 4; ++j) { const int d = 16 * j + rl; const float o = acc[j][e] * rstd * nwp[d] * sc;
                if (pn <= 1) ((bf16*)(F.ws + WS_Q))[m * 512 + (4 * pn + hd) * 64 + d] = (bf16)f2bf(o);
                else { out[O_KS + (size_t)s * 128 + hd * 64 + d] = o; ((bf16*)(F.ws + WS_KB))[m * 128 + hd * 64 + d] = (bf16)f2bf(o); } } }
        return;
    }
    if (pn == 5 && hd == 1) {
        if (rl < 8) {
#pragma unroll
            for (int e = 0; e < 4; ++e) { const int s = 16 * w + 4 * kq + e; ((float*)(F.ws + WS_WI))[(size_t)(MP + s) * 8 + rl] = acc[0][e] * WI_SCALE; } }
        return;
    }
    bf16* dst; int ld, cb; float* fo = nullptr; int fld = 0; bool act = false;
    if (pn == 2) { dst = (bf16*)(F.ws + WS_VB); ld = 128; cb = (hd - 2) * 64; fo = out + O_VS + cb; fld = 128; }
    else if (pn <= 4) { dst = (bf16*)(F.ws + WS_QI); ld = 512; cb = (4 * (pn - 3) + hd) * 64; }
    else if (pn == 5) { dst = (bf16*)(F.ws + WS_KI); ld = 64; cb = 0; fo = out + O_KIS; fld = 64; }
    else if (pn <= 7) { dst = (bf16*)(F.ws + WS_GA); ld = 512; cb = (4 * (pn - 6) + hd) * 64; act = true; }
    else if (pn <= 9) { dst = (bf16*)(F.ws + WS_U); ld = 512; cb = (4 * (pn - 8) + hd) * 64; fo = out + O_PS + 14 * 512 + cb; fld = 15 * 512; }
    else { dst = (bf16*)(F.ws + WS_GP); ld = 512; cb = (4 * (pn - 10) + hd) * 64; act = true; }
#pragma unroll
    for (int e = 0; e < 4; ++e) { const int s = 16 * w + 4 * kq + e; const size_t m = (size_t)(MP + s);
#pragma unroll
        for (int j = 0; j < 4; ++j) { const int d = 16 * j + rl; float o = acc[j][e]; if (act) o = pg8::silu1(o);
            dst[m * ld + cb + d] = (bf16)f2bf(o);
            if (fo) fo[(size_t)s * fld + d] = o; } }
}
__device__ __forceinline__ void p1_norm(Frame& F) {
    const float* ada = (const float*)(F.ws + WS_ADA); bf16* HB = (bf16*)(F.ws + WS_HB); bf16* HS = (bf16*)(F.ws + WS_HS);
    const int gw = F.vcu * NWAVES + F.wave, NGW = F.G * NWAVES;
    for (int ch = gw; ch < MP / 4 + DECB / 2; ch += NGW) {
        if (ch < MP / 4) { const int m = 4 * ch; norm_rows<4, true>(F, F.xp + (size_t)m * DM, ada + (size_t)(m >> 11) * 3072, 0, HB + (size_t)m * DM); }
        else { const int s = 2 * (ch - MP / 4); norm_rows<2, false>(F, F.xs + (size_t)s * DM, ada + (size_t)(NB + s) * 3072, 3072, HS + (size_t)s * DM); } }
}
__device__ __forceinline__ void p2_sample(Frame& F) {
    const int pn = F.bid >> 2, hd = F.bid & 3;
    if (F.bid < 48 && !(pn == 5 && hd >= 2)) sample_inproj(F, pn, hd);
}

constexpr int P3_BM = 0;
constexpr int P3_CNT = 4096;
constexpr int P3_WQ = 4608;
constexpr int P3_MID = 5120;
constexpr int P3_QI = 81920, P3_QI_STRIDE = 1040;
constexpr int P3_XB = 8192, P3_CK = 9216, P3_CI = 17408, P3_CN = 25600, P3_TJ = 25728, P3_CAND = 128;
constexpr int P3_K = 8192;
constexpr int P3_V = P3_K + 32768;
constexpr int P3_VBUF = 18432;
constexpr int P3_END = P3_V + 2 * P3_VBUF;

__device__ __forceinline__ float relu_s(float x) { return __builtin_amdgcn_fmed3f(x, 0.0f, __builtin_inff()); }
__device__ __forceinline__ unsigned f2key(float f) { unsigned u = __float_as_uint(f); if (f == 0.0f) u = 0u; return (u & 0x80000000u) ? ~u : (u | 0x80000000u); }
__device__ __forceinline__ float key2f(unsigned k) { return __uint_as_float((k & 0x80000000u) ? (k ^ 0x80000000u) : ~k); }

__device__ __forceinline__ unsigned half_reduce_add(unsigned v) {
    v += (unsigned)__builtin_amdgcn_update_dpp(0, (int)v, 0xB1, 0xF, 0xF, true);
    v += (unsigned)__builtin_amdgcn_update_dpp(0, (int)v, 0x4E, 0xF, 0xF, true);
    v += (unsigned)__builtin_amdgcn_update_dpp(0, (int)v, 0x141, 0xF, 0xF, true);
    v += (unsigned)__builtin_amdgcn_update_dpp(0, (int)v, 0x140, 0xF, 0xF, true);
    v += (unsigned)__builtin_amdgcn_ds_swizzle((int)v, 0x401F);
    return v;
}
__device__ __forceinline__ float probit_f(float p) {
    const float pp = p < 0.5f ? p : 1.0f - p; const float t = sqrtf(-2.0f * __logf(pp));
    const float z = t - (2.515517f + t * (0.802853f + t * 0.010328f)) * __builtin_amdgcn_rcpf(1.0f + t * (1.432788f + t * (0.189269f + t * 0.001308f)));
    return p < 0.5f ? -z : z;
}
__device__ __forceinline__ unsigned half_reduce_min(unsigned v) {
    v = min(v, (unsigned)__builtin_amdgcn_update_dpp(0, (int)v, 0xB1, 0xF, 0xF, true)); v = min(v, (unsigned)__builtin_amdgcn_update_dpp(0, (int)v, 0x4E, 0xF, 0xF, true));
    v = min(v, (unsigned)__builtin_amdgcn_update_dpp(0, (int)v, 0x141, 0xF, 0xF, true)); v = min(v, (unsigned)__builtin_amdgcn_update_dpp(0, (int)v, 0x140, 0xF, 0xF, true));
    v = min(v, (unsigned)__builtin_amdgcn_ds_swizzle((int)v, 0x401F)); return v; }
__device__ __forceinline__ unsigned half_reduce_max(unsigned v) {
    v = max(v, (unsigned)__builtin_amdgcn_update_dpp(0, (int)v, 0xB1, 0xF, 0xF, true)); v = max(v, (unsigned)__builtin_amdgcn_update_dpp(0, (int)v, 0x4E, 0xF, 0xF, true));
    v = max(v, (unsigned)__builtin_amdgcn_update_dpp(0, (int)v, 0x141, 0xF, 0xF, true)); v = max(v, (unsigned)__builtin_amdgcn_update_dpp(0, (int)v, 0x140, 0xF, 0xF, true));
    v = max(v, (unsigned)__builtin_amdgcn_ds_swizzle((int)v, 0x401F)); return v; }
#define P3_COUNT(mode, thr, Jv, cown, par) do { \
    unsigned pk_[4]; \
    _Pragma("unroll") for (int a_ = 0; a_ < 4; ++a_) { unsigned c0_ = 0u, c1_ = 0u; \
        _Pragma("unroll") for (int s_ = 0; s_ < 8; ++s_) { const int kidx_ = 32 * (w + 8 * s_) + r; \
            if (mode == 0) { c0_ += (sk[s_][a_][0] >= thr[a_][0]) ? 1u : 0u; c1_ += (sk[s_][a_][1] >= thr[a_][1]) ? 1u : 0u; } \
            else { c0_ += (sk[s_][a_][0] == thr[a_][0] && kidx_ <= Jv[a_][0]) ? 1u : 0u; c1_ += (sk[s_][a_][1] == thr[a_][1] && kidx_ <= Jv[a_][1]) ? 1u : 0u; } } \
        pk_[a_] = c0_ | (c1_ << 16); } \
    _Pragma("unroll") for (int a_ = 0; a_ < 4; ++a_) pk_[a_] = half_reduce_add(pk_[a_]); \
    LAS unsigned* cb_ = (LAS unsigned*)(F.lds + P3_CNT) + (par) * 64; \
    if (r == 0) { _Pragma("unroll") for (int a_ = 0; a_ < 4; ++a_) cb_[(hh * 4 + a_) * 8 + w] = pk_[a_]; } \
    __syncthreads(); \
    { const LAS v4u* p_ = (const LAS v4u*)(cb_ + (qh * 4 + qa) * 8); const v4u x_ = p_[0], y_ = p_[1]; \
      const unsigned t_ = (x_.x + x_.y) + (x_.z + x_.w) + (y_.x + y_.y) + (y_.z + y_.w); cown = qj ? (int)(t_ >> 16) : (int)(t_ & 0xffffu); } \
} while (0)

__device__ __forceinline__ void p3_prompt_item(Frame& F, int b, int qt) {
    const int tid = F.tid, lane = F.lane, w = F.wave, r = lane & 31, hh = lane >> 5;
    const int t0 = 16 * qt, L = t0 + 16, nkt32 = (L + 31) >> 5, nkt64 = (L + 63) >> 6;
    const size_t mb = (size_t)b * SEQ;
    LAS unsigned* bm = (LAS unsigned*)(F.lds + P3_BM);
    LAS float* wq = (LAS float*)(F.lds + P3_WQ);
    for (int i = tid; i < 1024; i += NWAVES * 64) bm[i] = 0u;
    if (tid < 128) wq[tid] = ((const float*)(F.ws + WS_WI))[(mb + t0 + (tid >> 3)) * 8 + (tid & 7)];
    { const bf16* QI = (const bf16*)(F.ws + WS_QI);
#pragma unroll
      for (int k = 0; k < 2; ++k) { const int i = tid + 512 * k, row = i >> 6, ch = i & 63; *(LAS v4u*)(F.lds + P3_QI + row * P3_QI_STRIDE + ch * 16) = *(const v4u*)(QI + (mb + t0 + row) * 512 + ch * 8); } }
    __syncthreads();
    FSTAMP();
    unsigned sk[8][4][2];
    for (int rep1_ = 0; rep1_ < REP_S1; ++rep1_) {
        const bf16* KI = (const bf16*)(F.ws + WS_KI);
        const int ns = (nkt32 - w + 7) >> 3;
        int l1_ = lane; asm volatile("" : "+v"(l1_)); const int r = l1_ & 31, hh = l1_ >> 5;
        bf16x8 bb[2][4];
#define P3_LDK(slot) do { const bf16* kp_ = KI + (mb + 32 * (w + 8 * (slot)) + r) * 64 + 8 * hh; \
        _Pragma("unroll") for (int ks_ = 0; ks_ < 4; ++ks_) bb[(slot) & 1][ks_] = *(const bf16x8*)(kp_ + 16 * ks_); } while (0)
        if (0 < ns) P3_LDK(0);
        const int arow = (2 * ((r >> 2) & 1) + (r >> 4)) * P3_QI_STRIDE + ((r & 3) + 4 * ((r >> 3) & 1)) * 128 + 16 * hh;
        const LAS unsigned char* qib = F.lds + P3_QI;
#define P3_MM(ACC, a, s) do { _Pragma("unroll") for (int e_ = 0; e_ < 16; ++e_) ACC[e_] = 0.f; \
        _Pragma("unroll") for (int ks_ = 0; ks_ < 4; ++ks_) { const bf16x8 af_ = *(const LAS bf16x8*)(qs_ + 4 * (a) * P3_QI_STRIDE + arow + 32 * ks_); \
            ACC = __builtin_amdgcn_mfma_f32_32x32x16_bf16(af_, bb[(s) & 1][ks_], ACC, 0, 0, 0); } } while (0)
#define P3_EPI(ACC, a, s) do { _Pragma("unroll") for (int j2_ = 0; j2_ < 2; ++j2_) { const int qq_ = 4 * (a) + 2 * hh + j2_; \
        const LAS f32x4* wp_ = (const LAS f32x4*)(wq + qq_ * 8); const f32x4 w0_ = wp_[0], w1_ = wp_[1]; \
        float sc_ = w0_[0] * relu_s(ACC[8 * j2_ + 0]); sc_ = fmaf(w0_[1], relu_s(ACC[8 * j2_ + 1]), sc_); sc_ = fmaf(w0_[2], relu_s(ACC[8 * j2_ + 2]), sc_); sc_ = fmaf(w0_[3], relu_s(ACC[8 * j2_ + 3]), sc_); \
        sc_ = fmaf(w1_[0], relu_s(ACC[8 * j2_ + 4]), sc_); sc_ = fmaf(w1_[1], relu_s(ACC[8 * j2_ + 5]), sc_); sc_ = fmaf(w1_[2], relu_s(ACC[8 * j2_ + 6]), sc_); sc_ = fmaf(w1_[3], relu_s(ACC[8 * j2_ + 7]), sc_); \
        const unsigned inval_ = (unsigned)((int)(t0 + qq_ - (32 * (w + 8 * (s)) + r)) >> 31);        \
        sk[s][a][j2_] = f2key(sc_) & ~inval_; } } while (0)
#pragma unroll
        for (int s = 0; s < 8; ++s) {
            if (s < ns) {
                if (s + 1 < ns) P3_LDK(s + 1);
                int zo_ = 0; asm volatile("" : "+v"(zo_));
                const LAS unsigned char* qs_ = qib + zo_;
                f32x16 accA, accB;
                P3_MM(accA, 0, s); P3_MM(accB, 1, s);
                P3_EPI(accA, 0, s); P3_MM(accA, 2, s);
                P3_EPI(accB, 1, s); P3_MM(accB, 3, s);
                P3_EPI(accA, 2, s); P3_EPI(accB, 3, s);
                __builtin_amdgcn_sched_barrier(0);
            } else {
#pragma unroll
                for (int a = 0; a < 4; ++a) { sk[s][a][0] = 0u; sk[s][a][1] = 0u; }
            }
        }
#undef P3_MM
#undef P3_EPI
#undef P3_LDK
    }
    FSTAMP();
    LAS unsigned* tj = (LAS unsigned*)(F.lds + P3_TJ);
    if (qt < 16) { if (tid < 16) { tj[tid] = 1u; tj[16 + tid] = 4095u; } }
    for (int rep2_ = 0; rep2_ < REP_S2; ++rep2_)
    if (qt >= 16) {
        int lq_ = lane; asm volatile("" : "+v"(lq_));
        const int myq = lq_ & 15, qa = myq >> 2, qh = (myq >> 1) & 1, qj = myq & 1;
        LAS unsigned* midb = (LAS unsigned*)(F.lds + P3_MID) + w * 16;
        LAS unsigned* cn = (LAS unsigned*)(F.lds + P3_CN); LAS unsigned* ck = (LAS unsigned*)(F.lds + P3_CK); LAS unsigned* ci = (LAS unsigned*)(F.lds + P3_CI);
        unsigned lo, hi;
        {
            unsigned mn0[4], mn1[4], mx0[4], mx1[4];
#pragma unroll
            for (int a = 0; a < 4; ++a) { mn0[a] = 0xffffffffu; mn1[a] = 0xffffffffu; mx0[a] = 0u; mx1[a] = 0u;
#pragma unroll
                for (int s = 0; s < 8; ++s) { const unsigned k0 = sk[s][a][0], k1 = sk[s][a][1];
                    mn0[a] = min(mn0[a], k0 ? k0 : 0xffffffffu); mn1[a] = min(mn1[a], k1 ? k1 : 0xffffffffu); mx0[a] = max(mx0[a], k0); mx1[a] = max(mx1[a], k1); } }
#pragma unroll
            for (int a = 0; a < 4; ++a) { mn0[a] = half_reduce_min(mn0[a]); mn1[a] = half_reduce_min(mn1[a]); mx0[a] = half_reduce_max(mx0[a]); mx1[a] = half_reduce_max(mx1[a]); }
            LAS unsigned* xb = (LAS unsigned*)(F.lds + P3_XB);
            if (r == 0) {
#pragma unroll
                for (int a = 0; a < 4; ++a) { xb[((0 * 2 + hh) * 4 + a) * 8 + w] = mn0[a]; xb[((1 * 2 + hh) * 4 + a) * 8 + w] = mn1[a]; xb[((2 * 2 + hh) * 4 + a) * 8 + w] = mx0[a]; xb[((3 * 2 + hh) * 4 + a) * 8 + w] = mx1[a]; } }
            if (tid < 16) cn[tid] = 0u;
            __syncthreads();
            unsigned m0 = 0xffffffffu, x0 = 0u;
#pragma unroll
            for (int ww = 0; ww < 8; ++ww) { m0 = min(m0, xb[((qj * 2 + qh) * 4 + qa) * 8 + ww]); x0 = max(x0, xb[(((2 + qj) * 2 + qh) * 4 + qa) * 8 + ww]); }
            lo = m0; hi = x0 + 1u;
        }
        int pc = 0;
        unsigned Tq = 1u; int Jq = 4095; int done = 0, tie = 0; int side = 0;
        const float nq = (float)(t0 + myq + 1), rnq = 1.0f / nq, ustar = probit_f(256.0f * rnq);
#define P3_G(c) (probit_f(fminf(fmaxf((float)(c), 0.5f), nq - 0.5f) * rnq) - ustar)
        int clo_i = t0 + myq + 1, chi_i = 0;
        float glo = P3_G(clo_i), ghi = P3_G(0);
        unsigned thr[4][2]; int cq;
#define P3_BCAST(val) do { if (lane < 16) midb[qh * 8 + qa * 2 + qj] = (val); asm volatile("" ::: "memory"); \
        { const LAS v4u* mp_ = (const LAS v4u*)(midb + hh * 8); const v4u t0_ = mp_[0], t1_ = mp_[1]; \
          thr[0][0] = t0_.x; thr[0][1] = t0_.y; thr[1][0] = t0_.z; thr[1][1] = t0_.w; thr[2][0] = t1_.x; thr[2][1] = t1_.y; thr[3][0] = t1_.z; thr[3][1] = t1_.w; } asm volatile("" ::: "memory"); } while (0)
        int it = 0;
        for (; it < 96; ++it) {
            if (!done && hi - lo <= 1u && clo_i - chi_i > P3_CAND) { Tq = lo; done = 1; tie = 1; }
            const bool act = !done && (clo_i - chi_i) > P3_CAND;
            if (!__any(act)) break;
            unsigned m_ = lo;
            if (act) {
                if ((it & 7) == 7) m_ = lo + ((hi - lo) >> 1);
                else { const float fl = key2f(lo), fh = key2f(hi);
                    const float t_ = (it & 1) ? 0.5f * fl + 0.5f * fh : fl + (fh - fl) * (glo * __builtin_amdgcn_rcpf(glo - ghi));
                    unsigned k_ = f2key(t_); if (!(k_ > lo)) k_ = lo + 1u; if (!(k_ < hi)) k_ = hi - 1u; m_ = k_; } }
            P3_BCAST(m_);
            P3_COUNT(0, thr, thr, cq, pc & 1); ++pc;
            if (act) {
                if (cq == 256) { Tq = m_; done = 1; }
                else if (cq > 256) { lo = m_; clo_i = cq; glo = P3_G(cq); if (side == 1) ghi *= 0.5f; side = 1; }
                else { hi = m_; chi_i = cq; ghi = P3_G(cq); if (side == 2) glo *= 0.5f; side = 2; } }
        }
#if TEST_MODE == 5
        if (threadIdx.x == 0) { unsigned* st_ = (unsigned*)(F.ws + WS_CTL + 900 * 1024); atomicMax(st_ + 0, (unsigned)it); atomicAdd(st_ + 1, (unsigned)it); atomicAdd(st_ + 2, 1u); if (__any(tie)) atomicAdd(st_ + 3, 1u); }
#endif
        if (__any(tie)) {
            int cgt;
            P3_BCAST(Tq + 1u);
            P3_COUNT(0, thr, thr, cgt, pc & 1); ++pc;
            const int need = 256 - cgt; int jlo = -1, jhi = 2047;
            unsigned Tt[4][2];
            P3_BCAST(Tq);
#pragma unroll
            for (int a = 0; a < 4; ++a) { Tt[a][0] = thr[a][0]; Tt[a][1] = thr[a][1]; }
            for (int it2 = 0; it2 < 11; ++it2) { const int jm = (jlo + jhi + 1) >> 1; int ce; int jmv[4][2];
                P3_BCAST((unsigned)jm);
#pragma unroll
                for (int a = 0; a < 4; ++a) { jmv[a][0] = (int)thr[a][0]; jmv[a][1] = (int)thr[a][1]; }
                P3_COUNT(1, Tt, jmv, ce, pc & 1); ++pc;
                if (jhi - jlo > 1) { if (ce >= need) jhi = jm; else jlo = jm; } }
            if (tie) Jq = jhi;
        }
        {
            unsigned lov[4][2];
            P3_BCAST(done ? 0u : lo);
#pragma unroll
            for (int a = 0; a < 4; ++a) { lov[a][0] = thr[a][0]; lov[a][1] = thr[a][1]; }
            P3_BCAST(done ? 0u : hi);
#pragma unroll
            for (int s = 0; s < 8; ++s)
#pragma unroll
                for (int a = 0; a < 4; ++a)
#pragma unroll
                    for (int j2 = 0; j2 < 2; ++j2) { const unsigned k = sk[s][a][j2];
                        if (k >= lov[a][j2] && k < thr[a][j2]) { const int qx = 4 * a + 2 * hh + j2;
                            const unsigned pos = __hip_atomic_fetch_add(cn + qx, 1u, __ATOMIC_RELAXED, __HIP_MEMORY_SCOPE_WORKGROUP);
                            if (pos < (unsigned)P3_CAND) { ck[qx * P3_CAND + pos] = k; ci[qx * P3_CAND + pos] = (unsigned)(32 * (w + 8 * s) + r); } } }
        }
        __syncthreads();
#pragma unroll
        for (int q2 = 0; q2 < 2; ++q2) { const int qx = 2 * w + q2;
            const int qdone = __builtin_amdgcn_readlane(done, qx), chq = __builtin_amdgcn_readlane(chi_i, qx);
            if (!qdone) {
                const int ncand = (int)cn[qx]; const int need = 256 - chq;
                const unsigned k0 = lane < ncand ? ck[qx * P3_CAND + lane] : 0u, k1 = lane + 64 < ncand ? ck[qx * P3_CAND + 64 + lane] : 0u;
                const int i0 = (int)ci[qx * P3_CAND + lane], i1 = (int)ci[qx * P3_CAND + 64 + lane];
                unsigned Tv = 0u;
                for (int bit = 31; bit >= 0; --bit) { const unsigned cand = Tv | (1u << bit);
                    const int c = __popcll(__ballot(k0 >= cand)) + __popcll(__ballot(k1 >= cand)); if (c >= need) Tv = cand; }
                const int cgt = __popcll(__ballot(k0 > Tv)) + __popcll(__ballot(k1 > Tv)); const int rr = need - cgt;
                int jlo = -1, jhi = 2047;
                for (int it2 = 0; it2 < 11; ++it2) { const int jm = (jlo + jhi + 1) >> 1;
                    const int c = __popcll(__ballot(k0 == Tv && i0 <= jm)) + __popcll(__ballot(k1 == Tv && i1 <= jm));
                    if (jhi - jlo > 1) { if (c >= rr) jhi = jm; else jlo = jm; } }
                if (lane == 0) { const int px = ((qx >> 1) & 1) * 8 + (qx >> 2) * 2 + (qx & 1); tj[px] = Tv; tj[16 + px] = (unsigned)jhi; }
            }
        }
        if (w == 0 && lane < 16 && done) { tj[qh * 8 + qa * 2 + qj] = Tq; tj[16 + qh * 8 + qa * 2 + qj] = (unsigned)Jq; }
#undef P3_BCAST
#undef P3_G
    }
    __syncthreads();
    unsigned T[4][2]; int J[4][2];
    { const LAS v4u* tp_ = (const LAS v4u*)(tj + hh * 8); const v4u a_ = tp_[0], b_ = tp_[1], c_ = tp_[4], d_ = tp_[5];
      T[0][0] = a_.x; T[0][1] = a_.y; T[1][0] = a_.z; T[1][1] = a_.w; T[2][0] = b_.x; T[2][1] = b_.y; T[3][0] = b_.z; T[3][1] = b_.w;
      J[0][0] = (int)c_.x; J[0][1] = (int)c_.y; J[1][0] = (int)c_.z; J[1][1] = (int)c_.w; J[2][0] = (int)d_.x; J[2][1] = (int)d_.y; J[3][0] = (int)d_.z; J[3][1] = (int)d_.w; }
    FSTAMP();
#pragma unroll
    for (int s = 0; s < 8; ++s) { const int kt = w + 8 * s;
        if (kt < nkt32) { const int kidx = 32 * kt + r;
#pragma unroll
            for (int a = 0; a < 4; ++a)
#pragma unroll
                for (int j2 = 0; j2 < 2; ++j2) { const unsigned k = sk[s][a][j2]; const bool selv = (k > T[a][j2]) || (k == T[a][j2] && kidx <= J[a][j2]);
                    const unsigned long long bal = __ballot(selv && k != 0u);
                    if (lane == 0) { bm[(4 * a + j2) * 64 + kt] = (unsigned)bal; bm[(4 * a + 2 + j2) * 64 + kt] = (unsigned)(bal >> 32); } } } }
    __syncthreads();
#if TEST_MODE
    { unsigned* dbg = (unsigned*)(F.ws + WS_DBG_BM) + (mb + t0) * 64; for (int i = tid; i < 1024; i += NWAVES * 64) dbg[i] = bm[i]; }
#endif
    FSTAMP();
    for (int rep4_ = 0; rep4_ < REP_S4; ++rep4_) {
        int l4_ = lane, t4_ = tid; asm volatile("" : "+v"(l4_), "+v"(t4_));
        const int g = w & 1, quad = w >> 1, j = l4_ & 15, kq = l4_ >> 4;
        const bf16* Q = (const bf16*)(F.ws + WS_Q); const bf16* KB = (const bf16*)(F.ws + WS_KB); const bf16* VB = (const bf16*)(F.ws + WS_VB);
        const int qq = 4 * quad + (j >> 2), hd = 4 * g + (j & 3);
        const size_t mrow = mb + t0 + qq;
        bf16x8 qf[2];
#pragma unroll
        for (int ks = 0; ks < 2; ++ks) qf[ks] = *(const bf16x8*)(Q + mrow * 512 + hd * 64 + 32 * ks + 8 * kq);
        f32x4 o[4];
#pragma unroll
        for (int dt = 0; dt < 4; ++dt) o[dt] = (f32x4){0.f, 0.f, 0.f, 0.f};
        float mrun = -INFINITY, lsum = 0.f;
        const int skey = t4_ >> 3, sc0 = 2 * (t4_ & 7);
        v4u kreg[2], vreg[2];
#define P3_STAGE_LOAD(t) do { const size_t row_ = (mb + 64 * (t) + skey) * 128; \
        kreg[0] = *(const v4u*)(KB + row_ + 8 * sc0); kreg[1] = *(const v4u*)(KB + row_ + 8 * sc0 + 8); \
        vreg[0] = *(const v4u*)(VB + row_ + 8 * sc0); vreg[1] = *(const v4u*)(VB + row_ + 8 * sc0 + 8); } while (0)
#define P3_STAGE_WRITE(bufi) do { LAS unsigned char* kb_ = F.lds + P3_K + (bufi) * 16384 + skey * 256; \
        *(LAS v4u*)(kb_ + ((sc0 ^ (skey & 15)) << 4)) = kreg[0]; *(LAS v4u*)(kb_ + (((sc0 + 1) ^ (skey & 15)) << 4)) = kreg[1]; \
        LAS unsigned char* vb_ = F.lds + P3_V + (bufi) * P3_VBUF + (sc0 >> 3) * 9216 + skey * 144 + ((sc0 & 7) << 4); \
        *(LAS v4u*)(vb_) = vreg[0]; *(LAS v4u*)(vb_ + 16) = vreg[1]; } while (0)
        P3_STAGE_LOAD(0); P3_STAGE_WRITE(0);
        __syncthreads();
        for (int t = 0; t < nkt64; ++t) {
            const int bufi = t & 1;
            if (t + 1 < nkt64) P3_STAGE_LOAD(t + 1);
            f32x4 sacc[4];
            const LAS unsigned char* kbase = F.lds + P3_K + bufi * 16384;
#pragma unroll
            for (int c = 0; c < 4; ++c) { sacc[c] = (f32x4){0.f, 0.f, 0.f, 0.f}; const int key = 16 * c + j;
#pragma unroll
                for (int ks = 0; ks < 2; ++ks) { const int ch = g * 8 + 4 * ks + kq;
                    const bf16x8 kf = *(const LAS bf16x8*)(kbase + key * 256 + ((ch ^ (key & 15)) << 4));
                    sacc[c] = __builtin_amdgcn_mfma_f32_16x16x32_bf16(kf, qf[ks], sacc[c], 0, 0, 0); } }
            const unsigned mw0 = bm[qq * 64 + 2 * t], mw1 = bm[qq * 64 + 2 * t + 1];
            float tmax = -INFINITY;
#pragma unroll
            for (int c = 0; c < 4; ++c)
#pragma unroll
                for (int e = 0; e < 4; ++e) { const unsigned mwd = (c >> 1) ? mw1 : mw0; const bool bit = (mwd >> (16 * (c & 1) + 4 * kq + e)) & 1u;
                    sacc[c][e] = bit ? sacc[c][e] : -INFINITY; tmax = fmaxf(tmax, sacc[c][e]); }
            tmax = fmaxf(tmax, __shfl_xor(tmax, 16)); tmax = fmaxf(tmax, __shfl_xor(tmax, 32));
            const float mnew = fmaxf(mrun, tmax), muse = (mnew == -INFINITY) ? 0.f : mnew;
            const float alpha = __builtin_amdgcn_exp2f(mrun - muse);
            mrun = mnew;
            float psum = 0.f;
#pragma unroll
            for (int c = 0; c < 4; ++c)
#pragma unroll
                for (int e = 0; e < 4; ++e) { const float p = __builtin_amdgcn_exp2f(sacc[c][e] - muse); sacc[c][e] = p; psum += p; }
            lsum = lsum * alpha + psum;
#pragma unroll
            for (int dt = 0; dt < 4; ++dt) o[dt] *= alpha;
            const LAS unsigned char* vbase = F.lds + P3_V + bufi * P3_VBUF + g * 9216;
#pragma unroll
            for (int ks = 0; ks < 2; ++ks) {
                v4u pw; pw.x = pk2(sacc[2 * ks][0], sacc[2 * ks][1]); pw.y = pk2(sacc[2 * ks][2], sacc[2 * ks][3]); pw.z = pk2(sacc[2 * ks + 1][0], sacc[2 * ks + 1][1]); pw.w = pk2(sacc[2 * ks + 1][2], sacc[2 * ks + 1][3]);
                const bf16x8 pf = __builtin_bit_cast(bf16x8, pw);
#pragma unroll
                for (int dt = 0; dt < 4; ++dt) {
                    const LAS unsigned char* va = vbase + (32 * ks + 4 * kq + (j >> 2)) * 144 + (16 * dt + 4 * (j & 3)) * 2;
                    typedef short v4i16_t __attribute__((ext_vector_type(4)));
                    const v4i16_t lo4 = __builtin_amdgcn_ds_read_tr16_b64_v4i16((LAS v4i16_t*)va);
                    const v4i16_t hi4 = __builtin_amdgcn_ds_read_tr16_b64_v4i16((LAS v4i16_t*)(va + 16 * 144));
                    const bf16x8 vf = (bf16x8){lo4[0], lo4[1], lo4[2], lo4[3], hi4[0], hi4[1], hi4[2], hi4[3]};
                    o[dt] = __builtin_amdgcn_mfma_f32_16x16x32_bf16(vf, pf, o[dt], 0, 0, 0); } }
            if (t + 1 < nkt64) P3_STAGE_WRITE(bufi ^ 1);
            __syncthreads();
        }
#undef P3_STAGE_LOAD
#undef P3_STAGE_WRITE
        lsum += __shfl_xor(lsum, 16); lsum += __shfl_xor(lsum, 32);
        const float inv = 1.0f / lsum;
        const bf16* GA = (const bf16*)(F.ws + WS_GA); bf16* MIX = (bf16*)(F.ws + WS_MIX);
#pragma unroll
        for (int dt = 0; dt < 4; ++dt) { const int d = 16 * dt + 4 * kq; const v2u gv = *(const v2u*)(GA + mrow * 512 + hd * 64 + d);
            const float g0 = bf2f((unsigned short)(gv.x & 0xffffu)), g1 = bf2f((unsigned short)(gv.x >> 16)), g2 = bf2f((unsigned short)(gv.y & 0xffffu)), g3 = bf2f((unsigned short)(gv.y >> 16));
            v2u ov; ov.x = pk2(o[dt][0] * inv * g0, o[dt][1] * inv * g1); ov.y = pk2(o[dt][2] * inv * g2, o[dt][3] * inv * g3);
            *(v2u*)(MIX + mrow * 1024 + hd * 64 + d) = ov; }
    }
}

constexpr int PL_U = 0, PL_W = 40960, PL_STRIDE = 272;
template <bool SAMPLE> __device__ __forceinline__ void p3_pool_item(Frame& F, int item) {
    const int tid = F.tid, lane = F.lane, w = F.wave, j = lane & 15, kq = lane >> 4;
    const bf16* U = (const bf16*)(F.ws + WS_U); const bf16* GP = (const bf16*)(F.ws + WS_GP); const bf16* WPT = (const bf16*)(F.ws + WS_WPOOLT); bf16* MIX = (bf16*)(F.ws + WS_MIX);
    const int tokb = SAMPLE ? 0 : (item & 15) * 128;
    const size_t m0 = SAMPLE ? (size_t)MP : (size_t)(item >> 4) * SEQ + tokb;
    const int tl = 16 * w + j;
    const size_t mrow = m0 + tl;
    v4u wr_[4], ur_[5];
#define PL_LOAD(gg) do { _Pragma("unroll") for (int k_ = 0; k_ < 4; ++k_) { const int i_ = tid + 512 * k_; wr_[k_] = *(const v4u*)(WPT + (size_t)(gg) * 16384 + (i_ >> 4) * 128 + (i_ & 15) * 8); } \
        if (!SAMPLE) { _Pragma("unroll") for (int k_ = 0; k_ < 5; ++k_) { const int i_ = tid + 512 * k_; const int row_ = i_ >> 4, ch_ = i_ & 15; ur_[k_] = (v4u){0u, 0u, 0u, 0u}; \
            if (i_ < 143 * 16 && tokb - 15 + row_ >= 0) ur_[k_] = *(const v4u*)(U + (m0 - 15 + row_) * 512 + (gg) * 128 + ch_ * 8); } } } while (0)
#define PL_STORE() do { _Pragma("unroll") for (int k_ = 0; k_ < 4; ++k_) { const int i_ = tid + 512 * k_; *(LAS v4u*)(F.lds + PL_W + (i_ >> 4) * PL_STRIDE + (i_ & 15) * 16) = wr_[k_]; } \
        if (!SAMPLE) { _Pragma("unroll") for (int k_ = 0; k_ < 5; ++k_) { const int i_ = tid + 512 * k_; if (i_ < 143 * 16) *(LAS v4u*)(F.lds + PL_U + (i_ >> 4) * PL_STRIDE + (i_ & 15) * 16) = ur_[k_]; } } } while (0)
    PL_LOAD(0);
#pragma unroll
    for (int g = 0; g < 4; ++g) {
        const int win = 2 << g;
        PL_STORE();
        __syncthreads();
        if (g + 1 < 4) PL_LOAD(g + 1);
        bf16x8 df[4];
#pragma unroll
        for (int ks = 0; ks < 4; ++ks) {
            float sum[8], cur[8];
            if (!SAMPLE) {
                const LAS unsigned char* up = F.lds + PL_U + (15 + tl) * PL_STRIDE + (4 * ks + kq) * 16;
                { const v4u c = *(const LAS v4u*)up;
#pragma unroll
                  for (int u = 0; u < 4; ++u) { const unsigned x = c[u]; cur[2 * u] = bf2f((unsigned short)(x & 0xffffu)); cur[2 * u + 1] = bf2f((unsigned short)(x >> 16)); sum[2 * u] = cur[2 * u]; sum[2 * u + 1] = cur[2 * u + 1]; } }
#pragma unroll
                for (int i = 1; i < win; ++i) { const v4u c = *(const LAS v4u*)(up - i * PL_STRIDE);
#pragma unroll
                    for (int u = 0; u < 4; ++u) { const unsigned x = c[u]; sum[2 * u] += bf2f((unsigned short)(x & 0xffffu)); sum[2 * u + 1] += bf2f((unsigned short)(x >> 16)); } }
            } else {
                const int c0 = g * 128 + 32 * ks + 8 * kq;
                { const v4u c = *(const v4u*)(U + mrow * 512 + c0);
#pragma unroll
                  for (int u = 0; u < 4; ++u) { const unsigned x = c[u]; cur[2 * u] = bf2f((unsigned short)(x & 0xffffu)); cur[2 * u + 1] = bf2f((unsigned short)(x >> 16)); sum[2 * u] = cur[2 * u]; sum[2 * u + 1] = cur[2 * u + 1]; } }
#pragma unroll
                for (int i = 1; i < win; ++i) { const float* sp = F.state_pool + ((size_t)tl * 15 + (15 - i)) * 512 + c0; const f32x4 a = *(const f32x4*)sp, bq = *(const f32x4*)(sp + 4);
                    sum[0] += a[0]; sum[1] += a[1]; sum[2] += a[2]; sum[3] += a[3]; sum[4] += bq[0]; sum[5] += bq[1]; sum[6] += bq[2]; sum[7] += bq[3]; }
            }
            const int tpos = tokb + tl; const float rc = 1.0f / (float)(SAMPLE ? win : ((tpos + 1 < win) ? tpos + 1 : win));
            v4u pw; pw.x = pk2(sum[0] * rc - cur[0], sum[1] * rc - cur[1]); pw.y = pk2(sum[2] * rc - cur[2], sum[3] * rc - cur[3]);
            pw.z = pk2(sum[4] * rc - cur[4], sum[5] * rc - cur[5]); pw.w = pk2(sum[6] * rc - cur[6], sum[7] * rc - cur[7]);
            df[ks] = __builtin_bit_cast(bf16x8, pw);
        }
#pragma unroll
        for (int jt = 0; jt < 8; ++jt) {
            f32x4 acc = (f32x4){0.f, 0.f, 0.f, 0.f};
#pragma unroll
            for (int ks = 0; ks < 4; ++ks) { const bf16x8 wf = *(const LAS bf16x8*)(F.lds + PL_W + (16 * jt + j) * PL_STRIDE + (4 * ks + kq) * 16);
                acc = __builtin_amdgcn_mfma_f32_16x16x32_bf16(wf, df[ks], acc, 0, 0, 0); }
            const int col = g * 128 + 16 * jt + 4 * kq;
            const f32x4 ps = *(const f32x4*)(F.pool_scale + col); const v2u gv = *(const v2u*)(GP + mrow * 512 + col);
            const float g0 = bf2f((unsigned short)(gv.x & 0xffffu)), g1 = bf2f((unsigned short)(gv.x >> 16)), g2 = bf2f((unsigned short)(gv.y & 0xffffu)), g3 = bf2f((unsigned short)(gv.y >> 16));
            v2u ov; ov.x = pk2(acc[0] * ps[0] * g0, acc[1] * ps[1] * g1); ov.y = pk2(acc[2] * ps[2] * g2, acc[3] * ps[3] * g3);
            *(v2u*)(MIX + mrow * 1024 + 512 + col) = ov;
        }
        __syncthreads();
    }
#undef PL_LOAD
#undef PL_STORE
}

constexpr int SM_SC = 0, SM_SEL = 8448, SM_Q = 9472, SM_P = 11520, SM_RED = 19712, SM_PT = 27904;
__device__ __forceinline__ void p3_sample_item(Frame& F, int s) {
    const int tid = F.tid, lane = F.lane, w = F.wave, r = lane & 31, hh = lane >> 5;
    const size_t m = (size_t)MP + s;
    LAS float* sc = (LAS float*)(F.lds + SM_SC); LAS int* sel = (LAS int*)(F.lds + SM_SEL); LAS float* ql = (LAS float*)(F.lds + SM_Q);
    LAS float* pl = (LAS float*)(F.lds + SM_P); LAS float* red = (LAS float*)(F.lds + SM_RED); LAS int* ptl = (LAS int*)(F.lds + SM_PT);
    const bf16* QI = (const bf16*)(F.ws + WS_QI) + m * 512; const float* WIp = (const float*)(F.ws + WS_WI) + m * 8;
    const int* pt = F.page_table + s * NPG;
    ql[tid] = bf2f(((const bf16*)(F.ws + WS_Q))[m * 512 + tid]);
    if (tid < NPG) ptl[tid] = pt[tid];
    {
        bf16x8 af[4];
#pragma unroll
        for (int ks = 0; ks < 4; ++ks) { af[ks] = (bf16x8){0, 0, 0, 0, 0, 0, 0, 0}; if (r < 8) af[ks] = *(const bf16x8*)(QI + r * 64 + 16 * ks + 8 * hh); }
        float wv[4];
#pragma unroll
        for (int e = 0; e < 4; ++e) wv[e] = WIp[4 * hh + e];
        int pg[8];
#pragma unroll
        for (int it = 0; it < 8; ++it) pg[it] = pt[(w + 8 * it) >> 2];
#pragma unroll
        for (int hf = 0; hf < 4; ++hf) {
            f32x4 x0[2][4], x1[2][4];
#pragma unroll
            for (int i4 = 0; i4 < 2; ++i4) { const int kt = w + 8 * (2 * hf + i4);
                const float* kp = F.cache_kidx + ((size_t)pg[2 * hf + i4] * PAGE + (kt & 3) * 32 + r) * 64 + 8 * hh;
#pragma unroll
                for (int ks = 0; ks < 4; ++ks) { x0[i4][ks] = *(const f32x4*)(kp + 16 * ks); x1[i4][ks] = *(const f32x4*)(kp + 16 * ks + 4); } }
#pragma unroll
            for (int i4 = 0; i4 < 2; ++i4) { const int kt = w + 8 * (2 * hf + i4);
                f32x16 acc;
#pragma unroll
                for (int e = 0; e < 16; ++e) acc[e] = 0.f;
#pragma unroll
                for (int ks = 0; ks < 4; ++ks) {
                    v4u pw; pw.x = pk2(x0[i4][ks][0], x0[i4][ks][1]); pw.y = pk2(x0[i4][ks][2], x0[i4][ks][3]); pw.z = pk2(x1[i4][ks][0], x1[i4][ks][1]); pw.w = pk2(x1[i4][ks][2], x1[i4][ks][3]);
                    acc = __builtin_amdgcn_mfma_f32_32x32x16_bf16(af[ks], __builtin_bit_cast(bf16x8, pw), acc, 0, 0, 0); }
                float part = wv[0] * fmaxf(acc[0], 0.f) + wv[1] * fmaxf(acc[1], 0.f) + wv[2] * fmaxf(acc[2], 0.f) + wv[3] * fmaxf(acc[3], 0.f);
                part += __shfl_xor(part, 32);
                if (hh == 0) sc[32 * kt + r] = part; }
        }
        if (w == 0) {
            const float kv = bf2f(((const bf16*)(F.ws + WS_KI))[m * 64 + lane]); float tot = 0.f;
#pragma unroll
            for (int h = 0; h < 8; ++h) { const float d = wave_sum(bf2f(QI[h * 64 + lane]) * kv); tot += WIp[h] * fmaxf(d, 0.f); }
            if (lane == 0) sc[PAST] = tot;
        }
    }
    __syncthreads();
    if (w == 0) {
        unsigned key[33];
#pragma unroll
        for (int jj = 0; jj < 33; ++jj) { const int l = jj * 64 + lane; key[jj] = l < PAST + 1 ? f2key(sc[l]) : 0u; }
        unsigned Tk = 0u;
        for (int bit = 31; bit >= 0; --bit) { const unsigned cand = Tk | (1u << bit); int cnt = 0;
#pragma unroll
            for (int jj = 0; jj < 33; ++jj) cnt += __popcll(__ballot(key[jj] >= cand));
            if (cnt >= 256) Tk = cand; }
        int cgt = 0;
#pragma unroll
        for (int jj = 0; jj < 33; ++jj) cgt += __popcll(__ballot(key[jj] > Tk));
        const int need = 256 - cgt; const unsigned long long lt = (1ull << lane) - 1ull; int pos = 0, eq_seen = 0;
#pragma unroll
        for (int jj = 0; jj < 33; ++jj) { const bool gt = key[jj] > Tk, eq = key[jj] == Tk;
            const unsigned long long meq = __ballot(eq); const int eqb = eq_seen + __popcll(meq & lt);
            const bool take = gt || (eq && eqb < need); const unsigned long long mt = __ballot(take);
            const int l = jj * 64 + lane;
            if (take) sel[pos + __popcll(mt & lt)] = l < PAST ? ptl[l >> 7] * PAGE + (l & 127) : -1;
            pos += __popcll(mt); eq_seen += __popcll(meq); }
    }
    __syncthreads();
    {
        const int jk = tid & 255, g = tid >> 8; const int pr = sel[jk];
        const float* krow = pr >= 0 ? F.cache_k + (size_t)pr * 128 + g * 64 : F.out + O_KS + (size_t)s * 128 + g * 64;
        f32x4 kv[16];
#pragma unroll
        for (int c = 0; c < 16; ++c) kv[c] = *(const f32x4*)(krow + 4 * c);
        float d4[4] = {0.f, 0.f, 0.f, 0.f};
#pragma unroll
        for (int c = 0; c < 16; ++c) {
#pragma unroll
            for (int rr = 0; rr < 4; ++rr) { const f32x4 qv = *(const LAS f32x4*)(ql + (4 * g + rr) * 64 + 4 * c); d4[rr] += (qv[0] * kv[c][0] + qv[1] * kv[c][1]) + (qv[2] * kv[c][2] + qv[3] * kv[c][3]); } }
#pragma unroll
        for (int rr = 0; rr < 4; ++rr) pl[(4 * g + rr) * 256 + jk] = d4[rr];
    }
    __syncthreads();
    {
        float v[4]; float mx = -INFINITY;
#pragma unroll
        for (int i = 0; i < 4; ++i) { v[i] = pl[w * 256 + lane + 64 * i]; mx = fmaxf(mx, v[i]); }
        mx = wave_max(mx); float sm = 0.f;
#pragma unroll
        for (int i = 0; i < 4; ++i) { v[i] = __builtin_amdgcn_exp2f(v[i] - mx); sm += v[i]; }
        sm = wave_sum(sm); const float inv = 1.0f / sm;
#pragma unroll
        for (int i = 0; i < 4; ++i) pl[w * 256 + lane + 64 * i] = v[i] * inv;
    }
    __syncthreads();
    {
        const int d = tid & 63, g = (tid >> 6) & 1, k4 = tid >> 7; float acc[4] = {0.f, 0.f, 0.f, 0.f};
#pragma unroll
        for (int hb = 0; hb < 2; ++hb) { float vv[32];
#pragma unroll
            for (int i = 0; i < 32; ++i) { const int pr = sel[64 * k4 + 32 * hb + i];
                const float* vrow = pr >= 0 ? F.cache_v + (size_t)pr * 128 + g * 64 : F.out + O_VS + (size_t)s * 128 + g * 64; vv[i] = vrow[d]; }
#pragma unroll
            for (int i = 0; i < 32; ++i) {
#pragma unroll
                for (int rr = 0; rr < 4; ++rr) acc[rr] += pl[(4 * g + rr) * 256 + 64 * k4 + 32 * hb + i] * vv[i]; } }
#pragma unroll
        for (int rr = 0; rr < 4; ++rr) red[((k4 * 2 + g) * 4 + rr) * 64 + d] = acc[rr];
    }
    __syncthreads();
    { const int h = tid >> 6, d = tid & 63; float a = 0.f;
#pragma unroll
        for (int k4 = 0; k4 < 4; ++k4) a += red[((k4 * 2 + (h >> 2)) * 4 + (h & 3)) * 64 + d];
        const float gate = bf2f(((const bf16*)(F.ws + WS_GA))[m * 512 + tid]);
        ((bf16*)(F.ws + WS_MIX))[m * 1024 + tid] = (bf16)f2bf(a * gate); }
    { const int c = tid, g = c >> 7, win = 2 << g; const float un = bf2f(((const bf16*)(F.ws + WS_U))[m * 512 + c]); float sum = un;
      const float* sp = F.state_pool + (size_t)s * 15 * 512 + c;
      float hv[15];
#pragma unroll
      for (int i = 1; i < 16; ++i) hv[i - 1] = sp[(size_t)(15 - i) * 512];
#pragma unroll
      for (int i = 1; i < 16; ++i) sum += (i < win) ? hv[i - 1] : 0.f;
      ql[c] = bf2f((unsigned short)f2bf(sum / (float)win - un)); }
    __syncthreads();
    { const int col = tid, g = col >> 7, j = col & 127; const bf16* wr = (const bf16*)(F.ws + WS_WPOOLT) + (size_t)g * 16384 + j * 128;
      v4u wv4[16];
#pragma unroll
      for (int i = 0; i < 16; ++i) wv4[i] = *(const v4u*)(wr + 8 * i);
      float acc = 0.f;
#pragma unroll
      for (int i = 0; i < 16; ++i) { const LAS f32x4* dp = (const LAS f32x4*)(ql + g * 128 + 8 * i); const f32x4 d0 = dp[0], d1 = dp[1];
          acc += d0[0] * bf2f((unsigned short)(wv4[i].x & 0xffffu)) + d0[1] * bf2f((unsigned short)(wv4[i].x >> 16)) + d0[2] * bf2f((unsigned short)(wv4[i].y & 0xffffu)) + d0[3] * bf2f((unsigned short)(wv4[i].y >> 16));
          acc += d1[0] * bf2f((unsigned short)(wv4[i].z & 0xffffu)) + d1[1] * bf2f((unsigned short)(wv4[i].z >> 16)) + d1[2] * bf2f((unsigned short)(wv4[i].w & 0xffffu)) + d1[3] * bf2f((unsigned short)(wv4[i].w >> 16)); }
      const float gp = bf2f(((const bf16*)(F.ws + WS_GP))[m * 512 + col]);
      ((bf16*)(F.ws + WS_MIX))[m * 1024 + 512 + col] = (bf16)f2bf(acc * F.pool_scale[col] * gp); }
    __syncthreads();
}

__device__ __forceinline__ void p3_mixer(Frame& F) {
    for (int p = F.bid; p < 512; p += F.G) { const int b = p >> 6, sidx = p & 63;
        p3_prompt_item(F, b, 127 - sidx); __syncthreads(); FSTAMP();
        p3_prompt_item(F, b, sidx); __syncthreads(); FSTAMP(); }
    for (int x = F.bid; x < 128; x += F.G) { p3_sample_item(F, x); __syncthreads(); FSTAMP(); }
    for (int x = F.bid + ((F.bid < 128) ? ((128 - F.bid + F.G - 1) / F.G) * F.G : 0); x < 256; x += F.G) { p3_pool_item<false>(F, x - 128); __syncthreads(); FSTAMP(); }
}
__device__ __forceinline__ void p4_sample_out(Frame& F) {
    if (F.bid >= 64) return;
    const int lane = F.lane, w = F.wave, rl = lane & 15, kq = lane >> 4, n0 = F.bid * 16;
    const bf16* ap = (const bf16*)(F.ws + WS_MIX) + (size_t)(MP + 16 * w + rl) * 1024 + 8 * kq;
    const bf16* bp = (const bf16*)(F.ws + WS_WOUTT) + (size_t)(n0 + rl) * 1024 + 8 * kq;
    f32x4 acc = (f32x4){0.f, 0.f, 0.f, 0.f};
#pragma unroll
    for (int hb = 0; hb < 2; ++hb) { bf16x8 fa[16], fb[16];
#pragma unroll
        for (int i = 0; i < 16; ++i) { fa[i] = *(const bf16x8*)(ap + 32 * (16 * hb + i)); fb[i] = *(const bf16x8*)(bp + 32 * (16 * hb + i)); }
#pragma unroll
        for (int i = 0; i < 16; ++i) acc = __builtin_amdgcn_mfma_f32_16x16x32_bf16(fa[i], fb[i], acc, 0, 0, 0); }
    const float* ada = (const float*)(F.ws + WS_ADA);
#pragma unroll
    for (int e = 0; e < 4; ++e) { const int s = 16 * w + 4 * kq + e, n = n0 + rl;
        F.out[O_YS + (size_t)s * 1024 + n] = F.xs[(size_t)s * 1024 + n] + ada[(size_t)(NB + s) * 3072 + 2048 + n] * acc[e]; }
}

struct Args { const float* in[18]; float* out; unsigned char* ws; int ph_lo, ph_hi, li, pad; };
__global__ void __launch_bounds__(NWAVES * 64, 2) mk_fwd(Args args) {
    extern __shared__ __attribute__((aligned(16))) unsigned char lds[];
    Frame F;
    F.lds = (LAS unsigned char*)lds;
    F.MISC = (volatile LAS unsigned*)(F.lds + MISC_OFF);
    F.tid = threadIdx.x; F.lane = F.tid & 63; F.wave = __builtin_amdgcn_readfirstlane(F.tid >> 6);
    F.G = gridDim.x; F.bid = blockIdx.x; { const int bx = blockIdx.x; F.vcu = (F.G % 8 == 0) ? (bx % 8) * (F.G / 8) + bx / 8 : bx; }
    F.ws = args.ws; F.out = args.out; F.ctl = (gu32*)(args.ws + WS_CTL);
    F.xp = args.in[0]; F.xs = args.in[1]; F.cache_k = args.in[2]; F.cache_v = args.in[3]; F.cache_kidx = args.in[4]; F.state_pool = args.in[5];
    F.page_table = (const int*)args.in[6]; F.cp = args.in[7]; F.cs = args.in[8]; F.norm_w = args.in[9]; F.w_ada = args.in[10]; F.b_ada = args.in[11];
    F.w_in = args.in[12]; F.qnw = args.in[13]; F.knw = args.in[14]; F.w_pool = args.in[15]; F.pool_scale = args.in[16]; F.w_out = args.in[17];
    for (int u = F.tid; u < (LDS_BYTES - LDSCTL_OFF) / 4; u += NWAVES * 64) ((LAS unsigned*)(F.lds + LDSCTL_OFF))[u] = 0u;
    __syncthreads();
    XcdBarrier bar = xcd_barrier_post((unsigned*)(F.ctl + CW_BAR) + args.li * XCD_BAR_WORDS, F.MISC + 8);
    const int lo = args.ph_lo, hi = args.ph_hi;
#if TEST_MODE == 4
    unsigned long long* ts = (unsigned long long*)(args.ws + WS_CTL + 768 * 1024); int nst = 0;
#define STAMP() do { if (blockIdx.x == STAMP_BLK && threadIdx.x == 0) ts[nst] = __builtin_amdgcn_s_memrealtime(); ++nst; } while (0)
#if P3FINE
    F.ts = ts + 16; F.nst = 0;
#endif
#else
#define STAMP() do { } while (0)
#endif
    STAMP();
#define IN(k) (lo <= (k) && (k) < hi)
#define BOTH(k) (IN(k) && IN((k) + 1))
    if (IN(0)) { for (int rp_ = 0; rp_ < REP_P0; ++rp_) { p0_prologue(F); if (rp_ + 1 < REP_P0) __syncthreads(); } STAMP(); if (BOTH(0)) xcd_barrier(bar); STAMP(); }
    if (IN(1)) { for (int rp_ = 0; rp_ < REP_P1; ++rp_) p1_norm(F); STAMP(); if (BOTH(1)) xcd_barrier(bar); STAMP(); }
    if (IN(2)) {
        p2_sample(F);
        pg8::Gemm g{(const pg8::bf16_t*)(F.ws + WS_HB), (const pg8::bf16_t*)(F.ws + WS_WINT), MP, 3072, DM};
        pg8::StaticOrder S; S.init(MP, 3072, F.G, (int)blockIdx.x);
        pg8::EpiIn E{F.ws, F.out, F.qnw, F.knw};
        pg8::gemm_phase<pg8::EpiIn, pg8::StaticOrder, true, true>(F.lds + RING_OFF, g, S, E);
        STAMP(); if (BOTH(2)) xcd_barrier(bar); STAMP();
    }
#if HAVE_P3
    if (IN(3)) { p3_mixer(F); STAMP(); if (BOTH(3)) xcd_barrier(bar); STAMP(); }
#endif
    if (IN(4)) {
        pg8::Gemm g{(const pg8::bf16_t*)(F.ws + WS_MIX), (const pg8::bf16_t*)(F.ws + WS_WOUTT), MP, DM, DM};
        pg8::StaticOrder S; S.init(MP, DM, F.G, (int)blockIdx.x);
        pg8::EpiOut E{F.xp, F.out + O_YP, (const float*)(F.ws + WS_ADA)};
        pg8::gemm_phase<pg8::EpiOut, pg8::StaticOrder, true, true>(F.lds + RING_OFF, g, S, E);
        STAMP(); for (int rp_ = 0; rp_ < REP_P4S; ++rp_) p4_sample_out(F); STAMP();
    }
#undef IN
#undef BOTH
}

#if TEST_MODE && TEST_MODE < 4
namespace gold {
constexpr size_t W_ADA = 0, W_H = W_ADA + (size_t)NR * 3072, W_PROJ = W_H + (size_t)MT * 1024, W_SC = W_PROJ + (size_t)MT * NIN,
                 W_SCS = W_SC + (size_t)MP * 2048, W_SEL = W_SCS + (size_t)DECB * 2112, W_NSEL = W_SEL + (size_t)MT * 256, W_END = W_NSEL + MT;
constexpr size_t W_YT = W_H, W_MIX = W_SC, W_DB = W_SC + (size_t)MT * 1024;

__device__ __forceinline__ float wave_sum(float v) {
#pragma unroll
    for (int o = 1; o < 64; o <<= 1) v += __shfl_xor(v, o);
    return v;
}
__device__ __forceinline__ float wave_max(float v) {
#pragma unroll
    for (int o = 1; o < 64; o <<= 1) v = fmaxf(v, __shfl_xor(v, o));
    return v;
}
__device__ __forceinline__ float silu_f(float x) { return x / (1.f + expf(-x)); }

__global__ void __launch_bounds__(256) k_ada(const float* __restrict__ cp, const float* __restrict__ cs, const float* __restrict__ w_ada,
                                              const float* __restrict__ b_ada, float* __restrict__ ada) {
    const int j = blockIdx.x * 256 + threadIdx.x, r = blockIdx.y;
    const float* c = r < NB ? cp + (size_t)r * DM : cs + (size_t)(r - NB) * DM;
    float acc = 0.f;
    for (int k = 0; k < DM; ++k) { const float cv = c[k]; acc += silu_f(cv) * w_ada[(size_t)k * 3072 + j]; }
    ada[(size_t)r * 3072 + j] = acc + b_ada[j];
}

__global__ void __launch_bounds__(256) k_h(const float* __restrict__ xp, const float* __restrict__ xs, const float* __restrict__ norm_w,
                                            const float* __restrict__ ada, float* __restrict__ H) {
    const int m = blockIdx.x * 4 + (threadIdx.x >> 6), lane = threadIdx.x & 63;
    const float* x = m < MP ? xp + (size_t)m * DM : xs + (size_t)(m - MP) * DM;
    const int r = m < MP ? m / SEQ : NB + (m - MP);
    float v[16]; float ss = 0.f;
#pragma unroll
    for (int i = 0; i < 16; ++i) { v[i] = x[lane + 64 * i]; ss += v[i] * v[i]; }
    ss = wave_sum(ss);
    const float rstd = 1.0f / sqrtf(ss * (1.0f / DM) + 1e-6f);
#pragma unroll
    for (int i = 0; i < 16; ++i) { const int c = lane + 64 * i;
        H[(size_t)m * DM + c] = v[i] * rstd * norm_w[c] * (1.f + ada[(size_t)r * 3072 + 1024 + c]) + ada[(size_t)r * 3072 + c]; }
}

__global__ void __launch_bounds__(256) k_gemm(const float* __restrict__ A, const float* __restrict__ B, float* __restrict__ C,
                                               int M, int N, int K, int lda, int ldb, int ldc) {
    const int wave = threadIdx.x >> 6, lane = threadIdx.x & 63, r = lane & 31, h = lane >> 5;
    const int m0 = blockIdx.y * 128 + (wave >> 1) * 64, n0 = blockIdx.x * 128 + (wave & 1) * 64;
    f32x16 acc[2][2];
#pragma unroll
    for (int i = 0; i < 2; ++i)
#pragma unroll
        for (int j = 0; j < 2; ++j)
#pragma unroll
            for (int e = 0; e < 16; ++e) acc[i][j][e] = 0.f;
    const float* a0 = A + (size_t)(m0 + r) * lda + h;
    const float* a1 = a0 + (size_t)32 * lda;
    const int c0 = n0 + r, c1 = n0 + 32 + r; const bool v0 = c0 < N, v1 = c1 < N;
    const float* b0 = B + (size_t)h * ldb + (v0 ? c0 : 0);
    const float* b1 = B + (size_t)h * ldb + (v1 ? c1 : 0);
#pragma unroll 4
    for (int k = 0; k < K; k += 2) {
        const float x0 = a0[k], x1 = a1[k];
        float y0 = b0[(size_t)k * ldb], y1 = b1[(size_t)k * ldb];
        y0 = v0 ? y0 : 0.f; y1 = v1 ? y1 : 0.f;
        acc[0][0] = __builtin_amdgcn_mfma_f32_32x32x2f32(x0, y0, acc[0][0], 0, 0, 0);
        acc[0][1] = __builtin_amdgcn_mfma_f32_32x32x2f32(x0, y1, acc[0][1], 0, 0, 0);
        acc[1][0] = __builtin_amdgcn_mfma_f32_32x32x2f32(x1, y0, acc[1][0], 0, 0, 0);
        acc[1][1] = __builtin_amdgcn_mfma_f32_32x32x2f32(x1, y1, acc[1][1], 0, 0, 0);
    }
#pragma unroll
    for (int i = 0; i < 2; ++i)
#pragma unroll
        for (int j = 0; j < 2; ++j) { const int col = n0 + 32 * j + r;
            if (col < N) {
#pragma unroll
                for (int e = 0; e < 16; ++e) { const int row = m0 + 32 * i + (e & 3) + 8 * (e >> 2) + 4 * h; C[(size_t)row * ldc + col] = acc[i][j][e]; } } }
}

__global__ void __launch_bounds__(256) k_post(float* __restrict__ proj, const float* __restrict__ qnw, const float* __restrict__ knw,
                                               const float* __restrict__ state_pool, float* __restrict__ out) {
    const int m = blockIdx.x * 4 + (threadIdx.x >> 6), lane = threadIdx.x & 63;
    float* p = proj + (size_t)m * NIN;
    for (int hh = 0; hh < 8; ++hh) { const float v = p[CQ + hh * 64 + lane]; const float ss = wave_sum(v * v);
        p[CQ + hh * 64 + lane] = v * (1.0f / sqrtf(ss * (1.f / 64.f) + 1e-6f)) * qnw[lane]; }
    float* ko = m < MP ? out + O_KP + (size_t)m * 128 : out + O_KS + (size_t)(m - MP) * 128;
    float* vo = m < MP ? out + O_VP + (size_t)m * 128 : out + O_VS + (size_t)(m - MP) * 128;
    float* kio = m < MP ? out + O_KIP + (size_t)m * 64 : out + O_KIS + (size_t)(m - MP) * 64;
    for (int g = 0; g < 2; ++g) { const float v = p[CK + g * 64 + lane]; const float ss = wave_sum(v * v);
        const float kn = v * (1.0f / sqrtf(ss * (1.f / 64.f) + 1e-6f)) * knw[lane];
        p[CK + g * 64 + lane] = kn; ko[g * 64 + lane] = kn; vo[g * 64 + lane] = p[CV + g * 64 + lane]; }
    kio[lane] = p[CKI + lane];
    if (lane < 8) p[CWI + lane] *= 0.04419417382415922f;
    if (m < MP) { const int b = m / SEQ, t = m % SEQ;
        if (t >= SEQ - 15) { float* po = out + O_PP + ((size_t)b * 15 + (t - (SEQ - 15))) * 512;
            for (int c = lane; c < 512; c += 64) po[c] = p[CU + c]; }
    } else { const int s = m - MP; float* po = out + O_PS + (size_t)s * 15 * 512;
        for (int i = lane; i < 14 * 512; i += 64) po[i] = state_pool[(size_t)s * 15 * 512 + 512 + i];
        for (int c = lane; c < 512; c += 64) po[14 * 512 + c] = p[CU + c]; }
}

__global__ void __launch_bounds__(256) k_scores_p(const float* __restrict__ proj, float* __restrict__ SC) {
    __shared__ float qs[8][512]; __shared__ float wsm[8][8];
    const int b = blockIdx.y, t0 = blockIdx.x * 8, tid = threadIdx.x;
    for (int i = tid; i < 8 * 512; i += 256) qs[i >> 9][i & 511] = proj[(size_t)(b * SEQ + t0 + (i >> 9)) * NIN + CQI + (i & 511)];
    if (tid < 64) wsm[tid >> 3][tid & 7] = proj[(size_t)(b * SEQ + t0 + (tid >> 3)) * NIN + CWI + (tid & 7)];
    __syncthreads();
    for (int l = tid; l <= t0 + 7; l += 256) {
        float kr[64];
        const float4* kp = (const float4*)(proj + (size_t)(b * SEQ + l) * NIN + CKI);
#pragma unroll
        for (int i = 0; i < 16; ++i) { const float4 v = kp[i]; kr[4 * i] = v.x; kr[4 * i + 1] = v.y; kr[4 * i + 2] = v.z; kr[4 * i + 3] = v.w; }
        for (int q = 0; q < 8; ++q) {
            if (l > t0 + q) continue;
            float s = 0.f;
            for (int hh = 0; hh < 8; ++hh) { float d = 0.f;
#pragma unroll
                for (int e = 0; e < 64; ++e) d += qs[q][hh * 64 + e] * kr[e];
                s += wsm[q][hh] * fmaxf(d, 0.f); }
            SC[(size_t)(b * SEQ + t0 + q) * 2048 + l] = s;
        }
    }
}
__global__ void __launch_bounds__(256) k_scores_s(const float* __restrict__ proj, const float* __restrict__ cache_kidx, const int* __restrict__ page_table,
                                                   float* __restrict__ SCS) {
    __shared__ float qs[512]; __shared__ float wsm[8];
    const int s = blockIdx.x, tid = threadIdx.x; const float* prow = proj + (size_t)(MP + s) * NIN;
    for (int i = tid; i < 512; i += 256) qs[i] = prow[CQI + i];
    if (tid < 8) wsm[tid] = prow[CWI + tid];
    __syncthreads();
    for (int l = tid; l < PAST + 1; l += 256) {
        const float* kp_ = l < PAST ? cache_kidx + ((size_t)page_table[s * NPG + l / PAGE] * PAGE + (l % PAGE)) * 64 : prow + CKI;
        float kr[64];
#pragma unroll
        for (int i = 0; i < 64; ++i) kr[i] = kp_[i];
        float sc = 0.f;
        for (int hh = 0; hh < 8; ++hh) { float d = 0.f;
#pragma unroll
            for (int e = 0; e < 64; ++e) d += qs[hh * 64 + e] * kr[e];
            sc += wsm[hh] * fmaxf(d, 0.f); }
        SCS[(size_t)s * 2112 + l] = sc;
    }
}

__device__ __forceinline__ unsigned f2key(float f) { unsigned u = __float_as_uint(f); if (f == 0.0f) u = 0u; return (u & 0x80000000u) ? ~u : (u | 0x80000000u); }
__global__ void __launch_bounds__(256) k_topk(const float* __restrict__ SC, const float* __restrict__ SCS, int* __restrict__ SEL, int* __restrict__ NSEL) {
    const int m = blockIdx.x * 4 + (threadIdx.x >> 6), lane = threadIdx.x & 63;
    const float* src; int n;
    if (m < MP) { n = (m % SEQ) + 1; src = SC + (size_t)m * 2048; } else { n = PAST + 1; src = SCS + (size_t)(m - MP) * 2112; }
    int* sel = SEL + (size_t)m * 256;
    if (n <= 256) { for (int i = lane; i < n; i += 64) sel[i] = i; if (lane == 0) NSEL[m] = n; return; }
    unsigned key[33];
#pragma unroll
    for (int j = 0; j < 33; ++j) { const int l = j * 64 + lane; key[j] = l < n ? f2key(src[l]) : 0u; }
    unsigned T = 0u;
    for (int bit = 31; bit >= 0; --bit) { const unsigned cand = T | (1u << bit); int cnt = 0;
#pragma unroll
        for (int j = 0; j < 33; ++j) cnt += __popcll(__ballot(key[j] >= cand));
        if (cnt >= 256) T = cand; }
    int cgt = 0;
#pragma unroll
    for (int j = 0; j < 33; ++j) cgt += __popcll(__ballot(key[j] > T));
    const int need = 256 - cgt;
    const unsigned long long lt = (1ull << lane) - 1ull;
    int pos = 0, eq_seen = 0;
#pragma unroll
    for (int j = 0; j < 33; ++j) { const bool gt = key[j] > T, eq = key[j] == T;
        const unsigned long long meq = __ballot(eq); const int eqb = eq_seen + __popcll(meq & lt);
        const bool take = gt || (eq && eqb < need);
        const unsigned long long mt = __ballot(take);
        if (take) sel[pos + __popcll(mt & lt)] = j * 64 + lane;
        pos += __popcll(mt); eq_seen += __popcll(meq); }
    if (lane == 0) NSEL[m] = 256;
}

__global__ void __launch_bounds__(256) k_attn(const float* __restrict__ proj, const float* __restrict__ cache_k, const float* __restrict__ cache_v,
                                               const int* __restrict__ page_table, const int* __restrict__ SEL, const int* __restrict__ NSEL, float* __restrict__ MIX) {
    __shared__ float pl[4][8][256]; __shared__ int il[4][256]; __shared__ float ql[4][512];
    const int w = threadIdx.x >> 6, lane = threadIdx.x & 63, m = blockIdx.x * 4 + w;
    const int nsel = NSEL[m]; const float* prow = proj + (size_t)m * NIN;
    const bool prompt = m < MP; const int b = m / SEQ, s = m - MP;
    for (int i = lane; i < 512; i += 64) ql[w][i] = prow[CQ + i];
    for (int i = lane; i < 256; i += 64) {
        if (i < nsel) { const int l = SEL[(size_t)m * 256 + i]; il[w][i] = l;
            const float* krow = prompt ? proj + (size_t)(b * SEQ + l) * NIN + CK
                                       : (l < PAST ? cache_k + ((size_t)page_table[s * NPG + l / PAGE] * PAGE + (l % PAGE)) * 128 : prow + CK);
            for (int g = 0; g < 2; ++g) { float kr[64];
#pragma unroll
                for (int e = 0; e < 64; ++e) kr[e] = krow[g * 64 + e];
                for (int r = 0; r < 4; ++r) { float d = 0.f;
#pragma unroll
                    for (int e = 0; e < 64; ++e) d += ql[w][(g * 4 + r) * 64 + e] * kr[e];
                    pl[w][g * 4 + r][i] = d * 0.125f; } }
        } else { il[w][i] = 0; for (int hh = 0; hh < 8; ++hh) pl[w][hh][i] = -INFINITY; }
    }
    for (int hh = 0; hh < 8; ++hh) { float v[4]; float mx = -INFINITY;
#pragma unroll
        for (int i = 0; i < 4; ++i) { v[i] = pl[w][hh][lane + 64 * i]; mx = fmaxf(mx, v[i]); }
        mx = wave_max(mx); float sm = 0.f;
#pragma unroll
        for (int i = 0; i < 4; ++i) { v[i] = expf(v[i] - mx); sm += v[i]; }
        sm = wave_sum(sm); const float inv = 1.0f / sm;
#pragma unroll
        for (int i = 0; i < 4; ++i) pl[w][hh][lane + 64 * i] = v[i] * inv; }
    for (int g = 0; g < 2; ++g) { float acc[4] = {0.f, 0.f, 0.f, 0.f};
        for (int i = 0; i < nsel; ++i) { const int l = il[w][i];
            const float* vrow = prompt ? proj + (size_t)(b * SEQ + l) * NIN + CV
                                       : (l < PAST ? cache_v + ((size_t)page_table[s * NPG + l / PAGE] * PAGE + (l % PAGE)) * 128 : prow + CV);
            const float vv = vrow[g * 64 + lane];
#pragma unroll
            for (int r = 0; r < 4; ++r) acc[r] += pl[w][g * 4 + r][i] * vv; }
#pragma unroll
        for (int r = 0; r < 4; ++r) { const int c = (g * 4 + r) * 64 + lane; MIX[(size_t)m * 1024 + c] = acc[r] * silu_f(prow[CGA + c]); } }
}

__global__ void __launch_bounds__(256) k_pool_d(const float* __restrict__ proj, const float* __restrict__ state_pool, float* __restrict__ DB) {
    const size_t idx = (size_t)blockIdx.x * 256 + threadIdx.x; const int m = (int)(idx >> 9), c = (int)(idx & 511);
    const int g = c >> 7, w = 2 << g; const float un = proj[(size_t)m * NIN + CU + c]; float sum = un; float cnt;
    if (m < MP) { const int t = m % SEQ; for (int i = 1; i < w; ++i) if (t - i >= 0) sum += proj[(size_t)(m - i) * NIN + CU + c]; cnt = (float)(t + 1 < w ? t + 1 : w); }
    else { const int s = m - MP; for (int i = 1; i < w; ++i) sum += state_pool[((size_t)s * 15 + (15 - i)) * 512 + c]; cnt = (float)w; }
    DB[idx] = sum / cnt - un;
}
__global__ void __launch_bounds__(256) k_pool_out(const float* __restrict__ proj, const float* __restrict__ DB, const float* __restrict__ w_pool,
                                                   const float* __restrict__ pool_scale, float* __restrict__ MIX) {
    const size_t idx = (size_t)blockIdx.x * 256 + threadIdx.x; const int m = (int)(idx >> 9), col = (int)(idx & 511), g = col >> 7, j = col & 127;
    float acc = 0.f;
    for (int c = 0; c < 128; ++c) acc += DB[(size_t)m * 512 + g * 128 + c] * w_pool[((size_t)g * 128 + c) * 128 + j];
    MIX[(size_t)m * 1024 + 512 + col] = acc * pool_scale[col] * silu_f(proj[(size_t)m * NIN + CGP + col]);
}
__global__ void __launch_bounds__(256) k_final(const float* __restrict__ xp, const float* __restrict__ xs, const float* __restrict__ ada,
                                                const float* __restrict__ YT, float* __restrict__ out) {
    const size_t idx = (size_t)blockIdx.x * 256 + threadIdx.x; const int m = (int)(idx >> 10), c = (int)(idx & 1023);
    const int r = m < MP ? m / SEQ : NB + (m - MP);
    const float x = m < MP ? xp[idx] : xs[idx - (size_t)MP * 1024];
    float* o = m < MP ? out + O_YP + idx : out + O_YS + (idx - (size_t)MP * 1024);
    *o = x + ada[(size_t)r * 3072 + 2048 + c] * YT[idx];
}

}
#endif

#if TEST_MODE
__global__ void __launch_bounds__(256) k_cmp(const void* a, int a_bf16, int lda, const float* ref, int ldr, int rows, int cols, float scale, int act, float* accum) {
    __shared__ float sd[256], sr[256];
    const size_t idx = (size_t)blockIdx.x * 256 + threadIdx.x; float d2 = 0.f, r2 = 0.f;
    if (idx < (size_t)rows * cols) { const size_t r = idx / cols, c = idx % cols;
        const float av = a_bf16 ? bf2f(((const bf16*)a)[r * lda + c]) : ((const float*)a)[r * lda + c];
        float rv = ref[r * ldr + c]; if (act) rv = rv / (1.f + expf(-rv)); rv *= scale;
        d2 = (av - rv) * (av - rv); r2 = rv * rv; if (!(d2 == d2)) d2 = 1e30f; }
    sd[threadIdx.x] = d2; sr[threadIdx.x] = r2; __syncthreads();
    for (int s = 128; s > 0; s >>= 1) { if ((int)threadIdx.x < s) { sd[threadIdx.x] += sd[threadIdx.x + s]; sr[threadIdx.x] += sr[threadIdx.x + s]; } __syncthreads(); }
    if (threadIdx.x == 0) { atomicAdd(accum, sd[0]); atomicAdd(accum + 1, sr[0]); }
}
__global__ void __launch_bounds__(256) k_cmp_sel(const int* SEL, const int* NSEL, const unsigned* bmdump, float* accum) {
    __shared__ float sd[256], sr[256];
    const size_t idx = (size_t)blockIdx.x * 256 + threadIdx.x; const int m = (int)(idx >> 8), i = (int)(idx & 255); float miss = 0.f, tot = 0.f;
    if (m < MP && i < NSEL[m]) { const int l = SEL[(size_t)m * 256 + i]; tot = 1.f; if (!((bmdump[(size_t)m * 64 + (l >> 5)] >> (l & 31)) & 1u)) miss = 1.f; }
    sd[threadIdx.x] = miss; sr[threadIdx.x] = tot; __syncthreads();
    for (int s = 128; s > 0; s >>= 1) { if ((int)threadIdx.x < s) { sd[threadIdx.x] += sd[threadIdx.x + s]; sr[threadIdx.x] += sr[threadIdx.x + s]; } __syncthreads(); }
    if (threadIdx.x == 0) { atomicAdd(accum, sd[0]); atomicAdd(accum + 1, sr[0]); }
}
__global__ void k_cmp_fin2(float* accum, int n, float amp) {
    float best = -1.f; int bi = 0;
    for (int k = 0; k < n; ++k) { const float rel = accum[2 * k] / fmaxf(accum[2 * k + 1], 1e-30f) / accum[32 + k]; if (rel > best) { best = rel; bi = k; } }
    accum[64] = sqrtf(amp * best); accum[65] = (float)bi;
}
__global__ void k_set(float* p, float a, float b, float c, float d, float e) { p[0] = a; p[1] = b; p[2] = c; p[3] = d; p[4] = e; }
__global__ void k_cmp_fin(float* accum, int n, float amp) {
    float best = -1.f; int bi = 0;
    for (int k = 0; k < n; ++k) { const float rel = accum[2 * k] / fmaxf(accum[2 * k + 1], 1e-30f); if (rel > best) { best = rel; bi = k; } }
    accum[64] = sqrtf(amp * best); accum[65] = (float)bi;
}
__global__ void __launch_bounds__(256) k_perturb(float* out, const float* accum) {
    const size_t offs[11] = {O_YP, O_YS, O_KP, O_VP, O_KIP, O_PP, O_KS, O_VS, O_KIS, O_PS, O_END};
    const int k = (int)accum[65] % 10; const float f = 1.0f + accum[64];
    for (size_t i = offs[k] + (size_t)blockIdx.x * 256 + threadIdx.x; i < offs[k + 1]; i += (size_t)gridDim.x * 256) out[i] *= f;
}
__global__ void __launch_bounds__(256) k_f32_to_bf16(const float* src, bf16* dst, size_t n) {
    for (size_t i = (size_t)blockIdx.x * 256 + threadIdx.x; i < n; i += (size_t)gridDim.x * 256) dst[i] = (bf16)f2bf(src[i]);
}
#endif

#if TEST_MODE == 5
__global__ void __launch_bounds__(256) k_stat(float* out, const unsigned* st, int which) {
    float v = which == 0 ? (float)st[0] : (which == 1 ? (float)st[1] / fmaxf((float)st[2], 1.f) : (float)st[3]);
    const float f = 1.0f + sqrtf(v * 1e-5f);
    for (size_t i = O_KS + (size_t)blockIdx.x * 256 + threadIdx.x; i < O_VS; i += (size_t)gridDim.x * 256) out[i] *= f;
}
#endif
#if TEST_MODE == 4
__global__ void __launch_bounds__(256) k_time(float* out, const unsigned long long* ts, int i0, int i1, float scale) {
    const float us = (float)(ts[i1] - ts[i0]) * 0.01f; const float f = 1.0f + sqrtf(us * scale);
    for (size_t i = O_KS + (size_t)blockIdx.x * 256 + threadIdx.x; i < O_VS; i += (size_t)gridDim.x * 256) out[i] *= f;
}
#endif
extern "C" void kernel_launch(void* const* d_in, const int* in_sizes, int n_in, void* d_out, int out_size, void* d_ws, size_t ws_size, hipStream_t stream) {
    static int grid = 0;
    if (grid == 0) {
        size_t need = WS_MEGA_END;
#if TEST_MODE && TEST_MODE < 4
        need = 192 * MiB + gold::W_END * 4;
#endif
        if (n_in != 18 || out_size != (int)O_END || ws_size < need) { fprintf(stderr, "kernel_launch: unexpected sizes: n_in %d out %d ws %zu (need %zu)\n", n_in, out_size, ws_size, need); grid = -1; return; }
        int dev = 0, cus = 0, per_cu = 0;
        if (hipGetDevice(&dev) != hipSuccess || hipDeviceGetAttribute(&cus, hipDeviceAttributeMultiprocessorCount, dev) != hipSuccess) { grid = -1; return; }
        if (hipFuncSetAttribute((const void*)mk_fwd, hipFuncAttributeMaxDynamicSharedMemorySize, LDS_BYTES) != hipSuccess) { fprintf(stderr, "kernel_launch: hipFuncSetAttribute failed\n"); grid = -1; return; }
        if (hipOccupancyMaxActiveBlocksPerMultiprocessor(&per_cu, (const void*)mk_fwd, NWAVES * 64, LDS_BYTES) != hipSuccess || per_cu < 1) { fprintf(stderr, "kernel_launch: occupancy query says %d blocks/CU\n", per_cu); (void)hipGetLastError(); grid = -1; return; }
        if (cus < 64) { fprintf(stderr, "kernel_launch: needs >= 64 CUs\n"); grid = -1; return; }
        grid = cus;
    }
    if (grid < 0) return;
    (void)hipMemsetAsync((char*)d_ws + WS_CTL, 0, CTL_ZERO_BYTES, stream);
    Args a{};
    for (int i = 0; i < 18; ++i) a.in[i] = (const float*)d_in[i];
    a.out = (float*)d_out; a.ws = (unsigned char*)d_ws;
#if TEST_MODE == 5
    a.ph_lo = 0; a.ph_hi = 5; a.li = 0;
    hipLaunchKernelGGL(mk_fwd, dim3(grid), dim3(NWAVES * 64), LDS_BYTES, stream, a);
    k_stat<<<16, 256, 0, stream>>>((float*)d_out, (const unsigned*)((char*)d_ws + WS_CTL + 900 * 1024), STATSEL);
#elif TEST_MODE == 4
    a.ph_lo = 0; a.ph_hi = 5; a.li = 0;
    hipLaunchKernelGGL(mk_fwd, dim3(grid), dim3(NWAVES * 64), LDS_BYTES, stream, a);
    k_time<<<16, 256, 0, stream>>>((float*)d_out, (const unsigned long long*)((char*)d_ws + WS_CTL + 768 * 1024), TS0, TS1, 1e-5f);
#elif TEST_MODE && TEST_MODE < 4
    {
        using namespace gold;
        const float* xp = (const float*)d_in[0]; const float* xs = (const float*)d_in[1];
        const float* cache_k = (const float*)d_in[2]; const float* cache_v = (const float*)d_in[3]; const float* cache_kidx = (const float*)d_in[4];
        const float* state_pool = (const float*)d_in[5]; const int* page_table = (const int*)d_in[6];
        const float* cp = (const float*)d_in[7]; const float* cs = (const float*)d_in[8]; const float* norm_w = (const float*)d_in[9];
        const float* w_ada = (const float*)d_in[10]; const float* b_ada = (const float*)d_in[11]; const float* w_in = (const float*)d_in[12];
        const float* qnw = (const float*)d_in[13]; const float* knw = (const float*)d_in[14]; const float* w_pool = (const float*)d_in[15];
        const float* pool_scale = (const float*)d_in[16]; const float* w_out = (const float*)d_in[17];
        float* out = (float*)d_out; float* ws = (float*)((char*)d_ws + 192 * MiB);
        float *ADA = ws + W_ADA, *H = ws + W_H, *PROJ = ws + W_PROJ, *SC = ws + W_SC, *SCS = ws + W_SCS, *MIX = ws + W_MIX, *DB = ws + W_DB, *YT = ws + W_YT;
        int *SEL = (int*)(ws + W_SEL), *NSEL = (int*)(ws + W_NSEL);
        k_ada<<<dim3(12, NR), 256, 0, stream>>>(cp, cs, w_ada, b_ada, ADA);
        k_h<<<MT / 4, 256, 0, stream>>>(xp, xs, norm_w, ADA, H);
        k_gemm<<<dim3((NIN + 127) / 128, MT / 128), 256, 0, stream>>>(H, w_in, PROJ, MT, NIN, DM, DM, NIN, NIN);
        k_post<<<MT / 4, 256, 0, stream>>>(PROJ, qnw, knw, state_pool, out);
        k_scores_p<<<dim3(SEQ / 8, NB), 256, 0, stream>>>(PROJ, SC);
        k_scores_s<<<DECB, 256, 0, stream>>>(PROJ, cache_kidx, page_table, SCS);
        k_topk<<<MT / 4, 256, 0, stream>>>(SC, SCS, SEL, NSEL);
        k_attn<<<MT / 4, 256, 0, stream>>>(PROJ, cache_k, cache_v, page_table, SEL, NSEL, MIX);
        k_pool_d<<<(MT * 512) / 256, 256, 0, stream>>>(PROJ, state_pool, DB);
        k_pool_out<<<(MT * 512) / 256, 256, 0, stream>>>(PROJ, DB, w_pool, pool_scale, MIX);
        k_gemm<<<dim3(1024 / 128, MT / 128), 256, 0, stream>>>(MIX, w_out, YT, MT, 1024, 1024, 1024, 1024, 1024);
        k_final<<<(MT * 1024) / 256, 256, 0, stream>>>(xp, xs, ADA, YT, out);
        unsigned char* mws = (unsigned char*)d_ws;
#if TEST_MODE == 1
        a.ph_lo = 0; a.ph_hi = 3; a.li = 0;
        hipLaunchKernelGGL(mk_fwd, dim3(grid), dim3(NWAVES * 64), LDS_BYTES, stream, a);
        float* accum = (float*)(mws + WS_CTL + 512 * 1024);
        struct { const void* a; int bf; int lda; int refcol; int cols; float scale; int act; } L[9] = {
            {mws + WS_Q, 1, 512, CQ, 512, C2, 0}, {mws + WS_QI, 1, 512, CQI, 512, 1.f, 0}, {mws + WS_GA, 1, 512, CGA, 512, 1.f, 1}, {mws + WS_U, 1, 512, CU, 512, 1.f, 0},
            {mws + WS_GP, 1, 512, CGP, 512, 1.f, 1}, {mws + WS_KB, 1, 128, CK, 128, 1.f, 0}, {mws + WS_VB, 1, 128, CV, 128, 1.f, 0}, {mws + WS_KI, 1, 64, CKI, 64, 1.f, 0},
            {mws + WS_WI, 0, 8, CWI, 8, 1.f, 0} };
        for (int k = 0; k < 9; ++k) k_cmp<<<(unsigned)(((size_t)MT * L[k].cols + 255) / 256), 256, 0, stream>>>(L[k].a, L[k].bf, L[k].lda, PROJ + L[k].refcol, NIN, MT, L[k].cols, L[k].scale, L[k].act, accum + 2 * k);
        k_cmp<<<(NR * 3072 + 255) / 256, 256, 0, stream>>>(mws + WS_ADA, 0, 3072, ADA, 3072, NR, 3072, 1.f, 0, accum + 18);
        k_cmp_fin<<<1, 1, 0, stream>>>(accum, 10, 5.0f);
        k_perturb<<<1024, 256, 0, stream>>>(out, accum);
#elif TEST_MODE == 3
        a.ph_lo = 0; a.ph_hi = 5; a.li = 0;
        hipLaunchKernelGGL(mk_fwd, dim3(grid), dim3(NWAVES * 64), LDS_BYTES, stream, a);
        float* accum = (float*)(mws + WS_CTL + 512 * 1024);
        const bf16* MB = (const bf16*)(mws + WS_MIX);
        k_cmp<<<(unsigned)(((size_t)MP * 512 + 255) / 256), 256, 0, stream>>>(MB, 1, 1024, MIX, 1024, MP, 512, 1.f, 0, accum + 0);
        k_cmp<<<(unsigned)(((size_t)MP * 512 + 255) / 256), 256, 0, stream>>>(MB + 512, 1, 1024, MIX + 512, 1024, MP, 512, 1.f, 0, accum + 2);
        k_cmp<<<(DECB * 512 + 255) / 256, 256, 0, stream>>>(MB + (size_t)MP * 1024, 1, 1024, MIX + (size_t)MP * 1024, 1024, DECB, 512, 1.f, 0, accum + 4);
        k_cmp<<<(DECB * 512 + 255) / 256, 256, 0, stream>>>(MB + (size_t)MP * 1024 + 512, 1, 1024, MIX + (size_t)MP * 1024 + 512, 1024, DECB, 512, 1.f, 0, accum + 6);
        k_cmp_sel<<<MP, 256, 0, stream>>>(SEL, NSEL, (const unsigned*)(mws + WS_DBG_BM), accum + 8);
        k_set<<<1, 1, 0, stream>>>(accum + 32, P3_TOL0, P3_TOL1, P3_TOL2, P3_TOL3, P3_TOL4);
        k_cmp_fin2<<<1, 1, 0, stream>>>(accum, 5, 1e-5f);
        k_perturb<<<1024, 256, 0, stream>>>(out, accum);
#elif TEST_MODE == 2
        a.ph_lo = 0; a.ph_hi = 3; a.li = 0;
        hipLaunchKernelGGL(mk_fwd, dim3(grid), dim3(NWAVES * 64), LDS_BYTES, stream, a);
        k_f32_to_bf16<<<2048, 256, 0, stream>>>(MIX, (bf16*)(mws + WS_MIX), (size_t)MT * 1024);
        a.ph_lo = 4; a.ph_hi = 5; a.li = 1;
        hipLaunchKernelGGL(mk_fwd, dim3(grid), dim3(NWAVES * 64), LDS_BYTES, stream, a);
#endif
    }
#else
    a.ph_lo = 0; a.ph_hi = 5; a.li = 0;
    hipLaunchKernelGGL(mk_fwd, dim3(grid), dim3(NWAVES * 64), LDS_BYTES, stream, a);
#endif
}
```

```cpp
#define TEST_MODE 0
#define HAVE_P3 1
#define REP_S1 1
#define REP_S2 1
#define REP_S4 1
#define REP_P0 1
#define REP_P1 1
#define REP_P4S 1
#define STATSEL 0
#define STAMP_BLK 0
#define P3FINE 0
#define TS0 0
#define TS1 1
#define P3_TOL0 1e-2f
#define P3_TOL1 1e-4f
#define P3_TOL2 1e-2f
#define P3_TOL3 1e-4f
#define P3_TOL4 3e-2f
#include <hip/hip_runtime.h>
#include <cstdio>
#include <cstdint>

constexpr int DM = 1024, NB = 8, SEQ = 2048, DECB = 128, PAST = 2048, PAGE = 128, NPG = 16;
constexpr int NIN = 2888, MP = NB * SEQ, MT = MP + DECB, NR = NB + DECB;
constexpr int CQ = 0, CK = 512, CV = 640, CQI = 768, CKI = 1280, CWI = 1344, CGA = 1352, CU = 1864, CGP = 2376;
constexpr size_t O_YP = 0, O_YS = 16777216, O_KP = 16908288, O_VP = 19005440, O_KIP = 21102592, O_PP = 22151168,
                 O_KS = 22212608, O_VS = 22228992, O_KIS = 22245376, O_PS = 22253568, O_END = 23236608;
constexpr float C2 = 0.125f * 1.4426950408889634f;
constexpr float WI_SCALE = 0.04419417382415922f;
constexpr float EPS = 1e-6f;
constexpr size_t MiB = 1u << 20;
constexpr size_t WS_CTL = 0, CTL_ZERO_BYTES = 1 * MiB;
constexpr size_t WS_ADA = 1 * MiB, WS_WINT = 3 * MiB, WS_WOUTT = 9 * MiB, WS_WPOOLT = 11 * MiB, WS_HS = 12 * MiB, WS_HB = 24 * MiB,
                 WS_Q = 56 * MiB, WS_QI = 73 * MiB, WS_GA = 90 * MiB, WS_U = 107 * MiB, WS_GP = 124 * MiB, WS_KB = 141 * MiB, WS_VB = 146 * MiB,
                 WS_KI = 151 * MiB, WS_WI = 154 * MiB, WS_MIX = 155 * MiB, WS_DBG_BM = 188 * MiB, WS_MEGA_END = 192 * MiB;
namespace pg8 {
#define PG8_LAS __attribute__((address_space(3)))
typedef unsigned short bf16_t;
typedef short bf16x8 __attribute__((ext_vector_type(8)));
typedef float f32x4 __attribute__((ext_vector_type(4)));
typedef unsigned u32x4 __attribute__((ext_vector_type(4)));
constexpr int BM = 256, BK = 64, HALF = 128, HTB = HALF * BK * 2  , STAGE_BYTES = 8 * HTB, NXCD = 8, WGM = 8;

__host__ __device__ __forceinline__ int lds_byte(int r, int c) { const int st = (r >> 4) * 2 + (c >> 5), rr = r & 15, cc = c & 31, ob = rr * 64 + cc * 2; return st * 1024 + (ob ^ (((ob >> 9) & 1) << 5)); }
__host__ __device__ __forceinline__ void stage_rc(int b, int& R, int& C) { const int st = b / 1024, sb = b % 1024, swz = sb ^ (((sb >> 9) & 1) << 5); R = (st >> 1) * 16 + swz / 64; C = (st & 1) * 32 + (swz % 64) / 2; }
__host__ __device__ __forceinline__ int perm32(int rho) { const int n = rho >> 4, i = rho & 15; return 8 * (i >> 2) + 4 * n + (i & 3); }

struct Unit { int pm, pn; };
struct Gemm { const bf16_t* A; const bf16_t* Bt; int M, N, K; };

struct StaticOrder {
    int nM, nN, nwg, G, c;
    __host__ __device__ void init(int M, int N, int G_, int c_) { nM = M / BM; nN = N / BM; nwg = nM * nN; G = G_; c = c_; }
    __host__ __device__ bool next(int i, Unit& u) const {
        const long L = (long)i * G + c; if (L >= nwg) return false;
        int wgid = (int)L; { const int q = nwg / NXCD, r = nwg % NXCD, xcd = wgid % NXCD, off = wgid / NXCD; wgid = (xcd < r ? xcd * (q + 1) : r * (q + 1) + (xcd - r) * q) + off; }
        const int nig = WGM * nN, gid = wgid / nig, fm = gid * WGM, gsz = (nM - fm) < WGM ? (nM - fm) : WGM;
        u.pm = fm + ((wgid % nig) % gsz); u.pn = (wgid % nig) / gsz; return true;
    }
    __device__ __forceinline__ void a_ready(const Unit&) const {}
    __device__ __forceinline__ void done(const Unit&) const {}
};


typedef unsigned u32x4 __attribute__((ext_vector_type(4)));
__device__ __forceinline__ unsigned cvt_pk_bf16(float lo, float hi) { unsigned r; asm volatile("v_cvt_pk_bf16_f32 %0, %1, %2" : "=v"(r) : "v"(lo), "v"(hi)); return r; }
__device__ __forceinline__ void st_bf16x8(bf16_t* p, const f32x4 a, const f32x4 b) {
    u32x4 w; w.x = cvt_pk_bf16(a[0], a[1]); w.y = cvt_pk_bf16(a[2], a[3]); w.z = cvt_pk_bf16(b[0], b[1]); w.w = cvt_pk_bf16(b[2], b[3]); *(u32x4*)p = w; }
__device__ __forceinline__ float silu1(float x) { return x * __builtin_amdgcn_rcpf(1.0f + __builtin_amdgcn_exp2f(-1.4426950408889634f * x)); }
__device__ __forceinline__ f32x4 silu4(const f32x4 v) { f32x4 r; r[0] = silu1(v[0]); r[1] = silu1(v[1]); r[2] = silu1(v[2]); r[3] = silu1(v[3]); return r; }

struct EpiIn {
    static constexpr bool PERM = true, AFTER_DRAIN = false;
    unsigned char* ws; float* out; const float* qnw; const float* knw;
    __device__ __forceinline__ void operator()(const f32x4 (&acc)[2][2][4][2], const Unit& u, int wr, int wc, int fr, int fq) const {
        const int pn = u.pn;
        if (pn == 5 && wc >= 2) return;
        const int rowb = u.pm * 256 + wr * 64 + fr, dof = 8 * fq;
        if (pn <= 1 || (pn == 2 && wc < 2)) {
            const float* nwp = pn <= 1 ? qnw : knw; const float sc = pn <= 1 ? C2 : 1.0f;
            f32x4 wv[2][2];
#pragma unroll
            for (int bj = 0; bj < 2; ++bj)
#pragma unroll
                for (int n = 0; n < 2; ++n) wv[bj][n] = *(const f32x4*)(nwp + 32 * bj + dof + 4 * n) * sc;
#pragma unroll
            for (int ai = 0; ai < 2; ++ai)
#pragma unroll
                for (int m = 0; m < 4; ++m) { const size_t row = (size_t)(rowb + ai * 128 + m * 16); float ss = 0.f;
#pragma unroll
                    for (int bj = 0; bj < 2; ++bj)
#pragma unroll
                        for (int n = 0; n < 2; ++n) { const f32x4 x = acc[ai][bj][m][n]; ss += (x[0] * x[0] + x[1] * x[1]) + (x[2] * x[2] + x[3] * x[3]); }
                    ss += __shfl_xor(ss, 16); ss += __shfl_xor(ss, 32);
                    const float rstd = 1.0f / sqrtf(ss * (1.0f / 64.0f) + EPS);
                    f32x4 o[2][2];
#pragma unroll
                    for (int bj = 0; bj < 2; ++bj)
#pragma unroll
                        for (int n = 0; n < 2; ++n) o[bj][n] = acc[ai][bj][m][n] * rstd * wv[bj][n];
                    if (pn <= 1) { bf16_t* q = (bf16_t*)(ws + WS_Q) + row * 512 + (4 * pn + wc) * 64 + dof; st_bf16x8(q, o[0][0], o[0][1]); st_bf16x8(q + 32, o[1][0], o[1][1]); }
                    else { float* ko = out + O_KP + row * 128 + wc * 64 + dof; *(f32x4*)ko = o[0][0]; *(f32x4*)(ko + 4) = o[0][1]; *(f32x4*)(ko + 32) = o[1][0]; *(f32x4*)(ko + 36) = o[1][1];
                        bf16_t* kb = (bf16_t*)(ws + WS_KB) + row * 128 + wc * 64 + dof; st_bf16x8(kb, o[0][0], o[0][1]); st_bf16x8(kb + 32, o[1][0], o[1][1]); } }
            return;
        }
        if (pn == 5 && wc == 1) {
            if (fq == 0) {
#pragma unroll
                for (int ai = 0; ai < 2; ++ai)
#pragma unroll
                    for (int m = 0; m < 4; ++m) { const size_t row = (size_t)(rowb + ai * 128 + m * 16); float* wp = (float*)(ws + WS_WI) + row * 8;
                        *(f32x4*)wp = acc[ai][0][m][0] * WI_SCALE; *(f32x4*)(wp + 4) = acc[ai][0][m][1] * WI_SCALE; } }
            return;
        }
        bf16_t* dst; int ld, cb; float* fo = nullptr; int fld = 0; bool act = false;
        if (pn == 2) { dst = (bf16_t*)(ws + WS_VB); ld = 128; cb = (wc - 2) * 64; fo = out + O_VP + cb; fld = 128; }
        else if (pn <= 4) { dst = (bf16_t*)(ws + WS_QI); ld = 512; cb = (4 * (pn - 3) + wc) * 64; }
        else if (pn == 5) { dst = (bf16_t*)(ws + WS_KI); ld = 64; cb = 0; fo = out + O_KIP; fld = 64; }
        else if (pn <= 7) { dst = (bf16_t*)(ws + WS_GA); ld = 512; cb = (4 * (pn - 6) + wc) * 64; act = true; }
        else if (pn <= 9) { dst = (bf16_t*)(ws + WS_U); ld = 512; cb = (4 * (pn - 8) + wc) * 64; }
        else { dst = (bf16_t*)(ws + WS_GP); ld = 512; cb = (4 * (pn - 10) + wc) * 64; act = true; }
        const bool is_u = (pn == 8 || pn == 9);
#pragma unroll
        for (int ai = 0; ai < 2; ++ai)
#pragma unroll
            for (int m = 0; m < 4; ++m) { const int rowi = rowb + ai * 128 + m * 16; const size_t row = (size_t)rowi;
                f32x4 o00 = acc[ai][0][m][0], o01 = acc[ai][0][m][1], o10 = acc[ai][1][m][0], o11 = acc[ai][1][m][1];
                if (act) { o00 = silu4(o00); o01 = silu4(o01); o10 = silu4(o10); o11 = silu4(o11); }
                bf16_t* d = dst + row * ld + cb + dof; st_bf16x8(d, o00, o01); st_bf16x8(d + 32, o10, o11);
                if (fo) { float* f = fo + row * fld + dof; *(f32x4*)f = o00; *(f32x4*)(f + 4) = o01; *(f32x4*)(f + 32) = o10; *(f32x4*)(f + 36) = o11; }
                if (is_u) { const int t = rowi & (SEQ - 1);
                    if (t >= SEQ - 15) { float* f = out + O_PP + ((size_t)(rowi >> 11) * 15 + (t - (SEQ - 15))) * 512 + cb + dof;
                        *(f32x4*)f = o00; *(f32x4*)(f + 4) = o01; *(f32x4*)(f + 32) = o10; *(f32x4*)(f + 36) = o11; } } }
    }
};
struct EpiOut {
    static constexpr bool PERM = true, AFTER_DRAIN = false;
    const float* x; float* y; const float* ada;
    __device__ __forceinline__ void operator()(const f32x4 (&acc)[2][2][4][2], const Unit& u, int wr, int wc, int fr, int fq) const {
        const int col0 = u.pn * 256 + wc * 32 + 8 * fq; const float* gp = ada + (size_t)(u.pm >> 3) * 3072 + 2048 + col0;
        f32x4 g[2][2];
#pragma unroll
        for (int bj = 0; bj < 2; ++bj)
#pragma unroll
            for (int n = 0; n < 2; ++n) g[bj][n] = *(const f32x4*)(gp + 128 * bj + 4 * n);
#pragma unroll
        for (int ai = 0; ai < 2; ++ai)
#pragma unroll
            for (int m = 0; m < 4; ++m) { const size_t off = (size_t)(u.pm * 256 + ai * 128 + wr * 64 + m * 16 + fr) * 1024 + col0;
#pragma unroll
                for (int bj = 0; bj < 2; ++bj)
#pragma unroll
                    for (int n = 0; n < 2; ++n) { const f32x4 xv = *(const f32x4*)(x + off + 128 * bj + 4 * n); *(f32x4*)(y + off + 128 * bj + 4 * n) = xv + g[bj][n] * acc[ai][bj][m][n]; } }
    }
};
template <class Epi, class Sched, bool ALIGN_EPI = false, bool SP2 = false>
__device__ __forceinline__ void gemm_phase(PG8_LAS unsigned char* lds, const Gemm g, const Sched& S, const Epi& E) {
    const int tid = threadIdx.x, wid = __builtin_amdgcn_readfirstlane(tid >> 6), lane = tid & 63, wr = wid >> 2, wc = wid & 3, fr = lane & 15, fq = lane >> 4;
    const int K = g.K, nt = K / BK;
    unsigned voffA[2], voffB[2];
#pragma unroll
    for (int i = 0; i < 2; ++i) { int R, C; stage_rc(tid * 16 + i * 8192, R, C); const int Rb = Epi::PERM ? ((R & ~31) + perm32(R & 31)) : R;
        voffA[i] = (unsigned)(R * K + C) * 2u; voffB[i] = (unsigned)(Rb * K + C) * 2u; }
    const size_t kstep = (size_t)(BK * 2);
    const size_t hstep = (size_t)HALF * K * 2;
    const size_t tstep = 2 * hstep;
    const unsigned ldsw = (unsigned)wid * 1024u;
    const int aoff = lds_byte(wr * 64 + fr, fq * 8), boff = lds_byte(wc * 32 + fr, fq * 8);
#define PG8_SA(b, h) (((b) * 2 + (h)) * HTB)
#define PG8_SB(b, h) ((4 + (b) * 2 + (h)) * HTB)
#define PG8_STAGE(bufoff, gbase, voff) do { _Pragma("unroll") for (int _i = 0; _i < 2; ++_i) \
        __builtin_amdgcn_global_load_lds((const unsigned*)((const char*)(gbase) + (voff)[_i]), (PG8_LAS unsigned*)(lds + (bufoff) + ldsw + _i * 8192), 16, 0, 0); } while (0)
#define PG8_LDA(dst, b, h) do { _Pragma("unroll") for (int m = 0; m < 4; ++m) _Pragma("unroll") for (int k = 0; k < 2; ++k) dst[m][k] = *(const PG8_LAS bf16x8*)(lds + PG8_SA(b, h) + aoff + m * 2048 + k * 1024); } while (0)
#define PG8_LDB(dst, b, h) do { _Pragma("unroll") for (int n = 0; n < 2; ++n) _Pragma("unroll") for (int k = 0; k < 2; ++k) dst[n][k] = *(const PG8_LAS bf16x8*)(lds + PG8_SB(b, h) + boff + n * 2048 + k * 1024); } while (0)
#define PG8_MMA(ai, bj, At, Bt) do { __builtin_amdgcn_s_setprio(1); _Pragma("unroll") for (int m = 0; m < 4; ++m) _Pragma("unroll") for (int n = 0; n < 2; ++n) _Pragma("unroll") for (int k = 0; k < 2; ++k) \
        acc[ai][bj][m][n] = __builtin_amdgcn_mfma_f32_16x16x32_bf16(Bt[n][k], At[m][k], acc[ai][bj][m][n], 0, 0, 0); __builtin_amdgcn_s_setprio(0); } while (0)
#define PG8_WAIT_V(n) asm volatile("s_waitcnt vmcnt(" #n ")" ::: "memory")
#define PG8_WAIT_L(n) asm volatile("s_waitcnt lgkmcnt(" #n ")" ::: "memory")
#define PG8_BAR __builtin_amdgcn_s_barrier()
#define PG8_SCHED __builtin_amdgcn_sched_barrier(0)
    Unit cur, nxt; int ui = 0;
    if (!S.next(0, cur)) return;
    f32x4 acc[2][2][4][2];
#pragma unroll
    for (int a = 0; a < 2; ++a)
#pragma unroll
        for (int b = 0; b < 2; ++b)
#pragma unroll
            for (int m = 0; m < 4; ++m)
#pragma unroll
                for (int n = 0; n < 2; ++n) acc[a][b][m][n] = (f32x4){0.f, 0.f, 0.f, 0.f};
    bf16x8 At[4][2], B0[2][2], B1[2][2];
    const char* cA = (const char*)g.A + (size_t)cur.pm * tstep; const char* cB = (const char*)g.Bt + (size_t)cur.pn * tstep;
    S.a_ready(cur);
    if constexpr (SP2) {
        PG8_STAGE(PG8_SB(0, 0), cB, voffB); PG8_STAGE(PG8_SB(0, 1), cB + hstep, voffB); PG8_STAGE(PG8_SA(0, 0), cA, voffA); PG8_STAGE(PG8_SA(0, 1), cA + hstep, voffA);
        if (wr == 1) PG8_BAR;
        PG8_WAIT_V(2); PG8_BAR;
        PG8_STAGE(PG8_SB(1, 0), cB + kstep, voffB); PG8_STAGE(PG8_SA(1, 0), cA + kstep, voffA); PG8_STAGE(PG8_SB(1, 1), cB + hstep + kstep, voffB);
        PG8_WAIT_V(6); PG8_BAR;
    } else {
        PG8_STAGE(PG8_SB(0, 0), cB, voffB); PG8_STAGE(PG8_SA(0, 0), cA, voffA); PG8_STAGE(PG8_SB(0, 1), cB + hstep, voffB); PG8_STAGE(PG8_SA(0, 1), cA + hstep, voffA);
        if (wr == 1) PG8_BAR;
        PG8_WAIT_V(4); PG8_BAR;
        PG8_STAGE(PG8_SB(1, 0), cB + kstep, voffB); PG8_STAGE(PG8_SA(1, 0), cA + kstep, voffA); PG8_STAGE(PG8_SB(1, 1), cB + hstep + kstep, voffB);
        PG8_WAIT_V(6); PG8_BAR;
    }
    for (;;) {
        const bool has_next = S.next(ui + 1, nxt);
        const char* nA = has_next ? (const char*)g.A + (size_t)nxt.pm * tstep : cA; const char* nB = has_next ? (const char*)g.Bt + (size_t)nxt.pn * tstep : cB;
        for (int t = 0; t < nt; t += 2) {
            const bool last = (t == nt - 2);
            const char* a1 = cA + (size_t)(t + 1) * kstep;
            const char* a2 = last ? nA : cA + (size_t)(t + 2) * kstep; const char* b2 = last ? nB : cB + (size_t)(t + 2) * kstep;
            const char* a3 = a2 + kstep; const char* b3 = b2 + kstep;
            if (last && has_next) S.a_ready(nxt);
            if constexpr (SP2) {
            PG8_LDB(B0, 0, 0); PG8_LDB(B1, 0, 1); PG8_SCHED; PG8_LDA(At, 0, 0); PG8_STAGE(PG8_SA(1, 1), a1 + hstep, voffA);
            PG8_WAIT_V(8); PG8_WAIT_L(0); PG8_BAR; PG8_MMA(0, 0, At, B0); PG8_MMA(0, 1, At, B1); PG8_BAR; PG8_SCHED;
            PG8_LDA(At, 0, 1); PG8_STAGE(PG8_SB(0, 0), b2, voffB); PG8_STAGE(PG8_SB(0, 1), b2 + hstep, voffB); PG8_STAGE(PG8_SA(0, 0), a2, voffA);
            PG8_WAIT_V(8); PG8_WAIT_L(0); PG8_BAR; PG8_MMA(1, 0, At, B0); PG8_MMA(1, 1, At, B1); PG8_BAR; PG8_SCHED;
            PG8_LDB(B0, 1, 0); PG8_LDB(B1, 1, 1); PG8_SCHED; PG8_LDA(At, 1, 0); PG8_STAGE(PG8_SA(0, 1), a2 + hstep, voffA);
            PG8_WAIT_V(8); PG8_WAIT_L(0); PG8_BAR; PG8_MMA(0, 0, At, B0); PG8_MMA(0, 1, At, B1); PG8_BAR; PG8_SCHED;
            PG8_LDA(At, 1, 1); PG8_STAGE(PG8_SB(1, 0), b3, voffB); PG8_STAGE(PG8_SB(1, 1), b3 + hstep, voffB); PG8_STAGE(PG8_SA(1, 0), a3, voffA);
            PG8_WAIT_V(8); PG8_WAIT_L(0); PG8_BAR; PG8_MMA(1, 0, At, B0); PG8_MMA(1, 1, At, B1); PG8_BAR; PG8_SCHED;
            } else {
            PG8_LDB(B0, 0, 0); PG8_SCHED; PG8_LDA(At, 0, 0); PG8_STAGE(PG8_SA(1, 1), a1 + hstep, voffA);
            PG8_WAIT_L(8); PG8_BAR; PG8_WAIT_L(0); PG8_MMA(0, 0, At, B0); PG8_BAR; PG8_SCHED;
            PG8_LDB(B1, 0, 1); PG8_STAGE(PG8_SB(0, 0), b2, voffB);
            PG8_BAR; PG8_WAIT_L(0); PG8_MMA(0, 1, At, B1); PG8_BAR;
            PG8_LDA(At, 0, 1); PG8_STAGE(PG8_SA(0, 0), a2, voffA);
            PG8_BAR; PG8_WAIT_L(0); PG8_MMA(1, 0, At, B0); PG8_BAR; PG8_SCHED;
            PG8_STAGE(PG8_SB(0, 1), b2 + hstep, voffB);
            PG8_WAIT_V(6); PG8_BAR; PG8_MMA(1, 1, At, B1); PG8_BAR;
            PG8_LDB(B0, 1, 0); PG8_SCHED; PG8_LDA(At, 1, 0); PG8_STAGE(PG8_SA(0, 1), a2 + hstep, voffA);
            PG8_WAIT_L(8); PG8_BAR; PG8_WAIT_L(0); PG8_MMA(0, 0, At, B0); PG8_BAR; PG8_SCHED;
            PG8_LDB(B1, 1, 1); PG8_STAGE(PG8_SB(1, 0), b3, voffB);
            PG8_BAR; PG8_WAIT_L(0); PG8_MMA(0, 1, At, B1); PG8_BAR;
            PG8_LDA(At, 1, 1); PG8_STAGE(PG8_SA(1, 0), a3, voffA);
            PG8_BAR; PG8_WAIT_L(0); PG8_MMA(1, 0, At, B0); PG8_BAR; PG8_SCHED;
            PG8_STAGE(PG8_SB(1, 1), b3 + hstep, voffB);
            PG8_WAIT_V(6); PG8_BAR; PG8_MMA(1, 1, At, B1); PG8_BAR;
            }
        }
        if constexpr (ALIGN_EPI) { if (wr == 0) PG8_BAR; }
        if constexpr (!Epi::AFTER_DRAIN) { E(acc, cur, wr, wc, fr, fq); S.done(cur); }
        if (!has_next) break;
#pragma unroll
        for (int a = 0; a < 2; ++a)
#pragma unroll
            for (int b = 0; b < 2; ++b)
#pragma unroll
                for (int m = 0; m < 4; ++m)
#pragma unroll
                    for (int n = 0; n < 2; ++n) acc[a][b][m][n] = (f32x4){0.f, 0.f, 0.f, 0.f};
        cur = nxt; cA = nA; cB = nB; ++ui;
        if constexpr (ALIGN_EPI) { if (wr == 1) PG8_BAR; }
    }
    PG8_WAIT_V(0);
    if constexpr (!ALIGN_EPI) { if (wr == 0) PG8_BAR; }
    PG8_BAR;
    if constexpr (Epi::AFTER_DRAIN) { E.fused(acc, cur, wr, wc, fr, fq, lds, wid, lane); S.done(cur); }
#undef PG8_SA
#undef PG8_SB
#undef PG8_STAGE
#undef PG8_LDA
#undef PG8_LDB
#undef PG8_MMA
#undef PG8_WAIT_V
#undef PG8_WAIT_L
#undef PG8_BAR
#undef PG8_SCHED
}
}

constexpr int NWAVES = 8;
constexpr int RING_OFF = 0, RING_BYTES = 131072;
constexpr int LDSCTL_OFF = RING_BYTES, MISC_OFF = LDSCTL_OFF + 320;
constexpr int LDS_BYTES = 163840;
constexpr int CW_BAR = 4096;
#define GAS __attribute__((address_space(1)))
#define LAS __attribute__((address_space(3)))
typedef unsigned short bf16;
typedef unsigned v4u __attribute__((ext_vector_type(4)));
typedef unsigned v2u __attribute__((ext_vector_type(2)));
typedef float f32x4 __attribute__((ext_vector_type(4)));
typedef float f32x16 __attribute__((ext_vector_type(16)));
typedef short bf16x8 __attribute__((ext_vector_type(8)));
typedef GAS unsigned gu32;
#define LDS_WAIT() asm volatile("s_waitcnt lgkmcnt(0)" ::: "memory")
#define VM_WAIT() asm volatile("s_waitcnt vmcnt(0)" ::: "memory")
__device__ __forceinline__ unsigned f2bf(float f) { unsigned u = __builtin_bit_cast(unsigned, f); return (u + 0x7fffu + ((u >> 16) & 1u)) >> 16; }
__device__ __forceinline__ unsigned pk2(float lo, float hi) { return pg8::cvt_pk_bf16(lo, hi); }
__device__ __forceinline__ float bf2f(unsigned short b) { return __builtin_bit_cast(float, (unsigned)b << 16); }
__device__ __forceinline__ float wave_sum(float v) {
#pragma unroll
    for (int o = 1; o < 64; o <<= 1) v += __shfl_xor(v, o);
    return v;
}
__device__ __forceinline__ float wave_max(float v) {
#pragma unroll
    for (int o = 1; o < 64; o <<= 1) v = fmaxf(v, __shfl_xor(v, o));
    return v;
}
#define XB_TMO      128
#define XB_XCNT(j)  (256  + 64 * (j))
#define XB_XSUB(j)  (1280 + 64 * (j))
#define XB_XGEN(j)  (2304 + 64 * (j))
#define XB_TOP      3328
#define XB_TOPGEN   3392
#define XCD_BAR_WORDS 3456
#define XB_SPIN_CAP (1u << 18)

__device__ __forceinline__ unsigned xb_ld(unsigned* p)              { return __hip_atomic_load(p, __ATOMIC_RELAXED, __HIP_MEMORY_SCOPE_AGENT); }
__device__ __forceinline__ unsigned xb_add(unsigned* p, unsigned v) { return __hip_atomic_fetch_add(p, v, __ATOMIC_RELAXED, __HIP_MEMORY_SCOPE_AGENT); }
__device__ __forceinline__ unsigned xb_xcc_id() { return (unsigned)__builtin_amdgcn_s_getreg((3 << 11) | 20) & 0xFu; }
#define XB_SPIN(cond, bar) do { unsigned _sp = 0; while (cond) { __builtin_amdgcn_s_sleep(1); \
    if ((++_sp & 255u) == 0u) { if (xb_ld(&(bar)[XB_TMO])) break; if (_sp > XB_SPIN_CAP) { atomicAdd(&(bar)[XB_TMO], 1u); break; } } } } while (0)

struct XcdBarrier {
    unsigned* bar; unsigned x;
    volatile LAS unsigned* st;
};

__device__ __forceinline__ XcdBarrier xcd_barrier_post(unsigned* bar, volatile LAS unsigned* st) {
    XcdBarrier b; b.bar = bar; b.x = xb_xcc_id(); b.st = st;
    if (threadIdx.x == 0) (void)xb_add(&bar[XB_XCNT(b.x)], 1u);
    return b;
}
__device__ __forceinline__ void xcd_barrier_complete(unsigned* bar, unsigned x, unsigned& nloc, unsigned& nx) {
    const unsigned G = gridDim.x * gridDim.y * gridDim.z;
    unsigned sum, cnt, mine, sp = 0u;
    for (;;) {
        sum = 0u; cnt = 0u; mine = 0u;
#pragma unroll
        for (unsigned j = 0; j < 16; ++j) { const unsigned c = xb_ld(&bar[XB_XCNT(j)]); sum += c; cnt += (c > 0u) ? 1u : 0u; mine = (j == x) ? c : mine; }
        if (sum == G) break;
        __builtin_amdgcn_s_sleep(1);
        if ((++sp & 255u) == 0u) { if (xb_ld(&bar[XB_TMO])) break; if (sp > XB_SPIN_CAP) { atomicAdd(&bar[XB_TMO], 1u); break; } }
    }
    nloc = mine > 0u ? mine : 1u; nx = cnt > 0u ? cnt : 1u;
}

__device__ __forceinline__ void xcd_barrier(const XcdBarrier& b) {
    asm volatile("s_waitcnt vmcnt(0)" ::: "memory");
    __syncthreads();
    if (threadIdx.x == 0) {
        unsigned* bar = b.bar;
        __builtin_amdgcn_s_waitcnt(0);
        unsigned nloc = b.st[0], nx = b.st[1];
        if (nloc == 0u) { xcd_barrier_complete(bar, b.x, nloc, nx); b.st[0] = nloc; b.st[1] = nx; }
        const unsigned old = xb_add(&bar[XB_XSUB(b.x)], 1u);
        const unsigned gen = old / nloc;
        if (old + 1u == (gen + 1u) * nloc) {
            __builtin_amdgcn_fence(__ATOMIC_RELEASE, "agent");
            asm volatile("s_waitcnt vmcnt(0)" ::: "memory");
            const unsigned og = xb_add(&bar[XB_TOP], 1u);
            const unsigned tg = og / nx;
            if (og + 1u == (tg + 1u) * nx) xb_add(&bar[XB_TOPGEN], 1u);
            else XB_SPIN(xb_ld(&bar[XB_TOPGEN]) == tg, bar);
            __builtin_amdgcn_fence(__ATOMIC_ACQUIRE, "agent");
            xb_add(&bar[XB_XGEN(b.x)], 1u);
            asm volatile("s_waitcnt vmcnt(0)" ::: "memory");
        } else {
            XB_SPIN(xb_ld(&bar[XB_XGEN(b.x)]) == gen, bar);
            __builtin_amdgcn_fence(__ATOMIC_ACQUIRE, "agent");
            asm volatile("s_waitcnt vmcnt(0)" ::: "memory");
        }
    }
    __syncthreads();
}

struct Frame {
    LAS unsigned char* lds; volatile LAS unsigned* MISC; gu32* ctl;
    int tid, lane, wave, vcu, G, bid;
    const float *xp, *xs, *cache_k, *cache_v, *cache_kidx, *state_pool; const int* page_table;
    const float *cp, *cs, *norm_w, *w_ada, *b_ada, *w_in, *qnw, *knw, *w_pool, *pool_scale, *w_out;
    float* out; unsigned char* ws;
#if TEST_MODE == 4 && P3FINE
    unsigned long long* ts; int nst;
#endif
};
#if TEST_MODE == 4 && P3FINE
#define FSTAMP() do { if (blockIdx.x == STAMP_BLK && threadIdx.x == 0) F.ts[F.nst] = __builtin_amdgcn_s_memrealtime(); ++F.nst; } while (0)
#else
#define FSTAMP() do { } while (0)
#endif

__device__ __forceinline__ void p0_ada(Frame& F, int task) {
    const int lane = F.lane, w = F.wave, rl = lane & 15, kq = lane >> 4, n0 = task * 16;
    float bv[32];
    { const float* wp = F.w_ada + (size_t)(w * 128 + 4 * kq) * 3072 + n0 + rl;
#pragma unroll
      for (int i4 = 0; i4 < 8; ++i4)
#pragma unroll
          for (int u = 0; u < 4; ++u) bv[i4 * 4 + u] = wp[(size_t)(16 * i4 + u) * 3072]; }
    f32x4 acc[9];
#pragma unroll
    for (int i3 = 0; i3 < 3; ++i3) {
        f32x4 cv[3][8]; bool valid[3];
#pragma unroll
        for (int ii = 0; ii < 3; ++ii) { const int row = 16 * (3 * i3 + ii) + rl; valid[ii] = row < NR;
            const float* cptr = (row < NB ? F.cp + (size_t)row * DM : F.cs + (size_t)((valid[ii] ? row : NB) - NB) * DM) + w * 128 + 4 * kq;
#pragma unroll
            for (int i4 = 0; i4 < 8; ++i4) cv[ii][i4] = *(const f32x4*)(cptr + 16 * i4); }
#pragma unroll
        for (int ii = 0; ii < 3; ++ii) { const int i = 3 * i3 + ii;
            acc[i] = (f32x4){0.f, 0.f, 0.f, 0.f};
#pragma unroll
            for (int i4 = 0; i4 < 8; ++i4)
#pragma unroll
                for (int u = 0; u < 4; ++u) { const float a = valid[ii] ? pg8::silu1(cv[ii][i4][u]) : 0.f; acc[i] = __builtin_amdgcn_mfma_f32_16x16x4f32(a, bv[i4 * 4 + u], acc[i], 0, 0, 0); } } }
    LAS float* red = (LAS float*)(F.lds + RING_OFF);
#pragma unroll
    for (int i = 0; i < 9; ++i)
#pragma unroll
        for (int e = 0; e < 4; ++e) red[(w * 144 + 16 * i + 4 * kq + e) * 16 + rl] = acc[i][e];
    __syncthreads();
    float* ada = (float*)(F.ws + WS_ADA);
    for (int o = F.tid; o < NR * 16; o += NWAVES * 64) { const int row = o >> 4, col = o & 15; float s = F.b_ada[n0 + col];
#pragma unroll
        for (int ww = 0; ww < 8; ++ww) s += red[(ww * 144 + row) * 16 + col];
        ada[(size_t)row * 3072 + n0 + col] = s; }
    __syncthreads();
}
__device__ __forceinline__ void transpose_item(const float* W, int ldn, int srccol0, int nvalid, bf16* WT, int K, int dstrow0, int k0, LAS float* scr, int lane) {
    float tv[32];
#pragma unroll
    for (int i = 0; i < 32; ++i) { const int kk = 2 * i + (lane >> 5), c = lane & 31; tv[i] = c < nvalid ? W[(size_t)(k0 + kk) * ldn + srccol0 + c] : 0.f; }
#pragma unroll
    for (int i = 0; i < 32; ++i) { const int kk = 2 * i + (lane >> 5), c = lane & 31; scr[kk * 33 + c] = tv[i]; }
    LDS_WAIT(); asm volatile("" ::: "memory");
    const int c = lane & 7;
#pragma unroll
    for (int j = 0; j < 4; ++j) { const int n = (lane >> 3) + 8 * j; const LAS float* s = scr + (8 * c) * 33 + n;
        v4u o; o.x = pk2(s[0 * 33], s[1 * 33]); o.y = pk2(s[2 * 33], s[3 * 33]); o.z = pk2(s[4 * 33], s[5 * 33]); o.w = pk2(s[6 * 33], s[7 * 33]);
        *(GAS v4u*)(WT + (size_t)(dstrow0 + n) * K + k0 + 8 * c) = o; }
    LDS_WAIT(); asm volatile("" ::: "memory");
}
__device__ __forceinline__ int win_col(int pn, int hd, int d) {
    if (pn <= 1) return CQ + (4 * pn + hd) * 64 + d;
    if (pn == 2) return hd < 2 ? CK + hd * 64 + d : CV + (hd - 2) * 64 + d;
    if (pn <= 4) return CQI + (4 * (pn - 3) + hd) * 64 + d;
    if (pn == 5) return hd == 0 ? CKI + d : ((hd == 1 && d < 8) ? CWI + d : -1);
    if (pn <= 7) return CGA + (4 * (pn - 6) + hd) * 64 + d;
    if (pn <= 9) return CU + (4 * (pn - 8) + hd) * 64 + d;
    return CGP + (4 * (pn - 10) + hd) * 64 + d;
}
__device__ __forceinline__ void p0_prologue(Frame& F) {
    if (F.bid < 192) p0_ada(F, F.bid);
    LAS float* scr = (LAS float*)(F.lds + RING_OFF + F.wave * 16384);
    const int gw = F.vcu * NWAVES + F.wave, NGW = F.G * NWAVES;
    bf16* WINT = (bf16*)(F.ws + WS_WINT); bf16* WOUTT = (bf16*)(F.ws + WS_WOUTT); bf16* WPOOLT = (bf16*)(F.ws + WS_WPOOLT);
    for (int it = gw; it < 2080; it += NGW) {
        if (it < 1536) { const int G = it >> 4, kb = it & 15, pn = G >> 3, bj = (G >> 2) & 1, hd = G & 3; const int src = win_col(pn, hd, 32 * bj);
            const int nvalid = src < 0 ? 0 : ((pn == 5 && hd == 1) ? 8 : 32);
            transpose_item(F.w_in, NIN, src < 0 ? 0 : src, nvalid, WINT, 1024, 32 * G, 64 * kb, scr, F.lane); }
        else if (it < 2048) { const int r = it - 1536, G = r >> 4, kb = r & 15; transpose_item(F.w_out, 1024, 32 * G, 32, WOUTT, 1024, 32 * G, 64 * kb, scr, F.lane); }
        else { const int r = it - 2048, g = r >> 3, kb = (r >> 2) & 1, G = r & 3; transpose_item(F.w_pool + (size_t)g * 16384, 128, 32 * G, 32, WPOOLT + (size_t)g * 16384, 128, 32 * G, 64 * kb, scr, F.lane); }
    }
    { const int nf4 = DECB * 1792; f32x4 t4[2]; int ix[2];
#pragma unroll
      for (int k = 0; k < 2; ++k) { ix[k] = gw * 64 + F.lane + k * NGW * 64; if (ix[k] < nf4) { const int s = ix[k] / 1792, i = ix[k] - s * 1792; t4[k] = *(const f32x4*)(F.state_pool + (size_t)s * 7680 + 512 + 4 * i); } }
#pragma unroll
      for (int k = 0; k < 2; ++k) { if (ix[k] < nf4) { const int s = ix[k] / 1792, i = ix[k] - s * 1792; *(f32x4*)(F.out + O_PS + (size_t)s * 7680 + 4 * i) = t4[k]; } }
      for (int ixx = gw * 64 + F.lane + 2 * NGW * 64; ixx < nf4; ixx += NGW * 64) { const int s = ixx / 1792, i = ixx - s * 1792; *(f32x4*)(F.out + O_PS + (size_t)s * 7680 + 4 * i) = *(const f32x4*)(F.state_pool + (size_t)s * 7680 + 512 + 4 * i); } }
}

template <int N, bool SAME_ADA> __device__ __forceinline__ void norm_rows(Frame& F, const float* x0, const float* adarow0, int adastride, bf16* o0) {
    f32x4 v[N][4]; float s2[N];
#pragma unroll
    for (int i = 0; i < N; ++i) { const GAS f32x4* xr = (const GAS f32x4*)(x0 + (size_t)i * DM) + F.lane;
#pragma unroll
        for (int j = 0; j < 4; ++j) v[i][j] = xr[64 * j]; }
#pragma unroll
    for (int i = 0; i < N; ++i) { s2[i] = 0.f;
#pragma unroll
        for (int j = 0; j < 4; ++j) s2[i] += (v[i][j].x * v[i][j].x + v[i][j].y * v[i][j].y) + (v[i][j].z * v[i][j].z + v[i][j].w * v[i][j].w); }
#pragma unroll
    for (int o = 1; o < 64; o <<= 1) {
#pragma unroll
        for (int i = 0; i < N; ++i) s2[i] += __shfl_xor(s2[i], o); }
#pragma unroll
    for (int j = 0; j < 4; ++j) { const int col = 4 * F.lane + 256 * j; const f32x4 nw = *(const f32x4*)(F.norm_w + col);
        f32x4 gq, sh;
        if (SAME_ADA) { sh = *(const f32x4*)(adarow0 + col); gq = nw * (*(const f32x4*)(adarow0 + 1024 + col) + 1.0f); }
#pragma unroll
        for (int i = 0; i < N; ++i) {
            if (!SAME_ADA) { const float* ar = adarow0 + (size_t)i * adastride; sh = *(const f32x4*)(ar + col); gq = nw * (*(const f32x4*)(ar + 1024 + col) + 1.0f); }
            const float rstd = 1.0f / sqrtf(s2[i] * (1.0f / DM) + EPS);
            const f32x4 o = v[i][j] * rstd * gq + sh;
            ((GAS unsigned long long*)(o0 + (size_t)i * DM))[F.lane + 64 * j] = (unsigned long long)pk2(o.x, o.y) | ((unsigned long long)pk2(o.z, o.w) << 32); } }
}
__device__ __forceinline__ void skinny_core(const bf16* arow, const bf16* b0, const bf16* b1, const bf16* b2, const bf16* b3, f32x4 (&acc)[4]) {
#pragma unroll
    for (int j = 0; j < 4; ++j) acc[j] = (f32x4){0.f, 0.f, 0.f, 0.f};
    bf16x8 fa[2][4], fb[2][4][4];
#define SK_LOAD(buf, kb) do { _Pragma("unroll") for (int q_ = 0; q_ < 4; ++q_) { const int ko_ = 32 * (4 * (kb) + q_); fa[buf][q_] = *(const bf16x8*)(arow + ko_); \
        fb[buf][q_][0] = *(const bf16x8*)(b0 + ko_); fb[buf][q_][1] = *(const bf16x8*)(b1 + ko_); fb[buf][q_][2] = *(const bf16x8*)(b2 + ko_); fb[buf][q_][3] = *(const bf16x8*)(b3 + ko_); } } while (0)
#define SK_MMA(buf) do { _Pragma("unroll") for (int q_ = 0; q_ < 4; ++q_) { _Pragma("unroll") for (int j_ = 0; j_ < 4; ++j_) acc[j_] = __builtin_amdgcn_mfma_f32_16x16x32_bf16(fa[buf][q_], fb[buf][q_][j_], acc[j_], 0, 0, 0); } } while (0)
    SK_LOAD(0, 0);
#pragma unroll
    for (int kb = 0; kb < 8; kb += 2) {
        SK_LOAD(1, kb + 1); SK_MMA(0);
        if (kb + 2 < 8) SK_LOAD(0, kb + 2);
        SK_MMA(1);
    }
#undef SK_LOAD
#undef SK_MMA
}
__device__ __forceinline__ void sample_inproj(Frame& F, int pn, int hd) {
    const int lane = F.lane, w = F.wave, rl = lane & 15, kq = lane >> 4;
    const bf16* HS = (const bf16*)(F.ws + WS_HS);
    const bf16* WINT = (const bf16*)(F.ws + WS_WINT);
    const bf16* bb = WINT + (size_t)(256 * pn + 32 * hd + rl) * 1024 + 8 * kq;
    f32x4 acc[4];
    skinny_core(HS + (size_t)(16 * w + rl) * 1024 + 8 * kq, bb, bb + 16 * 1024, bb + 128 * 1024, bb + 144 * 1024, acc);
    float* out = F.out;
    if (pn <= 1 || (pn == 2 && hd < 2)) {
        const float* nwp = pn <= 1 ? F.qnw : F.knw; const float sc = pn <= 1 ? C2 : 1.0f;
#pragma unroll
        for (int e = 0; e < 4; ++e) { float ss = 0.f;
#pragma unroll
            for (int j = 0; j < 4; ++j) ss += acc[j][e] * acc[j][e];
            ss += __shfl_xor(ss, 1); ss += __shfl_xor(ss, 2); ss += __shfl_xor(ss, 4); ss += __shfl_xor(ss, 8);
            const float rstd = 1.0f / sqrtf(ss * (1.0f / 64.0f) + EPS); const int s = 16 * w + 4 * kq + e; const size_t m = (size_t)(MP + s);
#pragma unroll
            for (int j = 0; j < 4; ++j) { const int d = 16 * j + rl; const float o = acc[j][e] * rstd * nwp[d] * sc;
                if (pn <= 1) ((bf16*)(F.ws + WS_Q))[m * 512 + (4 * pn + hd) * 64 + d] = (bf16)f2bf(o);
                else { out[O_KS + (size_t)s * 128 + hd * 64 + d] = o; ((bf16*)(F.ws + WS_KB))[m * 128 + hd * 64 + d] = (bf16)f2bf(o); } } }
        return;
    }
    if (pn == 5 && hd == 1) {
        if (rl < 8) {
#pragma unroll
            for (int e = 0; e < 4; ++e) { const int s = 16 * w + 4 * kq + e; ((float*)(F.ws + WS_WI))[(size_t)(MP + s) * 8 + rl] = acc[0][e] * WI_SCALE; } }
        return;
    }
    bf16* dst; int ld, cb; float* fo = nullptr; int fld = 0; bool act = false;
    if (pn == 2) { dst = (bf16*)(F.ws + WS_VB); ld = 128; cb = (hd - 2) * 64; fo = out + O_VS + cb; fld = 128; }
    else if (pn <= 4) { dst = (bf16*)(F.ws + WS_QI); ld = 512; cb = (4 * (pn - 3) + hd) * 64; }
    else if (pn == 5) { dst = (bf16*)(F.ws + WS_KI); ld = 64; cb = 0; fo = out + O_KIS; fld = 64; }
    else if (pn <= 7) { dst = (bf16*)(F.ws + WS_GA); ld = 512; cb = (4 * (pn - 6) + hd) * 64; act = true; }
    else if (pn <= 9) { dst = (bf16*)(F.ws + WS_U); ld = 512; cb = (4 * (pn - 8) + hd) * 64; fo = out + O_PS + 14 * 512 + cb; fld = 15 * 512; }
    else { dst = (bf16*)(F.ws + WS_GP); ld = 512; cb = (4 * (pn - 10) + hd) * 64; act = true; }
#pragma unroll
    for (int e = 0; e < 4; ++e) { const int s = 16 * w + 4 * kq + e; const size_t m = (size_t)(MP + s);
#pragma unroll
        for (int j = 0; j < 4; ++j) { const int d = 16 * j + rl; float o = acc[j][e]; if (act) o = pg8::silu1(o);
            dst[m * ld + cb + d] = (bf16)f2bf(o);
            if (fo) fo[(size_t)s * fld + d] = o; } }
}
__device__ __forceinline__ void p1_norm(Frame& F) {
    const float* ada = (const float*)(F.ws + WS_ADA); bf16* HB = (bf16*)(F.ws + WS_HB); bf16* HS = (bf16*)(F.ws + WS_HS);
    const int gw = F.vcu * NWAVES + F.wave, NGW = F.G * NWAVES;
    for (int ch = gw; ch < MP / 4 + DECB / 2; ch += NGW) {
        if (ch < MP / 4) { const int m = 4 * ch; norm_rows<4, true>(F, F.xp + (size_t)m * DM, ada + (size_t)(m >> 11) * 3072, 0, HB + (size_t)m * DM); }
        else { const int s = 2 * (ch - MP / 4); norm_rows<2, false>(F, F.xs + (size_t)s * DM, ada + (size_t)(NB + s) * 3072, 3072, HS + (size_t)s * DM); } }
}
__device__ __forceinline__ void p2_sample(Frame& F) {
    const int pn = F.bid >> 2, hd = F.bid & 3;
    if (F.bid < 48 && !(pn == 5 && hd >= 2)) sample_inproj(F, pn, hd);
}

constexpr int P3_KEYS = 0;
constexpr int P3_BM = 132096;
constexpr int P3_WQ = 136192;
constexpr int P3_QI = 136704, P3_QI_STRIDE = 1040;
constexpr int P3_K = 8192;
constexpr int P3_V = P3_K + 32768;
constexpr int P3_VBUF = 18432;
constexpr int P3_END = P3_V + 2 * P3_VBUF;

__device__ __forceinline__ float relu_s(float x) { return __builtin_amdgcn_fmed3f(x, 0.0f, __builtin_inff()); }
__device__ __forceinline__ unsigned f2key(float f) { unsigned u = __float_as_uint(f); if (f == 0.0f) u = 0u; return (u & 0x80000000u) ? ~u : (u | 0x80000000u); }
__device__ __forceinline__ float key2f(unsigned k) { return __uint_as_float((k & 0x80000000u) ? (k ^ 0x80000000u) : ~k); }

__device__ __forceinline__ unsigned half_reduce_add(unsigned v) {
    v += (unsigned)__builtin_amdgcn_update_dpp(0, (int)v, 0xB1, 0xF, 0xF, true);
    v += (unsigned)__builtin_amdgcn_update_dpp(0, (int)v, 0x4E, 0xF, 0xF, true);
    v += (unsigned)__builtin_amdgcn_update_dpp(0, (int)v, 0x141, 0xF, 0xF, true);
    v += (unsigned)__builtin_amdgcn_update_dpp(0, (int)v, 0x140, 0xF, 0xF, true);
    v += (unsigned)__builtin_amdgcn_ds_swizzle((int)v, 0x401F);
    return v;
}
__device__ __forceinline__ float probit_f(float p) {
    const float pp = p < 0.5f ? p : 1.0f - p; const float t = sqrtf(-2.0f * __logf(pp));
    const float z = t - (2.515517f + t * (0.802853f + t * 0.010328f)) * __builtin_amdgcn_rcpf(1.0f + t * (1.432788f + t * (0.189269f + t * 0.001308f)));
    return p < 0.5f ? -z : z;
}
__device__ __forceinline__ unsigned half_reduce_min(unsigned v) {
    v = min(v, (unsigned)__builtin_amdgcn_update_dpp(0, (int)v, 0xB1, 0xF, 0xF, true)); v = min(v, (unsigned)__builtin_amdgcn_update_dpp(0, (int)v, 0x4E, 0xF, 0xF, true));
    v = min(v, (unsigned)__builtin_amdgcn_update_dpp(0, (int)v, 0x141, 0xF, 0xF, true)); v = min(v, (unsigned)__builtin_amdgcn_update_dpp(0, (int)v, 0x140, 0xF, 0xF, true));
    v = min(v, (unsigned)__builtin_amdgcn_ds_swizzle((int)v, 0x401F)); return v; }
__device__ __forceinline__ unsigned half_reduce_max(unsigned v) {
    v = max(v, (unsigned)__builtin_amdgcn_update_dpp(0, (int)v, 0xB1, 0xF, 0xF, true)); v = max(v, (unsigned)__builtin_amdgcn_update_dpp(0, (int)v, 0x4E, 0xF, 0xF, true));
    v = max(v, (unsigned)__builtin_amdgcn_update_dpp(0, (int)v, 0x141, 0xF, 0xF, true)); v = max(v, (unsigned)__builtin_amdgcn_update_dpp(0, (int)v, 0x140, 0xF, 0xF, true));
    v = max(v, (unsigned)__builtin_amdgcn_ds_swizzle((int)v, 0x401F)); return v; }
__device__ __forceinline__ unsigned wave_reduce_add_u(unsigned v) {
    v += (unsigned)__builtin_amdgcn_update_dpp(0, (int)v, 0xB1, 0xF, 0xF, true); v += (unsigned)__builtin_amdgcn_update_dpp(0, (int)v, 0x4E, 0xF, 0xF, true);
    v += (unsigned)__builtin_amdgcn_update_dpp(0, (int)v, 0x141, 0xF, 0xF, true); v += (unsigned)__builtin_amdgcn_update_dpp(0, (int)v, 0x140, 0xF, 0xF, true);
    return ((unsigned)__builtin_amdgcn_readlane((int)v, 0) + (unsigned)__builtin_amdgcn_readlane((int)v, 16)) + ((unsigned)__builtin_amdgcn_readlane((int)v, 32) + (unsigned)__builtin_amdgcn_readlane((int)v, 48)); }
__device__ __forceinline__ unsigned wave_reduce_min_u(unsigned v) { v = half_reduce_min(v); return min((unsigned)__builtin_amdgcn_readlane((int)v, 0), (unsigned)__builtin_amdgcn_readlane((int)v, 32)); }
__device__ __forceinline__ unsigned wave_reduce_max_u(unsigned v) { v = half_reduce_max(v); return max((unsigned)__builtin_amdgcn_readlane((int)v, 0), (unsigned)__builtin_amdgcn_readlane((int)v, 32)); }

__device__ __forceinline__ void p3_prompt_item(Frame& F, int b, int qt) {
    const int tid = F.tid, lane = F.lane, w = F.wave, r = lane & 31, hh = lane >> 5;
    const int t0 = 16 * qt, L = t0 + 16, nkt32 = (L + 31) >> 5, nkt64 = (L + 63) >> 6;
    const size_t mb = (size_t)b * SEQ;
    LAS unsigned* bm = (LAS unsigned*)(F.lds + P3_BM);
    LAS float* wq = (LAS float*)(F.lds + P3_WQ);
    LAS unsigned* keys = (LAS unsigned*)(F.lds + P3_KEYS);
    if (tid < 128) wq[tid] = ((const float*)(F.ws + WS_WI))[(mb + t0 + (tid >> 3)) * 8 + (tid & 7)];
    { const bf16* QI = (const bf16*)(F.ws + WS_QI);
#pragma unroll
      for (int k = 0; k < 2; ++k) { const int i = tid + 512 * k, row = i >> 6, ch = i & 63; *(LAS v4u*)(F.lds + P3_QI + row * P3_QI_STRIDE + ch * 16) = *(const v4u*)(QI + (mb + t0 + row) * 512 + ch * 8); } }
    __syncthreads();
    FSTAMP();
    for (int rep1_ = 0; rep1_ < REP_S1; ++rep1_) {
        const bf16* KI = (const bf16*)(F.ws + WS_KI);
        const int ns = (nkt32 - w + 7) >> 3;
        bf16x8 bb[3][4];
#define P3_LDK(slot) do { const bf16* kp_ = KI + (mb + 32 * (w + 8 * (slot)) + r) * 64 + 8 * hh; \
        _Pragma("unroll") for (int ks_ = 0; ks_ < 4; ++ks_) bb[(slot) % 3][ks_] = *(const bf16x8*)(kp_ + 16 * ks_); } while (0)
        if (0 < ns) P3_LDK(0);
        if (1 < ns) P3_LDK(1);
        const int arow = (2 * ((r >> 2) & 1) + (r >> 4)) * P3_QI_STRIDE + ((r & 3) + 4 * ((r >> 3) & 1)) * 128 + 16 * hh;
        const LAS unsigned char* qib = F.lds + P3_QI;
#define P3_MM(ACC, a, s) do { _Pragma("unroll") for (int e_ = 0; e_ < 16; ++e_) ACC[e_] = 0.f; \
        _Pragma("unroll") for (int ks_ = 0; ks_ < 4; ++ks_) { const bf16x8 af_ = *(const LAS bf16x8*)(qs_ + 4 * (a) * P3_QI_STRIDE + arow + 32 * ks_); \
            ACC = __builtin_amdgcn_mfma_f32_32x32x16_bf16(af_, bb[(s) % 3][ks_], ACC, 0, 0, 0); } } while (0)
#define P3_EPI(ACC, a, s) do { _Pragma("unroll") for (int j2_ = 0; j2_ < 2; ++j2_) { const int qq_ = 4 * (a) + 2 * hh + j2_; \
        const LAS f32x4* wp_ = (const LAS f32x4*)(wq + qq_ * 8); const f32x4 w0_ = wp_[0], w1_ = wp_[1]; \
        float sc_ = w0_[0] * relu_s(ACC[8 * j2_ + 0]); sc_ = fmaf(w0_[1], relu_s(ACC[8 * j2_ + 1]), sc_); sc_ = fmaf(w0_[2], relu_s(ACC[8 * j2_ + 2]), sc_); sc_ = fmaf(w0_[3], relu_s(ACC[8 * j2_ + 3]), sc_); \
        sc_ = fmaf(w1_[0], relu_s(ACC[8 * j2_ + 4]), sc_); sc_ = fmaf(w1_[1], relu_s(ACC[8 * j2_ + 5]), sc_); sc_ = fmaf(w1_[2], relu_s(ACC[8 * j2_ + 6]), sc_); sc_ = fmaf(w1_[3], relu_s(ACC[8 * j2_ + 7]), sc_); \
        keys[qq_ * 2048 + 32 * (w + 8 * (s)) + r] = f2key(sc_); } } while (0)
#pragma unroll
        for (int s = 0; s < 8; ++s) {
            if (s < ns) {
                if (s + 2 < ns) P3_LDK(s + 2);
                int zo_ = 0; asm volatile("" : "+v"(zo_));
                const LAS unsigned char* qs_ = qib + zo_;
                f32x16 accA, accB;
                P3_MM(accA, 0, s); P3_MM(accB, 1, s);
                P3_EPI(accA, 0, s); P3_MM(accA, 2, s);
                P3_EPI(accB, 1, s); P3_MM(accB, 3, s);
                P3_EPI(accA, 2, s); P3_EPI(accB, 3, s);
            }
        }
#undef P3_MM
#undef P3_EPI
#undef P3_LDK
    }
    __syncthreads();
    FSTAMP();
    for (int rep2_ = 0; rep2_ < REP_S2; ++rep2_) {
        int lane_ = F.lane; asm volatile("" : "+v"(lane_));
#define lane lane_
        const int qx0 = 2 * w, tq0 = t0 + qx0;
        unsigned sel0, sel1;
        if (t0 + 16 <= 256) {
            sel0 = 0u; sel1 = 0u;
#pragma unroll
            for (int jj = 0; jj < 32; ++jj) { sel0 |= (64 * jj + lane <= tq0) ? (1u << jj) : 0u; sel1 |= (64 * jj + lane <= tq0 + 1) ? (1u << jj) : 0u; }
        } else {
            unsigned x[32], y[32];
#pragma unroll
            for (int jj = 0; jj < 32; ++jj) { const int l = 64 * jj + lane; x[jj] = (l <= tq0) ? keys[qx0 * 2048 + l] : 0u; y[jj] = (l <= tq0 + 1) ? keys[(qx0 + 1) * 2048 + l] : 0u; }
#pragma unroll
            for (int st = 0; st < 5; ++st) { const int j = 16 >> st; const unsigned m = st == 0 ? 0x0000ffffu : st == 1 ? 0x00ff00ffu : st == 2 ? 0x0f0f0f0fu : st == 3 ? 0x33333333u : 0x55555555u;
#pragma unroll
                for (int k = 0; k < 32; ++k) if (!(k & j)) { const unsigned t_ = ((x[k] >> j) ^ x[k + j]) & m; x[k] ^= t_ << j; x[k + j] ^= t_;
                    const unsigned u_ = ((y[k] >> j) ^ y[k + j]) & m; y[k] ^= u_ << j; y[k + j] ^= u_; } }
            unsigned cur0 = 0xffffffffu, gt0 = 0u, cur1 = 0xffffffffu, gt1 = 0u; int ab0 = 0, ab1 = 0;
#pragma unroll
            for (int b = 31; b >= 0; --b) { const unsigned c0 = cur0 & x[b], c1 = cur1 & y[b];
                const unsigned pk = wave_reduce_add_u((unsigned)__popc(c0) | ((unsigned)__popc(c1) << 16)); const int n0 = (int)(pk & 0xffffu), n1 = (int)(pk >> 16);
                if (ab0 + n0 >= 256) cur0 = c0; else { ab0 += n0; gt0 |= c0; cur0 &= ~x[b]; }
                if (ab1 + n1 >= 256) cur1 = c1; else { ab1 += n1; gt1 |= c1; cur1 &= ~y[b]; } }
            const unsigned pke = wave_reduce_add_u((unsigned)__popc(cur0) | ((unsigned)__popc(cur1) << 16));
            const unsigned long long lt = (1ull << lane) - 1ull;
            { int need = 256 - ab0; if ((int)(pke & 0xffffu) == need) sel0 = gt0 | cur0;
              else { sel0 = gt0;
                for (int jj = 0; jj < 32; ++jj) { const unsigned long long meq = __ballot((cur0 >> jj) & 1u);
                    if (((cur0 >> jj) & 1u) && __popcll(meq & lt) < need) sel0 |= 1u << jj;
                    const int pc_ = __popcll(meq); need = need > pc_ ? need - pc_ : 0; } } }
            { int need = 256 - ab1; if ((int)(pke >> 16) == need) sel1 = gt1 | cur1;
              else { sel1 = gt1;
                for (int jj = 0; jj < 32; ++jj) { const unsigned long long meq = __ballot((cur1 >> jj) & 1u);
                    if (((cur1 >> jj) & 1u) && __popcll(meq & lt) < need) sel1 |= 1u << jj;
                    const int pc_ = __popcll(meq); need = need > pc_ ? need - pc_ : 0; } } }
        }
#pragma unroll
        for (int jj = 0; jj < 32; ++jj) { const unsigned long long b0 = __ballot((sel0 >> jj) & 1u), b1 = __ballot((sel1 >> jj) & 1u);
            if (lane == 0) { bm[qx0 * 64 + 2 * jj] = (unsigned)b0; bm[qx0 * 64 + 2 * jj + 1] = (unsigned)(b0 >> 32); bm[(qx0 + 1) * 64 + 2 * jj] = (unsigned)b1; bm[(qx0 + 1) * 64 + 2 * jj + 1] = (unsigned)(b1 >> 32); } }
#undef lane
    }
    __syncthreads();
#if TEST_MODE
    { unsigned* dbg = (unsigned*)(F.ws + WS_DBG_BM) + (mb + t0) * 64; for (int i = tid; i < 1024; i += NWAVES * 64) dbg[i] = bm[i]; }
#endif
    FSTAMP();
    for (int rep4_ = 0; rep4_ < REP_S4; ++rep4_) {
        int l4_ = lane, t4_ = tid; asm volatile("" : "+v"(l4_), "+v"(t4_));
        const int g = w & 1, quad = w >> 1, j = l4_ & 15, kq = l4_ >> 4;
        const bf16* Q = (const bf16*)(F.ws + WS_Q); const bf16* KB = (const bf16*)(F.ws + WS_KB); const bf16* VB = (const bf16*)(F.ws + WS_VB);
        const int qq = 4 * quad + (j >> 2), hd = 4 * g + (j & 3);
        const size_t mrow = mb + t0 + qq;
        bf16x8 qf[2];
#pragma unroll
        for (int ks = 0; ks < 2; ++ks) qf[ks] = *(const bf16x8*)(Q + mrow * 512 + hd * 64 + 32 * ks + 8 * kq);
        f32x4 o[4];
#pragma unroll
        for (int dt = 0; dt < 4; ++dt) o[dt] = (f32x4){0.f, 0.f, 0.f, 0.f};
        float mrun = -INFINITY, lsum = 0.f;
        const int skey = t4_ >> 3, sc0 = 2 * (t4_ & 7);
        v4u kreg[2], vreg[2];
#define P3_STAGE_LOAD(t) do { const size_t row_ = (mb + 64 * (t) + skey) * 128; \
        kreg[0] = *(const v4u*)(KB + row_ + 8 * sc0); kreg[1] = *(const v4u*)(KB + row_ + 8 * sc0 + 8); \
        vreg[0] = *(const v4u*)(VB + row_ + 8 * sc0); vreg[1] = *(const v4u*)(VB + row_ + 8 * sc0 + 8); } while (0)
#define P3_STAGE_WRITE(bufi) do { LAS unsigned char* kb_ = F.lds + P3_K + (bufi) * 16384 + skey * 256; \
        *(LAS v4u*)(kb_ + ((sc0 ^ (skey & 15)) << 4)) = kreg[0]; *(LAS v4u*)(kb_ + (((sc0 + 1) ^ (skey & 15)) << 4)) = kreg[1]; \
        LAS unsigned char* vb_ = F.lds + P3_V + (bufi) * P3_VBUF + (sc0 >> 3) * 9216 + skey * 144 + ((sc0 & 7) << 4); \
        *(LAS v4u*)(vb_) = vreg[0]; *(LAS v4u*)(vb_ + 16) = vreg[1]; } while (0)
        P3_STAGE_LOAD(0); P3_STAGE_WRITE(0);
        __syncthreads();
        for (int t = 0; t < nkt64; ++t) {
            const int bufi = t & 1;
            if (t + 1 < nkt64) P3_STAGE_LOAD(t + 1);
            f32x4 sacc[4];
            const LAS unsigned char* kbase = F.lds + P3_K + bufi * 16384;
#pragma unroll
            for (int c = 0; c < 4; ++c) { sacc[c] = (f32x4){0.f, 0.f, 0.f, 0.f}; const int key = 16 * c + j;
#pragma unroll
                for (int ks = 0; ks < 2; ++ks) { const int ch = g * 8 + 4 * ks + kq;
                    const bf16x8 kf = *(const LAS bf16x8*)(kbase + key * 256 + ((ch ^ (key & 15)) << 4));
                    sacc[c] = __builtin_amdgcn_mfma_f32_16x16x32_bf16(kf, qf[ks], sacc[c], 0, 0, 0); } }
            const unsigned mw0 = bm[qq * 64 + 2 * t], mw1 = bm[qq * 64 + 2 * t + 1];
            float tmax = -INFINITY;
#pragma unroll
            for (int c = 0; c < 4; ++c)
#pragma unroll
                for (int e = 0; e < 4; ++e) { const unsigned mwd = (c >> 1) ? mw1 : mw0; const bool bit = (mwd >> (16 * (c & 1) + 4 * kq + e)) & 1u;
                    sacc[c][e] = bit ? sacc[c][e] : -INFINITY; tmax = fmaxf(tmax, sacc[c][e]); }
            tmax = fmaxf(tmax, __shfl_xor(tmax, 16)); tmax = fmaxf(tmax, __shfl_xor(tmax, 32));
            const float mnew = fmaxf(mrun, tmax), muse = (mnew == -INFINITY) ? 0.f : mnew;
            const float alpha = __builtin_amdgcn_exp2f(mrun - muse);
            mrun = mnew;
            float psum = 0.f;
#pragma unroll
            for (int c = 0; c < 4; ++c)
#pragma unroll
                for (int e = 0; e < 4; ++e) { const float p = __builtin_amdgcn_exp2f(sacc[c][e] - muse); sacc[c][e] = p; psum += p; }
            lsum = lsum * alpha + psum;
#pragma unroll
            for (int dt = 0; dt < 4; ++dt) o[dt] *= alpha;
            const LAS unsigned char* vbase = F.lds + P3_V + bufi * P3_VBUF + g * 9216;
#pragma unroll
            for (int ks = 0; ks < 2; ++ks) {
                v4u pw; pw.x = pk2(sacc[2 * ks][0], sacc[2 * ks][1]); pw.y = pk2(sacc[2 * ks][2], sacc[2 * ks][3]); pw.z = pk2(sacc[2 * ks + 1][0], sacc[2 * ks + 1][1]); pw.w = pk2(sacc[2 * ks + 1][2], sacc[2 * ks + 1][3]);
                const bf16x8 pf = __builtin_bit_cast(bf16x8, pw);
#pragma unroll
                for (int dt = 0; dt < 4; ++dt) {
                    const LAS unsigned char* va = vbase + (32 * ks + 4 * kq + (j >> 2)) * 144 + (16 * dt + 4 * (j & 3)) * 2;
                    typedef short v4i16_t __attribute__((ext_vector_type(4)));
                    const v4i16_t lo4 = __builtin_amdgcn_ds_read_tr16_b64_v4i16((LAS v4i16_t*)va);
                    const v4i16_t hi4 = __builtin_amdgcn_ds_read_tr16_b64_v4i16((LAS v4i16_t*)(va + 16 * 144));
                    const bf16x8 vf = (bf16x8){lo4[0], lo4[1], lo4[2], lo4[3], hi4[0], hi4[1], hi4[2], hi4[3]};
                    o[dt] = __builtin_amdgcn_mfma_f32_16x16x32_bf16(vf, pf, o[dt], 0, 0, 0); } }
            if (t + 1 < nkt64) P3_STAGE_WRITE(bufi ^ 1);
            __syncthreads();
        }
#undef P3_STAGE_LOAD
#undef P3_STAGE_WRITE
        lsum += __shfl_xor(lsum, 16); lsum += __shfl_xor(lsum, 32);
        const float inv = 1.0f / lsum;
        const bf16* GA = (const bf16*)(F.ws + WS_GA); bf16* MIX = (bf16*)(F.ws + WS_MIX);
#pragma unroll
        for (int dt = 0; dt < 4; ++dt) { const int d = 16 * dt + 4 * kq; const v2u gv = *(const v2u*)(GA + mrow * 512 + hd * 64 + d);
            const float g0 = bf2f((unsigned short)(gv.x & 0xffffu)), g1 = bf2f((unsigned short)(gv.x >> 16)), g2 = bf2f((unsigned short)(gv.y & 0xffffu)), g3 = bf2f((unsigned short)(gv.y >> 16));
            v2u ov; ov.x = pk2(o[dt][0] * inv * g0, o[dt][1] * inv * g1); ov.y = pk2(o[dt][2] * inv * g2, o[dt][3] * inv * g3);
            *(v2u*)(MIX + mrow * 1024 + hd * 64 + d) = ov; }
    }
}

constexpr int PL_U = 0, PL_W = 40960, PL_STRIDE = 272;
template <bool SAMPLE> __device__ __forceinline__ void p3_pool_item(Frame& F, int item) {
    const int tid = F.tid, lane = F.lane, w = F.wave, j = lane & 15, kq = lane >> 4;
    const bf16* U = (const bf16*)(F.ws + WS_U); const bf16* GP = (const bf16*)(F.ws + WS_GP); const bf16* WPT = (const bf16*)(F.ws + WS_WPOOLT); bf16* MIX = (bf16*)(F.ws + WS_MIX);
    const int tokb = SAMPLE ? 0 : (item & 15) * 128;
    const size_t m0 = SAMPLE ? (size_t)MP : (size_t)(item >> 4) * SEQ + tokb;
    const int tl = 16 * w + j;
    const size_t mrow = m0 + tl;
    v4u wr_[4], ur_[5];
#define PL_LOAD(gg) do { _Pragma("unroll") for (int k_ = 0; k_ < 4; ++k_) { const int i_ = tid + 512 * k_; wr_[k_] = *(const v4u*)(WPT + (size_t)(gg) * 16384 + (i_ >> 4) * 128 + (i_ & 15) * 8); } \
        if (!SAMPLE) { _Pragma("unroll") for (int k_ = 0; k_ < 5; ++k_) { const int i_ = tid + 512 * k_; const int row_ = i_ >> 4, ch_ = i_ & 15; ur_[k_] = (v4u){0u, 0u, 0u, 0u}; \
            if (i_ < 143 * 16 && tokb - 15 + row_ >= 0) ur_[k_] = *(const v4u*)(U + (m0 - 15 + row_) * 512 + (gg) * 128 + ch_ * 8); } } } while (0)
#define PL_STORE() do { _Pragma("unroll") for (int k_ = 0; k_ < 4; ++k_) { const int i_ = tid + 512 * k_; *(LAS v4u*)(F.lds + PL_W + (i_ >> 4) * PL_STRIDE + (i_ & 15) * 16) = wr_[k_]; } \
        if (!SAMPLE) { _Pragma("unroll") for (int k_ = 0; k_ < 5; ++k_) { const int i_ = tid + 512 * k_; if (i_ < 143 * 16) *(LAS v4u*)(F.lds + PL_U + (i_ >> 4) * PL_STRIDE + (i_ & 15) * 16) = ur_[k_]; } } } while (0)
    PL_LOAD(0);
#pragma unroll
    for (int g = 0; g < 4; ++g) {
        const int win = 2 << g;
        PL_STORE();
        __syncthreads();
        if (g + 1 < 4) PL_LOAD(g + 1);
        bf16x8 df[4];
#pragma unroll
        for (int ks = 0; ks < 4; ++ks) {
            float sum[8], cur[8];
            if (!SAMPLE) {
                const LAS unsigned char* up = F.lds + PL_U + (15 + tl) * PL_STRIDE + (4 * ks + kq) * 16;
                { const v4u c = *(const LAS v4u*)up;
#pragma unroll
                  for (int u = 0; u < 4; ++u) { const unsigned x = c[u]; cur[2 * u] = bf2f((unsigned short)(x & 0xffffu)); cur[2 * u + 1] = bf2f((unsigned short)(x >> 16)); sum[2 * u] = cur[2 * u]; sum[2 * u + 1] = cur[2 * u + 1]; } }
#pragma unroll
                for (int i = 1; i < win; ++i) { const v4u c = *(const LAS v4u*)(up - i * PL_STRIDE);
#pragma unroll
                    for (int u = 0; u < 4; ++u) { const unsigned x = c[u]; sum[2 * u] += bf2f((unsigned short)(x & 0xffffu)); sum[2 * u + 1] += bf2f((unsigned short)(x >> 16)); } }
            } else {
                const int c0 = g * 128 + 32 * ks + 8 * kq;
                { const v4u c = *(const v4u*)(U + mrow * 512 + c0);
#pragma unroll
                  for (int u = 0; u < 4; ++u) { const unsigned x = c[u]; cur[2 * u] = bf2f((unsigned short)(x & 0xffffu)); cur[2 * u + 1] = bf2f((unsigned short)(x >> 16)); sum[2 * u] = cur[2 * u]; sum[2 * u + 1] = cur[2 * u + 1]; } }
#pragma unroll
                for (int i = 1; i < win; ++i) { const float* sp = F.state_pool + ((size_t)tl * 15 + (15 - i)) * 512 + c0; const f32x4 a = *(const f32x4*)sp, bq = *(const f32x4*)(sp + 4);
                    sum[0] += a[0]; sum[1] += a[1]; sum[2] += a[2]; sum[3] += a[3]; sum[4] += bq[0]; sum[5] += bq[1]; sum[6] += bq[2]; sum[7] += bq[3]; }
            }
            const int tpos = tokb + tl; const float rc = 1.0f / (float)(SAMPLE ? win : ((tpos + 1 < win) ? tpos + 1 : win));
            v4u pw; pw.x = pk2(sum[0] * rc - cur[0], sum[1] * rc - cur[1]); pw.y = pk2(sum[2] * rc - cur[2], sum[3] * rc - cur[3]);
            pw.z = pk2(sum[4] * rc - cur[4], sum[5] * rc - cur[5]); pw.w = pk2(sum[6] * rc - cur[6], sum[7] * rc - cur[7]);
            df[ks] = __builtin_bit_cast(bf16x8, pw);
        }
#pragma unroll
        for (int jt = 0; jt < 8; ++jt) {
            f32x4 acc = (f32x4){0.f, 0.f, 0.f, 0.f};
#pragma unroll
            for (int ks = 0; ks < 4; ++ks) { const bf16x8 wf = *(const LAS bf16x8*)(F.lds + PL_W + (16 * jt + j) * PL_STRIDE + (4 * ks + kq) * 16);
                acc = __builtin_amdgcn_mfma_f32_16x16x32_bf16(wf, df[ks], acc, 0, 0, 0); }
            const int col = g * 128 + 16 * jt + 4 * kq;
            const f32x4 ps = *(const f32x4*)(F.pool_scale + col); const v2u gv = *(const v2u*)(GP + mrow * 512 + col);
            const float g0 = bf2f((unsigned short)(gv.x & 0xffffu)), g1 = bf2f((unsigned short)(gv.x >> 16)), g2 = bf2f((unsigned short)(gv.y & 0xffffu)), g3 = bf2f((unsigned short)(gv.y >> 16));
            v2u ov; ov.x = pk2(acc[0] * ps[0] * g0, acc[1] * ps[1] * g1); ov.y = pk2(acc[2] * ps[2] * g2, acc[3] * ps[3] * g3);
            *(v2u*)(MIX + mrow * 1024 + 512 + col) = ov;
        }
        __syncthreads();
    }
#undef PL_LOAD
#undef PL_STORE
}

constexpr int SM_SC = 0, SM_SEL = 8448, SM_Q = 9472, SM_P = 11520, SM_RED = 19712, SM_PT = 27904;
__device__ __forceinline__ void p3_sample_item(Frame& F, int s) {
    const int tid = F.tid, lane = F.lane, w = F.wave, r = lane & 31, hh = lane >> 5;
    const size_t m = (size_t)MP + s;
    LAS float* sc = (LAS float*)(F.lds + SM_SC); LAS int* sel = (LAS int*)(F.lds + SM_SEL); LAS float* ql = (LAS float*)(F.lds + SM_Q);
    LAS float* pl = (LAS float*)(F.lds + SM_P); LAS float* red = (LAS float*)(F.lds + SM_RED); LAS int* ptl = (LAS int*)(F.lds + SM_PT);
    const bf16* QI = (const bf16*)(F.ws + WS_QI) + m * 512; const float* WIp = (const float*)(F.ws + WS_WI) + m * 8;
    const int* pt = F.page_table + s * NPG;
    ql[tid] = bf2f(((const bf16*)(F.ws + WS_Q))[m * 512 + tid]);
    if (tid < NPG) ptl[tid] = pt[tid];
    {
        bf16x8 af[4];
#pragma unroll
        for (int ks = 0; ks < 4; ++ks) { af[ks] = (bf16x8){0, 0, 0, 0, 0, 0, 0, 0}; if (r < 8) af[ks] = *(const bf16x8*)(QI + r * 64 + 16 * ks + 8 * hh); }
        float wv[4];
#pragma unroll
        for (int e = 0; e < 4; ++e) wv[e] = WIp[4 * hh + e];
        int pg[8];
#pragma unroll
        for (int it = 0; it < 8; ++it) pg[it] = pt[(w + 8 * it) >> 2];
#pragma unroll
        for (int hf = 0; hf < 4; ++hf) {
            f32x4 x0[2][4], x1[2][4];
#pragma unroll
            for (int i4 = 0; i4 < 2; ++i4) { const int kt = w + 8 * (2 * hf + i4);
                const float* kp = F.cache_kidx + ((size_t)pg[2 * hf + i4] * PAGE + (kt & 3) * 32 + r) * 64 + 8 * hh;
#pragma unroll
                for (int ks = 0; ks < 4; ++ks) { x0[i4][ks] = *(const f32x4*)(kp + 16 * ks); x1[i4][ks] = *(const f32x4*)(kp + 16 * ks + 4); } }
#pragma unroll
            for (int i4 = 0; i4 < 2; ++i4) { const int kt = w + 8 * (2 * hf + i4);
                f32x16 acc;
#pragma unroll
                for (int e = 0; e < 16; ++e) acc[e] = 0.f;
#pragma unroll
                for (int ks = 0; ks < 4; ++ks) {
                    v4u pw; pw.x = pk2(x0[i4][ks][0], x0[i4][ks][1]); pw.y = pk2(x0[i4][ks][2], x0[i4][ks][3]); pw.z = pk2(x1[i4][ks][0], x1[i4][ks][1]); pw.w = pk2(x1[i4][ks][2], x1[i4][ks][3]);
                    acc = __builtin_amdgcn_mfma_f32_32x32x16_bf16(af[ks], __builtin_bit_cast(bf16x8, pw), acc, 0, 0, 0); }
                float part = wv[0] * fmaxf(acc[0], 0.f) + wv[1] * fmaxf(acc[1], 0.f) + wv[2] * fmaxf(acc[2], 0.f) + wv[3] * fmaxf(acc[3], 0.f);
                part += __shfl_xor(part, 32);
                if (hh == 0) sc[32 * kt + r] = part; }
        }
        if (w == 0) {
            const float kv = bf2f(((const bf16*)(F.ws + WS_KI))[m * 64 + lane]); float tot = 0.f;
#pragma unroll
            for (int h = 0; h < 8; ++h) { const float d = wave_sum(bf2f(QI[h * 64 + lane]) * kv); tot += WIp[h] * fmaxf(d, 0.f); }
            if (lane == 0) sc[PAST] = tot;
        }
    }
    __syncthreads();
    if (w == 0) {
        unsigned key[33];
#pragma unroll
        for (int jj = 0; jj < 33; ++jj) { const int l = jj * 64 + lane; key[jj] = l < PAST + 1 ? f2key(sc[l]) : 0u; }
        unsigned Tk = 0u;
        for (int bit = 31; bit >= 0; --bit) { const unsigned cand = Tk | (1u << bit); int cnt = 0;
#pragma unroll
            for (int jj = 0; jj < 33; ++jj) cnt += __popcll(__ballot(key[jj] >= cand));
            if (cnt >= 256) Tk = cand; }
        int cgt = 0;
#pragma unroll
        for (int jj = 0; jj < 33; ++jj) cgt += __popcll(__ballot(key[jj] > Tk));
        const int need = 256 - cgt; const unsigned long long lt = (1ull << lane) - 1ull; int pos = 0, eq_seen = 0;
#pragma unroll
        for (int jj = 0; jj < 33; ++jj) { const bool gt = key[jj] > Tk, eq = key[jj] == Tk;
            const unsigned long long meq = __ballot(eq); const int eqb = eq_seen + __popcll(meq & lt);
            const bool take = gt || (eq && eqb < need); const unsigned long long mt = __ballot(take);
            const int l = jj * 64 + lane;
            if (take) sel[pos + __popcll(mt & lt)] = l < PAST ? ptl[l >> 7] * PAGE + (l & 127) : -1;
            pos += __popcll(mt); eq_seen += __popcll(meq); }
    }
    __syncthreads();
    {
        const int jk = tid & 255, g = tid >> 8; const int pr = sel[jk];
        const float* krow = pr >= 0 ? F.cache_k + (size_t)pr * 128 + g * 64 : F.out + O_KS + (size_t)s * 128 + g * 64;
        f32x4 kv[16];
#pragma unroll
        for (int c = 0; c < 16; ++c) kv[c] = *(const f32x4*)(krow + 4 * c);
        float d4[4] = {0.f, 0.f, 0.f, 0.f};
#pragma unroll
        for (int c = 0; c < 16; ++c) {
#pragma unroll
            for (int rr = 0; rr < 4; ++rr) { const f32x4 qv = *(const LAS f32x4*)(ql + (4 * g + rr) * 64 + 4 * c); d4[rr] += (qv[0] * kv[c][0] + qv[1] * kv[c][1]) + (qv[2] * kv[c][2] + qv[3] * kv[c][3]); } }
#pragma unroll
        for (int rr = 0; rr < 4; ++rr) pl[(4 * g + rr) * 256 + jk] = d4[rr];
    }
    __syncthreads();
    {
        float v[4]; float mx = -INFINITY;
#pragma unroll
        for (int i = 0; i < 4; ++i) { v[i] = pl[w * 256 + lane + 64 * i]; mx = fmaxf(mx, v[i]); }
        mx = wave_max(mx); float sm = 0.f;
#pragma unroll
        for (int i = 0; i < 4; ++i) { v[i] = __builtin_amdgcn_exp2f(v[i] - mx); sm += v[i]; }
        sm = wave_sum(sm); const float inv = 1.0f / sm;
#pragma unroll
        for (int i = 0; i < 4; ++i) pl[w * 256 + lane + 64 * i] = v[i] * inv;
    }
    __syncthreads();
    {
        const int d = tid & 63, g = (tid >> 6) & 1, k4 = tid >> 7; float acc[4] = {0.f, 0.f, 0.f, 0.f};
#pragma unroll
        for (int hb = 0; hb < 2; ++hb) { float vv[32];
#pragma unroll
            for (int i = 0; i < 32; ++i) { const int pr = sel[64 * k4 + 32 * hb + i];
                const float* vrow = pr >= 0 ? F.cache_v + (size_t)pr * 128 + g * 64 : F.out + O_VS + (size_t)s * 128 + g * 64; vv[i] = vrow[d]; }
#pragma unroll
            for (int i = 0; i < 32; ++i) {
#pragma unroll
                for (int rr = 0; rr < 4; ++rr) acc[rr] += pl[(4 * g + rr) * 256 + 64 * k4 + 32 * hb + i] * vv[i]; } }
#pragma unroll
        for (int rr = 0; rr < 4; ++rr) red[((k4 * 2 + g) * 4 + rr) * 64 + d] = acc[rr];
    }
    __syncthreads();
    { const int h = tid >> 6, d = tid & 63; float a = 0.f;
#pragma unroll
        for (int k4 = 0; k4 < 4; ++k4) a += red[((k4 * 2 + (h >> 2)) * 4 + (h & 3)) * 64 + d];
        const float gate = bf2f(((const bf16*)(F.ws + WS_GA))[m * 512 + tid]);
        ((bf16*)(F.ws + WS_MIX))[m * 1024 + tid] = (bf16)f2bf(a * gate); }
    { const int c = tid, g = c >> 7, win = 2 << g; const float un = bf2f(((const bf16*)(F.ws + WS_U))[m * 512 + c]); float sum = un;
      const float* sp = F.state_pool + (size_t)s * 15 * 512 + c;
      float hv[15];
#pragma unroll
      for (int i = 1; i < 16; ++i) hv[i - 1] = sp[(size_t)(15 - i) * 512];
#pragma unroll
      for (int i = 1; i < 16; ++i) sum += (i < win) ? hv[i - 1] : 0.f;
      ql[c] = bf2f((unsigned short)f2bf(sum / (float)win - un)); }
    __syncthreads();
    { const int col = tid, g = col >> 7, j = col & 127; const bf16* wr = (const bf16*)(F.ws + WS_WPOOLT) + (size_t)g * 16384 + j * 128;
      v4u wv4[16];
#pragma unroll
      for (int i = 0; i < 16; ++i) wv4[i] = *(const v4u*)(wr + 8 * i);
      float acc = 0.f;
#pragma unroll
      for (int i = 0; i < 16; ++i) { const LAS f32x4* dp = (const LAS f32x4*)(ql + g * 128 + 8 * i); const f32x4 d0 = dp[0], d1 = dp[1];
          acc += d0[0] * bf2f((unsigned short)(wv4[i].x & 0xffffu)) + d0[1] * bf2f((unsigned short)(wv4[i].x >> 16)) + d0[2] * bf2f((unsigned short)(wv4[i].y & 0xffffu)) + d0[3] * bf2f((unsigned short)(wv4[i].y >> 16));
          acc += d1[0] * bf2f((unsigned short)(wv4[i].z & 0xffffu)) + d1[1] * bf2f((unsigned short)(wv4[i].z >> 16)) + d1[2] * bf2f((unsigned short)(wv4[i].w & 0xffffu)) + d1[3] * bf2f((unsigned short)(wv4[i].w >> 16)); }
      const float gp = bf2f(((const bf16*)(F.ws + WS_GP))[m * 512 + col]);
      ((bf16*)(F.ws + WS_MIX))[m * 1024 + 512 + col] = (bf16)f2bf(acc * F.pool_scale[col] * gp); }
    __syncthreads();
}

__device__ __forceinline__ void p3_mixer(Frame& F) {
    for (int p = F.bid; p < 512; p += F.G) { const int b = p >> 6, sidx = p & 63;
        p3_prompt_item(F, b, 127 - sidx); __syncthreads(); FSTAMP();
        p3_prompt_item(F, b, sidx); __syncthreads(); FSTAMP(); }
    for (int x = F.bid; x < 128; x += F.G) { p3_sample_item(F, x); __syncthreads(); FSTAMP(); }
    for (int x = F.bid + ((F.bid < 128) ? ((128 - F.bid + F.G - 1) / F.G) * F.G : 0); x < 256; x += F.G) { p3_pool_item<false>(F, x - 128); __syncthreads(); FSTAMP(); }
}
__device__ __forceinline__ void p4_sample_out(Frame& F) {
    if (F.bid >= 64) return;
    const int lane = F.lane, w = F.wave, rl = lane & 15, kq = lane >> 4, n0 = F.bid * 16;
    const bf16* ap = (const bf16*)(F.ws + WS_MIX) + (size_t)(MP + 16 * w + rl) * 1024 + 8 * kq;
    const bf16* bp = (const bf16*)(F.ws + WS_WOUTT) + (size_t)(n0 + rl) * 1024 + 8 * kq;
    f32x4 acc = (f32x4){0.f, 0.f, 0.f, 0.f};
#pragma unroll
    for (int hb = 0; hb < 2; ++hb) { bf16x8 fa[16], fb[16];
#pragma unroll
        for (int i = 0; i < 16; ++i) { fa[i] = *(const bf16x8*)(ap + 32 * (16 * hb + i)); fb[i] = *(const bf16x8*)(bp + 32 * (16 * hb + i)); }
#pragma unroll
        for (int i = 0; i < 16; ++i) acc = __builtin_amdgcn_mfma_f32_16x16x32_bf16(fa[i], fb[i], acc, 0, 0, 0); }
    const float* ada = (const float*)(F.ws + WS_ADA);
#pragma unroll
    for (int e = 0; e < 4; ++e) { const int s = 16 * w + 4 * kq + e, n = n0 + rl;
        F.out[O_YS + (size_t)s * 1024 + n] = F.xs[(size_t)s * 1024 + n] + ada[(size_t)(NB + s) * 3072 + 2048 + n] * acc[e]; }
}

struct Args { const float* in[18]; float* out; unsigned char* ws; int ph_lo, ph_hi, li, pad; };
__global__ void __launch_bounds__(NWAVES * 64, 2) mk_fwd(Args args) {
    extern __shared__ __attribute__((aligned(16))) unsigned char lds[];
    Frame F;
    F.lds = (LAS unsigned char*)lds;
    F.MISC = (volatile LAS unsigned*)(F.lds + MISC_OFF);
    F.tid = threadIdx.x; F.lane = F.tid & 63; F.wave = __builtin_amdgcn_readfirstlane(F.tid >> 6);
    F.G = gridDim.x; F.bid = blockIdx.x; { const int bx = blockIdx.x; F.vcu = (F.G % 8 == 0) ? (bx % 8) * (F.G / 8) + bx / 8 : bx; }
    F.ws = args.ws; F.out = args.out; F.ctl = (gu32*)(args.ws + WS_CTL);
    F.xp = args.in[0]; F.xs = args.in[1]; F.cache_k = args.in[2]; F.cache_v = args.in[3]; F.cache_kidx = args.in[4]; F.state_pool = args.in[5];
    F.page_table = (const int*)args.in[6]; F.cp = args.in[7]; F.cs = args.in[8]; F.norm_w = args.in[9]; F.w_ada = args.in[10]; F.b_ada = args.in[11];
    F.w_in = args.in[12]; F.qnw = args.in[13]; F.knw = args.in[14]; F.w_pool = args.in[15]; F.pool_scale = args.in[16]; F.w_out = args.in[17];
    for (int u = F.tid; u < (LDS_BYTES - LDSCTL_OFF) / 4; u += NWAVES * 64) ((LAS unsigned*)(F.lds + LDSCTL_OFF))[u] = 0u;
    __syncthreads();
    XcdBarrier bar = xcd_barrier_post((unsigned*)(F.ctl + CW_BAR) + args.li * XCD_BAR_WORDS, F.MISC + 8);
    const int lo = args.ph_lo, hi = args.ph_hi;
#if TEST_MODE == 4
    unsigned long long* ts = (unsigned long long*)(args.ws + WS_CTL + 768 * 1024); int nst = 0;
#define STAMP() do { if (blockIdx.x == STAMP_BLK && threadIdx.x == 0) ts[nst] = __builtin_amdgcn_s_memrealtime(); ++nst; } while (0)
#if P3FINE
    F.ts = ts + 16; F.nst = 0;
#endif
#else
#define STAMP() do { } while (0)
#endif
    STAMP();
#define IN(k) (lo <= (k) && (k) < hi)
#define BOTH(k) (IN(k) && IN((k) + 1))
    if (IN(0)) { for (int rp_ = 0; rp_ < REP_P0; ++rp_) { p0_prologue(F); if (rp_ + 1 < REP_P0) __syncthreads(); } STAMP(); if (BOTH(0)) xcd_barrier(bar); STAMP(); }
    if (IN(1)) { for (int rp_ = 0; rp_ < REP_P1; ++rp_) p1_norm(F); STAMP(); if (BOTH(1)) xcd_barrier(bar); STAMP(); }
    if (IN(2)) {
        p2_sample(F);
        pg8::Gemm g{(const pg8::bf16_t*)(F.ws + WS_HB), (const pg8::bf16_t*)(F.ws + WS_WINT), MP, 3072, DM};
        pg8::StaticOrder S; S.init(MP, 3072, F.G, (int)blockIdx.x);
        pg8::EpiIn E{F.ws, F.out, F.qnw, F.knw};
        pg8::gemm_phase<pg8::EpiIn, pg8::StaticOrder, true, true>(F.lds + RING_OFF, g, S, E);
        STAMP(); if (BOTH(2)) xcd_barrier(bar); STAMP();
    }
#if HAVE_P3
    if (IN(3)) { p3_mixer(F); STAMP(); if (BOTH(3)) xcd_barrier(bar); STAMP(); }
#endif
    if (IN(4)) {
        pg8::Gemm g{(const pg8::bf16_t*)(F.ws + WS_MIX), (const pg8::bf16_t*)(F.ws + WS_WOUTT), MP, DM, DM};
        pg8::StaticOrder S; S.init(MP, DM, F.G, (int)blockIdx.x);
        pg8::EpiOut E{F.xp, F.out + O_YP, (const float*)(F.ws + WS_ADA)};
        pg8::gemm_phase<pg8::EpiOut, pg8::StaticOrder, true, true>(F.lds + RING_OFF, g, S, E);
        STAMP(); for (int rp_ = 0; rp_ < REP_P4S; ++rp_) p4_sample_out(F); STAMP();
    }
#undef IN
#undef BOTH
}

#if TEST_MODE && TEST_MODE < 4
namespace gold {
constexpr size_t W_ADA = 0, W_H = W_ADA + (size_t)NR * 3072, W_PROJ = W_H + (size_t)MT * 1024, W_SC = W_PROJ + (size_t)MT * NIN,
                 W_SCS = W_SC + (size_t)MP * 2048, W_SEL = W_SCS + (size_t)DECB * 2112, W_NSEL = W_SEL + (size_t)MT * 256, W_END = W_NSEL + MT;
constexpr size_t W_YT = W_H, W_MIX = W_SC, W_DB = W_SC + (size_t)MT * 1024;

__device__ __forceinline__ float wave_sum(float v) {
#pragma unroll
    for (int o = 1; o < 64; o <<= 1) v += __shfl_xor(v, o);
    return v;
}
__device__ __forceinline__ float wave_max(float v) {
#pragma unroll
    for (int o = 1; o < 64; o <<= 1) v = fmaxf(v, __shfl_xor(v, o));
    return v;
}
__device__ __forceinline__ float silu_f(float x) { return x / (1.f + expf(-x)); }

__global__ void __launch_bounds__(256) k_ada(const float* __restrict__ cp, const float* __restrict__ cs, const float* __restrict__ w_ada,
                                              const float* __restrict__ b_ada, float* __restrict__ ada) {
    const int j = blockIdx.x * 256 + threadIdx.x, r = blockIdx.y;
    const float* c = r < NB ? cp + (size_t)r * DM : cs + (size_t)(r - NB) * DM;
    float acc = 0.f;
    for (int k = 0; k < DM; ++k) { const float cv = c[k]; acc += silu_f(cv) * w_ada[(size_t)k * 3072 + j]; }
    ada[(size_t)r * 3072 + j] = acc + b_ada[j];
}

__global__ void __launch_bounds__(256) k_h(const float* __restrict__ xp, const float* __restrict__ xs, const float* __restrict__ norm_w,
                                            const float* __restrict__ ada, float* __restrict__ H) {
    const int m = blockIdx.x * 4 + (threadIdx.x >> 6), lane = threadIdx.x & 63;
    const float* x = m < MP ? xp + (size_t)m * DM : xs + (size_t)(m - MP) * DM;
    const int r = m < MP ? m / SEQ : NB + (m - MP);
    float v[16]; float ss = 0.f;
#pragma unroll
    for (int i = 0; i < 16; ++i) { v[i] = x[lane + 64 * i]; ss += v[i] * v[i]; }
    ss = wave_sum(ss);
    const float rstd = 1.0f / sqrtf(ss * (1.0f / DM) + 1e-6f);
#pragma unroll
    for (int i = 0; i < 16; ++i) { const int c = lane + 64 * i;
        H[(size_t)m * DM + c] = v[i] * rstd * norm_w[c] * (1.f + ada[(size_t)r * 3072 + 1024 + c]) + ada[(size_t)r * 3072 + c]; }
}

__global__ void __launch_bounds__(256) k_gemm(const float* __restrict__ A, const float* __restrict__ B, float* __restrict__ C,
                                               int M, int N, int K, int lda, int ldb, int ldc) {
    const int wave = threadIdx.x >> 6, lane = threadIdx.x & 63, r = lane & 31, h = lane >> 5;
    const int m0 = blockIdx.y * 128 + (wave >> 1) * 64, n0 = blockIdx.x * 128 + (wave & 1) * 64;
    f32x16 acc[2][2];
#pragma unroll
    for (int i = 0; i < 2; ++i)
#pragma unroll
        for (int j = 0; j < 2; ++j)
#pragma unroll
            for (int e = 0; e < 16; ++e) acc[i][j][e] = 0.f;
    const float* a0 = A + (size_t)(m0 + r) * lda + h;
    const float* a1 = a0 + (size_t)32 * lda;
    const int c0 = n0 + r, c1 = n0 + 32 + r; const bool v0 = c0 < N, v1 = c1 < N;
    const float* b0 = B + (size_t)h * ldb + (v0 ? c0 : 0);
    const float* b1 = B + (size_t)h * ldb + (v1 ? c1 : 0);
#pragma unroll 4
    for (int k = 0; k < K; k += 2) {
        const float x0 = a0[k], x1 = a1[k];
        float y0 = b0[(size_t)k * ldb], y1 = b1[(size_t)k * ldb];
        y0 = v0 ? y0 : 0.f; y1 = v1 ? y1 : 0.f;
        acc[0][0] = __builtin_amdgcn_mfma_f32_32x32x2f32(x0, y0, acc[0][0], 0, 0, 0);
        acc[0][1] = __builtin_amdgcn_mfma_f32_32x32x2f32(x0, y1, acc[0][1], 0, 0, 0);
        acc[1][0] = __builtin_amdgcn_mfma_f32_32x32x2f32(x1, y0, acc[1][0], 0, 0, 0);
        acc[1][1] = __builtin_amdgcn_mfma_f32_32x32x2f32(x1, y1, acc[1][1], 0, 0, 0);
    }
#pragma unroll
    for (int i = 0; i < 2; ++i)
#pragma unroll
        for (int j = 0; j < 2; ++j) { const int col = n0 + 32 * j + r;
            if (col < N) {
#pragma unroll
                for (int e = 0; e < 16; ++e) { const int row = m0 + 32 * i + (e & 3) + 8 * (e >> 2) + 4 * h; C[(size_t)row * ldc + col] = acc[i][j][e]; } } }
}

__global__ void __launch_bounds__(256) k_post(float* __restrict__ proj, const float* __restrict__ qnw, const float* __restrict__ knw,
                                               const float* __restrict__ state_pool, float* __restrict__ out) {
    const int m = blockIdx.x * 4 + (threadIdx.x >> 6), lane = threadIdx.x & 63;
    float* p = proj + (size_t)m * NIN;
    for (int hh = 0; hh < 8; ++hh) { const float v = p[CQ + hh * 64 + lane]; const float ss = wave_sum(v * v);
        p[CQ + hh * 64 + lane] = v * (1.0f / sqrtf(ss * (1.f / 64.f) + 1e-6f)) * qnw[lane]; }
    float* ko = m < MP ? out + O_KP + (size_t)m * 128 : out + O_KS + (size_t)(m - MP) * 128;
    float* vo = m < MP ? out + O_VP + (size_t)m * 128 : out + O_VS + (size_t)(m - MP) * 128;
    float* kio = m < MP ? out + O_KIP + (size_t)m * 64 : out + O_KIS + (size_t)(m - MP) * 64;
    for (int g = 0; g < 2; ++g) { const float v = p[CK + g * 64 + lane]; const float ss = wave_sum(v * v);
        const float kn = v * (1.0f / sqrtf(ss * (1.f / 64.f) + 1e-6f)) * knw[lane];
        p[CK + g * 64 + lane] = kn; ko[g * 64 + lane] = kn; vo[g * 64 + lane] = p[CV + g * 64 + lane]; }
    kio[lane] = p[CKI + lane];
    if (lane < 8) p[CWI + lane] *= 0.04419417382415922f;
    if (m < MP) { const int b = m / SEQ, t = m % SEQ;
        if (t >= SEQ - 15) { float* po = out + O_PP + ((size_t)b * 15 + (t - (SEQ - 15))) * 512;
            for (int c = lane; c < 512; c += 64) po[c] = p[CU + c]; }
    } else { const int s = m - MP; float* po = out + O_PS + (size_t)s * 15 * 512;
        for (int i = lane; i < 14 * 512; i += 64) po[i] = state_pool[(size_t)s * 15 * 512 + 512 + i];
        for (int c = lane; c < 512; c += 64) po[14 * 512 + c] = p[CU + c]; }
}

__global__ void __launch_bounds__(256) k_scores_p(const float* __restrict__ proj, float* __restrict__ SC) {
    __shared__ float qs[8][512]; __shared__ float wsm[8][8];
    const int b = blockIdx.y, t0 = blockIdx.x * 8, tid = threadIdx.x;
    for (int i = tid; i < 8 * 512; i += 256) qs[i >> 9][i & 511] = proj[(size_t)(b * SEQ + t0 + (i >> 9)) * NIN + CQI + (i & 511)];
    if (tid < 64) wsm[tid >> 3][tid & 7] = proj[(size_t)(b * SEQ + t0 + (tid >> 3)) * NIN + CWI + (tid & 7)];
    __syncthreads();
    for (int l = tid; l <= t0 + 7; l += 256) {
        float kr[64];
        const float4* kp = (const float4*)(proj + (size_t)(b * SEQ + l) * NIN + CKI);
#pragma unroll
        for (int i = 0; i < 16; ++i) { const float4 v = kp[i]; kr[4 * i] = v.x; kr[4 * i + 1] = v.y; kr[4 * i + 2] = v.z; kr[4 * i + 3] = v.w; }
        for (int q = 0; q < 8; ++q) {
            if (l > t0 + q) continue;
            float s = 0.f;
            for (int hh = 0; hh < 8; ++hh) { float d = 0.f;
#pragma unroll
                for (int e = 0; e < 64; ++e) d += qs[q][hh * 64 + e] * kr[e];
                s += wsm[q][hh] * fmaxf(d, 0.f); }
            SC[(size_t)(b * SEQ + t0 + q) * 2048 + l] = s;
        }
    }
}
__global__ void __launch_bounds__(256) k_scores_s(const float* __restrict__ proj, const float* __restrict__ cache_kidx, const int* __restrict__ page_table,
                                                   float* __restrict__ SCS) {
    __shared__ float qs[512]; __shared__ float wsm[8];
    const int s = blockIdx.x, tid = threadIdx.x; const float* prow = proj + (size_t)(MP + s) * NIN;
    for (int i = tid; i < 512; i += 256) qs[i] = prow[CQI + i];
    if (tid < 8) wsm[tid] = prow[CWI + tid];
    __syncthreads();
    for (int l = tid; l < PAST + 1; l += 256) {
        const float* kp_ = l < PAST ? cache_kidx + ((size_t)page_table[s * NPG + l / PAGE] * PAGE + (l % PAGE)) * 64 : prow + CKI;
        float kr[64];
#pragma unroll
        for (int i = 0; i < 64; ++i) kr[i] = kp_[i];
        float sc = 0.f;
        for (int hh = 0; hh < 8; ++hh) { float d = 0.f;
#pragma unroll
            for (int e = 0; e < 64; ++e) d += qs[hh * 64 + e] * kr[e];
            sc += wsm[hh] * fmaxf(d, 0.f); }
        SCS[(size_t)s * 2112 + l] = sc;
    }
}

__device__ __forceinline__ unsigned f2key(float f) { unsigned u = __float_as_uint(f); if (f == 0.0f) u = 0u; return (u & 0x80000000u) ? ~u : (u | 0x80000000u); }
__global__ void __launch_bounds__(256) k_topk(const float* __restrict__ SC, const float* __restrict__ SCS, int* __restrict__ SEL, int* __restrict__ NSEL) {
    const int m = blockIdx.x * 4 + (threadIdx.x >> 6), lane = threadIdx.x & 63;
    const float* src; int n;
    if (m < MP) { n = (m % SEQ) + 1; src = SC + (size_t)m * 2048; } else { n = PAST + 1; src = SCS + (size_t)(m - MP) * 2112; }
    int* sel = SEL + (size_t)m * 256;
    if (n <= 256) { for (int i = lane; i < n; i += 64) sel[i] = i; if (lane == 0) NSEL[m] = n; return; }
    unsigned key[33];
#pragma unroll
    for (int j = 0; j < 33; ++j) { const int l = j * 64 + lane; key[j] = l < n ? f2key(src[l]) : 0u; }
    unsigned T = 0u;
    for (int bit = 31; bit >= 0; --bit) { const unsigned cand = T | (1u << bit); int cnt = 0;
#pragma unroll
        for (int j = 0; j < 33; ++j) cnt += __popcll(__ballot(key[j] >= cand));
        if (cnt >= 256) T = cand; }
    int cgt = 0;
#pragma unroll
    for (int j = 0; j < 33; ++j) cgt += __popcll(__ballot(key[j] > T));
    const int need = 256 - cgt;
    const unsigned long long lt = (1ull << lane) - 1ull;
    int pos = 0, eq_seen = 0;
#pragma unroll
    for (int j = 0; j < 33; ++j) { const bool gt = key[j] > T, eq = key[j] == T;
        const unsigned long long meq = __ballot(eq); const int eqb = eq_seen + __popcll(meq & lt);
        const bool take = gt || (eq && eqb < need);
        const unsigned long long mt = __ballot(take);
        if (take) sel[pos + __popcll(mt & lt)] = j * 64 + lane;
        pos += __popcll(mt); eq_seen += __popcll(meq); }
    if (lane == 0) NSEL[m] = 256;
}

__global__ void __launch_bounds__(256) k_attn(const float* __restrict__ proj, const float* __restrict__ cache_k, const float* __restrict__ cache_v,
                                               const int* __restrict__ page_table, const int* __restrict__ SEL, const int* __restrict__ NSEL, float* __restrict__ MIX) {
    __shared__ float pl[4][8][256]; __shared__ int il[4][256]; __shared__ float ql[4][512];
    const int w = threadIdx.x >> 6, lane = threadIdx.x & 63, m = blockIdx.x * 4 + w;
    const int nsel = NSEL[m]; const float* prow = proj + (size_t)m * NIN;
    const bool prompt = m < MP; const int b = m / SEQ, s = m - MP;
    for (int i = lane; i < 512; i += 64) ql[w][i] = prow[CQ + i];
    for (int i = lane; i < 256; i += 64) {
        if (i < nsel) { const int l = SEL[(size_t)m * 256 + i]; il[w][i] = l;
            const float* krow = prompt ? proj + (size_t)(b * SEQ + l) * NIN + CK
                                       : (l < PAST ? cache_k + ((size_t)page_table[s * NPG + l / PAGE] * PAGE + (l % PAGE)) * 128 : prow + CK);
            for (int g = 0; g < 2; ++g) { float kr[64];
#pragma unroll
                for (int e = 0; e < 64; ++e) kr[e] = krow[g * 64 + e];
                for (int r = 0; r < 4; ++r) { float d = 0.f;
#pragma unroll
                    for (int e = 0; e < 64; ++e) d += ql[w][(g * 4 + r) * 64 + e] * kr[e];
                    pl[w][g * 4 + r][i] = d * 0.125f; } }
        } else { il[w][i] = 0; for (int hh = 0; hh < 8; ++hh) pl[w][hh][i] = -INFINITY; }
    }
    for (int hh = 0; hh < 8; ++hh) { float v[4]; float mx = -INFINITY;
#pragma unroll
        for (int i = 0; i < 4; ++i) { v[i] = pl[w][hh][lane + 64 * i]; mx = fmaxf(mx, v[i]); }
        mx = wave_max(mx); float sm = 0.f;
#pragma unroll
        for (int i = 0; i < 4; ++i) { v[i] = expf(v[i] - mx); sm += v[i]; }
        sm = wave_sum(sm); const float inv = 1.0f / sm;
#pragma unroll
        for (int i = 0; i < 4; ++i) pl[w][hh][lane + 64 * i] = v[i] * inv; }
    for (int g = 0; g < 2; ++g) { float acc[4] = {0.f, 0.f, 0.f, 0.f};
        for (int i = 0; i < nsel; ++i) { const int l = il[w][i];
            const float* vrow = prompt ? proj + (size_t)(b * SEQ + l) * NIN + CV
                                       : (l < PAST ? cache_v + ((size_t)page_table[s * NPG + l / PAGE] * PAGE + (l % PAGE)) * 128 : prow + CV);
            const float vv = vrow[g * 64 + lane];
#pragma unroll
            for (int r = 0; r < 4; ++r) acc[r] += pl[w][g * 4 + r][i] * vv; }
#pragma unroll
        for (int r = 0; r < 4; ++r) { const int c = (g * 4 + r) * 64 + lane; MIX[(size_t)m * 1024 + c] = acc[r] * silu_f(prow[CGA + c]); } }
}

__global__ void __launch_bounds__(256) k_pool_d(const float* __restrict__ proj, const float* __restrict__ state_pool, float* __restrict__ DB) {
    const size_t idx = (size_t)blockIdx.x * 256 + threadIdx.x; const int m = (int)(idx >> 9), c = (int)(idx & 511);
    const int g = c >> 7, w = 2 << g; const float un = proj[(size_t)m * NIN + CU + c]; float sum = un; float cnt;
    if (m < MP) { const int t = m % SEQ; for (int i = 1; i < w; ++i) if (t - i >= 0) sum += proj[(size_t)(m - i) * NIN + CU + c]; cnt = (float)(t + 1 < w ? t + 1 : w); }
    else { const int s = m - MP; for (int i = 1; i < w; ++i) sum += state_pool[((size_t)s * 15 + (15 - i)) * 512 + c]; cnt = (float)w; }
    DB[idx] = sum / cnt - un;
}
__global__ void __launch_bounds__(256) k_pool_out(const float* __restrict__ proj, const float* __restrict__ DB, const float* __restrict__ w_pool,
                                                   const float* __restrict__ pool_scale, float* __restrict__ MIX) {
    const size_t idx = (size_t)blockIdx.x * 256 + threadIdx.x; const int m = (int)(idx >> 9), col = (int)(idx & 511), g = col >> 7, j = col & 127;
    float acc = 0.f;
    for (int c = 0; c < 128; ++c) acc += DB[(size_t)m * 512 + g * 128 + c] * w_pool[((size_t)g * 128 + c) * 128 + j];
    MIX[(size_t)m * 1024 + 512 + col] = acc * pool_scale[col] * silu_f(proj[(size_t)m * NIN + CGP + col]);
}
__global__ void __launch_bounds__(256) k_final(const float* __restrict__ xp, const float* __restrict__ xs, const float* __restrict__ ada,
                                                const float* __restrict__ YT, float* __restrict__ out) {
    const size_t idx = (size_t)blockIdx.x * 256 + threadIdx.x; const int m = (int)(idx >> 10), c = (int)(idx & 1023);
    const int r = m < MP ? m / SEQ : NB + (m - MP);
    const float x = m < MP ? xp[idx] : xs[idx - (size_t)MP * 1024];
    float* o = m < MP ? out + O_YP + idx : out + O_YS + (idx - (size_t)MP * 1024);
    *o = x + ada[(size_t)r * 3072 + 2048 + c] * YT[idx];
}

}
#endif

#if TEST_MODE
__global__ void __launch_bounds__(256) k_cmp(const void* a, int a_bf16, int lda, const float* ref, int ldr, int rows, int cols, float scale, int act, float* accum) {
    __shared__ float sd[256], sr[256];
    const size_t idx = (size_t)blockIdx.x * 256 + threadIdx.x; float d2 = 0.f, r2 = 0.f;
    if (idx < (size_t)rows * cols) { const size_t r = idx / cols, c = idx % cols;
        const float av = a_bf16 ? bf2f(((const bf16*)a)[r * lda + c]) : ((const float*)a)[r * lda + c];
        float rv = ref[r * ldr + c]; if (act) rv = rv / (1.f + expf(-rv)); rv *= scale;
        d2 = (av - rv) * (av - rv); r2 = rv * rv; if (!(d2 == d2)) d2 = 1e30f; }
    sd[threadIdx.x] = d2; sr[threadIdx.x] = r2; __syncthreads();
    for (int s = 128; s > 0; s >>= 1) { if ((int)threadIdx.x < s) { sd[threadIdx.x] += sd[threadIdx.x + s]; sr[threadIdx.x] += sr[threadIdx.x + s]; } __syncthreads(); }
    if (threadIdx.x == 0) { atomicAdd(accum, sd[0]); atomicAdd(accum + 1, sr[0]); }
}
__global__ void __launch_bounds__(256) k_cmp_sel(const int* SEL, const int* NSEL, const unsigned* bmdump, float* accum) {
    __shared__ float sd[256], sr[256];
    const size_t idx = (size_t)blockIdx.x * 256 + threadIdx.x; const int m = (int)(idx >> 8), i = (int)(idx & 255); float miss = 0.f, tot = 0.f;
    if (m < MP && i < NSEL[m]) { const int l = SEL[(size_t)m * 256 + i]; tot = 1.f; if (!((bmdump[(size_t)m * 64 + (l >> 5)] >> (l & 31)) & 1u)) miss = 1.f; }
    sd[threadIdx.x] = miss; sr[threadIdx.x] = tot; __syncthreads();
    for (int s = 128; s > 0; s >>= 1) { if ((int)threadIdx.x < s) { sd[threadIdx.x] += sd[threadIdx.x + s]; sr[threadIdx.x] += sr[threadIdx.x + s]; } __syncthreads(); }
    if (threadIdx.x == 0) { atomicAdd(accum, sd[0]); atomicAdd(accum + 1, sr[0]); }
}
__global__ void k_cmp_fin2(float* accum, int n, float amp) {
    float best = -1.f; int bi = 0;
    for (int k = 0; k < n; ++k) { const float rel = accum[2 * k] / fmaxf(accum[2 * k + 1], 1e-30f) / accum[32 + k]; if (rel > best) { best = rel; bi = k; } }
    accum[64] = sqrtf(amp * best); accum[65] = (float)bi;
}
__global__ void k_set(float* p, float a, float b, float c, float d, float e) { p[0] = a; p[1] = b; p[2] = c; p[3] = d; p[4] = e; }
__global__ void k_cmp_fin(float* accum, int n, float amp) {
    float best = -1.f; int bi = 0;
    for (int k = 0; k < n; ++k) { const float rel = accum[2 * k] / fmaxf(accum[2 * k + 1], 1e-30f); if (rel > best) { best = rel; bi = k; } }
    accum[64] = sqrtf(amp * best); accum[65] = (float)bi;
}
__global__ void __launch_bounds__(256) k_perturb(float* out, const float* accum) {
    const size_t offs[11] = {O_YP, O_YS, O_KP, O_VP, O_KIP, O_PP, O_KS, O_VS, O_KIS, O_PS, O_END};
    const int k = (int)accum[65] % 10; const float f = 1.0f + accum[64];
    for (size_t i = offs[k] + (size_t)blockIdx.x * 256 + threadIdx.x; i < offs[k + 1]; i += (size_t)gridDim.x * 256) out[i] *= f;
}
__global__ void __launch_bounds__(256) k_f32_to_bf16(const float* src, bf16* dst, size_t n) {
    for (size_t i = (size_t)blockIdx.x * 256 + threadIdx.x; i < n; i += (size_t)gridDim.x * 256) dst[i] = (bf16)f2bf(src[i]);
}
#endif

#if TEST_MODE == 5
__global__ void __launch_bounds__(256) k_stat(float* out, const unsigned* st, int which) {
    float v = which == 0 ? (float)st[0] : (which == 1 ? (float)st[1] / fmaxf((float)st[2], 1.f) : (float)st[3]);
    const float f = 1.0f + sqrtf(v * 1e-5f);
    for (size_t i = O_KS + (size_t)blockIdx.x * 256 + threadIdx.x; i < O_VS; i += (size_t)gridDim.x * 256) out[i] *= f;
}
#endif
#if TEST_MODE == 4
__global__ void __launch_bounds__(256) k_time(float* out, const unsigned long long* ts, int i0, int i1, float scale) {
    const float us = (float)(ts[i1] - ts[i0]) * 0.01f; const float f = 1.0f + sqrtf(us * scale);
    for (size_t i = O_KS + (size_t)blockIdx.x * 256 + threadIdx.x; i < O_VS; i += (size_t)gridDim.x * 256) out[i] *= f;
}
#endif
extern "C" void kernel_launch(void* const* d_in, const int* in_sizes, int n_in, void* d_out, int out_size, void* d_ws, size_t ws_size, hipStream_t stream) {
    static int grid = 0;
    if (grid == 0) {
        size_t need = WS_MEGA_END;
#if TEST_MODE && TEST_MODE < 4
        need = 192 * MiB + gold::W_END * 4;
#endif
        if (n_in != 18 || out_size != (int)O_END || ws_size < need) { fprintf(stderr, "kernel_launch: unexpected sizes: n_in %d out %d ws %zu (need %zu)\n", n_in, out_size, ws_size, need); grid = -1; return; }
        int dev = 0, cus = 0, per_cu = 0;
        if (hipGetDevice(&dev) != hipSuccess || hipDeviceGetAttribute(&cus, hipDeviceAttributeMultiprocessorCount, dev) != hipSuccess) { grid = -1; return; }
        if (hipFuncSetAttribute((const void*)mk_fwd, hipFuncAttributeMaxDynamicSharedMemorySize, LDS_BYTES) != hipSuccess) { fprintf(stderr, "kernel_launch: hipFuncSetAttribute failed\n"); grid = -1; return; }
        if (hipOccupancyMaxActiveBlocksPerMultiprocessor(&per_cu, (const void*)mk_fwd, NWAVES * 64, LDS_BYTES) != hipSuccess || per_cu < 1) { fprintf(stderr, "kernel_launch: occupancy query says %d blocks/CU\n", per_cu); (void)hipGetLastError(); grid = -1; return; }
        if (cus < 64) { fprintf(stderr, "kernel_launch: needs >= 64 CUs\n"); grid = -1; return; }
        grid = cus;
    }
    if (grid < 0) return;
    (void)hipMemsetAsync((char*)d_ws + WS_CTL, 0, CTL_ZERO_BYTES, stream);
    Args a{};
    for (int i = 0; i < 18; ++i) a.in[i] = (const float*)d_in[i];
    a.out = (float*)d_out; a.ws = (unsigned char*)d_ws;
#if TEST_MODE == 5
    a.ph_lo = 0; a.ph_hi = 5; a.li = 0;
    hipLaunchKernelGGL(mk_fwd, dim3(grid), dim3(NWAVES * 64), LDS_BYTES, stream, a);
    k_stat<<<16, 256, 0, stream>>>((float*)d_out, (const unsigned*)((char*)d_ws + WS_CTL + 900 * 1024), STATSEL);
#elif TEST_MODE == 4
    a.ph_lo = 0; a.ph_hi = 5; a.li = 0;
    hipLaunchKernelGGL(mk_fwd, dim3(grid), dim3(NWAVES * 64), LDS_BYTES, stream, a);
    k_time<<<16, 256, 0, stream>>>((float*)d_out, (const unsigned long long*)((char*)d_ws + WS_CTL + 768 * 1024), TS0, TS1, 1e-5f);
#elif TEST_MODE && TEST_MODE < 4
    {
        using namespace gold;
        const float* xp = (const float*)d_in[0]; const float* xs = (const float*)d_in[1];
        const float* cache_k = (const float*)d_in[2]; const float* cache_v = (const float*)d_in[3]; const float* cache_kidx = (const float*)d_in[4];
        const float* state_pool = (const float*)d_in[5]; const int* page_table = (const int*)d_in[6];
        const float* cp = (const float*)d_in[7]; const float* cs = (const float*)d_in[8]; const float* norm_w = (const float*)d_in[9];
        const float* w_ada = (const float*)d_in[10]; const float* b_ada = (const float*)d_in[11]; const float* w_in = (const float*)d_in[12];
        const float* qnw = (const float*)d_in[13]; const float* knw = (const float*)d_in[14]; const float* w_pool = (const float*)d_in[15];
        const float* pool_scale = (const float*)d_in[16]; const float* w_out = (const float*)d_in[17];
        float* out = (float*)d_out; float* ws = (float*)((char*)d_ws + 192 * MiB);
        float *ADA = ws + W_ADA, *H = ws + W_H, *PROJ = ws + W_PROJ, *SC = ws + W_SC, *SCS = ws + W_SCS, *MIX = ws + W_MIX, *DB = ws + W_DB, *YT = ws + W_YT;
        int *SEL = (int*)(ws + W_SEL), *NSEL = (int*)(ws + W_NSEL);
        k_ada<<<dim3(12, NR), 256, 0, stream>>>(cp, cs, w_ada, b_ada, ADA);
        k_h<<<MT / 4, 256, 0, stream>>>(xp, xs, norm_w, ADA, H);
        k_gemm<<<dim3((NIN + 127) / 128, MT / 128), 256, 0, stream>>>(H, w_in, PROJ, MT, NIN, DM, DM, NIN, NIN);
        k_post<<<MT / 4, 256, 0, stream>>>(PROJ, qnw, knw, state_pool, out);
        k_scores_p<<<dim3(SEQ / 8, NB), 256, 0, stream>>>(PROJ, SC);
        k_scores_s<<<DECB, 256, 0, stream>>>(PROJ, cache_kidx, page_table, SCS);
        k_topk<<<MT / 4, 256, 0, stream>>>(SC, SCS, SEL, NSEL);
        k_attn<<<MT / 4, 256, 0, stream>>>(PROJ, cache_k, cache_v, page_table, SEL, NSEL, MIX);
        k_pool_d<<<(MT * 512) / 256, 256, 0, stream>>>(PROJ, state_pool, DB);
        k_pool_out<<<(MT * 512) / 256, 256, 0, stream>>>(PROJ, DB, w_pool, pool_scale, MIX);
        k_gemm<<<dim3(1024 / 128, MT / 128), 256, 0, stream>>>(MIX, w_out, YT, MT, 1024, 1024, 1024, 1024, 1024);
        k_final<<<(MT * 1024) / 256, 256, 0, stream>>>(xp, xs, ADA, YT, out);
        unsigned char* mws = (unsigned char*)d_ws;
#if TEST_MODE == 1
        a.ph_lo = 0; a.ph_hi = 3; a.li = 0;
        hipLaunchKernelGGL(mk_fwd, dim3(grid), dim3(NWAVES * 64), LDS_BYTES, stream, a);
        float* accum = (float*)(mws + WS_CTL + 512 * 1024);
        struct { const void* a; int bf; int lda; int refcol; int cols; float scale; int act; } L[9] = {
            {mws + WS_Q, 1, 512, CQ, 512, C2, 0}, {mws + WS_QI, 1, 512, CQI, 512, 1.f, 0}, {mws + WS_GA, 1, 512, CGA, 512, 1.f, 1}, {mws + WS_U, 1, 512, CU, 512, 1.f, 0},
            {mws + WS_GP, 1, 512, CGP, 512, 1.f, 1}, {mws + WS_KB, 1, 128, CK, 128, 1.f, 0}, {mws + WS_VB, 1, 128, CV, 128, 1.f, 0}, {mws + WS_KI, 1, 64, CKI, 64, 1.f, 0},
            {mws + WS_WI, 0, 8, CWI, 8, 1.f, 0} };
        for (int k = 0; k < 9; ++k) k_cmp<<<(unsigned)(((size_t)MT * L[k].cols + 255) / 256), 256, 0, stream>>>(L[k].a, L[k].bf, L[k].lda, PROJ + L[k].refcol, NIN, MT, L[k].cols, L[k].scale, L[k].act, accum + 2 * k);
        k_cmp<<<(NR * 3072 + 255) / 256, 256, 0, stream>>>(mws + WS_ADA, 0, 3072, ADA, 3072, NR, 3072, 1.f, 0, accum + 18);
        k_cmp_fin<<<1, 1, 0, stream>>>(accum, 10, 5.0f);
        k_perturb<<<1024, 256, 0, stream>>>(out, accum);
#elif TEST_MODE == 3
        a.ph_lo = 0; a.ph_hi = 5; a.li = 0;
        hipLaunchKernelGGL(mk_fwd, dim3(grid), dim3(NWAVES * 64), LDS_BYTES, stream, a);
        float* accum = (float*)(mws + WS_CTL + 512 * 1024);
        const bf16* MB = (const bf16*)(mws + WS_MIX);
        k_cmp<<<(unsigned)(((size_t)MP * 512 + 255) / 256), 256, 0, stream>>>(MB, 1, 1024, MIX, 1024, MP, 512, 1.f, 0, accum + 0);
        k_cmp<<<(unsigned)(((size_t)MP * 512 + 255) / 256), 256, 0, stream>>>(MB + 512, 1, 1024, MIX + 512, 1024, MP, 512, 1.f, 0, accum + 2);
        k_cmp<<<(DECB * 512 + 255) / 256, 256, 0, stream>>>(MB + (size_t)MP * 1024, 1, 1024, MIX + (size_t)MP * 1024, 1024, DECB, 512, 1.f, 0, accum + 4);
        k_cmp<<<(DECB * 512 + 255) / 256, 256, 0, stream>>>(MB + (size_t)MP * 1024 + 512, 1, 1024, MIX + (size_t)MP * 1024 + 512, 1024, DECB, 512, 1.f, 0, accum + 6);
        k_cmp_sel<<<MP, 256, 0, stream>>>(SEL, NSEL, (const unsigned*)(mws + WS_DBG_BM), accum + 8);
        k_set<<<1, 1, 0, stream>>>(accum + 32, P3_TOL0, P3_TOL1, P3_TOL2, P3_TOL3, P3_TOL4);
        k_cmp_fin2<<<1, 1, 0, stream>>>(accum, 5, 1e-5f);
        k_perturb<<<1024, 256, 0, stream>>>(out, accum);
#elif TEST_MODE == 2
        a.ph_lo = 0; a.ph_hi = 3; a.li = 0;
        hipLaunchKernelGGL(mk_fwd, dim3(grid), dim3(NWAVES * 64), LDS_BYTES, stream, a);
        k_f32_to_bf16<<<2048, 256, 0, stream>>>(MIX, (bf16*)(mws + WS_MIX), (size_t)MT * 1024);
        a.ph_lo = 4; a.ph_hi = 5; a.li = 1;
        hipLaunchKernelGGL(mk_fwd, dim3(grid), dim3(NWAVES * 64), LDS_BYTES, stream, a);
#endif
    }
#else
    a.ph_lo = 0; a.ph_hi = 5; a.li = 0;
    hipLaunchKernelGGL(mk_fwd, dim3(grid), dim3(NWAVES * 64), LDS_BYTES, stream, a);
#endif
}
```

```cpp
#define TEST_MODE 0
#define HAVE_P3 1
#define REP_S1 1
#define REP_S2 1
#define REP_S4 1
#define REP_P0 1
#define REP_P1 1
#define REP_P4S 1
#define REP_P2G 1
#define REP_P4G 1
#define REP_P2S 1
#define REP_SMP 1
#define REP_POOL 1
#define STATSEL 0
#define STAMP_BLK 0
#define P3FINE 0
#define TS0 0
#define TS1 1
#define P3_TOL0 1e-2f
#define P3_TOL1 1e-4f
#define P3_TOL2 1e-2f
#define P3_TOL3 1e-4f
#define P3_TOL4 3e-2f
#include <hip/hip_runtime.h>
#include <cstdio>
#include <cstdint>

constexpr int DM = 1024, NB = 8, SEQ = 2048, DECB = 128, PAST = 2048, PAGE = 128, NPG = 16;
constexpr int NIN = 2888, MP = NB * SEQ, MT = MP + DECB, NR = NB + DECB;
constexpr int CQ = 0, CK = 512, CV = 640, CQI = 768, CKI = 1280, CWI = 1344, CGA = 1352, CU = 1864, CGP = 2376;
constexpr size_t O_YP = 0, O_YS = 16777216, O_KP = 16908288, O_VP = 19005440, O_KIP = 21102592, O_PP = 22151168,
                 O_KS = 22212608, O_VS = 22228992, O_KIS = 22245376, O_PS = 22253568, O_END = 23236608;
constexpr float C2 = 0.125f * 1.4426950408889634f;
constexpr float WI_SCALE = 0.04419417382415922f;
constexpr float EPS = 1e-6f;
constexpr size_t MiB = 1u << 20;
constexpr size_t WS_CTL = 0, CTL_ZERO_BYTES = 1 * MiB;
constexpr size_t WS_ADA = 1 * MiB, WS_WINT = 3 * MiB, WS_WOUTT = 9 * MiB, WS_WPOOLT = 11 * MiB, WS_HS = 12 * MiB, WS_HB = 24 * MiB,
                 WS_Q = 56 * MiB, WS_QI = 73 * MiB, WS_GA = 90 * MiB, WS_U = 107 * MiB, WS_GP = 124 * MiB, WS_KB = 141 * MiB, WS_VB = 146 * MiB,
                 WS_KI = 151 * MiB, WS_WI = 154 * MiB, WS_MIX = 155 * MiB, WS_DBG_BM = 188 * MiB, WS_MEGA_END = 192 * MiB;
namespace pg8 {
#define PG8_LAS __attribute__((address_space(3)))
typedef unsigned short bf16_t;
typedef short bf16x8 __attribute__((ext_vector_type(8)));
typedef float f32x4 __attribute__((ext_vector_type(4)));
typedef unsigned u32x4 __attribute__((ext_vector_type(4)));
constexpr int BM = 256, BK = 64, HALF = 128, HTB = HALF * BK * 2  , STAGE_BYTES = 8 * HTB, NXCD = 8, WGM = 8;

__host__ __device__ __forceinline__ int lds_byte(int r, int c) { const int st = (r >> 4) * 2 + (c >> 5), rr = r & 15, cc = c & 31, ob = rr * 64 + cc * 2; return st * 1024 + (ob ^ (((ob >> 9) & 1) << 5)); }
__host__ __device__ __forceinline__ void stage_rc(int b, int& R, int& C) { const int st = b / 1024, sb = b % 1024, swz = sb ^ (((sb >> 9) & 1) << 5); R = (st >> 1) * 16 + swz / 64; C = (st & 1) * 32 + (swz % 64) / 2; }
__host__ __device__ __forceinline__ int perm32(int rho) { const int n = rho >> 4, i = rho & 15; return 8 * (i >> 2) + 4 * n + (i & 3); }

struct Unit { int pm, pn; };
struct Gemm { const bf16_t* A; const bf16_t* Bt; int M, N, K; };

struct StaticOrder {
    int nM, nN, nwg, G, c;
    __host__ __device__ void init(int M, int N, int G_, int c_) { nM = M / BM; nN = N / BM; nwg = nM * nN; G = G_; c = c_; }
    __host__ __device__ bool next(int i, Unit& u) const {
        const long L = (long)i * G + c; if (L >= nwg) return false;
        int wgid = (int)L; { const int q = nwg / NXCD, r = nwg % NXCD, xcd = wgid % NXCD, off = wgid / NXCD; wgid = (xcd < r ? xcd * (q + 1) : r * (q + 1) + (xcd - r) * q) + off; }
        const int nig = WGM * nN, gid = wgid / nig, fm = gid * WGM, gsz = (nM - fm) < WGM ? (nM - fm) : WGM;
        u.pm = fm + ((wgid % nig) % gsz); u.pn = (wgid % nig) / gsz; return true;
    }
    __device__ __forceinline__ void a_ready(const Unit&) const {}
    __device__ __forceinline__ void done(const Unit&) const {}
};


typedef unsigned u32x4 __attribute__((ext_vector_type(4)));
__device__ __forceinline__ unsigned cvt_pk_bf16(float lo, float hi) { unsigned r; asm volatile("v_cvt_pk_bf16_f32 %0, %1, %2" : "=v"(r) : "v"(lo), "v"(hi)); return r; }
__device__ __forceinline__ void st_bf16x8(bf16_t* p, const f32x4 a, const f32x4 b) {
    u32x4 w; w.x = cvt_pk_bf16(a[0], a[1]); w.y = cvt_pk_bf16(a[2], a[3]); w.z = cvt_pk_bf16(b[0], b[1]); w.w = cvt_pk_bf16(b[2], b[3]); *(u32x4*)p = w; }
__device__ __forceinline__ float silu1(float x) { return x * __builtin_amdgcn_rcpf(1.0f + __builtin_amdgcn_exp2f(-1.4426950408889634f * x)); }
__device__ __forceinline__ f32x4 silu4(const f32x4 v) { f32x4 r; r[0] = silu1(v[0]); r[1] = silu1(v[1]); r[2] = silu1(v[2]); r[3] = silu1(v[3]); return r; }

struct EpiIn {
    static constexpr bool PERM = true, AFTER_DRAIN = false;
    unsigned char* ws; float* out; const float* qnw; const float* knw;
    __device__ __forceinline__ void operator()(const f32x4 (&acc)[2][2][4][2], const Unit& u, int wr, int wc, int fr, int fq) const {
        const int pn = u.pn;
        if (pn == 5 && wc >= 2) return;
        const int rowb = u.pm * 256 + wr * 64 + fr, dof = 8 * fq;
        if (pn <= 1 || (pn == 2 && wc < 2)) {
            const float* nwp = pn <= 1 ? qnw : knw; const float sc = pn <= 1 ? C2 : 1.0f;
            f32x4 wv[2][2];
#pragma unroll
            for (int bj = 0; bj < 2; ++bj)
#pragma unroll
                for (int n = 0; n < 2; ++n) wv[bj][n] = *(const f32x4*)(nwp + 32 * bj + dof + 4 * n) * sc;
#pragma unroll
            for (int ai = 0; ai < 2; ++ai)
#pragma unroll
                for (int m = 0; m < 4; ++m) { const size_t row = (size_t)(rowb + ai * 128 + m * 16); float ss = 0.f;
#pragma unroll
                    for (int bj = 0; bj < 2; ++bj)
#pragma unroll
                        for (int n = 0; n < 2; ++n) { const f32x4 x = acc[ai][bj][m][n]; ss += (x[0] * x[0] + x[1] * x[1]) + (x[2] * x[2] + x[3] * x[3]); }
                    ss += __shfl_xor(ss, 16); ss += __shfl_xor(ss, 32);
                    const float rstd = 1.0f / sqrtf(ss * (1.0f / 64.0f) + EPS);
                    f32x4 o[2][2];
#pragma unroll
                    for (int bj = 0; bj < 2; ++bj)
#pragma unroll
                        for (int n = 0; n < 2; ++n) o[bj][n] = acc[ai][bj][m][n] * rstd * wv[bj][n];
                    if (pn <= 1) { bf16_t* q = (bf16_t*)(ws + WS_Q) + row * 512 + (4 * pn + wc) * 64 + dof; st_bf16x8(q, o[0][0], o[0][1]); st_bf16x8(q + 32, o[1][0], o[1][1]); }
                    else { float* ko = out + O_KP + row * 128 + wc * 64 + dof; *(f32x4*)ko = o[0][0]; *(f32x4*)(ko + 4) = o[0][1]; *(f32x4*)(ko + 32) = o[1][0]; *(f32x4*)(ko + 36) = o[1][1];
                        bf16_t* kb = (bf16_t*)(ws + WS_KB) + row * 128 + wc * 64 + dof; st_bf16x8(kb, o[0][0], o[0][1]); st_bf16x8(kb + 32, o[1][0], o[1][1]); } }
            return;
        }
        if (pn == 5 && wc == 1) {
            if (fq == 0) {
#pragma unroll
                for (int ai = 0; ai < 2; ++ai)
#pragma unroll
                    for (int m = 0; m < 4; ++m) { const size_t row = (size_t)(rowb + ai * 128 + m * 16); float* wp = (float*)(ws + WS_WI) + row * 8;
                        *(f32x4*)wp = acc[ai][0][m][0] * WI_SCALE; *(f32x4*)(wp + 4) = acc[ai][0][m][1] * WI_SCALE; } }
            return;
        }
        bf16_t* dst; int ld, cb; float* fo = nullptr; int fld = 0; bool act = false;
        if (pn == 2) { dst = (bf16_t*)(ws + WS_VB); ld = 128; cb = (wc - 2) * 64; fo = out + O_VP + cb; fld = 128; }
        else if (pn <= 4) { dst = (bf16_t*)(ws + WS_QI); ld = 512; cb = (4 * (pn - 3) + wc) * 64; }
        else if (pn == 5) { dst = (bf16_t*)(ws + WS_KI); ld = 64; cb = 0; fo = out + O_KIP; fld = 64; }
        else if (pn <= 7) { dst = (bf16_t*)(ws + WS_GA); ld = 512; cb = (4 * (pn - 6) + wc) * 64; act = true; }
        else if (pn <= 9) { dst = (bf16_t*)(ws + WS_U); ld = 512; cb = (4 * (pn - 8) + wc) * 64; }
        else { dst = (bf16_t*)(ws + WS_GP); ld = 512; cb = (4 * (pn - 10) + wc) * 64; act = true; }
        const bool is_u = (pn == 8 || pn == 9);
#pragma unroll
        for (int ai = 0; ai < 2; ++ai)
#pragma unroll
            for (int m = 0; m < 4; ++m) { const int rowi = rowb + ai * 128 + m * 16; const size_t row = (size_t)rowi;
                f32x4 o00 = acc[ai][0][m][0], o01 = acc[ai][0][m][1], o10 = acc[ai][1][m][0], o11 = acc[ai][1][m][1];
                if (act) { o00 = silu4(o00); o01 = silu4(o01); o10 = silu4(o10); o11 = silu4(o11); }
                bf16_t* d = dst + row * ld + cb + dof; st_bf16x8(d, o00, o01); st_bf16x8(d + 32, o10, o11);
                if (fo) { float* f = fo + row * fld + dof; *(f32x4*)f = o00; *(f32x4*)(f + 4) = o01; *(f32x4*)(f + 32) = o10; *(f32x4*)(f + 36) = o11; }
                if (is_u) { const int t = rowi & (SEQ - 1);
                    if (t >= SEQ - 15) { float* f = out + O_PP + ((size_t)(rowi >> 11) * 15 + (t - (SEQ - 15))) * 512 + cb + dof;
                        *(f32x4*)f = o00; *(f32x4*)(f + 4) = o01; *(f32x4*)(f + 32) = o10; *(f32x4*)(f + 36) = o11; } } }
    }
};
struct EpiOut {
    static constexpr bool PERM = true, AFTER_DRAIN = false;
    const float* x; float* y; const float* ada;
    __device__ __forceinline__ void operator()(const f32x4 (&acc)[2][2][4][2], const Unit& u, int wr, int wc, int fr, int fq) const {
        const int col0 = u.pn * 256 + wc * 32 + 8 * fq; const float* gp = ada + (size_t)(u.pm >> 3) * 3072 + 2048 + col0;
        f32x4 g[2][2];
#pragma unroll
        for (int bj = 0; bj < 2; ++bj)
#pragma unroll
            for (int n = 0; n < 2; ++n) g[bj][n] = *(const f32x4*)(gp + 128 * bj + 4 * n);
#pragma unroll
        for (int ai = 0; ai < 2; ++ai)
#pragma unroll
            for (int m = 0; m < 4; ++m) { const size_t off = (size_t)(u.pm * 256 + ai * 128 + wr * 64 + m * 16 + fr) * 1024 + col0;
#pragma unroll
                for (int bj = 0; bj < 2; ++bj)
#pragma unroll
                    for (int n = 0; n < 2; ++n) { const f32x4 xv = *(const f32x4*)(x + off + 128 * bj + 4 * n); *(f32x4*)(y + off + 128 * bj + 4 * n) = xv + g[bj][n] * acc[ai][bj][m][n]; } }
    }
};
template <class Epi, class Sched, bool ALIGN_EPI = false, bool SP2 = false>
__device__ __forceinline__ void gemm_phase(PG8_LAS unsigned char* lds, const Gemm g, const Sched& S, const Epi& E) {
    const int tid = threadIdx.x, wid = __builtin_amdgcn_readfirstlane(tid >> 6), lane = tid & 63, wr = wid >> 2, wc = wid & 3, fr = lane & 15, fq = lane >> 4;
    const int K = g.K, nt = K / BK;
    unsigned voffA[2], voffB[2];
#pragma unroll
    for (int i = 0; i < 2; ++i) { int R, C; stage_rc(tid * 16 + i * 8192, R, C); const int Rb = Epi::PERM ? ((R & ~31) + perm32(R & 31)) : R;
        voffA[i] = (unsigned)(R * K + C) * 2u; voffB[i] = (unsigned)(Rb * K + C) * 2u; }
    const size_t kstep = (size_t)(BK * 2);
    const size_t hstep = (size_t)HALF * K * 2;
    const size_t tstep = 2 * hstep;
    const unsigned ldsw = (unsigned)wid * 1024u;
    const int aoff = lds_byte(wr * 64 + fr, fq * 8), boff = lds_byte(wc * 32 + fr, fq * 8);
#define PG8_SA(b, h) (((b) * 2 + (h)) * HTB)
#define PG8_SB(b, h) ((4 + (b) * 2 + (h)) * HTB)
#define PG8_STAGE(bufoff, gbase, voff) do { _Pragma("unroll") for (int _i = 0; _i < 2; ++_i) \
        __builtin_amdgcn_global_load_lds((const unsigned*)((const char*)(gbase) + (voff)[_i]), (PG8_LAS unsigned*)(lds + (bufoff) + ldsw + _i * 8192), 16, 0, 0); } while (0)
#define PG8_LDA(dst, b, h) do { _Pragma("unroll") for (int m = 0; m < 4; ++m) _Pragma("unroll") for (int k = 0; k < 2; ++k) dst[m][k] = *(const PG8_LAS bf16x8*)(lds + PG8_SA(b, h) + aoff + m * 2048 + k * 1024); } while (0)
#define PG8_LDB(dst, b, h) do { _Pragma("unroll") for (int n = 0; n < 2; ++n) _Pragma("unroll") for (int k = 0; k < 2; ++k) dst[n][k] = *(const PG8_LAS bf16x8*)(lds + PG8_SB(b, h) + boff + n * 2048 + k * 1024); } while (0)
#define PG8_MMA(ai, bj, At, Bt) do { __builtin_amdgcn_s_setprio(1); _Pragma("unroll") for (int m = 0; m < 4; ++m) _Pragma("unroll") for (int n = 0; n < 2; ++n) _Pragma("unroll") for (int k = 0; k < 2; ++k) \
        acc[ai][bj][m][n] = __builtin_amdgcn_mfma_f32_16x16x32_bf16(Bt[n][k], At[m][k], acc[ai][bj][m][n], 0, 0, 0); __builtin_amdgcn_s_setprio(0); } while (0)
#define PG8_WAIT_V(n) asm volatile("s_waitcnt vmcnt(" #n ")" ::: "memory")
#define PG8_WAIT_L(n) asm volatile("s_waitcnt lgkmcnt(" #n ")" ::: "memory")
#define PG8_BAR __builtin_amdgcn_s_barrier()
#define PG8_SCHED __builtin_amdgcn_sched_barrier(0)
    Unit cur, nxt; int ui = 0;
    if (!S.next(0, cur)) return;
    f32x4 acc[2][2][4][2];
#pragma unroll
    for (int a = 0; a < 2; ++a)
#pragma unroll
        for (int b = 0; b < 2; ++b)
#pragma unroll
            for (int m = 0; m < 4; ++m)
#pragma unroll
                for (int n = 0; n < 2; ++n) acc[a][b][m][n] = (f32x4){0.f, 0.f, 0.f, 0.f};
    bf16x8 At[4][2], B0[2][2], B1[2][2];
    const char* cA = (const char*)g.A + (size_t)cur.pm * tstep; const char* cB = (const char*)g.Bt + (size_t)cur.pn * tstep;
    S.a_ready(cur);
    if constexpr (SP2) {
        PG8_STAGE(PG8_SB(0, 0), cB, voffB); PG8_STAGE(PG8_SB(0, 1), cB + hstep, voffB); PG8_STAGE(PG8_SA(0, 0), cA, voffA); PG8_STAGE(PG8_SA(0, 1), cA + hstep, voffA);
        if (wr == 1) PG8_BAR;
        PG8_WAIT_V(2); PG8_BAR;
        PG8_STAGE(PG8_SB(1, 0), cB + kstep, voffB); PG8_STAGE(PG8_SA(1, 0), cA + kstep, voffA); PG8_STAGE(PG8_SB(1, 1), cB + hstep + kstep, voffB);
        PG8_WAIT_V(6); PG8_BAR;
    } else {
        PG8_STAGE(PG8_SB(0, 0), cB, voffB); PG8_STAGE(PG8_SA(0, 0), cA, voffA); PG8_STAGE(PG8_SB(0, 1), cB + hstep, voffB); PG8_STAGE(PG8_SA(0, 1), cA + hstep, voffA);
        if (wr == 1) PG8_BAR;
        PG8_WAIT_V(4); PG8_BAR;
        PG8_STAGE(PG8_SB(1, 0), cB + kstep, voffB); PG8_STAGE(PG8_SA(1, 0), cA + kstep, voffA); PG8_STAGE(PG8_SB(1, 1), cB + hstep + kstep, voffB);
        PG8_WAIT_V(6); PG8_BAR;
    }
    for (;;) {
        const bool has_next = S.next(ui + 1, nxt);
        const char* nA = has_next ? (const char*)g.A + (size_t)nxt.pm * tstep : cA; const char* nB = has_next ? (const char*)g.Bt + (size_t)nxt.pn * tstep : cB;
        for (int t = 0; t < nt; t += 2) {
            const bool last = (t == nt - 2);
            const char* a1 = cA + (size_t)(t + 1) * kstep;
            const char* a2 = last ? nA : cA + (size_t)(t + 2) * kstep; const char* b2 = last ? nB : cB + (size_t)(t + 2) * kstep;
            const char* a3 = a2 + kstep; const char* b3 = b2 + kstep;
            if (last && has_next) S.a_ready(nxt);
            if constexpr (SP2) {
            PG8_LDB(B0, 0, 0); PG8_LDB(B1, 0, 1); PG8_SCHED; PG8_LDA(At, 0, 0); PG8_STAGE(PG8_SA(1, 1), a1 + hstep, voffA);
            PG8_WAIT_V(8); PG8_WAIT_L(0); PG8_BAR; PG8_MMA(0, 0, At, B0); PG8_MMA(0, 1, At, B1); PG8_BAR; PG8_SCHED;
            PG8_LDA(At, 0, 1); PG8_STAGE(PG8_SB(0, 0), b2, voffB); PG8_STAGE(PG8_SB(0, 1), b2 + hstep, voffB); PG8_STAGE(PG8_SA(0, 0), a2, voffA);
            PG8_WAIT_V(8); PG8_WAIT_L(0); PG8_BAR; PG8_MMA(1, 0, At, B0); PG8_MMA(1, 1, At, B1); PG8_BAR; PG8_SCHED;
            PG8_LDB(B0, 1, 0); PG8_LDB(B1, 1, 1); PG8_SCHED; PG8_LDA(At, 1, 0); PG8_STAGE(PG8_SA(0, 1), a2 + hstep, voffA);
            PG8_WAIT_V(8); PG8_WAIT_L(0); PG8_BAR; PG8_MMA(0, 0, At, B0); PG8_MMA(0, 1, At, B1); PG8_BAR; PG8_SCHED;
            PG8_LDA(At, 1, 1); PG8_STAGE(PG8_SB(1, 0), b3, voffB); PG8_STAGE(PG8_SB(1, 1), b3 + hstep, voffB); PG8_STAGE(PG8_SA(1, 0), a3, voffA);
            PG8_WAIT_V(8); PG8_WAIT_L(0); PG8_BAR; PG8_MMA(1, 0, At, B0); PG8_MMA(1, 1, At, B1); PG8_BAR; PG8_SCHED;
            } else {
            PG8_LDB(B0, 0, 0); PG8_SCHED; PG8_LDA(At, 0, 0); PG8_STAGE(PG8_SA(1, 1), a1 + hstep, voffA);
            PG8_WAIT_L(8); PG8_BAR; PG8_WAIT_L(0); PG8_MMA(0, 0, At, B0); PG8_BAR; PG8_SCHED;
            PG8_LDB(B1, 0, 1); PG8_STAGE(PG8_SB(0, 0), b2, voffB);
            PG8_BAR; PG8_WAIT_L(0); PG8_MMA(0, 1, At, B1); PG8_BAR;
            PG8_LDA(At, 0, 1); PG8_STAGE(PG8_SA(0, 0), a2, voffA);
            PG8_BAR; PG8_WAIT_L(0); PG8_MMA(1, 0, At, B0); PG8_BAR; PG8_SCHED;
            PG8_STAGE(PG8_SB(0, 1), b2 + hstep, voffB);
            PG8_WAIT_V(6); PG8_BAR; PG8_MMA(1, 1, At, B1); PG8_BAR;
            PG8_LDB(B0, 1, 0); PG8_SCHED; PG8_LDA(At, 1, 0); PG8_STAGE(PG8_SA(0, 1), a2 + hstep, voffA);
            PG8_WAIT_L(8); PG8_BAR; PG8_WAIT_L(0); PG8_MMA(0, 0, At, B0); PG8_BAR; PG8_SCHED;
            PG8_LDB(B1, 1, 1); PG8_STAGE(PG8_SB(1, 0), b3, voffB);
            PG8_BAR; PG8_WAIT_L(0); PG8_MMA(0, 1, At, B1); PG8_BAR;
            PG8_LDA(At, 1, 1); PG8_STAGE(PG8_SA(1, 0), a3, voffA);
            PG8_BAR; PG8_WAIT_L(0); PG8_MMA(1, 0, At, B0); PG8_BAR; PG8_SCHED;
            PG8_STAGE(PG8_SB(1, 1), b3 + hstep, voffB);
            PG8_WAIT_V(6); PG8_BAR; PG8_MMA(1, 1, At, B1); PG8_BAR;
            }
        }
        if constexpr (ALIGN_EPI) { if (wr == 0) PG8_BAR; }
        if constexpr (!Epi::AFTER_DRAIN) { E(acc, cur, wr, wc, fr, fq); S.done(cur); }
        if (!has_next) break;
#pragma unroll
        for (int a = 0; a < 2; ++a)
#pragma unroll
            for (int b = 0; b < 2; ++b)
#pragma unroll
                for (int m = 0; m < 4; ++m)
#pragma unroll
                    for (int n = 0; n < 2; ++n) acc[a][b][m][n] = (f32x4){0.f, 0.f, 0.f, 0.f};
        cur = nxt; cA = nA; cB = nB; ++ui;
        if constexpr (ALIGN_EPI) { if (wr == 1) PG8_BAR; }
    }
    PG8_WAIT_V(0);
    if constexpr (!ALIGN_EPI) { if (wr == 0) PG8_BAR; }
    PG8_BAR;
    if constexpr (Epi::AFTER_DRAIN) { E.fused(acc, cur, wr, wc, fr, fq, lds, wid, lane); S.done(cur); }
#undef PG8_SA
#undef PG8_SB
#undef PG8_STAGE
#undef PG8_LDA
#undef PG8_LDB
#undef PG8_MMA
#undef PG8_WAIT_V
#undef PG8_WAIT_L
#undef PG8_BAR
#undef PG8_SCHED
}
}

constexpr int NWAVES = 8;
constexpr int RING_OFF = 0, RING_BYTES = 131072;
constexpr int LDSCTL_OFF = RING_BYTES, MISC_OFF = LDSCTL_OFF + 320;
constexpr int LDS_BYTES = 163840;
constexpr int CW_BAR = 4096;
#define GAS __attribute__((address_space(1)))
#define LAS __attribute__((address_space(3)))
typedef unsigned short bf16;
typedef unsigned v4u __attribute__((ext_vector_type(4)));
typedef unsigned v2u __attribute__((ext_vector_type(2)));
typedef float f32x4 __attribute__((ext_vector_type(4)));
typedef float f32x16 __attribute__((ext_vector_type(16)));
typedef short bf16x8 __attribute__((ext_vector_type(8)));
typedef GAS unsigned gu32;
#define LDS_WAIT() asm volatile("s_waitcnt lgkmcnt(0)" ::: "memory")
#define VM_WAIT() asm volatile("s_waitcnt vmcnt(0)" ::: "memory")
__device__ __forceinline__ unsigned f2bf(float f) { unsigned u = __builtin_bit_cast(unsigned, f); return (u + 0x7fffu + ((u >> 16) & 1u)) >> 16; }
__device__ __forceinline__ unsigned pk2(float lo, float hi) { return pg8::cvt_pk_bf16(lo, hi); }
__device__ __forceinline__ float bf2f(unsigned short b) { return __builtin_bit_cast(float, (unsigned)b << 16); }
__device__ __forceinline__ float wave_sum(float v) {
#pragma unroll
    for (int o = 1; o < 64; o <<= 1) v += __shfl_xor(v, o);
    return v;
}
__device__ __forceinline__ float wave_max(float v) {
#pragma unroll
    for (int o = 1; o < 64; o <<= 1) v = fmaxf(v, __shfl_xor(v, o));
    return v;
}
#define XB_TMO      128
#define XB_XCNT(j)  (256  + 64 * (j))
#define XB_XSUB(j)  (1280 + 64 * (j))
#define XB_XGEN(j)  (2304 + 64 * (j))
#define XB_TOP      3328
#define XB_TOPGEN   3392
#define XCD_BAR_WORDS 3456
#define XB_SPIN_CAP (1u << 18)

__device__ __forceinline__ unsigned xb_ld(unsigned* p)              { return __hip_atomic_load(p, __ATOMIC_RELAXED, __HIP_MEMORY_SCOPE_AGENT); }
__device__ __forceinline__ unsigned xb_add(unsigned* p, unsigned v) { return __hip_atomic_fetch_add(p, v, __ATOMIC_RELAXED, __HIP_MEMORY_SCOPE_AGENT); }
__device__ __forceinline__ unsigned xb_xcc_id() { return (unsigned)__builtin_amdgcn_s_getreg((3 << 11) | 20) & 0xFu; }
#define XB_SPIN(cond, bar) do { unsigned _sp = 0; while (cond) { __builtin_amdgcn_s_sleep(1); \
    if ((++_sp & 255u) == 0u) { if (xb_ld(&(bar)[XB_TMO])) break; if (_sp > XB_SPIN_CAP) { atomicAdd(&(bar)[XB_TMO], 1u); break; } } } } while (0)

struct XcdBarrier {
    unsigned* bar; unsigned x;
    volatile LAS unsigned* st;
};

__device__ __forceinline__ XcdBarrier xcd_barrier_post(unsigned* bar, volatile LAS unsigned* st) {
    XcdBarrier b; b.bar = bar; b.x = xb_xcc_id(); b.st = st;
    if (threadIdx.x == 0) (void)xb_add(&bar[XB_XCNT(b.x)], 1u);
    return b;
}
__device__ __forceinline__ void xcd_barrier_complete(unsigned* bar, unsigned x, unsigned& nloc, unsigned& nx) {
    const unsigned G = gridDim.x * gridDim.y * gridDim.z;
    unsigned sum, cnt, mine, sp = 0u;
    for (;;) {
        sum = 0u; cnt = 0u; mine = 0u;
#pragma unroll
        for (unsigned j = 0; j < 16; ++j) { const unsigned c = xb_ld(&bar[XB_XCNT(j)]); sum += c; cnt += (c > 0u) ? 1u : 0u; mine = (j == x) ? c : mine; }
        if (sum == G) break;
        __builtin_amdgcn_s_sleep(1);
        if ((++sp & 255u) == 0u) { if (xb_ld(&bar[XB_TMO])) break; if (sp > XB_SPIN_CAP) { atomicAdd(&bar[XB_TMO], 1u); break; } }
    }
    nloc = mine > 0u ? mine : 1u; nx = cnt > 0u ? cnt : 1u;
}

__device__ __forceinline__ void xcd_barrier(const XcdBarrier& b) {
    asm volatile("s_waitcnt vmcnt(0)" ::: "memory");
    __syncthreads();
    if (threadIdx.x == 0) {
        unsigned* bar = b.bar;
        __builtin_amdgcn_s_waitcnt(0);
        unsigned nloc = b.st[0], nx = b.st[1];
        if (nloc == 0u) { xcd_barrier_complete(bar, b.x, nloc, nx); b.st[0] = nloc; b.st[1] = nx; }
        const unsigned old = xb_add(&bar[XB_XSUB(b.x)], 1u);
        const unsigned gen = old / nloc;
        if (old + 1u == (gen + 1u) * nloc) {
            __builtin_amdgcn_fence(__ATOMIC_RELEASE, "agent");
            asm volatile("s_waitcnt vmcnt(0)" ::: "memory");
            const unsigned og = xb_add(&bar[XB_TOP], 1u);
            const unsigned tg = og / nx;
            if (og + 1u == (tg + 1u) * nx) xb_add(&bar[XB_TOPGEN], 1u);
            else XB_SPIN(xb_ld(&bar[XB_TOPGEN]) == tg, bar);
            __builtin_amdgcn_fence(__ATOMIC_ACQUIRE, "agent");
            xb_add(&bar[XB_XGEN(b.x)], 1u);
            asm volatile("s_waitcnt vmcnt(0)" ::: "memory");
        } else {
            XB_SPIN(xb_ld(&bar[XB_XGEN(b.x)]) == gen, bar);
            __builtin_amdgcn_fence(__ATOMIC_ACQUIRE, "agent");
            asm volatile("s_waitcnt vmcnt(0)" ::: "memory");
        }
    }
    __syncthreads();
}

struct Frame {
    LAS unsigned char* lds; volatile LAS unsigned* MISC; gu32* ctl;
    int tid, lane, wave, vcu, G, bid;
    const float *xp, *xs, *cache_k, *cache_v, *cache_kidx, *state_pool; const int* page_table;
    const float *cp, *cs, *norm_w, *w_ada, *b_ada, *w_in, *qnw, *knw, *w_pool, *pool_scale, *w_out;
    float* out; unsigned char* ws;
#if TEST_MODE == 4 && P3FINE
    unsigned long long* ts; int nst;
#endif
};
#if TEST_MODE == 4 && P3FINE
#define FSTAMP() do { if (blockIdx.x == STAMP_BLK && threadIdx.x == 0) F.ts[F.nst] = __builtin_amdgcn_s_memrealtime(); ++F.nst; } while (0)
#else
#define FSTAMP() do { } while (0)
#endif

__device__ __forceinline__ void p0_ada(Frame& F, int task) {
    const int lane = F.lane, w = F.wave, rl = lane & 15, kq = lane >> 4, n0 = task * 16;
    float bv[32];
    { const float* wp = F.w_ada + (size_t)(w * 128 + 4 * kq) * 3072 + n0 + rl;
#pragma unroll
      for (int i4 = 0; i4 < 8; ++i4)
#pragma unroll
          for (int u = 0; u < 4; ++u) bv[i4 * 4 + u] = wp[(size_t)(16 * i4 + u) * 3072]; }
    f32x4 acc[9];
#pragma unroll
    for (int i3 = 0; i3 < 3; ++i3) {
        f32x4 cv[3][8]; bool valid[3];
#pragma unroll
        for (int ii = 0; ii < 3; ++ii) { const int row = 16 * (3 * i3 + ii) + rl; valid[ii] = row < NR;
            const float* cptr = (row < NB ? F.cp + (size_t)row * DM : F.cs + (size_t)((valid[ii] ? row : NB) - NB) * DM) + w * 128 + 4 * kq;
#pragma unroll
            for (int i4 = 0; i4 < 8; ++i4) cv[ii][i4] = *(const f32x4*)(cptr + 16 * i4); }
#pragma unroll
        for (int ii = 0; ii < 3; ++ii) { const int i = 3 * i3 + ii;
            acc[i] = (f32x4){0.f, 0.f, 0.f, 0.f};
#pragma unroll
            for (int i4 = 0; i4 < 8; ++i4)
#pragma unroll
                for (int u = 0; u < 4; ++u) { const float a = valid[ii] ? pg8::silu1(cv[ii][i4][u]) : 0.f; acc[i] = __builtin_amdgcn_mfma_f32_16x16x4f32(a, bv[i4 * 4 + u], acc[i], 0, 0, 0); } } }
    LAS float* red = (LAS float*)(F.lds + RING_OFF);
#pragma unroll
    for (int i = 0; i < 9; ++i)
#pragma unroll
        for (int e = 0; e < 4; ++e) red[(w * 144 + 16 * i + 4 * kq + e) * 16 + rl] = acc[i][e];
    __syncthreads();
    float* ada = (float*)(F.ws + WS_ADA);
    for (int o = F.tid; o < NR * 16; o += NWAVES * 64) { const int row = o >> 4, col = o & 15; float s = F.b_ada[n0 + col];
#pragma unroll
        for (int ww = 0; ww < 8; ++ww) s += red[(ww * 144 + row) * 16 + col];
        ada[(size_t)row * 3072 + n0 + col] = s; }
    __syncthreads();
}
__device__ __forceinline__ void transpose_item(const float* W, int ldn, int srccol0, int nvalid, bf16* WT, int K, int dstrow0, int k0, LAS float* scr, int lane) {
    float tv[32];
#pragma unroll
    for (int i = 0; i < 32; ++i) { const int kk = 2 * i + (lane >> 5), c = lane & 31; tv[i] = c < nvalid ? W[(size_t)(k0 + kk) * ldn + srccol0 + c] : 0.f; }
#pragma unroll
    for (int i = 0; i < 32; ++i) { const int kk = 2 * i + (lane >> 5), c = lane & 31; scr[kk * 33 + c] = tv[i]; }
    LDS_WAIT(); asm volatile("" ::: "memory");
    const int c = lane & 7;
#pragma unroll
    for (int j = 0; j < 4; ++j) { const int n = (lane >> 3) + 8 * j; const LAS float* s = scr + (8 * c) * 33 + n;
        v4u o; o.x = pk2(s[0 * 33], s[1 * 33]); o.y = pk2(s[2 * 33], s[3 * 33]); o.z = pk2(s[4 * 33], s[5 * 33]); o.w = pk2(s[6 * 33], s[7 * 33]);
        *(GAS v4u*)(WT + (size_t)(dstrow0 + n) * K + k0 + 8 * c) = o; }
    LDS_WAIT(); asm volatile("" ::: "memory");
}
__device__ __forceinline__ int win_col(int pn, int hd, int d) {
    if (pn <= 1) return CQ + (4 * pn + hd) * 64 + d;
    if (pn == 2) return hd < 2 ? CK + hd * 64 + d : CV + (hd - 2) * 64 + d;
    if (pn <= 4) return CQI + (4 * (pn - 3) + hd) * 64 + d;
    if (pn == 5) return hd == 0 ? CKI + d : ((hd == 1 && d < 8) ? CWI + d : -1);
    if (pn <= 7) return CGA + (4 * (pn - 6) + hd) * 64 + d;
    if (pn <= 9) return CU + (4 * (pn - 8) + hd) * 64 + d;
    return CGP + (4 * (pn - 10) + hd) * 64 + d;
}
__device__ __forceinline__ void p0_prologue(Frame& F) {
    LAS float* scr = (LAS float*)(F.lds + RING_OFF + F.wave * 16384);
    const int gw = F.vcu * NWAVES + F.wave, NGW = F.G * NWAVES;
    bf16* WINT = (bf16*)(F.ws + WS_WINT); bf16* WOUTT = (bf16*)(F.ws + WS_WOUTT); bf16* WPOOLT = (bf16*)(F.ws + WS_WPOOLT);
    const bool split = F.G > 192 + 16;
    if (F.bid < 192) p0_ada(F, F.bid);
    if (!split || F.bid >= 192) {
        const int tw0 = split ? (F.bid - 192) * NWAVES + F.wave : gw, tws = split ? (F.G - 192) * NWAVES : NGW;
        for (int it = tw0; it < 2080; it += tws) {
            if (it < 1536) { const int G = it >> 4, kb = it & 15, pn = G >> 3, bj = (G >> 2) & 1, hd = G & 3; const int src = win_col(pn, hd, 32 * bj);
                const int nvalid = src < 0 ? 0 : ((pn == 5 && hd == 1) ? 8 : 32);
                transpose_item(F.w_in, NIN, src < 0 ? 0 : src, nvalid, WINT, 1024, 32 * G, 64 * kb, scr, F.lane); }
            else if (it < 2048) { const int r = it - 1536, G = r >> 4, kb = r & 15; transpose_item(F.w_out, 1024, 32 * G, 32, WOUTT, 1024, 32 * G, 64 * kb, scr, F.lane); }
            else { const int r = it - 2048, g = r >> 3, kb = (r >> 2) & 1, G = r & 3; transpose_item(F.w_pool + (size_t)g * 16384, 128, 32 * G, 32, WPOOLT + (size_t)g * 16384, 128, 32 * G, 64 * kb, scr, F.lane); }
        }
    }
    { const int nf4 = DECB * 1792; f32x4 t4[2]; int ix[2];
#pragma unroll
      for (int k = 0; k < 2; ++k) { ix[k] = gw * 64 + F.lane + k * NGW * 64; if (ix[k] < nf4) { const int s = ix[k] / 1792, i = ix[k] - s * 1792; t4[k] = *(const f32x4*)(F.state_pool + (size_t)s * 7680 + 512 + 4 * i); } }
#pragma unroll
      for (int k = 0; k < 2; ++k) { if (ix[k] < nf4) { const int s = ix[k] / 1792, i = ix[k] - s * 1792; *(f32x4*)(F.out + O_PS + (size_t)s * 7680 + 4 * i) = t4[k]; } }
      for (int ixx = gw * 64 + F.lane + 2 * NGW * 64; ixx < nf4; ixx += NGW * 64) { const int s = ixx / 1792, i = ixx - s * 1792; *(f32x4*)(F.out + O_PS + (size_t)s * 7680 + 4 * i) = *(const f32x4*)(F.state_pool + (size_t)s * 7680 + 512 + 4 * i); } }
}

template <int N, bool SAME_ADA> __device__ __forceinline__ void norm_rows(Frame& F, const float* x0, const float* adarow0, int adastride, bf16* o0) {
    f32x4 v[N][4]; float s2[N];
#pragma unroll
    for (int i = 0; i < N; ++i) { const GAS f32x4* xr = (const GAS f32x4*)(x0 + (size_t)i * DM) + F.lane;
#pragma unroll
        for (int j = 0; j < 4; ++j) v[i][j] = xr[64 * j]; }
#pragma unroll
    for (int i = 0; i < N; ++i) { s2[i] = 0.f;
#pragma unroll
        for (int j = 0; j < 4; ++j) s2[i] += (v[i][j].x * v[i][j].x + v[i][j].y * v[i][j].y) + (v[i][j].z * v[i][j].z + v[i][j].w * v[i][j].w); }
#pragma unroll
    for (int o = 1; o < 64; o <<= 1) {
#pragma unroll
        for (int i = 0; i < N; ++i) s2[i] += __shfl_xor(s2[i], o); }
#pragma unroll
    for (int j = 0; j < 4; ++j) { const int col = 4 * F.lane + 256 * j; const f32x4 nw = *(const f32x4*)(F.norm_w + col);
        f32x4 gq, sh;
        if (SAME_ADA) { sh = *(const f32x4*)(adarow0 + col); gq = nw * (*(const f32x4*)(adarow0 + 1024 + col) + 1.0f); }
#pragma unroll
        for (int i = 0; i < N; ++i) {
            if (!SAME_ADA) { const float* ar = adarow0 + (size_t)i * adastride; sh = *(const f32x4*)(ar + col); gq = nw * (*(const f32x4*)(ar + 1024 + col) + 1.0f); }
            const float rstd = 1.0f / sqrtf(s2[i] * (1.0f / DM) + EPS);
            const f32x4 o = v[i][j] * rstd * gq + sh;
            ((GAS unsigned long long*)(o0 + (size_t)i * DM))[F.lane + 64 * j] = (unsigned long long)pk2(o.x, o.y) | ((unsigned long long)pk2(o.z, o.w) << 32); } }
}
__device__ __forceinline__ void skinny_core(const bf16* arow, const bf16* b0, const bf16* b1, const bf16* b2, const bf16* b3, f32x4 (&acc)[4]) {
#pragma unroll
    for (int j = 0; j < 4; ++j) acc[j] = (f32x4){0.f, 0.f, 0.f, 0.f};
    bf16x8 fa[2][4], fb[2][4][4];
#define SK_LOAD(buf, kb) do { _Pragma("unroll") for (int q_ = 0; q_ < 4; ++q_) { const int ko_ = 32 * (4 * (kb) + q_); fa[buf][q_] = *(const bf16x8*)(arow + ko_); \
        fb[buf][q_][0] = *(const bf16x8*)(b0 + ko_); fb[buf][q_][1] = *(const bf16x8*)(b1 + ko_); fb[buf][q_][2] = *(const bf16x8*)(b2 + ko_); fb[buf][q_][3] = *(const bf16x8*)(b3 + ko_); } } while (0)
#define SK_MMA(buf) do { _Pragma("unroll") for (int q_ = 0; q_ < 4; ++q_) { _Pragma("unroll") for (int j_ = 0; j_ < 4; ++j_) acc[j_] = __builtin_amdgcn_mfma_f32_16x16x32_bf16(fa[buf][q_], fb[buf][q_][j_], acc[j_], 0, 0, 0); } } while (0)
    SK_LOAD(0, 0);
#pragma unroll
    for (int kb = 0; kb < 8; kb += 2) {
        SK_LOAD(1, kb + 1); SK_MMA(0);
        if (kb + 2 < 8) SK_LOAD(0, kb + 2);
        SK_MMA(1);
    }
#undef SK_LOAD
#undef SK_MMA
}
__device__ __forceinline__ void sample_inproj(Frame& F, int pn, int hd) {
    const int lane = F.lane, w = F.wave, rl = lane & 15, kq = lane >> 4;
    const bf16* HS = (const bf16*)(F.ws + WS_HS);
    const bf16* WINT = (const bf16*)(F.ws + WS_WINT);
    const bf16* bb = WINT + (size_t)(256 * pn + 32 * hd + rl) * 1024 + 8 * kq;
    f32x4 acc[4];
    skinny_core(HS + (size_t)(16 * w + rl) * 1024 + 8 * kq, bb, bb + 16 * 1024, bb + 128 * 1024, bb + 144 * 1024, acc);
    float* out = F.out;
    if (pn <= 1 || (pn == 2 && hd < 2)) {
        const float* nwp = pn <= 1 ? F.qnw : F.knw; const float sc = pn <= 1 ? C2 : 1.0f;
#pragma unroll
        for (int e = 0; e < 4; ++e) { float ss = 0.f;
#pragma unroll
            for (int j = 0; j < 4; ++j) ss += acc[j][e] * acc[j][e];
            ss += __shfl_xor(ss, 1); ss += __shfl_xor(ss, 2); ss += __shfl_xor(ss, 4); ss += __shfl_xor(ss, 8);
            const float rstd = 1.0f / sqrtf(ss * (1.0f / 64.0f) + EPS); const int s = 16 * w + 4 * kq + e; const size_t m = (size_t)(MP + s);
#pragma unroll
            for (int j = 0; j < 4; ++j) { const int d = 16 * j + rl; const float o = acc[j][e] * rstd * nwp[d] * sc;
                if (pn <= 1) ((bf16*)(F.ws + WS_Q))[m * 512 + (4 * pn + hd) * 64 + d] = (bf16)f2bf(o);
                else { out[O_KS + (size_t)s * 128 + hd * 64 + d] = o; ((bf16*)(F.ws + WS_KB))[m * 128 + hd * 64 + d] = (bf16)f2bf(o); } } }
        return;
    }
    if (pn == 5 && hd == 1) {
        if (rl < 8) {
#pragma unroll
            for (int e = 0; e < 4; ++e) { const int s = 16 * w + 4 * kq + e; ((float*)(F.ws + WS_WI))[(size_t)(MP + s) * 8 + rl] = acc[0][e] * WI_SCALE; } }
        return;
    }
    bf16* dst; int ld, cb; float* fo = nullptr; int fld = 0; bool act = false;
    if (pn == 2) { dst = (bf16*)(F.ws + WS_VB); ld = 128; cb = (hd - 2) * 64; fo = out + O_VS + cb; fld = 128; }
    else if (pn <= 4) { dst = (bf16*)(F.ws + WS_QI); ld = 512; cb = (4 * (pn - 3) + hd) * 64; }
    else if (pn == 5) { dst = (bf16*)(F.ws + WS_KI); ld = 64; cb = 0; fo = out + O_KIS; fld = 64; }
    else if (pn <= 7) { dst = (bf16*)(F.ws + WS_GA); ld = 512; cb = (4 * (pn - 6) + hd) * 64; act = true; }
    else if (pn <= 9) { dst = (bf16*)(F.ws + WS_U); ld = 512; cb = (4 * (pn - 8) + hd) * 64; fo = out + O_PS + 14 * 512 + cb; fld = 15 * 512; }
    else { dst = (bf16*)(F.ws + WS_GP); ld = 512; cb = (4 * (pn - 10) + hd) * 64; act = true; }
#pragma unroll
    for (int e = 0; e < 4; ++e) { const int s = 16 * w + 4 * kq + e; const size_t m = (size_t)(MP + s);
#pragma unroll
        for (int j = 0; j < 4; ++j) { const int d = 16 * j + rl; float o = acc[j][e]; if (act) o = pg8::silu1(o);
            dst[m * ld + cb + d] = (bf16)f2bf(o);
            if (fo) fo[(size_t)s * fld + d] = o; } }
}
__device__ __forceinline__ void p1_norm(Frame& F) {
    const float* ada = (const float*)(F.ws + WS_ADA); bf16* HB = (bf16*)(F.ws + WS_HB); bf16* HS = (bf16*)(F.ws + WS_HS);
    const int gw = F.vcu * NWAVES + F.wave, NGW = F.G * NWAVES;
    for (int ch = gw; ch < MP / 4 + DECB / 2; ch += NGW) {
        if (ch < MP / 4) { const int m = 4 * ch; norm_rows<4, true>(F, F.xp + (size_t)m * DM, ada + (size_t)(m >> 11) * 3072, 0, HB + (size_t)m * DM); }
        else { const int s = 2 * (ch - MP / 4); norm_rows<2, false>(F, F.xs + (size_t)s * DM, ada + (size_t)(NB + s) * 3072, 3072, HS + (size_t)s * DM); } }
}
__device__ __forceinline__ void p2_sample(Frame& F) {
    const int pn = F.bid >> 2, hd = F.bid & 3;
    if (F.bid < 48 && !(pn == 5 && hd >= 2)) sample_inproj(F, pn, hd);
}

constexpr int P3_KEYS = 0;
constexpr int P3_BM = 132096;
constexpr int P3_WQ = 136192;
constexpr int P3_QI = 136704, P3_QI_STRIDE = 1040;
constexpr int P3_XM = 153344;
constexpr int P3_VW = 0, P3_VWB = 4096;

__device__ __forceinline__ float relu_s(float x) { return __builtin_amdgcn_fmed3f(x, 0.0f, __builtin_inff()); }
__device__ __forceinline__ unsigned f2key(float f) { unsigned u = __float_as_uint(f); if (f == 0.0f) u = 0u; return (u & 0x80000000u) ? ~u : (u | 0x80000000u); }
__device__ __forceinline__ float key2f(unsigned k) { return __uint_as_float((k & 0x80000000u) ? (k ^ 0x80000000u) : ~k); }

__device__ __forceinline__ unsigned half_reduce_add(unsigned v) {
    v += (unsigned)__builtin_amdgcn_update_dpp(0, (int)v, 0xB1, 0xF, 0xF, true);
    v += (unsigned)__builtin_amdgcn_update_dpp(0, (int)v, 0x4E, 0xF, 0xF, true);
    v += (unsigned)__builtin_amdgcn_update_dpp(0, (int)v, 0x141, 0xF, 0xF, true);
    v += (unsigned)__builtin_amdgcn_update_dpp(0, (int)v, 0x140, 0xF, 0xF, true);
    v += (unsigned)__builtin_amdgcn_ds_swizzle((int)v, 0x401F);
    return v;
}
__device__ __forceinline__ float probit_f(float p) {
    const float pp = p < 0.5f ? p : 1.0f - p; const float t = sqrtf(-2.0f * __logf(pp));
    const float z = t - (2.515517f + t * (0.802853f + t * 0.010328f)) * __builtin_amdgcn_rcpf(1.0f + t * (1.432788f + t * (0.189269f + t * 0.001308f)));
    return p < 0.5f ? -z : z;
}
__device__ __forceinline__ unsigned half_reduce_min(unsigned v) {
    v = min(v, (unsigned)__builtin_amdgcn_update_dpp(0, (int)v, 0xB1, 0xF, 0xF, true)); v = min(v, (unsigned)__builtin_amdgcn_update_dpp(0, (int)v, 0x4E, 0xF, 0xF, true));
    v = min(v, (unsigned)__builtin_amdgcn_update_dpp(0, (int)v, 0x141, 0xF, 0xF, true)); v = min(v, (unsigned)__builtin_amdgcn_update_dpp(0, (int)v, 0x140, 0xF, 0xF, true));
    v = min(v, (unsigned)__builtin_amdgcn_ds_swizzle((int)v, 0x401F)); return v; }
__device__ __forceinline__ unsigned half_reduce_max(unsigned v) {
    v = max(v, (unsigned)__builtin_amdgcn_update_dpp(0, (int)v, 0xB1, 0xF, 0xF, true)); v = max(v, (unsigned)__builtin_amdgcn_update_dpp(0, (int)v, 0x4E, 0xF, 0xF, true));
    v = max(v, (unsigned)__builtin_amdgcn_update_dpp(0, (int)v, 0x141, 0xF, 0xF, true)); v = max(v, (unsigned)__builtin_amdgcn_update_dpp(0, (int)v, 0x140, 0xF, 0xF, true));
    v = max(v, (unsigned)__builtin_amdgcn_ds_swizzle((int)v, 0x401F)); return v; }
__device__ __forceinline__ unsigned wave_reduce_add_u(unsigned v) {
    v += (unsigned)__builtin_amdgcn_update_dpp(0, (int)v, 0xB1, 0xF, 0xF, true); v += (unsigned)__builtin_amdgcn_update_dpp(0, (int)v, 0x4E, 0xF, 0xF, true);
    v += (unsigned)__builtin_amdgcn_update_dpp(0, (int)v, 0x141, 0xF, 0xF, true); v += (unsigned)__builtin_amdgcn_update_dpp(0, (int)v, 0x140, 0xF, 0xF, true);
    return ((unsigned)__builtin_amdgcn_readlane((int)v, 0) + (unsigned)__builtin_amdgcn_readlane((int)v, 16)) + ((unsigned)__builtin_amdgcn_readlane((int)v, 32) + (unsigned)__builtin_amdgcn_readlane((int)v, 48)); }
__device__ __forceinline__ float kq_max(float v) {
    auto a = __builtin_amdgcn_permlane16_swap(__float_as_uint(v), __float_as_uint(v), false, false); v = fmaxf(__uint_as_float(a[0]), __uint_as_float(a[1]));
    auto b = __builtin_amdgcn_permlane32_swap(__float_as_uint(v), __float_as_uint(v), false, false); return fmaxf(__uint_as_float(b[0]), __uint_as_float(b[1])); }
__device__ __forceinline__ float kq_sum(float v) {
    auto a = __builtin_amdgcn_permlane16_swap(__float_as_uint(v), __float_as_uint(v), false, false); v = __uint_as_float(a[0]) + __uint_as_float(a[1]);
    auto b = __builtin_amdgcn_permlane32_swap(__float_as_uint(v), __float_as_uint(v), false, false); return __uint_as_float(b[0]) + __uint_as_float(b[1]); }
__device__ __forceinline__ unsigned wave_reduce_min_u(unsigned v) { v = half_reduce_min(v); return min((unsigned)__builtin_amdgcn_readlane((int)v, 0), (unsigned)__builtin_amdgcn_readlane((int)v, 32)); }
__device__ __forceinline__ unsigned wave_reduce_max_u(unsigned v) { v = half_reduce_max(v); return max((unsigned)__builtin_amdgcn_readlane((int)v, 0), (unsigned)__builtin_amdgcn_readlane((int)v, 32)); }

__device__ __forceinline__ void p3_prompt_item(Frame& F, int b, int qt) {
    int tid_o_ = F.tid; asm volatile("" : "+v"(tid_o_));
    const int tid = tid_o_, lane = tid & 63, w = F.wave, r = lane & 31, hh = lane >> 5;
    const int t0 = 16 * qt, L = t0 + 16, nkt32 = (L + 31) >> 5, nkt64 = (L + 63) >> 6;
    const size_t mb = (size_t)b * SEQ;
    LAS unsigned* bm = (LAS unsigned*)(F.lds + P3_BM);
    LAS float* wq = (LAS float*)(F.lds + P3_WQ);
    LAS unsigned* keys = (LAS unsigned*)(F.lds + P3_KEYS);
    if (tid < 128) wq[tid] = ((const float*)(F.ws + WS_WI))[(mb + t0 + (tid >> 3)) * 8 + (tid & 7)];
    { const bf16* QI = (const bf16*)(F.ws + WS_QI);
#pragma unroll
      for (int k = 0; k < 2; ++k) { const int i = tid + 512 * k, row = i >> 6, ch = i & 63; *(LAS v4u*)(F.lds + P3_QI + row * P3_QI_STRIDE + ch * 16) = *(const v4u*)(QI + (mb + t0 + row) * 512 + ch * 8); } }
    __syncthreads();
    FSTAMP();
    for (int rep1_ = 0; rep1_ < REP_S1; ++rep1_) {
        const bf16* KI = (const bf16*)(F.ws + WS_KI);
        const int ns = (nkt32 - w + 7) >> 3;
        bf16x8 bb[3][4];
#define P3_LDK(slot) do { const bf16* kp_ = KI + (mb + 32 * (w + 8 * (slot)) + r) * 64 + 8 * hh; \
        _Pragma("unroll") for (int ks_ = 0; ks_ < 4; ++ks_) bb[(slot) % 3][ks_] = *(const bf16x8*)(kp_ + 16 * ks_); } while (0)
        if (0 < ns) P3_LDK(0);
        if (1 < ns) P3_LDK(1);
        const int arow = (2 * ((r >> 2) & 1) + (r >> 4)) * P3_QI_STRIDE + ((r & 3) + 4 * ((r >> 3) & 1)) * 128 + 16 * hh;
        const LAS unsigned char* qib = F.lds + P3_QI;
#define P3_MM(ACC, a, s) do { _Pragma("unroll") for (int e_ = 0; e_ < 16; ++e_) ACC[e_] = 0.f; \
        _Pragma("unroll") for (int ks_ = 0; ks_ < 4; ++ks_) { const bf16x8 af_ = *(const LAS bf16x8*)(qs_ + 4 * (a) * P3_QI_STRIDE + arow + 32 * ks_); \
            ACC = __builtin_amdgcn_mfma_f32_32x32x16_bf16(af_, bb[(s) % 3][ks_], ACC, 0, 0, 0); } } while (0)
#define P3_EPI(ACC, a, s) do { _Pragma("unroll") for (int j2_ = 0; j2_ < 2; ++j2_) { const int qq_ = 4 * (a) + 2 * hh + j2_; \
        const LAS f32x4* wp_ = (const LAS f32x4*)(wq + qq_ * 8); const f32x4 w0_ = wp_[0], w1_ = wp_[1]; \
        float sc_ = w0_[0] * relu_s(ACC[8 * j2_ + 0]); sc_ = fmaf(w0_[1], relu_s(ACC[8 * j2_ + 1]), sc_); sc_ = fmaf(w0_[2], relu_s(ACC[8 * j2_ + 2]), sc_); sc_ = fmaf(w0_[3], relu_s(ACC[8 * j2_ + 3]), sc_); \
        sc_ = fmaf(w1_[0], relu_s(ACC[8 * j2_ + 4]), sc_); sc_ = fmaf(w1_[1], relu_s(ACC[8 * j2_ + 5]), sc_); sc_ = fmaf(w1_[2], relu_s(ACC[8 * j2_ + 6]), sc_); sc_ = fmaf(w1_[3], relu_s(ACC[8 * j2_ + 7]), sc_); \
        keys[qq_ * 2048 + 32 * (w + 8 * (s)) + r] = f2key(sc_); } } while (0)
#pragma unroll
        for (int s = 0; s < 8; ++s) {
            if (s < ns) {
                if (s + 2 < ns) P3_LDK(s + 2);
                int zo_ = 0; asm volatile("" : "+v"(zo_));
                const LAS unsigned char* qs_ = qib + zo_;
                f32x16 accA, accB;
                P3_MM(accA, 0, s); P3_MM(accB, 1, s);
                P3_EPI(accA, 0, s); P3_MM(accA, 2, s);
                P3_EPI(accB, 1, s); P3_MM(accB, 3, s);
                P3_EPI(accA, 2, s); P3_EPI(accB, 3, s);
            }
        }
#undef P3_MM
#undef P3_EPI
#undef P3_LDK
    }
    __syncthreads();
    FSTAMP();
    { const bf16* Qg = (const bf16*)(F.ws + WS_Q);
#pragma unroll
      for (int k = 0; k < 2; ++k) { const int i = tid + 512 * k, row = i >> 6, ch = i & 63; *(LAS v4u*)(F.lds + P3_QI + row * P3_QI_STRIDE + ch * 16) = *(const v4u*)(Qg + (mb + t0 + row) * 512 + ch * 8); } }
    for (int rep2_ = 0; rep2_ < REP_S2; ++rep2_) {
        int lane_ = F.lane; asm volatile("" : "+v"(lane_));
#define lane lane_
        const int qx0 = 2 * w, tq0 = t0 + qx0;
        unsigned sel0, sel1;
        if (t0 + 16 <= 256) {
            sel0 = 0u; sel1 = 0u;
#pragma unroll
            for (int jj = 0; jj < 32; ++jj) { sel0 |= (64 * jj + lane <= tq0) ? (1u << jj) : 0u; sel1 |= (64 * jj + lane <= tq0 + 1) ? (1u << jj) : 0u; }
        } else {
            unsigned x[32], y[32];
#pragma unroll
            for (int jj = 0; jj < 32; ++jj) { const int l = 64 * jj + lane; x[jj] = (l <= tq0) ? keys[qx0 * 2048 + l] : 0u; y[jj] = (l <= tq0 + 1) ? keys[(qx0 + 1) * 2048 + l] : 0u; }
#pragma unroll
            for (int st = 0; st < 5; ++st) { const int j = 16 >> st; const unsigned m = st == 0 ? 0x0000ffffu : st == 1 ? 0x00ff00ffu : st == 2 ? 0x0f0f0f0fu : st == 3 ? 0x33333333u : 0x55555555u;
#pragma unroll
                for (int k = 0; k < 32; ++k) if (!(k & j)) { const unsigned t_ = ((x[k] >> j) ^ x[k + j]) & m; x[k] ^= t_ << j; x[k + j] ^= t_;
                    const unsigned u_ = ((y[k] >> j) ^ y[k + j]) & m; y[k] ^= u_ << j; y[k + j] ^= u_; } }
            unsigned cur0 = 0xffffffffu, gt0 = 0u, cur1 = 0xffffffffu, gt1 = 0u; int ab0 = 0, ab1 = 0;
#pragma unroll
            for (int b = 31; b >= 0; --b) { const unsigned c0 = cur0 & x[b], c1 = cur1 & y[b];
                const unsigned pk = wave_reduce_add_u((unsigned)__popc(c0) | ((unsigned)__popc(c1) << 16)); const int n0 = (int)(pk & 0xffffu), n1 = (int)(pk >> 16);
                if (ab0 + n0 >= 256) cur0 = c0; else { ab0 += n0; gt0 |= c0; cur0 &= ~x[b]; }
                if (ab1 + n1 >= 256) cur1 = c1; else { ab1 += n1; gt1 |= c1; cur1 &= ~y[b]; } }
            const unsigned pke = wave_reduce_add_u((unsigned)__popc(cur0) | ((unsigned)__popc(cur1) << 16));
            const unsigned long long lt = (1ull << lane) - 1ull;
            { int need = 256 - ab0; if ((int)(pke & 0xffffu) == need) sel0 = gt0 | cur0;
              else { sel0 = gt0;
                for (int jj = 0; jj < 32; ++jj) { const unsigned long long meq = __ballot((cur0 >> jj) & 1u);
                    if (((cur0 >> jj) & 1u) && __popcll(meq & lt) < need) sel0 |= 1u << jj;
                    const int pc_ = __popcll(meq); need = need > pc_ ? need - pc_ : 0; } } }
            { int need = 256 - ab1; if ((int)(pke >> 16) == need) sel1 = gt1 | cur1;
              else { sel1 = gt1;
                for (int jj = 0; jj < 32; ++jj) { const unsigned long long meq = __ballot((cur1 >> jj) & 1u);
                    if (((cur1 >> jj) & 1u) && __popcll(meq & lt) < need) sel1 |= 1u << jj;
                    const int pc_ = __popcll(meq); need = need > pc_ ? need - pc_ : 0; } } }
        }
#pragma unroll
        for (int jj = 0; jj < 32; ++jj) { const unsigned long long b0 = __ballot((sel0 >> jj) & 1u), b1 = __ballot((sel1 >> jj) & 1u);
            if (lane == 0) { bm[qx0 * 64 + 2 * jj] = (unsigned)b0; bm[qx0 * 64 + 2 * jj + 1] = (unsigned)(b0 >> 32); bm[(qx0 + 1) * 64 + 2 * jj] = (unsigned)b1; bm[(qx0 + 1) * 64 + 2 * jj + 1] = (unsigned)(b1 >> 32); } }
#undef lane
    }
    __syncthreads();
#if TEST_MODE
    { unsigned* dbg = (unsigned*)(F.ws + WS_DBG_BM) + (mb + t0) * 64; for (int i = tid; i < 1024; i += NWAVES * 64) dbg[i] = bm[i]; }
#endif
    FSTAMP();
    for (int rep4_ = 0; rep4_ < REP_S4; ++rep4_) {
        int l4_ = lane; asm volatile("" : "+v"(l4_));
        const int g = w & 1, kq4 = w >> 1, j = l4_ & 15, kq = l4_ >> 4;
        const bf16* Q = (const bf16*)(F.ws + WS_Q); const bf16* KB = (const bf16*)(F.ws + WS_KB); const bf16* VB = (const bf16*)(F.ws + WS_VB);
        const LAS unsigned char* qlb = F.lds + P3_QI + (j >> 2) * P3_QI_STRIDE + ((4 * g + (j & 3)) * 64 + 8 * kq) * 2;
        f32x4 o[4][4];
#pragma unroll
        for (int dt = 0; dt < 4; ++dt)
#pragma unroll
            for (int rb = 0; rb < 4; ++rb) o[dt][rb] = (f32x4){0.f, 0.f, 0.f, 0.f};
        float mrun[4], lsum[4];
#pragma unroll
        for (int rb = 0; rb < 4; ++rb) { mrun[rb] = -INFINITY; lsum[rb] = 0.f; }
        const int ntw = (nkt32 - kq4 + 3) >> 2;
        LAS unsigned char* vst = F.lds + P3_VW + w * (3 * P3_VWB);
        bf16x8 kf[2][2], kfn[2][2];
        const bf16* kgp = KB + (mb + j) * 128 + g * 64 + 8 * kq;
        const bf16* vgp = VB + (mb + (l4_ >> 3)) * 128 + g * 64 + (l4_ & 7) * 8;
#define P4_LOADK(dst, kt_) do { _Pragma("unroll") for (int c_ = 0; c_ < 2; ++c_) _Pragma("unroll") for (int ks_ = 0; ks_ < 2; ++ks_) dst[c_][ks_] = *(const bf16x8*)(kgp + (size_t)(32 * (kt_) + 16 * c_) * 128 + 32 * ks_); } while (0)
        const unsigned vst_u = (unsigned)(size_t)vst;
#define P4_DMAV(kt_, buf_) do { _Pragma("unroll") for (int i_ = 0; i_ < 4; ++i_) { unsigned keep_; const void* gs_ = (const void*)(vgp + (size_t)(32 * (kt_) + 8 * i_) * 128); \
        const unsigned ld_ = (unsigned)__builtin_amdgcn_readfirstlane((int)(vst_u + (buf_) * P3_VWB + i_ * 1024)); \
        asm volatile("s_mov_b32 %0, m0\n\ts_mov_b32 m0, %2\n\ts_nop 0\n\tglobal_load_lds_dwordx4 %1, off\n\ts_mov_b32 m0, %0" : "=&s"(keep_) : "v"(gs_), "s"(ld_) : "memory"); } } while (0)
        if (ntw > 0) { P4_LOADK(kf, kq4); P4_DMAV(kq4, 0); }
        if (ntw > 1) { P4_DMAV(kq4 + 4, 1); }
        int vb_cur = 0;
        for (int ti = 0; ti < ntw; ++ti) {
            const int kt = kq4 + 4 * ti;
            if (ti + 1 < ntw) asm volatile("s_waitcnt vmcnt(4)" ::: "memory"); else asm volatile("s_waitcnt vmcnt(0)" ::: "memory");
            const int vb_n2 = vb_cur == 0 ? 2 : vb_cur - 1;
            if (ti + 1 < ntw) { P4_LOADK(kfn, kt + 4); }
            if (ti + 2 < ntw) { P4_DMAV(kt + 8, vb_n2); }
            int zq_ = 0; asm volatile("" : "+v"(zq_));
            f32x4 sa[2][4];
#pragma unroll
            for (int c = 0; c < 2; ++c)
#pragma unroll
                for (int rb = 0; rb < 4; ++rb) sa[c][rb] = (f32x4){0.f, 0.f, 0.f, 0.f};
#pragma unroll
            for (int c = 0; c < 2; ++c)
#pragma unroll
                for (int ks = 0; ks < 2; ++ks)
#pragma unroll
                    for (int rb = 0; rb < 4; ++rb) { const bf16x8 qv = *(const LAS bf16x8*)(qlb + zq_ + 4 * rb * P3_QI_STRIDE + 64 * ks); sa[c][rb] = __builtin_amdgcn_mfma_f32_16x16x32_bf16(kf[c][ks], qv, sa[c][rb], 0, 0, 0); }
            float tmax[4];
#pragma unroll
            for (int rb = 0; rb < 4; ++rb) { const unsigned wd = bm[(4 * rb + (j >> 2)) * 64 + kt] >> (4 * kq); float tm = -INFINITY;
#pragma unroll
                for (int c = 0; c < 2; ++c)
#pragma unroll
                    for (int e = 0; e < 4; ++e) { const bool bit = (wd >> (16 * c + e)) & 1u; sa[c][rb][e] = bit ? sa[c][rb][e] : -INFINITY; tm = fmaxf(tm, sa[c][rb][e]); }
                tmax[rb] = tm; }
#pragma unroll
            for (int rb = 0; rb < 4; ++rb) tmax[rb] = kq_max(tmax[rb]);
            if (__any(tmax[0] > mrun[0] || tmax[1] > mrun[1] || tmax[2] > mrun[2] || tmax[3] > mrun[3])) {
#pragma unroll
                for (int rb = 0; rb < 4; ++rb) { const float mnew = fmaxf(mrun[rb], tmax[rb]), mu = (mnew == -INFINITY) ? 0.f : mnew;
                    const float alpha = __builtin_amdgcn_exp2f(mrun[rb] - mu); mrun[rb] = mnew; lsum[rb] *= alpha;
#pragma unroll
                    for (int dt = 0; dt < 4; ++dt) o[dt][rb] *= alpha; } }
            bf16x8 pf[4];
#pragma unroll
            for (int rb = 0; rb < 4; ++rb) { const float mu = (mrun[rb] == -INFINITY) ? 0.f : mrun[rb]; float ps = 0.f;
#pragma unroll
                for (int c = 0; c < 2; ++c)
#pragma unroll
                    for (int e = 0; e < 4; ++e) { const float p = __builtin_amdgcn_exp2f(sa[c][rb][e] - mu); sa[c][rb][e] = p; ps += p; }
                lsum[rb] += ps;
                v4u pw; pw.x = pk2(sa[0][rb][0], sa[0][rb][1]); pw.y = pk2(sa[0][rb][2], sa[0][rb][3]); pw.z = pk2(sa[1][rb][0], sa[1][rb][1]); pw.w = pk2(sa[1][rb][2], sa[1][rb][3]);
                pf[rb] = __builtin_bit_cast(bf16x8, pw); }
            { const LAS unsigned char* vb = vst + vb_cur * P3_VWB + (4 * kq + (j >> 2)) * 128 + (4 * (j & 3)) * 2;
              typedef short v4i16_t __attribute__((ext_vector_type(4)));
#pragma unroll
              for (int dt = 0; dt < 4; ++dt) {
                  const v4i16_t lo4 = __builtin_amdgcn_ds_read_tr16_b64_v4i16((LAS v4i16_t*)(vb + 32 * dt));
                  const v4i16_t hi4 = __builtin_amdgcn_ds_read_tr16_b64_v4i16((LAS v4i16_t*)(vb + 32 * dt + 16 * 128));
                  const bf16x8 vf = (bf16x8){lo4[0], lo4[1], lo4[2], lo4[3], hi4[0], hi4[1], hi4[2], hi4[3]};
#pragma unroll
                  for (int rb = 0; rb < 4; ++rb) o[dt][rb] = __builtin_amdgcn_mfma_f32_16x16x32_bf16(vf, pf[rb], o[dt][rb], 0, 0, 0); } }
            vb_cur = vb_cur == 2 ? 0 : vb_cur + 1;
#pragma unroll
            for (int c = 0; c < 2; ++c) { kf[c][0] = kfn[c][0]; kf[c][1] = kfn[c][1]; }
        }
#undef P4_LOADK
#undef P4_DMAV
#pragma unroll
        for (int rb = 0; rb < 4; ++rb) lsum[rb] = kq_sum(lsum[rb]);
        __syncthreads();
        {
            LAS unsigned char* xo = F.lds + ((g * 4 + kq4) * 4) * 4096; LAS float* xm = (LAS float*)(F.lds + P3_XM) + ((g * 4 + kq4) * 4) * 32;
#pragma unroll
            for (int rb = 0; rb < 4; ++rb) {
#pragma unroll
                for (int dt = 0; dt < 4; ++dt) *(LAS f32x4*)(xo + rb * 4096 + dt * 1024 + l4_ * 16) = o[dt][rb];
                if (kq == 0) { xm[rb * 32 + j] = mrun[rb]; xm[rb * 32 + 16 + j] = lsum[rb]; } }
        }
        __syncthreads();
        {
            const int rb = kq4; float ms[4], ls[4]; float M = -INFINITY;
#pragma unroll
            for (int s4 = 0; s4 < 4; ++s4) { const LAS float* xm = (const LAS float*)(F.lds + P3_XM) + ((g * 4 + s4) * 4 + rb) * 32; ms[s4] = xm[j]; ls[s4] = xm[16 + j]; M = fmaxf(M, ms[s4]); }
            float Lt = 0.f; f32x4 oo[4];
#pragma unroll
            for (int dt = 0; dt < 4; ++dt) oo[dt] = (f32x4){0.f, 0.f, 0.f, 0.f};
#pragma unroll
            for (int s4 = 0; s4 < 4; ++s4) { const float sc = __builtin_amdgcn_exp2f(ms[s4] - M); Lt += ls[s4] * sc;
                const LAS unsigned char* xo = F.lds + (((g * 4 + s4) * 4) + rb) * 4096;
#pragma unroll
                for (int dt = 0; dt < 4; ++dt) oo[dt] += *(const LAS f32x4*)(xo + dt * 1024 + l4_ * 16) * sc; }
            const float inv = 1.0f / Lt;
            const size_t mrow = mb + t0 + 4 * rb + (j >> 2); const int hd = 4 * g + (j & 3);
            const bf16* GA = (const bf16*)(F.ws + WS_GA); bf16* MIX = (bf16*)(F.ws + WS_MIX);
#pragma unroll
            for (int dt = 0; dt < 4; ++dt) { const int d = 16 * dt + 4 * kq; const v2u gv = *(const v2u*)(GA + mrow * 512 + hd * 64 + d);
                const float g0 = bf2f((unsigned short)(gv.x & 0xffffu)), g1 = bf2f((unsigned short)(gv.x >> 16)), g2 = bf2f((unsigned short)(gv.y & 0xffffu)), g3 = bf2f((unsigned short)(gv.y >> 16));
                v2u ov; ov.x = pk2(oo[dt][0] * inv * g0, oo[dt][1] * inv * g1); ov.y = pk2(oo[dt][2] * inv * g2, oo[dt][3] * inv * g3);
                *(v2u*)(MIX + mrow * 1024 + hd * 64 + d) = ov; }
        }
        if (REP_S4 > 1) __syncthreads();
    }
}

constexpr int PL_U = 0, PL_W = 40960, PL_STRIDE = 272;
template <bool SAMPLE> __device__ __forceinline__ void p3_pool_item(Frame& F, int item) {
    const int tid = F.tid, lane = F.lane, w = F.wave, j = lane & 15, kq = lane >> 4;
    const bf16* U = (const bf16*)(F.ws + WS_U); const bf16* GP = (const bf16*)(F.ws + WS_GP); const bf16* WPT = (const bf16*)(F.ws + WS_WPOOLT); bf16* MIX = (bf16*)(F.ws + WS_MIX);
    const int tokb = SAMPLE ? 0 : (item & 15) * 128;
    const size_t m0 = SAMPLE ? (size_t)MP : (size_t)(item >> 4) * SEQ + tokb;
    const int tl = 16 * w + j;
    const size_t mrow = m0 + tl;
    v4u wr_[4], ur_[5];
#define PL_LOAD(gg) do { _Pragma("unroll") for (int k_ = 0; k_ < 4; ++k_) { const int i_ = tid + 512 * k_; wr_[k_] = *(const v4u*)(WPT + (size_t)(gg) * 16384 + (i_ >> 4) * 128 + (i_ & 15) * 8); } \
        if (!SAMPLE) { _Pragma("unroll") for (int k_ = 0; k_ < 5; ++k_) { const int i_ = tid + 512 * k_; const int row_ = i_ >> 4, ch_ = i_ & 15; ur_[k_] = (v4u){0u, 0u, 0u, 0u}; \
            if (i_ < 143 * 16 && tokb - 15 + row_ >= 0) ur_[k_] = *(const v4u*)(U + (m0 - 15 + row_) * 512 + (gg) * 128 + ch_ * 8); } } } while (0)
#define PL_STORE() do { _Pragma("unroll") for (int k_ = 0; k_ < 4; ++k_) { const int i_ = tid + 512 * k_; *(LAS v4u*)(F.lds + PL_W + (i_ >> 4) * PL_STRIDE + (i_ & 15) * 16) = wr_[k_]; } \
        if (!SAMPLE) { _Pragma("unroll") for (int k_ = 0; k_ < 5; ++k_) { const int i_ = tid + 512 * k_; if (i_ < 143 * 16) *(LAS v4u*)(F.lds + PL_U + (i_ >> 4) * PL_STRIDE + (i_ & 15) * 16) = ur_[k_]; } } } while (0)
    PL_LOAD(0);
#pragma unroll
    for (int g = 0; g < 4; ++g) {
        const int win = 2 << g;
        PL_STORE();
        __syncthreads();
        if (g + 1 < 4) PL_LOAD(g + 1);
        bf16x8 df[4];
#pragma unroll
        for (int ks = 0; ks < 4; ++ks) {
            float sum[8], cur[8];
            if (!SAMPLE) {
                const LAS unsigned char* up = F.lds + PL_U + (15 + tl) * PL_STRIDE + (4 * ks + kq) * 16;
                { const v4u c = *(const LAS v4u*)up;
#pragma unroll
                  for (int u = 0; u < 4; ++u) { const unsigned x = c[u]; cur[2 * u] = bf2f((unsigned short)(x & 0xffffu)); cur[2 * u + 1] = bf2f((unsigned short)(x >> 16)); sum[2 * u] = cur[2 * u]; sum[2 * u + 1] = cur[2 * u + 1]; } }
#pragma unroll
                for (int i = 1; i < win; ++i) { const v4u c = *(const LAS v4u*)(up - i * PL_STRIDE);
#pragma unroll
                    for (int u = 0; u < 4; ++u) { const unsigned x = c[u]; sum[2 * u] += bf2f((unsigned short)(x & 0xffffu)); sum[2 * u + 1] += bf2f((unsigned short)(x >> 16)); } }
            } else {
                const int c0 = g * 128 + 32 * ks + 8 * kq;
                { const v4u c = *(const v4u*)(U + mrow * 512 + c0);
#pragma unroll
                  for (int u = 0; u < 4; ++u) { const unsigned x = c[u]; cur[2 * u] = bf2f((unsigned short)(x & 0xffffu)); cur[2 * u + 1] = bf2f((unsigned short)(x >> 16)); sum[2 * u] = cur[2 * u]; sum[2 * u + 1] = cur[2 * u + 1]; } }
#pragma unroll
                for (int i = 1; i < win; ++i) { const float* sp = F.state_pool + ((size_t)tl * 15 + (15 - i)) * 512 + c0; const f32x4 a = *(const f32x4*)sp, bq = *(const f32x4*)(sp + 4);
                    sum[0] += a[0]; sum[1] += a[1]; sum[2] += a[2]; sum[3] += a[3]; sum[4] += bq[0]; sum[5] += bq[1]; sum[6] += bq[2]; sum[7] += bq[3]; }
            }
            const int tpos = tokb + tl; const float rc = 1.0f / (float)(SAMPLE ? win : ((tpos + 1 < win) ? tpos + 1 : win));
            v4u pw; pw.x = pk2(sum[0] * rc - cur[0], sum[1] * rc - cur[1]); pw.y = pk2(sum[2] * rc - cur[2], sum[3] * rc - cur[3]);
            pw.z = pk2(sum[4] * rc - cur[4], sum[5] * rc - cur[5]); pw.w = pk2(sum[6] * rc - cur[6], sum[7] * rc - cur[7]);
            df[ks] = __builtin_bit_cast(bf16x8, pw);
        }
#pragma unroll
        for (int jt = 0; jt < 8; ++jt) {
            f32x4 acc = (f32x4){0.f, 0.f, 0.f, 0.f};
#pragma unroll
            for (int ks = 0; ks < 4; ++ks) { const bf16x8 wf = *(const LAS bf16x8*)(F.lds + PL_W + (16 * jt + j) * PL_STRIDE + (4 * ks + kq) * 16);
                acc = __builtin_amdgcn_mfma_f32_16x16x32_bf16(wf, df[ks], acc, 0, 0, 0); }
            const int col = g * 128 + 16 * jt + 4 * kq;
            const f32x4 ps = *(const f32x4*)(F.pool_scale + col); const v2u gv = *(const v2u*)(GP + mrow * 512 + col);
            const float g0 = bf2f((unsigned short)(gv.x & 0xffffu)), g1 = bf2f((unsigned short)(gv.x >> 16)), g2 = bf2f((unsigned short)(gv.y & 0xffffu)), g3 = bf2f((unsigned short)(gv.y >> 16));
            v2u ov; ov.x = pk2(acc[0] * ps[0] * g0, acc[1] * ps[1] * g1); ov.y = pk2(acc[2] * ps[2] * g2, acc[3] * ps[3] * g3);
            *(v2u*)(MIX + mrow * 1024 + 512 + col) = ov;
        }
        __syncthreads();
    }
#undef PL_LOAD
#undef PL_STORE
}

constexpr int SM_SC = 0, SM_SEL = 8448, SM_Q = 9472, SM_P = 11520, SM_RED = 19712, SM_PT = 27904;
__device__ __forceinline__ void p3_sample_item(Frame& F, int s) {
    const int tid = F.tid, lane = F.lane, w = F.wave, r = lane & 31, hh = lane >> 5;
    const size_t m = (size_t)MP + s;
    LAS float* sc = (LAS float*)(F.lds + SM_SC); LAS int* sel = (LAS int*)(F.lds + SM_SEL); LAS float* ql = (LAS float*)(F.lds + SM_Q);
    LAS float* pl = (LAS float*)(F.lds + SM_P); LAS float* red = (LAS float*)(F.lds + SM_RED); LAS int* ptl = (LAS int*)(F.lds + SM_PT);
    const bf16* QI = (const bf16*)(F.ws + WS_QI) + m * 512; const float* WIp = (const float*)(F.ws + WS_WI) + m * 8;
    const int* pt = F.page_table + s * NPG;
    ql[tid] = bf2f(((const bf16*)(F.ws + WS_Q))[m * 512 + tid]);
    if (tid < NPG) ptl[tid] = pt[tid];
    {
        bf16x8 af[4];
#pragma unroll
        for (int ks = 0; ks < 4; ++ks) { af[ks] = (bf16x8){0, 0, 0, 0, 0, 0, 0, 0}; if (r < 8) af[ks] = *(const bf16x8*)(QI + r * 64 + 16 * ks + 8 * hh); }
        float wv[4];
#pragma unroll
        for (int e = 0; e < 4; ++e) wv[e] = WIp[4 * hh + e];
        int pg[8];
#pragma unroll
        for (int it = 0; it < 8; ++it) pg[it] = pt[(w + 8 * it) >> 2];
#pragma unroll
        for (int hf = 0; hf < 4; ++hf) {
            f32x4 x0[2][4], x1[2][4];
#pragma unroll
            for (int i4 = 0; i4 < 2; ++i4) { const int kt = w + 8 * (2 * hf + i4);
                const float* kp = F.cache_kidx + ((size_t)pg[2 * hf + i4] * PAGE + (kt & 3) * 32 + r) * 64 + 8 * hh;
#pragma unroll
                for (int ks = 0; ks < 4; ++ks) { x0[i4][ks] = *(const f32x4*)(kp + 16 * ks); x1[i4][ks] = *(const f32x4*)(kp + 16 * ks + 4); } }
#pragma unroll
            for (int i4 = 0; i4 < 2; ++i4) { const int kt = w + 8 * (2 * hf + i4);
                f32x16 acc;
#pragma unroll
                for (int e = 0; e < 16; ++e) acc[e] = 0.f;
#pragma unroll
                for (int ks = 0; ks < 4; ++ks) {
                    v4u pw; pw.x = pk2(x0[i4][ks][0], x0[i4][ks][1]); pw.y = pk2(x0[i4][ks][2], x0[i4][ks][3]); pw.z = pk2(x1[i4][ks][0], x1[i4][ks][1]); pw.w = pk2(x1[i4][ks][2], x1[i4][ks][3]);
                    acc = __builtin_amdgcn_mfma_f32_32x32x16_bf16(af[ks], __builtin_bit_cast(bf16x8, pw), acc, 0, 0, 0); }
                float part = wv[0] * fmaxf(acc[0], 0.f) + wv[1] * fmaxf(acc[1], 0.f) + wv[2] * fmaxf(acc[2], 0.f) + wv[3] * fmaxf(acc[3], 0.f);
                part += __shfl_xor(part, 32);
                if (hh == 0) sc[32 * kt + r] = part; }
        }
        if (w == 0) {
            const float kv = bf2f(((const bf16*)(F.ws + WS_KI))[m * 64 + lane]); float tot = 0.f;
#pragma unroll
            for (int h = 0; h < 8; ++h) { const float d = wave_sum(bf2f(QI[h * 64 + lane]) * kv); tot += WIp[h] * fmaxf(d, 0.f); }
            if (lane == 0) sc[PAST] = tot;
        }
    }
    __syncthreads();
    if (w == 0) {
        unsigned key[33];
#pragma unroll
        for (int jj = 0; jj < 33; ++jj) { const int l = jj * 64 + lane; key[jj] = l < PAST + 1 ? f2key(sc[l]) : 0u; }
        unsigned Tk = 0u;
        for (int bit = 31; bit >= 0; --bit) { const unsigned cand = Tk | (1u << bit); int cnt = 0;
#pragma unroll
            for (int jj = 0; jj < 33; ++jj) cnt += __popcll(__ballot(key[jj] >= cand));
            if (cnt >= 256) Tk = cand; }
        int cgt = 0;
#pragma unroll
        for (int jj = 0; jj < 33; ++jj) cgt += __popcll(__ballot(key[jj] > Tk));
        const int need = 256 - cgt; const unsigned long long lt = (1ull << lane) - 1ull; int pos = 0, eq_seen = 0;
#pragma unroll
        for (int jj = 0; jj < 33; ++jj) { const bool gt = key[jj] > Tk, eq = key[jj] == Tk;
            const unsigned long long meq = __ballot(eq); const int eqb = eq_seen + __popcll(meq & lt);
            const bool take = gt || (eq && eqb < need); const unsigned long long mt = __ballot(take);
            const int l = jj * 64 + lane;
            if (take) sel[pos + __popcll(mt & lt)] = l < PAST ? ptl[l >> 7] * PAGE + (l & 127) : -1;
            pos += __popcll(mt); eq_seen += __popcll(meq); }
    }
    __syncthreads();
    {
        const int jk = tid & 255, g = tid >> 8; const int pr = sel[jk];
        const float* krow = pr >= 0 ? F.cache_k + (size_t)pr * 128 + g * 64 : F.out + O_KS + (size_t)s * 128 + g * 64;
        f32x4 kv[16];
#pragma unroll
        for (int c = 0; c < 16; ++c) kv[c] = *(const f32x4*)(krow + 4 * c);
        float d4[4] = {0.f, 0.f, 0.f, 0.f};
#pragma unroll
        for (int c = 0; c < 16; ++c) {
#pragma unroll
            for (int rr = 0; rr < 4; ++rr) { const f32x4 qv = *(const LAS f32x4*)(ql + (4 * g + rr) * 64 + 4 * c); d4[rr] += (qv[0] * kv[c][0] + qv[1] * kv[c][1]) + (qv[2] * kv[c][2] + qv[3] * kv[c][3]); } }
#pragma unroll
        for (int rr = 0; rr < 4; ++rr) pl[(4 * g + rr) * 256 + jk] = d4[rr];
    }
    __syncthreads();
    {
        float v[4]; float mx = -INFINITY;
#pragma unroll
        for (int i = 0; i < 4; ++i) { v[i] = pl[w * 256 + lane + 64 * i]; mx = fmaxf(mx, v[i]); }
        mx = wave_max(mx); float sm = 0.f;
#pragma unroll
        for (int i = 0; i < 4; ++i) { v[i] = __builtin_amdgcn_exp2f(v[i] - mx); sm += v[i]; }
        sm = wave_sum(sm); const float inv = 1.0f / sm;
#pragma unroll
        for (int i = 0; i < 4; ++i) pl[w * 256 + lane + 64 * i] = v[i] * inv;
    }
    __syncthreads();
    {
        const int d = tid & 63, g = (tid >> 6) & 1, k4 = tid >> 7; float acc[4] = {0.f, 0.f, 0.f, 0.f};
#pragma unroll
        for (int hb = 0; hb < 2; ++hb) { float vv[32];
#pragma unroll
            for (int i = 0; i < 32; ++i) { const int pr = sel[64 * k4 + 32 * hb + i];
                const float* vrow = pr >= 0 ? F.cache_v + (size_t)pr * 128 + g * 64 : F.out + O_VS + (size_t)s * 128 + g * 64; vv[i] = vrow[d]; }
#pragma unroll
            for (int i = 0; i < 32; ++i) {
#pragma unroll
                for (int rr = 0; rr < 4; ++rr) acc[rr] += pl[(4 * g + rr) * 256 + 64 * k4 + 32 * hb + i] * vv[i]; } }
#pragma unroll
        for (int rr = 0; rr < 4; ++rr) red[((k4 * 2 + g) * 4 + rr) * 64 + d] = acc[rr];
    }
    __syncthreads();
    { const int h = tid >> 6, d = tid & 63; float a = 0.f;
#pragma unroll
        for (int k4 = 0; k4 < 4; ++k4) a += red[((k4 * 2 + (h >> 2)) * 4 + (h & 3)) * 64 + d];
        const float gate = bf2f(((const bf16*)(F.ws + WS_GA))[m * 512 + tid]);
        ((bf16*)(F.ws + WS_MIX))[m * 1024 + tid] = (bf16)f2bf(a * gate); }
    { const int c = tid, g = c >> 7, win = 2 << g; const float un = bf2f(((const bf16*)(F.ws + WS_U))[m * 512 + c]); float sum = un;
      const float* sp = F.state_pool + (size_t)s * 15 * 512 + c;
      float hv[15];
#pragma unroll
      for (int i = 1; i < 16; ++i) hv[i - 1] = sp[(size_t)(15 - i) * 512];
#pragma unroll
      for (int i = 1; i < 16; ++i) sum += (i < win) ? hv[i - 1] : 0.f;
      ql[c] = bf2f((unsigned short)f2bf(sum / (float)win - un)); }
    __syncthreads();
    { const int col = tid, g = col >> 7, j = col & 127; const bf16* wr = (const bf16*)(F.ws + WS_WPOOLT) + (size_t)g * 16384 + j * 128;
      v4u wv4[16];
#pragma unroll
      for (int i = 0; i < 16; ++i) wv4[i] = *(const v4u*)(wr + 8 * i);
      float acc = 0.f;
#pragma unroll
      for (int i = 0; i < 16; ++i) { const LAS f32x4* dp = (const LAS f32x4*)(ql + g * 128 + 8 * i); const f32x4 d0 = dp[0], d1 = dp[1];
          acc += d0[0] * bf2f((unsigned short)(wv4[i].x & 0xffffu)) + d0[1] * bf2f((unsigned short)(wv4[i].x >> 16)) + d0[2] * bf2f((unsigned short)(wv4[i].y & 0xffffu)) + d0[3] * bf2f((unsigned short)(wv4[i].y >> 16));
          acc += d1[0] * bf2f((unsigned short)(wv4[i].z & 0xffffu)) + d1[1] * bf2f((unsigned short)(wv4[i].z >> 16)) + d1[2] * bf2f((unsigned short)(wv4[i].w & 0xffffu)) + d1[3] * bf2f((unsigned short)(wv4[i].w >> 16)); }
      const float gp = bf2f(((const bf16*)(F.ws + WS_GP))[m * 512 + col]);
      ((bf16*)(F.ws + WS_MIX))[m * 1024 + 512 + col] = (bf16)f2bf(acc * F.pool_scale[col] * gp); }
    __syncthreads();
}

__device__ __forceinline__ void p3_mixer(Frame& F) {
    if (F.G == 256) {
        const int b = F.bid & 7, idx = F.bid >> 3; const bool light = idx < 16; const int i2 = idx & 15;
        for (int h = 0; h < 2; ++h) { const int pi = i2 + 16 * h, grp = pi >> 3, k = pi & 7;
            const int qa_ = light ? 16 * grp + k : 8 + 16 * grp + k, qb_ = light ? 119 - 16 * grp - k : 127 - 16 * grp - k;
            p3_prompt_item(F, b, qb_); __syncthreads(); FSTAMP();
            p3_prompt_item(F, b, qa_); __syncthreads(); FSTAMP(); }
    } else if ((F.G & 7) == 0 && F.G <= 512) {
        const int b = F.bid & 7, nper = F.G >> 3;
        for (int sidx = F.bid >> 3; sidx < 64; sidx += nper) {
            p3_prompt_item(F, b, 127 - sidx); __syncthreads(); FSTAMP();
            p3_prompt_item(F, b, sidx); __syncthreads(); FSTAMP(); }
    } else {
        for (int p = F.bid; p < 512; p += F.G) { const int b = p >> 6, sidx = p & 63;
            p3_prompt_item(F, b, 127 - sidx); __syncthreads(); FSTAMP();
            p3_prompt_item(F, b, sidx); __syncthreads(); FSTAMP(); }
    }
    for (int x = F.bid; x < 128; x += F.G) { for (int rp_ = 0; rp_ < REP_SMP; ++rp_) { p3_sample_item(F, x); __syncthreads(); } FSTAMP(); }
    for (int x = F.bid + ((F.bid < 128) ? ((128 - F.bid + F.G - 1) / F.G) * F.G : 0); x < 256; x += F.G) { for (int rp_ = 0; rp_ < REP_POOL; ++rp_) { p3_pool_item<false>(F, x - 128); __syncthreads(); } FSTAMP(); }
}
__device__ __forceinline__ void p4_sample_out(Frame& F) {
    if (F.bid >= 64) return;
    const int lane = F.lane, w = F.wave, rl = lane & 15, kq = lane >> 4, n0 = F.bid * 16;
    const bf16* ap = (const bf16*)(F.ws + WS_MIX) + (size_t)(MP + 16 * w + rl) * 1024 + 8 * kq;
    const bf16* bp = (const bf16*)(F.ws + WS_WOUTT) + (size_t)(n0 + rl) * 1024 + 8 * kq;
    f32x4 acc = (f32x4){0.f, 0.f, 0.f, 0.f};
#pragma unroll
    for (int hb = 0; hb < 2; ++hb) { bf16x8 fa[16], fb[16];
#pragma unroll
        for (int i = 0; i < 16; ++i) { fa[i] = *(const bf16x8*)(ap + 32 * (16 * hb + i)); fb[i] = *(const bf16x8*)(bp + 32 * (16 * hb + i)); }
#pragma unroll
        for (int i = 0; i < 16; ++i) acc = __builtin_amdgcn_mfma_f32_16x16x32_bf16(fa[i], fb[i], acc, 0, 0, 0); }
    const float* ada = (const float*)(F.ws + WS_ADA);
#pragma unroll
    for (int e = 0; e < 4; ++e) { const int s = 16 * w + 4 * kq + e, n = n0 + rl;
        F.out[O_YS + (size_t)s * 1024 + n] = F.xs[(size_t)s * 1024 + n] + ada[(size_t)(NB + s) * 3072 + 2048 + n] * acc[e]; }
}

struct Args { const float* in[18]; float* out; unsigned char* ws; int ph_lo, ph_hi, li, pad; };
__global__ void __launch_bounds__(NWAVES * 64, 2) mk_fwd(Args args) {
    extern __shared__ __attribute__((aligned(16))) unsigned char lds[];
    Frame F;
    F.lds = (LAS unsigned char*)lds;
    F.MISC = (volatile LAS unsigned*)(F.lds + MISC_OFF);
    F.tid = threadIdx.x; F.lane = F.tid & 63; F.wave = __builtin_amdgcn_readfirstlane(F.tid >> 6);
    F.G = gridDim.x; F.bid = blockIdx.x; { const int bx = blockIdx.x; F.vcu = (F.G % 8 == 0) ? (bx % 8) * (F.G / 8) + bx / 8 : bx; }
    F.ws = args.ws; F.out = args.out; F.ctl = (gu32*)(args.ws + WS_CTL);
    F.xp = args.in[0]; F.xs = args.in[1]; F.cache_k = args.in[2]; F.cache_v = args.in[3]; F.cache_kidx = args.in[4]; F.state_pool = args.in[5];
    F.page_table = (const int*)args.in[6]; F.cp = args.in[7]; F.cs = args.in[8]; F.norm_w = args.in[9]; F.w_ada = args.in[10]; F.b_ada = args.in[11];
    F.w_in = args.in[12]; F.qnw = args.in[13]; F.knw = args.in[14]; F.w_pool = args.in[15]; F.pool_scale = args.in[16]; F.w_out = args.in[17];
    for (int u = F.tid; u < (LDS_BYTES - LDSCTL_OFF) / 4; u += NWAVES * 64) ((LAS unsigned*)(F.lds + LDSCTL_OFF))[u] = 0u;
    __syncthreads();
    XcdBarrier bar = xcd_barrier_post((unsigned*)(F.ctl + CW_BAR) + args.li * XCD_BAR_WORDS, F.MISC + 8);
    const int lo = args.ph_lo, hi = args.ph_hi;
#if TEST_MODE == 4
    unsigned long long* ts = (unsigned long long*)(args.ws + WS_CTL + 768 * 1024); int nst = 0;
#define STAMP() do { if (blockIdx.x == STAMP_BLK && threadIdx.x == 0) ts[nst] = __builtin_amdgcn_s_memrealtime(); ++nst; } while (0)
#if P3FINE
    F.ts = ts + 16; F.nst = 0;
#endif
#else
#define STAMP() do { } while (0)
#endif
    STAMP();
#define IN(k) (lo <= (k) && (k) < hi)
#define BOTH(k) (IN(k) && IN((k) + 1))
    if (IN(0)) { for (int rp_ = 0; rp_ < REP_P0; ++rp_) { p0_prologue(F); if (rp_ + 1 < REP_P0) __syncthreads(); } STAMP(); if (BOTH(0)) xcd_barrier(bar); STAMP(); }
    if (IN(1)) { for (int rp_ = 0; rp_ < REP_P1; ++rp_) p1_norm(F); STAMP(); if (BOTH(1)) xcd_barrier(bar); STAMP(); }
    if (IN(2)) {
        for (int rp_ = 0; rp_ < REP_P2S; ++rp_) p2_sample(F);
        pg8::Gemm g{(const pg8::bf16_t*)(F.ws + WS_HB), (const pg8::bf16_t*)(F.ws + WS_WINT), MP, 3072, DM};
        pg8::StaticOrder S; S.init(MP, 3072, F.G, (int)blockIdx.x);
        pg8::EpiIn E{F.ws, F.out, F.qnw, F.knw};
        for (int rp_ = 0; rp_ < REP_P2G; ++rp_) pg8::gemm_phase<pg8::EpiIn, pg8::StaticOrder, true, true>(F.lds + RING_OFF, g, S, E);
        STAMP(); if (BOTH(2)) xcd_barrier(bar); STAMP();
    }
#if HAVE_P3
    if (IN(3)) { p3_mixer(F); STAMP(); if (BOTH(3)) xcd_barrier(bar); STAMP(); }
#endif
    if (IN(4)) {
        pg8::Gemm g{(const pg8::bf16_t*)(F.ws + WS_MIX), (const pg8::bf16_t*)(F.ws + WS_WOUTT), MP, DM, DM};
        pg8::StaticOrder S; S.init(MP, DM, F.G, (int)blockIdx.x);
        pg8::EpiOut E{F.xp, F.out + O_YP, (const float*)(F.ws + WS_ADA)};
        for (int rp_ = 0; rp_ < REP_P4G; ++rp_) pg8::gemm_phase<pg8::EpiOut, pg8::StaticOrder, true, true>(F.lds + RING_OFF, g, S, E);
        STAMP(); for (int rp_ = 0; rp_ < REP_P4S; ++rp_) p4_sample_out(F); STAMP();
    }
#undef IN
#undef BOTH
}

#if TEST_MODE && TEST_MODE < 4
namespace gold {
constexpr size_t W_ADA = 0, W_H = W_ADA + (size_t)NR * 3072, W_PROJ = W_H + (size_t)MT * 1024, W_SC = W_PROJ + (size_t)MT * NIN,
                 W_SCS = W_SC + (size_t)MP * 2048, W_SEL = W_SCS + (size_t)DECB * 2112, W_NSEL = W_SEL + (size_t)MT * 256, W_END = W_NSEL + MT;
constexpr size_t W_YT = W_H, W_MIX = W_SC, W_DB = W_SC + (size_t)MT * 1024;

__device__ __forceinline__ float wave_sum(float v) {
#pragma unroll
    for (int o = 1; o < 64; o <<= 1) v += __shfl_xor(v, o);
    return v;
}
__device__ __forceinline__ float wave_max(float v) {
#pragma unroll
    for (int o = 1; o < 64; o <<= 1) v = fmaxf(v, __shfl_xor(v, o));
    return v;
}
__device__ __forceinline__ float silu_f(float x) { return x / (1.f + expf(-x)); }

__global__ void __launch_bounds__(256) k_ada(const float* __restrict__ cp, const float* __restrict__ cs, const float* __restrict__ w_ada,
                                              const float* __restrict__ b_ada, float* __restrict__ ada) {
    const int j = blockIdx.x * 256 + threadIdx.x, r = blockIdx.y;
    const float* c = r < NB ? cp + (size_t)r * DM : cs + (size_t)(r - NB) * DM;
    float acc = 0.f;
    for (int k = 0; k < DM; ++k) { const float cv = c[k]; acc += silu_f(cv) * w_ada[(size_t)k * 3072 + j]; }
    ada[(size_t)r * 3072 + j] = acc + b_ada[j];
}

__global__ void __launch_bounds__(256) k_h(const float* __restrict__ xp, const float* __restrict__ xs, const float* __restrict__ norm_w,
                                            const float* __restrict__ ada, float* __restrict__ H) {
    const int m = blockIdx.x * 4 + (threadIdx.x >> 6), lane = threadIdx.x & 63;
    const float* x = m < MP ? xp + (size_t)m * DM : xs + (size_t)(m - MP) * DM;
    const int r = m < MP ? m / SEQ : NB + (m - MP);
    float v[16]; float ss = 0.f;
#pragma unroll
    for (int i = 0; i < 16; ++i) { v[i] = x[lane + 64 * i]; ss += v[i] * v[i]; }
    ss = wave_sum(ss);
    const float rstd = 1.0f / sqrtf(ss * (1.0f / DM) + 1e-6f);
#pragma unroll
    for (int i = 0; i < 16; ++i) { const int c = lane + 64 * i;
        H[(size_t)m * DM + c] = v[i] * rstd * norm_w[c] * (1.f + ada[(size_t)r * 3072 + 1024 + c]) + ada[(size_t)r * 3072 + c]; }
}

__global__ void __launch_bounds__(256) k_gemm(const float* __restrict__ A, const float* __restrict__ B, float* __restrict__ C,
                                               int M, int N, int K, int lda, int ldb, int ldc) {
    const int wave = threadIdx.x >> 6, lane = threadIdx.x & 63, r = lane & 31, h = lane >> 5;
    const int m0 = blockIdx.y * 128 + (wave >> 1) * 64, n0 = blockIdx.x * 128 + (wave & 1) * 64;
    f32x16 acc[2][2];
#pragma unroll
    for (int i = 0; i < 2; ++i)
#pragma unroll
        for (int j = 0; j < 2; ++j)
#pragma unroll
            for (int e = 0; e < 16; ++e) acc[i][j][e] = 0.f;
    const float* a0 = A + (size_t)(m0 + r) * lda + h;
    const float* a1 = a0 + (size_t)32 * lda;
    const int c0 = n0 + r, c1 = n0 + 32 + r; const bool v0 = c0 < N, v1 = c1 < N;
    const float* b0 = B + (size_t)h * ldb + (v0 ? c0 : 0);
    const float* b1 = B + (size_t)h * ldb + (v1 ? c1 : 0);
#pragma unroll 4
    for (int k = 0; k < K; k += 2) {
        const float x0 = a0[k], x1 = a1[k];
        float y0 = b0[(size_t)k * ldb], y1 = b1[(size_t)k * ldb];
        y0 = v0 ? y0 : 0.f; y1 = v1 ? y1 : 0.f;
        acc[0][0] = __builtin_amdgcn_mfma_f32_32x32x2f32(x0, y0, acc[0][0], 0, 0, 0);
        acc[0][1] = __builtin_amdgcn_mfma_f32_32x32x2f32(x0, y1, acc[0][1], 0, 0, 0);
        acc[1][0] = __builtin_amdgcn_mfma_f32_32x32x2f32(x1, y0, acc[1][0], 0, 0, 0);
        acc[1][1] = __builtin_amdgcn_mfma_f32_32x32x2f32(x1, y1, acc[1][1], 0, 0, 0);
    }
#pragma unroll
    for (int i = 0; i < 2; ++i)
#pragma unroll
        for (int j = 0; j < 2; ++j) { const int col = n0 + 32 * j + r;
            if (col < N) {
#pragma unroll
                for (int e = 0; e < 16; ++e) { const int row = m0 + 32 * i + (e & 3) + 8 * (e >> 2) + 4 * h; C[(size_t)row * ldc + col] = acc[i][j][e]; } } }
}

__global__ void __launch_bounds__(256) k_post(float* __restrict__ proj, const float* __restrict__ qnw, const float* __restrict__ knw,
                                               const float* __restrict__ state_pool, float* __restrict__ out) {
    const int m = blockIdx.x * 4 + (threadIdx.x >> 6), lane = threadIdx.x & 63;
    float* p = proj + (size_t)m * NIN;
    for (int hh = 0; hh < 8; ++hh) { const float v = p[CQ + hh * 64 + lane]; const float ss = wave_sum(v * v);
        p[CQ + hh * 64 + lane] = v * (1.0f / sqrtf(ss * (1.f / 64.f) + 1e-6f)) * qnw[lane]; }
    float* ko = m < MP ? out + O_KP + (size_t)m * 128 : out + O_KS + (size_t)(m - MP) * 128;
    float* vo = m < MP ? out + O_VP + (size_t)m * 128 : out + O_VS + (size_t)(m - MP) * 128;
    float* kio = m < MP ? out + O_KIP + (size_t)m * 64 : out + O_KIS + (size_t)(m - MP) * 64;
    for (int g = 0; g < 2; ++g) { const float v = p[CK + g * 64 + lane]; const float ss = wave_sum(v * v);
        const float kn = v * (1.0f / sqrtf(ss * (1.f / 64.f) + 1e-6f)) * knw[lane];
        p[CK + g * 64 + lane] = kn; ko[g * 64 + lane] = kn; vo[g * 64 + lane] = p[CV + g * 64 + lane]; }
    kio[lane] = p[CKI + lane];
    if (lane < 8) p[CWI + lane] *= 0.04419417382415922f;
    if (m < MP) { const int b = m / SEQ, t = m % SEQ;
        if (t >= SEQ - 15) { float* po = out + O_PP + ((size_t)b * 15 + (t - (SEQ - 15))) * 512;
            for (int c = lane; c < 512; c += 64) po[c] = p[CU + c]; }
    } else { const int s = m - MP; float* po = out + O_PS + (size_t)s * 15 * 512;
        for (int i = lane; i < 14 * 512; i += 64) po[i] = state_pool[(size_t)s * 15 * 512 + 512 + i];
        for (int c = lane; c < 512; c += 64) po[14 * 512 + c] = p[CU + c]; }
}

__global__ void __launch_bounds__(256) k_scores_p(const float* __restrict__ proj, float* __restrict__ SC) {
    __shared__ float qs[8][512]; __shared__ float wsm[8][8];
    const int b = blockIdx.y, t0 = blockIdx.x * 8, tid = threadIdx.x;
    for (int i = tid; i < 8 * 512; i += 256) qs[i >> 9][i & 511] = proj[(size_t)(b * SEQ + t0 + (i >> 9)) * NIN + CQI + (i & 511)];
    if (tid < 64) wsm[tid >> 3][tid & 7] = proj[(size_t)(b * SEQ + t0 + (tid >> 3)) * NIN + CWI + (tid & 7)];
    __syncthreads();
    for (int l = tid; l <= t0 + 7; l += 256) {
        float kr[64];
        const float4* kp = (const float4*)(proj + (size_t)(b * SEQ + l) * NIN + CKI);
#pragma unroll
        for (int i = 0; i < 16; ++i) { const float4 v = kp[i]; kr[4 * i] = v.x; kr[4 * i + 1] = v.y; kr[4 * i + 2] = v.z; kr[4 * i + 3] = v.w; }
        for (int q = 0; q < 8; ++q) {
            if (l > t0 + q) continue;
            float s = 0.f;
            for (int hh = 0; hh < 8; ++hh) { float d = 0.f;
#pragma unroll
                for (int e = 0; e < 64; ++e) d += qs[q][hh * 64 + e] * kr[e];
                s += wsm[q][hh] * fmaxf(d, 0.f); }
            SC[(size_t)(b * SEQ + t0 + q) * 2048 + l] = s;
        }
    }
}
__global__ void __launch_bounds__(256) k_scores_s(const float* __restrict__ proj, const float* __restrict__ cache_kidx, const int* __restrict__ page_table,
                                                   float* __restrict__ SCS) {
    __shared__ float qs[512]; __shared__ float wsm[8];
    const int s = blockIdx.x, tid = threadIdx.x; const float* prow = proj + (size_t)(MP + s) * NIN;
    for (int i = tid; i < 512; i += 256) qs[i] = prow[CQI + i];
    if (tid < 8) wsm[tid] = prow[CWI + tid];
    __syncthreads();
    for (int l = tid; l < PAST + 1; l += 256) {
        const float* kp_ = l < PAST ? cache_kidx + ((size_t)page_table[s * NPG + l / PAGE] * PAGE + (l % PAGE)) * 64 : prow + CKI;
        float kr[64];
#pragma unroll
        for (int i = 0; i < 64; ++i) kr[i] = kp_[i];
        float sc = 0.f;
        for (int hh = 0; hh < 8; ++hh) { float d = 0.f;
#pragma unroll
            for (int e = 0; e < 64; ++e) d += qs[hh * 64 + e] * kr[e];
            sc += wsm[hh] * fmaxf(d, 0.f); }
        SCS[(size_t)s * 2112 + l] = sc;
    }
}

__device__ __forceinline__ unsigned f2key(float f) { unsigned u = __float_as_uint(f); if (f == 0.0f) u = 0u; return (u & 0x80000000u) ? ~u : (u | 0x80000000u); }
__global__ void __launch_bounds__(256) k_topk(const float* __restrict__ SC, const float* __restrict__ SCS, int* __restrict__ SEL, int* __restrict__ NSEL) {
    const int m = blockIdx.x * 4 + (threadIdx.x >> 6), lane = threadIdx.x & 63;
    const float* src; int n;
    if (m < MP) { n = (m % SEQ) + 1; src = SC + (size_t)m * 2048; } else { n = PAST + 1; src = SCS + (size_t)(m - MP) * 2112; }
    int* sel = SEL + (size_t)m * 256;
    if (n <= 256) { for (int i = lane; i < n; i += 64) sel[i] = i; if (lane == 0) NSEL[m] = n; return; }
    unsigned key[33];
#pragma unroll
    for (int j = 0; j < 33; ++j) { const int l = j * 64 + lane; key[j] = l < n ? f2key(src[l]) : 0u; }
    unsigned T = 0u;
    for (int bit = 31; bit >= 0; --bit) { const unsigned cand = T | (1u << bit); int cnt = 0;
#pragma unroll
        for (int j = 0; j < 33; ++j) cnt += __popcll(__ballot(key[j] >= cand));
        if (cnt >= 256) T = cand; }
    int cgt = 0;
#pragma unroll
    for (int j = 0; j < 33; ++j) cgt += __popcll(__ballot(key[j] > T));
    const int need = 256 - cgt;
    const unsigned long long lt = (1ull << lane) - 1ull;
    int pos = 0, eq_seen = 0;
#pragma unroll
    for (int j = 0; j < 33; ++j) { const bool gt = key[j] > T, eq = key[j] == T;
        const unsigned long long meq = __ballot(eq); const int eqb = eq_seen + __popcll(meq & lt);
        const bool take = gt || (eq && eqb < need);
        const unsigned long long mt = __ballot(take);
        if (take) sel[pos + __popcll(mt & lt)] = j * 64 + lane;
        pos += __popcll(mt); eq_seen += __popcll(meq); }
    if (lane == 0) NSEL[m] = 256;
}

__global__ void __launch_bounds__(256) k_attn(const float* __restrict__ proj, const float* __restrict__ cache_k, const float* __restrict__ cache_v,
                                               const int* __restrict__ page_table, const int* __restrict__ SEL, const int* __restrict__ NSEL, float* __restrict__ MIX) {
    __shared__ float pl[4][8][256]; __shared__ int il[4][256]; __shared__ float ql[4][512];
    const int w = threadIdx.x >> 6, lane = threadIdx.x & 63, m = blockIdx.x * 4 + w;
    const int nsel = NSEL[m]; const float* prow = proj + (size_t)m * NIN;
    const bool prompt = m < MP; const int b = m / SEQ, s = m - MP;
    for (int i = lane; i < 512; i += 64) ql[w][i] = prow[CQ + i];
    for (int i = lane; i < 256; i += 64) {
        if (i < nsel) { const int l = SEL[(size_t)m * 256 + i]; il[w][i] = l;
            const float* krow = prompt ? proj + (size_t)(b * SEQ + l) * NIN + CK
                                       : (l < PAST ? cache_k + ((size_t)page_table[s * NPG + l / PAGE] * PAGE + (l % PAGE)) * 128 : prow + CK);
            for (int g = 0; g < 2; ++g) { float kr[64];
#pragma unroll
                for (int e = 0; e < 64; ++e) kr[e] = krow[g * 64 + e];
                for (int r = 0; r < 4; ++r) { float d = 0.f;
#pragma unroll
                    for (int e = 0; e < 64; ++e) d += ql[w][(g * 4 + r) * 64 + e] * kr[e];
                    pl[w][g * 4 + r][i] = d * 0.125f; } }
        } else { il[w][i] = 0; for (int hh = 0; hh < 8; ++hh) pl[w][hh][i] = -INFINITY; }
    }
    for (int hh = 0; hh < 8; ++hh) { float v[4]; float mx = -INFINITY;
#pragma unroll
        for (int i = 0; i < 4; ++i) { v[i] = pl[w][hh][lane + 64 * i]; mx = fmaxf(mx, v[i]); }
        mx = wave_max(mx); float sm = 0.f;
#pragma unroll
        for (int i = 0; i < 4; ++i) { v[i] = expf(v[i] - mx); sm += v[i]; }
        sm = wave_sum(sm); const float inv = 1.0f / sm;
#pragma unroll
        for (int i = 0; i < 4; ++i) pl[w][hh][lane + 64 * i] = v[i] * inv; }
    for (int g = 0; g < 2; ++g) { float acc[4] = {0.f, 0.f, 0.f, 0.f};
        for (int i = 0; i < nsel; ++i) { const int l = il[w][i];
            const float* vrow = prompt ? proj + (size_t)(b * SEQ + l) * NIN + CV
                                       : (l < PAST ? cache_v + ((size_t)page_table[s * NPG + l / PAGE] * PAGE + (l % PAGE)) * 128 : prow + CV);
            const float vv = vrow[g * 64 + lane];
#pragma unroll
            for (int r = 0; r < 4; ++r) acc[r] += pl[w][g * 4 + r][i] * vv; }
#pragma unroll
        for (int r = 0; r < 4; ++r) { const int c = (g * 4 + r) * 64 + lane; MIX[(size_t)m * 1024 + c] = acc[r] * silu_f(prow[CGA + c]); } }
}

__global__ void __launch_bounds__(256) k_pool_d(const float* __restrict__ proj, const float* __restrict__ state_pool, float* __restrict__ DB) {
    const size_t idx = (size_t)blockIdx.x * 256 + threadIdx.x; const int m = (int)(idx >> 9), c = (int)(idx & 511);
    const int g = c >> 7, w = 2 << g; const float un = proj[(size_t)m * NIN + CU + c]; float sum = un; float cnt;
    if (m < MP) { const int t = m % SEQ; for (int i = 1; i < w; ++i) if (t - i >= 0) sum += proj[(size_t)(m - i) * NIN + CU + c]; cnt = (float)(t + 1 < w ? t + 1 : w); }
    else { const int s = m - MP; for (int i = 1; i < w; ++i) sum += state_pool[((size_t)s * 15 + (15 - i)) * 512 + c]; cnt = (float)w; }
    DB[idx] = sum / cnt - un;
}
__global__ void __launch_bounds__(256) k_pool_out(const float* __restrict__ proj, const float* __restrict__ DB, const float* __restrict__ w_pool,
                                                   const float* __restrict__ pool_scale, float* __restrict__ MIX) {
    const size_t idx = (size_t)blockIdx.x * 256 + threadIdx.x; const int m = (int)(idx >> 9), col = (int)(idx & 511), g = col >> 7, j = col & 127;
    float acc = 0.f;
    for (int c = 0; c < 128; ++c) acc += DB[(size_t)m * 512 + g * 128 + c] * w_pool[((size_t)g * 128 + c) * 128 + j];
    MIX[(size_t)m * 1024 + 512 + col] = acc * pool_scale[col] * silu_f(proj[(size_t)m * NIN + CGP + col]);
}
__global__ void __launch_bounds__(256) k_final(const float* __restrict__ xp, const float* __restrict__ xs, const float* __restrict__ ada,
                                                const float* __restrict__ YT, float* __restrict__ out) {
    const size_t idx = (size_t)blockIdx.x * 256 + threadIdx.x; const int m = (int)(idx >> 10), c = (int)(idx & 1023);
    const int r = m < MP ? m / SEQ : NB + (m - MP);
    const float x = m < MP ? xp[idx] : xs[idx - (size_t)MP * 1024];
    float* o = m < MP ? out + O_YP + idx : out + O_YS + (idx - (size_t)MP * 1024);
    *o = x + ada[(size_t)r * 3072 + 2048 + c] * YT[idx];
}

}
#endif

#if TEST_MODE
__global__ void __launch_bounds__(256) k_cmp(const void* a, int a_bf16, int lda, const float* ref, int ldr, int rows, int cols, float scale, int act, float* accum) {
    __shared__ float sd[256], sr[256];
    const size_t idx = (size_t)blockIdx.x * 256 + threadIdx.x; float d2 = 0.f, r2 = 0.f;
    if (idx < (size_t)rows * cols) { const size_t r = idx / cols, c = idx % cols;
        const float av = a_bf16 ? bf2f(((const bf16*)a)[r * lda + c]) : ((const float*)a)[r * lda + c];
        float rv = ref[r * ldr + c]; if (act) rv = rv / (1.f + expf(-rv)); rv *= scale;
        d2 = (av - rv) * (av - rv); r2 = rv * rv; if (!(d2 == d2)) d2 = 1e30f; }
    sd[threadIdx.x] = d2; sr[threadIdx.x] = r2; __syncthreads();
    for (int s = 128; s > 0; s >>= 1) { if ((int)threadIdx.x < s) { sd[threadIdx.x] += sd[threadIdx.x + s]; sr[threadIdx.x] += sr[threadIdx.x + s]; } __syncthreads(); }
    if (threadIdx.x == 0) { atomicAdd(accum, sd[0]); atomicAdd(accum + 1, sr[0]); }
}
__global__ void __launch_bounds__(256) k_cmp_sel(const int* SEL, const int* NSEL, const unsigned* bmdump, float* accum) {
    __shared__ float sd[256], sr[256];
    const size_t idx = (size_t)blockIdx.x * 256 + threadIdx.x; const int m = (int)(idx >> 8), i = (int)(idx & 255); float miss = 0.f, tot = 0.f;
    if (m < MP && i < NSEL[m]) { const int l = SEL[(size_t)m * 256 + i]; tot = 1.f; if (!((bmdump[(size_t)m * 64 + (l >> 5)] >> (l & 31)) & 1u)) miss = 1.f; }
    sd[threadIdx.x] = miss; sr[threadIdx.x] = tot; __syncthreads();
    for (int s = 128; s > 0; s >>= 1) { if ((int)threadIdx.x < s) { sd[threadIdx.x] += sd[threadIdx.x + s]; sr[threadIdx.x] += sr[threadIdx.x + s]; } __syncthreads(); }
    if (threadIdx.x == 0) { atomicAdd(accum, sd[0]); atomicAdd(accum + 1, sr[0]); }
}
__global__ void k_cmp_fin2(float* accum, int n, float amp) {
    float best = -1.f; int bi = 0;
    for (int k = 0; k < n; ++k) { const float rel = accum[2 * k] / fmaxf(accum[2 * k + 1], 1e-30f) / accum[32 + k]; if (rel > best) { best = rel; bi = k; } }
    accum[64] = sqrtf(amp * best); accum[65] = (float)bi;
}
__global__ void k_set(float* p, float a, float b, float c, float d, float e) { p[0] = a; p[1] = b; p[2] = c; p[3] = d; p[4] = e; }
__global__ void k_cmp_fin(float* accum, int n, float amp) {
    float best = -1.f; int bi = 0;
    for (int k = 0; k < n; ++k) { const float rel = accum[2 * k] / fmaxf(accum[2 * k + 1], 1e-30f); if (rel > best) { best = rel; bi = k; } }
    accum[64] = sqrtf(amp * best); accum[65] = (float)bi;
}
__global__ void __launch_bounds__(256) k_perturb(float* out, const float* accum) {
    const size_t offs[11] = {O_YP, O_YS, O_KP, O_VP, O_KIP, O_PP, O_KS, O_VS, O_KIS, O_PS, O_END};
    const int k = (int)accum[65] % 10; const float f = 1.0f + accum[64];
    for (size_t i = offs[k] + (size_t)blockIdx.x * 256 + threadIdx.x; i < offs[k + 1]; i += (size_t)gridDim.x * 256) out[i] *= f;
}
__global__ void __launch_bounds__(256) k_f32_to_bf16(const float* src, bf16* dst, size_t n) {
    for (size_t i = (size_t)blockIdx.x * 256 + threadIdx.x; i < n; i += (size_t)gridDim.x * 256) dst[i] = (bf16)f2bf(src[i]);
}
#endif

#if TEST_MODE == 5
__global__ void __launch_bounds__(256) k_stat(float* out, const unsigned* st, int which) {
    float v = which == 0 ? (float)st[0] : (which == 1 ? (float)st[1] / fmaxf((float)st[2], 1.f) : (float)st[3]);
    const float f = 1.0f + sqrtf(v * 1e-5f);
    for (size_t i = O_KS + (size_t)blockIdx.x * 256 + threadIdx.x; i < O_VS; i += (size_t)gridDim.x * 256) out[i] *= f;
}
#endif
#if TEST_MODE == 4
__global__ void __launch_bounds__(256) k_time(float* out, const unsigned long long* ts, int i0, int i1, float scale) {
    const float us = (float)(ts[i1] - ts[i0]) * 0.01f; const float f = 1.0f + sqrtf(us * scale);
    for (size_t i = O_KS + (size_t)blockIdx.x * 256 + threadIdx.x; i < O_VS; i += (size_t)gridDim.x * 256) out[i] *= f;
}
#endif
extern "C" void kernel_launch(void* const* d_in, const int* in_sizes, int n_in, void* d_out, int out_size, void* d_ws, size_t ws_size, hipStream_t stream) {
    static int grid = 0;
    if (grid == 0) {
        size_t need = WS_MEGA_END;
#if TEST_MODE && TEST_MODE < 4
        need = 192 * MiB + gold::W_END * 4;
#endif
        if (n_in != 18 || out_size != (int)O_END || ws_size < need) { fprintf(stderr, "kernel_launch: unexpected sizes: n_in %d out %d ws %zu (need %zu)\n", n_in, out_size, ws_size, need); grid = -1; return; }
        int dev = 0, cus = 0, per_cu = 0;
        if (hipGetDevice(&dev) != hipSuccess || hipDeviceGetAttribute(&cus, hipDeviceAttributeMultiprocessorCount, dev) != hipSuccess) { grid = -1; return; }
        if (hipFuncSetAttribute((const void*)mk_fwd, hipFuncAttributeMaxDynamicSharedMemorySize, LDS_BYTES) != hipSuccess) { fprintf(stderr, "kernel_launch: hipFuncSetAttribute failed\n"); grid = -1; return; }
        if (hipOccupancyMaxActiveBlocksPerMultiprocessor(&per_cu, (const void*)mk_fwd, NWAVES * 64, LDS_BYTES) != hipSuccess || per_cu < 1) { fprintf(stderr, "kernel_launch: occupancy query says %d blocks/CU\n", per_cu); (void)hipGetLastError(); grid = -1; return; }
        if (cus < 64) { fprintf(stderr, "kernel_launch: needs >= 64 CUs\n"); grid = -1; return; }
        grid = cus;
    }
    if (grid < 0) return;
#if TEST_MODE
    (void)hipMemsetAsync((char*)d_ws + WS_CTL, 0, CTL_ZERO_BYTES, stream);
#else
    (void)hipMemsetAsync((char*)d_ws + WS_CTL + CW_BAR * 4, 0, XCD_BAR_WORDS * 4, stream);
#endif
    Args a{};
    for (int i = 0; i < 18; ++i) a.in[i] = (const float*)d_in[i];
    a.out = (float*)d_out; a.ws = (unsigned char*)d_ws;
#if TEST_MODE == 5
    a.ph_lo = 0; a.ph_hi = 5; a.li = 0;
    hipLaunchKernelGGL(mk_fwd, dim3(grid), dim3(NWAVES * 64), LDS_BYTES, stream, a);
    k_stat<<<16, 256, 0, stream>>>((float*)d_out, (const unsigned*)((char*)d_ws + WS_CTL + 900 * 1024), STATSEL);
#elif TEST_MODE == 4
    a.ph_lo = 0; a.ph_hi = 5; a.li = 0;
    hipLaunchKernelGGL(mk_fwd, dim3(grid), dim3(NWAVES * 64), LDS_BYTES, stream, a);
    k_time<<<16, 256, 0, stream>>>((float*)d_out, (const unsigned long long*)((char*)d_ws + WS_CTL + 768 * 1024), TS0, TS1, 1e-5f);
#elif TEST_MODE && TEST_MODE < 4
    {
        using namespace gold;
        const float* xp = (const float*)d_in[0]; const float* xs = (const float*)d_in[1];
        const float* cache_k = (const float*)d_in[2]; const float* cache_v = (const float*)d_in[3]; const float* cache_kidx = (const float*)d_in[4];
        const float* state_pool = (const float*)d_in[5]; const int* page_table = (const int*)d_in[6];
        const float* cp = (const float*)d_in[7]; const float* cs = (const float*)d_in[8]; const float* norm_w = (const float*)d_in[9];
        const float* w_ada = (const float*)d_in[10]; const float* b_ada = (const float*)d_in[11]; const float* w_in = (const float*)d_in[12];
        const float* qnw = (const float*)d_in[13]; const float* knw = (const float*)d_in[14]; const float* w_pool = (const float*)d_in[15];
        const float* pool_scale = (const float*)d_in[16]; const float* w_out = (const float*)d_in[17];
        float* out = (float*)d_out; float* ws = (float*)((char*)d_ws + 192 * MiB);
        float *ADA = ws + W_ADA, *H = ws + W_H, *PROJ = ws + W_PROJ, *SC = ws + W_SC, *SCS = ws + W_SCS, *MIX = ws + W_MIX, *DB = ws + W_DB, *YT = ws + W_YT;
        int *SEL = (int*)(ws + W_SEL), *NSEL = (int*)(ws + W_NSEL);
        k_ada<<<dim3(12, NR), 256, 0, stream>>>(cp, cs, w_ada, b_ada, ADA);
        k_h<<<MT / 4, 256, 0, stream>>>(xp, xs, norm_w, ADA, H);
        k_gemm<<<dim3((NIN + 127) / 128, MT / 128), 256, 0, stream>>>(H, w_in, PROJ, MT, NIN, DM, DM, NIN, NIN);
        k_post<<<MT / 4, 256, 0, stream>>>(PROJ, qnw, knw, state_pool, out);
        k_scores_p<<<dim3(SEQ / 8, NB), 256, 0, stream>>>(PROJ, SC);
        k_scores_s<<<DECB, 256, 0, stream>>>(PROJ, cache_kidx, page_table, SCS);
        k_topk<<<MT / 4, 256, 0, stream>>>(SC, SCS, SEL, NSEL);
        k_attn<<<MT / 4, 256, 0, stream>>>(PROJ, cache_k, cache_v, page_table, SEL, NSEL, MIX);
        k_pool_d<<<(MT * 512) / 256, 256, 0, stream>>>(PROJ, state_pool, DB);
        k_pool_out<<<(MT * 512) / 256, 256, 0, stream>>>(PROJ, DB, w_pool, pool_scale, MIX);
        k_gemm<<<dim3(1024 / 128, MT / 128), 256, 0, stream>>>(MIX, w_out, YT, MT, 1024, 1024, 1024, 1024, 1024);
        k_final<<<(MT * 1024) / 256, 256, 0, stream>>>(xp, xs, ADA, YT, out);
        unsigned char* mws = (unsigned char*)d_ws;
#if TEST_MODE == 1
        a.ph_lo = 0; a.ph_hi = 3; a.li = 0;
        hipLaunchKernelGGL(mk_fwd, dim3(grid), dim3(NWAVES * 64), LDS_BYTES, stream, a);
        float* accum = (float*)(mws + WS_CTL + 512 * 1024);
        struct { const void* a; int bf; int lda; int refcol; int cols; float scale; int act; } L[9] = {
            {mws + WS_Q, 1, 512, CQ, 512, C2, 0}, {mws + WS_QI, 1, 512, CQI, 512, 1.f, 0}, {mws + WS_GA, 1, 512, CGA, 512, 1.f, 1}, {mws + WS_U, 1, 512, CU, 512, 1.f, 0},
            {mws + WS_GP, 1, 512, CGP, 512, 1.f, 1}, {mws + WS_KB, 1, 128, CK, 128, 1.f, 0}, {mws + WS_VB, 1, 128, CV, 128, 1.f, 0}, {mws + WS_KI, 1, 64, CKI, 64, 1.f, 0},
            {mws + WS_WI, 0, 8, CWI, 8, 1.f, 0} };
        for (int k = 0; k < 9; ++k) k_cmp<<<(unsigned)(((size_t)MT * L[k].cols + 255) / 256), 256, 0, stream>>>(L[k].a, L[k].bf, L[k].lda, PROJ + L[k].refcol, NIN, MT, L[k].cols, L[k].scale, L[k].act, accum + 2 * k);
        k_cmp<<<(NR * 3072 + 255) / 256, 256, 0, stream>>>(mws + WS_ADA, 0, 3072, ADA, 3072, NR, 3072, 1.f, 0, accum + 18);
        k_cmp_fin<<<1, 1, 0, stream>>>(accum, 10, 5.0f);
        k_perturb<<<1024, 256, 0, stream>>>(out, accum);
#elif TEST_MODE == 3
        a.ph_lo = 0; a.ph_hi = 5; a.li = 0;
        hipLaunchKernelGGL(mk_fwd, dim3(grid), dim3(NWAVES * 64), LDS_BYTES, stream, a);
        float* accum = (float*)(mws + WS_CTL + 512 * 1024);
        const bf16* MB = (const bf16*)(mws + WS_MIX);
        k_cmp<<<(unsigned)(((size_t)MP * 512 + 255) / 256), 256, 0, stream>>>(MB, 1, 1024, MIX, 1024, MP, 512, 1.f, 0, accum + 0);
        k_cmp<<<(unsigned)(((size_t)MP * 512 + 255) / 256), 256, 0, stream>>>(MB + 512, 1, 1024, MIX + 512, 1024, MP, 512, 1.f, 0, accum + 2);
        k_cmp<<<(DECB * 512 + 255) / 256, 256, 0, stream>>>(MB + (size_t)MP * 1024, 1, 1024, MIX + (size_t)MP * 1024, 1024, DECB, 512, 1.f, 0, accum + 4);
        k_cmp<<<(DECB * 512 + 255) / 256, 256, 0, stream>>>(MB + (size_t)MP * 1024 + 512, 1, 1024, MIX + (size_t)MP * 1024 + 512, 1024, DECB, 512, 1.f, 0, accum + 6);
        k_cmp_sel<<<MP, 256, 0, stream>>>(SEL, NSEL, (const unsigned*)(mws + WS_DBG_BM), accum + 8);
        k_set<<<1, 1, 0, stream>>>(accum + 32, P3_TOL0, P3_TOL1, P3_TOL2, P3_TOL3, P3_TOL4);
        k_cmp_fin2<<<1, 1, 0, stream>>>(accum, 5, 1e-5f);
        k_perturb<<<1024, 256, 0, stream>>>(out, accum);
#elif TEST_MODE == 2
        a.ph_lo = 0; a.ph_hi = 3; a.li = 0;
        hipLaunchKernelGGL(mk_fwd, dim3(grid), dim3(NWAVES * 64), LDS_BYTES, stream, a);
        k_f32_to_bf16<<<2048, 256, 0, stream>>>(MIX, (bf16*)(mws + WS_MIX), (size_t)MT * 1024);
        a.ph_lo = 4; a.ph_hi = 5; a.li = 1;
        hipLaunchKernelGGL(mk_fwd, dim3(grid), dim3(NWAVES * 64), LDS_BYTES, stream, a);
#endif
    }
#else
    a.ph_lo = 0; a.ph_hi = 5; a.li = 0;
    hipLaunchKernelGGL(mk_fwd, dim3(grid), dim3(NWAVES * 64), LDS_BYTES, stream, a);
#endif
}
```

```cpp
#define TEST_MODE 0
#define HAVE_P3 1
#define REP_S1 1
#define REP_S2 1
#define REP_S4 1
#define REP_P0 1
#define REP_P1 1
#define REP_P4S 1
#define REP_P2G 1
#define REP_P4G 1
#define REP_P2S 1
#define REP_SMP 1
#define REP_POOL 1
#define STATSEL 0
#define STAMP_BLK 0
#define P3FINE 0
#define TS0 0
#define TS1 1
#define P3_TOL0 1e-2f
#define P3_TOL1 1e-4f
#define P3_TOL2 1e-2f
#define P3_TOL3 1e-4f
#define P3_TOL4 3e-2f
#include <hip/hip_runtime.h>
#include <cstdio>
#include <cstdint>

constexpr int DM = 1024, NB = 8, SEQ = 2048, DECB = 128, PAST = 2048, PAGE = 128, NPG = 16;
constexpr int NIN = 2888, MP = NB * SEQ, MT = MP + DECB, NR = NB + DECB;
constexpr int CQ = 0, CK = 512, CV = 640, CQI = 768, CKI = 1280, CWI = 1344, CGA = 1352, CU = 1864, CGP = 2376;
constexpr size_t O_YP = 0, O_YS = 16777216, O_KP = 16908288, O_VP = 19005440, O_KIP = 21102592, O_PP = 22151168,
                 O_KS = 22212608, O_VS = 22228992, O_KIS = 22245376, O_PS = 22253568, O_END = 23236608;
constexpr float C2 = 0.125f * 1.4426950408889634f;
constexpr float WI_SCALE = 0.04419417382415922f;
constexpr float EPS = 1e-6f;
constexpr size_t MiB = 1u << 20;
constexpr size_t WS_CTL = 0, CTL_ZERO_BYTES = 1 * MiB;
constexpr size_t WS_ADA = 1 * MiB, WS_WINT = 3 * MiB, WS_WOUTT = 9 * MiB, WS_WPOOLT = 11 * MiB, WS_HS = 12 * MiB, WS_HB = 24 * MiB,
                 WS_Q = 56 * MiB, WS_QI = 73 * MiB, WS_GA = 90 * MiB, WS_U = 107 * MiB, WS_GP = 124 * MiB, WS_KB = 141 * MiB, WS_VB = 146 * MiB,
                 WS_KI = 151 * MiB, WS_WI = 154 * MiB, WS_MIX = 155 * MiB, WS_DBG_BM = 188 * MiB, WS_MEGA_END = 192 * MiB;
namespace pg8 {
#define PG8_LAS __attribute__((address_space(3)))
typedef unsigned short bf16_t;
typedef short bf16x8 __attribute__((ext_vector_type(8)));
typedef float f32x4 __attribute__((ext_vector_type(4)));
typedef unsigned u32x4 __attribute__((ext_vector_type(4)));
constexpr int BM = 256, BK = 64, HALF = 128, HTB = HALF * BK * 2  , STAGE_BYTES = 8 * HTB, NXCD = 8, WGM = 8;

__host__ __device__ __forceinline__ int lds_byte(int r, int c) { const int st = (r >> 4) * 2 + (c >> 5), rr = r & 15, cc = c & 31, ob = rr * 64 + cc * 2; return st * 1024 + (ob ^ (((ob >> 9) & 1) << 5)); }
__host__ __device__ __forceinline__ void stage_rc(int b, int& R, int& C) { const int st = b / 1024, sb = b % 1024, swz = sb ^ (((sb >> 9) & 1) << 5); R = (st >> 1) * 16 + swz / 64; C = (st & 1) * 32 + (swz % 64) / 2; }
__host__ __device__ __forceinline__ int perm32(int rho) { const int n = rho >> 4, i = rho & 15; return 8 * (i >> 2) + 4 * n + (i & 3); }

struct Unit { int pm, pn; };
struct Gemm { const bf16_t* A; const bf16_t* Bt; int M, N, K; };

struct StaticOrder {
    int nM, nN, nwg, G, c;
    __host__ __device__ void init(int M, int N, int G_, int c_) { nM = M / BM; nN = N / BM; nwg = nM * nN; G = G_; c = c_; }
    __host__ __device__ bool next(int i, Unit& u) const {
        const long L = (long)i * G + c; if (L >= nwg) return false;
        int wgid = (int)L; { const int q = nwg / NXCD, r = nwg % NXCD, xcd = wgid % NXCD, off = wgid / NXCD; wgid = (xcd < r ? xcd * (q + 1) : r * (q + 1) + (xcd - r) * q) + off; }
        const int nig = WGM * nN, gid = wgid / nig, fm = gid * WGM, gsz = (nM - fm) < WGM ? (nM - fm) : WGM;
        u.pm = fm + ((wgid % nig) % gsz); u.pn = (wgid % nig) / gsz; return true;
    }
    __device__ __forceinline__ void a_ready(const Unit&) const {}
    __device__ __forceinline__ void done(const Unit&) const {}
};


typedef unsigned u32x4 __attribute__((ext_vector_type(4)));
__device__ __forceinline__ unsigned cvt_pk_bf16(float lo, float hi) { unsigned r; asm volatile("v_cvt_pk_bf16_f32 %0, %1, %2" : "=v"(r) : "v"(lo), "v"(hi)); return r; }
__device__ __forceinline__ void st_bf16x8(bf16_t* p, const f32x4 a, const f32x4 b) {
    u32x4 w; w.x = cvt_pk_bf16(a[0], a[1]); w.y = cvt_pk_bf16(a[2], a[3]); w.z = cvt_pk_bf16(b[0], b[1]); w.w = cvt_pk_bf16(b[2], b[3]); *(u32x4*)p = w; }
__device__ __forceinline__ float silu1(float x) { return x * __builtin_amdgcn_rcpf(1.0f + __builtin_amdgcn_exp2f(-1.4426950408889634f * x)); }
__device__ __forceinline__ f32x4 silu4(const f32x4 v) { f32x4 r; r[0] = silu1(v[0]); r[1] = silu1(v[1]); r[2] = silu1(v[2]); r[3] = silu1(v[3]); return r; }

struct EpiIn {
    static constexpr bool PERM = true, AFTER_DRAIN = false;
    unsigned char* ws; float* out; const float* qnw; const float* knw;
    __device__ __forceinline__ void operator()(const f32x4 (&acc)[2][2][4][2], const Unit& u, int wr, int wc, int fr, int fq) const {
        const int pn = u.pn;
        if (pn == 5 && wc >= 2) return;
        const int rowb = u.pm * 256 + wr * 64 + fr, dof = 8 * fq;
        if (pn <= 1 || (pn == 2 && wc < 2)) {
            const float* nwp = pn <= 1 ? qnw : knw; const float sc = pn <= 1 ? C2 : 1.0f;
            f32x4 wv[2][2];
#pragma unroll
            for (int bj = 0; bj < 2; ++bj)
#pragma unroll
                for (int n = 0; n < 2; ++n) wv[bj][n] = *(const f32x4*)(nwp + 32 * bj + dof + 4 * n) * sc;
#pragma unroll
            for (int ai = 0; ai < 2; ++ai)
#pragma unroll
                for (int m = 0; m < 4; ++m) { const size_t row = (size_t)(rowb + ai * 128 + m * 16); float ss = 0.f;
#pragma unroll
                    for (int bj = 0; bj < 2; ++bj)
#pragma unroll
                        for (int n = 0; n < 2; ++n) { const f32x4 x = acc[ai][bj][m][n]; ss += (x[0] * x[0] + x[1] * x[1]) + (x[2] * x[2] + x[3] * x[3]); }
                    ss += __shfl_xor(ss, 16); ss += __shfl_xor(ss, 32);
                    const float rstd = 1.0f / sqrtf(ss * (1.0f / 64.0f) + EPS);
                    f32x4 o[2][2];
#pragma unroll
                    for (int bj = 0; bj < 2; ++bj)
#pragma unroll
                        for (int n = 0; n < 2; ++n) o[bj][n] = acc[ai][bj][m][n] * rstd * wv[bj][n];
                    if (pn <= 1) { bf16_t* q = (bf16_t*)(ws + WS_Q) + row * 512 + (4 * pn + wc) * 64 + dof; st_bf16x8(q, o[0][0], o[0][1]); st_bf16x8(q + 32, o[1][0], o[1][1]); }
                    else { float* ko = out + O_KP + row * 128 + wc * 64 + dof; *(f32x4*)ko = o[0][0]; *(f32x4*)(ko + 4) = o[0][1]; *(f32x4*)(ko + 32) = o[1][0]; *(f32x4*)(ko + 36) = o[1][1];
                        bf16_t* kb = (bf16_t*)(ws + WS_KB) + row * 128 + wc * 64 + dof; st_bf16x8(kb, o[0][0], o[0][1]); st_bf16x8(kb + 32, o[1][0], o[1][1]); } }
            return;
        }
        if (pn == 5 && wc == 1) {
            if (fq == 0) {
#pragma unroll
                for (int ai = 0; ai < 2; ++ai)
#pragma unroll
                    for (int m = 0; m < 4; ++m) { const size_t row = (size_t)(rowb + ai * 128 + m * 16); float* wp = (float*)(ws + WS_WI) + row * 8;
                        *(f32x4*)wp = acc[ai][0][m][0] * WI_SCALE; *(f32x4*)(wp + 4) = acc[ai][0][m][1] * WI_SCALE; } }
            return;
        }
        bf16_t* dst; int ld, cb; float* fo = nullptr; int fld = 0; bool act = false;
        if (pn == 2) { dst = (bf16_t*)(ws + WS_VB); ld = 128; cb = (wc - 2) * 64; fo = out + O_VP + cb; fld = 128; }
        else if (pn <= 4) { dst = (bf16_t*)(ws + WS_QI); ld = 512; cb = (4 * (pn - 3) + wc) * 64; }
        else if (pn == 5) { dst = (bf16_t*)(ws + WS_KI); ld = 64; cb = 0; fo = out + O_KIP; fld = 64; }
        else if (pn <= 7) { dst = (bf16_t*)(ws + WS_GA); ld = 512; cb = (4 * (pn - 6) + wc) * 64; act = true; }
        else if (pn <= 9) { dst = (bf16_t*)(ws + WS_U); ld = 512; cb = (4 * (pn - 8) + wc) * 64; }
        else { dst = (bf16_t*)(ws + WS_GP); ld = 512; cb = (4 * (pn - 10) + wc) * 64; act = true; }
        const bool is_u = (pn == 8 || pn == 9);
#pragma unroll
        for (int ai = 0; ai < 2; ++ai)
#pragma unroll
            for (int m = 0; m < 4; ++m) { const int rowi = rowb + ai * 128 + m * 16; const size_t row = (size_t)rowi;
                f32x4 o00 = acc[ai][0][m][0], o01 = acc[ai][0][m][1], o10 = acc[ai][1][m][0], o11 = acc[ai][1][m][1];
                if (act) { o00 = silu4(o00); o01 = silu4(o01); o10 = silu4(o10); o11 = silu4(o11); }
                bf16_t* d = dst + row * ld + cb + dof; st_bf16x8(d, o00, o01); st_bf16x8(d + 32, o10, o11);
                if (fo) { float* f = fo + row * fld + dof; *(f32x4*)f = o00; *(f32x4*)(f + 4) = o01; *(f32x4*)(f + 32) = o10; *(f32x4*)(f + 36) = o11; }
                if (is_u) { const int t = rowi & (SEQ - 1);
                    if (t >= SEQ - 15) { float* f = out + O_PP + ((size_t)(rowi >> 11) * 15 + (t - (SEQ - 15))) * 512 + cb + dof;
                        *(f32x4*)f = o00; *(f32x4*)(f + 4) = o01; *(f32x4*)(f + 32) = o10; *(f32x4*)(f + 36) = o11; } } }
    }
};
struct EpiOut {
    static constexpr bool PERM = true, AFTER_DRAIN = false;
    const float* x; float* y; const float* ada;
    __device__ __forceinline__ void operator()(const f32x4 (&acc)[2][2][4][2], const Unit& u, int wr, int wc, int fr, int fq) const {
        const int col0 = u.pn * 256 + wc * 32 + 8 * fq; const float* gp = ada + (size_t)(u.pm >> 3) * 3072 + 2048 + col0;
        f32x4 g[2][2];
#pragma unroll
        for (int bj = 0; bj < 2; ++bj)
#pragma unroll
            for (int n = 0; n < 2; ++n) g[bj][n] = *(const f32x4*)(gp + 128 * bj + 4 * n);
#pragma unroll
        for (int ai = 0; ai < 2; ++ai)
#pragma unroll
            for (int m = 0; m < 4; ++m) { const size_t off = (size_t)(u.pm * 256 + ai * 128 + wr * 64 + m * 16 + fr) * 1024 + col0;
#pragma unroll
                for (int bj = 0; bj < 2; ++bj)
#pragma unroll
                    for (int n = 0; n < 2; ++n) { const f32x4 xv = *(const f32x4*)(x + off + 128 * bj + 4 * n); *(f32x4*)(y + off + 128 * bj + 4 * n) = xv + g[bj][n] * acc[ai][bj][m][n]; } }
    }
};
template <class Epi, class Sched, bool ALIGN_EPI = false, bool SP2 = false>
__device__ __forceinline__ void gemm_phase(PG8_LAS unsigned char* lds, const Gemm g, const Sched& S, const Epi& E) {
    const int tid = threadIdx.x, wid = __builtin_amdgcn_readfirstlane(tid >> 6), lane = tid & 63, wr = wid >> 2, wc = wid & 3, fr = lane & 15, fq = lane >> 4;
    const int K = g.K, nt = K / BK;
    unsigned voffA[2], voffB[2];
#pragma unroll
    for (int i = 0; i < 2; ++i) { int R, C; stage_rc(tid * 16 + i * 8192, R, C); const int Rb = Epi::PERM ? ((R & ~31) + perm32(R & 31)) : R;
        voffA[i] = (unsigned)(R * K + C) * 2u; voffB[i] = (unsigned)(Rb * K + C) * 2u; }
    const size_t kstep = (size_t)(BK * 2);
    const size_t hstep = (size_t)HALF * K * 2;
    const size_t tstep = 2 * hstep;
    const unsigned ldsw = (unsigned)wid * 1024u;
    const int aoff = lds_byte(wr * 64 + fr, fq * 8), boff = lds_byte(wc * 32 + fr, fq * 8);
#define PG8_SA(b, h) (((b) * 2 + (h)) * HTB)
#define PG8_SB(b, h) ((4 + (b) * 2 + (h)) * HTB)
#define PG8_STAGE(bufoff, gbase, voff) do { _Pragma("unroll") for (int _i = 0; _i < 2; ++_i) \
        __builtin_amdgcn_global_load_lds((const unsigned*)((const char*)(gbase) + (voff)[_i]), (PG8_LAS unsigned*)(lds + (bufoff) + ldsw + _i * 8192), 16, 0, 0); } while (0)
#define PG8_LDA(dst, b, h) do { _Pragma("unroll") for (int m = 0; m < 4; ++m) _Pragma("unroll") for (int k = 0; k < 2; ++k) dst[m][k] = *(const PG8_LAS bf16x8*)(lds + PG8_SA(b, h) + aoff + m * 2048 + k * 1024); } while (0)
#define PG8_LDB(dst, b, h) do { _Pragma("unroll") for (int n = 0; n < 2; ++n) _Pragma("unroll") for (int k = 0; k < 2; ++k) dst[n][k] = *(const PG8_LAS bf16x8*)(lds + PG8_SB(b, h) + boff + n * 2048 + k * 1024); } while (0)
#define PG8_MMA(ai, bj, At, Bt) do { __builtin_amdgcn_s_setprio(1); _Pragma("unroll") for (int m = 0; m < 4; ++m) _Pragma("unroll") for (int n = 0; n < 2; ++n) _Pragma("unroll") for (int k = 0; k < 2; ++k) \
        acc[ai][bj][m][n] = __builtin_amdgcn_mfma_f32_16x16x32_bf16(Bt[n][k], At[m][k], acc[ai][bj][m][n], 0, 0, 0); __builtin_amdgcn_s_setprio(0); } while (0)
#define PG8_WAIT_V(n) asm volatile("s_waitcnt vmcnt(" #n ")" ::: "memory")
#define PG8_WAIT_L(n) asm volatile("s_waitcnt lgkmcnt(" #n ")" ::: "memory")
#define PG8_BAR __builtin_amdgcn_s_barrier()
#define PG8_SCHED __builtin_amdgcn_sched_barrier(0)
    Unit cur, nxt; int ui = 0;
    if (!S.next(0, cur)) return;
    f32x4 acc[2][2][4][2];
#pragma unroll
    for (int a = 0; a < 2; ++a)
#pragma unroll
        for (int b = 0; b < 2; ++b)
#pragma unroll
            for (int m = 0; m < 4; ++m)
#pragma unroll
                for (int n = 0; n < 2; ++n) acc[a][b][m][n] = (f32x4){0.f, 0.f, 0.f, 0.f};
    bf16x8 At[4][2], B0[2][2], B1[2][2];
    const char* cA = (const char*)g.A + (size_t)cur.pm * tstep; const char* cB = (const char*)g.Bt + (size_t)cur.pn * tstep;
    S.a_ready(cur);
    if constexpr (SP2) {
        PG8_STAGE(PG8_SB(0, 0), cB, voffB); PG8_STAGE(PG8_SB(0, 1), cB + hstep, voffB); PG8_STAGE(PG8_SA(0, 0), cA, voffA); PG8_STAGE(PG8_SA(0, 1), cA + hstep, voffA);
        if (wr == 1) PG8_BAR;
        PG8_WAIT_V(2); PG8_BAR;
        PG8_STAGE(PG8_SB(1, 0), cB + kstep, voffB); PG8_STAGE(PG8_SA(1, 0), cA + kstep, voffA); PG8_STAGE(PG8_SB(1, 1), cB + hstep + kstep, voffB);
        PG8_WAIT_V(6); PG8_BAR;
    } else {
        PG8_STAGE(PG8_SB(0, 0), cB, voffB); PG8_STAGE(PG8_SA(0, 0), cA, voffA); PG8_STAGE(PG8_SB(0, 1), cB + hstep, voffB); PG8_STAGE(PG8_SA(0, 1), cA + hstep, voffA);
        if (wr == 1) PG8_BAR;
        PG8_WAIT_V(4); PG8_BAR;
        PG8_STAGE(PG8_SB(1, 0), cB + kstep, voffB); PG8_STAGE(PG8_SA(1, 0), cA + kstep, voffA); PG8_STAGE(PG8_SB(1, 1), cB + hstep + kstep, voffB);
        PG8_WAIT_V(6); PG8_BAR;
    }
    for (;;) {
        const bool has_next = S.next(ui + 1, nxt);
        const char* nA = has_next ? (const char*)g.A + (size_t)nxt.pm * tstep : cA; const char* nB = has_next ? (const char*)g.Bt + (size_t)nxt.pn * tstep : cB;
        for (int t = 0; t < nt; t += 2) {
            const bool last = (t == nt - 2);
            const char* a1 = cA + (size_t)(t + 1) * kstep;
            const char* a2 = last ? nA : cA + (size_t)(t + 2) * kstep; const char* b2 = last ? nB : cB + (size_t)(t + 2) * kstep;
            const char* a3 = a2 + kstep; const char* b3 = b2 + kstep;
            if (last && has_next) S.a_ready(nxt);
            if constexpr (SP2) {
            PG8_LDB(B0, 0, 0); PG8_LDB(B1, 0, 1); PG8_SCHED; PG8_LDA(At, 0, 0); PG8_STAGE(PG8_SA(1, 1), a1 + hstep, voffA);
            PG8_WAIT_V(8); PG8_WAIT_L(0); PG8_BAR; PG8_MMA(0, 0, At, B0); PG8_MMA(0, 1, At, B1); PG8_BAR; PG8_SCHED;
            PG8_LDA(At, 0, 1); PG8_STAGE(PG8_SB(0, 0), b2, voffB); PG8_STAGE(PG8_SB(0, 1), b2 + hstep, voffB); PG8_STAGE(PG8_SA(0, 0), a2, voffA);
            PG8_WAIT_V(8); PG8_WAIT_L(0); PG8_BAR; PG8_MMA(1, 0, At, B0); PG8_MMA(1, 1, At, B1); PG8_BAR; PG8_SCHED;
            PG8_LDB(B0, 1, 0); PG8_LDB(B1, 1, 1); PG8_SCHED; PG8_LDA(At, 1, 0); PG8_STAGE(PG8_SA(0, 1), a2 + hstep, voffA);
            PG8_WAIT_V(8); PG8_WAIT_L(0); PG8_BAR; PG8_MMA(0, 0, At, B0); PG8_MMA(0, 1, At, B1); PG8_BAR; PG8_SCHED;
            PG8_LDA(At, 1, 1); PG8_STAGE(PG8_SB(1, 0), b3, voffB); PG8_STAGE(PG8_SB(1, 1), b3 + hstep, voffB); PG8_STAGE(PG8_SA(1, 0), a3, voffA);
            PG8_WAIT_V(8); PG8_WAIT_L(0); PG8_BAR; PG8_MMA(1, 0, At, B0); PG8_MMA(1, 1, At, B1); PG8_BAR; PG8_SCHED;
            } else {
            PG8_LDB(B0, 0, 0); PG8_SCHED; PG8_LDA(At, 0, 0); PG8_STAGE(PG8_SA(1, 1), a1 + hstep, voffA);
            PG8_WAIT_L(8); PG8_BAR; PG8_WAIT_L(0); PG8_MMA(0, 0, At, B0); PG8_BAR; PG8_SCHED;
            PG8_LDB(B1, 0, 1); PG8_STAGE(PG8_SB(0, 0), b2, voffB);
            PG8_BAR; PG8_WAIT_L(0); PG8_MMA(0, 1, At, B1); PG8_BAR;
            PG8_LDA(At, 0, 1); PG8_STAGE(PG8_SA(0, 0), a2, voffA);
            PG8_BAR; PG8_WAIT_L(0); PG8_MMA(1, 0, At, B0); PG8_BAR; PG8_SCHED;
            PG8_STAGE(PG8_SB(0, 1), b2 + hstep, voffB);
            PG8_WAIT_V(6); PG8_BAR; PG8_MMA(1, 1, At, B1); PG8_BAR;
            PG8_LDB(B0, 1, 0); PG8_SCHED; PG8_LDA(At, 1, 0); PG8_STAGE(PG8_SA(0, 1), a2 + hstep, voffA);
            PG8_WAIT_L(8); PG8_BAR; PG8_WAIT_L(0); PG8_MMA(0, 0, At, B0); PG8_BAR; PG8_SCHED;
            PG8_LDB(B1, 1, 1); PG8_STAGE(PG8_SB(1, 0), b3, voffB);
            PG8_BAR; PG8_WAIT_L(0); PG8_MMA(0, 1, At, B1); PG8_BAR;
            PG8_LDA(At, 1, 1); PG8_STAGE(PG8_SA(1, 0), a3, voffA);
            PG8_BAR; PG8_WAIT_L(0); PG8_MMA(1, 0, At, B0); PG8_BAR; PG8_SCHED;
            PG8_STAGE(PG8_SB(1, 1), b3 + hstep, voffB);
            PG8_WAIT_V(6); PG8_BAR; PG8_MMA(1, 1, At, B1); PG8_BAR;
            }
        }
        if constexpr (ALIGN_EPI) { if (wr == 0) PG8_BAR; }
        if constexpr (!Epi::AFTER_DRAIN) { E(acc, cur, wr, wc, fr, fq); S.done(cur); }
        if (!has_next) break;
#pragma unroll
        for (int a = 0; a < 2; ++a)
#pragma unroll
            for (int b = 0; b < 2; ++b)
#pragma unroll
                for (int m = 0; m < 4; ++m)
#pragma unroll
                    for (int n = 0; n < 2; ++n) acc[a][b][m][n] = (f32x4){0.f, 0.f, 0.f, 0.f};
        cur = nxt; cA = nA; cB = nB; ++ui;
        if constexpr (ALIGN_EPI) { if (wr == 1) PG8_BAR; }
    }
    PG8_WAIT_V(0);
    if constexpr (!ALIGN_EPI) { if (wr == 0) PG8_BAR; }
    PG8_BAR;
    if constexpr (Epi::AFTER_DRAIN) { E.fused(acc, cur, wr, wc, fr, fq, lds, wid, lane); S.done(cur); }
#undef PG8_SA
#undef PG8_SB
#undef PG8_STAGE
#undef PG8_LDA
#undef PG8_LDB
#undef PG8_MMA
#undef PG8_WAIT_V
#undef PG8_WAIT_L
#undef PG8_BAR
#undef PG8_SCHED
}
}

constexpr int NWAVES = 8;
constexpr int RING_OFF = 0, RING_BYTES = 131072;
constexpr int LDSCTL_OFF = RING_BYTES, MISC_OFF = LDSCTL_OFF + 320;
constexpr int LDS_BYTES = 163840;
constexpr int CW_BAR = 4096;
#define GAS __attribute__((address_space(1)))
#define LAS __attribute__((address_space(3)))
typedef unsigned short bf16;
typedef unsigned v4u __attribute__((ext_vector_type(4)));
typedef unsigned v2u __attribute__((ext_vector_type(2)));
typedef float f32x4 __attribute__((ext_vector_type(4)));
typedef float f32x16 __attribute__((ext_vector_type(16)));
typedef short bf16x8 __attribute__((ext_vector_type(8)));
typedef GAS unsigned gu32;
#define LDS_WAIT() asm volatile("s_waitcnt lgkmcnt(0)" ::: "memory")
#define VM_WAIT() asm volatile("s_waitcnt vmcnt(0)" ::: "memory")
__device__ __forceinline__ unsigned f2bf(float f) { unsigned u = __builtin_bit_cast(unsigned, f); return (u + 0x7fffu + ((u >> 16) & 1u)) >> 16; }
__device__ __forceinline__ unsigned pk2(float lo, float hi) { return pg8::cvt_pk_bf16(lo, hi); }
__device__ __forceinline__ float bf2f(unsigned short b) { return __builtin_bit_cast(float, (unsigned)b << 16); }
__device__ __forceinline__ float wave_sum(float v) {
#pragma unroll
    for (int o = 1; o < 64; o <<= 1) v += __shfl_xor(v, o);
    return v;
}
__device__ __forceinline__ float wave_max(float v) {
#pragma unroll
    for (int o = 1; o < 64; o <<= 1) v = fmaxf(v, __shfl_xor(v, o));
    return v;
}
#define XB_TMO      128
#define XB_XCNT(j)  (256  + 64 * (j))
#define XB_XSUB(j)  (1280 + 64 * (j))
#define XB_XGEN(j)  (2304 + 64 * (j))
#define XB_TOP      3328
#define XB_TOPGEN   3392
#define XCD_BAR_WORDS 3456
#define XB_SPIN_CAP (1u << 18)

__device__ __forceinline__ unsigned xb_ld(unsigned* p)              { return __hip_atomic_load(p, __ATOMIC_RELAXED, __HIP_MEMORY_SCOPE_AGENT); }
__device__ __forceinline__ unsigned xb_add(unsigned* p, unsigned v) { return __hip_atomic_fetch_add(p, v, __ATOMIC_RELAXED, __HIP_MEMORY_SCOPE_AGENT); }
__device__ __forceinline__ unsigned xb_xcc_id() { return (unsigned)__builtin_amdgcn_s_getreg((3 << 11) | 20) & 0xFu; }
#define XB_SPIN(cond, bar) do { unsigned _sp = 0; while (cond) { __builtin_amdgcn_s_sleep(1); \
    if ((++_sp & 255u) == 0u) { if (xb_ld(&(bar)[XB_TMO])) break; if (_sp > XB_SPIN_CAP) { atomicAdd(&(bar)[XB_TMO], 1u); break; } } } } while (0)

struct XcdBarrier {
    unsigned* bar; unsigned x;
    volatile LAS unsigned* st;
};

__device__ __forceinline__ XcdBarrier xcd_barrier_post(unsigned* bar, volatile LAS unsigned* st) {
    XcdBarrier b; b.bar = bar; b.x = xb_xcc_id(); b.st = st;
    if (threadIdx.x == 0) (void)xb_add(&bar[XB_XCNT(b.x)], 1u);
    return b;
}
__device__ __forceinline__ void xcd_barrier_complete(unsigned* bar, unsigned x, unsigned& nloc, unsigned& nx) {
    const unsigned G = gridDim.x * gridDim.y * gridDim.z;
    unsigned sum, cnt, mine, sp = 0u;
    for (;;) {
        sum = 0u; cnt = 0u; mine = 0u;
#pragma unroll
        for (unsigned j = 0; j < 16; ++j) { const unsigned c = xb_ld(&bar[XB_XCNT(j)]); sum += c; cnt += (c > 0u) ? 1u : 0u; mine = (j == x) ? c : mine; }
        if (sum == G) break;
        __builtin_amdgcn_s_sleep(1);
        if ((++sp & 255u) == 0u) { if (xb_ld(&bar[XB_TMO])) break; if (sp > XB_SPIN_CAP) { atomicAdd(&bar[XB_TMO], 1u); break; } }
    }
    nloc = mine > 0u ? mine : 1u; nx = cnt > 0u ? cnt : 1u;
}

__device__ __forceinline__ void xcd_barrier(const XcdBarrier& b) {
    asm volatile("s_waitcnt vmcnt(0)" ::: "memory");
    __syncthreads();
    if (threadIdx.x == 0) {
        unsigned* bar = b.bar;
        __builtin_amdgcn_s_waitcnt(0);
        unsigned nloc = b.st[0], nx = b.st[1];
        if (nloc == 0u) { xcd_barrier_complete(bar, b.x, nloc, nx); b.st[0] = nloc; b.st[1] = nx; }
        const unsigned old = xb_add(&bar[XB_XSUB(b.x)], 1u);
        const unsigned gen = old / nloc;
        if (old + 1u == (gen + 1u) * nloc) {
            __builtin_amdgcn_fence(__ATOMIC_RELEASE, "agent");
            asm volatile("s_waitcnt vmcnt(0)" ::: "memory");
            const unsigned og = xb_add(&bar[XB_TOP], 1u);
            const unsigned tg = og / nx;
            if (og + 1u == (tg + 1u) * nx) xb_add(&bar[XB_TOPGEN], 1u);
            else XB_SPIN(xb_ld(&bar[XB_TOPGEN]) == tg, bar);
            __builtin_amdgcn_fence(__ATOMIC_ACQUIRE, "agent");
            xb_add(&bar[XB_XGEN(b.x)], 1u);
            asm volatile("s_waitcnt vmcnt(0)" ::: "memory");
        } else {
            XB_SPIN(xb_ld(&bar[XB_XGEN(b.x)]) == gen, bar);
            __builtin_amdgcn_fence(__ATOMIC_ACQUIRE, "agent");
            asm volatile("s_waitcnt vmcnt(0)" ::: "memory");
        }
    }
    __syncthreads();
}

struct Frame {
    LAS unsigned char* lds; volatile LAS unsigned* MISC; gu32* ctl;
    int tid, lane, wave, vcu, G, bid;
    const float *xp, *xs, *cache_k, *cache_v, *cache_kidx, *state_pool; const int* page_table;
    const float *cp, *cs, *norm_w, *w_ada, *b_ada, *w_in, *qnw, *knw, *w_pool, *pool_scale, *w_out;
    float* out; unsigned char* ws;
#if TEST_MODE == 4 && P3FINE
    unsigned long long* ts; int nst;
#endif
};
#if TEST_MODE == 4 && P3FINE
#define FSTAMP() do { if (blockIdx.x == STAMP_BLK && threadIdx.x == 0) F.ts[F.nst] = __builtin_amdgcn_s_memrealtime(); ++F.nst; } while (0)
#else
#define FSTAMP() do { } while (0)
#endif

__device__ __forceinline__ void p0_ada(Frame& F, int task) {
    const int lane = F.lane, w = F.wave, rl = lane & 15, kq = lane >> 4, n0 = task * 16;
    float bv[32];
    { const float* wp = F.w_ada + (size_t)(w * 128 + 4 * kq) * 3072 + n0 + rl;
#pragma unroll
      for (int i4 = 0; i4 < 8; ++i4)
#pragma unroll
          for (int u = 0; u < 4; ++u) bv[i4 * 4 + u] = wp[(size_t)(16 * i4 + u) * 3072]; }
    f32x4 acc[9];
#pragma unroll
    for (int i3 = 0; i3 < 3; ++i3) {
        f32x4 cv[3][8]; bool valid[3];
#pragma unroll
        for (int ii = 0; ii < 3; ++ii) { const int row = 16 * (3 * i3 + ii) + rl; valid[ii] = row < NR;
            const float* cptr = (row < NB ? F.cp + (size_t)row * DM : F.cs + (size_t)((valid[ii] ? row : NB) - NB) * DM) + w * 128 + 4 * kq;
#pragma unroll
            for (int i4 = 0; i4 < 8; ++i4) cv[ii][i4] = *(const f32x4*)(cptr + 16 * i4); }
#pragma unroll
        for (int ii = 0; ii < 3; ++ii) { const int i = 3 * i3 + ii;
            acc[i] = (f32x4){0.f, 0.f, 0.f, 0.f};
#pragma unroll
            for (int i4 = 0; i4 < 8; ++i4)
#pragma unroll
                for (int u = 0; u < 4; ++u) { const float a = valid[ii] ? pg8::silu1(cv[ii][i4][u]) : 0.f; acc[i] = __builtin_amdgcn_mfma_f32_16x16x4f32(a, bv[i4 * 4 + u], acc[i], 0, 0, 0); } } }
    LAS float* red = (LAS float*)(F.lds + RING_OFF);
#pragma unroll
    for (int i = 0; i < 9; ++i)
#pragma unroll
        for (int e = 0; e < 4; ++e) red[(w * 144 + 16 * i + 4 * kq + e) * 16 + rl] = acc[i][e];
    __syncthreads();
    float* ada = (float*)(F.ws + WS_ADA);
    for (int o = F.tid; o < NR * 16; o += NWAVES * 64) { const int row = o >> 4, col = o & 15; float s = F.b_ada[n0 + col];
#pragma unroll
        for (int ww = 0; ww < 8; ++ww) s += red[(ww * 144 + row) * 16 + col];
        ada[(size_t)row * 3072 + n0 + col] = s; }
    __syncthreads();
}
__device__ __forceinline__ void transpose_item(const float* W, int ldn, int srccol0, int nvalid, bf16* WT, int K, int dstrow0, int k0, LAS float* scr, int lane) {
    float tv[32];
#pragma unroll
    for (int i = 0; i < 32; ++i) { const int kk = 2 * i + (lane >> 5), c = lane & 31; tv[i] = c < nvalid ? W[(size_t)(k0 + kk) * ldn + srccol0 + c] : 0.f; }
#pragma unroll
    for (int i = 0; i < 32; ++i) { const int kk = 2 * i + (lane >> 5), c = lane & 31; scr[kk * 33 + c] = tv[i]; }
    LDS_WAIT(); asm volatile("" ::: "memory");
    const int c = lane & 7;
#pragma unroll
    for (int j = 0; j < 4; ++j) { const int n = (lane >> 3) + 8 * j; const LAS float* s = scr + (8 * c) * 33 + n;
        v4u o; o.x = pk2(s[0 * 33], s[1 * 33]); o.y = pk2(s[2 * 33], s[3 * 33]); o.z = pk2(s[4 * 33], s[5 * 33]); o.w = pk2(s[6 * 33], s[7 * 33]);
        *(GAS v4u*)(WT + (size_t)(dstrow0 + n) * K + k0 + 8 * c) = o; }
    LDS_WAIT(); asm volatile("" ::: "memory");
}
__device__ __forceinline__ int win_col(int pn, int hd, int d) {
    if (pn <= 1) return CQ + (4 * pn + hd) * 64 + d;
    if (pn == 2) return hd < 2 ? CK + hd * 64 + d : CV + (hd - 2) * 64 + d;
    if (pn <= 4) return CQI + (4 * (pn - 3) + hd) * 64 + d;
    if (pn == 5) return hd == 0 ? CKI + d : ((hd == 1 && d < 8) ? CWI + d : -1);
    if (pn <= 7) return CGA + (4 * (pn - 6) + hd) * 64 + d;
    if (pn <= 9) return CU + (4 * (pn - 8) + hd) * 64 + d;
    return CGP + (4 * (pn - 10) + hd) * 64 + d;
}
__device__ __forceinline__ void p0_prologue(Frame& F) {
    LAS float* scr = (LAS float*)(F.lds + RING_OFF + F.wave * 16384);
    const int gw = F.vcu * NWAVES + F.wave, NGW = F.G * NWAVES;
    bf16* WINT = (bf16*)(F.ws + WS_WINT); bf16* WOUTT = (bf16*)(F.ws + WS_WOUTT); bf16* WPOOLT = (bf16*)(F.ws + WS_WPOOLT);
    const bool split = F.G > 192 + 16;
    if (F.bid < 192) p0_ada(F, F.bid);
    if (!split || F.bid >= 192) {
        const int tw0 = split ? (F.bid - 192) * NWAVES + F.wave : gw, tws = split ? (F.G - 192) * NWAVES : NGW;
        for (int it = tw0; it < 2080; it += tws) {
            if (it < 1536) { const int G = it >> 4, kb = it & 15, pn = G >> 3, bj = (G >> 2) & 1, hd = G & 3; const int src = win_col(pn, hd, 32 * bj);
                const int nvalid = src < 0 ? 0 : ((pn == 5 && hd == 1) ? 8 : 32);
                transpose_item(F.w_in, NIN, src < 0 ? 0 : src, nvalid, WINT, 1024, 32 * G, 64 * kb, scr, F.lane); }
            else if (it < 2048) { const int r = it - 1536, G = r >> 4, kb = r & 15; transpose_item(F.w_out, 1024, 32 * G, 32, WOUTT, 1024, 32 * G, 64 * kb, scr, F.lane); }
            else { const int r = it - 2048, g = r >> 3, kb = (r >> 2) & 1, G = r & 3; transpose_item(F.w_pool + (size_t)g * 16384, 128, 32 * G, 32, WPOOLT + (size_t)g * 16384, 128, 32 * G, 64 * kb, scr, F.lane); }
        }
    }
    { const int nf4 = DECB * 1792; f32x4 t4[2]; int ix[2];
#pragma unroll
      for (int k = 0; k < 2; ++k) { ix[k] = gw * 64 + F.lane + k * NGW * 64; if (ix[k] < nf4) { const int s = ix[k] / 1792, i = ix[k] - s * 1792; t4[k] = *(const f32x4*)(F.state_pool + (size_t)s * 7680 + 512 + 4 * i); } }
#pragma unroll
      for (int k = 0; k < 2; ++k) { if (ix[k] < nf4) { const int s = ix[k] / 1792, i = ix[k] - s * 1792; *(f32x4*)(F.out + O_PS + (size_t)s * 7680 + 4 * i) = t4[k]; } }
      for (int ixx = gw * 64 + F.lane + 2 * NGW * 64; ixx < nf4; ixx += NGW * 64) { const int s = ixx / 1792, i = ixx - s * 1792; *(f32x4*)(F.out + O_PS + (size_t)s * 7680 + 4 * i) = *(const f32x4*)(F.state_pool + (size_t)s * 7680 + 512 + 4 * i); } }
}

template <int N, bool SAME_ADA> __device__ __forceinline__ void norm_rows(Frame& F, const float* x0, const float* adarow0, int adastride, bf16* o0) {
    f32x4 v[N][4]; float s2[N];
#pragma unroll
    for (int i = 0; i < N; ++i) { const GAS f32x4* xr = (const GAS f32x4*)(x0 + (size_t)i * DM) + F.lane;
#pragma unroll
        for (int j = 0; j < 4; ++j) v[i][j] = xr[64 * j]; }
#pragma unroll
    for (int i = 0; i < N; ++i) { s2[i] = 0.f;
#pragma unroll
        for (int j = 0; j < 4; ++j) s2[i] += (v[i][j].x * v[i][j].x + v[i][j].y * v[i][j].y) + (v[i][j].z * v[i][j].z + v[i][j].w * v[i][j].w); }
#pragma unroll
    for (int o = 1; o < 64; o <<= 1) {
#pragma unroll
        for (int i = 0; i < N; ++i) s2[i] += __shfl_xor(s2[i], o); }
#pragma unroll
    for (int j = 0; j < 4; ++j) { const int col = 4 * F.lane + 256 * j; const f32x4 nw = *(const f32x4*)(F.norm_w + col);
        f32x4 gq, sh;
        if (SAME_ADA) { sh = *(const f32x4*)(adarow0 + col); gq = nw * (*(const f32x4*)(adarow0 + 1024 + col) + 1.0f); }
#pragma unroll
        for (int i = 0; i < N; ++i) {
            if (!SAME_ADA) { const float* ar = adarow0 + (size_t)i * adastride; sh = *(const f32x4*)(ar + col); gq = nw * (*(const f32x4*)(ar + 1024 + col) + 1.0f); }
            const float rstd = 1.0f / sqrtf(s2[i] * (1.0f / DM) + EPS);
            const f32x4 o = v[i][j] * rstd * gq + sh;
            ((GAS unsigned long long*)(o0 + (size_t)i * DM))[F.lane + 64 * j] = (unsigned long long)pk2(o.x, o.y) | ((unsigned long long)pk2(o.z, o.w) << 32); } }
}
__device__ __forceinline__ void skinny_core(const bf16* arow, const bf16* b0, const bf16* b1, const bf16* b2, const bf16* b3, f32x4 (&acc)[4]) {
#pragma unroll
    for (int j = 0; j < 4; ++j) acc[j] = (f32x4){0.f, 0.f, 0.f, 0.f};
    bf16x8 fa[2][4], fb[2][4][4];
#define SK_LOAD(buf, kb) do { _Pragma("unroll") for (int q_ = 0; q_ < 4; ++q_) { const int ko_ = 32 * (4 * (kb) + q_); fa[buf][q_] = *(const bf16x8*)(arow + ko_); \
        fb[buf][q_][0] = *(const bf16x8*)(b0 + ko_); fb[buf][q_][1] = *(const bf16x8*)(b1 + ko_); fb[buf][q_][2] = *(const bf16x8*)(b2 + ko_); fb[buf][q_][3] = *(const bf16x8*)(b3 + ko_); } } while (0)
#define SK_MMA(buf) do { _Pragma("unroll") for (int q_ = 0; q_ < 4; ++q_) { _Pragma("unroll") for (int j_ = 0; j_ < 4; ++j_) acc[j_] = __builtin_amdgcn_mfma_f32_16x16x32_bf16(fa[buf][q_], fb[buf][q_][j_], acc[j_], 0, 0, 0); } } while (0)
    SK_LOAD(0, 0);
#pragma unroll
    for (int kb = 0; kb < 8; kb += 2) {
        SK_LOAD(1, kb + 1); SK_MMA(0);
        if (kb + 2 < 8) SK_LOAD(0, kb + 2);
        SK_MMA(1);
    }
#undef SK_LOAD
#undef SK_MMA
}
__device__ __forceinline__ void sample_inproj(Frame& F, int pn, int hd) {
    const int lane = F.lane, w = F.wave, rl = lane & 15, kq = lane >> 4;
    const bf16* HS = (const bf16*)(F.ws + WS_HS);
    const bf16* WINT = (const bf16*)(F.ws + WS_WINT);
    const bf16* bb = WINT + (size_t)(256 * pn + 32 * hd + rl) * 1024 + 8 * kq;
    f32x4 acc[4];
    skinny_core(HS + (size_t)(16 * w + rl) * 1024 + 8 * kq, bb, bb + 16 * 1024, bb + 128 * 1024, bb + 144 * 1024, acc);
    float* out = F.out;
    if (pn <= 1 || (pn == 2 && hd < 2)) {
        const float* nwp = pn <= 1 ? F.qnw : F.knw; const float sc = pn <= 1 ? C2 : 1.0f;
#pragma unroll
        for (int e = 0; e < 4; ++e) { float ss = 0.f;
#pragma unroll
            for (int j = 0; j < 4; ++j) ss += acc[j][e] * acc[j][e];
            ss += __shfl_xor(ss, 1); ss += __shfl_xor(ss, 2); ss += __shfl_xor(ss, 4); ss += __shfl_xor(ss, 8);
            const float rstd = 1.0f / sqrtf(ss * (1.0f / 64.0f) + EPS); const int s = 16 * w + 4 * kq + e; const size_t m = (size_t)(MP + s);
#pragma unroll
            for (int j = 0; j < 4; ++j) { const int d = 16 * j + rl; const float o = acc[j][e] * rstd * nwp[d] * sc;
                if (pn <= 1) ((bf16*)(F.ws + WS_Q))[m * 512 + (4 * pn + hd) * 64 + d] = (bf16)f2bf(o);
                else { out[O_KS + (size_t)s * 128 + hd * 64 + d] = o; ((bf16*)(F.ws + WS_KB))[m * 128 + hd * 64 + d] = (bf16)f2bf(o); } } }
        return;
    }
    if (pn == 5 && hd == 1) {
        if (rl < 8) {
#pragma unroll
            for (int e = 0; e < 4; ++e) { const int s = 16 * w + 4 * kq + e; ((float*)(F.ws + WS_WI))[(size_t)(MP + s) * 8 + rl] = acc[0][e] * WI_SCALE; } }
        return;
    }
    bf16* dst; int ld, cb; float* fo = nullptr; int fld = 0; bool act = false;
    if (pn == 2) { dst = (bf16*)(F.ws + WS_VB); ld = 128; cb = (hd - 2) * 64; fo = out + O_VS + cb; fld = 128; }
    else if (pn <= 4) { dst = (bf16*)(F.ws + WS_QI); ld = 512; cb = (4 * (pn - 3) + hd) * 64; }
    else if (pn == 5) { dst = (bf16*)(F.ws + WS_KI); ld = 64; cb = 0; fo = out + O_KIS; fld = 64; }
    else if (pn <= 7) { dst = (bf16*)(F.ws + WS_GA); ld = 512; cb = (4 * (pn - 6) + hd) * 64; act = true; }
    else if (pn <= 9) { dst = (bf16*)(F.ws + WS_U); ld = 512; cb = (4 * (pn - 8) + hd) * 64; fo = out + O_PS + 14 * 512 + cb; fld = 15 * 512; }
    else { dst = (bf16*)(F.ws + WS_GP); ld = 512; cb = (4 * (pn - 10) + hd) * 64; act = true; }
#pragma unroll
    for (int e = 0; e < 4; ++e) { const int s = 16 * w + 4 * kq + e; const size_t m = (size_t)(MP + s);
#pragma unroll
        for (int j = 0; j < 4; ++j) { const int d = 16 * j + rl; float o = acc[j][e]; if (act) o = pg8::silu1(o);
            dst[m * ld + cb + d] = (bf16)f2bf(o);
            if (fo) fo[(size_t)s * fld + d] = o; } }
}
__device__ __forceinline__ void p1_norm(Frame& F) {
    const float* ada = (const float*)(F.ws + WS_ADA); bf16* HB = (bf16*)(F.ws + WS_HB); bf16* HS = (bf16*)(F.ws + WS_HS);
    const int gw = F.vcu * NWAVES + F.wave, NGW = F.G * NWAVES;
    for (int ch = gw; ch < MP / 4 + DECB / 2; ch += NGW) {
        if (ch < MP / 4) { const int m = 4 * ch; norm_rows<4, true>(F, F.xp + (size_t)m * DM, ada + (size_t)(m >> 11) * 3072, 0, HB + (size_t)m * DM); }
        else { const int s = 2 * (ch - MP / 4); norm_rows<2, false>(F, F.xs + (size_t)s * DM, ada + (size_t)(NB + s) * 3072, 3072, HS + (size_t)s * DM); } }
}
__device__ __forceinline__ void p2_sample(Frame& F) {
    const int pn = F.bid >> 2, hd = F.bid & 3;
    if (F.bid < 48 && !(pn == 5 && hd >= 2)) sample_inproj(F, pn, hd);
}

constexpr int P3_KEYS = 0;
constexpr int P3_BM = 132096;
constexpr int P3_WQ = 136192;
constexpr int P3_QI = 136704;
constexpr int P3_AI_HS = 144, P3_AI_RS = 1152;
constexpr int P3_AQ_HS = 160, P3_AQ_RS = 1408;
constexpr int P3_QL = 159232;
constexpr int P3_XM = 159232;
constexpr int P3_VW = 0, P3_VWB = 4096;

__device__ __forceinline__ float relu_s(float x) { return __builtin_amdgcn_fmed3f(x, 0.0f, __builtin_inff()); }
__device__ __forceinline__ unsigned f2key(float f) { unsigned u = __float_as_uint(f); if (f == 0.0f) u = 0u; return (u & 0x80000000u) ? ~u : (u | 0x80000000u); }
__device__ __forceinline__ float key2f(unsigned k) { return __uint_as_float((k & 0x80000000u) ? (k ^ 0x80000000u) : ~k); }

__device__ __forceinline__ unsigned half_reduce_add(unsigned v) {
    v += (unsigned)__builtin_amdgcn_update_dpp(0, (int)v, 0xB1, 0xF, 0xF, true);
    v += (unsigned)__builtin_amdgcn_update_dpp(0, (int)v, 0x4E, 0xF, 0xF, true);
    v += (unsigned)__builtin_amdgcn_update_dpp(0, (int)v, 0x141, 0xF, 0xF, true);
    v += (unsigned)__builtin_amdgcn_update_dpp(0, (int)v, 0x140, 0xF, 0xF, true);
    v += (unsigned)__builtin_amdgcn_ds_swizzle((int)v, 0x401F);
    return v;
}
__device__ __forceinline__ float probit_f(float p) {
    const float pp = p < 0.5f ? p : 1.0f - p; const float t = sqrtf(-2.0f * __logf(pp));
    const float z = t - (2.515517f + t * (0.802853f + t * 0.010328f)) * __builtin_amdgcn_rcpf(1.0f + t * (1.432788f + t * (0.189269f + t * 0.001308f)));
    return p < 0.5f ? -z : z;
}
__device__ __forceinline__ unsigned half_reduce_min(unsigned v) {
    v = min(v, (unsigned)__builtin_amdgcn_update_dpp(0, (int)v, 0xB1, 0xF, 0xF, true)); v = min(v, (unsigned)__builtin_amdgcn_update_dpp(0, (int)v, 0x4E, 0xF, 0xF, true));
    v = min(v, (unsigned)__builtin_amdgcn_update_dpp(0, (int)v, 0x141, 0xF, 0xF, true)); v = min(v, (unsigned)__builtin_amdgcn_update_dpp(0, (int)v, 0x140, 0xF, 0xF, true));
    v = min(v, (unsigned)__builtin_amdgcn_ds_swizzle((int)v, 0x401F)); return v; }
__device__ __forceinline__ unsigned half_reduce_max(unsigned v) {
    v = max(v, (unsigned)__builtin_amdgcn_update_dpp(0, (int)v, 0xB1, 0xF, 0xF, true)); v = max(v, (unsigned)__builtin_amdgcn_update_dpp(0, (int)v, 0x4E, 0xF, 0xF, true));
    v = max(v, (unsigned)__builtin_amdgcn_update_dpp(0, (int)v, 0x141, 0xF, 0xF, true)); v = max(v, (unsigned)__builtin_amdgcn_update_dpp(0, (int)v, 0x140, 0xF, 0xF, true));
    v = max(v, (unsigned)__builtin_amdgcn_ds_swizzle((int)v, 0x401F)); return v; }
__device__ __forceinline__ unsigned wave_reduce_add_u(unsigned v) {
    v += (unsigned)__builtin_amdgcn_update_dpp(0, (int)v, 0xB1, 0xF, 0xF, true); v += (unsigned)__builtin_amdgcn_update_dpp(0, (int)v, 0x4E, 0xF, 0xF, true);
    v += (unsigned)__builtin_amdgcn_update_dpp(0, (int)v, 0x141, 0xF, 0xF, true); v += (unsigned)__builtin_amdgcn_update_dpp(0, (int)v, 0x140, 0xF, 0xF, true);
    return ((unsigned)__builtin_amdgcn_readlane((int)v, 0) + (unsigned)__builtin_amdgcn_readlane((int)v, 16)) + ((unsigned)__builtin_amdgcn_readlane((int)v, 32) + (unsigned)__builtin_amdgcn_readlane((int)v, 48)); }
__device__ __forceinline__ float kq_max(float v) {
    auto a = __builtin_amdgcn_permlane16_swap(__float_as_uint(v), __float_as_uint(v), false, false); v = fmaxf(__uint_as_float(a[0]), __uint_as_float(a[1]));
    auto b = __builtin_amdgcn_permlane32_swap(__float_as_uint(v), __float_as_uint(v), false, false); return fmaxf(__uint_as_float(b[0]), __uint_as_float(b[1])); }
__device__ __forceinline__ float kq_sum(float v) {
    auto a = __builtin_amdgcn_permlane16_swap(__float_as_uint(v), __float_as_uint(v), false, false); v = __uint_as_float(a[0]) + __uint_as_float(a[1]);
    auto b = __builtin_amdgcn_permlane32_swap(__float_as_uint(v), __float_as_uint(v), false, false); return __uint_as_float(b[0]) + __uint_as_float(b[1]); }
__device__ __forceinline__ unsigned wave_reduce_min_u(unsigned v) { v = half_reduce_min(v); return min((unsigned)__builtin_amdgcn_readlane((int)v, 0), (unsigned)__builtin_amdgcn_readlane((int)v, 32)); }
__device__ __forceinline__ unsigned wave_reduce_max_u(unsigned v) { v = half_reduce_max(v); return max((unsigned)__builtin_amdgcn_readlane((int)v, 0), (unsigned)__builtin_amdgcn_readlane((int)v, 32)); }

struct P3Pre { v4u qi[2]; v4u qq[2]; float wqv; };
__device__ __forceinline__ void p3_prefetch(Frame& F, int b, int qt, P3Pre& pre) {
    const int tid = F.tid; const size_t mb = (size_t)b * SEQ; const int t0 = 16 * qt;
    const bf16* QI = (const bf16*)(F.ws + WS_QI); const bf16* Qg = (const bf16*)(F.ws + WS_Q);
#pragma unroll
    for (int k = 0; k < 2; ++k) { const int i = tid + 512 * k, row = i >> 6, ch = i & 63;
        pre.qi[k] = *(const v4u*)(QI + (mb + t0 + row) * 512 + ch * 8); pre.qq[k] = *(const v4u*)(Qg + (mb + t0 + row) * 512 + ch * 8); }
    pre.wqv = ((const float*)(F.ws + WS_WI))[(mb + t0 + ((tid & 127) >> 3)) * 8 + (tid & 7)];
}
__device__ __forceinline__ void p3_prompt_item(Frame& F, int b, int qt, P3Pre& pre, bool has_next, int nb, int nqt) {
    int tid_o_ = F.tid; asm volatile("" : "+v"(tid_o_));
    const int tid = tid_o_, lane = tid & 63, w = F.wave, r = lane & 31, hh = lane >> 5;
    const int t0 = 16 * qt, L = t0 + 16, nkt32 = (L + 31) >> 5, nkt64 = (L + 63) >> 6;
    const size_t mb = (size_t)b * SEQ;
    LAS unsigned* bm = (LAS unsigned*)(F.lds + P3_BM);
    LAS float* wq = (LAS float*)(F.lds + P3_WQ);
    LAS unsigned* keys = (LAS unsigned*)(F.lds + P3_KEYS);
    v4u qreg[2] = {pre.qq[0], pre.qq[1]};
    if (tid < 128) wq[tid] = pre.wqv;
#pragma unroll
    for (int k = 0; k < 2; ++k) { const int i = tid + 512 * k, row = i >> 6, ch = i & 63; *(LAS v4u*)(F.lds + P3_QI + row * P3_AI_RS + (ch >> 3) * P3_AI_HS + (ch & 7) * 16) = pre.qi[k]; }
    bf16x8 bb[3][4];
    { const bf16* KI_ = (const bf16*)(F.ws + WS_KI); const int ns_ = (nkt32 - w + 7) >> 3;
      if (0 < ns_) { const bf16* kp_ = KI_ + (mb + 32 * w + r) * 64 + 8 * hh;
#pragma unroll
          for (int ks_ = 0; ks_ < 4; ++ks_) bb[0][ks_] = *(const bf16x8*)(kp_ + 16 * ks_); }
      if (1 < ns_) { const bf16* kp_ = KI_ + (mb + 32 * (w + 8) + r) * 64 + 8 * hh;
#pragma unroll
          for (int ks_ = 0; ks_ < 4; ++ks_) bb[1][ks_] = *(const bf16x8*)(kp_ + 16 * ks_); } }
    __syncthreads();
    { LAS unsigned short* ql = (LAS unsigned short*)(F.lds + P3_QL);
#pragma unroll
      for (int k = 0; k < 2; ++k) { const int i = tid + 512 * k, qq = i >> 6, d = i & 63; float s = 0.f;
#pragma unroll
          for (int h = 0; h < 8; ++h) s += wq[qq * 8 + h] * bf2f(*(const LAS unsigned short*)(F.lds + P3_QI + qq * P3_AI_RS + h * P3_AI_HS + d * 2));
          ql[qq * 64 + d] = (unsigned short)f2bf(s); } }
    __syncthreads();
    FSTAMP();
    for (int rep1_ = 0; rep1_ < REP_S1; ++rep1_) {
        const bf16* KI = (const bf16*)(F.ws + WS_KI);
        const int ns = (nkt32 - w + 7) >> 3;
#define P3_LDK(slot) do { const bf16* kp_ = KI + (mb + 32 * (w + 8 * (slot)) + r) * 64 + 8 * hh; \
        _Pragma("unroll") for (int ks_ = 0; ks_ < 4; ++ks_) bb[(slot) % 3][ks_] = *(const bf16x8*)(kp_ + 16 * ks_); } while (0)
        const int arow = (2 * ((r >> 2) & 1) + (r >> 4)) * P3_AI_RS + ((r & 3) + 4 * ((r >> 3) & 1)) * P3_AI_HS + 16 * hh;
        const LAS unsigned char* qib = F.lds + P3_QI;
        const int lq_ = 4 * ((((r & 3) + 4 * (r >> 3)) >> 1) & 3) + 2 * ((r >> 2) & 1) + (r & 1);
        const LAS unsigned char* qlb = F.lds + P3_QL + lq_ * 128 + 16 * hh;
#define P3_MM(ACC, a, s) do { _Pragma("unroll") for (int e_ = 0; e_ < 16; ++e_) ACC[e_] = 0.f; \
        _Pragma("unroll") for (int ks_ = 0; ks_ < 4; ++ks_) { const bf16x8 af_ = *(const LAS bf16x8*)(qs_ + 4 * (a) * P3_AI_RS + arow + 32 * ks_); \
            ACC = __builtin_amdgcn_mfma_f32_32x32x16_bf16(af_, bb[(s) % 3][ks_], ACC, 0, 0, 0); } } while (0)
#define P3_EPI(ACC, a, s, u_) do { _Pragma("unroll") for (int j2_ = 0; j2_ < 2; ++j2_) { const int qq_ = 4 * (a) + 2 * hh + j2_; \
        const LAS f32x4* wp_ = (const LAS f32x4*)(wq + qq_ * 8); const f32x4 w0_ = wp_[0], w1_ = wp_[1]; \
        float sc_ = accL[2 * (a) + j2_]; sc_ = fmaf(w0_[0], fabsf(ACC[8 * j2_ + 0]), sc_); sc_ = fmaf(w0_[1], fabsf(ACC[8 * j2_ + 1]), sc_); sc_ = fmaf(w0_[2], fabsf(ACC[8 * j2_ + 2]), sc_); sc_ = fmaf(w0_[3], fabsf(ACC[8 * j2_ + 3]), sc_); \
        sc_ = fmaf(w1_[0], fabsf(ACC[8 * j2_ + 4]), sc_); sc_ = fmaf(w1_[1], fabsf(ACC[8 * j2_ + 5]), sc_); sc_ = fmaf(w1_[2], fabsf(ACC[8 * j2_ + 6]), sc_); sc_ = fmaf(w1_[3], fabsf(ACC[8 * j2_ + 7]), sc_); \
        keys[qq_ * 2048 + 32 * (w + 8 * (s)) + r] = f2key(sc_); } } while (0)
#define P3_MML(ACC, s) do { _Pragma("unroll") for (int e_ = 0; e_ < 16; ++e_) ACC[e_] = 0.f; \
        _Pragma("unroll") for (int ks_ = 0; ks_ < 4; ++ks_) { bf16x8 af_ = (bf16x8){0, 0, 0, 0, 0, 0, 0, 0}; if (r < 16) af_ = *(const LAS bf16x8*)(qlb + zo_ + 32 * ks_); \
            ACC = __builtin_amdgcn_mfma_f32_32x32x16_bf16(af_, bb[(s) % 3][ks_], ACC, 0, 0, 0); } } while (0)
#pragma unroll 1
        for (int s0 = 0; s0 < ns; s0 += 3) {
#pragma unroll
            for (int u = 0; u < 3; ++u) { const int s = s0 + u;
                if (s < ns) {
                    if (s + 2 < ns) { const bf16* kp_ = KI + (mb + 32 * (w + 8 * (s + 2)) + r) * 64 + 8 * hh;
#pragma unroll
                        for (int ks_ = 0; ks_ < 4; ++ks_) bb[(u + 2) % 3][ks_] = *(const bf16x8*)(kp_ + 16 * ks_); }
                    int zo_ = 0; asm volatile("" : "+v"(zo_));
                    const LAS unsigned char* qs_ = qib + zo_;
                    f32x16 accA, accB, accL;
                    P3_MML(accL, u);
                    P3_MM(accA, 0, u); P3_MM(accB, 1, u);
                    P3_EPI(accA, 0, s, u); P3_MM(accA, 2, u);
                    P3_EPI(accB, 1, s, u); P3_MM(accB, 3, u);
                    P3_EPI(accA, 2, s, u); P3_EPI(accB, 3, s, u);
                }
            }
        }
#undef P3_MM
#undef P3_MML
#undef P3_EPI
#undef P3_LDK
    }
    __syncthreads();
    FSTAMP();
    {
#pragma unroll
      for (int k = 0; k < 2; ++k) { const int i = tid + 512 * k, row = i >> 6, ch = i & 63; *(LAS v4u*)(F.lds + P3_QI + row * P3_AQ_RS + (ch >> 3) * P3_AQ_HS + (ch & 7) * 16) = qreg[k]; } }
    bf16x8 kf0[2][2]; v4u vr0[4];
    { const int g_ = w & 1, kq4_ = w >> 1, j_ = lane & 15, kq_ = lane >> 4;
      if (kq4_ < nkt32) {
#pragma unroll
          for (int c = 0; c < 2; ++c)
#pragma unroll
              for (int ks = 0; ks < 2; ++ks) kf0[c][ks] = *(const bf16x8*)((const bf16*)(F.ws + WS_KB) + (mb + 32 * kq4_ + 16 * c + j_) * 128 + g_ * 64 + 32 * ks + 8 * kq_);
#pragma unroll
          for (int i = 0; i < 4; ++i) vr0[i] = *(const v4u*)((const bf16*)(F.ws + WS_VB) + (mb + 32 * kq4_ + 8 * i + (lane >> 3)) * 128 + g_ * 64 + (lane & 7) * 8); } }
    for (int rep2_ = 0; rep2_ < REP_S2; ++rep2_) {
        int lane_ = F.lane; asm volatile("" : "+v"(lane_));
#define lane lane_
        const int qx0 = 2 * w, tq0 = t0 + qx0;
        unsigned sel0, sel1;
        if (t0 + 16 <= 256) {
            sel0 = 0u; sel1 = 0u;
#pragma unroll
            for (int jj = 0; jj < 32; ++jj) { sel0 |= (64 * jj + lane <= tq0) ? (1u << jj) : 0u; sel1 |= (64 * jj + lane <= tq0 + 1) ? (1u << jj) : 0u; }
        } else {
            unsigned x[32], y[32];
#pragma unroll
            for (int jj = 0; jj < 32; ++jj) { const int l = 64 * jj + lane; x[jj] = (l <= tq0) ? keys[qx0 * 2048 + l] : 0u; y[jj] = (l <= tq0 + 1) ? keys[(qx0 + 1) * 2048 + l] : 0u; }
#pragma unroll
            for (int st = 0; st < 5; ++st) { const int j = 16 >> st; const unsigned m = st == 0 ? 0x0000ffffu : st == 1 ? 0x00ff00ffu : st == 2 ? 0x0f0f0f0fu : st == 3 ? 0x33333333u : 0x55555555u;
#pragma unroll
                for (int k = 0; k < 32; ++k) if (!(k & j)) { const unsigned t_ = ((x[k] >> j) ^ x[k + j]) & m; x[k] ^= t_ << j; x[k + j] ^= t_;
                    const unsigned u_ = ((y[k] >> j) ^ y[k + j]) & m; y[k] ^= u_ << j; y[k + j] ^= u_; } }
            unsigned cur0 = 0xffffffffu, gt0 = 0u, cur1 = 0xffffffffu, gt1 = 0u; int ab0 = 0, ab1 = 0;
#pragma unroll
            for (int b = 31; b >= 0; --b) { const unsigned c0 = cur0 & x[b], c1 = cur1 & y[b];
                const unsigned pk = wave_reduce_add_u((unsigned)__popc(c0) | ((unsigned)__popc(c1) << 16)); const int n0 = (int)(pk & 0xffffu), n1 = (int)(pk >> 16);
                if (ab0 + n0 >= 256) cur0 = c0; else { ab0 += n0; gt0 |= c0; cur0 &= ~x[b]; }
                if (ab1 + n1 >= 256) cur1 = c1; else { ab1 += n1; gt1 |= c1; cur1 &= ~y[b]; } }
            const unsigned pke = wave_reduce_add_u((unsigned)__popc(cur0) | ((unsigned)__popc(cur1) << 16));
            const unsigned long long lt = (1ull << lane) - 1ull;
            { int need = 256 - ab0; if ((int)(pke & 0xffffu) == need) sel0 = gt0 | cur0;
              else { sel0 = gt0;
                for (int jj = 0; jj < 32; ++jj) { const unsigned long long meq = __ballot((cur0 >> jj) & 1u);
                    if (((cur0 >> jj) & 1u) && __popcll(meq & lt) < need) sel0 |= 1u << jj;
                    const int pc_ = __popcll(meq); need = need > pc_ ? need - pc_ : 0; } } }
            { int need = 256 - ab1; if ((int)(pke >> 16) == need) sel1 = gt1 | cur1;
              else { sel1 = gt1;
                for (int jj = 0; jj < 32; ++jj) { const unsigned long long meq = __ballot((cur1 >> jj) & 1u);
                    if (((cur1 >> jj) & 1u) && __popcll(meq & lt) < need) sel1 |= 1u << jj;
                    const int pc_ = __popcll(meq); need = need > pc_ ? need - pc_ : 0; } } }
        }
#pragma unroll
        for (int jj = 0; jj < 32; ++jj) { const unsigned long long b0 = __ballot((sel0 >> jj) & 1u), b1 = __ballot((sel1 >> jj) & 1u);
            if (lane == 0) { bm[qx0 * 64 + 2 * jj] = (unsigned)b0; bm[qx0 * 64 + 2 * jj + 1] = (unsigned)(b0 >> 32); bm[(qx0 + 1) * 64 + 2 * jj] = (unsigned)b1; bm[(qx0 + 1) * 64 + 2 * jj + 1] = (unsigned)(b1 >> 32); } }
#undef lane
    }
    __syncthreads();
#if TEST_MODE
    { unsigned* dbg = (unsigned*)(F.ws + WS_DBG_BM) + (mb + t0) * 64; for (int i = tid; i < 1024; i += NWAVES * 64) dbg[i] = bm[i]; }
#endif
    FSTAMP();
    for (int rep4_ = 0; rep4_ < REP_S4; ++rep4_) {
        int l4_ = lane; asm volatile("" : "+v"(l4_));
        const int g = w & 1, kq4 = w >> 1, j = l4_ & 15, kq = l4_ >> 4;
        const bf16* Q = (const bf16*)(F.ws + WS_Q); const bf16* KB = (const bf16*)(F.ws + WS_KB); const bf16* VB = (const bf16*)(F.ws + WS_VB);
        const LAS unsigned char* qlb = F.lds + P3_QI + (j >> 2) * P3_AQ_RS + (4 * g + (j & 3)) * P3_AQ_HS + 16 * kq;
        f32x4 o[4][4];
#pragma unroll
        for (int dt = 0; dt < 4; ++dt)
#pragma unroll
            for (int rb = 0; rb < 4; ++rb) o[dt][rb] = (f32x4){0.f, 0.f, 0.f, 0.f};
        float mref[4], lsum[4]; f32x4 negm[4];
#pragma unroll
        for (int rb = 0; rb < 4; ++rb) { mref[rb] = 0.f; lsum[rb] = 0.f; negm[rb] = (f32x4){0.f, 0.f, 0.f, 0.f}; }
        const int ntw = (nkt32 - kq4 + 3) >> 2;
        LAS unsigned char* vst = F.lds + P3_VW + w * (3 * P3_VWB);
        bf16x8 kf[2][2], kfn[2][2];
        const bf16* kgp = KB + (mb + j) * 128 + g * 64 + 8 * kq;
        const bf16* vgp = VB + (mb + (l4_ >> 3)) * 128 + g * 64 + (l4_ & 7) * 8;
#define P4_LOADK(dst, kt_) do { _Pragma("unroll") for (int c_ = 0; c_ < 2; ++c_) _Pragma("unroll") for (int ks_ = 0; ks_ < 2; ++ks_) dst[c_][ks_] = *(const bf16x8*)(kgp + (size_t)(32 * (kt_) + 16 * c_) * 128 + 32 * ks_); } while (0)
        const unsigned vst_u = (unsigned)(size_t)vst;
#define P4_DMAV(kt_, buf_) do { _Pragma("unroll") for (int i_ = 0; i_ < 4; ++i_) { unsigned keep_; const void* gs_ = (const void*)(vgp + (size_t)(32 * (kt_) + 8 * i_) * 128); \
        const unsigned ld_ = (unsigned)__builtin_amdgcn_readfirstlane((int)(vst_u + (buf_) * P3_VWB + i_ * 1024)); \
        asm volatile("s_mov_b32 %0, m0\n\ts_mov_b32 m0, %2\n\ts_nop 0\n\tglobal_load_lds_dwordx4 %1, off\n\ts_mov_b32 m0, %0" : "=&s"(keep_) : "v"(gs_), "s"(ld_) : "memory"); } } while (0)
        if (ntw > 0) {
#pragma unroll
            for (int c = 0; c < 2; ++c) { kf[c][0] = kf0[c][0]; kf[c][1] = kf0[c][1]; }
#pragma unroll
            for (int i = 0; i < 4; ++i) *(LAS v4u*)(vst + i * 1024 + l4_ * 16) = vr0[i]; }
        if (ntw > 1) { P4_DMAV(kq4 + 4, 1); }
        int vb_cur = 0;
#if TEST_MODE == 5
        unsigned long long tacc_[5] = {0, 0, 0, 0, 0}; unsigned long long tprev_ = __builtin_amdgcn_s_memtime();
#define TSEC(i) do { __builtin_amdgcn_sched_barrier(0); const unsigned long long tn_ = __builtin_amdgcn_s_memtime(); tacc_[i] += tn_ - tprev_; tprev_ = tn_; __builtin_amdgcn_sched_barrier(0); } while (0)
#else
#define TSEC(i) do { } while (0)
#endif
        for (int ti = 0; ti < ntw; ++ti) {
            const int kt = kq4 + 4 * ti;
            TSEC(4);
            if (ti + 1 < ntw) asm volatile("s_waitcnt vmcnt(4)" ::: "memory"); else asm volatile("s_waitcnt vmcnt(0)" ::: "memory");
            const int vb_n2 = vb_cur == 0 ? 2 : vb_cur - 1;
            if (ti + 1 < ntw) { P4_LOADK(kfn, kt + 4); }
            if (ti + 2 < ntw) { P4_DMAV(kt + 8, vb_n2); }
            TSEC(0);
            int zq_ = 0; asm volatile("" : "+v"(zq_));
            f32x4 sa[2][4];
#pragma unroll
            for (int c = 0; c < 2; ++c)
#pragma unroll
                for (int ks = 0; ks < 2; ++ks)
#pragma unroll
                    for (int rb = 0; rb < 4; ++rb) { const bf16x8 qv = *(const LAS bf16x8*)(qlb + zq_ + 4 * rb * P3_AQ_RS + 64 * ks);
                        sa[c][rb] = __builtin_amdgcn_mfma_f32_16x16x32_bf16(kf[c][ks], qv, ks == 0 ? negm[rb] : sa[c][rb], 0, 0, 0); }
            TSEC(1);
            float tmax[4];
#pragma unroll
            for (int rb = 0; rb < 4; ++rb) { const int wd = (int)(bm[(4 * rb + (j >> 2)) * 64 + kt] >> (4 * kq)); float tm = -INFINITY;
#pragma unroll
                for (int c = 0; c < 2; ++c)
#pragma unroll
                    for (int e = 0; e < 4; ++e) { const unsigned keep = (unsigned)__builtin_amdgcn_sbfe(wd, 16 * c + e, 1);
                        const float v = __uint_as_float((__float_as_uint(sa[c][rb][e]) & keep) | (0xff800000u & ~keep)); sa[c][rb][e] = v; tm = fmaxf(tm, v); }
                tmax[rb] = tm; }
#pragma unroll
            for (int rb = 0; rb < 4; ++rb) tmax[rb] = kq_max(tmax[rb]);
            if (ti == 0 || __any(tmax[0] > 0.f || tmax[1] > 0.f || tmax[2] > 0.f || tmax[3] > 0.f)) {
#pragma unroll
                for (int rb = 0; rb < 4; ++rb) { const float dl = (ti == 0) ? ((tmax[rb] == -INFINITY) ? 0.f : tmax[rb]) : fmaxf(tmax[rb], 0.f); const float alpha = __builtin_amdgcn_exp2f(-dl); mref[rb] += dl; lsum[rb] *= alpha;
                    negm[rb] = (f32x4){-mref[rb], -mref[rb], -mref[rb], -mref[rb]};
#pragma unroll
                    for (int c = 0; c < 2; ++c) sa[c][rb] -= dl;
#pragma unroll
                    for (int dt = 0; dt < 4; ++dt) o[dt][rb] *= alpha; } }
            bf16x8 pf[4];
#pragma unroll
            for (int rb = 0; rb < 4; ++rb) { float ps = 0.f;
#pragma unroll
                for (int c = 0; c < 2; ++c)
#pragma unroll
                    for (int e = 0; e < 4; ++e) { const float p = __builtin_amdgcn_exp2f(sa[c][rb][e]); sa[c][rb][e] = p; ps += p; }
                lsum[rb] += ps;
                v4u pw; pw.x = pk2(sa[0][rb][0], sa[0][rb][1]); pw.y = pk2(sa[0][rb][2], sa[0][rb][3]); pw.z = pk2(sa[1][rb][0], sa[1][rb][1]); pw.w = pk2(sa[1][rb][2], sa[1][rb][3]);
                pf[rb] = __builtin_bit_cast(bf16x8, pw); }
            TSEC(2);
            { const LAS unsigned char* vb = vst + vb_cur * P3_VWB + (4 * kq + (j >> 2)) * 128 + (4 * (j & 3)) * 2;
              typedef short v4i16_t __attribute__((ext_vector_type(4)));
#pragma unroll
              for (int dt = 0; dt < 4; ++dt) {
                  const v4i16_t lo4 = __builtin_amdgcn_ds_read_tr16_b64_v4i16((LAS v4i16_t*)(vb + 32 * dt));
                  const v4i16_t hi4 = __builtin_amdgcn_ds_read_tr16_b64_v4i16((LAS v4i16_t*)(vb + 32 * dt + 16 * 128));
                  const bf16x8 vf = (bf16x8){lo4[0], lo4[1], lo4[2], lo4[3], hi4[0], hi4[1], hi4[2], hi4[3]};
#pragma unroll
                  for (int rb = 0; rb < 4; ++rb) o[dt][rb] = __builtin_amdgcn_mfma_f32_16x16x32_bf16(vf, pf[rb], o[dt][rb], 0, 0, 0); } }
            TSEC(3);
            vb_cur = vb_cur == 2 ? 0 : vb_cur + 1;
#pragma unroll
            for (int c = 0; c < 2; ++c) { kf[c][0] = kfn[c][0]; kf[c][1] = kfn[c][1]; }
        }
#undef P4_LOADK
#if TEST_MODE == 5
        if (blockIdx.x == STAMP_BLK && threadIdx.x == 0) { unsigned* st_ = (unsigned*)(F.ws + WS_CTL + 900 * 1024); for (int i_ = 0; i_ < 5; ++i_) atomicAdd(st_ + 8 + i_, (unsigned)(tacc_[i_] >> 4)); atomicAdd(st_ + 13, (unsigned)ntw); }
#endif
#undef TSEC
#undef P4_DMAV
#pragma unroll
        for (int rb = 0; rb < 4; ++rb) lsum[rb] = kq_sum(lsum[rb]);
        if (has_next && rep4_ == REP_S4 - 1) p3_prefetch(F, nb, nqt, pre);
        const size_t mrow_m = mb + t0 + 4 * kq4 + (j >> 2); const int hd_m = 4 * g + (j & 3);
        v2u gvm[4];
#pragma unroll
        for (int dt = 0; dt < 4; ++dt) gvm[dt] = *(const v2u*)((const bf16*)(F.ws + WS_GA) + mrow_m * 512 + hd_m * 64 + 16 * dt + 4 * kq);
        __syncthreads();
        {
            LAS unsigned char* xo = F.lds + ((g * 4 + kq4) * 4) * 4096; LAS float* xm = (LAS float*)(F.lds + P3_XM) + ((g * 4 + kq4) * 4) * 32;
#pragma unroll
            for (int rb = 0; rb < 4; ++rb) {
#pragma unroll
                for (int dt = 0; dt < 4; ++dt) *(LAS f32x4*)(xo + rb * 4096 + dt * 1024 + l4_ * 16) = o[dt][rb];
                if (kq == 0) { xm[rb * 32 + j] = (lsum[rb] > 0.f) ? mref[rb] : -INFINITY; xm[rb * 32 + 16 + j] = lsum[rb]; } }
        }
        __syncthreads();
        {
            const int rb = kq4; float ms[4], ls[4]; float M = -INFINITY;
#pragma unroll
            for (int s4 = 0; s4 < 4; ++s4) { const LAS float* xm = (const LAS float*)(F.lds + P3_XM) + ((g * 4 + s4) * 4 + rb) * 32; ms[s4] = xm[j]; ls[s4] = xm[16 + j]; M = fmaxf(M, ms[s4]); }
            float Lt = 0.f; f32x4 oo[4];
#pragma unroll
            for (int dt = 0; dt < 4; ++dt) oo[dt] = (f32x4){0.f, 0.f, 0.f, 0.f};
#pragma unroll
            for (int s4 = 0; s4 < 4; ++s4) { const float sc = __builtin_amdgcn_exp2f(ms[s4] - M); Lt += ls[s4] * sc;
                const LAS unsigned char* xo = F.lds + (((g * 4 + s4) * 4) + rb) * 4096;
#pragma unroll
                for (int dt = 0; dt < 4; ++dt) oo[dt] += *(const LAS f32x4*)(xo + dt * 1024 + l4_ * 16) * sc; }
            const float inv = 1.0f / Lt;
            const size_t mrow = mrow_m; const int hd = hd_m;
            bf16* MIX = (bf16*)(F.ws + WS_MIX);
#pragma unroll
            for (int dt = 0; dt < 4; ++dt) { const int d = 16 * dt + 4 * kq; const v2u gv = gvm[dt];
                const float g0 = bf2f((unsigned short)(gv.x & 0xffffu)), g1 = bf2f((unsigned short)(gv.x >> 16)), g2 = bf2f((unsigned short)(gv.y & 0xffffu)), g3 = bf2f((unsigned short)(gv.y >> 16));
                v2u ov; ov.x = pk2(oo[dt][0] * inv * g0, oo[dt][1] * inv * g1); ov.y = pk2(oo[dt][2] * inv * g2, oo[dt][3] * inv * g3);
                *(v2u*)(MIX + mrow * 1024 + hd * 64 + d) = ov; }
        }
        if (REP_S4 > 1) __syncthreads();
    }
}

constexpr int PL_U = 0, PL_W = 40960, PL_STRIDE = 272;
template <bool SAMPLE> __device__ __forceinline__ void p3_pool_item(Frame& F, int item) {
    const int tid = F.tid, lane = F.lane, w = F.wave, j = lane & 15, kq = lane >> 4;
    const bf16* U = (const bf16*)(F.ws + WS_U); const bf16* GP = (const bf16*)(F.ws + WS_GP); const bf16* WPT = (const bf16*)(F.ws + WS_WPOOLT); bf16* MIX = (bf16*)(F.ws + WS_MIX);
    const int tokb = SAMPLE ? 0 : (item & 15) * 128;
    const size_t m0 = SAMPLE ? (size_t)MP : (size_t)(item >> 4) * SEQ + tokb;
    const int tl = 16 * w + j;
    const size_t mrow = m0 + tl;
    v4u wr_[4], ur_[5];
#define PL_LOAD(gg) do { _Pragma("unroll") for (int k_ = 0; k_ < 4; ++k_) { const int i_ = tid + 512 * k_; wr_[k_] = *(const v4u*)(WPT + (size_t)(gg) * 16384 + (i_ >> 4) * 128 + (i_ & 15) * 8); } \
        if (!SAMPLE) { _Pragma("unroll") for (int k_ = 0; k_ < 5; ++k_) { const int i_ = tid + 512 * k_; const int row_ = i_ >> 4, ch_ = i_ & 15; ur_[k_] = (v4u){0u, 0u, 0u, 0u}; \
            if (i_ < 143 * 16 && tokb - 15 + row_ >= 0) ur_[k_] = *(const v4u*)(U + (m0 - 15 + row_) * 512 + (gg) * 128 + ch_ * 8); } } } while (0)
#define PL_STORE() do { _Pragma("unroll") for (int k_ = 0; k_ < 4; ++k_) { const int i_ = tid + 512 * k_; *(LAS v4u*)(F.lds + PL_W + (i_ >> 4) * PL_STRIDE + (i_ & 15) * 16) = wr_[k_]; } \
        if (!SAMPLE) { _Pragma("unroll") for (int k_ = 0; k_ < 5; ++k_) { const int i_ = tid + 512 * k_; if (i_ < 143 * 16) *(LAS v4u*)(F.lds + PL_U + (i_ >> 4) * PL_STRIDE + (i_ & 15) * 16) = ur_[k_]; } } } while (0)
    PL_LOAD(0);
#pragma unroll
    for (int g = 0; g < 4; ++g) {
        const int win = 2 << g;
        PL_STORE();
        __syncthreads();
        if (g + 1 < 4) PL_LOAD(g + 1);
        bf16x8 df[4];
#pragma unroll
        for (int ks = 0; ks < 4; ++ks) {
            float sum[8], cur[8];
            if (!SAMPLE) {
                const LAS unsigned char* up = F.lds + PL_U + (15 + tl) * PL_STRIDE + (4 * ks + kq) * 16;
                { const v4u c = *(const LAS v4u*)up;
#pragma unroll
                  for (int u = 0; u < 4; ++u) { const unsigned x = c[u]; cur[2 * u] = bf2f((unsigned short)(x & 0xffffu)); cur[2 * u + 1] = bf2f((unsigned short)(x >> 16)); sum[2 * u] = cur[2 * u]; sum[2 * u + 1] = cur[2 * u + 1]; } }
#pragma unroll
                for (int i = 1; i < win; ++i) { const v4u c = *(const LAS v4u*)(up - i * PL_STRIDE);
#pragma unroll
                    for (int u = 0; u < 4; ++u) { const unsigned x = c[u]; sum[2 * u] += bf2f((unsigned short)(x & 0xffffu)); sum[2 * u + 1] += bf2f((unsigned short)(x >> 16)); } }
            } else {
                const int c0 = g * 128 + 32 * ks + 8 * kq;
                { const v4u c = *(const v4u*)(U + mrow * 512 + c0);
#pragma unroll
                  for (int u = 0; u < 4; ++u) { const unsigned x = c[u]; cur[2 * u] = bf2f((unsigned short)(x & 0xffffu)); cur[2 * u + 1] = bf2f((unsigned short)(x >> 16)); sum[2 * u] = cur[2 * u]; sum[2 * u + 1] = cur[2 * u + 1]; } }
#pragma unroll
                for (int i = 1; i < win; ++i) { const float* sp = F.state_pool + ((size_t)tl * 15 + (15 - i)) * 512 + c0; const f32x4 a = *(const f32x4*)sp, bq = *(const f32x4*)(sp + 4);
                    sum[0] += a[0]; sum[1] += a[1]; sum[2] += a[2]; sum[3] += a[3]; sum[4] += bq[0]; sum[5] += bq[1]; sum[6] += bq[2]; sum[7] += bq[3]; }
            }
            const int tpos = tokb + tl; const float rc = 1.0f / (float)(SAMPLE ? win : ((tpos + 1 < win) ? tpos + 1 : win));
            v4u pw; pw.x = pk2(sum[0] * rc - cur[0], sum[1] * rc - cur[1]); pw.y = pk2(sum[2] * rc - cur[2], sum[3] * rc - cur[3]);
            pw.z = pk2(sum[4] * rc - cur[4], sum[5] * rc - cur[5]); pw.w = pk2(sum[6] * rc - cur[6], sum[7] * rc - cur[7]);
            df[ks] = __builtin_bit_cast(bf16x8, pw);
        }
#pragma unroll
        for (int jt = 0; jt < 8; ++jt) {
            f32x4 acc = (f32x4){0.f, 0.f, 0.f, 0.f};
#pragma unroll
            for (int ks = 0; ks < 4; ++ks) { const bf16x8 wf = *(const LAS bf16x8*)(F.lds + PL_W + (16 * jt + j) * PL_STRIDE + (4 * ks + kq) * 16);
                acc = __builtin_amdgcn_mfma_f32_16x16x32_bf16(wf, df[ks], acc, 0, 0, 0); }
            const int col = g * 128 + 16 * jt + 4 * kq;
            const f32x4 ps = *(const f32x4*)(F.pool_scale + col); const v2u gv = *(const v2u*)(GP + mrow * 512 + col);
            const float g0 = bf2f((unsigned short)(gv.x & 0xffffu)), g1 = bf2f((unsigned short)(gv.x >> 16)), g2 = bf2f((unsigned short)(gv.y & 0xffffu)), g3 = bf2f((unsigned short)(gv.y >> 16));
            v2u ov; ov.x = pk2(acc[0] * ps[0] * g0, acc[1] * ps[1] * g1); ov.y = pk2(acc[2] * ps[2] * g2, acc[3] * ps[3] * g3);
            *(v2u*)(MIX + mrow * 1024 + 512 + col) = ov;
        }
        __syncthreads();
    }
#undef PL_LOAD
#undef PL_STORE
}

constexpr int SM_SC = 0, SM_SEL = 8448, SM_Q = 9472, SM_P = 11520, SM_RED = 19712, SM_PT = 27904;
__device__ __forceinline__ void p3_sample_item(Frame& F, int s) {
    const int tid = F.tid, lane = F.lane, w = F.wave, r = lane & 31, hh = lane >> 5;
    const size_t m = (size_t)MP + s;
    LAS float* sc = (LAS float*)(F.lds + SM_SC); LAS int* sel = (LAS int*)(F.lds + SM_SEL); LAS float* ql = (LAS float*)(F.lds + SM_Q);
    LAS float* pl = (LAS float*)(F.lds + SM_P); LAS float* red = (LAS float*)(F.lds + SM_RED); LAS int* ptl = (LAS int*)(F.lds + SM_PT);
    const bf16* QI = (const bf16*)(F.ws + WS_QI) + m * 512; const float* WIp = (const float*)(F.ws + WS_WI) + m * 8;
    const int* pt = F.page_table + s * NPG;
    ql[tid] = bf2f(((const bf16*)(F.ws + WS_Q))[m * 512 + tid]);
    if (tid < NPG) ptl[tid] = pt[tid];
    {
        bf16x8 af[4];
#pragma unroll
        for (int ks = 0; ks < 4; ++ks) { af[ks] = (bf16x8){0, 0, 0, 0, 0, 0, 0, 0}; if (r < 8) af[ks] = *(const bf16x8*)(QI + r * 64 + 16 * ks + 8 * hh); }
        float wv[4];
#pragma unroll
        for (int e = 0; e < 4; ++e) wv[e] = WIp[4 * hh + e];
        int pg[8];
#pragma unroll
        for (int it = 0; it < 8; ++it) pg[it] = pt[(w + 8 * it) >> 2];
#pragma unroll
        for (int hf = 0; hf < 4; ++hf) {
            f32x4 x0[2][4], x1[2][4];
#pragma unroll
            for (int i4 = 0; i4 < 2; ++i4) { const int kt = w + 8 * (2 * hf + i4);
                const float* kp = F.cache_kidx + ((size_t)pg[2 * hf + i4] * PAGE + (kt & 3) * 32 + r) * 64 + 8 * hh;
#pragma unroll
                for (int ks = 0; ks < 4; ++ks) { x0[i4][ks] = *(const f32x4*)(kp + 16 * ks); x1[i4][ks] = *(const f32x4*)(kp + 16 * ks + 4); } }
#pragma unroll
            for (int i4 = 0; i4 < 2; ++i4) { const int kt = w + 8 * (2 * hf + i4);
                f32x16 acc;
#pragma unroll
                for (int e = 0; e < 16; ++e) acc[e] = 0.f;
#pragma unroll
                for (int ks = 0; ks < 4; ++ks) {
                    v4u pw; pw.x = pk2(x0[i4][ks][0], x0[i4][ks][1]); pw.y = pk2(x0[i4][ks][2], x0[i4][ks][3]); pw.z = pk2(x1[i4][ks][0], x1[i4][ks][1]); pw.w = pk2(x1[i4][ks][2], x1[i4][ks][3]);
                    acc = __builtin_amdgcn_mfma_f32_32x32x16_bf16(af[ks], __builtin_bit_cast(bf16x8, pw), acc, 0, 0, 0); }
                float part = wv[0] * fmaxf(acc[0], 0.f) + wv[1] * fmaxf(acc[1], 0.f) + wv[2] * fmaxf(acc[2], 0.f) + wv[3] * fmaxf(acc[3], 0.f);
                part += __shfl_xor(part, 32);
                if (hh == 0) sc[32 * kt + r] = part; }
        }
        if (w == 0) {
            const float kv = bf2f(((const bf16*)(F.ws + WS_KI))[m * 64 + lane]); float tot = 0.f;
#pragma unroll
            for (int h = 0; h < 8; ++h) { const float d = wave_sum(bf2f(QI[h * 64 + lane]) * kv); tot += WIp[h] * fmaxf(d, 0.f); }
            if (lane == 0) sc[PAST] = tot;
        }
    }
    __syncthreads();
    if (w == 0) {
        unsigned key[33];
#pragma unroll
        for (int jj = 0; jj < 33; ++jj) { const int l = jj * 64 + lane; key[jj] = l < PAST + 1 ? f2key(sc[l]) : 0u; }
        unsigned Tk = 0u;
        for (int bit = 31; bit >= 0; --bit) { const unsigned cand = Tk | (1u << bit); int cnt = 0;
#pragma unroll
            for (int jj = 0; jj < 33; ++jj) cnt += __popcll(__ballot(key[jj] >= cand));
            if (cnt >= 256) Tk = cand; }
        int cgt = 0;
#pragma unroll
        for (int jj = 0; jj < 33; ++jj) cgt += __popcll(__ballot(key[jj] > Tk));
        const int need = 256 - cgt; const unsigned long long lt = (1ull << lane) - 1ull; int pos = 0, eq_seen = 0;
#pragma unroll
        for (int jj = 0; jj < 33; ++jj) { const bool gt = key[jj] > Tk, eq = key[jj] == Tk;
            const unsigned long long meq = __ballot(eq); const int eqb = eq_seen + __popcll(meq & lt);
            const bool take = gt || (eq && eqb < need); const unsigned long long mt = __ballot(take);
            const int l = jj * 64 + lane;
            if (take) sel[pos + __popcll(mt & lt)] = l < PAST ? ptl[l >> 7] * PAGE + (l & 127) : -1;
            pos += __popcll(mt); eq_seen += __popcll(meq); }
    }
    __syncthreads();
    {
        const int jk = tid & 255, g = tid >> 8; const int pr = sel[jk];
        const float* krow = pr >= 0 ? F.cache_k + (size_t)pr * 128 + g * 64 : F.out + O_KS + (size_t)s * 128 + g * 64;
        f32x4 kv[16];
#pragma unroll
        for (int c = 0; c < 16; ++c) kv[c] = *(const f32x4*)(krow + 4 * c);
        float d4[4] = {0.f, 0.f, 0.f, 0.f};
#pragma unroll
        for (int c = 0; c < 16; ++c) {
#pragma unroll
            for (int rr = 0; rr < 4; ++rr) { const f32x4 qv = *(const LAS f32x4*)(ql + (4 * g + rr) * 64 + 4 * c); d4[rr] += (qv[0] * kv[c][0] + qv[1] * kv[c][1]) + (qv[2] * kv[c][2] + qv[3] * kv[c][3]); } }
#pragma unroll
        for (int rr = 0; rr < 4; ++rr) pl[(4 * g + rr) * 256 + jk] = d4[rr];
    }
    __syncthreads();
    {
        float v[4]; float mx = -INFINITY;
#pragma unroll
        for (int i = 0; i < 4; ++i) { v[i] = pl[w * 256 + lane + 64 * i]; mx = fmaxf(mx, v[i]); }
        mx = wave_max(mx); float sm = 0.f;
#pragma unroll
        for (int i = 0; i < 4; ++i) { v[i] = __builtin_amdgcn_exp2f(v[i] - mx); sm += v[i]; }
        sm = wave_sum(sm); const float inv = 1.0f / sm;
#pragma unroll
        for (int i = 0; i < 4; ++i) pl[w * 256 + lane + 64 * i] = v[i] * inv;
    }
    __syncthreads();
    {
        const int d = tid & 63, g = (tid >> 6) & 1, k4 = tid >> 7; float acc[4] = {0.f, 0.f, 0.f, 0.f};
#pragma unroll
        for (int hb = 0; hb < 2; ++hb) { float vv[32];
#pragma unroll
            for (int i = 0; i < 32; ++i) { const int pr = sel[64 * k4 + 32 * hb + i];
                const float* vrow = pr >= 0 ? F.cache_v + (size_t)pr * 128 + g * 64 : F.out + O_VS + (size_t)s * 128 + g * 64; vv[i] = vrow[d]; }
#pragma unroll
            for (int i = 0; i < 32; ++i) {
#pragma unroll
                for (int rr = 0; rr < 4; ++rr) acc[rr] += pl[(4 * g + rr) * 256 + 64 * k4 + 32 * hb + i] * vv[i]; } }
#pragma unroll
        for (int rr = 0; rr < 4; ++rr) red[((k4 * 2 + g) * 4 + rr) * 64 + d] = acc[rr];
    }
    __syncthreads();
    { const int h = tid >> 6, d = tid & 63; float a = 0.f;
#pragma unroll
        for (int k4 = 0; k4 < 4; ++k4) a += red[((k4 * 2 + (h >> 2)) * 4 + (h & 3)) * 64 + d];
        const float gate = bf2f(((const bf16*)(F.ws + WS_GA))[m * 512 + tid]);
        ((bf16*)(F.ws + WS_MIX))[m * 1024 + tid] = (bf16)f2bf(a * gate); }
    { const int c = tid, g = c >> 7, win = 2 << g; const float un = bf2f(((const bf16*)(F.ws + WS_U))[m * 512 + c]); float sum = un;
      const float* sp = F.state_pool + (size_t)s * 15 * 512 + c;
      float hv[15];
#pragma unroll
      for (int i = 1; i < 16; ++i) hv[i - 1] = sp[(size_t)(15 - i) * 512];
#pragma unroll
      for (int i = 1; i < 16; ++i) sum += (i < win) ? hv[i - 1] : 0.f;
      ql[c] = bf2f((unsigned short)f2bf(sum / (float)win - un)); }
    __syncthreads();
    { const int col = tid, g = col >> 7, j = col & 127; const bf16* wr = (const bf16*)(F.ws + WS_WPOOLT) + (size_t)g * 16384 + j * 128;
      v4u wv4[16];
#pragma unroll
      for (int i = 0; i < 16; ++i) wv4[i] = *(const v4u*)(wr + 8 * i);
      float acc = 0.f;
#pragma unroll
      for (int i = 0; i < 16; ++i) { const LAS f32x4* dp = (const LAS f32x4*)(ql + g * 128 + 8 * i); const f32x4 d0 = dp[0], d1 = dp[1];
          acc += d0[0] * bf2f((unsigned short)(wv4[i].x & 0xffffu)) + d0[1] * bf2f((unsigned short)(wv4[i].x >> 16)) + d0[2] * bf2f((unsigned short)(wv4[i].y & 0xffffu)) + d0[3] * bf2f((unsigned short)(wv4[i].y >> 16));
          acc += d1[0] * bf2f((unsigned short)(wv4[i].z & 0xffffu)) + d1[1] * bf2f((unsigned short)(wv4[i].z >> 16)) + d1[2] * bf2f((unsigned short)(wv4[i].w & 0xffffu)) + d1[3] * bf2f((unsigned short)(wv4[i].w >> 16)); }
      const float gp = bf2f(((const bf16*)(F.ws + WS_GP))[m * 512 + col]);
      ((bf16*)(F.ws + WS_MIX))[m * 1024 + 512 + col] = (bf16)f2bf(acc * F.pool_scale[col] * gp); }
    __syncthreads();
}

__device__ __forceinline__ void p3_mixer(Frame& F) {
    P3Pre pre; int cb, cqt; bool cv;
#define P3_ITEM(i_, ok_, b_, qt_) do { if (F.G == 256) { ok_ = (i_) < 4; \
            const int idx_ = F.bid >> 3, i2_ = idx_ & 15, pi_ = i2_ + 16 * (((i_) >> 1) & 1), grp_ = pi_ >> 3, k_ = pi_ & 7; const bool light_ = idx_ < 16; \
            b_ = F.bid & 7; qt_ = ((i_) & 1) ? (light_ ? 16 * grp_ + k_ : 8 + 16 * grp_ + k_) : (light_ ? 119 - 16 * grp_ - k_ : 127 - 16 * grp_ - k_); } \
        else { const int p_ = F.bid + ((i_) >> 1) * F.G; ok_ = p_ < 512; b_ = (p_ >> 6) & 7; qt_ = ((i_) & 1) ? (p_ & 63) : 127 - (p_ & 63); } } while (0)
    P3_ITEM(0, cv, cb, cqt);
    if (cv) p3_prefetch(F, cb, cqt, pre);
#pragma unroll 1
    for (int i = 0; cv; ++i) {
        int nb, nqt; bool nv;
        P3_ITEM(i + 1, nv, nb, nqt);
        p3_prompt_item(F, cb, cqt, pre, nv, nb, nqt); __syncthreads(); FSTAMP();
        cv = nv; cb = nb; cqt = nqt;
    }
#undef P3_ITEM
    for (int x = F.bid; x < 128; x += F.G) { for (int rp_ = 0; rp_ < REP_SMP; ++rp_) { p3_sample_item(F, x); __syncthreads(); } FSTAMP(); }
    for (int x = F.bid + ((F.bid < 128) ? ((128 - F.bid + F.G - 1) / F.G) * F.G : 0); x < 256; x += F.G) { for (int rp_ = 0; rp_ < REP_POOL; ++rp_) { p3_pool_item<false>(F, x - 128); __syncthreads(); } FSTAMP(); }
}
__device__ __forceinline__ void p4_sample_out(Frame& F) {
    if (F.bid >= 64) return;
    const int lane = F.lane, w = F.wave, rl = lane & 15, kq = lane >> 4, n0 = F.bid * 16;
    const bf16* ap = (const bf16*)(F.ws + WS_MIX) + (size_t)(MP + 16 * w + rl) * 1024 + 8 * kq;
    const bf16* bp = (const bf16*)(F.ws + WS_WOUTT) + (size_t)(n0 + rl) * 1024 + 8 * kq;
    f32x4 acc = (f32x4){0.f, 0.f, 0.f, 0.f};
#pragma unroll
    for (int hb = 0; hb < 2; ++hb) { bf16x8 fa[16], fb[16];
#pragma unroll
        for (int i = 0; i < 16; ++i) { fa[i] = *(const bf16x8*)(ap + 32 * (16 * hb + i)); fb[i] = *(const bf16x8*)(bp + 32 * (16 * hb + i)); }
#pragma unroll
        for (int i = 0; i < 16; ++i) acc = __builtin_amdgcn_mfma_f32_16x16x32_bf16(fa[i], fb[i], acc, 0, 0, 0); }
    const float* ada = (const float*)(F.ws + WS_ADA);
#pragma unroll
    for (int e = 0; e < 4; ++e) { const int s = 16 * w + 4 * kq + e, n = n0 + rl;
        F.out[O_YS + (size_t)s * 1024 + n] = F.xs[(size_t)s * 1024 + n] + ada[(size_t)(NB + s) * 3072 + 2048 + n] * acc[e]; }
}

struct Args { const float* in[18]; float* out; unsigned char* ws; int ph_lo, ph_hi, li, pad; };
__global__ void __launch_bounds__(NWAVES * 64, 2) mk_fwd(Args args) {
    extern __shared__ __attribute__((aligned(16))) unsigned char lds[];
    Frame F;
    F.lds = (LAS unsigned char*)lds;
    F.MISC = (volatile LAS unsigned*)(F.lds + MISC_OFF);
    F.tid = threadIdx.x; F.lane = F.tid & 63; F.wave = __builtin_amdgcn_readfirstlane(F.tid >> 6);
    F.G = gridDim.x; F.bid = blockIdx.x; { const int bx = blockIdx.x; F.vcu = (F.G % 8 == 0) ? (bx % 8) * (F.G / 8) + bx / 8 : bx; }
    F.ws = args.ws; F.out = args.out; F.ctl = (gu32*)(args.ws + WS_CTL);
    F.xp = args.in[0]; F.xs = args.in[1]; F.cache_k = args.in[2]; F.cache_v = args.in[3]; F.cache_kidx = args.in[4]; F.state_pool = args.in[5];
    F.page_table = (const int*)args.in[6]; F.cp = args.in[7]; F.cs = args.in[8]; F.norm_w = args.in[9]; F.w_ada = args.in[10]; F.b_ada = args.in[11];
    F.w_in = args.in[12]; F.qnw = args.in[13]; F.knw = args.in[14]; F.w_pool = args.in[15]; F.pool_scale = args.in[16]; F.w_out = args.in[17];
    for (int u = F.tid; u < (LDS_BYTES - LDSCTL_OFF) / 4; u += NWAVES * 64) ((LAS unsigned*)(F.lds + LDSCTL_OFF))[u] = 0u;
    __syncthreads();
    XcdBarrier bar = xcd_barrier_post((unsigned*)(F.ctl + CW_BAR) + args.li * XCD_BAR_WORDS, F.MISC + 8);
    const int lo = args.ph_lo, hi = args.ph_hi;
#if TEST_MODE == 4
    unsigned long long* ts = (unsigned long long*)(args.ws + WS_CTL + 768 * 1024); int nst = 0;
#define STAMP() do { if (blockIdx.x == STAMP_BLK && threadIdx.x == 0) ts[nst] = __builtin_amdgcn_s_memrealtime(); ++nst; } while (0)
#if P3FINE
    F.ts = ts + 16; F.nst = 0;
#endif
#else
#define STAMP() do { } while (0)
#endif
    STAMP();
#define IN(k) (lo <= (k) && (k) < hi)
#define BOTH(k) (IN(k) && IN((k) + 1))
    if (IN(0)) { for (int rp_ = 0; rp_ < REP_P0; ++rp_) { p0_prologue(F); if (rp_ + 1 < REP_P0) __syncthreads(); } STAMP(); if (BOTH(0)) xcd_barrier(bar); STAMP(); }
    if (IN(1)) { for (int rp_ = 0; rp_ < REP_P1; ++rp_) p1_norm(F); STAMP(); if (BOTH(1)) xcd_barrier(bar); STAMP(); }
    if (IN(2)) {
        for (int rp_ = 0; rp_ < REP_P2S; ++rp_) p2_sample(F);
        pg8::Gemm g{(const pg8::bf16_t*)(F.ws + WS_HB), (const pg8::bf16_t*)(F.ws + WS_WINT), MP, 3072, DM};
        pg8::StaticOrder S; S.init(MP, 3072, F.G, (int)blockIdx.x);
        pg8::EpiIn E{F.ws, F.out, F.qnw, F.knw};
        for (int rp_ = 0; rp_ < REP_P2G; ++rp_) pg8::gemm_phase<pg8::EpiIn, pg8::StaticOrder, true, true>(F.lds + RING_OFF, g, S, E);
        STAMP(); if (BOTH(2)) xcd_barrier(bar); STAMP();
    }
#if HAVE_P3
    if (IN(3)) { p3_mixer(F); STAMP(); if (BOTH(3)) xcd_barrier(bar); STAMP(); }
#endif
    if (IN(4)) {
        pg8::Gemm g{(const pg8::bf16_t*)(F.ws + WS_MIX), (const pg8::bf16_t*)(F.ws + WS_WOUTT), MP, DM, DM};
        pg8::StaticOrder S; S.init(MP, DM, F.G, (int)blockIdx.x);
        pg8::EpiOut E{F.xp, F.out + O_YP, (const float*)(F.ws + WS_ADA)};
        for (int rp_ = 0; rp_ < REP_P4G; ++rp_) pg8::gemm_phase<pg8::EpiOut, pg8::StaticOrder, true, true>(F.lds + RING_OFF, g, S, E);
        STAMP(); for (int rp_ = 0; rp_ < REP_P4S; ++rp_) p4_sample_out(F); STAMP();
    }
#undef IN
#undef BOTH
}

#if TEST_MODE && TEST_MODE < 4
namespace gold {
constexpr size_t W_ADA = 0, W_H = W_ADA + (size_t)NR * 3072, W_PROJ = W_H + (size_t)MT * 1024, W_SC = W_PROJ + (size_t)MT * NIN,
                 W_SCS = W_SC + (size_t)MP * 2048, W_SEL = W_SCS + (size_t)DECB * 2112, W_NSEL = W_SEL + (size_t)MT * 256, W_END = W_NSEL + MT;
constexpr size_t W_YT = W_H, W_MIX = W_SC, W_DB = W_SC + (size_t)MT * 1024;

__device__ __forceinline__ float wave_sum(float v) {
#pragma unroll
    for (int o = 1; o < 64; o <<= 1) v += __shfl_xor(v, o);
    return v;
}
__device__ __forceinline__ float wave_max(float v) {
#pragma unroll
    for (int o = 1; o < 64; o <<= 1) v = fmaxf(v, __shfl_xor(v, o));
    return v;
}
__device__ __forceinline__ float silu_f(float x) { return x / (1.f + expf(-x)); }

__global__ void __launch_bounds__(256) k_ada(const float* __restrict__ cp, const float* __restrict__ cs, const float* __restrict__ w_ada,
                                              const float* __restrict__ b_ada, float* __restrict__ ada) {
    const int j = blockIdx.x * 256 + threadIdx.x, r = blockIdx.y;
    const float* c = r < NB ? cp + (size_t)r * DM : cs + (size_t)(r - NB) * DM;
    float acc = 0.f;
    for (int k = 0; k < DM; ++k) { const float cv = c[k]; acc += silu_f(cv) * w_ada[(size_t)k * 3072 + j]; }
    ada[(size_t)r * 3072 + j] = acc + b_ada[j];
}

__global__ void __launch_bounds__(256) k_h(const float* __restrict__ xp, const float* __restrict__ xs, const float* __restrict__ norm_w,
                                            const float* __restrict__ ada, float* __restrict__ H) {
    const int m = blockIdx.x * 4 + (threadIdx.x >> 6), lane = threadIdx.x & 63;
    const float* x = m < MP ? xp + (size_t)m * DM : xs + (size_t)(m - MP) * DM;
    const int r = m < MP ? m / SEQ : NB + (m - MP);
    float v[16]; float ss = 0.f;
#pragma unroll
    for (int i = 0; i < 16; ++i) { v[i] = x[lane + 64 * i]; ss += v[i] * v[i]; }
    ss = wave_sum(ss);
    const float rstd = 1.0f / sqrtf(ss * (1.0f / DM) + 1e-6f);
#pragma unroll
    for (int i = 0; i < 16; ++i) { const int c = lane + 64 * i;
        H[(size_t)m * DM + c] = v[i] * rstd * norm_w[c] * (1.f + ada[(size_t)r * 3072 + 1024 + c]) + ada[(size_t)r * 3072 + c]; }
}

__global__ void __launch_bounds__(256) k_gemm(const float* __restrict__ A, const float* __restrict__ B, float* __restrict__ C,
                                               int M, int N, int K, int lda, int ldb, int ldc) {
    const int wave = threadIdx.x >> 6, lane = threadIdx.x & 63, r = lane & 31, h = lane >> 5;
    const int m0 = blockIdx.y * 128 + (wave >> 1) * 64, n0 = blockIdx.x * 128 + (wave & 1) * 64;
    f32x16 acc[2][2];
#pragma unroll
    for (int i = 0; i < 2; ++i)
#pragma unroll
        for (int j = 0; j < 2; ++j)
#pragma unroll
            for (int e = 0; e < 16; ++e) acc[i][j][e] = 0.f;
    const float* a0 = A + (size_t)(m0 + r) * lda + h;
    const float* a1 = a0 + (size_t)32 * lda;
    const int c0 = n0 + r, c1 = n0 + 32 + r; const bool v0 = c0 < N, v1 = c1 < N;
    const float* b0 = B + (size_t)h * ldb + (v0 ? c0 : 0);
    const float* b1 = B + (size_t)h * ldb + (v1 ? c1 : 0);
#pragma unroll 4
    for (int k = 0; k < K; k += 2) {
        const float x0 = a0[k], x1 = a1[k];
        float y0 = b0[(size_t)k * ldb], y1 = b1[(size_t)k * ldb];
        y0 = v0 ? y0 : 0.f; y1 = v1 ? y1 : 0.f;
        acc[0][0] = __builtin_amdgcn_mfma_f32_32x32x2f32(x0, y0, acc[0][0], 0, 0, 0);
        acc[0][1] = __builtin_amdgcn_mfma_f32_32x32x2f32(x0, y1, acc[0][1], 0, 0, 0);
        acc[1][0] = __builtin_amdgcn_mfma_f32_32x32x2f32(x1, y0, acc[1][0], 0, 0, 0);
        acc[1][1] = __builtin_amdgcn_mfma_f32_32x32x2f32(x1, y1, acc[1][1], 0, 0, 0);
    }
#pragma unroll
    for (int i = 0; i < 2; ++i)
#pragma unroll
        for (int j = 0; j < 2; ++j) { const int col = n0 + 32 * j + r;
            if (col < N) {
#pragma unroll
                for (int e = 0; e < 16; ++e) { const int row = m0 + 32 * i + (e & 3) + 8 * (e >> 2) + 4 * h; C[(size_t)row * ldc + col] = acc[i][j][e]; } } }
}

__global__ void __launch_bounds__(256) k_post(float* __restrict__ proj, const float* __restrict__ qnw, const float* __restrict__ knw,
                                               const float* __restrict__ state_pool, float* __restrict__ out) {
    const int m = blockIdx.x * 4 + (threadIdx.x >> 6), lane = threadIdx.x & 63;
    float* p = proj + (size_t)m * NIN;
    for (int hh = 0; hh < 8; ++hh) { const float v = p[CQ + hh * 64 + lane]; const float ss = wave_sum(v * v);
        p[CQ + hh * 64 + lane] = v * (1.0f / sqrtf(ss * (1.f / 64.f) + 1e-6f)) * qnw[lane]; }
    float* ko = m < MP ? out + O_KP + (size_t)m * 128 : out + O_KS + (size_t)(m - MP) * 128;
    float* vo = m < MP ? out + O_VP + (size_t)m * 128 : out + O_VS + (size_t)(m - MP) * 128;
    float* kio = m < MP ? out + O_KIP + (size_t)m * 64 : out + O_KIS + (size_t)(m - MP) * 64;
    for (int g = 0; g < 2; ++g) { const float v = p[CK + g * 64 + lane]; const float ss = wave_sum(v * v);
        const float kn = v * (1.0f / sqrtf(ss * (1.f / 64.f) + 1e-6f)) * knw[lane];
        p[CK + g * 64 + lane] = kn; ko[g * 64 + lane] = kn; vo[g * 64 + lane] = p[CV + g * 64 + lane]; }
    kio[lane] = p[CKI + lane];
    if (lane < 8) p[CWI + lane] *= 0.04419417382415922f;
    if (m < MP) { const int b = m / SEQ, t = m % SEQ;
        if (t >= SEQ - 15) { float* po = out + O_PP + ((size_t)b * 15 + (t - (SEQ - 15))) * 512;
            for (int c = lane; c < 512; c += 64) po[c] = p[CU + c]; }
    } else { const int s = m - MP; float* po = out + O_PS + (size_t)s * 15 * 512;
        for (int i = lane; i < 14 * 512; i += 64) po[i] = state_pool[(size_t)s * 15 * 512 + 512 + i];
        for (int c = lane; c < 512; c += 64) po[14 * 512 + c] = p[CU + c]; }
}

__global__ void __launch_bounds__(256) k_scores_p(const float* __restrict__ proj, float* __restrict__ SC) {
    __shared__ float qs[8][512]; __shared__ float wsm[8][8];
    const int b = blockIdx.y, t0 = blockIdx.x * 8, tid = threadIdx.x;
    for (int i = tid; i < 8 * 512; i += 256) qs[i >> 9][i & 511] = proj[(size_t)(b * SEQ + t0 + (i >> 9)) * NIN + CQI + (i & 511)];
    if (tid < 64) wsm[tid >> 3][tid & 7] = proj[(size_t)(b * SEQ + t0 + (tid >> 3)) * NIN + CWI + (tid & 7)];
    __syncthreads();
    for (int l = tid; l <= t0 + 7; l += 256) {
        float kr[64];
        const float4* kp = (const float4*)(proj + (size_t)(b * SEQ + l) * NIN + CKI);
#pragma unroll
        for (int i = 0; i < 16; ++i) { const float4 v = kp[i]; kr[4 * i] = v.x; kr[4 * i + 1] = v.y; kr[4 * i + 2] = v.z; kr[4 * i + 3] = v.w; }
        for (int q = 0; q < 8; ++q) {
            if (l > t0 + q) continue;
            float s = 0.f;
            for (int hh = 0; hh < 8; ++hh) { float d = 0.f;
#pragma unroll
                for (int e = 0; e < 64; ++e) d += qs[q][hh * 64 + e] * kr[e];
                s += wsm[q][hh] * fmaxf(d, 0.f); }
            SC[(size_t)(b * SEQ + t0 + q) * 2048 + l] = s;
        }
    }
}
__global__ void __launch_bounds__(256) k_scores_s(const float* __restrict__ proj, const float* __restrict__ cache_kidx, const int* __restrict__ page_table,
                                                   float* __restrict__ SCS) {
    __shared__ float qs[512]; __shared__ float wsm[8];
    const int s = blockIdx.x, tid = threadIdx.x; const float* prow = proj + (size_t)(MP + s) * NIN;
    for (int i = tid; i < 512; i += 256) qs[i] = prow[CQI + i];
    if (tid < 8) wsm[tid] = prow[CWI + tid];
    __syncthreads();
    for (int l = tid; l < PAST + 1; l += 256) {
        const float* kp_ = l < PAST ? cache_kidx + ((size_t)page_table[s * NPG + l / PAGE] * PAGE + (l % PAGE)) * 64 : prow + CKI;
        float kr[64];
#pragma unroll
        for (int i = 0; i < 64; ++i) kr[i] = kp_[i];
        float sc = 0.f;
        for (int hh = 0; hh < 8; ++hh) { float d = 0.f;
#pragma unroll
            for (int e = 0; e < 64; ++e) d += qs[hh * 64 + e] * kr[e];
            sc += wsm[hh] * fmaxf(d, 0.f); }
        SCS[(size_t)s * 2112 + l] = sc;
    }
}

__device__ __forceinline__ unsigned f2key(float f) { unsigned u = __float_as_uint(f); if (f == 0.0f) u = 0u; return (u & 0x80000000u) ? ~u : (u | 0x80000000u); }
__global__ void __launch_bounds__(256) k_topk(const float* __restrict__ SC, const float* __restrict__ SCS, int* __restrict__ SEL, int* __restrict__ NSEL) {
    const int m = blockIdx.x * 4 + (threadIdx.x >> 6), lane = threadIdx.x & 63;
    const float* src; int n;
    if (m < MP) { n = (m % SEQ) + 1; src = SC + (size_t)m * 2048; } else { n = PAST + 1; src = SCS + (size_t)(m - MP) * 2112; }
    int* sel = SEL + (size_t)m * 256;
    if (n <= 256) { for (int i = lane; i < n; i += 64) sel[i] = i; if (lane == 0) NSEL[m] = n; return; }
    unsigned key[33];
#pragma unroll
    for (int j = 0; j < 33; ++j) { const int l = j * 64 + lane; key[j] = l < n ? f2key(src[l]) : 0u; }
    unsigned T = 0u;
    for (int bit = 31; bit >= 0; --bit) { const unsigned cand = T | (1u << bit); int cnt = 0;
#pragma unroll
        for (int j = 0; j < 33; ++j) cnt += __popcll(__ballot(key[j] >= cand));
        if (cnt >= 256) T = cand; }
    int cgt = 0;
#pragma unroll
    for (int j = 0; j < 33; ++j) cgt += __popcll(__ballot(key[j] > T));
    const int need = 256 - cgt;
    const unsigned long long lt = (1ull << lane) - 1ull;
    int pos = 0, eq_seen = 0;
#pragma unroll
    for (int j = 0; j < 33; ++j) { const bool gt = key[j] > T, eq = key[j] == T;
        const unsigned long long meq = __ballot(eq); const int eqb = eq_seen + __popcll(meq & lt);
        const bool take = gt || (eq && eqb < need);
        const unsigned long long mt = __ballot(take);
        if (take) sel[pos + __popcll(mt & lt)] = j * 64 + lane;
        pos += __popcll(mt); eq_seen += __popcll(meq); }
    if (lane == 0) NSEL[m] = 256;
}

__global__ void __launch_bounds__(256) k_attn(const float* __restrict__ proj, const float* __restrict__ cache_k, const float* __restrict__ cache_v,
                                               const int* __restrict__ page_table, const int* __restrict__ SEL, const int* __restrict__ NSEL, float* __restrict__ MIX) {
    __shared__ float pl[4][8][256]; __shared__ int il[4][256]; __shared__ float ql[4][512];
    const int w = threadIdx.x >> 6, lane = threadIdx.x & 63, m = blockIdx.x * 4 + w;
    const int nsel = NSEL[m]; const float* prow = proj + (size_t)m * NIN;
    const bool prompt = m < MP; const int b = m / SEQ, s = m - MP;
    for (int i = lane; i < 512; i += 64) ql[w][i] = prow[CQ + i];
    for (int i = lane; i < 256; i += 64) {
        if (i < nsel) { const int l = SEL[(size_t)m * 256 + i]; il[w][i] = l;
            const float* krow = prompt ? proj + (size_t)(b * SEQ + l) * NIN + CK
                                       : (l < PAST ? cache_k + ((size_t)page_table[s * NPG + l / PAGE] * PAGE + (l % PAGE)) * 128 : prow + CK);
            for (int g = 0; g < 2; ++g) { float kr[64];
#pragma unroll
                for (int e = 0; e < 64; ++e) kr[e] = krow[g * 64 + e];
                for (int r = 0; r < 4; ++r) { float d = 0.f;
#pragma unroll
                    for (int e = 0; e < 64; ++e) d += ql[w][(g * 4 + r) * 64 + e] * kr[e];
                    pl[w][g * 4 + r][i] = d * 0.125f; } }
        } else { il[w][i] = 0; for (int hh = 0; hh < 8; ++hh) pl[w][hh][i] = -INFINITY; }
    }
    for (int hh = 0; hh < 8; ++hh) { float v[4]; float mx = -INFINITY;
#pragma unroll
        for (int i = 0; i < 4; ++i) { v[i] = pl[w][hh][lane + 64 * i]; mx = fmaxf(mx, v[i]); }
        mx = wave_max(mx); float sm = 0.f;
#pragma unroll
        for (int i = 0; i < 4; ++i) { v[i] = expf(v[i] - mx); sm += v[i]; }
        sm = wave_sum(sm); const float inv = 1.0f / sm;
#pragma unroll
        for (int i = 0; i < 4; ++i) pl[w][hh][lane + 64 * i] = v[i] * inv; }
    for (int g = 0; g < 2; ++g) { float acc[4] = {0.f, 0.f, 0.f, 0.f};
        for (int i = 0; i < nsel; ++i) { const int l = il[w][i];
            const float* vrow = prompt ? proj + (size_t)(b * SEQ + l) * NIN + CV
                                       : (l < PAST ? cache_v + ((size_t)page_table[s * NPG + l / PAGE] * PAGE + (l % PAGE)) * 128 : prow + CV);
            const float vv = vrow[g * 64 + lane];
#pragma unroll
            for (int r = 0; r < 4; ++r) acc[r] += pl[w][g * 4 + r][i] * vv; }
#pragma unroll
        for (int r = 0; r < 4; ++r) { const int c = (g * 4 + r) * 64 + lane; MIX[(size_t)m * 1024 + c] = acc[r] * silu_f(prow[CGA + c]); } }
}

__global__ void __launch_bounds__(256) k_pool_d(const float* __restrict__ proj, const float* __restrict__ state_pool, float* __restrict__ DB) {
    const size_t idx = (size_t)blockIdx.x * 256 + threadIdx.x; const int m = (int)(idx >> 9), c = (int)(idx & 511);
    const int g = c >> 7, w = 2 << g; const float un = proj[(size_t)m * NIN + CU + c]; float sum = un; float cnt;
    if (m < MP) { const int t = m % SEQ; for (int i = 1; i < w; ++i) if (t - i >= 0) sum += proj[(size_t)(m - i) * NIN + CU + c]; cnt = (float)(t + 1 < w ? t + 1 : w); }
    else { const int s = m - MP; for (int i = 1; i < w; ++i) sum += state_pool[((size_t)s * 15 + (15 - i)) * 512 + c]; cnt = (float)w; }
    DB[idx] = sum / cnt - un;
}
__global__ void __launch_bounds__(256) k_pool_out(const float* __restrict__ proj, const float* __restrict__ DB, const float* __restrict__ w_pool,
                                                   const float* __restrict__ pool_scale, float* __restrict__ MIX) {
    const size_t idx = (size_t)blockIdx.x * 256 + threadIdx.x; const int m = (int)(idx >> 9), col = (int)(idx & 511), g = col >> 7, j = col & 127;
    float acc = 0.f;
    for (int c = 0; c < 128; ++c) acc += DB[(size_t)m * 512 + g * 128 + c] * w_pool[((size_t)g * 128 + c) * 128 + j];
    MIX[(size_t)m * 1024 + 512 + col] = acc * pool_scale[col] * silu_f(proj[(size_t)m * NIN + CGP + col]);
}
__global__ void __launch_bounds__(256) k_final(const float* __restrict__ xp, const float* __restrict__ xs, const float* __restrict__ ada,
                                                const float* __restrict__ YT, float* __restrict__ out) {
    const size_t idx = (size_t)blockIdx.x * 256 + threadIdx.x; const int m = (int)(idx >> 10), c = (int)(idx & 1023);
    const int r = m < MP ? m / SEQ : NB + (m - MP);
    const float x = m < MP ? xp[idx] : xs[idx - (size_t)MP * 1024];
    float* o = m < MP ? out + O_YP + idx : out + O_YS + (idx - (size_t)MP * 1024);
    *o = x + ada[(size_t)r * 3072 + 2048 + c] * YT[idx];
}

}
#endif

#if TEST_MODE
__global__ void __launch_bounds__(256) k_cmp(const void* a, int a_bf16, int lda, const float* ref, int ldr, int rows, int cols, float scale, int act, float* accum) {
    __shared__ float sd[256], sr[256];
    const size_t idx = (size_t)blockIdx.x * 256 + threadIdx.x; float d2 = 0.f, r2 = 0.f;
    if (idx < (size_t)rows * cols) { const size_t r = idx / cols, c = idx % cols;
        const float av = a_bf16 ? bf2f(((const bf16*)a)[r * lda + c]) : ((const float*)a)[r * lda + c];
        float rv = ref[r * ldr + c]; if (act) rv = rv / (1.f + expf(-rv)); rv *= scale;
        d2 = (av - rv) * (av - rv); r2 = rv * rv; if (!(d2 == d2)) d2 = 1e30f; }
    sd[threadIdx.x] = d2; sr[threadIdx.x] = r2; __syncthreads();
    for (int s = 128; s > 0; s >>= 1) { if ((int)threadIdx.x < s) { sd[threadIdx.x] += sd[threadIdx.x + s]; sr[threadIdx.x] += sr[threadIdx.x + s]; } __syncthreads(); }
    if (threadIdx.x == 0) { atomicAdd(accum, sd[0]); atomicAdd(accum + 1, sr[0]); }
}
__global__ void __launch_bounds__(256) k_cmp_sel(const int* SEL, const int* NSEL, const unsigned* bmdump, float* accum) {
    __shared__ float sd[256], sr[256];
    const size_t idx = (size_t)blockIdx.x * 256 + threadIdx.x; const int m = (int)(idx >> 8), i = (int)(idx & 255); float miss = 0.f, tot = 0.f;
    if (m < MP && i < NSEL[m]) { const int l = SEL[(size_t)m * 256 + i]; tot = 1.f; if (!((bmdump[(size_t)m * 64 + (l >> 5)] >> (l & 31)) & 1u)) miss = 1.f; }
    sd[threadIdx.x] = miss; sr[threadIdx.x] = tot; __syncthreads();
    for (int s = 128; s > 0; s >>= 1) { if ((int)threadIdx.x < s) { sd[threadIdx.x] += sd[threadIdx.x + s]; sr[threadIdx.x] += sr[threadIdx.x + s]; } __syncthreads(); }
    if (threadIdx.x == 0) { atomicAdd(accum, sd[0]); atomicAdd(accum + 1, sr[0]); }
}
__global__ void k_cmp_fin2(float* accum, int n, float amp) {
    float best = -1.f; int bi = 0;
    for (int k = 0; k < n; ++k) { const float rel = accum[2 * k] / fmaxf(accum[2 * k + 1], 1e-30f) / accum[32 + k]; if (rel > best) { best = rel; bi = k; } }
    accum[64] = sqrtf(amp * best); accum[65] = (float)bi;
}
__global__ void k_set(float* p, float a, float b, float c, float d, float e) { p[0] = a; p[1] = b; p[2] = c; p[3] = d; p[4] = e; }
__global__ void k_cmp_fin(float* accum, int n, float amp) {
    float best = -1.f; int bi = 0;
    for (int k = 0; k < n; ++k) { const float rel = accum[2 * k] / fmaxf(accum[2 * k + 1], 1e-30f); if (rel > best) { best = rel; bi = k; } }
    accum[64] = sqrtf(amp * best); accum[65] = (float)bi;
}
__global__ void __launch_bounds__(256) k_perturb(float* out, const float* accum) {
    const size_t offs[11] = {O_YP, O_YS, O_KP, O_VP, O_KIP, O_PP, O_KS, O_VS, O_KIS, O_PS, O_END};
    const int k = (int)accum[65] % 10; const float f = 1.0f + accum[64];
    for (size_t i = offs[k] + (size_t)blockIdx.x * 256 + threadIdx.x; i < offs[k + 1]; i += (size_t)gridDim.x * 256) out[i] *= f;
}
__global__ void __launch_bounds__(256) k_f32_to_bf16(const float* src, bf16* dst, size_t n) {
    for (size_t i = (size_t)blockIdx.x * 256 + threadIdx.x; i < n; i += (size_t)gridDim.x * 256) dst[i] = (bf16)f2bf(src[i]);
}
#endif

#if TEST_MODE == 5
__global__ void __launch_bounds__(256) k_stat(float* out, const unsigned* st, int which) {
    float v = which == 0 ? (float)st[0] : (which == 1 ? (float)st[1] / fmaxf((float)st[2], 1.f) : (which < 8 ? (float)st[3] : (which == 13 ? (float)st[13] : (float)st[which] * (16.0f / 1000.0f))));
    const float f = 1.0f + sqrtf(v * 1e-5f);
    for (size_t i = O_KS + (size_t)blockIdx.x * 256 + threadIdx.x; i < O_VS; i += (size_t)gridDim.x * 256) out[i] *= f;
}
#endif
#if TEST_MODE == 4
__global__ void __launch_bounds__(256) k_time(float* out, const unsigned long long* ts, int i0, int i1, float scale) {
    const float us = (float)(ts[i1] - ts[i0]) * 0.01f; const float f = 1.0f + sqrtf(us * scale);
    for (size_t i = O_KS + (size_t)blockIdx.x * 256 + threadIdx.x; i < O_VS; i += (size_t)gridDim.x * 256) out[i] *= f;
}
#endif
extern "C" void kernel_launch(void* const* d_in, const int* in_sizes, int n_in, void* d_out, int out_size, void* d_ws, size_t ws_size, hipStream_t stream) {
    static int grid = 0;
    if (grid == 0) {
        size_t need = WS_MEGA_END;
#if TEST_MODE && TEST_MODE < 4
        need = 192 * MiB + gold::W_END * 4;
#endif
        if (n_in != 18 || out_size != (int)O_END || ws_size < need) { fprintf(stderr, "kernel_launch: unexpected sizes: n_in %d out %d ws %zu (need %zu)\n", n_in, out_size, ws_size, need); grid = -1; return; }
        int dev = 0, cus = 0, per_cu = 0;
        if (hipGetDevice(&dev) != hipSuccess || hipDeviceGetAttribute(&cus, hipDeviceAttributeMultiprocessorCount, dev) != hipSuccess) { grid = -1; return; }
        if (hipFuncSetAttribute((const void*)mk_fwd, hipFuncAttributeMaxDynamicSharedMemorySize, LDS_BYTES) != hipSuccess) { fprintf(stderr, "kernel_launch: hipFuncSetAttribute failed\n"); grid = -1; return; }
        if (hipOccupancyMaxActiveBlocksPerMultiprocessor(&per_cu, (const void*)mk_fwd, NWAVES * 64, LDS_BYTES) != hipSuccess || per_cu < 1) { fprintf(stderr, "kernel_launch: occupancy query says %d blocks/CU\n", per_cu); (void)hipGetLastError(); grid = -1; return; }
        if (cus < 64) { fprintf(stderr, "kernel_launch: needs >= 64 CUs\n"); grid = -1; return; }
        grid = cus;
    }
    if (grid < 0) return;
#if TEST_MODE
    (void)hipMemsetAsync((char*)d_ws + WS_CTL, 0, CTL_ZERO_BYTES, stream);
#else
    (void)hipMemsetAsync((char*)d_ws + WS_CTL + CW_BAR * 4, 0, XCD_BAR_WORDS * 4, stream);
#endif
    Args a{};
    for (int i = 0; i < 18; ++i) a.in[i] = (const float*)d_in[i];
    a.out = (float*)d_out; a.ws = (unsigned char*)d_ws;
#if TEST_MODE == 5
    a.ph_lo = 0; a.ph_hi = 5; a.li = 0;
    hipLaunchKernelGGL(mk_fwd, dim3(grid), dim3(NWAVES * 64), LDS_BYTES, stream, a);
    k_stat<<<16, 256, 0, stream>>>((float*)d_out, (const unsigned*)((char*)d_ws + WS_CTL + 900 * 1024), STATSEL);
#elif TEST_MODE == 4
    a.ph_lo = 0; a.ph_hi = 5; a.li = 0;
    hipLaunchKernelGGL(mk_fwd, dim3(grid), dim3(NWAVES * 64), LDS_BYTES, stream, a);
    k_time<<<16, 256, 0, stream>>>((float*)d_out, (const unsigned long long*)((char*)d_ws + WS_CTL + 768 * 1024), TS0, TS1, 1e-5f);
#elif TEST_MODE && TEST_MODE < 4
    {
        using namespace gold;
        const float* xp = (const float*)d_in[0]; const float* xs = (const float*)d_in[1];
        const float* cache_k = (const float*)d_in[2]; const float* cache_v = (const float*)d_in[3]; const float* cache_kidx = (const float*)d_in[4];
        const float* state_pool = (const float*)d_in[5]; const int* page_table = (const int*)d_in[6];
        const float* cp = (const float*)d_in[7]; const float* cs = (const float*)d_in[8]; const float* norm_w = (const float*)d_in[9];
        const float* w_ada = (const float*)d_in[10]; const float* b_ada = (const float*)d_in[11]; const float* w_in = (const float*)d_in[12];
        const float* qnw = (const float*)d_in[13]; const float* knw = (const float*)d_in[14]; const float* w_pool = (const float*)d_in[15];
        const float* pool_scale = (const float*)d_in[16]; const float* w_out = (const float*)d_in[17];
        float* out = (float*)d_out; float* ws = (float*)((char*)d_ws + 192 * MiB);
        float *ADA = ws + W_ADA, *H = ws + W_H, *PROJ = ws + W_PROJ, *SC = ws + W_SC, *SCS = ws + W_SCS, *MIX = ws + W_MIX, *DB = ws + W_DB, *YT = ws + W_YT;
        int *SEL = (int*)(ws + W_SEL), *NSEL = (int*)(ws + W_NSEL);
        k_ada<<<dim3(12, NR), 256, 0, stream>>>(cp, cs, w_ada, b_ada, ADA);
        k_h<<<MT / 4, 256, 0, stream>>>(xp, xs, norm_w, ADA, H);
        k_gemm<<<dim3((NIN + 127) / 128, MT / 128), 256, 0, stream>>>(H, w_in, PROJ, MT, NIN, DM, DM, NIN, NIN);
        k_post<<<MT / 4, 256, 0, stream>>>(PROJ, qnw, knw, state_pool, out);
        k_scores_p<<<dim3(SEQ / 8, NB), 256, 0, stream>>>(PROJ, SC);
        k_scores_s<<<DECB, 256, 0, stream>>>(PROJ, cache_kidx, page_table, SCS);
        k_topk<<<MT / 4, 256, 0, stream>>>(SC, SCS, SEL, NSEL);
        k_attn<<<MT / 4, 256, 0, stream>>>(PROJ, cache_k, cache_v, page_table, SEL, NSEL, MIX);
        k_pool_d<<<(MT * 512) / 256, 256, 0, stream>>>(PROJ, state_pool, DB);
        k_pool_out<<<(MT * 512) / 256, 256, 0, stream>>>(PROJ, DB, w_pool, pool_scale, MIX);
        k_gemm<<<dim3(1024 / 128, MT / 128), 256, 0, stream>>>(MIX, w_out, YT, MT, 1024, 1024, 1024, 1024, 1024);
        k_final<<<(MT * 1024) / 256, 256, 0, stream>>>(xp, xs, ADA, YT, out);
        unsigned char* mws = (unsigned char*)d_ws;
#if TEST_MODE == 1
        a.ph_lo = 0; a.ph_hi = 3; a.li = 0;
        hipLaunchKernelGGL(mk_fwd, dim3(grid), dim3(NWAVES * 64), LDS_BYTES, stream, a);
        float* accum = (float*)(mws + WS_CTL + 512 * 1024);
        struct { const void* a; int bf; int lda; int refcol; int cols; float scale; int act; } L[9] = {
            {mws + WS_Q, 1, 512, CQ, 512, C2, 0}, {mws + WS_QI, 1, 512, CQI, 512, 1.f, 0}, {mws + WS_GA, 1, 512, CGA, 512, 1.f, 1}, {mws + WS_U, 1, 512, CU, 512, 1.f, 0},
            {mws + WS_GP, 1, 512, CGP, 512, 1.f, 1}, {mws + WS_KB, 1, 128, CK, 128, 1.f, 0}, {mws + WS_VB, 1, 128, CV, 128, 1.f, 0}, {mws + WS_KI, 1, 64, CKI, 64, 1.f, 0},
            {mws + WS_WI, 0, 8, CWI, 8, 1.f, 0} };
        for (int k = 0; k < 9; ++k) k_cmp<<<(unsigned)(((size_t)MT * L[k].cols + 255) / 256), 256, 0, stream>>>(L[k].a, L[k].bf, L[k].lda, PROJ + L[k].refcol, NIN, MT, L[k].cols, L[k].scale, L[k].act, accum + 2 * k);
        k_cmp<<<(NR * 3072 + 255) / 256, 256, 0, stream>>>(mws + WS_ADA, 0, 3072, ADA, 3072, NR, 3072, 1.f, 0, accum + 18);
        k_cmp_fin<<<1, 1, 0, stream>>>(accum, 10, 5.0f);
        k_perturb<<<1024, 256, 0, stream>>>(out, accum);
#elif TEST_MODE == 3
        a.ph_lo = 0; a.ph_hi = 5; a.li = 0;
        hipLaunchKernelGGL(mk_fwd, dim3(grid), dim3(NWAVES * 64), LDS_BYTES, stream, a);
        float* accum = (float*)(mws + WS_CTL + 512 * 1024);
        const bf16* MB = (const bf16*)(mws + WS_MIX);
        k_cmp<<<(unsigned)(((size_t)MP * 512 + 255) / 256), 256, 0, stream>>>(MB, 1, 1024, MIX, 1024, MP, 512, 1.f, 0, accum + 0);
        k_cmp<<<(unsigned)(((size_t)MP * 512 + 255) / 256), 256, 0, stream>>>(MB + 512, 1, 1024, MIX + 512, 1024, MP, 512, 1.f, 0, accum + 2);
        k_cmp<<<(DECB * 512 + 255) / 256, 256, 0, stream>>>(MB + (size_t)MP * 1024, 1, 1024, MIX + (size_t)MP * 1024, 1024, DECB, 512, 1.f, 0, accum + 4);
        k_cmp<<<(DECB * 512 + 255) / 256, 256, 0, stream>>>(MB + (size_t)MP * 1024 + 512, 1, 1024, MIX + (size_t)MP * 1024 + 512, 1024, DECB, 512, 1.f, 0, accum + 6);
        k_cmp_sel<<<MP, 256, 0, stream>>>(SEL, NSEL, (const unsigned*)(mws + WS_DBG_BM), accum + 8);
        k_set<<<1, 1, 0, stream>>>(accum + 32, P3_TOL0, P3_TOL1, P3_TOL2, P3_TOL3, P3_TOL4);
        k_cmp_fin2<<<1, 1, 0, stream>>>(accum, 5, 1e-5f);
        k_perturb<<<1024, 256, 0, stream>>>(out, accum);
#elif TEST_MODE == 2
        a.ph_lo = 0; a.ph_hi = 3; a.li = 0;
        hipLaunchKernelGGL(mk_fwd, dim3(grid), dim3(NWAVES * 64), LDS_BYTES, stream, a);
        k_f32_to_bf16<<<2048, 256, 0, stream>>>(MIX, (bf16*)(mws + WS_MIX), (size_t)MT * 1024);
        a.ph_lo = 4; a.ph_hi = 5; a.li = 1;
        hipLaunchKernelGGL(mk_fwd, dim3(grid), dim3(NWAVES * 64), LDS_BYTES, stream, a);
#endif
    }
#else
    a.ph_lo = 0; a.ph_hi = 5; a.li = 0;
    hipLaunchKernelGGL(mk_fwd, dim3(grid), dim3(NWAVES * 64), LDS_BYTES, stream, a);
#endif
}
```

```cpp
#define TEST_MODE 0
#define HAVE_P3 1
#define REP_S1 1
#define REP_S2 1
#define REP_S4 1
#define REP_P0 1
#define REP_P1 1
#define REP_P4S 1
#define REP_P2G 1
#define REP_P4G 1
#define REP_P2S 1
#define REP_SMP 1
#define REP_POOL 1
#define STATSEL 0
#define USE_COOP 1
#define STAMP_BLK 0
#define P3FINE 0
#define TS0 0
#define TS1 1
#include <hip/hip_runtime.h>
#include <cstdio>
#include <cstdint>

constexpr int DM = 1024, NB = 8, SEQ = 2048, DECB = 128, PAST = 2048, PAGE = 128, NPG = 16;
constexpr int NIN = 2888, MP = NB * SEQ, MT = MP + DECB, NR = NB + DECB;
constexpr int CQ = 0, CK = 512, CV = 640, CQI = 768, CKI = 1280, CWI = 1344, CGA = 1352, CU = 1864, CGP = 2376;
constexpr size_t O_YP = 0, O_YS = 16777216, O_KP = 16908288, O_VP = 19005440, O_KIP = 21102592, O_PP = 22151168,
                 O_KS = 22212608, O_VS = 22228992, O_KIS = 22245376, O_PS = 22253568, O_END = 23236608;
constexpr float C2 = 0.125f * 1.4426950408889634f;
constexpr float WI_SCALE = 0.04419417382415922f;
constexpr float EPS = 1e-6f;
constexpr size_t MiB = 1u << 20;
constexpr size_t WS_CTL = 0, CTL_ZERO_BYTES = 1 * MiB;
constexpr size_t WS_ADA = 1 * MiB, WS_WINT = 3 * MiB, WS_WOUTT = 9 * MiB, WS_WPOOLT = 11 * MiB, WS_HS = 12 * MiB, WS_HB = 24 * MiB,
                 WS_Q = 56 * MiB, WS_QI = 73 * MiB, WS_GA = 90 * MiB, WS_U = 107 * MiB, WS_GP = 124 * MiB, WS_KB = 141 * MiB, WS_VB = 146 * MiB,
                 WS_KI = 151 * MiB, WS_WI = 154 * MiB, WS_MIX = 155 * MiB, WS_DBG_BM = 188 * MiB, WS_MEGA_END = 192 * MiB;
namespace pg8 {
#define PG8_LAS __attribute__((address_space(3)))
typedef unsigned short bf16_t;
typedef short bf16x8 __attribute__((ext_vector_type(8)));
typedef float f32x4 __attribute__((ext_vector_type(4)));
typedef unsigned u32x4 __attribute__((ext_vector_type(4)));
constexpr int BM = 256, BK = 64, HALF = 128, HTB = HALF * BK * 2  , STAGE_BYTES = 8 * HTB, NXCD = 8, WGM = 8;

__host__ __device__ __forceinline__ int lds_byte(int r, int c) { const int st = (r >> 4) * 2 + (c >> 5), rr = r & 15, cc = c & 31, ob = rr * 64 + cc * 2; return st * 1024 + (ob ^ (((ob >> 9) & 1) << 5)); }
__host__ __device__ __forceinline__ void stage_rc(int b, int& R, int& C) { const int st = b / 1024, sb = b % 1024, swz = sb ^ (((sb >> 9) & 1) << 5); R = (st >> 1) * 16 + swz / 64; C = (st & 1) * 32 + (swz % 64) / 2; }
__host__ __device__ __forceinline__ int perm32(int rho) { const int n = rho >> 4, i = rho & 15; return 8 * (i >> 2) + 4 * n + (i & 3); }

struct Unit { int pm, pn; };
struct Gemm { const bf16_t* A; const bf16_t* Bt; int M, N, K; };

struct StaticOrder {
    int nM, nN, nwg, G, c;
    __host__ __device__ void init(int M, int N, int G_, int c_) { nM = M / BM; nN = N / BM; nwg = nM * nN; G = G_; c = c_; }
    __host__ __device__ bool next(int i, Unit& u) const {
        const long L = (long)i * G + c; if (L >= nwg) return false;
        int wgid = (int)L; { const int q = nwg / NXCD, r = nwg % NXCD, xcd = wgid % NXCD, off = wgid / NXCD; wgid = (xcd < r ? xcd * (q + 1) : r * (q + 1) + (xcd - r) * q) + off; }
        const int nig = WGM * nN, gid = wgid / nig, fm = gid * WGM, gsz = (nM - fm) < WGM ? (nM - fm) : WGM;
        u.pm = fm + ((wgid % nig) % gsz); u.pn = (wgid % nig) / gsz; return true;
    }
    __device__ __forceinline__ void a_ready(const Unit&) const {}
    __device__ __forceinline__ void done(const Unit&) const {}
};


typedef unsigned u32x4 __attribute__((ext_vector_type(4)));
__device__ __forceinline__ unsigned cvt_pk_bf16(float lo, float hi) { unsigned r; asm volatile("v_cvt_pk_bf16_f32 %0, %1, %2" : "=v"(r) : "v"(lo), "v"(hi)); return r; }
__device__ __forceinline__ void st_bf16x8(bf16_t* p, const f32x4 a, const f32x4 b) {
    u32x4 w; w.x = cvt_pk_bf16(a[0], a[1]); w.y = cvt_pk_bf16(a[2], a[3]); w.z = cvt_pk_bf16(b[0], b[1]); w.w = cvt_pk_bf16(b[2], b[3]); *(u32x4*)p = w; }
__device__ __forceinline__ float silu1(float x) { return x * __builtin_amdgcn_rcpf(1.0f + __builtin_amdgcn_exp2f(-1.4426950408889634f * x)); }
__device__ __forceinline__ f32x4 silu4(const f32x4 v) { f32x4 r; r[0] = silu1(v[0]); r[1] = silu1(v[1]); r[2] = silu1(v[2]); r[3] = silu1(v[3]); return r; }

struct EpiIn {
    static constexpr bool PERM = true, AFTER_DRAIN = false;
    unsigned char* ws; float* out; const float* qnw; const float* knw;
    __device__ __forceinline__ void operator()(const f32x4 (&acc)[2][2][4][2], const Unit& u, int wr, int wc, int fr, int fq) const {
        const int pn = u.pn;
        if (pn == 5 && wc >= 2) return;
        const int rowb = u.pm * 256 + wr * 64 + fr, dof = 8 * fq;
        if (pn <= 1 || (pn == 2 && wc < 2)) {
            const float* nwp = pn <= 1 ? qnw : knw; const float sc = pn <= 1 ? C2 : 1.0f;
            f32x4 wv[2][2];
#pragma unroll
            for (int bj = 0; bj < 2; ++bj)
#pragma unroll
                for (int n = 0; n < 2; ++n) wv[bj][n] = *(const f32x4*)(nwp + 32 * bj + dof + 4 * n) * sc;
#pragma unroll
            for (int ai = 0; ai < 2; ++ai)
#pragma unroll
                for (int m = 0; m < 4; ++m) { const size_t row = (size_t)(rowb + ai * 128 + m * 16); float ss = 0.f;
#pragma unroll
                    for (int bj = 0; bj < 2; ++bj)
#pragma unroll
                        for (int n = 0; n < 2; ++n) { const f32x4 x = acc[ai][bj][m][n]; ss += (x[0] * x[0] + x[1] * x[1]) + (x[2] * x[2] + x[3] * x[3]); }
                    ss += __shfl_xor(ss, 16); ss += __shfl_xor(ss, 32);
                    const float rstd = 1.0f / sqrtf(ss * (1.0f / 64.0f) + EPS);
                    f32x4 o[2][2];
#pragma unroll
                    for (int bj = 0; bj < 2; ++bj)
#pragma unroll
                        for (int n = 0; n < 2; ++n) o[bj][n] = acc[ai][bj][m][n] * rstd * wv[bj][n];
                    if (pn <= 1) { bf16_t* q = (bf16_t*)(ws + WS_Q) + row * 512 + (4 * pn + wc) * 64 + dof; st_bf16x8(q, o[0][0], o[0][1]); st_bf16x8(q + 32, o[1][0], o[1][1]); }
                    else { float* ko = out + O_KP + row * 128 + wc * 64 + dof; *(f32x4*)ko = o[0][0]; *(f32x4*)(ko + 4) = o[0][1]; *(f32x4*)(ko + 32) = o[1][0]; *(f32x4*)(ko + 36) = o[1][1];
                        bf16_t* kb = (bf16_t*)(ws + WS_KB) + row * 128 + wc * 64 + dof; st_bf16x8(kb, o[0][0], o[0][1]); st_bf16x8(kb + 32, o[1][0], o[1][1]); } }
            return;
        }
        if (pn == 5 && wc == 1) {
            if (fq == 0) {
#pragma unroll
                for (int ai = 0; ai < 2; ++ai)
#pragma unroll
                    for (int m = 0; m < 4; ++m) { const size_t row = (size_t)(rowb + ai * 128 + m * 16); float* wp = (float*)(ws + WS_WI) + row * 8;
                        *(f32x4*)wp = acc[ai][0][m][0] * WI_SCALE; *(f32x4*)(wp + 4) = acc[ai][0][m][1] * WI_SCALE; } }
            return;
        }
        bf16_t* dst; int ld, cb; float* fo = nullptr; int fld = 0; bool act = false;
        if (pn == 2) { dst = (bf16_t*)(ws + WS_VB); ld = 128; cb = (wc - 2) * 64; fo = out + O_VP + cb; fld = 128; }
        else if (pn <= 4) { dst = (bf16_t*)(ws + WS_QI); ld = 512; cb = (4 * (pn - 3) + wc) * 64; }
        else if (pn == 5) { dst = (bf16_t*)(ws + WS_KI); ld = 64; cb = 0; fo = out + O_KIP; fld = 64; }
        else if (pn <= 7) { dst = (bf16_t*)(ws + WS_GA); ld = 512; cb = (4 * (pn - 6) + wc) * 64; act = true; }
        else if (pn <= 9) { dst = (bf16_t*)(ws + WS_U); ld = 512; cb = (4 * (pn - 8) + wc) * 64; }
        else { dst = (bf16_t*)(ws + WS_GP); ld = 512; cb = (4 * (pn - 10) + wc) * 64; act = true; }
        const bool is_u = (pn == 8 || pn == 9);
#pragma unroll
        for (int ai = 0; ai < 2; ++ai)
#pragma unroll
            for (int m = 0; m < 4; ++m) { const int rowi = rowb + ai * 128 + m * 16; const size_t row = (size_t)rowi;
                f32x4 o00 = acc[ai][0][m][0], o01 = acc[ai][0][m][1], o10 = acc[ai][1][m][0], o11 = acc[ai][1][m][1];
                if (act) { o00 = silu4(o00); o01 = silu4(o01); o10 = silu4(o10); o11 = silu4(o11); }
                bf16_t* d = dst + row * ld + cb + dof; st_bf16x8(d, o00, o01); st_bf16x8(d + 32, o10, o11);
                if (fo) { float* f = fo + row * fld + dof; *(f32x4*)f = o00; *(f32x4*)(f + 4) = o01; *(f32x4*)(f + 32) = o10; *(f32x4*)(f + 36) = o11; }
                if (is_u) { const int t = rowi & (SEQ - 1);
                    if (t >= SEQ - 15) { float* f = out + O_PP + ((size_t)(rowi >> 11) * 15 + (t - (SEQ - 15))) * 512 + cb + dof;
                        *(f32x4*)f = o00; *(f32x4*)(f + 4) = o01; *(f32x4*)(f + 32) = o10; *(f32x4*)(f + 36) = o11; } } }
    }
};
struct EpiOut {
    static constexpr bool PERM = true, AFTER_DRAIN = false;
    const float* x; float* y; const float* ada;
    __device__ __forceinline__ void operator()(const f32x4 (&acc)[2][2][4][2], const Unit& u, int wr, int wc, int fr, int fq) const {
        const int col0 = u.pn * 256 + wc * 32 + 8 * fq; const float* gp = ada + (size_t)(u.pm >> 3) * 3072 + 2048 + col0;
        f32x4 g[2][2];
#pragma unroll
        for (int bj = 0; bj < 2; ++bj)
#pragma unroll
            for (int n = 0; n < 2; ++n) g[bj][n] = *(const f32x4*)(gp + 128 * bj + 4 * n);
#pragma unroll
        for (int ai = 0; ai < 2; ++ai)
#pragma unroll
            for (int m = 0; m < 4; ++m) { const size_t off = (size_t)(u.pm * 256 + ai * 128 + wr * 64 + m * 16 + fr) * 1024 + col0;
#pragma unroll
                for (int bj = 0; bj < 2; ++bj)
#pragma unroll
                    for (int n = 0; n < 2; ++n) { const f32x4 xv = *(const f32x4*)(x + off + 128 * bj + 4 * n); *(f32x4*)(y + off + 128 * bj + 4 * n) = xv + g[bj][n] * acc[ai][bj][m][n]; } }
    }
};
template <class Epi, class Sched, bool ALIGN_EPI = false, bool SP2 = false>
__device__ __forceinline__ void gemm_phase(PG8_LAS unsigned char* lds, const Gemm g, const Sched& S, const Epi& E) {
    const int tid = threadIdx.x, wid = __builtin_amdgcn_readfirstlane(tid >> 6), lane = tid & 63, wr = wid >> 2, wc = wid & 3, fr = lane & 15, fq = lane >> 4;
    const int K = g.K, nt = K / BK;
    unsigned voffA[2], voffB[2];
#pragma unroll
    for (int i = 0; i < 2; ++i) { int R, C; stage_rc(tid * 16 + i * 8192, R, C); const int Rb = Epi::PERM ? ((R & ~31) + perm32(R & 31)) : R;
        voffA[i] = (unsigned)(R * K + C) * 2u; voffB[i] = (unsigned)(Rb * K + C) * 2u; }
    const size_t kstep = (size_t)(BK * 2);
    const size_t hstep = (size_t)HALF * K * 2;
    const size_t tstep = 2 * hstep;
    const unsigned ldsw = (unsigned)wid * 1024u;
    const int aoff = lds_byte(wr * 64 + fr, fq * 8), boff = lds_byte(wc * 32 + fr, fq * 8);
#define PG8_SA(b, h) (((b) * 2 + (h)) * HTB)
#define PG8_SB(b, h) ((4 + (b) * 2 + (h)) * HTB)
#define PG8_STAGE(bufoff, gbase, voff) do { _Pragma("unroll") for (int _i = 0; _i < 2; ++_i) \
        __builtin_amdgcn_global_load_lds((const unsigned*)((const char*)(gbase) + (voff)[_i]), (PG8_LAS unsigned*)(lds + (bufoff) + ldsw + _i * 8192), 16, 0, 0); } while (0)
#define PG8_LDA(dst, b, h) do { _Pragma("unroll") for (int m = 0; m < 4; ++m) _Pragma("unroll") for (int k = 0; k < 2; ++k) dst[m][k] = *(const PG8_LAS bf16x8*)(lds + PG8_SA(b, h) + aoff + m * 2048 + k * 1024); } while (0)
#define PG8_LDB(dst, b, h) do { _Pragma("unroll") for (int n = 0; n < 2; ++n) _Pragma("unroll") for (int k = 0; k < 2; ++k) dst[n][k] = *(const PG8_LAS bf16x8*)(lds + PG8_SB(b, h) + boff + n * 2048 + k * 1024); } while (0)
#define PG8_MMA(ai, bj, At, Bt) do { __builtin_amdgcn_s_setprio(1); _Pragma("unroll") for (int m = 0; m < 4; ++m) _Pragma("unroll") for (int n = 0; n < 2; ++n) _Pragma("unroll") for (int k = 0; k < 2; ++k) \
        acc[ai][bj][m][n] = __builtin_amdgcn_mfma_f32_16x16x32_bf16(Bt[n][k], At[m][k], acc[ai][bj][m][n], 0, 0, 0); __builtin_amdgcn_s_setprio(0); } while (0)
#define PG8_WAIT_V(n) asm volatile("s_waitcnt vmcnt(" #n ")" ::: "memory")
#define PG8_WAIT_L(n) asm volatile("s_waitcnt lgkmcnt(" #n ")" ::: "memory")
#define PG8_BAR __builtin_amdgcn_s_barrier()
#define PG8_SCHED __builtin_amdgcn_sched_barrier(0)
    Unit cur, nxt; int ui = 0;
    if (!S.next(0, cur)) return;
    f32x4 acc[2][2][4][2];
#pragma unroll
    for (int a = 0; a < 2; ++a)
#pragma unroll
        for (int b = 0; b < 2; ++b)
#pragma unroll
            for (int m = 0; m < 4; ++m)
#pragma unroll
                for (int n = 0; n < 2; ++n) acc[a][b][m][n] = (f32x4){0.f, 0.f, 0.f, 0.f};
    bf16x8 At[4][2], B0[2][2], B1[2][2];
    const char* cA = (const char*)g.A + (size_t)cur.pm * tstep; const char* cB = (const char*)g.Bt + (size_t)cur.pn * tstep;
    S.a_ready(cur);
    if constexpr (SP2) {
        PG8_STAGE(PG8_SB(0, 0), cB, voffB); PG8_STAGE(PG8_SB(0, 1), cB + hstep, voffB); PG8_STAGE(PG8_SA(0, 0), cA, voffA); PG8_STAGE(PG8_SA(0, 1), cA + hstep, voffA);
        if (wr == 1) PG8_BAR;
        PG8_WAIT_V(2); PG8_BAR;
        PG8_STAGE(PG8_SB(1, 0), cB + kstep, voffB); PG8_STAGE(PG8_SA(1, 0), cA + kstep, voffA); PG8_STAGE(PG8_SB(1, 1), cB + hstep + kstep, voffB);
        PG8_WAIT_V(6); PG8_BAR;
    } else {
        PG8_STAGE(PG8_SB(0, 0), cB, voffB); PG8_STAGE(PG8_SA(0, 0), cA, voffA); PG8_STAGE(PG8_SB(0, 1), cB + hstep, voffB); PG8_STAGE(PG8_SA(0, 1), cA + hstep, voffA);
        if (wr == 1) PG8_BAR;
        PG8_WAIT_V(4); PG8_BAR;
        PG8_STAGE(PG8_SB(1, 0), cB + kstep, voffB); PG8_STAGE(PG8_SA(1, 0), cA + kstep, voffA); PG8_STAGE(PG8_SB(1, 1), cB + hstep + kstep, voffB);
        PG8_WAIT_V(6); PG8_BAR;
    }
    for (;;) {
        const bool has_next = S.next(ui + 1, nxt);
        const char* nA = has_next ? (const char*)g.A + (size_t)nxt.pm * tstep : cA; const char* nB = has_next ? (const char*)g.Bt + (size_t)nxt.pn * tstep : cB;
        for (int t = 0; t < nt; t += 2) {
            const bool last = (t == nt - 2);
            const char* a1 = cA + (size_t)(t + 1) * kstep;
            const char* a2 = last ? nA : cA + (size_t)(t + 2) * kstep; const char* b2 = last ? nB : cB + (size_t)(t + 2) * kstep;
            const char* a3 = a2 + kstep; const char* b3 = b2 + kstep;
            if (last && has_next) S.a_ready(nxt);
            if constexpr (SP2) {
            PG8_LDB(B0, 0, 0); PG8_LDB(B1, 0, 1); PG8_SCHED; PG8_LDA(At, 0, 0); PG8_STAGE(PG8_SA(1, 1), a1 + hstep, voffA);
            PG8_WAIT_V(8); PG8_WAIT_L(0); PG8_BAR; PG8_MMA(0, 0, At, B0); PG8_MMA(0, 1, At, B1); PG8_BAR; PG8_SCHED;
            PG8_LDA(At, 0, 1); PG8_STAGE(PG8_SB(0, 0), b2, voffB); PG8_STAGE(PG8_SB(0, 1), b2 + hstep, voffB); PG8_STAGE(PG8_SA(0, 0), a2, voffA);
            PG8_WAIT_V(8); PG8_WAIT_L(0); PG8_BAR; PG8_MMA(1, 0, At, B0); PG8_MMA(1, 1, At, B1); PG8_BAR; PG8_SCHED;
            PG8_LDB(B0, 1, 0); PG8_LDB(B1, 1, 1); PG8_SCHED; PG8_LDA(At, 1, 0); PG8_STAGE(PG8_SA(0, 1), a2 + hstep, voffA);
            PG8_WAIT_V(8); PG8_WAIT_L(0); PG8_BAR; PG8_MMA(0, 0, At, B0); PG8_MMA(0, 1, At, B1); PG8_BAR; PG8_SCHED;
            PG8_LDA(At, 1, 1); PG8_STAGE(PG8_SB(1, 0), b3, voffB); PG8_STAGE(PG8_SB(1, 1), b3 + hstep, voffB); PG8_STAGE(PG8_SA(1, 0), a3, voffA);
            PG8_WAIT_V(8); PG8_WAIT_L(0); PG8_BAR; PG8_MMA(1, 0, At, B0); PG8_MMA(1, 1, At, B1); PG8_BAR; PG8_SCHED;
            } else {
            PG8_LDB(B0, 0, 0); PG8_SCHED; PG8_LDA(At, 0, 0); PG8_STAGE(PG8_SA(1, 1), a1 + hstep, voffA);
            PG8_WAIT_L(8); PG8_BAR; PG8_WAIT_L(0); PG8_MMA(0, 0, At, B0); PG8_BAR; PG8_SCHED;
            PG8_LDB(B1, 0, 1); PG8_STAGE(PG8_SB(0, 0), b2, voffB);
            PG8_BAR; PG8_WAIT_L(0); PG8_MMA(0, 1, At, B1); PG8_BAR;
            PG8_LDA(At, 0, 1); PG8_STAGE(PG8_SA(0, 0), a2, voffA);
            PG8_BAR; PG8_WAIT_L(0); PG8_MMA(1, 0, At, B0); PG8_BAR; PG8_SCHED;
            PG8_STAGE(PG8_SB(0, 1), b2 + hstep, voffB);
            PG8_WAIT_V(6); PG8_BAR; PG8_MMA(1, 1, At, B1); PG8_BAR;
            PG8_LDB(B0, 1, 0); PG8_SCHED; PG8_LDA(At, 1, 0); PG8_STAGE(PG8_SA(0, 1), a2 + hstep, voffA);
            PG8_WAIT_L(8); PG8_BAR; PG8_WAIT_L(0); PG8_MMA(0, 0, At, B0); PG8_BAR; PG8_SCHED;
            PG8_LDB(B1, 1, 1); PG8_STAGE(PG8_SB(1, 0), b3, voffB);
            PG8_BAR; PG8_WAIT_L(0); PG8_MMA(0, 1, At, B1); PG8_BAR;
            PG8_LDA(At, 1, 1); PG8_STAGE(PG8_SA(1, 0), a3, voffA);
            PG8_BAR; PG8_WAIT_L(0); PG8_MMA(1, 0, At, B0); PG8_BAR; PG8_SCHED;
            PG8_STAGE(PG8_SB(1, 1), b3 + hstep, voffB);
            PG8_WAIT_V(6); PG8_BAR; PG8_MMA(1, 1, At, B1); PG8_BAR;
            }
        }
        if constexpr (ALIGN_EPI) { if (wr == 0) PG8_BAR; }
        if constexpr (!Epi::AFTER_DRAIN) { E(acc, cur, wr, wc, fr, fq); S.done(cur); }
        if (!has_next) break;
#pragma unroll
        for (int a = 0; a < 2; ++a)
#pragma unroll
            for (int b = 0; b < 2; ++b)
#pragma unroll
                for (int m = 0; m < 4; ++m)
#pragma unroll
                    for (int n = 0; n < 2; ++n) acc[a][b][m][n] = (f32x4){0.f, 0.f, 0.f, 0.f};
        cur = nxt; cA = nA; cB = nB; ++ui;
        if constexpr (ALIGN_EPI) { if (wr == 1) PG8_BAR; }
    }
    PG8_WAIT_V(0);
    if constexpr (!ALIGN_EPI) { if (wr == 0) PG8_BAR; }
    PG8_BAR;
    if constexpr (Epi::AFTER_DRAIN) { E.fused(acc, cur, wr, wc, fr, fq, lds, wid, lane); S.done(cur); }
#undef PG8_SA
#undef PG8_SB
#undef PG8_STAGE
#undef PG8_LDA
#undef PG8_LDB
#undef PG8_MMA
#undef PG8_WAIT_V
#undef PG8_WAIT_L
#undef PG8_BAR
#undef PG8_SCHED
}
}

constexpr int NWAVES = 8;
constexpr int RING_OFF = 0, RING_BYTES = 131072;
constexpr int LDSCTL_OFF = RING_BYTES, MISC_OFF = LDSCTL_OFF + 320;
constexpr int LDS_BYTES = 163840;
constexpr int CW_BAR = 4096;
#define GAS __attribute__((address_space(1)))
#define LAS __attribute__((address_space(3)))
typedef unsigned short bf16;
typedef unsigned v4u __attribute__((ext_vector_type(4)));
typedef unsigned v2u __attribute__((ext_vector_type(2)));
typedef float f32x4 __attribute__((ext_vector_type(4)));
typedef float f32x16 __attribute__((ext_vector_type(16)));
typedef short bf16x8 __attribute__((ext_vector_type(8)));
typedef GAS unsigned gu32;
#define LDS_WAIT() asm volatile("s_waitcnt lgkmcnt(0)" ::: "memory")
#define VM_WAIT() asm volatile("s_waitcnt vmcnt(0)" ::: "memory")
__device__ __forceinline__ unsigned f2bf(float f) { unsigned u = __builtin_bit_cast(unsigned, f); return (u + 0x7fffu + ((u >> 16) & 1u)) >> 16; }
__device__ __forceinline__ unsigned pk2(float lo, float hi) { return pg8::cvt_pk_bf16(lo, hi); }
__device__ __forceinline__ float bf2f(unsigned short b) { return __builtin_bit_cast(float, (unsigned)b << 16); }
__device__ __forceinline__ float wave_sum(float v) {
#pragma unroll
    for (int o = 1; o < 64; o <<= 1) v += __shfl_xor(v, o);
    return v;
}
__device__ __forceinline__ float wave_max(float v) {
#pragma unroll
    for (int o = 1; o < 64; o <<= 1) v = fmaxf(v, __shfl_xor(v, o));
    return v;
}
#define XB_TMO      128
#define XB_XCNT(j)  (256  + 64 * (j))
#define XB_XSUB(j)  (1280 + 64 * (j))
#define XB_XGEN(j)  (2304 + 64 * (j))
#define XB_TOP      3328
#define XB_TOPGEN   3392
#define XCD_BAR_WORDS 3456
#define XB_SPIN_CAP (1u << 18)

__device__ __forceinline__ unsigned xb_ld(unsigned* p)              { return __hip_atomic_load(p, __ATOMIC_RELAXED, __HIP_MEMORY_SCOPE_AGENT); }
__device__ __forceinline__ unsigned xb_add(unsigned* p, unsigned v) { return __hip_atomic_fetch_add(p, v, __ATOMIC_RELAXED, __HIP_MEMORY_SCOPE_AGENT); }
__device__ __forceinline__ unsigned xb_xcc_id() { return (unsigned)__builtin_amdgcn_s_getreg((3 << 11) | 20) & 0xFu; }
#define XB_SPIN(cond, bar) do { unsigned _sp = 0; while (cond) { __builtin_amdgcn_s_sleep(1); \
    if ((++_sp & 255u) == 0u) { if (xb_ld(&(bar)[XB_TMO])) break; if (_sp > XB_SPIN_CAP) { atomicAdd(&(bar)[XB_TMO], 1u); break; } } } } while (0)

struct XcdBarrier {
    unsigned* bar; unsigned x;
    volatile LAS unsigned* st;
};

__device__ __forceinline__ XcdBarrier xcd_barrier_post(unsigned* bar, volatile LAS unsigned* st) {
    XcdBarrier b; b.bar = bar; b.x = xb_xcc_id(); b.st = st;
    if (threadIdx.x == 0) (void)xb_add(&bar[XB_XCNT(b.x)], 1u);
    return b;
}
__device__ __forceinline__ void xcd_barrier_complete(unsigned* bar, unsigned x, unsigned& nloc, unsigned& nx) {
    const unsigned G = gridDim.x * gridDim.y * gridDim.z;
    unsigned sum, cnt, mine, sp = 0u;
    for (;;) {
        sum = 0u; cnt = 0u; mine = 0u;
#pragma unroll
        for (unsigned j = 0; j < 16; ++j) { const unsigned c = xb_ld(&bar[XB_XCNT(j)]); sum += c; cnt += (c > 0u) ? 1u : 0u; mine = (j == x) ? c : mine; }
        if (sum == G) break;
        __builtin_amdgcn_s_sleep(1);
        if ((++sp & 255u) == 0u) { if (xb_ld(&bar[XB_TMO])) break; if (sp > XB_SPIN_CAP) { atomicAdd(&bar[XB_TMO], 1u); break; } }
    }
    nloc = mine > 0u ? mine : 1u; nx = cnt > 0u ? cnt : 1u;
}

__device__ __forceinline__ void xcd_barrier(const XcdBarrier& b) {
    asm volatile("s_waitcnt vmcnt(0)" ::: "memory");
    __syncthreads();
    if (threadIdx.x == 0) {
        unsigned* bar = b.bar;
        __builtin_amdgcn_s_waitcnt(0);
        unsigned nloc = b.st[0], nx = b.st[1];
        if (nloc == 0u) { xcd_barrier_complete(bar, b.x, nloc, nx); b.st[0] = nloc; b.st[1] = nx; }
        const unsigned old = xb_add(&bar[XB_XSUB(b.x)], 1u);
        const unsigned gen = old / nloc;
        if (old + 1u == (gen + 1u) * nloc) {
            __builtin_amdgcn_fence(__ATOMIC_RELEASE, "agent");
            asm volatile("s_waitcnt vmcnt(0)" ::: "memory");
            const unsigned og = xb_add(&bar[XB_TOP], 1u);
            const unsigned tg = og / nx;
            if (og + 1u == (tg + 1u) * nx) xb_add(&bar[XB_TOPGEN], 1u);
            else XB_SPIN(xb_ld(&bar[XB_TOPGEN]) == tg, bar);
            __builtin_amdgcn_fence(__ATOMIC_ACQUIRE, "agent");
            xb_add(&bar[XB_XGEN(b.x)], 1u);
            asm volatile("s_waitcnt vmcnt(0)" ::: "memory");
        } else {
            XB_SPIN(xb_ld(&bar[XB_XGEN(b.x)]) == gen, bar);
            __builtin_amdgcn_fence(__ATOMIC_ACQUIRE, "agent");
            asm volatile("s_waitcnt vmcnt(0)" ::: "memory");
        }
    }
    __syncthreads();
}

struct Frame {
    LAS unsigned char* lds; volatile LAS unsigned* MISC; gu32* ctl;
    int tid, lane, wave, vcu, G, bid;
    const float *xp, *xs, *cache_k, *cache_v, *cache_kidx, *state_pool; const int* page_table;
    const float *cp, *cs, *norm_w, *w_ada, *b_ada, *w_in, *qnw, *knw, *w_pool, *pool_scale, *w_out;
    float* out; unsigned char* ws;
#if TEST_MODE == 4 && P3FINE
    unsigned long long* ts; int nst;
#endif
};
#if TEST_MODE == 4 && P3FINE
#define FSTAMP() do { if (blockIdx.x == STAMP_BLK && threadIdx.x == 0) F.ts[F.nst] = __builtin_amdgcn_s_memrealtime(); ++F.nst; } while (0)
#else
#define FSTAMP() do { } while (0)
#endif

__device__ __forceinline__ void p0_ada(Frame& F, int task) {
    const int lane = F.lane, w = F.wave, rl = lane & 15, kq = lane >> 4, n0 = task * 16;
    float bv[32];
    { const float* wp = F.w_ada + (size_t)(w * 128 + 4 * kq) * 3072 + n0 + rl;
#pragma unroll
      for (int i4 = 0; i4 < 8; ++i4)
#pragma unroll
          for (int u = 0; u < 4; ++u) bv[i4 * 4 + u] = wp[(size_t)(16 * i4 + u) * 3072]; }
    f32x4 acc[9];
#pragma unroll
    for (int i3 = 0; i3 < 3; ++i3) {
        f32x4 cv[3][8]; bool valid[3];
#pragma unroll
        for (int ii = 0; ii < 3; ++ii) { const int row = 16 * (3 * i3 + ii) + rl; valid[ii] = row < NR;
            const float* cptr = (row < NB ? F.cp + (size_t)row * DM : F.cs + (size_t)((valid[ii] ? row : NB) - NB) * DM) + w * 128 + 4 * kq;
#pragma unroll
            for (int i4 = 0; i4 < 8; ++i4) cv[ii][i4] = *(const f32x4*)(cptr + 16 * i4); }
#pragma unroll
        for (int ii = 0; ii < 3; ++ii) { const int i = 3 * i3 + ii;
            acc[i] = (f32x4){0.f, 0.f, 0.f, 0.f};
#pragma unroll
            for (int i4 = 0; i4 < 8; ++i4)
#pragma unroll
                for (int u = 0; u < 4; ++u) { const float a = valid[ii] ? pg8::silu1(cv[ii][i4][u]) : 0.f; acc[i] = __builtin_amdgcn_mfma_f32_16x16x4f32(a, bv[i4 * 4 + u], acc[i], 0, 0, 0); } } }
    LAS float* red = (LAS float*)(F.lds + RING_OFF);
#pragma unroll
    for (int i = 0; i < 9; ++i)
#pragma unroll
        for (int e = 0; e < 4; ++e) red[(w * 144 + 16 * i + 4 * kq + e) * 16 + rl] = acc[i][e];
    __syncthreads();
    float* ada = (float*)(F.ws + WS_ADA);
    for (int o = F.tid; o < NR * 16; o += NWAVES * 64) { const int row = o >> 4, col = o & 15; float s = F.b_ada[n0 + col];
#pragma unroll
        for (int ww = 0; ww < 8; ++ww) s += red[(ww * 144 + row) * 16 + col];
        ada[(size_t)row * 3072 + n0 + col] = s; }
    __syncthreads();
}
__device__ __forceinline__ void transpose_item(const float* W, int ldn, int srccol0, int nvalid, bf16* WT, int K, int dstrow0, int k0, LAS float* scr, int lane) {
    float tv[32];
#pragma unroll
    for (int i = 0; i < 32; ++i) { const int kk = 2 * i + (lane >> 5), c = lane & 31; tv[i] = c < nvalid ? W[(size_t)(k0 + kk) * ldn + srccol0 + c] : 0.f; }
#pragma unroll
    for (int i = 0; i < 32; ++i) { const int kk = 2 * i + (lane >> 5), c = lane & 31; scr[kk * 33 + c] = tv[i]; }
    LDS_WAIT(); asm volatile("" ::: "memory");
    const int c = lane & 7;
#pragma unroll
    for (int j = 0; j < 4; ++j) { const int n = (lane >> 3) + 8 * j; const LAS float* s = scr + (8 * c) * 33 + n;
        v4u o; o.x = pk2(s[0 * 33], s[1 * 33]); o.y = pk2(s[2 * 33], s[3 * 33]); o.z = pk2(s[4 * 33], s[5 * 33]); o.w = pk2(s[6 * 33], s[7 * 33]);
        *(GAS v4u*)(WT + (size_t)(dstrow0 + n) * K + k0 + 8 * c) = o; }
    LDS_WAIT(); asm volatile("" ::: "memory");
}
__device__ __forceinline__ int win_col(int pn, int hd, int d) {
    if (pn <= 1) return CQ + (4 * pn + hd) * 64 + d;
    if (pn == 2) return hd < 2 ? CK + hd * 64 + d : CV + (hd - 2) * 64 + d;
    if (pn <= 4) return CQI + (4 * (pn - 3) + hd) * 64 + d;
    if (pn == 5) return hd == 0 ? CKI + d : ((hd == 1 && d < 8) ? CWI + d : -1);
    if (pn <= 7) return CGA + (4 * (pn - 6) + hd) * 64 + d;
    if (pn <= 9) return CU + (4 * (pn - 8) + hd) * 64 + d;
    return CGP + (4 * (pn - 10) + hd) * 64 + d;
}
__device__ __forceinline__ void p0_prologue(Frame& F) {
    LAS float* scr = (LAS float*)(F.lds + RING_OFF + F.wave * 16384);
    const int gw = F.vcu * NWAVES + F.wave, NGW = F.G * NWAVES;
    bf16* WINT = (bf16*)(F.ws + WS_WINT); bf16* WOUTT = (bf16*)(F.ws + WS_WOUTT); bf16* WPOOLT = (bf16*)(F.ws + WS_WPOOLT);
    const bool split = F.G > 192 + 16;
    if (F.bid < 192) p0_ada(F, F.bid);
    if (!split || F.bid >= 192) {
        const int tw0 = split ? (F.bid - 192) * NWAVES + F.wave : gw, tws = split ? (F.G - 192) * NWAVES : NGW;
        for (int it = tw0; it < 2080; it += tws) {
            if (it < 1536) { const int G = it >> 4, kb = it & 15, pn = G >> 3, bj = (G >> 2) & 1, hd = G & 3; const int src = win_col(pn, hd, 32 * bj);
                const int nvalid = src < 0 ? 0 : ((pn == 5 && hd == 1) ? 8 : 32);
                transpose_item(F.w_in, NIN, src < 0 ? 0 : src, nvalid, WINT, 1024, 32 * G, 64 * kb, scr, F.lane); }
            else if (it < 2048) { const int r = it - 1536, G = r >> 4, kb = r & 15; transpose_item(F.w_out, 1024, 32 * G, 32, WOUTT, 1024, 32 * G, 64 * kb, scr, F.lane); }
            else { const int r = it - 2048, g = r >> 3, kb = (r >> 2) & 1, G = r & 3; transpose_item(F.w_pool + (size_t)g * 16384, 128, 32 * G, 32, WPOOLT + (size_t)g * 16384, 128, 32 * G, 64 * kb, scr, F.lane); }
        }
    }
    { const int nf4 = DECB * 1792; f32x4 t4[2]; int ix[2];
#pragma unroll
      for (int k = 0; k < 2; ++k) { ix[k] = gw * 64 + F.lane + k * NGW * 64; if (ix[k] < nf4) { const int s = ix[k] / 1792, i = ix[k] - s * 1792; t4[k] = *(const f32x4*)(F.state_pool + (size_t)s * 7680 + 512 + 4 * i); } }
#pragma unroll
      for (int k = 0; k < 2; ++k) { if (ix[k] < nf4) { const int s = ix[k] / 1792, i = ix[k] - s * 1792; *(f32x4*)(F.out + O_PS + (size_t)s * 7680 + 4 * i) = t4[k]; } }
      for (int ixx = gw * 64 + F.lane + 2 * NGW * 64; ixx < nf4; ixx += NGW * 64) { const int s = ixx / 1792, i = ixx - s * 1792; *(f32x4*)(F.out + O_PS + (size_t)s * 7680 + 4 * i) = *(const f32x4*)(F.state_pool + (size_t)s * 7680 + 512 + 4 * i); } }
}

template <int N, bool SAME_ADA> __device__ __forceinline__ void norm_rows(Frame& F, const float* x0, const float* adarow0, int adastride, bf16* o0) {
    f32x4 v[N][4]; float s2[N];
#pragma unroll
    for (int i = 0; i < N; ++i) { const GAS f32x4* xr = (const GAS f32x4*)(x0 + (size_t)i * DM) + F.lane;
#pragma unroll
        for (int j = 0; j < 4; ++j) v[i][j] = xr[64 * j]; }
#pragma unroll
    for (int i = 0; i < N; ++i) { s2[i] = 0.f;
#pragma unroll
        for (int j = 0; j < 4; ++j) s2[i] += (v[i][j].x * v[i][j].x + v[i][j].y * v[i][j].y) + (v[i][j].z * v[i][j].z + v[i][j].w * v[i][j].w); }
#pragma unroll
    for (int o = 1; o < 64; o <<= 1) {
#pragma unroll
        for (int i = 0; i < N; ++i) s2[i] += __shfl_xor(s2[i], o); }
#pragma unroll
    for (int j = 0; j < 4; ++j) { const int col = 4 * F.lane + 256 * j; const f32x4 nw = *(const f32x4*)(F.norm_w + col);
        f32x4 gq, sh;
        if (SAME_ADA) { sh = *(const f32x4*)(adarow0 + col); gq = nw * (*(const f32x4*)(adarow0 + 1024 + col) + 1.0f); }
#pragma unroll
        for (int i = 0; i < N; ++i) {
            if (!SAME_ADA) { const float* ar = adarow0 + (size_t)i * adastride; sh = *(const f32x4*)(ar + col); gq = nw * (*(const f32x4*)(ar + 1024 + col) + 1.0f); }
            const float rstd = 1.0f / sqrtf(s2[i] * (1.0f / DM) + EPS);
            const f32x4 o = v[i][j] * rstd * gq + sh;
            ((GAS unsigned long long*)(o0 + (size_t)i * DM))[F.lane + 64 * j] = (unsigned long long)pk2(o.x, o.y) | ((unsigned long long)pk2(o.z, o.w) << 32); } }
}
__device__ __forceinline__ void skinny_core(const bf16* arow, const bf16* b0, const bf16* b1, const bf16* b2, const bf16* b3, f32x4 (&acc)[4]) {
#pragma unroll
    for (int j = 0; j < 4; ++j) acc[j] = (f32x4){0.f, 0.f, 0.f, 0.f};
    bf16x8 fa[2][4], fb[2][4][4];
#define SK_LOAD(buf, kb) do { _Pragma("unroll") for (int q_ = 0; q_ < 4; ++q_) { const int ko_ = 32 * (4 * (kb) + q_); fa[buf][q_] = *(const bf16x8*)(arow + ko_); \
        fb[buf][q_][0] = *(const bf16x8*)(b0 + ko_); fb[buf][q_][1] = *(const bf16x8*)(b1 + ko_); fb[buf][q_][2] = *(const bf16x8*)(b2 + ko_); fb[buf][q_][3] = *(const bf16x8*)(b3 + ko_); } } while (0)
#define SK_MMA(buf) do { _Pragma("unroll") for (int q_ = 0; q_ < 4; ++q_) { _Pragma("unroll") for (int j_ = 0; j_ < 4; ++j_) acc[j_] = __builtin_amdgcn_mfma_f32_16x16x32_bf16(fa[buf][q_], fb[buf][q_][j_], acc[j_], 0, 0, 0); } } while (0)
    SK_LOAD(0, 0);
#pragma unroll
    for (int kb = 0; kb < 8; kb += 2) {
        SK_LOAD(1, kb + 1); SK_MMA(0);
        if (kb + 2 < 8) SK_LOAD(0, kb + 2);
        SK_MMA(1);
    }
#undef SK_LOAD
#undef SK_MMA
}
__device__ __forceinline__ void sample_inproj(Frame& F, int pn, int hd) {
    const int lane = F.lane, w = F.wave, rl = lane & 15, kq = lane >> 4;
    const bf16* HS = (const bf16*)(F.ws + WS_HS);
    const bf16* WINT = (const bf16*)(F.ws + WS_WINT);
    const bf16* bb = WINT + (size_t)(256 * pn + 32 * hd + rl) * 1024 + 8 * kq;
    f32x4 acc[4];
    skinny_core(HS + (size_t)(16 * w + rl) * 1024 + 8 * kq, bb, bb + 16 * 1024, bb + 128 * 1024, bb + 144 * 1024, acc);
    float* out = F.out;
    if (pn <= 1 || (pn == 2 && hd < 2)) {
        const float* nwp = pn <= 1 ? F.qnw : F.knw; const float sc = pn <= 1 ? C2 : 1.0f;
#pragma unroll
        for (int e = 0; e < 4; ++e) { float ss = 0.f;
#pragma unroll
            for (int j = 0; j < 4; ++j) ss += acc[j][e] * acc[j][e];
            ss += __shfl_xor(ss, 1); ss += __shfl_xor(ss, 2); ss += __shfl_xor(ss, 4); ss += __shfl_xor(ss, 8);
            const float rstd = 1.0f / sqrtf(ss * (1.0f / 64.0f) + EPS); const int s = 16 * w + 4 * kq + e; const size_t m = (size_t)(MP + s);
#pragma unroll
            for (int j = 0; j < 4; ++j) { const int d = 16 * j + rl; const float o = acc[j][e] * rstd * nwp[d] * sc;
                if (pn <= 1) ((bf16*)(F.ws + WS_Q))[m * 512 + (4 * pn + hd) * 64 + d] = (bf16)f2bf(o);
                else { out[O_KS + (size_t)s * 128 + hd * 64 + d] = o; ((bf16*)(F.ws + WS_KB))[m * 128 + hd * 64 + d] = (bf16)f2bf(o); } } }
        return;
    }
    if (pn == 5 && hd == 1) {
        if (rl < 8) {
#pragma unroll
            for (int e = 0; e < 4; ++e) { const int s = 16 * w + 4 * kq + e; ((float*)(F.ws + WS_WI))[(size_t)(MP + s) * 8 + rl] = acc[0][e] * WI_SCALE; } }
        return;
    }
    bf16* dst; int ld, cb; float* fo = nullptr; int fld = 0; bool act = false;
    if (pn == 2) { dst = (bf16*)(F.ws + WS_VB); ld = 128; cb = (hd - 2) * 64; fo = out + O_VS + cb; fld = 128; }
    else if (pn <= 4) { dst = (bf16*)(F.ws + WS_QI); ld = 512; cb = (4 * (pn - 3) + hd) * 64; }
    else if (pn == 5) { dst = (bf16*)(F.ws + WS_KI); ld = 64; cb = 0; fo = out + O_KIS; fld = 64; }
    else if (pn <= 7) { dst = (bf16*)(F.ws + WS_GA); ld = 512; cb = (4 * (pn - 6) + hd) * 64; act = true; }
    else if (pn <= 9) { dst = (bf16*)(F.ws + WS_U); ld = 512; cb = (4 * (pn - 8) + hd) * 64; fo = out + O_PS + 14 * 512 + cb; fld = 15 * 512; }
    else { dst = (bf16*)(F.ws + WS_GP); ld = 512; cb = (4 * (pn - 10) + hd) * 64; act = true; }
#pragma unroll
    for (int e = 0; e < 4; ++e) { const int s = 16 * w + 4 * kq + e; const size_t m = (size_t)(MP + s);
#pragma unroll
        for (int j = 0; j < 4; ++j) { const int d = 16 * j + rl; float o = acc[j][e]; if (act) o = pg8::silu1(o);
            dst[m * ld + cb + d] = (bf16)f2bf(o);
            if (fo) fo[(size_t)s * fld + d] = o; } }
}
__device__ __forceinline__ void p1_norm(Frame& F) {
    const float* ada = (const float*)(F.ws + WS_ADA); bf16* HB = (bf16*)(F.ws + WS_HB); bf16* HS = (bf16*)(F.ws + WS_HS);
    const int gw = F.vcu * NWAVES + F.wave, NGW = F.G * NWAVES;
    for (int ch = gw; ch < MP / 4 + DECB / 2; ch += NGW) {
        if (ch < MP / 4) { const int m = 4 * ch; norm_rows<4, true>(F, F.xp + (size_t)m * DM, ada + (size_t)(m >> 11) * 3072, 0, HB + (size_t)m * DM); }
        else { const int s = 2 * (ch - MP / 4); norm_rows<2, false>(F, F.xs + (size_t)s * DM, ada + (size_t)(NB + s) * 3072, 3072, HS + (size_t)s * DM); } }
}
__device__ __forceinline__ void p2_sample(Frame& F) {
    const int pn = F.bid >> 2, hd = F.bid & 3;
    if (F.bid < 48 && !(pn == 5 && hd >= 2)) sample_inproj(F, pn, hd);
}

constexpr int P3_KEYS = 0;
constexpr int P3_BM = 132096;
constexpr int P3_WQ = 136192;
constexpr int P3_QI = 136704;
constexpr int P3_AI_HS = 144, P3_AI_RS = 1152;
constexpr int P3_AQ_HS = 160, P3_AQ_RS = 1408;
constexpr int P3_QL = 159232;
constexpr int P3_XM = 159232;
constexpr int P3_VW = 0, P3_VWB = 4096;

__device__ __forceinline__ float relu_s(float x) { return __builtin_amdgcn_fmed3f(x, 0.0f, __builtin_inff()); }
__device__ __forceinline__ unsigned f2key(float f) { unsigned u = __float_as_uint(f); if (f == 0.0f) u = 0u; return (u & 0x80000000u) ? ~u : (u | 0x80000000u); }
__device__ __forceinline__ float key2f(unsigned k) { return __uint_as_float((k & 0x80000000u) ? (k ^ 0x80000000u) : ~k); }

__device__ __forceinline__ unsigned half_reduce_add(unsigned v) {
    v += (unsigned)__builtin_amdgcn_update_dpp(0, (int)v, 0xB1, 0xF, 0xF, true);
    v += (unsigned)__builtin_amdgcn_update_dpp(0, (int)v, 0x4E, 0xF, 0xF, true);
    v += (unsigned)__builtin_amdgcn_update_dpp(0, (int)v, 0x141, 0xF, 0xF, true);
    v += (unsigned)__builtin_amdgcn_update_dpp(0, (int)v, 0x140, 0xF, 0xF, true);
    v += (unsigned)__builtin_amdgcn_ds_swizzle((int)v, 0x401F);
    return v;
}
__device__ __forceinline__ float probit_f(float p) {
    const float pp = p < 0.5f ? p : 1.0f - p; const float t = sqrtf(-2.0f * __logf(pp));
    const float z = t - (2.515517f + t * (0.802853f + t * 0.010328f)) * __builtin_amdgcn_rcpf(1.0f + t * (1.432788f + t * (0.189269f + t * 0.001308f)));
    return p < 0.5f ? -z : z;
}
__device__ __forceinline__ unsigned half_reduce_min(unsigned v) {
    v = min(v, (unsigned)__builtin_amdgcn_update_dpp(0, (int)v, 0xB1, 0xF, 0xF, true)); v = min(v, (unsigned)__builtin_amdgcn_update_dpp(0, (int)v, 0x4E, 0xF, 0xF, true));
    v = min(v, (unsigned)__builtin_amdgcn_update_dpp(0, (int)v, 0x141, 0xF, 0xF, true)); v = min(v, (unsigned)__builtin_amdgcn_update_dpp(0, (int)v, 0x140, 0xF, 0xF, true));
    v = min(v, (unsigned)__builtin_amdgcn_ds_swizzle((int)v, 0x401F)); return v; }
__device__ __forceinline__ unsigned half_reduce_max(unsigned v) {
    v = max(v, (unsigned)__builtin_amdgcn_update_dpp(0, (int)v, 0xB1, 0xF, 0xF, true)); v = max(v, (unsigned)__builtin_amdgcn_update_dpp(0, (int)v, 0x4E, 0xF, 0xF, true));
    v = max(v, (unsigned)__builtin_amdgcn_update_dpp(0, (int)v, 0x141, 0xF, 0xF, true)); v = max(v, (unsigned)__builtin_amdgcn_update_dpp(0, (int)v, 0x140, 0xF, 0xF, true));
    v = max(v, (unsigned)__builtin_amdgcn_ds_swizzle((int)v, 0x401F)); return v; }
__device__ __forceinline__ unsigned wave_reduce_add_u(unsigned v) {
    v += (unsigned)__builtin_amdgcn_update_dpp(0, (int)v, 0xB1, 0xF, 0xF, true); v += (unsigned)__builtin_amdgcn_update_dpp(0, (int)v, 0x4E, 0xF, 0xF, true);
    v += (unsigned)__builtin_amdgcn_update_dpp(0, (int)v, 0x141, 0xF, 0xF, true); v += (unsigned)__builtin_amdgcn_update_dpp(0, (int)v, 0x140, 0xF, 0xF, true);
    return ((unsigned)__builtin_amdgcn_readlane((int)v, 0) + (unsigned)__builtin_amdgcn_readlane((int)v, 16)) + ((unsigned)__builtin_amdgcn_readlane((int)v, 32) + (unsigned)__builtin_amdgcn_readlane((int)v, 48)); }
__device__ __forceinline__ float kq_max(float v) {
    auto a = __builtin_amdgcn_permlane16_swap(__float_as_uint(v), __float_as_uint(v), false, false); v = fmaxf(__uint_as_float(a[0]), __uint_as_float(a[1]));
    auto b = __builtin_amdgcn_permlane32_swap(__float_as_uint(v), __float_as_uint(v), false, false); return fmaxf(__uint_as_float(b[0]), __uint_as_float(b[1])); }
__device__ __forceinline__ float kq_sum(float v) {
    auto a = __builtin_amdgcn_permlane16_swap(__float_as_uint(v), __float_as_uint(v), false, false); v = __uint_as_float(a[0]) + __uint_as_float(a[1]);
    auto b = __builtin_amdgcn_permlane32_swap(__float_as_uint(v), __float_as_uint(v), false, false); return __uint_as_float(b[0]) + __uint_as_float(b[1]); }
__device__ __forceinline__ unsigned wave_reduce_min_u(unsigned v) { v = half_reduce_min(v); return min((unsigned)__builtin_amdgcn_readlane((int)v, 0), (unsigned)__builtin_amdgcn_readlane((int)v, 32)); }
__device__ __forceinline__ unsigned wave_reduce_max_u(unsigned v) { v = half_reduce_max(v); return max((unsigned)__builtin_amdgcn_readlane((int)v, 0), (unsigned)__builtin_amdgcn_readlane((int)v, 32)); }

struct P3Pre { v4u qi[2]; v4u qq[2]; float wqv; };
__device__ __forceinline__ void p3_prefetch(Frame& F, int b, int qt, P3Pre& pre) {
    const int tid = F.tid; const size_t mb = (size_t)b * SEQ; const int t0 = 16 * qt;
    const bf16* QI = (const bf16*)(F.ws + WS_QI); const bf16* Qg = (const bf16*)(F.ws + WS_Q);
#pragma unroll
    for (int k = 0; k < 2; ++k) { const int i = tid + 512 * k, row = i >> 6, ch = i & 63;
        pre.qi[k] = *(const v4u*)(QI + (mb + t0 + row) * 512 + ch * 8); pre.qq[k] = *(const v4u*)(Qg + (mb + t0 + row) * 512 + ch * 8); }
    pre.wqv = ((const float*)(F.ws + WS_WI))[(mb + t0 + ((tid & 127) >> 3)) * 8 + (tid & 7)];
}
__device__ __forceinline__ void p3_prompt_item(Frame& F, int b, int qt, P3Pre& pre, bool has_next, int nb, int nqt) {
    int tid_o_ = F.tid; asm volatile("" : "+v"(tid_o_));
    const int tid = tid_o_, lane = tid & 63, w = F.wave, r = lane & 31, hh = lane >> 5;
    const int t0 = 16 * qt, L = t0 + 16, nkt32 = (L + 31) >> 5, nkt64 = (L + 63) >> 6;
    const size_t mb = (size_t)b * SEQ;
    LAS unsigned* bm = (LAS unsigned*)(F.lds + P3_BM);
    LAS float* wq = (LAS float*)(F.lds + P3_WQ);
    LAS unsigned* keys = (LAS unsigned*)(F.lds + P3_KEYS);
    v4u qreg[2] = {pre.qq[0], pre.qq[1]};
    if (tid < 128) wq[tid] = pre.wqv;
#pragma unroll
    for (int k = 0; k < 2; ++k) { const int i = tid + 512 * k, row = i >> 6, ch = i & 63; *(LAS v4u*)(F.lds + P3_QI + row * P3_AI_RS + (ch >> 3) * P3_AI_HS + (ch & 7) * 16) = pre.qi[k]; }
    bf16x8 bb[3][4];
    { const bf16* KI_ = (const bf16*)(F.ws + WS_KI); const int ns_ = (nkt32 - w + 7) >> 3;
      if (0 < ns_) { const bf16* kp_ = KI_ + (mb + 32 * w + r) * 64 + 8 * hh;
#pragma unroll
          for (int ks_ = 0; ks_ < 4; ++ks_) bb[0][ks_] = *(const bf16x8*)(kp_ + 16 * ks_); }
      if (1 < ns_) { const bf16* kp_ = KI_ + (mb + 32 * (w + 8) + r) * 64 + 8 * hh;
#pragma unroll
          for (int ks_ = 0; ks_ < 4; ++ks_) bb[1][ks_] = *(const bf16x8*)(kp_ + 16 * ks_); } }
    __syncthreads();
    { LAS unsigned short* ql = (LAS unsigned short*)(F.lds + P3_QL);
#pragma unroll
      for (int k = 0; k < 2; ++k) { const int i = tid + 512 * k, qq = i >> 6, d = i & 63; float s = 0.f;
#pragma unroll
          for (int h = 0; h < 8; ++h) s += wq[qq * 8 + h] * bf2f(*(const LAS unsigned short*)(F.lds + P3_QI + qq * P3_AI_RS + h * P3_AI_HS + d * 2));
          ql[qq * 64 + d] = (unsigned short)f2bf(s); } }
    __syncthreads();
    FSTAMP();
    for (int rep1_ = 0; rep1_ < REP_S1; ++rep1_) {
        const bf16* KI = (const bf16*)(F.ws + WS_KI);
        const int ns = (nkt32 - w + 7) >> 3;
#define P3_LDK(slot) do { const bf16* kp_ = KI + (mb + 32 * (w + 8 * (slot)) + r) * 64 + 8 * hh; \
        _Pragma("unroll") for (int ks_ = 0; ks_ < 4; ++ks_) bb[(slot) % 3][ks_] = *(const bf16x8*)(kp_ + 16 * ks_); } while (0)
        const int arow = (2 * ((r >> 2) & 1) + (r >> 4)) * P3_AI_RS + ((r & 3) + 4 * ((r >> 3) & 1)) * P3_AI_HS + 16 * hh;
        const LAS unsigned char* qib = F.lds + P3_QI;
        const int lq_ = 4 * ((((r & 3) + 4 * (r >> 3)) >> 1) & 3) + 2 * ((r >> 2) & 1) + (r & 1);
        const LAS unsigned char* qlb = F.lds + P3_QL + lq_ * 128 + 16 * hh;
#define P3_MM(ACC, a, s) do { _Pragma("unroll") for (int e_ = 0; e_ < 16; ++e_) ACC[e_] = 0.f; \
        _Pragma("unroll") for (int ks_ = 0; ks_ < 4; ++ks_) { const bf16x8 af_ = *(const LAS bf16x8*)(qs_ + 4 * (a) * P3_AI_RS + arow + 32 * ks_); \
            ACC = __builtin_amdgcn_mfma_f32_32x32x16_bf16(af_, bb[(s) % 3][ks_], ACC, 0, 0, 0); } } while (0)
#define P3_EPI(ACC, a, s, u_) do { _Pragma("unroll") for (int j2_ = 0; j2_ < 2; ++j2_) { const int qq_ = 4 * (a) + 2 * hh + j2_; \
        const LAS f32x4* wp_ = (const LAS f32x4*)(wq + qq_ * 8); const f32x4 w0_ = wp_[0], w1_ = wp_[1]; \
        float sc_ = accL[2 * (a) + j2_]; sc_ = fmaf(w0_[0], fabsf(ACC[8 * j2_ + 0]), sc_); sc_ = fmaf(w0_[1], fabsf(ACC[8 * j2_ + 1]), sc_); sc_ = fmaf(w0_[2], fabsf(ACC[8 * j2_ + 2]), sc_); sc_ = fmaf(w0_[3], fabsf(ACC[8 * j2_ + 3]), sc_); \
        sc_ = fmaf(w1_[0], fabsf(ACC[8 * j2_ + 4]), sc_); sc_ = fmaf(w1_[1], fabsf(ACC[8 * j2_ + 5]), sc_); sc_ = fmaf(w1_[2], fabsf(ACC[8 * j2_ + 6]), sc_); sc_ = fmaf(w1_[3], fabsf(ACC[8 * j2_ + 7]), sc_); \
        keys[qq_ * 2048 + 32 * (w + 8 * (s)) + r] = f2key(sc_); } } while (0)
#define P3_MML(ACC, s) do { _Pragma("unroll") for (int e_ = 0; e_ < 16; ++e_) ACC[e_] = 0.f; \
        _Pragma("unroll") for (int ks_ = 0; ks_ < 4; ++ks_) { bf16x8 af_ = (bf16x8){0, 0, 0, 0, 0, 0, 0, 0}; if (r < 16) af_ = *(const LAS bf16x8*)(qlb + zo_ + 32 * ks_); \
            ACC = __builtin_amdgcn_mfma_f32_32x32x16_bf16(af_, bb[(s) % 3][ks_], ACC, 0, 0, 0); } } while (0)
#pragma unroll 1
        for (int s0 = 0; s0 < ns; s0 += 3) {
#pragma unroll
            for (int u = 0; u < 3; ++u) { const int s = s0 + u;
                if (s < ns) {
                    if (s + 2 < ns) { const bf16* kp_ = KI + (mb + 32 * (w + 8 * (s + 2)) + r) * 64 + 8 * hh;
#pragma unroll
                        for (int ks_ = 0; ks_ < 4; ++ks_) bb[(u + 2) % 3][ks_] = *(const bf16x8*)(kp_ + 16 * ks_); }
                    int zo_ = 0; asm volatile("" : "+v"(zo_));
                    const LAS unsigned char* qs_ = qib + zo_;
                    f32x16 accA, accB, accL;
                    P3_MML(accL, u);
                    P3_MM(accA, 0, u); P3_MM(accB, 1, u);
                    P3_EPI(accA, 0, s, u); P3_MM(accA, 2, u);
                    P3_EPI(accB, 1, s, u); P3_MM(accB, 3, u);
                    P3_EPI(accA, 2, s, u); P3_EPI(accB, 3, s, u);
                }
            }
        }
#undef P3_MM
#undef P3_MML
#undef P3_EPI
#undef P3_LDK
    }
    __syncthreads();
    FSTAMP();
    {
#pragma unroll
      for (int k = 0; k < 2; ++k) { const int i = tid + 512 * k, row = i >> 6, ch = i & 63; *(LAS v4u*)(F.lds + P3_QI + row * P3_AQ_RS + (ch >> 3) * P3_AQ_HS + (ch & 7) * 16) = qreg[k]; } }
    bf16x8 kf0[2][2]; v4u vr0[4];
    { const int g_ = w & 1, kq4_ = w >> 1, j_ = lane & 15, kq_ = lane >> 4;
      if (kq4_ < nkt32) {
#pragma unroll
          for (int c = 0; c < 2; ++c)
#pragma unroll
              for (int ks = 0; ks < 2; ++ks) kf0[c][ks] = *(const bf16x8*)((const bf16*)(F.ws + WS_KB) + (mb + 32 * kq4_ + 16 * c + j_) * 128 + g_ * 64 + 32 * ks + 8 * kq_);
#pragma unroll
          for (int i = 0; i < 4; ++i) vr0[i] = *(const v4u*)((const bf16*)(F.ws + WS_VB) + (mb + 32 * kq4_ + 8 * i + (lane >> 3)) * 128 + g_ * 64 + (lane & 7) * 8); } }
    for (int rep2_ = 0; rep2_ < REP_S2; ++rep2_) {
        int lane_ = F.lane; asm volatile("" : "+v"(lane_));
#define lane lane_
        const int qx0 = 2 * w, tq0 = t0 + qx0;
        unsigned sel0, sel1;
        if (t0 + 16 <= 256) {
            sel0 = 0u; sel1 = 0u;
#pragma unroll
            for (int jj = 0; jj < 32; ++jj) { sel0 |= (64 * jj + lane <= tq0) ? (1u << jj) : 0u; sel1 |= (64 * jj + lane <= tq0 + 1) ? (1u << jj) : 0u; }
        } else {
            unsigned x[32], y[32];
#pragma unroll
            for (int jj = 0; jj < 32; ++jj) { const int l = 64 * jj + lane; x[jj] = (l <= tq0) ? keys[qx0 * 2048 + l] : 0u; y[jj] = (l <= tq0 + 1) ? keys[(qx0 + 1) * 2048 + l] : 0u; }
#pragma unroll
            for (int st = 0; st < 5; ++st) { const int j = 16 >> st; const unsigned m = st == 0 ? 0x0000ffffu : st == 1 ? 0x00ff00ffu : st == 2 ? 0x0f0f0f0fu : st == 3 ? 0x33333333u : 0x55555555u;
#pragma unroll
                for (int k = 0; k < 32; ++k) if (!(k & j)) { const unsigned t_ = ((x[k] >> j) ^ x[k + j]) & m; x[k] ^= t_ << j; x[k + j] ^= t_;
                    const unsigned u_ = ((y[k] >> j) ^ y[k + j]) & m; y[k] ^= u_ << j; y[k + j] ^= u_; } }
            unsigned cur0 = 0xffffffffu, gt0 = 0u, cur1 = 0xffffffffu, gt1 = 0u; int ab0 = 0, ab1 = 0;
#pragma unroll
            for (int b = 31; b >= 0; --b) { const unsigned c0 = cur0 & x[b], c1 = cur1 & y[b];
                const unsigned pk = wave_reduce_add_u((unsigned)__popc(c0) | ((unsigned)__popc(c1) << 16)); const int n0 = (int)(pk & 0xffffu), n1 = (int)(pk >> 16);
                if (ab0 + n0 >= 256) cur0 = c0; else { ab0 += n0; gt0 |= c0; cur0 &= ~x[b]; }
                if (ab1 + n1 >= 256) cur1 = c1; else { ab1 += n1; gt1 |= c1; cur1 &= ~y[b]; } }
            const unsigned pke = wave_reduce_add_u((unsigned)__popc(cur0) | ((unsigned)__popc(cur1) << 16));
            const unsigned long long lt = (1ull << lane) - 1ull;
            { int need = 256 - ab0; if ((int)(pke & 0xffffu) == need) sel0 = gt0 | cur0;
              else { sel0 = gt0;
                for (int jj = 0; jj < 32; ++jj) { const unsigned long long meq = __ballot((cur0 >> jj) & 1u);
                    if (((cur0 >> jj) & 1u) && __popcll(meq & lt) < need) sel0 |= 1u << jj;
                    const int pc_ = __popcll(meq); need = need > pc_ ? need - pc_ : 0; } } }
            { int need = 256 - ab1; if ((int)(pke >> 16) == need) sel1 = gt1 | cur1;
              else { sel1 = gt1;
                for (int jj = 0; jj < 32; ++jj) { const unsigned long long meq = __ballot((cur1 >> jj) & 1u);
                    if (((cur1 >> jj) & 1u) && __popcll(meq & lt) < need) sel1 |= 1u << jj;
                    const int pc_ = __popcll(meq); need = need > pc_ ? need - pc_ : 0; } } }
        }
#pragma unroll
        for (int jj = 0; jj < 32; ++jj) { const unsigned long long b0 = __ballot((sel0 >> jj) & 1u), b1 = __ballot((sel1 >> jj) & 1u);
            if (lane == 0) { bm[qx0 * 64 + 2 * jj] = (unsigned)b0; bm[qx0 * 64 + 2 * jj + 1] = (unsigned)(b0 >> 32); bm[(qx0 + 1) * 64 + 2 * jj] = (unsigned)b1; bm[(qx0 + 1) * 64 + 2 * jj + 1] = (unsigned)(b1 >> 32); } }
#undef lane
    }
    __syncthreads();
#if TEST_MODE
    { unsigned* dbg = (unsigned*)(F.ws + WS_DBG_BM) + (mb + t0) * 64; for (int i = tid; i < 1024; i += NWAVES * 64) dbg[i] = bm[i]; }
#endif
    FSTAMP();
    for (int rep4_ = 0; rep4_ < REP_S4; ++rep4_) {
        int l4_ = lane; asm volatile("" : "+v"(l4_));
        const int g = w & 1, kq4 = w >> 1, j = l4_ & 15, kq = l4_ >> 4;
        const bf16* Q = (const bf16*)(F.ws + WS_Q); const bf16* KB = (const bf16*)(F.ws + WS_KB); const bf16* VB = (const bf16*)(F.ws + WS_VB);
        const LAS unsigned char* qlb = F.lds + P3_QI + (j >> 2) * P3_AQ_RS + (4 * g + (j & 3)) * P3_AQ_HS + 16 * kq;
        bf16x8 qf[4][2];
#pragma unroll
        for (int rb = 0; rb < 4; ++rb)
#pragma unroll
            for (int ks = 0; ks < 2; ++ks) qf[rb][ks] = *(const LAS bf16x8*)(qlb + 4 * rb * P3_AQ_RS + 64 * ks);
        f32x4 o[4][4];
#pragma unroll
        for (int dt = 0; dt < 4; ++dt)
#pragma unroll
            for (int rb = 0; rb < 4; ++rb) o[dt][rb] = (f32x4){0.f, 0.f, 0.f, 0.f};
        float mref[4], lsum[4]; f32x4 negm[4];
#pragma unroll
        for (int rb = 0; rb < 4; ++rb) { mref[rb] = 0.f; lsum[rb] = 0.f; negm[rb] = (f32x4){0.f, 0.f, 0.f, 0.f}; }
        const int ntw = (nkt32 - kq4 + 3) >> 2;
        LAS unsigned char* vst = F.lds + P3_VW + w * (3 * P3_VWB);
        bf16x8 kf[2][2];
        const bf16* kgp = KB + (mb + j) * 128 + g * 64 + 8 * kq;
        const bf16* vgp = VB + (mb + (l4_ >> 3)) * 128 + g * 64 + (l4_ & 7) * 8;
#define P4_LOADK(dst, kt_) do { _Pragma("unroll") for (int c_ = 0; c_ < 2; ++c_) _Pragma("unroll") for (int ks_ = 0; ks_ < 2; ++ks_) dst[c_][ks_] = *(const bf16x8*)(kgp + (size_t)(32 * (kt_) + 16 * c_) * 128 + 32 * ks_); } while (0)
        const unsigned vst_u = (unsigned)(size_t)vst;
#define P4_DMAV(kt_, buf_) do { _Pragma("unroll") for (int i_ = 0; i_ < 4; ++i_) { unsigned keep_; const void* gs_ = (const void*)(vgp + (size_t)(32 * (kt_) + 8 * i_) * 128); \
        const unsigned ld_ = (unsigned)__builtin_amdgcn_readfirstlane((int)(vst_u + (buf_) * P3_VWB + i_ * 1024)); \
        asm volatile("s_mov_b32 %0, m0\n\ts_mov_b32 m0, %2\n\ts_nop 0\n\tglobal_load_lds_dwordx4 %1, off\n\ts_mov_b32 m0, %0" : "=&s"(keep_) : "v"(gs_), "s"(ld_) : "memory"); } } while (0)
        if (ntw > 0) {
#pragma unroll
            for (int c = 0; c < 2; ++c) { kf[c][0] = kf0[c][0]; kf[c][1] = kf0[c][1]; }
#pragma unroll
            for (int i = 0; i < 4; ++i) *(LAS v4u*)(vst + i * 1024 + l4_ * 16) = vr0[i]; }
        if (ntw > 1) { P4_DMAV(kq4 + 4, 1); }
        int vb_cur = 0;
#if TEST_MODE == 5
        unsigned long long tacc_[5] = {0, 0, 0, 0, 0}; unsigned long long tprev_ = __builtin_amdgcn_s_memtime();
#define TSEC(i) do { __builtin_amdgcn_sched_barrier(0); const unsigned long long tn_ = __builtin_amdgcn_s_memtime(); tacc_[i] += tn_ - tprev_; tprev_ = tn_; __builtin_amdgcn_sched_barrier(0); } while (0)
#else
#define TSEC(i) do { } while (0)
#endif
        for (int ti = 0; ti < ntw; ++ti) {
            const int kt = kq4 + 4 * ti;
            TSEC(4);
            asm volatile("s_waitcnt vmcnt(0)" ::: "memory");
            const int vb_n2 = vb_cur == 0 ? 2 : vb_cur - 1;
            if (ti + 2 < ntw) { P4_DMAV(kt + 8, vb_n2); }
            TSEC(0);
            f32x4 sa[2][4];
#pragma unroll
            for (int c = 0; c < 2; ++c)
#pragma unroll
                for (int ks = 0; ks < 2; ++ks)
#pragma unroll
                    for (int rb = 0; rb < 4; ++rb) sa[c][rb] = __builtin_amdgcn_mfma_f32_16x16x32_bf16(kf[c][ks], qf[rb][ks], ks == 0 ? negm[rb] : sa[c][rb], 0, 0, 0);
            if (ti + 1 < ntw) { P4_LOADK(kf, kt + 4); }
            TSEC(1);
            float tmax[4];
#pragma unroll
            for (int rb = 0; rb < 4; ++rb) { const int wd = (int)(bm[(4 * rb + (j >> 2)) * 64 + kt] >> (4 * kq)); float tm = -INFINITY;
#pragma unroll
                for (int c = 0; c < 2; ++c)
#pragma unroll
                    for (int e = 0; e < 4; ++e) { const unsigned keep = (unsigned)__builtin_amdgcn_sbfe(wd, 16 * c + e, 1);
                        const float v = __uint_as_float((__float_as_uint(sa[c][rb][e]) & keep) | (0xff800000u & ~keep)); sa[c][rb][e] = v; tm = fmaxf(tm, v); }
                tmax[rb] = tm; }
#pragma unroll
            for (int rb = 0; rb < 4; ++rb) tmax[rb] = kq_max(tmax[rb]);
            if (ti == 0 || __any(tmax[0] > 0.f || tmax[1] > 0.f || tmax[2] > 0.f || tmax[3] > 0.f)) {
#pragma unroll
                for (int rb = 0; rb < 4; ++rb) { const float dl = (ti == 0) ? ((tmax[rb] == -INFINITY) ? 0.f : tmax[rb]) : fmaxf(tmax[rb], 0.f); const float alpha = __builtin_amdgcn_exp2f(-dl); mref[rb] += dl; lsum[rb] *= alpha;
                    negm[rb] = (f32x4){-mref[rb], -mref[rb], -mref[rb], -mref[rb]};
#pragma unroll
                    for (int c = 0; c < 2; ++c) sa[c][rb] -= dl;
#pragma unroll
                    for (int dt = 0; dt < 4; ++dt) o[dt][rb] *= alpha; } }
            bf16x8 pf[4];
#pragma unroll
            for (int rb = 0; rb < 4; ++rb) { float ps = 0.f;
#pragma unroll
                for (int c = 0; c < 2; ++c)
#pragma unroll
                    for (int e = 0; e < 4; ++e) { const float p = __builtin_amdgcn_exp2f(sa[c][rb][e]); sa[c][rb][e] = p; ps += p; }
                lsum[rb] += ps;
                v4u pw; pw.x = pk2(sa[0][rb][0], sa[0][rb][1]); pw.y = pk2(sa[0][rb][2], sa[0][rb][3]); pw.z = pk2(sa[1][rb][0], sa[1][rb][1]); pw.w = pk2(sa[1][rb][2], sa[1][rb][3]);
                pf[rb] = __builtin_bit_cast(bf16x8, pw); }
            TSEC(2);
            { const LAS unsigned char* vb = vst + vb_cur * P3_VWB + (4 * kq + (j >> 2)) * 128 + (4 * (j & 3)) * 2;
              typedef short v4i16_t __attribute__((ext_vector_type(4)));
#pragma unroll
              for (int dt = 0; dt < 4; ++dt) {
                  const v4i16_t lo4 = __builtin_amdgcn_ds_read_tr16_b64_v4i16((LAS v4i16_t*)(vb + 32 * dt));
                  const v4i16_t hi4 = __builtin_amdgcn_ds_read_tr16_b64_v4i16((LAS v4i16_t*)(vb + 32 * dt + 16 * 128));
                  const bf16x8 vf = (bf16x8){lo4[0], lo4[1], lo4[2], lo4[3], hi4[0], hi4[1], hi4[2], hi4[3]};
#pragma unroll
                  for (int rb = 0; rb < 4; ++rb) o[dt][rb] = __builtin_amdgcn_mfma_f32_16x16x32_bf16(vf, pf[rb], o[dt][rb], 0, 0, 0); } }
            TSEC(3);
            vb_cur = vb_cur == 2 ? 0 : vb_cur + 1;
        }
#undef P4_LOADK
#if TEST_MODE == 5
        if (blockIdx.x == STAMP_BLK && threadIdx.x == 0) { unsigned* st_ = (unsigned*)(F.ws + WS_CTL + 900 * 1024); for (int i_ = 0; i_ < 5; ++i_) atomicAdd(st_ + 8 + i_, (unsigned)(tacc_[i_] >> 4)); atomicAdd(st_ + 13, (unsigned)ntw); }
#endif
#undef TSEC
#undef P4_DMAV
#pragma unroll
        for (int rb = 0; rb < 4; ++rb) lsum[rb] = kq_sum(lsum[rb]);
        if (has_next && rep4_ == REP_S4 - 1) p3_prefetch(F, nb, nqt, pre);
        const size_t mrow_m = mb + t0 + 4 * kq4 + (j >> 2); const int hd_m = 4 * g + (j & 3);
        v2u gvm[4];
#pragma unroll
        for (int dt = 0; dt < 4; ++dt) gvm[dt] = *(const v2u*)((const bf16*)(F.ws + WS_GA) + mrow_m * 512 + hd_m * 64 + 16 * dt + 4 * kq);
        __syncthreads();
        {
            LAS unsigned char* xo = F.lds + ((g * 4 + kq4) * 4) * 4096; LAS float* xm = (LAS float*)(F.lds + P3_XM) + ((g * 4 + kq4) * 4) * 32;
#pragma unroll
            for (int rb = 0; rb < 4; ++rb) {
#pragma unroll
                for (int dt = 0; dt < 4; ++dt) *(LAS f32x4*)(xo + rb * 4096 + dt * 1024 + l4_ * 16) = o[dt][rb];
                if (kq == 0) { xm[rb * 32 + j] = (lsum[rb] > 0.f) ? mref[rb] : -INFINITY; xm[rb * 32 + 16 + j] = lsum[rb]; } }
        }
        __syncthreads();
        {
            const int rb = kq4; float ms[4], ls[4]; float M = -INFINITY;
#pragma unroll
            for (int s4 = 0; s4 < 4; ++s4) { const LAS float* xm = (const LAS float*)(F.lds + P3_XM) + ((g * 4 + s4) * 4 + rb) * 32; ms[s4] = xm[j]; ls[s4] = xm[16 + j]; M = fmaxf(M, ms[s4]); }
            float Lt = 0.f; f32x4 oo[4];
#pragma unroll
            for (int dt = 0; dt < 4; ++dt) oo[dt] = (f32x4){0.f, 0.f, 0.f, 0.f};
#pragma unroll
            for (int s4 = 0; s4 < 4; ++s4) { const float sc = __builtin_amdgcn_exp2f(ms[s4] - M); Lt += ls[s4] * sc;
                const LAS unsigned char* xo = F.lds + (((g * 4 + s4) * 4) + rb) * 4096;
#pragma unroll
                for (int dt = 0; dt < 4; ++dt) oo[dt] += *(const LAS f32x4*)(xo + dt * 1024 + l4_ * 16) * sc; }
            const float inv = 1.0f / Lt;
            const size_t mrow = mrow_m; const int hd = hd_m;
            bf16* MIX = (bf16*)(F.ws + WS_MIX);
#pragma unroll
            for (int dt = 0; dt < 4; ++dt) { const int d = 16 * dt + 4 * kq; const v2u gv = gvm[dt];
                const float g0 = bf2f((unsigned short)(gv.x & 0xffffu)), g1 = bf2f((unsigned short)(gv.x >> 16)), g2 = bf2f((unsigned short)(gv.y & 0xffffu)), g3 = bf2f((unsigned short)(gv.y >> 16));
                v2u ov; ov.x = pk2(oo[dt][0] * inv * g0, oo[dt][1] * inv * g1); ov.y = pk2(oo[dt][2] * inv * g2, oo[dt][3] * inv * g3);
                *(v2u*)(MIX + mrow * 1024 + hd * 64 + d) = ov; }
        }
        if (REP_S4 > 1) __syncthreads();
    }
}

constexpr int PL_U = 0, PL_W = 40960, PL_STRIDE = 272;
template <bool SAMPLE> __device__ __forceinline__ void p3_pool_item(Frame& F, int item) {
    const int tid = F.tid, lane = F.lane, w = F.wave, j = lane & 15, kq = lane >> 4;
    const bf16* U = (const bf16*)(F.ws + WS_U); const bf16* GP = (const bf16*)(F.ws + WS_GP); const bf16* WPT = (const bf16*)(F.ws + WS_WPOOLT); bf16* MIX = (bf16*)(F.ws + WS_MIX);
    const int tokb = SAMPLE ? 0 : (item & 15) * 128;
    const size_t m0 = SAMPLE ? (size_t)MP : (size_t)(item >> 4) * SEQ + tokb;
    const int tl = 16 * w + j;
    const size_t mrow = m0 + tl;
    v4u wr_[4], ur_[5];
#define PL_LOAD(gg) do { _Pragma("unroll") for (int k_ = 0; k_ < 4; ++k_) { const int i_ = tid + 512 * k_; wr_[k_] = *(const v4u*)(WPT + (size_t)(gg) * 16384 + (i_ >> 4) * 128 + (i_ & 15) * 8); } \
        if (!SAMPLE) { _Pragma("unroll") for (int k_ = 0; k_ < 5; ++k_) { const int i_ = tid + 512 * k_; const int row_ = i_ >> 4, ch_ = i_ & 15; ur_[k_] = (v4u){0u, 0u, 0u, 0u}; \
            if (i_ < 143 * 16 && tokb - 15 + row_ >= 0) ur_[k_] = *(const v4u*)(U + (m0 - 15 + row_) * 512 + (gg) * 128 + ch_ * 8); } } } while (0)
#define PL_STORE() do { _Pragma("unroll") for (int k_ = 0; k_ < 4; ++k_) { const int i_ = tid + 512 * k_; *(LAS v4u*)(F.lds + PL_W + (i_ >> 4) * PL_STRIDE + (i_ & 15) * 16) = wr_[k_]; } \
        if (!SAMPLE) { _Pragma("unroll") for (int k_ = 0; k_ < 5; ++k_) { const int i_ = tid + 512 * k_; if (i_ < 143 * 16) *(LAS v4u*)(F.lds + PL_U + (i_ >> 4) * PL_STRIDE + (i_ & 15) * 16) = ur_[k_]; } } } while (0)
    PL_LOAD(0);
#pragma unroll
    for (int g = 0; g < 4; ++g) {
        const int win = 2 << g;
        PL_STORE();
        __syncthreads();
        if (g + 1 < 4) PL_LOAD(g + 1);
        bf16x8 df[4];
#pragma unroll
        for (int ks = 0; ks < 4; ++ks) {
            float sum[8], cur[8];
            if (!SAMPLE) {
                const LAS unsigned char* up = F.lds + PL_U + (15 + tl) * PL_STRIDE + (4 * ks + kq) * 16;
                { const v4u c = *(const LAS v4u*)up;
#pragma unroll
                  for (int u = 0; u < 4; ++u) { const unsigned x = c[u]; cur[2 * u] = bf2f((unsigned short)(x & 0xffffu)); cur[2 * u + 1] = bf2f((unsigned short)(x >> 16)); sum[2 * u] = cur[2 * u]; sum[2 * u + 1] = cur[2 * u + 1]; } }
#pragma unroll
                for (int i = 1; i < win; ++i) { const v4u c = *(const LAS v4u*)(up - i * PL_STRIDE);
#pragma unroll
                    for (int u = 0; u < 4; ++u) { const unsigned x = c[u]; sum[2 * u] += bf2f((unsigned short)(x & 0xffffu)); sum[2 * u + 1] += bf2f((unsigned short)(x >> 16)); } }
            } else {
                const int c0 = g * 128 + 32 * ks + 8 * kq;
                { const v4u c = *(const v4u*)(U + mrow * 512 + c0);
#pragma unroll
                  for (int u = 0; u < 4; ++u) { const unsigned x = c[u]; cur[2 * u] = bf2f((unsigned short)(x & 0xffffu)); cur[2 * u + 1] = bf2f((unsigned short)(x >> 16)); sum[2 * u] = cur[2 * u]; sum[2 * u + 1] = cur[2 * u + 1]; } }
#pragma unroll
                for (int i = 1; i < win; ++i) { const float* sp = F.state_pool + ((size_t)tl * 15 + (15 - i)) * 512 + c0; const f32x4 a = *(const f32x4*)sp, bq = *(const f32x4*)(sp + 4);
                    sum[0] += a[0]; sum[1] += a[1]; sum[2] += a[2]; sum[3] += a[3]; sum[4] += bq[0]; sum[5] += bq[1]; sum[6] += bq[2]; sum[7] += bq[3]; }
            }
            const int tpos = tokb + tl; const float rc = 1.0f / (float)(SAMPLE ? win : ((tpos + 1 < win) ? tpos + 1 : win));
            v4u pw; pw.x = pk2(sum[0] * rc - cur[0], sum[1] * rc - cur[1]); pw.y = pk2(sum[2] * rc - cur[2], sum[3] * rc - cur[3]);
            pw.z = pk2(sum[4] * rc - cur[4], sum[5] * rc - cur[5]); pw.w = pk2(sum[6] * rc - cur[6], sum[7] * rc - cur[7]);
            df[ks] = __builtin_bit_cast(bf16x8, pw);
        }
#pragma unroll
        for (int jt = 0; jt < 8; ++jt) {
            f32x4 acc = (f32x4){0.f, 0.f, 0.f, 0.f};
#pragma unroll
            for (int ks = 0; ks < 4; ++ks) { const bf16x8 wf = *(const LAS bf16x8*)(F.lds + PL_W + (16 * jt + j) * PL_STRIDE + (4 * ks + kq) * 16);
                acc = __builtin_amdgcn_mfma_f32_16x16x32_bf16(wf, df[ks], acc, 0, 0, 0); }
            const int col = g * 128 + 16 * jt + 4 * kq;
            const f32x4 ps = *(const f32x4*)(F.pool_scale + col); const v2u gv = *(const v2u*)(GP + mrow * 512 + col);
            const float g0 = bf2f((unsigned short)(gv.x & 0xffffu)), g1 = bf2f((unsigned short)(gv.x >> 16)), g2 = bf2f((unsigned short)(gv.y & 0xffffu)), g3 = bf2f((unsigned short)(gv.y >> 16));
            v2u ov; ov.x = pk2(acc[0] * ps[0] * g0, acc[1] * ps[1] * g1); ov.y = pk2(acc[2] * ps[2] * g2, acc[3] * ps[3] * g3);
            *(v2u*)(MIX + mrow * 1024 + 512 + col) = ov;
        }
        __syncthreads();
    }
#undef PL_LOAD
#undef PL_STORE
}

constexpr int SM_SC = 0, SM_SEL = 8448, SM_Q = 9472, SM_P = 11520, SM_RED = 19712, SM_PT = 27904;
__device__ __forceinline__ void p3_sample_item(Frame& F, int s) {
    const int tid = F.tid, lane = F.lane, w = F.wave, r = lane & 31, hh = lane >> 5;
    const size_t m = (size_t)MP + s;
    LAS float* sc = (LAS float*)(F.lds + SM_SC); LAS int* sel = (LAS int*)(F.lds + SM_SEL); LAS float* ql = (LAS float*)(F.lds + SM_Q);
    LAS float* pl = (LAS float*)(F.lds + SM_P); LAS float* red = (LAS float*)(F.lds + SM_RED); LAS int* ptl = (LAS int*)(F.lds + SM_PT);
    const bf16* QI = (const bf16*)(F.ws + WS_QI) + m * 512; const float* WIp = (const float*)(F.ws + WS_WI) + m * 8;
    const int* pt = F.page_table + s * NPG;
    ql[tid] = bf2f(((const bf16*)(F.ws + WS_Q))[m * 512 + tid]);
    if (tid < NPG) ptl[tid] = pt[tid];
    {
        bf16x8 af[4];
#pragma unroll
        for (int ks = 0; ks < 4; ++ks) { af[ks] = (bf16x8){0, 0, 0, 0, 0, 0, 0, 0}; if (r < 8) af[ks] = *(const bf16x8*)(QI + r * 64 + 16 * ks + 8 * hh); }
        float wv[4];
#pragma unroll
        for (int e = 0; e < 4; ++e) wv[e] = WIp[4 * hh + e];
        int pg[8];
#pragma unroll
        for (int it = 0; it < 8; ++it) pg[it] = pt[(w + 8 * it) >> 2];
#pragma unroll
        for (int hf = 0; hf < 2; ++hf) {
            f32x4 x0[4][4], x1[4][4];
#pragma unroll
            for (int i4 = 0; i4 < 4; ++i4) { const int kt = w + 8 * (4 * hf + i4);
                const float* kp = F.cache_kidx + ((size_t)pg[4 * hf + i4] * PAGE + (kt & 3) * 32 + r) * 64 + 8 * hh;
#pragma unroll
                for (int ks = 0; ks < 4; ++ks) { x0[i4][ks] = *(const f32x4*)(kp + 16 * ks); x1[i4][ks] = *(const f32x4*)(kp + 16 * ks + 4); } }
#pragma unroll
            for (int i4 = 0; i4 < 4; ++i4) { const int kt = w + 8 * (4 * hf + i4);
                f32x16 acc;
#pragma unroll
                for (int e = 0; e < 16; ++e) acc[e] = 0.f;
#pragma unroll
                for (int ks = 0; ks < 4; ++ks) {
                    v4u pw; pw.x = pk2(x0[i4][ks][0], x0[i4][ks][1]); pw.y = pk2(x0[i4][ks][2], x0[i4][ks][3]); pw.z = pk2(x1[i4][ks][0], x1[i4][ks][1]); pw.w = pk2(x1[i4][ks][2], x1[i4][ks][3]);
                    acc = __builtin_amdgcn_mfma_f32_32x32x16_bf16(af[ks], __builtin_bit_cast(bf16x8, pw), acc, 0, 0, 0); }
                float part = wv[0] * fmaxf(acc[0], 0.f) + wv[1] * fmaxf(acc[1], 0.f) + wv[2] * fmaxf(acc[2], 0.f) + wv[3] * fmaxf(acc[3], 0.f);
                part += __shfl_xor(part, 32);
                if (hh == 0) sc[32 * kt + r] = part; }
        }
        if (w == 0) {
            const float kv = bf2f(((const bf16*)(F.ws + WS_KI))[m * 64 + lane]); float tot = 0.f;
#pragma unroll
            for (int h = 0; h < 8; ++h) { const float d = wave_sum(bf2f(QI[h * 64 + lane]) * kv); tot += WIp[h] * fmaxf(d, 0.f); }
            if (lane == 0) sc[PAST] = tot;
        }
    }
    __syncthreads();
    if (w == 0) {
        unsigned key[33];
#pragma unroll
        for (int jj = 0; jj < 33; ++jj) { const int l = jj * 64 + lane; key[jj] = l < PAST + 1 ? f2key(sc[l]) : 0u; }
        unsigned Tk = 0u;
        for (int bit = 31; bit >= 0; --bit) { const unsigned cand = Tk | (1u << bit); int cnt = 0;
#pragma unroll
            for (int jj = 0; jj < 33; ++jj) cnt += __popcll(__ballot(key[jj] >= cand));
            if (cnt >= 256) Tk = cand; }
        int cgt = 0;
#pragma unroll
        for (int jj = 0; jj < 33; ++jj) cgt += __popcll(__ballot(key[jj] > Tk));
        const int need = 256 - cgt; const unsigned long long lt = (1ull << lane) - 1ull; int pos = 0, eq_seen = 0;
#pragma unroll
        for (int jj = 0; jj < 33; ++jj) { const bool gt = key[jj] > Tk, eq = key[jj] == Tk;
            const unsigned long long meq = __ballot(eq); const int eqb = eq_seen + __popcll(meq & lt);
            const bool take = gt || (eq && eqb < need); const unsigned long long mt = __ballot(take);
            const int l = jj * 64 + lane;
            if (take) sel[pos + __popcll(mt & lt)] = l < PAST ? ptl[l >> 7] * PAGE + (l & 127) : -1;
            pos += __popcll(mt); eq_seen += __popcll(meq); }
    }
    __syncthreads();
    {
        const int jk = tid & 255, g = tid >> 8; const int pr = sel[jk];
        const float* krow = pr >= 0 ? F.cache_k + (size_t)pr * 128 + g * 64 : F.out + O_KS + (size_t)s * 128 + g * 64;
        f32x4 kv[16];
#pragma unroll
        for (int c = 0; c < 16; ++c) kv[c] = *(const f32x4*)(krow + 4 * c);
        float d4[4] = {0.f, 0.f, 0.f, 0.f};
#pragma unroll
        for (int c = 0; c < 16; ++c) {
#pragma unroll
            for (int rr = 0; rr < 4; ++rr) { const f32x4 qv = *(const LAS f32x4*)(ql + (4 * g + rr) * 64 + 4 * c); d4[rr] += (qv[0] * kv[c][0] + qv[1] * kv[c][1]) + (qv[2] * kv[c][2] + qv[3] * kv[c][3]); } }
#pragma unroll
        for (int rr = 0; rr < 4; ++rr) pl[(4 * g + rr) * 256 + jk] = d4[rr];
    }
    __syncthreads();
    {
        float v[4]; float mx = -INFINITY;
#pragma unroll
        for (int i = 0; i < 4; ++i) { v[i] = pl[w * 256 + lane + 64 * i]; mx = fmaxf(mx, v[i]); }
        mx = wave_max(mx); float sm = 0.f;
#pragma unroll
        for (int i = 0; i < 4; ++i) { v[i] = __builtin_amdgcn_exp2f(v[i] - mx); sm += v[i]; }
        sm = wave_sum(sm); const float inv = 1.0f / sm;
#pragma unroll
        for (int i = 0; i < 4; ++i) pl[w * 256 + lane + 64 * i] = v[i] * inv;
    }
    __syncthreads();
    {
        const int d = tid & 63, g = (tid >> 6) & 1, k4 = tid >> 7; float acc[4] = {0.f, 0.f, 0.f, 0.f};
#pragma unroll
        for (int hb = 0; hb < 1; ++hb) { float vv[64];
#pragma unroll
            for (int i = 0; i < 64; ++i) { const int pr = sel[64 * k4 + i];
                const float* vrow = pr >= 0 ? F.cache_v + (size_t)pr * 128 + g * 64 : F.out + O_VS + (size_t)s * 128 + g * 64; vv[i] = vrow[d]; }
#pragma unroll
            for (int i = 0; i < 64; ++i) {
#pragma unroll
                for (int rr = 0; rr < 4; ++rr) acc[rr] += pl[(4 * g + rr) * 256 + 64 * k4 + i] * vv[i]; } }
#pragma unroll
        for (int rr = 0; rr < 4; ++rr) red[((k4 * 2 + g) * 4 + rr) * 64 + d] = acc[rr];
    }
    __syncthreads();
    { const int h = tid >> 6, d = tid & 63; float a = 0.f;
#pragma unroll
        for (int k4 = 0; k4 < 4; ++k4) a += red[((k4 * 2 + (h >> 2)) * 4 + (h & 3)) * 64 + d];
        const float gate = bf2f(((const bf16*)(F.ws + WS_GA))[m * 512 + tid]);
        ((bf16*)(F.ws + WS_MIX))[m * 1024 + tid] = (bf16)f2bf(a * gate); }
    { const int c = tid, g = c >> 7, win = 2 << g; const float un = bf2f(((const bf16*)(F.ws + WS_U))[m * 512 + c]); float sum = un;
      const float* sp = F.state_pool + (size_t)s * 15 * 512 + c;
      float hv[15];
#pragma unroll
      for (int i = 1; i < 16; ++i) hv[i - 1] = sp[(size_t)(15 - i) * 512];
#pragma unroll
      for (int i = 1; i < 16; ++i) sum += (i < win) ? hv[i - 1] : 0.f;
      ql[c] = bf2f((unsigned short)f2bf(sum / (float)win - un)); }
    __syncthreads();
    { const int col = tid, g = col >> 7, j = col & 127; const bf16* wr = (const bf16*)(F.ws + WS_WPOOLT) + (size_t)g * 16384 + j * 128;
      v4u wv4[16];
#pragma unroll
      for (int i = 0; i < 16; ++i) wv4[i] = *(const v4u*)(wr + 8 * i);
      float acc = 0.f;
#pragma unroll
      for (int i = 0; i < 16; ++i) { const LAS f32x4* dp = (const LAS f32x4*)(ql + g * 128 + 8 * i); const f32x4 d0 = dp[0], d1 = dp[1];
          acc += d0[0] * bf2f((unsigned short)(wv4[i].x & 0xffffu)) + d0[1] * bf2f((unsigned short)(wv4[i].x >> 16)) + d0[2] * bf2f((unsigned short)(wv4[i].y & 0xffffu)) + d0[3] * bf2f((unsigned short)(wv4[i].y >> 16));
          acc += d1[0] * bf2f((unsigned short)(wv4[i].z & 0xffffu)) + d1[1] * bf2f((unsigned short)(wv4[i].z >> 16)) + d1[2] * bf2f((unsigned short)(wv4[i].w & 0xffffu)) + d1[3] * bf2f((unsigned short)(wv4[i].w >> 16)); }
      const float gp = bf2f(((const bf16*)(F.ws + WS_GP))[m * 512 + col]);
      ((bf16*)(F.ws + WS_MIX))[m * 1024 + 512 + col] = (bf16)f2bf(acc * F.pool_scale[col] * gp); }
    __syncthreads();
}

__device__ __forceinline__ void p3_mixer(Frame& F) {
    P3Pre pre; int cb, cqt; bool cv;
#define P3_ITEM(i_, ok_, b_, qt_) do { if (F.G == 256) { ok_ = (i_) < 4; \
            const int idx_ = F.bid >> 3, i2_ = idx_ & 15, pi_ = i2_ + 16 * (((i_) >> 1) & 1), grp_ = pi_ >> 3, k_ = pi_ & 7; const bool light_ = idx_ < 16; \
            b_ = F.bid & 7; qt_ = ((i_) & 1) ? (light_ ? 16 * grp_ + k_ : 8 + 16 * grp_ + k_) : (light_ ? 119 - 16 * grp_ - k_ : 127 - 16 * grp_ - k_); } \
        else { const int p_ = F.bid + ((i_) >> 1) * F.G; ok_ = p_ < 512; b_ = (p_ >> 6) & 7; qt_ = ((i_) & 1) ? (p_ & 63) : 127 - (p_ & 63); } } while (0)
    P3_ITEM(0, cv, cb, cqt);
    if (cv) p3_prefetch(F, cb, cqt, pre);
#pragma unroll 1
    for (int i = 0; cv; ++i) {
        int nb, nqt; bool nv;
        P3_ITEM(i + 1, nv, nb, nqt);
        p3_prompt_item(F, cb, cqt, pre, nv, nb, nqt); __syncthreads(); FSTAMP();
        cv = nv; cb = nb; cqt = nqt;
    }
#undef P3_ITEM
    for (int x = F.bid; x < 128; x += F.G) { for (int rp_ = 0; rp_ < REP_SMP; ++rp_) { p3_sample_item(F, x); __syncthreads(); } FSTAMP(); }
    for (int x = F.bid + ((F.bid < 128) ? ((128 - F.bid + F.G - 1) / F.G) * F.G : 0); x < 256; x += F.G) { for (int rp_ = 0; rp_ < REP_POOL; ++rp_) { p3_pool_item<false>(F, x - 128); __syncthreads(); } FSTAMP(); }
}
__device__ __forceinline__ void p4_sample_out(Frame& F) {
    if (F.bid >= 64) return;
    const int lane = F.lane, w = F.wave, rl = lane & 15, kq = lane >> 4, n0 = F.bid * 16;
    const bf16* ap = (const bf16*)(F.ws + WS_MIX) + (size_t)(MP + 16 * w + rl) * 1024 + 8 * kq;
    const bf16* bp = (const bf16*)(F.ws + WS_WOUTT) + (size_t)(n0 + rl) * 1024 + 8 * kq;
    f32x4 acc = (f32x4){0.f, 0.f, 0.f, 0.f};
#pragma unroll
    for (int hb = 0; hb < 2; ++hb) { bf16x8 fa[16], fb[16];
#pragma unroll
        for (int i = 0; i < 16; ++i) { fa[i] = *(const bf16x8*)(ap + 32 * (16 * hb + i)); fb[i] = *(const bf16x8*)(bp + 32 * (16 * hb + i)); }
#pragma unroll
        for (int i = 0; i < 16; ++i) acc = __builtin_amdgcn_mfma_f32_16x16x32_bf16(fa[i], fb[i], acc, 0, 0, 0); }
    const float* ada = (const float*)(F.ws + WS_ADA);
#pragma unroll
    for (int e = 0; e < 4; ++e) { const int s = 16 * w + 4 * kq + e, n = n0 + rl;
        F.out[O_YS + (size_t)s * 1024 + n] = F.xs[(size_t)s * 1024 + n] + ada[(size_t)(NB + s) * 3072 + 2048 + n] * acc[e]; }
}

struct Args { const float* in[18]; float* out; unsigned char* ws; int ph_lo, ph_hi, li, pad; };
__global__ void __launch_bounds__(NWAVES * 64, 2) mk_fwd(Args args) {
    extern __shared__ __attribute__((aligned(16))) unsigned char lds[];
    Frame F;
    F.lds = (LAS unsigned char*)lds;
    F.MISC = (volatile LAS unsigned*)(F.lds + MISC_OFF);
    F.tid = threadIdx.x; F.lane = F.tid & 63; F.wave = __builtin_amdgcn_readfirstlane(F.tid >> 6);
    F.G = gridDim.x; F.bid = blockIdx.x; { const int bx = blockIdx.x; F.vcu = (F.G % 8 == 0) ? (bx % 8) * (F.G / 8) + bx / 8 : bx; }
    F.ws = args.ws; F.out = args.out; F.ctl = (gu32*)(args.ws + WS_CTL);
    F.xp = args.in[0]; F.xs = args.in[1]; F.cache_k = args.in[2]; F.cache_v = args.in[3]; F.cache_kidx = args.in[4]; F.state_pool = args.in[5];
    F.page_table = (const int*)args.in[6]; F.cp = args.in[7]; F.cs = args.in[8]; F.norm_w = args.in[9]; F.w_ada = args.in[10]; F.b_ada = args.in[11];
    F.w_in = args.in[12]; F.qnw = args.in[13]; F.knw = args.in[14]; F.w_pool = args.in[15]; F.pool_scale = args.in[16]; F.w_out = args.in[17];
    for (int u = F.tid; u < (LDS_BYTES - LDSCTL_OFF) / 4; u += NWAVES * 64) ((LAS unsigned*)(F.lds + LDSCTL_OFF))[u] = 0u;
    __syncthreads();
    XcdBarrier bar = xcd_barrier_post((unsigned*)(F.ctl + CW_BAR) + args.li * XCD_BAR_WORDS, F.MISC + 8);
    const int lo = args.ph_lo, hi = args.ph_hi;
#if TEST_MODE == 4
    unsigned long long* ts = (unsigned long long*)(args.ws + WS_CTL + 768 * 1024); int nst = 0;
#define STAMP() do { if (blockIdx.x == STAMP_BLK && threadIdx.x == 0) ts[nst] = __builtin_amdgcn_s_memrealtime(); ++nst; } while (0)
#if P3FINE
    F.ts = ts + 16; F.nst = 0;
#endif
#else
#define STAMP() do { } while (0)
#endif
    STAMP();
#define IN(k) (lo <= (k) && (k) < hi)
#define BOTH(k) (IN(k) && IN((k) + 1))
    if (IN(0)) { for (int rp_ = 0; rp_ < REP_P0; ++rp_) { p0_prologue(F); if (rp_ + 1 < REP_P0) __syncthreads(); } STAMP(); if (BOTH(0)) xcd_barrier(bar); STAMP(); }
    if (IN(1)) { for (int rp_ = 0; rp_ < REP_P1; ++rp_) p1_norm(F); STAMP(); if (BOTH(1)) xcd_barrier(bar); STAMP(); }
    if (IN(2)) {
        for (int rp_ = 0; rp_ < REP_P2S; ++rp_) p2_sample(F);
        pg8::Gemm g{(const pg8::bf16_t*)(F.ws + WS_HB), (const pg8::bf16_t*)(F.ws + WS_WINT), MP, 3072, DM};
        pg8::StaticOrder S; S.init(MP, 3072, F.G, (int)blockIdx.x);
        pg8::EpiIn E{F.ws, F.out, F.qnw, F.knw};
        for (int rp_ = 0; rp_ < REP_P2G; ++rp_) pg8::gemm_phase<pg8::EpiIn, pg8::StaticOrder, true, true>(F.lds + RING_OFF, g, S, E);
        STAMP(); if (BOTH(2)) xcd_barrier(bar); STAMP();
    }
#if HAVE_P3
    if (IN(3)) { p3_mixer(F); STAMP(); if (BOTH(3)) xcd_barrier(bar); STAMP(); }
#endif
    if (IN(4)) {
        pg8::Gemm g{(const pg8::bf16_t*)(F.ws + WS_MIX), (const pg8::bf16_t*)(F.ws + WS_WOUTT), MP, DM, DM};
        pg8::StaticOrder S; S.init(MP, DM, F.G, (int)blockIdx.x);
        pg8::EpiOut E{F.xp, F.out + O_YP, (const float*)(F.ws + WS_ADA)};
        for (int rp_ = 0; rp_ < REP_P4G; ++rp_) pg8::gemm_phase<pg8::EpiOut, pg8::StaticOrder, true, true>(F.lds + RING_OFF, g, S, E);
        STAMP(); for (int rp_ = 0; rp_ < REP_P4S; ++rp_) p4_sample_out(F); STAMP();
    }
#undef IN
#undef BOTH
}

#if TEST_MODE
__global__ void __launch_bounds__(256) k_cmp(const void* a, int a_bf16, int lda, const float* ref, int ldr, int rows, int cols, float scale, int act, float* accum) {
    __shared__ float sd[256], sr[256];
    const size_t idx = (size_t)blockIdx.x * 256 + threadIdx.x; float d2 = 0.f, r2 = 0.f;
    if (idx < (size_t)rows * cols) { const size_t r = idx / cols, c = idx % cols;
        const float av = a_bf16 ? bf2f(((const bf16*)a)[r * lda + c]) : ((const float*)a)[r * lda + c];
        float rv = ref[r * ldr + c]; if (act) rv = rv / (1.f + expf(-rv)); rv *= scale;
        d2 = (av - rv) * (av - rv); r2 = rv * rv; if (!(d2 == d2)) d2 = 1e30f; }
    sd[threadIdx.x] = d2; sr[threadIdx.x] = r2; __syncthreads();
    for (int s = 128; s > 0; s >>= 1) { if ((int)threadIdx.x < s) { sd[threadIdx.x] += sd[threadIdx.x + s]; sr[threadIdx.x] += sr[threadIdx.x + s]; } __syncthreads(); }
    if (threadIdx.x == 0) { atomicAdd(accum, sd[0]); atomicAdd(accum + 1, sr[0]); }
}
__global__ void __launch_bounds__(256) k_cmp_sel(const int* SEL, const int* NSEL, const unsigned* bmdump, float* accum) {
    __shared__ float sd[256], sr[256];
    const size_t idx = (size_t)blockIdx.x * 256 + threadIdx.x; const int m = (int)(idx >> 8), i = (int)(idx & 255); float miss = 0.f, tot = 0.f;
    if (m < MP && i < NSEL[m]) { const int l = SEL[(size_t)m * 256 + i]; tot = 1.f; if (!((bmdump[(size_t)m * 64 + (l >> 5)] >> (l & 31)) & 1u)) miss = 1.f; }
    sd[threadIdx.x] = miss; sr[threadIdx.x] = tot; __syncthreads();
    for (int s = 128; s > 0; s >>= 1) { if ((int)threadIdx.x < s) { sd[threadIdx.x] += sd[threadIdx.x + s]; sr[threadIdx.x] += sr[threadIdx.x + s]; } __syncthreads(); }
    if (threadIdx.x == 0) { atomicAdd(accum, sd[0]); atomicAdd(accum + 1, sr[0]); }
}
__global__ void k_cmp_fin2(float* accum, int n, float amp) {
    float best = -1.f; int bi = 0;
    for (int k = 0; k < n; ++k) { const float rel = accum[2 * k] / fmaxf(accum[2 * k + 1], 1e-30f) / accum[32 + k]; if (rel > best) { best = rel; bi = k; } }
    accum[64] = sqrtf(amp * best); accum[65] = (float)bi;
}
__global__ void k_set(float* p, float a, float b, float c, float d, float e) { p[0] = a; p[1] = b; p[2] = c; p[3] = d; p[4] = e; }
__global__ void k_cmp_fin(float* accum, int n, float amp) {
    float best = -1.f; int bi = 0;
    for (int k = 0; k < n; ++k) { const float rel = accum[2 * k] / fmaxf(accum[2 * k + 1], 1e-30f); if (rel > best) { best = rel; bi = k; } }
    accum[64] = sqrtf(amp * best); accum[65] = (float)bi;
}
__global__ void __launch_bounds__(256) k_perturb(float* out, const float* accum) {
    const size_t offs[11] = {O_YP, O_YS, O_KP, O_VP, O_KIP, O_PP, O_KS, O_VS, O_KIS, O_PS, O_END};
    const int k = (int)accum[65] % 10; const float f = 1.0f + accum[64];
    for (size_t i = offs[k] + (size_t)blockIdx.x * 256 + threadIdx.x; i < offs[k + 1]; i += (size_t)gridDim.x * 256) out[i] *= f;
}
__global__ void __launch_bounds__(256) k_f32_to_bf16(const float* src, bf16* dst, size_t n) {
    for (size_t i = (size_t)blockIdx.x * 256 + threadIdx.x; i < n; i += (size_t)gridDim.x * 256) dst[i] = (bf16)f2bf(src[i]);
}
#endif

#if TEST_MODE == 5
__global__ void __launch_bounds__(256) k_stat(float* out, const unsigned* st, int which) {
    float v = which == 0 ? (float)st[0] : (which == 1 ? (float)st[1] / fmaxf((float)st[2], 1.f) : (which < 8 ? (float)st[3] : (which == 13 ? (float)st[13] : (float)st[which] * (16.0f / 1000.0f))));
    const float f = 1.0f + sqrtf(v * 1e-5f);
    for (size_t i = O_KS + (size_t)blockIdx.x * 256 + threadIdx.x; i < O_VS; i += (size_t)gridDim.x * 256) out[i] *= f;
}
#endif
#if TEST_MODE == 4
__global__ void __launch_bounds__(256) k_time(float* out, const unsigned long long* ts, int i0, int i1, float scale) {
    const float us = (float)(ts[i1] - ts[i0]) * 0.01f; const float f = 1.0f + sqrtf(us * scale);
    for (size_t i = O_KS + (size_t)blockIdx.x * 256 + threadIdx.x; i < O_VS; i += (size_t)gridDim.x * 256) out[i] *= f;
}
#endif
extern "C" void kernel_launch(void* const* d_in, const int* in_sizes, int n_in, void* d_out, int out_size, void* d_ws, size_t ws_size, hipStream_t stream) {
    static int grid = 0;
    if (grid == 0) {
        size_t need = WS_MEGA_END;
#if TEST_MODE && TEST_MODE < 4
        need = 192 * MiB + gold::W_END * 4;
#endif
        if (n_in != 18 || out_size != (int)O_END || ws_size < need) { fprintf(stderr, "kernel_launch: unexpected sizes: n_in %d out %d ws %zu (need %zu)\n", n_in, out_size, ws_size, need); grid = -1; return; }
        int dev = 0, cus = 0, per_cu = 0;
        if (hipGetDevice(&dev) != hipSuccess || hipDeviceGetAttribute(&cus, hipDeviceAttributeMultiprocessorCount, dev) != hipSuccess) { grid = -1; return; }
        if (hipFuncSetAttribute((const void*)mk_fwd, hipFuncAttributeMaxDynamicSharedMemorySize, LDS_BYTES) != hipSuccess) { fprintf(stderr, "kernel_launch: hipFuncSetAttribute failed\n"); grid = -1; return; }
        if (hipOccupancyMaxActiveBlocksPerMultiprocessor(&per_cu, (const void*)mk_fwd, NWAVES * 64, LDS_BYTES) != hipSuccess || per_cu < 1) { fprintf(stderr, "kernel_launch: occupancy query says %d blocks/CU\n", per_cu); (void)hipGetLastError(); grid = -1; return; }
        if (cus < 64) { fprintf(stderr, "kernel_launch: needs >= 64 CUs\n"); grid = -1; return; }
        grid = cus;
    }
    if (grid < 0) return;
#if TEST_MODE
    (void)hipMemsetAsync((char*)d_ws + WS_CTL, 0, CTL_ZERO_BYTES, stream);
#else
    (void)hipMemsetAsync((char*)d_ws + WS_CTL + CW_BAR * 4, 0, XCD_BAR_WORDS * 4, stream);
#endif
    Args a{};
    for (int i = 0; i < 18; ++i) a.in[i] = (const float*)d_in[i];
    a.out = (float*)d_out; a.ws = (unsigned char*)d_ws;
#if TEST_MODE == 5
    a.ph_lo = 0; a.ph_hi = 5; a.li = 0;
    hipLaunchKernelGGL(mk_fwd, dim3(grid), dim3(NWAVES * 64), LDS_BYTES, stream, a);
    k_stat<<<16, 256, 0, stream>>>((float*)d_out, (const unsigned*)((char*)d_ws + WS_CTL + 900 * 1024), STATSEL);
#elif TEST_MODE == 4
    a.ph_lo = 0; a.ph_hi = 5; a.li = 0;
    hipLaunchKernelGGL(mk_fwd, dim3(grid), dim3(NWAVES * 64), LDS_BYTES, stream, a);
    k_time<<<16, 256, 0, stream>>>((float*)d_out, (const unsigned long long*)((char*)d_ws + WS_CTL + 768 * 1024), TS0, TS1, 1e-5f);
#elif TEST_MODE && TEST_MODE < 4
    {
        using namespace gold;
        const float* xp = (const float*)d_in[0]; const float* xs = (const float*)d_in[1];
        const float* cache_k = (const float*)d_in[2]; const float* cache_v = (const float*)d_in[3]; const float* cache_kidx = (const float*)d_in[4];
        const float* state_pool = (const float*)d_in[5]; const int* page_table = (const int*)d_in[6];
        const float* cp = (const float*)d_in[7]; const float* cs = (const float*)d_in[8]; const float* norm_w = (const float*)d_in[9];
        const float* w_ada = (const float*)d_in[10]; const float* b_ada = (const float*)d_in[11]; const float* w_in = (const float*)d_in[12];
        const float* qnw = (const float*)d_in[13]; const float* knw = (const float*)d_in[14]; const float* w_pool = (const float*)d_in[15];
        const float* pool_scale = (const float*)d_in[16]; const float* w_out = (const float*)d_in[17];
        float* out = (float*)d_out; float* ws = (float*)((char*)d_ws + 192 * MiB);
        float *ADA = ws + W_ADA, *H = ws + W_H, *PROJ = ws + W_PROJ, *SC = ws + W_SC, *SCS = ws + W_SCS, *MIX = ws + W_MIX, *DB = ws + W_DB, *YT = ws + W_YT;
        int *SEL = (int*)(ws + W_SEL), *NSEL = (int*)(ws + W_NSEL);
        k_ada<<<dim3(12, NR), 256, 0, stream>>>(cp, cs, w_ada, b_ada, ADA);
        k_h<<<MT / 4, 256, 0, stream>>>(xp, xs, norm_w, ADA, H);
        k_gemm<<<dim3((NIN + 127) / 128, MT / 128), 256, 0, stream>>>(H, w_in, PROJ, MT, NIN, DM, DM, NIN, NIN);
        k_post<<<MT / 4, 256, 0, stream>>>(PROJ, qnw, knw, state_pool, out);
        k_scores_p<<<dim3(SEQ / 8, NB), 256, 0, stream>>>(PROJ, SC);
        k_scores_s<<<DECB, 256, 0, stream>>>(PROJ, cache_kidx, page_table, SCS);
        k_topk<<<MT / 4, 256, 0, stream>>>(SC, SCS, SEL, NSEL);
        k_attn<<<MT / 4, 256, 0, stream>>>(PROJ, cache_k, cache_v, page_table, SEL, NSEL, MIX);
        k_pool_d<<<(MT * 512) / 256, 256, 0, stream>>>(PROJ, state_pool, DB);
        k_pool_out<<<(MT * 512) / 256, 256, 0, stream>>>(PROJ, DB, w_pool, pool_scale, MIX);
        k_gemm<<<dim3(1024 / 128, MT / 128), 256, 0, stream>>>(MIX, w_out, YT, MT, 1024, 1024, 1024, 1024, 1024);
        k_final<<<(MT * 1024) / 256, 256, 0, stream>>>(xp, xs, ADA, YT, out);
        unsigned char* mws = (unsigned char*)d_ws;
#if TEST_MODE == 1
        a.ph_lo = 0; a.ph_hi = 3; a.li = 0;
        hipLaunchKernelGGL(mk_fwd, dim3(grid), dim3(NWAVES * 64), LDS_BYTES, stream, a);
        float* accum = (float*)(mws + WS_CTL + 512 * 1024);
        struct { const void* a; int bf; int lda; int refcol; int cols; float scale; int act; } L[9] = {
            {mws + WS_Q, 1, 512, CQ, 512, C2, 0}, {mws + WS_QI, 1, 512, CQI, 512, 1.f, 0}, {mws + WS_GA, 1, 512, CGA, 512, 1.f, 1}, {mws + WS_U, 1, 512, CU, 512, 1.f, 0},
            {mws + WS_GP, 1, 512, CGP, 512, 1.f, 1}, {mws + WS_KB, 1, 128, CK, 128, 1.f, 0}, {mws + WS_VB, 1, 128, CV, 128, 1.f, 0}, {mws + WS_KI, 1, 64, CKI, 64, 1.f, 0},
            {mws + WS_WI, 0, 8, CWI, 8, 1.f, 0} };
        for (int k = 0; k < 9; ++k) k_cmp<<<(unsigned)(((size_t)MT * L[k].cols + 255) / 256), 256, 0, stream>>>(L[k].a, L[k].bf, L[k].lda, PROJ + L[k].refcol, NIN, MT, L[k].cols, L[k].scale, L[k].act, accum + 2 * k);
        k_cmp<<<(NR * 3072 + 255) / 256, 256, 0, stream>>>(mws + WS_ADA, 0, 3072, ADA, 3072, NR, 3072, 1.f, 0, accum + 18);
        k_cmp_fin<<<1, 1, 0, stream>>>(accum, 10, 5.0f);
        k_perturb<<<1024, 256, 0, stream>>>(out, accum);
#elif TEST_MODE == 3
        a.ph_lo = 0; a.ph_hi = 5; a.li = 0;
        hipLaunchKernelGGL(mk_fwd, dim3(grid), dim3(NWAVES * 64), LDS_BYTES, stream, a);
        float* accum = (float*)(mws + WS_CTL + 512 * 1024);
        const bf16* MB = (const bf16*)(mws + WS_MIX);
        k_cmp<<<(unsigned)(((size_t)MP * 512 + 255) / 256), 256, 0, stream>>>(MB, 1, 1024, MIX, 1024, MP, 512, 1.f, 0, accum + 0);
        k_cmp<<<(unsigned)(((size_t)MP * 512 + 255) / 256), 256, 0, stream>>>(MB + 512, 1, 1024, MIX + 512, 1024, MP, 512, 1.f, 0, accum + 2);
        k_cmp<<<(DECB * 512 + 255) / 256, 256, 0, stream>>>(MB + (size_t)MP * 1024, 1, 1024, MIX + (size_t)MP * 1024, 1024, DECB, 512, 1.f, 0, accum + 4);
        k_cmp<<<(DECB * 512 + 255) / 256, 256, 0, stream>>>(MB + (size_t)MP * 1024 + 512, 1, 1024, MIX + (size_t)MP * 1024 + 512, 1024, DECB, 512, 1.f, 0, accum + 6);
        k_cmp_sel<<<MP, 256, 0, stream>>>(SEL, NSEL, (const unsigned*)(mws + WS_DBG_BM), accum + 8);
        k_set<<<1, 1, 0, stream>>>(accum + 32, P3_TOL0, P3_TOL1, P3_TOL2, P3_TOL3, P3_TOL4);
        k_cmp_fin2<<<1, 1, 0, stream>>>(accum, 5, 1e-5f);
        k_perturb<<<1024, 256, 0, stream>>>(out, accum);
#elif TEST_MODE == 2
        a.ph_lo = 0; a.ph_hi = 3; a.li = 0;
        hipLaunchKernelGGL(mk_fwd, dim3(grid), dim3(NWAVES * 64), LDS_BYTES, stream, a);
        k_f32_to_bf16<<<2048, 256, 0, stream>>>(MIX, (bf16*)(mws + WS_MIX), (size_t)MT * 1024);
        a.ph_lo = 4; a.ph_hi = 5; a.li = 1;
        hipLaunchKernelGGL(mk_fwd, dim3(grid), dim3(NWAVES * 64), LDS_BYTES, stream, a);
#endif
    }
#else
    a.ph_lo = 0; a.ph_hi = 5; a.li = 0;
#if USE_COOP
    { void* kargs[] = {&a}; (void)hipLaunchCooperativeKernel((const void*)mk_fwd, dim3(grid), dim3(NWAVES * 64), kargs, LDS_BYTES, stream); }
#else
    hipLaunchKernelGGL(mk_fwd, dim3(grid), dim3(NWAVES * 64), LDS_BYTES, stream, a);
#endif
#endif
}
```

```cpp
#define TEST_MODE 0
#define HAVE_P3 1
#define REP_S1 1
#define REP_S2 1
#define REP_S4 1
#define REP_P0 1
#define REP_P1 1
#define REP_P4S 1
#define REP_P2G 1
#define REP_P4G 1
#define REP_P2S 1
#define REP_SMP 1
#define REP_POOL 1
#define STATSEL 0
#define USE_COOP 1
#define STAMP_BLK 0
#define P3FINE 0
#define TS0 0
#define TS1 1
#include <hip/hip_runtime.h>
#include <cstdio>
#include <cstdint>

constexpr int DM = 1024, NB = 8, SEQ = 2048, DECB = 128, PAST = 2048, PAGE = 128, NPG = 16;
constexpr int NIN = 2888, MP = NB * SEQ, MT = MP + DECB, NR = NB + DECB;
constexpr int CQ = 0, CK = 512, CV = 640, CQI = 768, CKI = 1280, CWI = 1344, CGA = 1352, CU = 1864, CGP = 2376;
constexpr size_t O_YP = 0, O_YS = 16777216, O_KP = 16908288, O_VP = 19005440, O_KIP = 21102592, O_PP = 22151168,
                 O_KS = 22212608, O_VS = 22228992, O_KIS = 22245376, O_PS = 22253568, O_END = 23236608;
constexpr float C2 = 0.125f * 1.4426950408889634f;
constexpr float WI_SCALE = 0.04419417382415922f;
constexpr float EPS = 1e-6f;
constexpr size_t MiB = 1u << 20;
constexpr size_t WS_CTL = 0, CTL_ZERO_BYTES = 1 * MiB;
constexpr size_t WS_ADA = 1 * MiB, WS_WINT = 3 * MiB, WS_WOUTT = 9 * MiB, WS_WPOOLT = 11 * MiB, WS_HS = 12 * MiB, WS_HB = 24 * MiB,
                 WS_Q = 56 * MiB, WS_QI = 73 * MiB, WS_GA = 90 * MiB, WS_U = 107 * MiB, WS_GP = 124 * MiB, WS_KB = 141 * MiB, WS_VB = 146 * MiB,
                 WS_KI = 151 * MiB, WS_WI = 154 * MiB, WS_MIX = 155 * MiB, WS_DBG_BM = 188 * MiB, WS_MEGA_END = 192 * MiB;
namespace pg8 {
#define PG8_LAS __attribute__((address_space(3)))
typedef unsigned short bf16_t;
typedef short bf16x8 __attribute__((ext_vector_type(8)));
typedef float f32x4 __attribute__((ext_vector_type(4)));
typedef unsigned u32x4 __attribute__((ext_vector_type(4)));
constexpr int BM = 256, BK = 64, HALF = 128, HTB = HALF * BK * 2  , STAGE_BYTES = 8 * HTB, NXCD = 8, WGM = 8;

__host__ __device__ __forceinline__ int lds_byte(int r, int c) { const int st = (r >> 4) * 2 + (c >> 5), rr = r & 15, cc = c & 31, ob = rr * 64 + cc * 2; return st * 1024 + (ob ^ (((ob >> 9) & 1) << 5)); }
__host__ __device__ __forceinline__ void stage_rc(int b, int& R, int& C) { const int st = b / 1024, sb = b % 1024, swz = sb ^ (((sb >> 9) & 1) << 5); R = (st >> 1) * 16 + swz / 64; C = (st & 1) * 32 + (swz % 64) / 2; }
__host__ __device__ __forceinline__ int perm32(int rho) { const int n = rho >> 4, i = rho & 15; return 8 * (i >> 2) + 4 * n + (i & 3); }

struct Unit { int pm, pn; };
struct Gemm { const bf16_t* A; const bf16_t* Bt; int M, N, K; };

struct StaticOrder {
    int nM, nN, nwg, G, c;
    __host__ __device__ void init(int M, int N, int G_, int c_) { nM = M / BM; nN = N / BM; nwg = nM * nN; G = G_; c = c_; }
    __host__ __device__ bool next(int i, Unit& u) const {
        const long L = (long)i * G + c; if (L >= nwg) return false;
        int wgid = (int)L; { const int q = nwg / NXCD, r = nwg % NXCD, xcd = wgid % NXCD, off = wgid / NXCD; wgid = (xcd < r ? xcd * (q + 1) : r * (q + 1) + (xcd - r) * q) + off; }
        const int nig = WGM * nN, gid = wgid / nig, fm = gid * WGM, gsz = (nM - fm) < WGM ? (nM - fm) : WGM;
        u.pm = fm + ((wgid % nig) % gsz); u.pn = (wgid % nig) / gsz; return true;
    }
    __device__ __forceinline__ void a_ready(const Unit&) const {}
    __device__ __forceinline__ void done(const Unit&) const {}
};


typedef unsigned u32x4 __attribute__((ext_vector_type(4)));
__device__ __forceinline__ unsigned cvt_pk_bf16(float lo, float hi) { unsigned r; asm volatile("v_cvt_pk_bf16_f32 %0, %1, %2" : "=v"(r) : "v"(lo), "v"(hi)); return r; }
__device__ __forceinline__ void st_bf16x8(bf16_t* p, const f32x4 a, const f32x4 b) {
    u32x4 w; w.x = cvt_pk_bf16(a[0], a[1]); w.y = cvt_pk_bf16(a[2], a[3]); w.z = cvt_pk_bf16(b[0], b[1]); w.w = cvt_pk_bf16(b[2], b[3]); *(u32x4*)p = w; }
__device__ __forceinline__ float silu1(float x) { return x * __builtin_amdgcn_rcpf(1.0f + __builtin_amdgcn_exp2f(-1.4426950408889634f * x)); }
__device__ __forceinline__ f32x4 silu4(const f32x4 v) { f32x4 r; r[0] = silu1(v[0]); r[1] = silu1(v[1]); r[2] = silu1(v[2]); r[3] = silu1(v[3]); return r; }

struct EpiIn {
    static constexpr bool PERM = true, AFTER_DRAIN = false;
    unsigned char* ws; float* out; const float* qnw; const float* knw;
    __device__ __forceinline__ void operator()(const f32x4 (&acc)[2][2][4][2], const Unit& u, int wr, int wc, int fr, int fq) const {
        const int pn = u.pn;
        if (pn == 5 && wc >= 2) return;
        const int rowb = u.pm * 256 + wr * 64 + fr, dof = 8 * fq;
        if (pn <= 1 || (pn == 2 && wc < 2)) {
            const float* nwp = pn <= 1 ? qnw : knw; const float sc = pn <= 1 ? C2 : 1.0f;
            f32x4 wv[2][2];
#pragma unroll
            for (int bj = 0; bj < 2; ++bj)
#pragma unroll
                for (int n = 0; n < 2; ++n) wv[bj][n] = *(const f32x4*)(nwp + 32 * bj + dof + 4 * n) * sc;
#pragma unroll
            for (int ai = 0; ai < 2; ++ai)
#pragma unroll
                for (int m = 0; m < 4; ++m) { const size_t row = (size_t)(rowb + ai * 128 + m * 16); float ss = 0.f;
#pragma unroll
                    for (int bj = 0; bj < 2; ++bj)
#pragma unroll
                        for (int n = 0; n < 2; ++n) { const f32x4 x = acc[ai][bj][m][n]; ss += (x[0] * x[0] + x[1] * x[1]) + (x[2] * x[2] + x[3] * x[3]); }
                    ss += __shfl_xor(ss, 16); ss += __shfl_xor(ss, 32);
                    const float rstd = 1.0f / sqrtf(ss * (1.0f / 64.0f) + EPS);
                    f32x4 o[2][2];
#pragma unroll
                    for (int bj = 0; bj < 2; ++bj)
#pragma unroll
                        for (int n = 0; n < 2; ++n) o[bj][n] = acc[ai][bj][m][n] * rstd * wv[bj][n];
                    if (pn <= 1) { bf16_t* q = (bf16_t*)(ws + WS_Q) + row * 512 + (4 * pn + wc) * 64 + dof; st_bf16x8(q, o[0][0], o[0][1]); st_bf16x8(q + 32, o[1][0], o[1][1]); }
                    else { float* ko = out + O_KP + row * 128 + wc * 64 + dof; *(f32x4*)ko = o[0][0]; *(f32x4*)(ko + 4) = o[0][1]; *(f32x4*)(ko + 32) = o[1][0]; *(f32x4*)(ko + 36) = o[1][1];
                        bf16_t* kb = (bf16_t*)(ws + WS_KB) + row * 128 + wc * 64 + dof; st_bf16x8(kb, o[0][0], o[0][1]); st_bf16x8(kb + 32, o[1][0], o[1][1]); } }
            return;
        }
        if (pn == 5 && wc == 1) {
            if (fq == 0) {
#pragma unroll
                for (int ai = 0; ai < 2; ++ai)
#pragma unroll
                    for (int m = 0; m < 4; ++m) { const size_t row = (size_t)(rowb + ai * 128 + m * 16); float* wp = (float*)(ws + WS_WI) + row * 8;
                        *(f32x4*)wp = acc[ai][0][m][0] * WI_SCALE; *(f32x4*)(wp + 4) = acc[ai][0][m][1] * WI_SCALE; } }
            return;
        }
        bf16_t* dst; int ld, cb; float* fo = nullptr; int fld = 0; bool act = false;
        if (pn == 2) { dst = (bf16_t*)(ws + WS_VB); ld = 128; cb = (wc - 2) * 64; fo = out + O_VP + cb; fld = 128; }
        else if (pn <= 4) { dst = (bf16_t*)(ws + WS_QI); ld = 512; cb = (4 * (pn - 3) + wc) * 64; }
        else if (pn == 5) { dst = (bf16_t*)(ws + WS_KI); ld = 64; cb = 0; fo = out + O_KIP; fld = 64; }
        else if (pn <= 7) { dst = (bf16_t*)(ws + WS_GA); ld = 512; cb = (4 * (pn - 6) + wc) * 64; act = true; }
        else if (pn <= 9) { dst = (bf16_t*)(ws + WS_U); ld = 512; cb = (4 * (pn - 8) + wc) * 64; }
        else { dst = (bf16_t*)(ws + WS_GP); ld = 512; cb = (4 * (pn - 10) + wc) * 64; act = true; }
        const bool is_u = (pn == 8 || pn == 9);
#pragma unroll
        for (int ai = 0; ai < 2; ++ai)
#pragma unroll
            for (int m = 0; m < 4; ++m) { const int rowi = rowb + ai * 128 + m * 16; const size_t row = (size_t)rowi;
                f32x4 o00 = acc[ai][0][m][0], o01 = acc[ai][0][m][1], o10 = acc[ai][1][m][0], o11 = acc[ai][1][m][1];
                if (act) { o00 = silu4(o00); o01 = silu4(o01); o10 = silu4(o10); o11 = silu4(o11); }
                bf16_t* d = dst + row * ld + cb + dof; st_bf16x8(d, o00, o01); st_bf16x8(d + 32, o10, o11);
                if (fo) { float* f = fo + row * fld + dof; *(f32x4*)f = o00; *(f32x4*)(f + 4) = o01; *(f32x4*)(f + 32) = o10; *(f32x4*)(f + 36) = o11; }
                if (is_u) { const int t = rowi & (SEQ - 1);
                    if (t >= SEQ - 15) { float* f = out + O_PP + ((size_t)(rowi >> 11) * 15 + (t - (SEQ - 15))) * 512 + cb + dof;
                        *(f32x4*)f = o00; *(f32x4*)(f + 4) = o01; *(f32x4*)(f + 32) = o10; *(f32x4*)(f + 36) = o11; } } }
    }
};
struct EpiOut {
    static constexpr bool PERM = true, AFTER_DRAIN = false;
    const float* x; float* y; const float* ada;
    __device__ __forceinline__ void operator()(const f32x4 (&acc)[2][2][4][2], const Unit& u, int wr, int wc, int fr, int fq) const {
        const int col0 = u.pn * 256 + wc * 32 + 8 * fq; const float* gp = ada + (size_t)(u.pm >> 3) * 3072 + 2048 + col0;
        f32x4 g[2][2];
#pragma unroll
        for (int bj = 0; bj < 2; ++bj)
#pragma unroll
            for (int n = 0; n < 2; ++n) g[bj][n] = *(const f32x4*)(gp + 128 * bj + 4 * n);
#pragma unroll
        for (int ai = 0; ai < 2; ++ai)
#pragma unroll
            for (int m = 0; m < 4; ++m) { const size_t off = (size_t)(u.pm * 256 + ai * 128 + wr * 64 + m * 16 + fr) * 1024 + col0;
#pragma unroll
                for (int bj = 0; bj < 2; ++bj)
#pragma unroll
                    for (int n = 0; n < 2; ++n) { const f32x4 xv = *(const f32x4*)(x + off + 128 * bj + 4 * n); *(f32x4*)(y + off + 128 * bj + 4 * n) = xv + g[bj][n] * acc[ai][bj][m][n]; } }
    }
};
template <class Epi, class Sched, bool ALIGN_EPI = false, bool SP2 = false>
__device__ __forceinline__ void gemm_phase(PG8_LAS unsigned char* lds, const Gemm g, const Sched& S, const Epi& E) {
    const int tid = threadIdx.x, wid = __builtin_amdgcn_readfirstlane(tid >> 6), lane = tid & 63, wr = wid >> 2, wc = wid & 3, fr = lane & 15, fq = lane >> 4;
    const int K = g.K, nt = K / BK;
    unsigned voffA[2], voffB[2];
#pragma unroll
    for (int i = 0; i < 2; ++i) { int R, C; stage_rc(tid * 16 + i * 8192, R, C); const int Rb = Epi::PERM ? ((R & ~31) + perm32(R & 31)) : R;
        voffA[i] = (unsigned)(R * K + C) * 2u; voffB[i] = (unsigned)(Rb * K + C) * 2u; }
    const size_t kstep = (size_t)(BK * 2);
    const size_t hstep = (size_t)HALF * K * 2;
    const size_t tstep = 2 * hstep;
    const unsigned ldsw = (unsigned)wid * 1024u;
    const int aoff = lds_byte(wr * 64 + fr, fq * 8), boff = lds_byte(wc * 32 + fr, fq * 8);
#define PG8_SA(b, h) (((b) * 2 + (h)) * HTB)
#define PG8_SB(b, h) ((4 + (b) * 2 + (h)) * HTB)
#define PG8_STAGE(bufoff, gbase, voff) do { _Pragma("unroll") for (int _i = 0; _i < 2; ++_i) \
        __builtin_amdgcn_global_load_lds((const unsigned*)((const char*)(gbase) + (voff)[_i]), (PG8_LAS unsigned*)(lds + (bufoff) + ldsw + _i * 8192), 16, 0, 0); } while (0)
#define PG8_LDA(dst, b, h) do { _Pragma("unroll") for (int m = 0; m < 4; ++m) _Pragma("unroll") for (int k = 0; k < 2; ++k) dst[m][k] = *(const PG8_LAS bf16x8*)(lds + PG8_SA(b, h) + aoff + m * 2048 + k * 1024); } while (0)
#define PG8_LDB(dst, b, h) do { _Pragma("unroll") for (int n = 0; n < 2; ++n) _Pragma("unroll") for (int k = 0; k < 2; ++k) dst[n][k] = *(const PG8_LAS bf16x8*)(lds + PG8_SB(b, h) + boff + n * 2048 + k * 1024); } while (0)
#define PG8_MMA(ai, bj, At, Bt) do { __builtin_amdgcn_s_setprio(1); _Pragma("unroll") for (int m = 0; m < 4; ++m) _Pragma("unroll") for (int n = 0; n < 2; ++n) _Pragma("unroll") for (int k = 0; k < 2; ++k) \
        acc[ai][bj][m][n] = __builtin_amdgcn_mfma_f32_16x16x32_bf16(Bt[n][k], At[m][k], acc[ai][bj][m][n], 0, 0, 0); __builtin_amdgcn_s_setprio(0); } while (0)
#define PG8_WAIT_V(n) asm volatile("s_waitcnt vmcnt(" #n ")" ::: "memory")
#define PG8_WAIT_L(n) asm volatile("s_waitcnt lgkmcnt(" #n ")" ::: "memory")
#define PG8_BAR __builtin_amdgcn_s_barrier()
#define PG8_SCHED __builtin_amdgcn_sched_barrier(0)
    Unit cur, nxt; int ui = 0;
    if (!S.next(0, cur)) return;
    f32x4 acc[2][2][4][2];
#pragma unroll
    for (int a = 0; a < 2; ++a)
#pragma unroll
        for (int b = 0; b < 2; ++b)
#pragma unroll
            for (int m = 0; m < 4; ++m)
#pragma unroll
                for (int n = 0; n < 2; ++n) acc[a][b][m][n] = (f32x4){0.f, 0.f, 0.f, 0.f};
    bf16x8 At[4][2], B0[2][2], B1[2][2];
    const char* cA = (const char*)g.A + (size_t)cur.pm * tstep; const char* cB = (const char*)g.Bt + (size_t)cur.pn * tstep;
    S.a_ready(cur);
    if constexpr (SP2) {
        PG8_STAGE(PG8_SB(0, 0), cB, voffB); PG8_STAGE(PG8_SB(0, 1), cB + hstep, voffB); PG8_STAGE(PG8_SA(0, 0), cA, voffA); PG8_STAGE(PG8_SA(0, 1), cA + hstep, voffA);
        if (wr == 1) PG8_BAR;
        PG8_WAIT_V(2); PG8_BAR;
        PG8_STAGE(PG8_SB(1, 0), cB + kstep, voffB); PG8_STAGE(PG8_SA(1, 0), cA + kstep, voffA); PG8_STAGE(PG8_SB(1, 1), cB + hstep + kstep, voffB);
        PG8_WAIT_V(6); PG8_BAR;
    } else {
        PG8_STAGE(PG8_SB(0, 0), cB, voffB); PG8_STAGE(PG8_SA(0, 0), cA, voffA); PG8_STAGE(PG8_SB(0, 1), cB + hstep, voffB); PG8_STAGE(PG8_SA(0, 1), cA + hstep, voffA);
        if (wr == 1) PG8_BAR;
        PG8_WAIT_V(4); PG8_BAR;
        PG8_STAGE(PG8_SB(1, 0), cB + kstep, voffB); PG8_STAGE(PG8_SA(1, 0), cA + kstep, voffA); PG8_STAGE(PG8_SB(1, 1), cB + hstep + kstep, voffB);
        PG8_WAIT_V(6); PG8_BAR;
    }
    for (;;) {
        const bool has_next = S.next(ui + 1, nxt);
        const char* nA = has_next ? (const char*)g.A + (size_t)nxt.pm * tstep : cA; const char* nB = has_next ? (const char*)g.Bt + (size_t)nxt.pn * tstep : cB;
        for (int t = 0; t < nt; t += 2) {
            const bool last = (t == nt - 2);
            const char* a1 = cA + (size_t)(t + 1) * kstep;
            const char* a2 = last ? nA : cA + (size_t)(t + 2) * kstep; const char* b2 = last ? nB : cB + (size_t)(t + 2) * kstep;
            const char* a3 = a2 + kstep; const char* b3 = b2 + kstep;
            if (last && has_next) S.a_ready(nxt);
            if constexpr (SP2) {
            PG8_LDB(B0, 0, 0); PG8_LDB(B1, 0, 1); PG8_SCHED; PG8_LDA(At, 0, 0); PG8_STAGE(PG8_SA(1, 1), a1 + hstep, voffA);
            PG8_WAIT_V(8); PG8_WAIT_L(0); PG8_BAR; PG8_MMA(0, 0, At, B0); PG8_MMA(0, 1, At, B1); PG8_BAR; PG8_SCHED;
            PG8_LDA(At, 0, 1); PG8_STAGE(PG8_SB(0, 0), b2, voffB); PG8_STAGE(PG8_SB(0, 1), b2 + hstep, voffB); PG8_STAGE(PG8_SA(0, 0), a2, voffA);
            PG8_WAIT_V(8); PG8_WAIT_L(0); PG8_BAR; PG8_MMA(1, 0, At, B0); PG8_MMA(1, 1, At, B1); PG8_BAR; PG8_SCHED;
            PG8_LDB(B0, 1, 0); PG8_LDB(B1, 1, 1); PG8_SCHED; PG8_LDA(At, 1, 0); PG8_STAGE(PG8_SA(0, 1), a2 + hstep, voffA);
            PG8_WAIT_V(8); PG8_WAIT_L(0); PG8_BAR; PG8_MMA(0, 0, At, B0); PG8_MMA(0, 1, At, B1); PG8_BAR; PG8_SCHED;
            PG8_LDA(At, 1, 1); PG8_STAGE(PG8_SB(1, 0), b3, voffB); PG8_STAGE(PG8_SB(1, 1), b3 + hstep, voffB); PG8_STAGE(PG8_SA(1, 0), a3, voffA);
            PG8_WAIT_V(8); PG8_WAIT_L(0); PG8_BAR; PG8_MMA(1, 0, At, B0); PG8_MMA(1, 1, At, B1); PG8_BAR; PG8_SCHED;
            } else {
            PG8_LDB(B0, 0, 0); PG8_SCHED; PG8_LDA(At, 0, 0); PG8_STAGE(PG8_SA(1, 1), a1 + hstep, voffA);
            PG8_WAIT_L(8); PG8_BAR; PG8_WAIT_L(0); PG8_MMA(0, 0, At, B0); PG8_BAR; PG8_SCHED;
            PG8_LDB(B1, 0, 1); PG8_STAGE(PG8_SB(0, 0), b2, voffB);
            PG8_BAR; PG8_WAIT_L(0); PG8_MMA(0, 1, At, B1); PG8_BAR;
            PG8_LDA(At, 0, 1); PG8_STAGE(PG8_SA(0, 0), a2, voffA);
            PG8_BAR; PG8_WAIT_L(0); PG8_MMA(1, 0, At, B0); PG8_BAR; PG8_SCHED;
            PG8_STAGE(PG8_SB(0, 1), b2 + hstep, voffB);
            PG8_WAIT_V(6); PG8_BAR; PG8_MMA(1, 1, At, B1); PG8_BAR;
            PG8_LDB(B0, 1, 0); PG8_SCHED; PG8_LDA(At, 1, 0); PG8_STAGE(PG8_SA(0, 1), a2 + hstep, voffA);
            PG8_WAIT_L(8); PG8_BAR; PG8_WAIT_L(0); PG8_MMA(0, 0, At, B0); PG8_BAR; PG8_SCHED;
            PG8_LDB(B1, 1, 1); PG8_STAGE(PG8_SB(1, 0), b3, voffB);
            PG8_BAR; PG8_WAIT_L(0); PG8_MMA(0, 1, At, B1); PG8_BAR;
            PG8_LDA(At, 1, 1); PG8_STAGE(PG8_SA(1, 0), a3, voffA);
            PG8_BAR; PG8_WAIT_L(0); PG8_MMA(1, 0, At, B0); PG8_BAR; PG8_SCHED;
            PG8_STAGE(PG8_SB(1, 1), b3 + hstep, voffB);
            PG8_WAIT_V(6); PG8_BAR; PG8_MMA(1, 1, At, B1); PG8_BAR;
            }
        }
        if constexpr (ALIGN_EPI) { if (wr == 0) PG8_BAR; }
        if constexpr (!Epi::AFTER_DRAIN) { E(acc, cur, wr, wc, fr, fq); S.done(cur); }
        if (!has_next) break;
#pragma unroll
        for (int a = 0; a < 2; ++a)
#pragma unroll
            for (int b = 0; b < 2; ++b)
#pragma unroll
                for (int m = 0; m < 4; ++m)
#pragma unroll
                    for (int n = 0; n < 2; ++n) acc[a][b][m][n] = (f32x4){0.f, 0.f, 0.f, 0.f};
        cur = nxt; cA = nA; cB = nB; ++ui;
        if constexpr (ALIGN_EPI) { if (wr == 1) PG8_BAR; }
    }
    PG8_WAIT_V(0);
    if constexpr (!ALIGN_EPI) { if (wr == 0) PG8_BAR; }
    PG8_BAR;
    if constexpr (Epi::AFTER_DRAIN) { E.fused(acc, cur, wr, wc, fr, fq, lds, wid, lane); S.done(cur); }
#undef PG8_SA
#undef PG8_SB
#undef PG8_STAGE
#undef PG8_LDA
#undef PG8_LDB
#undef PG8_MMA
#undef PG8_WAIT_V
#undef PG8_WAIT_L
#undef PG8_BAR
#undef PG8_SCHED
}
}

constexpr int NWAVES = 8;
constexpr int RING_OFF = 0, RING_BYTES = 131072;
constexpr int LDSCTL_OFF = RING_BYTES, MISC_OFF = LDSCTL_OFF + 320;
constexpr int LDS_BYTES = 163840;
constexpr int CW_Q = 8192;
constexpr int CW_BAR = 4096;
#define GAS __attribute__((address_space(1)))
#define LAS __attribute__((address_space(3)))
typedef unsigned short bf16;
typedef unsigned v4u __attribute__((ext_vector_type(4)));
typedef unsigned v2u __attribute__((ext_vector_type(2)));
typedef float f32x4 __attribute__((ext_vector_type(4)));
typedef float f32x16 __attribute__((ext_vector_type(16)));
typedef short bf16x8 __attribute__((ext_vector_type(8)));
typedef GAS unsigned gu32;
#define LDS_WAIT() asm volatile("s_waitcnt lgkmcnt(0)" ::: "memory")
#define VM_WAIT() asm volatile("s_waitcnt vmcnt(0)" ::: "memory")
__device__ __forceinline__ unsigned f2bf(float f) { unsigned u = __builtin_bit_cast(unsigned, f); return (u + 0x7fffu + ((u >> 16) & 1u)) >> 16; }
__device__ __forceinline__ unsigned pk2(float lo, float hi) { return pg8::cvt_pk_bf16(lo, hi); }
__device__ __forceinline__ float bf2f(unsigned short b) { return __builtin_bit_cast(float, (unsigned)b << 16); }
__device__ __forceinline__ float wave_sum(float v) {
#pragma unroll
    for (int o = 1; o < 64; o <<= 1) v += __shfl_xor(v, o);
    return v;
}
__device__ __forceinline__ float wave_max(float v) {
#pragma unroll
    for (int o = 1; o < 64; o <<= 1) v = fmaxf(v, __shfl_xor(v, o));
    return v;
}
#define XB_TMO      128
#define XB_XCNT(j)  (256  + 64 * (j))
#define XB_XSUB(j)  (1280 + 64 * (j))
#define XB_XGEN(j)  (2304 + 64 * (j))
#define XB_TOP      3328
#define XB_TOPGEN   3392
#define XCD_BAR_WORDS 3456
#define XB_SPIN_CAP (1u << 18)

__device__ __forceinline__ unsigned xb_ld(unsigned* p)              { return __hip_atomic_load(p, __ATOMIC_RELAXED, __HIP_MEMORY_SCOPE_AGENT); }
__device__ __forceinline__ unsigned xb_add(unsigned* p, unsigned v) { return __hip_atomic_fetch_add(p, v, __ATOMIC_RELAXED, __HIP_MEMORY_SCOPE_AGENT); }
__device__ __forceinline__ unsigned xb_xcc_id() { return (unsigned)__builtin_amdgcn_s_getreg((3 << 11) | 20) & 0xFu; }
#define XB_SPIN(cond, bar) do { unsigned _sp = 0; while (cond) { __builtin_amdgcn_s_sleep(1); \
    if ((++_sp & 255u) == 0u) { if (xb_ld(&(bar)[XB_TMO])) break; if (_sp > XB_SPIN_CAP) { atomicAdd(&(bar)[XB_TMO], 1u); break; } } } } while (0)

struct XcdBarrier {
    unsigned* bar; unsigned x;
    volatile LAS unsigned* st;
};

__device__ __forceinline__ XcdBarrier xcd_barrier_post(unsigned* bar, volatile LAS unsigned* st) {
    XcdBarrier b; b.bar = bar; b.x = xb_xcc_id(); b.st = st;
    if (threadIdx.x == 0) (void)xb_add(&bar[XB_XCNT(b.x)], 1u);
    return b;
}
__device__ __forceinline__ void xcd_barrier_complete(unsigned* bar, unsigned x, unsigned& nloc, unsigned& nx) {
    const unsigned G = gridDim.x * gridDim.y * gridDim.z;
    unsigned sum, cnt, mine, sp = 0u;
    for (;;) {
        sum = 0u; cnt = 0u; mine = 0u;
#pragma unroll
        for (unsigned j = 0; j < 16; ++j) { const unsigned c = xb_ld(&bar[XB_XCNT(j)]); sum += c; cnt += (c > 0u) ? 1u : 0u; mine = (j == x) ? c : mine; }
        if (sum == G) break;
        __builtin_amdgcn_s_sleep(1);
        if ((++sp & 255u) == 0u) { if (xb_ld(&bar[XB_TMO])) break; if (sp > XB_SPIN_CAP) { atomicAdd(&bar[XB_TMO], 1u); break; } }
    }
    nloc = mine > 0u ? mine : 1u; nx = cnt > 0u ? cnt : 1u;
}

__device__ __forceinline__ void xcd_barrier(const XcdBarrier& b) {
    asm volatile("s_waitcnt vmcnt(0)" ::: "memory");
    __syncthreads();
    if (threadIdx.x == 0) {
        unsigned* bar = b.bar;
        __builtin_amdgcn_s_waitcnt(0);
        unsigned nloc = b.st[0], nx = b.st[1];
        if (nloc == 0u) { xcd_barrier_complete(bar, b.x, nloc, nx); b.st[0] = nloc; b.st[1] = nx; }
        const unsigned old = xb_add(&bar[XB_XSUB(b.x)], 1u);
        const unsigned gen = old / nloc;
        if (old + 1u == (gen + 1u) * nloc) {
            __builtin_amdgcn_fence(__ATOMIC_RELEASE, "agent");
            asm volatile("s_waitcnt vmcnt(0)" ::: "memory");
            const unsigned og = xb_add(&bar[XB_TOP], 1u);
            const unsigned tg = og / nx;
            if (og + 1u == (tg + 1u) * nx) xb_add(&bar[XB_TOPGEN], 1u);
            else XB_SPIN(xb_ld(&bar[XB_TOPGEN]) == tg, bar);
            __builtin_amdgcn_fence(__ATOMIC_ACQUIRE, "agent");
            xb_add(&bar[XB_XGEN(b.x)], 1u);
            asm volatile("s_waitcnt vmcnt(0)" ::: "memory");
        } else {
            XB_SPIN(xb_ld(&bar[XB_XGEN(b.x)]) == gen, bar);
            __builtin_amdgcn_fence(__ATOMIC_ACQUIRE, "agent");
            asm volatile("s_waitcnt vmcnt(0)" ::: "memory");
        }
    }
    __syncthreads();
}

struct Frame {
    LAS unsigned char* lds; volatile LAS unsigned* MISC; gu32* ctl;
    int tid, lane, wave, vcu, G, bid;
    const float *xp, *xs, *cache_k, *cache_v, *cache_kidx, *state_pool; const int* page_table;
    const float *cp, *cs, *norm_w, *w_ada, *b_ada, *w_in, *qnw, *knw, *w_pool, *pool_scale, *w_out;
    float* out; unsigned char* ws;
#if TEST_MODE == 4 && P3FINE
    unsigned long long* ts; int nst;
#endif
};
#if TEST_MODE == 4 && P3FINE
#define FSTAMP() do { if (blockIdx.x == STAMP_BLK && threadIdx.x == 0) F.ts[F.nst] = __builtin_amdgcn_s_memrealtime(); ++F.nst; } while (0)
#else
#define FSTAMP() do { } while (0)
#endif

__device__ __forceinline__ void p0_ada(Frame& F, int task) {
    const int lane = F.lane, w = F.wave, rl = lane & 15, kq = lane >> 4, n0 = task * 16;
    float bv[32];
    { const float* wp = F.w_ada + (size_t)(w * 128 + 4 * kq) * 3072 + n0 + rl;
#pragma unroll
      for (int i4 = 0; i4 < 8; ++i4)
#pragma unroll
          for (int u = 0; u < 4; ++u) bv[i4 * 4 + u] = wp[(size_t)(16 * i4 + u) * 3072]; }
    f32x4 acc[9];
#pragma unroll
    for (int i3 = 0; i3 < 3; ++i3) {
        f32x4 cv[3][8]; bool valid[3];
#pragma unroll
        for (int ii = 0; ii < 3; ++ii) { const int row = 16 * (3 * i3 + ii) + rl; valid[ii] = row < NR;
            const float* cptr = (row < NB ? F.cp + (size_t)row * DM : F.cs + (size_t)((valid[ii] ? row : NB) - NB) * DM) + w * 128 + 4 * kq;
#pragma unroll
            for (int i4 = 0; i4 < 8; ++i4) cv[ii][i4] = *(const f32x4*)(cptr + 16 * i4); }
#pragma unroll
        for (int ii = 0; ii < 3; ++ii) { const int i = 3 * i3 + ii;
            acc[i] = (f32x4){0.f, 0.f, 0.f, 0.f};
#pragma unroll
            for (int i4 = 0; i4 < 8; ++i4)
#pragma unroll
                for (int u = 0; u < 4; ++u) { const float a = valid[ii] ? pg8::silu1(cv[ii][i4][u]) : 0.f; acc[i] = __builtin_amdgcn_mfma_f32_16x16x4f32(a, bv[i4 * 4 + u], acc[i], 0, 0, 0); } } }
    LAS float* red = (LAS float*)(F.lds + RING_OFF);
#pragma unroll
    for (int i = 0; i < 9; ++i)
#pragma unroll
        for (int e = 0; e < 4; ++e) red[(w * 144 + 16 * i + 4 * kq + e) * 16 + rl] = acc[i][e];
    __syncthreads();
    float* ada = (float*)(F.ws + WS_ADA);
    for (int o = F.tid; o < NR * 16; o += NWAVES * 64) { const int row = o >> 4, col = o & 15; float s = F.b_ada[n0 + col];
#pragma unroll
        for (int ww = 0; ww < 8; ++ww) s += red[(ww * 144 + row) * 16 + col];
        ada[(size_t)row * 3072 + n0 + col] = s; }
    __syncthreads();
}
__device__ __forceinline__ void transpose_item(const float* W, int ldn, int srccol0, int nvalid, bf16* WT, int K, int dstrow0, int k0, LAS float* scr, int lane) {
    float tv[32];
#pragma unroll
    for (int i = 0; i < 32; ++i) { const int kk = 2 * i + (lane >> 5), c = lane & 31; tv[i] = c < nvalid ? W[(size_t)(k0 + kk) * ldn + srccol0 + c] : 0.f; }
#pragma unroll
    for (int i = 0; i < 32; ++i) { const int kk = 2 * i + (lane >> 5), c = lane & 31; scr[kk * 33 + c] = tv[i]; }
    LDS_WAIT(); asm volatile("" ::: "memory");
    const int c = lane & 7;
#pragma unroll
    for (int j = 0; j < 4; ++j) { const int n = (lane >> 3) + 8 * j; const LAS float* s = scr + (8 * c) * 33 + n;
        v4u o; o.x = pk2(s[0 * 33], s[1 * 33]); o.y = pk2(s[2 * 33], s[3 * 33]); o.z = pk2(s[4 * 33], s[5 * 33]); o.w = pk2(s[6 * 33], s[7 * 33]);
        *(GAS v4u*)(WT + (size_t)(dstrow0 + n) * K + k0 + 8 * c) = o; }
    LDS_WAIT(); asm volatile("" ::: "memory");
}
__device__ __forceinline__ int win_col(int pn, int hd, int d) {
    if (pn <= 1) return CQ + (4 * pn + hd) * 64 + d;
    if (pn == 2) return hd < 2 ? CK + hd * 64 + d : CV + (hd - 2) * 64 + d;
    if (pn <= 4) return CQI + (4 * (pn - 3) + hd) * 64 + d;
    if (pn == 5) return hd == 0 ? CKI + d : ((hd == 1 && d < 8) ? CWI + d : -1);
    if (pn <= 7) return CGA + (4 * (pn - 6) + hd) * 64 + d;
    if (pn <= 9) return CU + (4 * (pn - 8) + hd) * 64 + d;
    return CGP + (4 * (pn - 10) + hd) * 64 + d;
}
__device__ __forceinline__ void p0_prologue(Frame& F) {
    LAS float* scr = (LAS float*)(F.lds + RING_OFF + F.wave * 16384);
    const int gw = F.vcu * NWAVES + F.wave, NGW = F.G * NWAVES;
    bf16* WINT = (bf16*)(F.ws + WS_WINT); bf16* WOUTT = (bf16*)(F.ws + WS_WOUTT); bf16* WPOOLT = (bf16*)(F.ws + WS_WPOOLT);
    const bool split = F.G > 192 + 16;
    if (split) { if (F.bid < 192) p0_ada(F, F.bid); }
    else { for (int task = F.bid; task < 192; task += F.G) p0_ada(F, task); }
    if (!split || F.bid >= 192) {
        const int tw0 = split ? (F.bid - 192) * NWAVES + F.wave : gw, tws = split ? (F.G - 192) * NWAVES : NGW;
        for (int it = tw0; it < 2080; it += tws) {
            if (it < 1536) { const int G = it >> 4, kb = it & 15, pn = G >> 3, bj = (G >> 2) & 1, hd = G & 3; const int src = win_col(pn, hd, 32 * bj);
                const int nvalid = src < 0 ? 0 : ((pn == 5 && hd == 1) ? 8 : 32);
                transpose_item(F.w_in, NIN, src < 0 ? 0 : src, nvalid, WINT, 1024, 32 * G, 64 * kb, scr, F.lane); }
            else if (it < 2048) { const int r = it - 1536, G = r >> 4, kb = r & 15; transpose_item(F.w_out, 1024, 32 * G, 32, WOUTT, 1024, 32 * G, 64 * kb, scr, F.lane); }
            else { const int r = it - 2048, g = r >> 3, kb = (r >> 2) & 1, G = r & 3; transpose_item(F.w_pool + (size_t)g * 16384, 128, 32 * G, 32, WPOOLT + (size_t)g * 16384, 128, 32 * G, 64 * kb, scr, F.lane); }
        }
    }
    { const int nf4 = DECB * 1792; f32x4 t4[2]; int ix[2];
#pragma unroll
      for (int k = 0; k < 2; ++k) { ix[k] = gw * 64 + F.lane + k * NGW * 64; if (ix[k] < nf4) { const int s = ix[k] / 1792, i = ix[k] - s * 1792; t4[k] = *(const f32x4*)(F.state_pool + (size_t)s * 7680 + 512 + 4 * i); } }
#pragma unroll
      for (int k = 0; k < 2; ++k) { if (ix[k] < nf4) { const int s = ix[k] / 1792, i = ix[k] - s * 1792; *(f32x4*)(F.out + O_PS + (size_t)s * 7680 + 4 * i) = t4[k]; } }
      for (int ixx = gw * 64 + F.lane + 2 * NGW * 64; ixx < nf4; ixx += NGW * 64) { const int s = ixx / 1792, i = ixx - s * 1792; *(f32x4*)(F.out + O_PS + (size_t)s * 7680 + 4 * i) = *(const f32x4*)(F.state_pool + (size_t)s * 7680 + 512 + 4 * i); } }
}

template <int N> __device__ __forceinline__ void norm_rows_load(Frame& F, const float* x0, f32x4 (&v)[N][4]) {
#pragma unroll
    for (int i = 0; i < N; ++i) { const GAS f32x4* xr = (const GAS f32x4*)(x0 + (size_t)i * DM) + F.lane;
#pragma unroll
        for (int j = 0; j < 4; ++j) v[i][j] = xr[64 * j]; }
}
template <int N, bool SAME_ADA> __device__ __forceinline__ void norm_rows_finish(Frame& F, f32x4 (&v)[N][4], const float* adarow0, int adastride, bf16* o0) {
    float s2[N];
#pragma unroll
    for (int i = 0; i < N; ++i) { s2[i] = 0.f;
#pragma unroll
        for (int j = 0; j < 4; ++j) s2[i] += (v[i][j].x * v[i][j].x + v[i][j].y * v[i][j].y) + (v[i][j].z * v[i][j].z + v[i][j].w * v[i][j].w); }
#pragma unroll
    for (int o = 1; o < 64; o <<= 1) {
#pragma unroll
        for (int i = 0; i < N; ++i) s2[i] += __shfl_xor(s2[i], o); }
#pragma unroll
    for (int j = 0; j < 4; ++j) { const int col = 4 * F.lane + 256 * j; const f32x4 nw = *(const f32x4*)(F.norm_w + col);
        f32x4 gq, sh;
        if (SAME_ADA) { sh = *(const f32x4*)(adarow0 + col); gq = nw * (*(const f32x4*)(adarow0 + 1024 + col) + 1.0f); }
#pragma unroll
        for (int i = 0; i < N; ++i) {
            if (!SAME_ADA) { const float* ar = adarow0 + (size_t)i * adastride; sh = *(const f32x4*)(ar + col); gq = nw * (*(const f32x4*)(ar + 1024 + col) + 1.0f); }
            const float rstd = 1.0f / sqrtf(s2[i] * (1.0f / DM) + EPS);
            const f32x4 o = v[i][j] * rstd * gq + sh;
            ((GAS unsigned long long*)(o0 + (size_t)i * DM))[F.lane + 64 * j] = (unsigned long long)pk2(o.x, o.y) | ((unsigned long long)pk2(o.z, o.w) << 32); } }
}
template <int N, bool SAME_ADA> __device__ __forceinline__ void norm_rows(Frame& F, const float* x0, const float* adarow0, int adastride, bf16* o0) {
    f32x4 v[N][4]; norm_rows_load<N>(F, x0, v); norm_rows_finish<N, SAME_ADA>(F, v, adarow0, adastride, o0);
}
template <int NBATCH> __device__ __forceinline__ void skinny_core(const bf16* arow, const bf16* b0, const bf16* b1, const bf16* b2, const bf16* b3, f32x4 (&acc)[4]) {
#pragma unroll
    for (int j = 0; j < 4; ++j) acc[j] = (f32x4){0.f, 0.f, 0.f, 0.f};
    bf16x8 fa[2][4], fb[2][4][4];
#define SK_LOAD(buf, kb) do { _Pragma("unroll") for (int q_ = 0; q_ < 4; ++q_) { const int ko_ = 32 * (4 * (kb) + q_); fa[buf][q_] = *(const bf16x8*)(arow + ko_); \
        fb[buf][q_][0] = *(const bf16x8*)(b0 + ko_); fb[buf][q_][1] = *(const bf16x8*)(b1 + ko_); fb[buf][q_][2] = *(const bf16x8*)(b2 + ko_); fb[buf][q_][3] = *(const bf16x8*)(b3 + ko_); } } while (0)
#define SK_MMA(buf) do { _Pragma("unroll") for (int q_ = 0; q_ < 4; ++q_) { _Pragma("unroll") for (int j_ = 0; j_ < 4; ++j_) acc[j_] = __builtin_amdgcn_mfma_f32_16x16x32_bf16(fa[buf][q_], fb[buf][q_][j_], acc[j_], 0, 0, 0); } } while (0)
    SK_LOAD(0, 0);
#pragma unroll
    for (int kb = 0; kb < NBATCH; kb += 2) {
        SK_LOAD(1, kb + 1); SK_MMA(0);
        if (kb + 2 < NBATCH) SK_LOAD(0, kb + 2);
        SK_MMA(1);
    }
#undef SK_LOAD
#undef SK_MMA
}
__device__ __forceinline__ void sample_inproj(Frame& F, int pn, int hd, int rh) {
    const int lane = F.lane, w = F.wave & 3, kh = F.wave >> 2, rl = lane & 15, kq = lane >> 4;
    const bf16* HS = (const bf16*)(F.ws + WS_HS);
    const bf16* WINT = (const bf16*)(F.ws + WS_WINT);
    const bf16* bb = WINT + (size_t)(256 * pn + 32 * hd + rl) * 1024 + 512 * kh + 8 * kq;
    f32x4 acc[4];
    skinny_core<4>(HS + (size_t)(64 * rh + 16 * w + rl) * 1024 + 512 * kh + 8 * kq, bb, bb + 16 * 1024, bb + 128 * 1024, bb + 144 * 1024, acc);
    { LAS f32x4* red = (LAS f32x4*)(F.lds + RING_OFF);
      if (kh == 1) {
#pragma unroll
          for (int j = 0; j < 4; ++j) red[(w * 4 + j) * 64 + lane] = acc[j]; }
      __syncthreads();
      if (kh == 1) return;
#pragma unroll
      for (int j = 0; j < 4; ++j) acc[j] += red[(w * 4 + j) * 64 + lane]; }
    const int sbase = 64 * rh + 16 * w + 4 * kq;
    float* out = F.out;
    if (pn <= 1 || (pn == 2 && hd < 2)) {
        const float* nwp = pn <= 1 ? F.qnw : F.knw; const float sc = pn <= 1 ? C2 : 1.0f;
#pragma unroll
        for (int e = 0; e < 4; ++e) { float ss = 0.f;
#pragma unroll
            for (int j = 0; j < 4; ++j) ss += acc[j][e] * acc[j][e];
            ss += __shfl_xor(ss, 1); ss += __shfl_xor(ss, 2); ss += __shfl_xor(ss, 4); ss += __shfl_xor(ss, 8);
            const float rstd = 1.0f / sqrtf(ss * (1.0f / 64.0f) + EPS); const int s = sbase + e; const size_t m = (size_t)(MP + s);
#pragma unroll
            for (int j = 0; j < 4; ++j) { const int d = 16 * j + rl; const float o = acc[j][e] * rstd * nwp[d] * sc;
                if (pn <= 1) ((bf16*)(F.ws + WS_Q))[m * 512 + (4 * pn + hd) * 64 + d] = (bf16)f2bf(o);
                else { out[O_KS + (size_t)s * 128 + hd * 64 + d] = o; ((bf16*)(F.ws + WS_KB))[m * 128 + hd * 64 + d] = (bf16)f2bf(o); } } }
        return;
    }
    if (pn == 5 && hd == 1) {
        if (rl < 8) {
#pragma unroll
            for (int e = 0; e < 4; ++e) { const int s = sbase + e; ((float*)(F.ws + WS_WI))[(size_t)(MP + s) * 8 + rl] = acc[0][e] * WI_SCALE; } }
        return;
    }
    bf16* dst; int ld, cb; float* fo = nullptr; int fld = 0; bool act = false;
    if (pn == 2) { dst = (bf16*)(F.ws + WS_VB); ld = 128; cb = (hd - 2) * 64; fo = out + O_VS + cb; fld = 128; }
    else if (pn <= 4) { dst = (bf16*)(F.ws + WS_QI); ld = 512; cb = (4 * (pn - 3) + hd) * 64; }
    else if (pn == 5) { dst = (bf16*)(F.ws + WS_KI); ld = 64; cb = 0; fo = out + O_KIS; fld = 64; }
    else if (pn <= 7) { dst = (bf16*)(F.ws + WS_GA); ld = 512; cb = (4 * (pn - 6) + hd) * 64; act = true; }
    else if (pn <= 9) { dst = (bf16*)(F.ws + WS_U); ld = 512; cb = (4 * (pn - 8) + hd) * 64; fo = out + O_PS + 14 * 512 + cb; fld = 15 * 512; }
    else { dst = (bf16*)(F.ws + WS_GP); ld = 512; cb = (4 * (pn - 10) + hd) * 64; act = true; }
#pragma unroll
    for (int e = 0; e < 4; ++e) { const int s = sbase + e; const size_t m = (size_t)(MP + s);
#pragma unroll
        for (int j = 0; j < 4; ++j) { const int d = 16 * j + rl; float o = acc[j][e]; if (act) o = pg8::silu1(o);
            dst[m * ld + cb + d] = (bf16)f2bf(o);
            if (fo) fo[(size_t)s * fld + d] = o; } }
}
struct P1Pre { f32x4 v[2][4][4]; };
__device__ __forceinline__ void p1_prefetch(Frame& F, P1Pre& pre) {
    const int gw = F.vcu * NWAVES + F.wave, NGW = F.G * NWAVES;
#pragma unroll
    for (int k = 0; k < 2; ++k) { const int ch = gw + k * NGW; if (ch < MP / 4) norm_rows_load<4>(F, F.xp + (size_t)(4 * ch) * DM, pre.v[k]); }
}
__device__ __forceinline__ void p1_norm(Frame& F, P1Pre& pre) {
    const float* ada = (const float*)(F.ws + WS_ADA); bf16* HB = (bf16*)(F.ws + WS_HB); bf16* HS = (bf16*)(F.ws + WS_HS);
    const int gw = F.vcu * NWAVES + F.wave, NGW = F.G * NWAVES;
#pragma unroll
    for (int k = 0; k < 2; ++k) { const int ch = gw + k * NGW; if (ch < MP / 4) { const int m = 4 * ch; norm_rows_finish<4, true>(F, pre.v[k], ada + (size_t)(m >> 11) * 3072, 0, HB + (size_t)m * DM); } }
    for (int ch = gw + 2 * NGW; ch < MP / 4 + DECB / 2; ch += NGW) {
        if (ch < MP / 4) { const int m = 4 * ch; norm_rows<4, true>(F, F.xp + (size_t)m * DM, ada + (size_t)(m >> 11) * 3072, 0, HB + (size_t)m * DM); }
        else { const int s = 2 * (ch - MP / 4); norm_rows<2, false>(F, F.xs + (size_t)s * DM, ada + (size_t)(NB + s) * 3072, 3072, HS + (size_t)s * DM); } }
}
__device__ __forceinline__ void p2_sample(Frame& F) {
    const int task = F.bid >> 1, pn = task >> 2, hd = task & 3;
    if (F.bid < 96 && !(pn == 5 && hd >= 2)) { sample_inproj(F, pn, hd, F.bid & 1); __syncthreads(); }
}

constexpr int P3_KEYS = 0;
constexpr int P3_BM = 132096;
constexpr int P3_WQ = 136192;
constexpr int P3_QI = 136704;
constexpr int P3_AI_HS = 144, P3_AI_RS = 1152;
constexpr int P3_AQ_HS = 160, P3_AQ_RS = 1408;
constexpr int P3_QL = 159232;
constexpr int P3_XM = 159232;
constexpr int P3_VW = 0, P3_VWB = 4096;

__device__ __forceinline__ float relu_s(float x) { return __builtin_amdgcn_fmed3f(x, 0.0f, __builtin_inff()); }
__device__ __forceinline__ unsigned f2key(float f) { unsigned u = __float_as_uint(f); if (f == 0.0f) u = 0u; return (u & 0x80000000u) ? ~u : (u | 0x80000000u); }
__device__ __forceinline__ float key2f(unsigned k) { return __uint_as_float((k & 0x80000000u) ? (k ^ 0x80000000u) : ~k); }

__device__ __forceinline__ unsigned half_reduce_add(unsigned v) {
    v += (unsigned)__builtin_amdgcn_update_dpp(0, (int)v, 0xB1, 0xF, 0xF, true);
    v += (unsigned)__builtin_amdgcn_update_dpp(0, (int)v, 0x4E, 0xF, 0xF, true);
    v += (unsigned)__builtin_amdgcn_update_dpp(0, (int)v, 0x141, 0xF, 0xF, true);
    v += (unsigned)__builtin_amdgcn_update_dpp(0, (int)v, 0x140, 0xF, 0xF, true);
    v += (unsigned)__builtin_amdgcn_ds_swizzle((int)v, 0x401F);
    return v;
}
__device__ __forceinline__ float probit_f(float p) {
    const float pp = p < 0.5f ? p : 1.0f - p; const float t = sqrtf(-2.0f * __logf(pp));
    const float z = t - (2.515517f + t * (0.802853f + t * 0.010328f)) * __builtin_amdgcn_rcpf(1.0f + t * (1.432788f + t * (0.189269f + t * 0.001308f)));
    return p < 0.5f ? -z : z;
}
__device__ __forceinline__ unsigned half_reduce_min(unsigned v) {
    v = min(v, (unsigned)__builtin_amdgcn_update_dpp(0, (int)v, 0xB1, 0xF, 0xF, true)); v = min(v, (unsigned)__builtin_amdgcn_update_dpp(0, (int)v, 0x4E, 0xF, 0xF, true));
    v = min(v, (unsigned)__builtin_amdgcn_update_dpp(0, (int)v, 0x141, 0xF, 0xF, true)); v = min(v, (unsigned)__builtin_amdgcn_update_dpp(0, (int)v, 0x140, 0xF, 0xF, true));
    v = min(v, (unsigned)__builtin_amdgcn_ds_swizzle((int)v, 0x401F)); return v; }
__device__ __forceinline__ unsigned half_reduce_max(unsigned v) {
    v = max(v, (unsigned)__builtin_amdgcn_update_dpp(0, (int)v, 0xB1, 0xF, 0xF, true)); v = max(v, (unsigned)__builtin_amdgcn_update_dpp(0, (int)v, 0x4E, 0xF, 0xF, true));
    v = max(v, (unsigned)__builtin_amdgcn_update_dpp(0, (int)v, 0x141, 0xF, 0xF, true)); v = max(v, (unsigned)__builtin_amdgcn_update_dpp(0, (int)v, 0x140, 0xF, 0xF, true));
    v = max(v, (unsigned)__builtin_amdgcn_ds_swizzle((int)v, 0x401F)); return v; }
__device__ __forceinline__ unsigned wave_reduce_add_u(unsigned v) {
    v += (unsigned)__builtin_amdgcn_update_dpp(0, (int)v, 0xB1, 0xF, 0xF, true); v += (unsigned)__builtin_amdgcn_update_dpp(0, (int)v, 0x4E, 0xF, 0xF, true);
    v += (unsigned)__builtin_amdgcn_update_dpp(0, (int)v, 0x141, 0xF, 0xF, true); v += (unsigned)__builtin_amdgcn_update_dpp(0, (int)v, 0x140, 0xF, 0xF, true);
    return ((unsigned)__builtin_amdgcn_readlane((int)v, 0) + (unsigned)__builtin_amdgcn_readlane((int)v, 16)) + ((unsigned)__builtin_amdgcn_readlane((int)v, 32) + (unsigned)__builtin_amdgcn_readlane((int)v, 48)); }
__device__ __forceinline__ float row16_sum(float v) {
    v += __int_as_float(__builtin_amdgcn_update_dpp(0, __float_as_int(v), 0xB1, 0xF, 0xF, true)); v += __int_as_float(__builtin_amdgcn_update_dpp(0, __float_as_int(v), 0x4E, 0xF, 0xF, true));
    v += __int_as_float(__builtin_amdgcn_update_dpp(0, __float_as_int(v), 0x141, 0xF, 0xF, true)); v += __int_as_float(__builtin_amdgcn_update_dpp(0, __float_as_int(v), 0x140, 0xF, 0xF, true));
    return v; }
__device__ __forceinline__ float kq_max(float v) {
    auto a = __builtin_amdgcn_permlane16_swap(__float_as_uint(v), __float_as_uint(v), false, false); v = fmaxf(__uint_as_float(a[0]), __uint_as_float(a[1]));
    auto b = __builtin_amdgcn_permlane32_swap(__float_as_uint(v), __float_as_uint(v), false, false); return fmaxf(__uint_as_float(b[0]), __uint_as_float(b[1])); }
__device__ __forceinline__ float kq_sum(float v) {
    auto a = __builtin_amdgcn_permlane16_swap(__float_as_uint(v), __float_as_uint(v), false, false); v = __uint_as_float(a[0]) + __uint_as_float(a[1]);
    auto b = __builtin_amdgcn_permlane32_swap(__float_as_uint(v), __float_as_uint(v), false, false); return __uint_as_float(b[0]) + __uint_as_float(b[1]); }
__device__ __forceinline__ unsigned wave_reduce_min_u(unsigned v) { v = half_reduce_min(v); return min((unsigned)__builtin_amdgcn_readlane((int)v, 0), (unsigned)__builtin_amdgcn_readlane((int)v, 32)); }
__device__ __forceinline__ unsigned wave_reduce_max_u(unsigned v) { v = half_reduce_max(v); return max((unsigned)__builtin_amdgcn_readlane((int)v, 0), (unsigned)__builtin_amdgcn_readlane((int)v, 32)); }

struct P3Pre { v4u qi[2]; v4u qq[2]; float wqv; };
__device__ __forceinline__ void p3_prefetch(Frame& F, int b, int qt, P3Pre& pre) {
    const int tid = F.tid; const size_t mb = (size_t)b * SEQ; const int t0 = 16 * qt;
    const bf16* QI = (const bf16*)(F.ws + WS_QI); const bf16* Qg = (const bf16*)(F.ws + WS_Q);
#pragma unroll
    for (int k = 0; k < 2; ++k) { const int i = tid + 512 * k, row = i >> 6, ch = i & 63;
        pre.qi[k] = *(const v4u*)(QI + (mb + t0 + row) * 512 + ch * 8); pre.qq[k] = *(const v4u*)(Qg + (mb + t0 + row) * 512 + ch * 8); }
    pre.wqv = ((const float*)(F.ws + WS_WI))[(mb + t0 + ((tid & 127) >> 3)) * 8 + (tid & 7)];
}
__device__ __forceinline__ void p3_prompt_item(Frame& F, int b, int qt, P3Pre& pre, bool has_next, int nb, int nqt) {
    int tid_o_ = F.tid; asm volatile("" : "+v"(tid_o_));
    const int tid = tid_o_, lane = tid & 63, w = F.wave, r = lane & 31, hh = lane >> 5;
    const int t0 = 16 * qt, L = t0 + 16, nkt32 = (L + 31) >> 5, nkt64 = (L + 63) >> 6;
    const size_t mb = (size_t)b * SEQ;
    LAS unsigned* bm = (LAS unsigned*)(F.lds + P3_BM);
    LAS float* wq = (LAS float*)(F.lds + P3_WQ);
    LAS unsigned* keys = (LAS unsigned*)(F.lds + P3_KEYS);
    v4u qreg[2] = {pre.qq[0], pre.qq[1]};
    if (tid < 128) wq[tid] = pre.wqv;
#pragma unroll
    for (int k = 0; k < 2; ++k) { const int i = tid + 512 * k, row = i >> 6, ch = i & 63; *(LAS v4u*)(F.lds + P3_QI + row * P3_AI_RS + (ch >> 3) * P3_AI_HS + (ch & 7) * 16) = pre.qi[k]; }
    bf16x8 bb[3][4];
    { const bf16* KI_ = (const bf16*)(F.ws + WS_KI); const int ns_ = (nkt32 - w + 7) >> 3;
      if (0 < ns_) { const bf16* kp_ = KI_ + (mb + 32 * w + r) * 64 + 8 * hh;
#pragma unroll
          for (int ks_ = 0; ks_ < 4; ++ks_) bb[0][ks_] = *(const bf16x8*)(kp_ + 16 * ks_); }
      if (1 < ns_) { const bf16* kp_ = KI_ + (mb + 32 * (w + 8) + r) * 64 + 8 * hh;
#pragma unroll
          for (int ks_ = 0; ks_ < 4; ++ks_) bb[1][ks_] = *(const bf16x8*)(kp_ + 16 * ks_); } }
    __syncthreads();
    { LAS unsigned short* ql = (LAS unsigned short*)(F.lds + P3_QL);
#pragma unroll
      for (int k = 0; k < 2; ++k) { const int i = tid + 512 * k, qq = i >> 6, d = i & 63; float s = 0.f;
#pragma unroll
          for (int h = 0; h < 8; ++h) s += wq[qq * 8 + h] * bf2f(*(const LAS unsigned short*)(F.lds + P3_QI + qq * P3_AI_RS + h * P3_AI_HS + d * 2));
          ql[qq * 64 + d] = (unsigned short)f2bf(s); } }
    __syncthreads();
    FSTAMP();
    for (int rep1_ = 0; rep1_ < REP_S1; ++rep1_) {
        const bf16* KI = (const bf16*)(F.ws + WS_KI);
        const int ns = (nkt32 - w + 7) >> 3;
#define P3_LDK(slot) do { const bf16* kp_ = KI + (mb + 32 * (w + 8 * (slot)) + r) * 64 + 8 * hh; \
        _Pragma("unroll") for (int ks_ = 0; ks_ < 4; ++ks_) bb[(slot) % 3][ks_] = *(const bf16x8*)(kp_ + 16 * ks_); } while (0)
        const int arow = (2 * ((r >> 2) & 1) + (r >> 4)) * P3_AI_RS + ((r & 3) + 4 * ((r >> 3) & 1)) * P3_AI_HS + 16 * hh;
        const LAS unsigned char* qib = F.lds + P3_QI;
        const int lq_ = 4 * ((((r & 3) + 4 * (r >> 3)) >> 1) & 3) + 2 * ((r >> 2) & 1) + (r & 1);
        const LAS unsigned char* qlb = F.lds + P3_QL + lq_ * 128 + 16 * hh;
#define P3_MM(ACC, a, s) do { _Pragma("unroll") for (int e_ = 0; e_ < 16; ++e_) ACC[e_] = 0.f; \
        _Pragma("unroll") for (int ks_ = 0; ks_ < 4; ++ks_) { const bf16x8 af_ = *(const LAS bf16x8*)(qs_ + 4 * (a) * P3_AI_RS + arow + 32 * ks_); \
            ACC = __builtin_amdgcn_mfma_f32_32x32x16_bf16(af_, bb[(s) % 3][ks_], ACC, 0, 0, 0); } } while (0)
#define P3_EPI(ACC, a, s, u_) do { _Pragma("unroll") for (int j2_ = 0; j2_ < 2; ++j2_) { const int qq_ = 4 * (a) + 2 * hh + j2_; \
        const LAS f32x4* wp_ = (const LAS f32x4*)(wq + qq_ * 8); const f32x4 w0_ = wp_[0], w1_ = wp_[1]; \
        float sc_ = accL[2 * (a) + j2_]; sc_ = fmaf(w0_[0], fabsf(ACC[8 * j2_ + 0]), sc_); sc_ = fmaf(w0_[1], fabsf(ACC[8 * j2_ + 1]), sc_); sc_ = fmaf(w0_[2], fabsf(ACC[8 * j2_ + 2]), sc_); sc_ = fmaf(w0_[3], fabsf(ACC[8 * j2_ + 3]), sc_); \
        sc_ = fmaf(w1_[0], fabsf(ACC[8 * j2_ + 4]), sc_); sc_ = fmaf(w1_[1], fabsf(ACC[8 * j2_ + 5]), sc_); sc_ = fmaf(w1_[2], fabsf(ACC[8 * j2_ + 6]), sc_); sc_ = fmaf(w1_[3], fabsf(ACC[8 * j2_ + 7]), sc_); \
        keys[qq_ * 2048 + 32 * (w + 8 * (s)) + r] = f2key(sc_); } } while (0)
#define P3_MML(ACC, s) do { _Pragma("unroll") for (int e_ = 0; e_ < 16; ++e_) ACC[e_] = 0.f; \
        _Pragma("unroll") for (int ks_ = 0; ks_ < 4; ++ks_) { bf16x8 af_ = (bf16x8){0, 0, 0, 0, 0, 0, 0, 0}; if (r < 16) af_ = *(const LAS bf16x8*)(qlb + zo_ + 32 * ks_); \
            ACC = __builtin_amdgcn_mfma_f32_32x32x16_bf16(af_, bb[(s) % 3][ks_], ACC, 0, 0, 0); } } while (0)
#pragma unroll 1
        for (int s0 = 0; s0 < ns; s0 += 3) {
#pragma unroll
            for (int u = 0; u < 3; ++u) { const int s = s0 + u;
                if (s < ns) {
                    if (s + 2 < ns) { const bf16* kp_ = KI + (mb + 32 * (w + 8 * (s + 2)) + r) * 64 + 8 * hh;
#pragma unroll
                        for (int ks_ = 0; ks_ < 4; ++ks_) bb[(u + 2) % 3][ks_] = *(const bf16x8*)(kp_ + 16 * ks_); }
                    int zo_ = 0; asm volatile("" : "+v"(zo_));
                    const LAS unsigned char* qs_ = qib + zo_;
                    f32x16 accA, accB, accL;
                    P3_MML(accL, u);
                    P3_MM(accA, 0, u); P3_MM(accB, 1, u);
                    P3_EPI(accA, 0, s, u); P3_MM(accA, 2, u);
                    P3_EPI(accB, 1, s, u); P3_MM(accB, 3, u);
                    P3_EPI(accA, 2, s, u); P3_EPI(accB, 3, s, u);
                }
            }
        }
#undef P3_MM
#undef P3_MML
#undef P3_EPI
#undef P3_LDK
    }
    __syncthreads();
    FSTAMP();
    {
#pragma unroll
      for (int k = 0; k < 2; ++k) { const int i = tid + 512 * k, row = i >> 6, ch = i & 63; *(LAS v4u*)(F.lds + P3_QI + row * P3_AQ_RS + (ch >> 3) * P3_AQ_HS + (ch & 7) * 16) = qreg[k]; } }
    bf16x8 kf0[2][2]; v4u vr0[4];
    { const int g_ = w & 1, kq4_ = w >> 1, j_ = lane & 15, kq_ = lane >> 4;
      if (kq4_ < nkt32) {
#pragma unroll
          for (int c = 0; c < 2; ++c)
#pragma unroll
              for (int ks = 0; ks < 2; ++ks) kf0[c][ks] = *(const bf16x8*)((const bf16*)(F.ws + WS_KB) + (mb + 32 * kq4_ + 16 * c + j_) * 128 + g_ * 64 + 32 * ks + 8 * kq_);
#pragma unroll
          for (int i = 0; i < 4; ++i) vr0[i] = *(const v4u*)((const bf16*)(F.ws + WS_VB) + (mb + 32 * kq4_ + 8 * i + (lane >> 3)) * 128 + g_ * 64 + (lane & 7) * 8); } }
    for (int rep2_ = 0; rep2_ < REP_S2; ++rep2_) {
        int lane_ = F.lane; asm volatile("" : "+v"(lane_));
#define lane lane_
        const int qx0 = 2 * w, tq0 = t0 + qx0;
        unsigned sel0, sel1;
        if (t0 + 16 <= 256) {
            sel0 = 0u; sel1 = 0u;
#pragma unroll
            for (int jj = 0; jj < 32; ++jj) { sel0 |= (64 * jj + lane <= tq0) ? (1u << jj) : 0u; sel1 |= (64 * jj + lane <= tq0 + 1) ? (1u << jj) : 0u; }
        } else {
            unsigned x[32], y[32];
#pragma unroll
            for (int jj = 0; jj < 32; ++jj) { const int l = 64 * jj + lane; x[jj] = (l <= tq0) ? keys[qx0 * 2048 + l] : 0u; y[jj] = (l <= tq0 + 1) ? keys[(qx0 + 1) * 2048 + l] : 0u; }
#pragma unroll
            for (int st = 0; st < 5; ++st) { const int j = 16 >> st; const unsigned m = st == 0 ? 0x0000ffffu : st == 1 ? 0x00ff00ffu : st == 2 ? 0x0f0f0f0fu : st == 3 ? 0x33333333u : 0x55555555u;
#pragma unroll
                for (int k = 0; k < 32; ++k) if (!(k & j)) { const unsigned t_ = ((x[k] >> j) ^ x[k + j]) & m; x[k] ^= t_ << j; x[k + j] ^= t_;
                    const unsigned u_ = ((y[k] >> j) ^ y[k + j]) & m; y[k] ^= u_ << j; y[k + j] ^= u_; } }
            unsigned cur0 = 0xffffffffu, gt0 = 0u, cur1 = 0xffffffffu, gt1 = 0u; int ab0 = 0, ab1 = 0;
#pragma unroll
            for (int b = 31; b >= 0; --b) { const unsigned c0 = cur0 & x[b], c1 = cur1 & y[b];
                const unsigned pk = wave_reduce_add_u((unsigned)__popc(c0) | ((unsigned)__popc(c1) << 16)); const int n0 = (int)(pk & 0xffffu), n1 = (int)(pk >> 16);
                if (ab0 + n0 >= 256) cur0 = c0; else { ab0 += n0; gt0 |= c0; cur0 &= ~x[b]; }
                if (ab1 + n1 >= 256) cur1 = c1; else { ab1 += n1; gt1 |= c1; cur1 &= ~y[b]; } }
            const unsigned pke = wave_reduce_add_u((unsigned)__popc(cur0) | ((unsigned)__popc(cur1) << 16));
            const unsigned long long lt = (1ull << lane) - 1ull;
            { int need = 256 - ab0; if ((int)(pke & 0xffffu) == need) sel0 = gt0 | cur0;
              else { sel0 = gt0;
                for (int jj = 0; jj < 32; ++jj) { const unsigned long long meq = __ballot((cur0 >> jj) & 1u);
                    if (((cur0 >> jj) & 1u) && __popcll(meq & lt) < need) sel0 |= 1u << jj;
                    const int pc_ = __popcll(meq); need = need > pc_ ? need - pc_ : 0; } } }
            { int need = 256 - ab1; if ((int)(pke >> 16) == need) sel1 = gt1 | cur1;
              else { sel1 = gt1;
                for (int jj = 0; jj < 32; ++jj) { const unsigned long long meq = __ballot((cur1 >> jj) & 1u);
                    if (((cur1 >> jj) & 1u) && __popcll(meq & lt) < need) sel1 |= 1u << jj;
                    const int pc_ = __popcll(meq); need = need > pc_ ? need - pc_ : 0; } } }
        }
#pragma unroll
        for (int jj = 0; jj < 32; ++jj) { const unsigned long long b0 = __ballot((sel0 >> jj) & 1u), b1 = __ballot((sel1 >> jj) & 1u);
            if (lane == 0) { bm[qx0 * 64 + 2 * jj] = (unsigned)b0; bm[qx0 * 64 + 2 * jj + 1] = (unsigned)(b0 >> 32); bm[(qx0 + 1) * 64 + 2 * jj] = (unsigned)b1; bm[(qx0 + 1) * 64 + 2 * jj + 1] = (unsigned)(b1 >> 32); } }
#undef lane
    }
    __syncthreads();
#if TEST_MODE
    { unsigned* dbg = (unsigned*)(F.ws + WS_DBG_BM) + (mb + t0) * 64; for (int i = tid; i < 1024; i += NWAVES * 64) dbg[i] = bm[i]; }
#endif
    FSTAMP();
    for (int rep4_ = 0; rep4_ < REP_S4; ++rep4_) {
        int l4_ = lane; asm volatile("" : "+v"(l4_));
        const int g = w & 1, kq4 = w >> 1, j = l4_ & 15, kq = l4_ >> 4;
        const bf16* Q = (const bf16*)(F.ws + WS_Q); const bf16* KB = (const bf16*)(F.ws + WS_KB); const bf16* VB = (const bf16*)(F.ws + WS_VB);
        const LAS unsigned char* qlb = F.lds + P3_QI + (j >> 2) * P3_AQ_RS + (4 * g + (j & 3)) * P3_AQ_HS + 16 * kq;
        bf16x8 qf[4][2];
#pragma unroll
        for (int rb = 0; rb < 4; ++rb)
#pragma unroll
            for (int ks = 0; ks < 2; ++ks) qf[rb][ks] = *(const LAS bf16x8*)(qlb + 4 * rb * P3_AQ_RS + 64 * ks);
        f32x4 o[4][4];
#pragma unroll
        for (int dt = 0; dt < 4; ++dt)
#pragma unroll
            for (int rb = 0; rb < 4; ++rb) o[dt][rb] = (f32x4){0.f, 0.f, 0.f, 0.f};
        float mref[4], lsum[4]; f32x4 negm[4];
#pragma unroll
        for (int rb = 0; rb < 4; ++rb) { mref[rb] = 0.f; lsum[rb] = 0.f; negm[rb] = (f32x4){0.f, 0.f, 0.f, 0.f}; }
        const int ntw = (nkt32 - kq4 + 3) >> 2;
        LAS unsigned char* vst = F.lds + P3_VW + w * (3 * P3_VWB);
        bf16x8 kf[2][2];
        const bf16* kgp = KB + (mb + j) * 128 + g * 64 + 8 * kq;
        const bf16* vgp = VB + (mb + (l4_ >> 3)) * 128 + g * 64 + (l4_ & 7) * 8;
#define P4_LOADK(dst, kt_) do { _Pragma("unroll") for (int c_ = 0; c_ < 2; ++c_) _Pragma("unroll") for (int ks_ = 0; ks_ < 2; ++ks_) dst[c_][ks_] = *(const bf16x8*)(kgp + (size_t)(32 * (kt_) + 16 * c_) * 128 + 32 * ks_); } while (0)
        const unsigned vst_u = (unsigned)(size_t)vst;
#define P4_DMAV(kt_, buf_) do { _Pragma("unroll") for (int i_ = 0; i_ < 4; ++i_) { unsigned keep_; const void* gs_ = (const void*)(vgp + (size_t)(32 * (kt_) + 8 * i_) * 128); \
        const unsigned ld_ = (unsigned)__builtin_amdgcn_readfirstlane((int)(vst_u + (buf_) * P3_VWB + i_ * 1024)); \
        asm volatile("s_mov_b32 %0, m0\n\ts_mov_b32 m0, %2\n\ts_nop 0\n\tglobal_load_lds_dwordx4 %1, off\n\ts_mov_b32 m0, %0" : "=&s"(keep_) : "v"(gs_), "s"(ld_) : "memory"); } } while (0)
        if (ntw > 0) {
#pragma unroll
            for (int c = 0; c < 2; ++c) { kf[c][0] = kf0[c][0]; kf[c][1] = kf0[c][1]; }
#pragma unroll
            for (int i = 0; i < 4; ++i) *(LAS v4u*)(vst + i * 1024 + l4_ * 16) = vr0[i]; }
        if (ntw > 1) { P4_DMAV(kq4 + 4, 1); }
        int vb_cur = 0;
#if TEST_MODE == 5
        unsigned long long tacc_[5] = {0, 0, 0, 0, 0}; unsigned long long tprev_ = __builtin_amdgcn_s_memtime();
#define TSEC(i) do { __builtin_amdgcn_sched_barrier(0); const unsigned long long tn_ = __builtin_amdgcn_s_memtime(); tacc_[i] += tn_ - tprev_; tprev_ = tn_; __builtin_amdgcn_sched_barrier(0); } while (0)
#else
#define TSEC(i) do { } while (0)
#endif
        for (int ti = 0; ti < ntw; ++ti) {
            const int kt = kq4 + 4 * ti;
            TSEC(4);
            asm volatile("s_waitcnt vmcnt(0)" ::: "memory");
            const int vb_n2 = vb_cur == 0 ? 2 : vb_cur - 1;
            if (ti + 2 < ntw) { P4_DMAV(kt + 8, vb_n2); }
            TSEC(0);
            f32x4 sa[2][4];
#pragma unroll
            for (int c = 0; c < 2; ++c)
#pragma unroll
                for (int ks = 0; ks < 2; ++ks)
#pragma unroll
                    for (int rb = 0; rb < 4; ++rb) sa[c][rb] = __builtin_amdgcn_mfma_f32_16x16x32_bf16(kf[c][ks], qf[rb][ks], ks == 0 ? negm[rb] : sa[c][rb], 0, 0, 0);
            if (ti + 1 < ntw) { P4_LOADK(kf, kt + 4); }
            TSEC(1);
            float tmax[4];
#pragma unroll
            for (int rb = 0; rb < 4; ++rb) { const int wd = (int)(bm[(4 * rb + (j >> 2)) * 64 + kt] >> (4 * kq)); float tm = -INFINITY;
#pragma unroll
                for (int c = 0; c < 2; ++c)
#pragma unroll
                    for (int e = 0; e < 4; ++e) { const unsigned keep = (unsigned)__builtin_amdgcn_sbfe(wd, 16 * c + e, 1);
                        const float v = __uint_as_float((__float_as_uint(sa[c][rb][e]) & keep) | (0xff800000u & ~keep)); sa[c][rb][e] = v; tm = fmaxf(tm, v); }
                tmax[rb] = tm; }
#pragma unroll
            for (int rb = 0; rb < 4; ++rb) tmax[rb] = kq_max(tmax[rb]);
            if (ti == 0 || __any(tmax[0] > 0.f || tmax[1] > 0.f || tmax[2] > 0.f || tmax[3] > 0.f)) {
#pragma unroll
                for (int rb = 0; rb < 4; ++rb) { const float dl = (ti == 0) ? ((tmax[rb] == -INFINITY) ? 0.f : tmax[rb]) : fmaxf(tmax[rb], 0.f); const float alpha = __builtin_amdgcn_exp2f(-dl); mref[rb] += dl; lsum[rb] *= alpha;
                    negm[rb] = (f32x4){-mref[rb], -mref[rb], -mref[rb], -mref[rb]};
#pragma unroll
                    for (int c = 0; c < 2; ++c) sa[c][rb] -= dl;
#pragma unroll
                    for (int dt = 0; dt < 4; ++dt) o[dt][rb] *= alpha; } }
            bf16x8 pf[4];
#pragma unroll
            for (int rb = 0; rb < 4; ++rb) { float ps = 0.f;
#pragma unroll
                for (int c = 0; c < 2; ++c)
#pragma unroll
                    for (int e = 0; e < 4; ++e) { const float p = __builtin_amdgcn_exp2f(sa[c][rb][e]); sa[c][rb][e] = p; ps += p; }
                lsum[rb] += ps;
                v4u pw; pw.x = pk2(sa[0][rb][0], sa[0][rb][1]); pw.y = pk2(sa[0][rb][2], sa[0][rb][3]); pw.z = pk2(sa[1][rb][0], sa[1][rb][1]); pw.w = pk2(sa[1][rb][2], sa[1][rb][3]);
                pf[rb] = __builtin_bit_cast(bf16x8, pw); }
            TSEC(2);
            { const LAS unsigned char* vb = vst + vb_cur * P3_VWB + (4 * kq + (j >> 2)) * 128 + (4 * (j & 3)) * 2;
              typedef short v4i16_t __attribute__((ext_vector_type(4)));
#pragma unroll
              for (int dt = 0; dt < 4; ++dt) {
                  const v4i16_t lo4 = __builtin_amdgcn_ds_read_tr16_b64_v4i16((LAS v4i16_t*)(vb + 32 * dt));
                  const v4i16_t hi4 = __builtin_amdgcn_ds_read_tr16_b64_v4i16((LAS v4i16_t*)(vb + 32 * dt + 16 * 128));
                  const bf16x8 vf = (bf16x8){lo4[0], lo4[1], lo4[2], lo4[3], hi4[0], hi4[1], hi4[2], hi4[3]};
#pragma unroll
                  for (int rb = 0; rb < 4; ++rb) o[dt][rb] = __builtin_amdgcn_mfma_f32_16x16x32_bf16(vf, pf[rb], o[dt][rb], 0, 0, 0); } }
            TSEC(3);
            vb_cur = vb_cur == 2 ? 0 : vb_cur + 1;
        }
#undef P4_LOADK
#if TEST_MODE == 5
        if (blockIdx.x == STAMP_BLK && threadIdx.x == 0) { unsigned* st_ = (unsigned*)(F.ws + WS_CTL + 900 * 1024); for (int i_ = 0; i_ < 5; ++i_) atomicAdd(st_ + 8 + i_, (unsigned)(tacc_[i_] >> 4)); atomicAdd(st_ + 13, (unsigned)ntw); }
#endif
#undef TSEC
#undef P4_DMAV
#pragma unroll
        for (int rb = 0; rb < 4; ++rb) lsum[rb] = kq_sum(lsum[rb]);
        if (has_next && rep4_ == REP_S4 - 1) p3_prefetch(F, nb, nqt, pre);
        const size_t mrow_m = mb + t0 + 4 * kq4 + (j >> 2); const int hd_m = 4 * g + (j & 3);
        v2u gvm[4];
#pragma unroll
        for (int dt = 0; dt < 4; ++dt) gvm[dt] = *(const v2u*)((const bf16*)(F.ws + WS_GA) + mrow_m * 512 + hd_m * 64 + 16 * dt + 4 * kq);
        __syncthreads();
        {
            LAS unsigned char* xo = F.lds + ((g * 4 + kq4) * 4) * 4096; LAS float* xm = (LAS float*)(F.lds + P3_XM) + ((g * 4 + kq4) * 4) * 32;
#pragma unroll
            for (int rb = 0; rb < 4; ++rb) {
#pragma unroll
                for (int dt = 0; dt < 4; ++dt) *(LAS f32x4*)(xo + rb * 4096 + dt * 1024 + l4_ * 16) = o[dt][rb];
                if (kq == 0) { xm[rb * 32 + j] = (lsum[rb] > 0.f) ? mref[rb] : -INFINITY; xm[rb * 32 + 16 + j] = lsum[rb]; } }
        }
        __syncthreads();
        {
            const int rb = kq4; float ms[4], ls[4]; float M = -INFINITY;
#pragma unroll
            for (int s4 = 0; s4 < 4; ++s4) { const LAS float* xm = (const LAS float*)(F.lds + P3_XM) + ((g * 4 + s4) * 4 + rb) * 32; ms[s4] = xm[j]; ls[s4] = xm[16 + j]; M = fmaxf(M, ms[s4]); }
            float Lt = 0.f; f32x4 oo[4];
#pragma unroll
            for (int dt = 0; dt < 4; ++dt) oo[dt] = (f32x4){0.f, 0.f, 0.f, 0.f};
#pragma unroll
            for (int s4 = 0; s4 < 4; ++s4) { const float sc = __builtin_amdgcn_exp2f(ms[s4] - M); Lt += ls[s4] * sc;
                const LAS unsigned char* xo = F.lds + (((g * 4 + s4) * 4) + rb) * 4096;
#pragma unroll
                for (int dt = 0; dt < 4; ++dt) oo[dt] += *(const LAS f32x4*)(xo + dt * 1024 + l4_ * 16) * sc; }
            const float inv = 1.0f / Lt;
            const size_t mrow = mrow_m; const int hd = hd_m;
            bf16* MIX = (bf16*)(F.ws + WS_MIX);
#pragma unroll
            for (int dt = 0; dt < 4; ++dt) { const int d = 16 * dt + 4 * kq; const v2u gv = gvm[dt];
                const float g0 = bf2f((unsigned short)(gv.x & 0xffffu)), g1 = bf2f((unsigned short)(gv.x >> 16)), g2 = bf2f((unsigned short)(gv.y & 0xffffu)), g3 = bf2f((unsigned short)(gv.y >> 16));
                v2u ov; ov.x = pk2(oo[dt][0] * inv * g0, oo[dt][1] * inv * g1); ov.y = pk2(oo[dt][2] * inv * g2, oo[dt][3] * inv * g3);
                *(v2u*)(MIX + mrow * 1024 + hd * 64 + d) = ov; }
        }
        if (REP_S4 > 1) __syncthreads();
    }
}

constexpr int PL_U = 0, PL_W = 40960, PL_STRIDE = 272;
template <bool SAMPLE> __device__ __forceinline__ void p3_pool_item(Frame& F, int item) {
    const int tid = F.tid, lane = F.lane, w = F.wave, j = lane & 15, kq = lane >> 4;
    const bf16* U = (const bf16*)(F.ws + WS_U); const bf16* GP = (const bf16*)(F.ws + WS_GP); const bf16* WPT = (const bf16*)(F.ws + WS_WPOOLT); bf16* MIX = (bf16*)(F.ws + WS_MIX);
    const int tokb = SAMPLE ? 0 : (item & 15) * 128;
    const size_t m0 = SAMPLE ? (size_t)MP : (size_t)(item >> 4) * SEQ + tokb;
    const int tl = 16 * w + j;
    const size_t mrow = m0 + tl;
    v4u wr_[4], ur_[5];
#define PL_LOAD(gg) do { _Pragma("unroll") for (int k_ = 0; k_ < 4; ++k_) { const int i_ = tid + 512 * k_; wr_[k_] = *(const v4u*)(WPT + (size_t)(gg) * 16384 + (i_ >> 4) * 128 + (i_ & 15) * 8); } \
        if (!SAMPLE) { _Pragma("unroll") for (int k_ = 0; k_ < 5; ++k_) { const int i_ = tid + 512 * k_; const int row_ = i_ >> 4, ch_ = i_ & 15; ur_[k_] = (v4u){0u, 0u, 0u, 0u}; \
            if (i_ < 143 * 16 && tokb - 15 + row_ >= 0) ur_[k_] = *(const v4u*)(U + (m0 - 15 + row_) * 512 + (gg) * 128 + ch_ * 8); } } } while (0)
#define PL_STORE() do { _Pragma("unroll") for (int k_ = 0; k_ < 4; ++k_) { const int i_ = tid + 512 * k_; *(LAS v4u*)(F.lds + PL_W + (i_ >> 4) * PL_STRIDE + (i_ & 15) * 16) = wr_[k_]; } \
        if (!SAMPLE) { _Pragma("unroll") for (int k_ = 0; k_ < 5; ++k_) { const int i_ = tid + 512 * k_; if (i_ < 143 * 16) *(LAS v4u*)(F.lds + PL_U + (i_ >> 4) * PL_STRIDE + (i_ & 15) * 16) = ur_[k_]; } } } while (0)
    PL_LOAD(0);
#pragma unroll
    for (int g = 0; g < 4; ++g) {
        const int win = 2 << g;
        PL_STORE();
        __syncthreads();
        if (g + 1 < 4) PL_LOAD(g + 1);
        bf16x8 df[4];
#pragma unroll
        for (int ks = 0; ks < 4; ++ks) {
            float sum[8], cur[8];
            if (!SAMPLE) {
                const LAS unsigned char* up = F.lds + PL_U + (15 + tl) * PL_STRIDE + (4 * ks + kq) * 16;
                { const v4u c = *(const LAS v4u*)up;
#pragma unroll
                  for (int u = 0; u < 4; ++u) { const unsigned x = c[u]; cur[2 * u] = bf2f((unsigned short)(x & 0xffffu)); cur[2 * u + 1] = bf2f((unsigned short)(x >> 16)); sum[2 * u] = cur[2 * u]; sum[2 * u + 1] = cur[2 * u + 1]; } }
#pragma unroll
                for (int i = 1; i < win; ++i) { const v4u c = *(const LAS v4u*)(up - i * PL_STRIDE);
#pragma unroll
                    for (int u = 0; u < 4; ++u) { const unsigned x = c[u]; sum[2 * u] += bf2f((unsigned short)(x & 0xffffu)); sum[2 * u + 1] += bf2f((unsigned short)(x >> 16)); } }
            } else {
                const int c0 = g * 128 + 32 * ks + 8 * kq;
                { const v4u c = *(const v4u*)(U + mrow * 512 + c0);
#pragma unroll
                  for (int u = 0; u < 4; ++u) { const unsigned x = c[u]; cur[2 * u] = bf2f((unsigned short)(x & 0xffffu)); cur[2 * u + 1] = bf2f((unsigned short)(x >> 16)); sum[2 * u] = cur[2 * u]; sum[2 * u + 1] = cur[2 * u + 1]; } }
#pragma unroll
                for (int i = 1; i < win; ++i) { const float* sp = F.state_pool + ((size_t)tl * 15 + (15 - i)) * 512 + c0; const f32x4 a = *(const f32x4*)sp, bq = *(const f32x4*)(sp + 4);
                    sum[0] += a[0]; sum[1] += a[1]; sum[2] += a[2]; sum[3] += a[3]; sum[4] += bq[0]; sum[5] += bq[1]; sum[6] += bq[2]; sum[7] += bq[3]; }
            }
            const int tpos = tokb + tl; const float rc = 1.0f / (float)(SAMPLE ? win : ((tpos + 1 < win) ? tpos + 1 : win));
            v4u pw; pw.x = pk2(sum[0] * rc - cur[0], sum[1] * rc - cur[1]); pw.y = pk2(sum[2] * rc - cur[2], sum[3] * rc - cur[3]);
            pw.z = pk2(sum[4] * rc - cur[4], sum[5] * rc - cur[5]); pw.w = pk2(sum[6] * rc - cur[6], sum[7] * rc - cur[7]);
            df[ks] = __builtin_bit_cast(bf16x8, pw);
        }
#pragma unroll
        for (int jt = 0; jt < 8; ++jt) {
            f32x4 acc = (f32x4){0.f, 0.f, 0.f, 0.f};
#pragma unroll
            for (int ks = 0; ks < 4; ++ks) { const bf16x8 wf = *(const LAS bf16x8*)(F.lds + PL_W + (16 * jt + j) * PL_STRIDE + (4 * ks + kq) * 16);
                acc = __builtin_amdgcn_mfma_f32_16x16x32_bf16(wf, df[ks], acc, 0, 0, 0); }
            const int col = g * 128 + 16 * jt + 4 * kq;
            const f32x4 ps = *(const f32x4*)(F.pool_scale + col); const v2u gv = *(const v2u*)(GP + mrow * 512 + col);
            const float g0 = bf2f((unsigned short)(gv.x & 0xffffu)), g1 = bf2f((unsigned short)(gv.x >> 16)), g2 = bf2f((unsigned short)(gv.y & 0xffffu)), g3 = bf2f((unsigned short)(gv.y >> 16));
            v2u ov; ov.x = pk2(acc[0] * ps[0] * g0, acc[1] * ps[1] * g1); ov.y = pk2(acc[2] * ps[2] * g2, acc[3] * ps[3] * g3);
            *(v2u*)(MIX + mrow * 1024 + 512 + col) = ov;
        }
        __syncthreads();
    }
#undef PL_LOAD
#undef PL_STORE
}

constexpr int SM_SC = 0, SM_SEL = 8448, SM_Q = 9472, SM_P = 11520, SM_RED = 19712, SM_PT = 36096;
__device__ __forceinline__ void p3_sample_item(Frame& F, int s) {
    const int tid = F.tid, lane = F.lane, w = F.wave, r = lane & 31, hh = lane >> 5;
    const size_t m = (size_t)MP + s;
    LAS float* sc = (LAS float*)(F.lds + SM_SC); LAS int* sel = (LAS int*)(F.lds + SM_SEL); LAS float* ql = (LAS float*)(F.lds + SM_Q);
    LAS float* pl = (LAS float*)(F.lds + SM_P); LAS float* red = (LAS float*)(F.lds + SM_RED); LAS int* ptl = (LAS int*)(F.lds + SM_PT);
    const bf16* QI = (const bf16*)(F.ws + WS_QI) + m * 512; const float* WIp = (const float*)(F.ws + WS_WI) + m * 8;
    const int* pt = F.page_table + s * NPG;
    ql[tid] = bf2f(((const bf16*)(F.ws + WS_Q))[m * 512 + tid]);
    if (tid < NPG) ptl[tid] = pt[tid];
    {
        bf16x8 af[4];
#pragma unroll
        for (int ks = 0; ks < 4; ++ks) { af[ks] = (bf16x8){0, 0, 0, 0, 0, 0, 0, 0}; if (r < 8) af[ks] = *(const bf16x8*)(QI + r * 64 + 16 * ks + 8 * hh); }
        float wv[4];
#pragma unroll
        for (int e = 0; e < 4; ++e) wv[e] = WIp[4 * hh + e];
        int pg[8];
#pragma unroll
        for (int it = 0; it < 8; ++it) pg[it] = pt[(w + 8 * it) >> 2];
#pragma unroll
        for (int hf = 0; hf < 2; ++hf) {
            f32x4 x0[4][4], x1[4][4];
#pragma unroll
            for (int i4 = 0; i4 < 4; ++i4) { const int kt = w + 8 * (4 * hf + i4);
                const float* kp = F.cache_kidx + ((size_t)pg[4 * hf + i4] * PAGE + (kt & 3) * 32 + r) * 64 + 8 * hh;
#pragma unroll
                for (int ks = 0; ks < 4; ++ks) { x0[i4][ks] = *(const f32x4*)(kp + 16 * ks); x1[i4][ks] = *(const f32x4*)(kp + 16 * ks + 4); } }
#pragma unroll
            for (int i4 = 0; i4 < 4; ++i4) { const int kt = w + 8 * (4 * hf + i4);
                f32x16 acc;
#pragma unroll
                for (int e = 0; e < 16; ++e) acc[e] = 0.f;
#pragma unroll
                for (int ks = 0; ks < 4; ++ks) {
                    v4u pw; pw.x = pk2(x0[i4][ks][0], x0[i4][ks][1]); pw.y = pk2(x0[i4][ks][2], x0[i4][ks][3]); pw.z = pk2(x1[i4][ks][0], x1[i4][ks][1]); pw.w = pk2(x1[i4][ks][2], x1[i4][ks][3]);
                    acc = __builtin_amdgcn_mfma_f32_32x32x16_bf16(af[ks], __builtin_bit_cast(bf16x8, pw), acc, 0, 0, 0); }
                float part = wv[0] * fmaxf(acc[0], 0.f) + wv[1] * fmaxf(acc[1], 0.f) + wv[2] * fmaxf(acc[2], 0.f) + wv[3] * fmaxf(acc[3], 0.f);
                part += __shfl_xor(part, 32);
                if (hh == 0) sc[32 * kt + r] = part; }
        }
        if (w == 0) {
            const float kv = bf2f(((const bf16*)(F.ws + WS_KI))[m * 64 + lane]); float tot = 0.f;
#pragma unroll
            for (int h = 0; h < 8; ++h) { const float d = wave_sum(bf2f(QI[h * 64 + lane]) * kv); tot += WIp[h] * fmaxf(d, 0.f); }
            if (lane == 0) sc[PAST] = tot;
        }
    }
    __syncthreads();
    if (w == 0) {
        unsigned x[32];
#pragma unroll
        for (int jj = 0; jj < 32; ++jj) x[jj] = f2key(sc[64 * jj + lane]);
        const unsigned ke = (unsigned)__builtin_amdgcn_readfirstlane((int)f2key(sc[PAST]));
#pragma unroll
        for (int st = 0; st < 5; ++st) { const int j = 16 >> st; const unsigned mk = st == 0 ? 0x0000ffffu : st == 1 ? 0x00ff00ffu : st == 2 ? 0x0f0f0f0fu : st == 3 ? 0x33333333u : 0x55555555u;
#pragma unroll
            for (int k = 0; k < 32; ++k) if (!(k & j)) { const unsigned t_ = ((x[k] >> j) ^ x[k + j]) & mk; x[k] ^= t_ << j; x[k + j] ^= t_; } }
        unsigned cur = 0xffffffffu, gt = 0u; int ab = 0; bool ecur = true, egt = false;
#pragma unroll
        for (int b = 31; b >= 0; --b) { const unsigned c0 = cur & x[b]; const bool eb = ecur && ((ke >> b) & 1u);
            const int n = (int)wave_reduce_add_u((unsigned)__popc(c0)) + (eb ? 1 : 0);
            if (ab + n >= 256) { cur = c0; ecur = eb; } else { ab += n; gt |= c0; egt = egt || eb; cur &= ~x[b]; ecur = ecur && !eb; } }
        const int neq = (int)wave_reduce_add_u((unsigned)__popc(cur)); int need = 256 - ab;
        const bool take_e = egt || (ecur && need > neq);
        const unsigned long long lt = (1ull << lane) - 1ull;
        unsigned selm = gt;
        if (neq <= need) selm |= cur;
        else {
            for (int jj = 0; jj < 32; ++jj) { const unsigned long long meq = __ballot((cur >> jj) & 1u);
                if (((cur >> jj) & 1u) && __popcll(meq & lt) < need) selm |= 1u << jj;
                const int pc_ = __popcll(meq); need = need > pc_ ? need - pc_ : 0; } }
        int pos = 0;
#pragma unroll
        for (int jj = 0; jj < 32; ++jj) { const bool take = (selm >> jj) & 1u; const unsigned long long mt = __ballot(take);
            if (take) sel[pos + __popcll(mt & lt)] = ptl[jj >> 1] * PAGE + ((64 * jj + lane) & 127);
            pos += __popcll(mt); }
        if (take_e && lane == 0) sel[pos] = -1;
    }
    __syncthreads();
    {
        const int c4 = 4 * (lane & 31), g = (lane >> 4) & 1, rp = lane >> 5;
        f32x4 kv[16], vv[16];
#pragma unroll
        for (int i = 0; i < 16; ++i) { const int pr = sel[32 * w + 2 * i + rp];
            const float* krow = pr >= 0 ? F.cache_k + (size_t)pr * 128 : F.out + O_KS + (size_t)s * 128; kv[i] = *(const f32x4*)(krow + c4); }
#pragma unroll
        for (int i = 0; i < 16; ++i) { const int pr = sel[32 * w + 2 * i + rp];
            const float* vrow = pr >= 0 ? F.cache_v + (size_t)pr * 128 : F.out + O_VS + (size_t)s * 128; vv[i] = *(const f32x4*)(vrow + c4); }
        f32x4 qv[4];
#pragma unroll
        for (int rr = 0; rr < 4; ++rr) qv[rr] = *(const LAS f32x4*)(ql + (4 * g + rr) * 64 + 4 * (lane & 15));
#pragma unroll
        for (int i = 0; i < 16; ++i) {
#pragma unroll
            for (int rr = 0; rr < 4; ++rr) { float p = (qv[rr][0] * kv[i][0] + qv[rr][1] * kv[i][1]) + (qv[rr][2] * kv[i][2] + qv[rr][3] * kv[i][3]);
                p = row16_sum(p);
                if ((lane & 15) == 0) pl[(4 * g + rr) * 256 + 32 * w + 2 * i + rp] = p; } }
        __syncthreads();
        {
            float v[4]; float mx = -INFINITY;
#pragma unroll
            for (int i = 0; i < 4; ++i) { v[i] = pl[w * 256 + lane + 64 * i]; mx = fmaxf(mx, v[i]); }
            mx = wave_max(mx); float sm = 0.f;
#pragma unroll
            for (int i = 0; i < 4; ++i) { v[i] = __builtin_amdgcn_exp2f(v[i] - mx); sm += v[i]; }
            sm = wave_sum(sm); const float inv = 1.0f / sm;
#pragma unroll
            for (int i = 0; i < 4; ++i) pl[w * 256 + lane + 64 * i] = v[i] * inv;
        }
        __syncthreads();
        f32x4 acc[4];
#pragma unroll
        for (int rr = 0; rr < 4; ++rr) acc[rr] = (f32x4){0.f, 0.f, 0.f, 0.f};
#pragma unroll
        for (int i = 0; i < 16; ++i) {
#pragma unroll
            for (int rr = 0; rr < 4; ++rr) { const float p = pl[(4 * g + rr) * 256 + 32 * w + 2 * i + rp];
                acc[rr][0] += p * vv[i][0]; acc[rr][1] += p * vv[i][1]; acc[rr][2] += p * vv[i][2]; acc[rr][3] += p * vv[i][3]; } }
#pragma unroll
        for (int rr = 0; rr < 4; ++rr) {
#pragma unroll
            for (int c = 0; c < 4; ++c) acc[rr][c] += __shfl_xor(acc[rr][c], 32);
            if (rp == 0) *(LAS f32x4*)(red + ((w * 8 + 4 * g + rr) * 64) + 4 * (lane & 15)) = acc[rr]; }
    }
    __syncthreads();
    { const int h = tid >> 6, d = tid & 63; float a = 0.f;
#pragma unroll
        for (int k8 = 0; k8 < 8; ++k8) a += red[(k8 * 8 + h) * 64 + d];
        const float gate = bf2f(((const bf16*)(F.ws + WS_GA))[m * 512 + tid]);
        ((bf16*)(F.ws + WS_MIX))[m * 1024 + tid] = (bf16)f2bf(a * gate); }
    { const int c = tid, g = c >> 7, win = 2 << g; const float un = bf2f(((const bf16*)(F.ws + WS_U))[m * 512 + c]); float sum = un;
      const float* sp = F.state_pool + (size_t)s * 15 * 512 + c;
      float hv[15];
#pragma unroll
      for (int i = 1; i < 16; ++i) hv[i - 1] = sp[(size_t)(15 - i) * 512];
#pragma unroll
      for (int i = 1; i < 16; ++i) sum += (i < win) ? hv[i - 1] : 0.f;
      ql[c] = bf2f((unsigned short)f2bf(sum / (float)win - un)); }
    __syncthreads();
    { const int col = tid, g = col >> 7, j = col & 127; const bf16* wr = (const bf16*)(F.ws + WS_WPOOLT) + (size_t)g * 16384 + j * 128;
      v4u wv4[16];
#pragma unroll
      for (int i = 0; i < 16; ++i) wv4[i] = *(const v4u*)(wr + 8 * i);
      float acc = 0.f;
#pragma unroll
      for (int i = 0; i < 16; ++i) { const LAS f32x4* dp = (const LAS f32x4*)(ql + g * 128 + 8 * i); const f32x4 d0 = dp[0], d1 = dp[1];
          acc += d0[0] * bf2f((unsigned short)(wv4[i].x & 0xffffu)) + d0[1] * bf2f((unsigned short)(wv4[i].x >> 16)) + d0[2] * bf2f((unsigned short)(wv4[i].y & 0xffffu)) + d0[3] * bf2f((unsigned short)(wv4[i].y >> 16));
          acc += d1[0] * bf2f((unsigned short)(wv4[i].z & 0xffffu)) + d1[1] * bf2f((unsigned short)(wv4[i].z >> 16)) + d1[2] * bf2f((unsigned short)(wv4[i].w & 0xffffu)) + d1[3] * bf2f((unsigned short)(wv4[i].w >> 16)); }
      const float gp = bf2f(((const bf16*)(F.ws + WS_GP))[m * 512 + col]);
      ((bf16*)(F.ws + WS_MIX))[m * 1024 + 512 + col] = (bf16)f2bf(acc * F.pool_scale[col] * gp); }
    __syncthreads();
}

__device__ __forceinline__ void p3_mixer(Frame& F) {
    P3Pre pre; int cb, cqt; bool cv;
#define P3_ITEM(i_, ok_, b_, qt_) do { if (F.G == 256) { ok_ = (i_) < 4; \
            const int idx_ = F.bid >> 3, i2_ = idx_ & 15, pi_ = i2_ + 16 * (((i_) >> 1) & 1), grp_ = pi_ >> 4, k_ = pi_ & 15; const bool light_ = idx_ < 16; \
            const int x1_ = (k_ & 7) + 16 * (k_ >> 3) + (light_ ? 0 : 8), sm_ = grp_ ? 32 + x1_ : (light_ ? k_ : 16 + k_), sum_ = grp_ ? (light_ ? 119 : 135) : (light_ ? 111 : 143); \
            b_ = F.bid & 7; qt_ = ((i_) & 1) ? sm_ : sum_ - sm_; } \
        else { const int p_ = F.bid + ((i_) >> 1) * F.G; ok_ = p_ < 512; b_ = (p_ >> 6) & 7; qt_ = ((i_) & 1) ? (p_ & 63) : 127 - (p_ & 63); } } while (0)
    P3_ITEM(0, cv, cb, cqt);
    if (cv) p3_prefetch(F, cb, cqt, pre);
#pragma unroll 1
    for (int i = 0; cv; ++i) {
        int nb, nqt; bool nv;
        P3_ITEM(i + 1, nv, nb, nqt);
        p3_prompt_item(F, cb, cqt, pre, nv, nb, nqt); __syncthreads(); FSTAMP();
        cv = nv; cb = nb; cqt = nqt;
    }
#undef P3_ITEM
    for (int x = F.bid; x < 128; x += F.G) { for (int rp_ = 0; rp_ < REP_SMP; ++rp_) { p3_sample_item(F, x); __syncthreads(); } FSTAMP(); }
    for (int x = F.bid + ((F.bid < 128) ? ((128 - F.bid + F.G - 1) / F.G) * F.G : 0); x < 256; x += F.G) { for (int rp_ = 0; rp_ < REP_POOL; ++rp_) { p3_pool_item<false>(F, x - 128); __syncthreads(); } FSTAMP(); }
}
struct P4SPre { bf16x8 fb[32]; };
__device__ __forceinline__ void p4_sample_prefetch(Frame& F, P4SPre& pre) {
    if (F.bid >= 64) return;
    const int rl = F.lane & 15, kq = F.lane >> 4, n0 = F.bid * 16;
    const bf16* bp = (const bf16*)(F.ws + WS_WOUTT) + (size_t)(n0 + rl) * 1024 + 8 * kq;
#pragma unroll
    for (int i = 0; i < 32; ++i) pre.fb[i] = *(const bf16x8*)(bp + 32 * i);
}
__device__ __forceinline__ void p4_sample_out(Frame& F, P4SPre& pre) {
    if (F.bid >= 64) return;
    const int lane = F.lane, w = F.wave, rl = lane & 15, kq = lane >> 4, n0 = F.bid * 16;
    const bf16* ap = (const bf16*)(F.ws + WS_MIX) + (size_t)(MP + 16 * w + rl) * 1024 + 8 * kq;
    const float* ada = (const float*)(F.ws + WS_ADA);
    float xv[4], gv[4];
#pragma unroll
    for (int e = 0; e < 4; ++e) { const int s = 16 * w + 4 * kq + e, n = n0 + rl; xv[e] = F.xs[(size_t)s * 1024 + n]; gv[e] = ada[(size_t)(NB + s) * 3072 + 2048 + n]; }
    f32x4 acc = (f32x4){0.f, 0.f, 0.f, 0.f};
    bf16x8 fa[32];
#pragma unroll
    for (int i = 0; i < 32; ++i) fa[i] = *(const bf16x8*)(ap + 32 * i);
#pragma unroll
    for (int i = 0; i < 32; ++i) acc = __builtin_amdgcn_mfma_f32_16x16x32_bf16(fa[i], pre.fb[i], acc, 0, 0, 0);
#pragma unroll
    for (int e = 0; e < 4; ++e) { const int s = 16 * w + 4 * kq + e, n = n0 + rl; F.out[O_YS + (size_t)s * 1024 + n] = xv[e] + gv[e] * acc[e]; }
}

struct Args { const float* in[18]; float* out; unsigned char* ws; int ph_lo, ph_hi, li, pad; };
__global__ void __launch_bounds__(NWAVES * 64, 2) mk_fwd(Args args) {
    extern __shared__ __attribute__((aligned(16))) unsigned char lds[];
    Frame F;
    F.lds = (LAS unsigned char*)lds;
    F.MISC = (volatile LAS unsigned*)(F.lds + MISC_OFF);
    F.tid = threadIdx.x; F.lane = F.tid & 63; F.wave = __builtin_amdgcn_readfirstlane(F.tid >> 6);
    F.G = gridDim.x; F.bid = blockIdx.x; { const int bx = blockIdx.x; F.vcu = (F.G % 8 == 0) ? (bx % 8) * (F.G / 8) + bx / 8 : bx; }
    F.ws = args.ws; F.out = args.out; F.ctl = (gu32*)(args.ws + WS_CTL);
    F.xp = args.in[0]; F.xs = args.in[1]; F.cache_k = args.in[2]; F.cache_v = args.in[3]; F.cache_kidx = args.in[4]; F.state_pool = args.in[5];
    F.page_table = (const int*)args.in[6]; F.cp = args.in[7]; F.cs = args.in[8]; F.norm_w = args.in[9]; F.w_ada = args.in[10]; F.b_ada = args.in[11];
    F.w_in = args.in[12]; F.qnw = args.in[13]; F.knw = args.in[14]; F.w_pool = args.in[15]; F.pool_scale = args.in[16]; F.w_out = args.in[17];
    for (int u = F.tid; u < (LDS_BYTES - LDSCTL_OFF) / 4; u += NWAVES * 64) ((LAS unsigned*)(F.lds + LDSCTL_OFF))[u] = 0u;
    __syncthreads();
    XcdBarrier bar = xcd_barrier_post((unsigned*)(F.ctl + CW_BAR) + args.li * XCD_BAR_WORDS, F.MISC + 8);
    const int lo = args.ph_lo, hi = args.ph_hi;
#if TEST_MODE == 4
    unsigned long long* ts = (unsigned long long*)(args.ws + WS_CTL + 768 * 1024); int nst = 0;
#define STAMP() do { if (blockIdx.x == STAMP_BLK && threadIdx.x == 0) ts[nst] = __builtin_amdgcn_s_memrealtime(); ++nst; } while (0)
#if P3FINE
    F.ts = ts + 16; F.nst = 0;
#endif
#else
#define STAMP() do { } while (0)
#endif
    STAMP();
#define IN(k) (lo <= (k) && (k) < hi)
#define BOTH(k) (IN(k) && IN((k) + 1))
    P1Pre p1pre;
    if (IN(0)) { for (int rp_ = 0; rp_ < REP_P0; ++rp_) { p0_prologue(F); if (rp_ + 1 < REP_P0) __syncthreads(); } STAMP(); if (IN(1)) p1_prefetch(F, p1pre); if (BOTH(0)) xcd_barrier(bar); STAMP(); }
    else if (IN(1)) p1_prefetch(F, p1pre);
    if (IN(1)) { for (int rp_ = 0; rp_ < REP_P1; ++rp_) p1_norm(F, p1pre); STAMP(); if (BOTH(1)) xcd_barrier(bar); STAMP(); }
    if (IN(2)) {
        for (int rp_ = 0; rp_ < REP_P2S; ++rp_) p2_sample(F);
        pg8::Gemm g{(const pg8::bf16_t*)(F.ws + WS_HB), (const pg8::bf16_t*)(F.ws + WS_WINT), MP, 3072, DM};
        pg8::StaticOrder S; S.init(MP, 3072, F.G, (int)blockIdx.x);
        pg8::EpiIn E{F.ws, F.out, F.qnw, F.knw};
        for (int rp_ = 0; rp_ < REP_P2G; ++rp_) pg8::gemm_phase<pg8::EpiIn, pg8::StaticOrder, true, true>(F.lds + RING_OFF, g, S, E);
        STAMP(); if (BOTH(2)) xcd_barrier(bar); STAMP();
    }
#if HAVE_P3
    P4SPre p4pre;
    if (IN(3)) { p3_mixer(F);
#if TEST_MODE == 6
        if (threadIdx.x == 0) ((unsigned long long*)(F.ws + WS_CTL + 800 * 1024))[blockIdx.x] = __builtin_amdgcn_s_memrealtime();
#endif
        STAMP(); if (IN(4)) p4_sample_prefetch(F, p4pre); if (BOTH(3)) xcd_barrier(bar); STAMP(); }
    else if (IN(4)) p4_sample_prefetch(F, p4pre);
#endif
    if (IN(4)) {
        for (int rp_ = 0; rp_ < REP_P4S; ++rp_) p4_sample_out(F, p4pre);
        pg8::Gemm g{(const pg8::bf16_t*)(F.ws + WS_MIX), (const pg8::bf16_t*)(F.ws + WS_WOUTT), MP, DM, DM};
        pg8::StaticOrder S; S.init(MP, DM, F.G, (int)blockIdx.x);
        pg8::EpiOut E{F.xp, F.out + O_YP, (const float*)(F.ws + WS_ADA)};
        for (int rp_ = 0; rp_ < REP_P4G; ++rp_) pg8::gemm_phase<pg8::EpiOut, pg8::StaticOrder, true, true>(F.lds + RING_OFF, g, S, E);
        STAMP(); STAMP();
    }
#undef IN
#undef BOTH
}

#if TEST_MODE
__global__ void __launch_bounds__(256) k_cmp(const void* a, int a_bf16, int lda, const float* ref, int ldr, int rows, int cols, float scale, int act, float* accum) {
    __shared__ float sd[256], sr[256];
    const size_t idx = (size_t)blockIdx.x * 256 + threadIdx.x; float d2 = 0.f, r2 = 0.f;
    if (idx < (size_t)rows * cols) { const size_t r = idx / cols, c = idx % cols;
        const float av = a_bf16 ? bf2f(((const bf16*)a)[r * lda + c]) : ((const float*)a)[r * lda + c];
        float rv = ref[r * ldr + c]; if (act) rv = rv / (1.f + expf(-rv)); rv *= scale;
        d2 = (av - rv) * (av - rv); r2 = rv * rv; if (!(d2 == d2)) d2 = 1e30f; }
    sd[threadIdx.x] = d2; sr[threadIdx.x] = r2; __syncthreads();
    for (int s = 128; s > 0; s >>= 1) { if ((int)threadIdx.x < s) { sd[threadIdx.x] += sd[threadIdx.x + s]; sr[threadIdx.x] += sr[threadIdx.x + s]; } __syncthreads(); }
    if (threadIdx.x == 0) { atomicAdd(accum, sd[0]); atomicAdd(accum + 1, sr[0]); }
}
__global__ void __launch_bounds__(256) k_cmp_sel(const int* SEL, const int* NSEL, const unsigned* bmdump, float* accum) {
    __shared__ float sd[256], sr[256];
    const size_t idx = (size_t)blockIdx.x * 256 + threadIdx.x; const int m = (int)(idx >> 8), i = (int)(idx & 255); float miss = 0.f, tot = 0.f;
    if (m < MP && i < NSEL[m]) { const int l = SEL[(size_t)m * 256 + i]; tot = 1.f; if (!((bmdump[(size_t)m * 64 + (l >> 5)] >> (l & 31)) & 1u)) miss = 1.f; }
    sd[threadIdx.x] = miss; sr[threadIdx.x] = tot; __syncthreads();
    for (int s = 128; s > 0; s >>= 1) { if ((int)threadIdx.x < s) { sd[threadIdx.x] += sd[threadIdx.x + s]; sr[threadIdx.x] += sr[threadIdx.x + s]; } __syncthreads(); }
    if (threadIdx.x == 0) { atomicAdd(accum, sd[0]); atomicAdd(accum + 1, sr[0]); }
}
__global__ void k_cmp_fin2(float* accum, int n, float amp) {
    float best = -1.f; int bi = 0;
    for (int k = 0; k < n; ++k) { const float rel = accum[2 * k] / fmaxf(accum[2 * k + 1], 1e-30f) / accum[32 + k]; if (rel > best) { best = rel; bi = k; } }
    accum[64] = sqrtf(amp * best); accum[65] = (float)bi;
}
__global__ void k_set(float* p, float a, float b, float c, float d, float e) { p[0] = a; p[1] = b; p[2] = c; p[3] = d; p[4] = e; }
__global__ void k_cmp_fin(float* accum, int n, float amp) {
    float best = -1.f; int bi = 0;
    for (int k = 0; k < n; ++k) { const float rel = accum[2 * k] / fmaxf(accum[2 * k + 1], 1e-30f); if (rel > best) { best = rel; bi = k; } }
    accum[64] = sqrtf(amp * best); accum[65] = (float)bi;
}
__global__ void __launch_bounds__(256) k_perturb(float* out, const float* accum) {
    const size_t offs[11] = {O_YP, O_YS, O_KP, O_VP, O_KIP, O_PP, O_KS, O_VS, O_KIS, O_PS, O_END};
    const int k = (int)accum[65] % 10; const float f = 1.0f + accum[64];
    for (size_t i = offs[k] + (size_t)blockIdx.x * 256 + threadIdx.x; i < offs[k + 1]; i += (size_t)gridDim.x * 256) out[i] *= f;
}
__global__ void __launch_bounds__(256) k_f32_to_bf16(const float* src, bf16* dst, size_t n) {
    for (size_t i = (size_t)blockIdx.x * 256 + threadIdx.x; i < n; i += (size_t)gridDim.x * 256) dst[i] = (bf16)f2bf(src[i]);
}
#endif

#if TEST_MODE == 5
__global__ void __launch_bounds__(256) k_stat(float* out, const unsigned* st, int which) {
    float v = which == 0 ? (float)st[0] : (which == 1 ? (float)st[1] / fmaxf((float)st[2], 1.f) : (which < 8 ? (float)st[3] : (which == 13 ? (float)st[13] : (float)st[which] * (16.0f / 1000.0f))));
    const float f = 1.0f + sqrtf(v * 1e-5f);
    for (size_t i = O_KS + (size_t)blockIdx.x * 256 + threadIdx.x; i < O_VS; i += (size_t)gridDim.x * 256) out[i] *= f;
}
#endif
#if TEST_MODE == 6
__global__ void __launch_bounds__(256) k_blk(float* out, const unsigned long long* tb, int sel, float scale) {
    unsigned long long mx = 0; int am = 0;
    for (int i = 0; i < 256; ++i) if (tb[i] > mx) { mx = tb[i]; am = i; }
    float us = 0.f;
    if (sel == 3) us = (float)(am >> 4); else if (sel == 4) us = (float)(am & 15);
    else { double s = 0; int n = 0; for (int i = 0; i < 256; ++i) { const bool in = sel == 1 ? i < 128 : sel == 2 ? i >= 128 : sel >= 10 && sel < 18 ? (i & 7) == sel - 10 : sel >= 20 && sel < 52 ? (i >> 3) == sel - 20 : true; if (in) { s += (double)(mx - tb[i]); ++n; } } us = (float)(s / n) * 0.01f; }
    const float f = 1.0f + sqrtf(us * scale);
    for (size_t i = O_KS + (size_t)blockIdx.x * 256 + threadIdx.x; i < O_VS; i += (size_t)gridDim.x * 256) out[i] *= f;
}
#endif
#if TEST_MODE == 4
__global__ void __launch_bounds__(256) k_time(float* out, const unsigned long long* ts, int i0, int i1, float scale) {
    const float us = (float)(ts[i1] - ts[i0]) * 0.01f; const float f = 1.0f + sqrtf(us * scale);
    for (size_t i = O_KS + (size_t)blockIdx.x * 256 + threadIdx.x; i < O_VS; i += (size_t)gridDim.x * 256) out[i] *= f;
}
#endif
extern "C" void kernel_launch(void* const* d_in, const int* in_sizes, int n_in, void* d_out, int out_size, void* d_ws, size_t ws_size, hipStream_t stream) {
    static int grid = 0;
    if (grid == 0) {
        size_t need = WS_MEGA_END;
#if TEST_MODE && TEST_MODE < 4
        need = 192 * MiB + gold::W_END * 4;
#endif
        if (n_in != 18 || out_size != (int)O_END || ws_size < need) { fprintf(stderr, "kernel_launch: unexpected sizes: n_in %d out %d ws %zu (need %zu)\n", n_in, out_size, ws_size, need); grid = -1; return; }
        int dev = 0, cus = 0, per_cu = 0;
        if (hipGetDevice(&dev) != hipSuccess || hipDeviceGetAttribute(&cus, hipDeviceAttributeMultiprocessorCount, dev) != hipSuccess) { grid = -1; return; }
        if (hipFuncSetAttribute((const void*)mk_fwd, hipFuncAttributeMaxDynamicSharedMemorySize, LDS_BYTES) != hipSuccess) { fprintf(stderr, "kernel_launch: hipFuncSetAttribute failed\n"); grid = -1; return; }
        if (hipOccupancyMaxActiveBlocksPerMultiprocessor(&per_cu, (const void*)mk_fwd, NWAVES * 64, LDS_BYTES) != hipSuccess || per_cu < 1) { fprintf(stderr, "kernel_launch: occupancy query says %d blocks/CU\n", per_cu); (void)hipGetLastError(); grid = -1; return; }
        if (cus < 64) { fprintf(stderr, "kernel_launch: needs >= 64 CUs\n"); grid = -1; return; }
        grid = cus;
    }
#if defined(FORCE_GRID)
    if (grid > FORCE_GRID) grid = FORCE_GRID;
#endif
    if (grid < 0) return;
#if TEST_MODE
    (void)hipMemsetAsync((char*)d_ws + WS_CTL, 0, CTL_ZERO_BYTES, stream);
#else
    (void)hipMemsetAsync((char*)d_ws + WS_CTL + CW_BAR * 4, 0, (CW_Q - CW_BAR + 256) * 4, stream);
#endif
    Args a{};
    for (int i = 0; i < 18; ++i) a.in[i] = (const float*)d_in[i];
    a.out = (float*)d_out; a.ws = (unsigned char*)d_ws;
#if TEST_MODE == 6
    a.ph_lo = 0; a.ph_hi = 5; a.li = 0;
    hipLaunchKernelGGL(mk_fwd, dim3(grid), dim3(NWAVES * 64), LDS_BYTES, stream, a);
    k_blk<<<16, 256, 0, stream>>>((float*)d_out, (const unsigned long long*)((char*)d_ws + WS_CTL + 800 * 1024), STATSEL, 1e-5f);
#elif TEST_MODE == 5
    a.ph_lo = 0; a.ph_hi = 5; a.li = 0;
    hipLaunchKernelGGL(mk_fwd, dim3(grid), dim3(NWAVES * 64), LDS_BYTES, stream, a);
    k_stat<<<16, 256, 0, stream>>>((float*)d_out, (const unsigned*)((char*)d_ws + WS_CTL + 900 * 1024), STATSEL);
#elif TEST_MODE == 4
    a.ph_lo = 0; a.ph_hi = 5; a.li = 0;
    hipLaunchKernelGGL(mk_fwd, dim3(grid), dim3(NWAVES * 64), LDS_BYTES, stream, a);
    k_time<<<16, 256, 0, stream>>>((float*)d_out, (const unsigned long long*)((char*)d_ws + WS_CTL + 768 * 1024), TS0, TS1, 1e-5f);
#elif TEST_MODE && TEST_MODE < 4
    {
        using namespace gold;
        const float* xp = (const float*)d_in[0]; const float* xs = (const float*)d_in[1];
        const float* cache_k = (const float*)d_in[2]; const float* cache_v = (const float*)d_in[3]; const float* cache_kidx = (const float*)d_in[4];
        const float* state_pool = (const float*)d_in[5]; const int* page_table = (const int*)d_in[6];
        const float* cp = (const float*)d_in[7]; const float* cs = (const float*)d_in[8]; const float* norm_w = (const float*)d_in[9];
        const float* w_ada = (const float*)d_in[10]; const float* b_ada = (const float*)d_in[11]; const float* w_in = (const float*)d_in[12];
        const float* qnw = (const float*)d_in[13]; const float* knw = (const float*)d_in[14]; const float* w_pool = (const float*)d_in[15];
        const float* pool_scale = (const float*)d_in[16]; const float* w_out = (const float*)d_in[17];
        float* out = (float*)d_out; float* ws = (float*)((char*)d_ws + 192 * MiB);
        float *ADA = ws + W_ADA, *H = ws + W_H, *PROJ = ws + W_PROJ, *SC = ws + W_SC, *SCS = ws + W_SCS, *MIX = ws + W_MIX, *DB = ws + W_DB, *YT = ws + W_YT;
        int *SEL = (int*)(ws + W_SEL), *NSEL = (int*)(ws + W_NSEL);
        k_ada<<<dim3(12, NR), 256, 0, stream>>>(cp, cs, w_ada, b_ada, ADA);
        k_h<<<MT / 4, 256, 0, stream>>>(xp, xs, norm_w, ADA, H);
        k_gemm<<<dim3((NIN + 127) / 128, MT / 128), 256, 0, stream>>>(H, w_in, PROJ, MT, NIN, DM, DM, NIN, NIN);
        k_post<<<MT / 4, 256, 0, stream>>>(PROJ, qnw, knw, state_pool, out);
        k_scores_p<<<dim3(SEQ / 8, NB), 256, 0, stream>>>(PROJ, SC);
        k_scores_s<<<DECB, 256, 0, stream>>>(PROJ, cache_kidx, page_table, SCS);
        k_topk<<<MT / 4, 256, 0, stream>>>(SC, SCS, SEL, NSEL);
        k_attn<<<MT / 4, 256, 0, stream>>>(PROJ, cache_k, cache_v, page_table, SEL, NSEL, MIX);
        k_pool_d<<<(MT * 512) / 256, 256, 0, stream>>>(PROJ, state_pool, DB);
        k_pool_out<<<(MT * 512) / 256, 256, 0, stream>>>(PROJ, DB, w_pool, pool_scale, MIX);
        k_gemm<<<dim3(1024 / 128, MT / 128), 256, 0, stream>>>(MIX, w_out, YT, MT, 1024, 1024, 1024, 1024, 1024);
        k_final<<<(MT * 1024) / 256, 256, 0, stream>>>(xp, xs, ADA, YT, out);
        unsigned char* mws = (unsigned char*)d_ws;
#if TEST_MODE == 1
        a.ph_lo = 0; a.ph_hi = 3; a.li = 0;
        hipLaunchKernelGGL(mk_fwd, dim3(grid), dim3(NWAVES * 64), LDS_BYTES, stream, a);
        float* accum = (float*)(mws + WS_CTL + 512 * 1024);
        struct { const void* a; int bf; int lda; int refcol; int cols; float scale; int act; } L[9] = {
            {mws + WS_Q, 1, 512, CQ, 512, C2, 0}, {mws + WS_QI, 1, 512, CQI, 512, 1.f, 0}, {mws + WS_GA, 1, 512, CGA, 512, 1.f, 1}, {mws + WS_U, 1, 512, CU, 512, 1.f, 0},
            {mws + WS_GP, 1, 512, CGP, 512, 1.f, 1}, {mws + WS_KB, 1, 128, CK, 128, 1.f, 0}, {mws + WS_VB, 1, 128, CV, 128, 1.f, 0}, {mws + WS_KI, 1, 64, CKI, 64, 1.f, 0},
            {mws + WS_WI, 0, 8, CWI, 8, 1.f, 0} };
        for (int k = 0; k < 9; ++k) k_cmp<<<(unsigned)(((size_t)MT * L[k].cols + 255) / 256), 256, 0, stream>>>(L[k].a, L[k].bf, L[k].lda, PROJ + L[k].refcol, NIN, MT, L[k].cols, L[k].scale, L[k].act, accum + 2 * k);
        k_cmp<<<(NR * 3072 + 255) / 256, 256, 0, stream>>>(mws + WS_ADA, 0, 3072, ADA, 3072, NR, 3072, 1.f, 0, accum + 18);
        k_cmp_fin<<<1, 1, 0, stream>>>(accum, 10, 5.0f);
        k_perturb<<<1024, 256, 0, stream>>>(out, accum);
#elif TEST_MODE == 3
        a.ph_lo = 0; a.ph_hi = 5; a.li = 0;
        hipLaunchKernelGGL(mk_fwd, dim3(grid), dim3(NWAVES * 64), LDS_BYTES, stream, a);
        float* accum = (float*)(mws + WS_CTL + 512 * 1024);
        const bf16* MB = (const bf16*)(mws + WS_MIX);
        k_cmp<<<(unsigned)(((size_t)MP * 512 + 255) / 256), 256, 0, stream>>>(MB, 1, 1024, MIX, 1024, MP, 512, 1.f, 0, accum + 0);
        k_cmp<<<(unsigned)(((size_t)MP * 512 + 255) / 256), 256, 0, stream>>>(MB + 512, 1, 1024, MIX + 512, 1024, MP, 512, 1.f, 0, accum + 2);
        k_cmp<<<(DECB * 512 + 255) / 256, 256, 0, stream>>>(MB + (size_t)MP * 1024, 1, 1024, MIX + (size_t)MP * 1024, 1024, DECB, 512, 1.f, 0, accum + 4);
        k_cmp<<<(DECB * 512 + 255) / 256, 256, 0, stream>>>(MB + (size_t)MP * 1024 + 512, 1, 1024, MIX + (size_t)MP * 1024 + 512, 1024, DECB, 512, 1.f, 0, accum + 6);
        k_cmp_sel<<<MP, 256, 0, stream>>>(SEL, NSEL, (const unsigned*)(mws + WS_DBG_BM), accum + 8);
        k_set<<<1, 1, 0, stream>>>(accum + 32, P3_TOL0, P3_TOL1, P3_TOL2, P3_TOL3, P3_TOL4);
        k_cmp_fin2<<<1, 1, 0, stream>>>(accum, 5, 1e-5f);
        k_perturb<<<1024, 256, 0, stream>>>(out, accum);
#elif TEST_MODE == 2
        a.ph_lo = 0; a.ph_hi = 3; a.li = 0;
        hipLaunchKernelGGL(mk_fwd, dim3(grid), dim3(NWAVES * 64), LDS_BYTES, stream, a);
        k_f32_to_bf16<<<2048, 256, 0, stream>>>(MIX, (bf16*)(mws + WS_MIX), (size_t)MT * 1024);
        a.ph_lo = 4; a.ph_hi = 5; a.li = 1;
        hipLaunchKernelGGL(mk_fwd, dim3(grid), dim3(NWAVES * 64), LDS_BYTES, stream, a);
#endif
    }
#else
    a.ph_lo = 0; a.ph_hi = 5; a.li = 0;
#if USE_COOP
    { void* kargs[] = {&a}; (void)hipLaunchCooperativeKernel((const void*)mk_fwd, dim3(grid), dim3(NWAVES * 64), kargs, LDS_BYTES, stream); }
#else
    hipLaunchKernelGGL(mk_fwd, dim3(grid), dim3(NWAVES * 64), LDS_BYTES, stream, a);
#endif
#endif
}
```

```cpp
#define TEST_MODE 0
#define HAVE_P3 1
#define REP_S1 1
#define REP_S2 1
#define REP_S4 1
#define REP_P0 1
#define REP_P1 1
#define REP_P4S 1
#define REP_P2G 1
#define REP_P4G 1
#define REP_P2S 1
#define REP_SMP 1
#define REP_POOL 1
#define STATSEL 0
#define USE_COOP 1
#define STAMP_BLK 0
#define P3FINE 0
#define TS0 0
#define TS1 1
#include <hip/hip_runtime.h>
#include <cstdio>
#include <cstdint>

constexpr int DM = 1024, NB = 8, SEQ = 2048, DECB = 128, PAST = 2048, PAGE = 128, NPG = 16;
constexpr int NIN = 2888, MP = NB * SEQ, MT = MP + DECB, NR = NB + DECB;
constexpr int CQ = 0, CK = 512, CV = 640, CQI = 768, CKI = 1280, CWI = 1344, CGA = 1352, CU = 1864, CGP = 2376;
constexpr size_t O_YP = 0, O_YS = 16777216, O_KP = 16908288, O_VP = 19005440, O_KIP = 21102592, O_PP = 22151168,
                 O_KS = 22212608, O_VS = 22228992, O_KIS = 22245376, O_PS = 22253568, O_END = 23236608;
constexpr float C2 = 0.125f * 1.4426950408889634f;
constexpr float WI_SCALE = 0.04419417382415922f;
constexpr float EPS = 1e-6f;
constexpr size_t MiB = 1u << 20;
constexpr size_t WS_CTL = 0, CTL_ZERO_BYTES = 1 * MiB;
constexpr size_t WS_ADA = 1 * MiB, WS_WINT = 3 * MiB, WS_WOUTT = 9 * MiB, WS_WPOOLT = 11 * MiB, WS_HS = 12 * MiB, WS_HB = 24 * MiB,
                 WS_Q = 56 * MiB, WS_QI = 73 * MiB, WS_GA = 90 * MiB, WS_U = 107 * MiB, WS_GP = 124 * MiB, WS_KB = 141 * MiB, WS_VB = 146 * MiB,
                 WS_KI = 151 * MiB, WS_WI = 154 * MiB, WS_MIX = 155 * MiB, WS_DBG_BM = 188 * MiB, WS_MEGA_END = 192 * MiB;
namespace pg8 {
#define PG8_LAS __attribute__((address_space(3)))
typedef unsigned short bf16_t;
typedef short bf16x8 __attribute__((ext_vector_type(8)));
typedef float f32x4 __attribute__((ext_vector_type(4)));
typedef unsigned u32x4 __attribute__((ext_vector_type(4)));
constexpr int BM = 256, BK = 64, HALF = 128, HTB = HALF * BK * 2  , STAGE_BYTES = 8 * HTB, NXCD = 8, WGM = 8;

__host__ __device__ __forceinline__ int lds_byte(int r, int c) { const int st = (r >> 4) * 2 + (c >> 5), rr = r & 15, cc = c & 31, ob = rr * 64 + cc * 2; return st * 1024 + (ob ^ (((ob >> 9) & 1) << 5)); }
__host__ __device__ __forceinline__ void stage_rc(int b, int& R, int& C) { const int st = b / 1024, sb = b % 1024, swz = sb ^ (((sb >> 9) & 1) << 5); R = (st >> 1) * 16 + swz / 64; C = (st & 1) * 32 + (swz % 64) / 2; }
__host__ __device__ __forceinline__ int perm32(int rho) { const int n = rho >> 4, i = rho & 15; return 8 * (i >> 2) + 4 * n + (i & 3); }

struct Unit { int pm, pn; };
struct Gemm { const bf16_t* A; const bf16_t* Bt; int M, N, K; };

struct StaticOrder {
    int nM, nN, nwg, G, c;
    __host__ __device__ void init(int M, int N, int G_, int c_) { nM = M / BM; nN = N / BM; nwg = nM * nN; G = G_; c = c_; }
    __host__ __device__ bool next(int i, Unit& u) const {
        const long L = (long)i * G + c; if (L >= nwg) return false;
        int wgid = (int)L; { const int q = nwg / NXCD, r = nwg % NXCD, xcd = wgid % NXCD, off = wgid / NXCD; wgid = (xcd < r ? xcd * (q + 1) : r * (q + 1) + (xcd - r) * q) + off; }
        const int nig = WGM * nN, gid = wgid / nig, fm = gid * WGM, gsz = (nM - fm) < WGM ? (nM - fm) : WGM;
        u.pm = fm + ((wgid % nig) % gsz); u.pn = (wgid % nig) / gsz; return true;
    }
    __device__ __forceinline__ void a_ready(const Unit&) const {}
    __device__ __forceinline__ void done(const Unit&) const {}
};


typedef unsigned u32x4 __attribute__((ext_vector_type(4)));
__device__ __forceinline__ unsigned cvt_pk_bf16(float lo, float hi) { unsigned r; asm volatile("v_cvt_pk_bf16_f32 %0, %1, %2" : "=v"(r) : "v"(lo), "v"(hi)); return r; }
__device__ __forceinline__ void st_bf16x8(bf16_t* p, const f32x4 a, const f32x4 b) {
    u32x4 w; w.x = cvt_pk_bf16(a[0], a[1]); w.y = cvt_pk_bf16(a[2], a[3]); w.z = cvt_pk_bf16(b[0], b[1]); w.w = cvt_pk_bf16(b[2], b[3]); *(u32x4*)p = w; }
__device__ __forceinline__ float silu1(float x) { return x * __builtin_amdgcn_rcpf(1.0f + __builtin_amdgcn_exp2f(-1.4426950408889634f * x)); }
__device__ __forceinline__ f32x4 silu4(const f32x4 v) { f32x4 r; r[0] = silu1(v[0]); r[1] = silu1(v[1]); r[2] = silu1(v[2]); r[3] = silu1(v[3]); return r; }

struct EpiIn {
    static constexpr bool PERM = true, AFTER_DRAIN = false;
    unsigned char* ws; float* out; const float* qnw; const float* knw;
    __device__ __forceinline__ void operator()(const f32x4 (&acc)[2][2][4][2], const Unit& u, int wr, int wc, int fr, int fq) const {
        const int pn = u.pn;
        if (pn == 5 && wc >= 2) return;
        const int rowb = u.pm * 256 + wr * 64 + fr, dof = 8 * fq;
        if (pn <= 1 || (pn == 2 && wc < 2)) {
            const float* nwp = pn <= 1 ? qnw : knw; const float sc = pn <= 1 ? C2 : 1.0f;
            f32x4 wv[2][2];
#pragma unroll
            for (int bj = 0; bj < 2; ++bj)
#pragma unroll
                for (int n = 0; n < 2; ++n) wv[bj][n] = *(const f32x4*)(nwp + 32 * bj + dof + 4 * n) * sc;
#pragma unroll
            for (int ai = 0; ai < 2; ++ai)
#pragma unroll
                for (int m = 0; m < 4; ++m) { const size_t row = (size_t)(rowb + ai * 128 + m * 16); float ss = 0.f;
#pragma unroll
                    for (int bj = 0; bj < 2; ++bj)
#pragma unroll
                        for (int n = 0; n < 2; ++n) { const f32x4 x = acc[ai][bj][m][n]; ss += (x[0] * x[0] + x[1] * x[1]) + (x[2] * x[2] + x[3] * x[3]); }
                    ss += __shfl_xor(ss, 16); ss += __shfl_xor(ss, 32);
                    const float rstd = 1.0f / sqrtf(ss * (1.0f / 64.0f) + EPS);
                    f32x4 o[2][2];
#pragma unroll
                    for (int bj = 0; bj < 2; ++bj)
#pragma unroll
                        for (int n = 0; n < 2; ++n) o[bj][n] = acc[ai][bj][m][n] * rstd * wv[bj][n];
                    if (pn <= 1) { bf16_t* q = (bf16_t*)(ws + WS_Q) + row * 512 + (4 * pn + wc) * 64 + dof; st_bf16x8(q, o[0][0], o[0][1]); st_bf16x8(q + 32, o[1][0], o[1][1]); }
                    else { float* ko = out + O_KP + row * 128 + wc * 64 + dof; *(f32x4*)ko = o[0][0]; *(f32x4*)(ko + 4) = o[0][1]; *(f32x4*)(ko + 32) = o[1][0]; *(f32x4*)(ko + 36) = o[1][1];
                        bf16_t* kb = (bf16_t*)(ws + WS_KB) + row * 128 + wc * 64 + dof; st_bf16x8(kb, o[0][0], o[0][1]); st_bf16x8(kb + 32, o[1][0], o[1][1]); } }
            return;
        }
        if (pn == 5 && wc == 1) {
            if (fq == 0) {
#pragma unroll
                for (int ai = 0; ai < 2; ++ai)
#pragma unroll
                    for (int m = 0; m < 4; ++m) { const size_t row = (size_t)(rowb + ai * 128 + m * 16); float* wp = (float*)(ws + WS_WI) + row * 8;
                        *(f32x4*)wp = acc[ai][0][m][0] * WI_SCALE; *(f32x4*)(wp + 4) = acc[ai][0][m][1] * WI_SCALE; } }
            return;
        }
        bf16_t* dst; int ld, cb; float* fo = nullptr; int fld = 0; bool act = false;
        if (pn == 2) { dst = (bf16_t*)(ws + WS_VB); ld = 128; cb = (wc - 2) * 64; fo = out + O_VP + cb; fld = 128; }
        else if (pn <= 4) { dst = (bf16_t*)(ws + WS_QI); ld = 512; cb = (4 * (pn - 3) + wc) * 64; }
        else if (pn == 5) { dst = (bf16_t*)(ws + WS_KI); ld = 64; cb = 0; fo = out + O_KIP; fld = 64; }
        else if (pn <= 7) { dst = (bf16_t*)(ws + WS_GA); ld = 512; cb = (4 * (pn - 6) + wc) * 64; act = true; }
        else if (pn <= 9) { dst = (bf16_t*)(ws + WS_U); ld = 512; cb = (4 * (pn - 8) + wc) * 64; }
        else { dst = (bf16_t*)(ws + WS_GP); ld = 512; cb = (4 * (pn - 10) + wc) * 64; act = true; }
        const bool is_u = (pn == 8 || pn == 9);
#pragma unroll
        for (int ai = 0; ai < 2; ++ai)
#pragma unroll
            for (int m = 0; m < 4; ++m) { const int rowi = rowb + ai * 128 + m * 16; const size_t row = (size_t)rowi;
                f32x4 o00 = acc[ai][0][m][0], o01 = acc[ai][0][m][1], o10 = acc[ai][1][m][0], o11 = acc[ai][1][m][1];
                if (act) { o00 = silu4(o00); o01 = silu4(o01); o10 = silu4(o10); o11 = silu4(o11); }
                bf16_t* d = dst + row * ld + cb + dof; st_bf16x8(d, o00, o01); st_bf16x8(d + 32, o10, o11);
                if (fo) { float* f = fo + row * fld + dof; *(f32x4*)f = o00; *(f32x4*)(f + 4) = o01; *(f32x4*)(f + 32) = o10; *(f32x4*)(f + 36) = o11; }
                if (is_u) { const int t = rowi & (SEQ - 1);
                    if (t >= SEQ - 15) { float* f = out + O_PP + ((size_t)(rowi >> 11) * 15 + (t - (SEQ - 15))) * 512 + cb + dof;
                        *(f32x4*)f = o00; *(f32x4*)(f + 4) = o01; *(f32x4*)(f + 32) = o10; *(f32x4*)(f + 36) = o11; } } }
    }
};
struct EpiOut {
    static constexpr bool PERM = true, AFTER_DRAIN = false;
    const float* x; float* y; const float* ada;
    __device__ __forceinline__ void operator()(const f32x4 (&acc)[2][2][4][2], const Unit& u, int wr, int wc, int fr, int fq) const {
        const int col0 = u.pn * 256 + wc * 32 + 8 * fq; const float* gp = ada + (size_t)(u.pm >> 3) * 3072 + 2048 + col0;
        f32x4 g[2][2];
#pragma unroll
        for (int bj = 0; bj < 2; ++bj)
#pragma unroll
            for (int n = 0; n < 2; ++n) g[bj][n] = *(const f32x4*)(gp + 128 * bj + 4 * n);
#pragma unroll
        for (int ai = 0; ai < 2; ++ai)
#pragma unroll
            for (int m = 0; m < 4; ++m) { const size_t off = (size_t)(u.pm * 256 + ai * 128 + wr * 64 + m * 16 + fr) * 1024 + col0;
#pragma unroll
                for (int bj = 0; bj < 2; ++bj)
#pragma unroll
                    for (int n = 0; n < 2; ++n) { const f32x4 xv = *(const f32x4*)(x + off + 128 * bj + 4 * n); *(f32x4*)(y + off + 128 * bj + 4 * n) = xv + g[bj][n] * acc[ai][bj][m][n]; } }
    }
};
template <class Epi, class Sched, bool ALIGN_EPI = false, bool SP2 = false>
__device__ __forceinline__ void gemm_phase(PG8_LAS unsigned char* lds, const Gemm g, const Sched& S, const Epi& E) {
    const int tid = threadIdx.x, wid = __builtin_amdgcn_readfirstlane(tid >> 6), lane = tid & 63, wr = wid >> 2, wc = wid & 3, fr = lane & 15, fq = lane >> 4;
    const int K = g.K, nt = K / BK;
    unsigned voffA[2], voffB[2];
#pragma unroll
    for (int i = 0; i < 2; ++i) { int R, C; stage_rc(tid * 16 + i * 8192, R, C); const int Rb = Epi::PERM ? ((R & ~31) + perm32(R & 31)) : R;
        voffA[i] = (unsigned)(R * K + C) * 2u; voffB[i] = (unsigned)(Rb * K + C) * 2u; }
    const size_t kstep = (size_t)(BK * 2);
    const size_t hstep = (size_t)HALF * K * 2;
    const size_t tstep = 2 * hstep;
    const unsigned ldsw = (unsigned)wid * 1024u;
    const int aoff = lds_byte(wr * 64 + fr, fq * 8), boff = lds_byte(wc * 32 + fr, fq * 8);
#define PG8_SA(b, h) (((b) * 2 + (h)) * HTB)
#define PG8_SB(b, h) ((4 + (b) * 2 + (h)) * HTB)
#define PG8_STAGE(bufoff, gbase, voff) do { _Pragma("unroll") for (int _i = 0; _i < 2; ++_i) \
        __builtin_amdgcn_global_load_lds((const unsigned*)((const char*)(gbase) + (voff)[_i]), (PG8_LAS unsigned*)(lds + (bufoff) + ldsw + _i * 8192), 16, 0, 0); } while (0)
#define PG8_LDA(dst, b, h) do { _Pragma("unroll") for (int m = 0; m < 4; ++m) _Pragma("unroll") for (int k = 0; k < 2; ++k) dst[m][k] = *(const PG8_LAS bf16x8*)(lds + PG8_SA(b, h) + aoff + m * 2048 + k * 1024); } while (0)
#define PG8_LDB(dst, b, h) do { _Pragma("unroll") for (int n = 0; n < 2; ++n) _Pragma("unroll") for (int k = 0; k < 2; ++k) dst[n][k] = *(const PG8_LAS bf16x8*)(lds + PG8_SB(b, h) + boff + n * 2048 + k * 1024); } while (0)
#define PG8_MMA(ai, bj, At, Bt) do { __builtin_amdgcn_s_setprio(1); _Pragma("unroll") for (int m = 0; m < 4; ++m) _Pragma("unroll") for (int n = 0; n < 2; ++n) _Pragma("unroll") for (int k = 0; k < 2; ++k) \
        acc[ai][bj][m][n] = __builtin_amdgcn_mfma_f32_16x16x32_bf16(Bt[n][k], At[m][k], acc[ai][bj][m][n], 0, 0, 0); __builtin_amdgcn_s_setprio(0); } while (0)
#define PG8_WAIT_V(n) asm volatile("s_waitcnt vmcnt(" #n ")" ::: "memory")
#define PG8_WAIT_L(n) asm volatile("s_waitcnt lgkmcnt(" #n ")" ::: "memory")
#define PG8_BAR __builtin_amdgcn_s_barrier()
#define PG8_SCHED __builtin_amdgcn_sched_barrier(0)
    Unit cur, nxt; int ui = 0;
    if (!S.next(0, cur)) return;
    f32x4 acc[2][2][4][2];
#pragma unroll
    for (int a = 0; a < 2; ++a)
#pragma unroll
        for (int b = 0; b < 2; ++b)
#pragma unroll
            for (int m = 0; m < 4; ++m)
#pragma unroll
                for (int n = 0; n < 2; ++n) acc[a][b][m][n] = (f32x4){0.f, 0.f, 0.f, 0.f};
    bf16x8 At[4][2], B0[2][2], B1[2][2];
    const char* cA = (const char*)g.A + (size_t)cur.pm * tstep; const char* cB = (const char*)g.Bt + (size_t)cur.pn * tstep;
    S.a_ready(cur);
    if constexpr (SP2) {
        PG8_STAGE(PG8_SB(0, 0), cB, voffB); PG8_STAGE(PG8_SB(0, 1), cB + hstep, voffB); PG8_STAGE(PG8_SA(0, 0), cA, voffA); PG8_STAGE(PG8_SA(0, 1), cA + hstep, voffA);
        if (wr == 1) PG8_BAR;
        PG8_WAIT_V(2); PG8_BAR;
        PG8_STAGE(PG8_SB(1, 0), cB + kstep, voffB); PG8_STAGE(PG8_SA(1, 0), cA + kstep, voffA); PG8_STAGE(PG8_SB(1, 1), cB + hstep + kstep, voffB);
        PG8_WAIT_V(6); PG8_BAR;
    } else {
        PG8_STAGE(PG8_SB(0, 0), cB, voffB); PG8_STAGE(PG8_SA(0, 0), cA, voffA); PG8_STAGE(PG8_SB(0, 1), cB + hstep, voffB); PG8_STAGE(PG8_SA(0, 1), cA + hstep, voffA);
        if (wr == 1) PG8_BAR;
        PG8_WAIT_V(4); PG8_BAR;
        PG8_STAGE(PG8_SB(1, 0), cB + kstep, voffB); PG8_STAGE(PG8_SA(1, 0), cA + kstep, voffA); PG8_STAGE(PG8_SB(1, 1), cB + hstep + kstep, voffB);
        PG8_WAIT_V(6); PG8_BAR;
    }
    for (;;) {
        const bool has_next = S.next(ui + 1, nxt);
        const char* nA = has_next ? (const char*)g.A + (size_t)nxt.pm * tstep : cA; const char* nB = has_next ? (const char*)g.Bt + (size_t)nxt.pn * tstep : cB;
        for (int t = 0; t < nt; t += 2) {
            const bool last = (t == nt - 2);
            const char* a1 = cA + (size_t)(t + 1) * kstep;
            const char* a2 = last ? nA : cA + (size_t)(t + 2) * kstep; const char* b2 = last ? nB : cB + (size_t)(t + 2) * kstep;
            const char* a3 = a2 + kstep; const char* b3 = b2 + kstep;
            if (last && has_next) S.a_ready(nxt);
            if constexpr (SP2) {
            PG8_LDB(B0, 0, 0); PG8_LDB(B1, 0, 1); PG8_SCHED; PG8_LDA(At, 0, 0); PG8_STAGE(PG8_SA(1, 1), a1 + hstep, voffA);
            PG8_WAIT_V(8); PG8_WAIT_L(0); PG8_BAR; PG8_MMA(0, 0, At, B0); PG8_MMA(0, 1, At, B1); PG8_BAR; PG8_SCHED;
            PG8_LDA(At, 0, 1); PG8_STAGE(PG8_SB(0, 0), b2, voffB); PG8_STAGE(PG8_SB(0, 1), b2 + hstep, voffB); PG8_STAGE(PG8_SA(0, 0), a2, voffA);
            PG8_WAIT_V(8); PG8_WAIT_L(0); PG8_BAR; PG8_MMA(1, 0, At, B0); PG8_MMA(1, 1, At, B1); PG8_BAR; PG8_SCHED;
            PG8_LDB(B0, 1, 0); PG8_LDB(B1, 1, 1); PG8_SCHED; PG8_LDA(At, 1, 0); PG8_STAGE(PG8_SA(0, 1), a2 + hstep, voffA);
            PG8_WAIT_V(8); PG8_WAIT_L(0); PG8_BAR; PG8_MMA(0, 0, At, B0); PG8_MMA(0, 1, At, B1); PG8_BAR; PG8_SCHED;
            PG8_LDA(At, 1, 1); PG8_STAGE(PG8_SB(1, 0), b3, voffB); PG8_STAGE(PG8_SB(1, 1), b3 + hstep, voffB); PG8_STAGE(PG8_SA(1, 0), a3, voffA);
            PG8_WAIT_V(8); PG8_WAIT_L(0); PG8_BAR; PG8_MMA(1, 0, At, B0); PG8_MMA(1, 1, At, B1); PG8_BAR; PG8_SCHED;
            } else {
            PG8_LDB(B0, 0, 0); PG8_SCHED; PG8_LDA(At, 0, 0); PG8_STAGE(PG8_SA(1, 1), a1 + hstep, voffA);
            PG8_WAIT_L(8); PG8_BAR; PG8_WAIT_L(0); PG8_MMA(0, 0, At, B0); PG8_BAR; PG8_SCHED;
            PG8_LDB(B1, 0, 1); PG8_STAGE(PG8_SB(0, 0), b2, voffB);
            PG8_BAR; PG8_WAIT_L(0); PG8_MMA(0, 1, At, B1); PG8_BAR;
            PG8_LDA(At, 0, 1); PG8_STAGE(PG8_SA(0, 0), a2, voffA);
            PG8_BAR; PG8_WAIT_L(0); PG8_MMA(1, 0, At, B0); PG8_BAR; PG8_SCHED;
            PG8_STAGE(PG8_SB(0, 1), b2 + hstep, voffB);
            PG8_WAIT_V(6); PG8_BAR; PG8_MMA(1, 1, At, B1); PG8_BAR;
            PG8_LDB(B0, 1, 0); PG8_SCHED; PG8_LDA(At, 1, 0); PG8_STAGE(PG8_SA(0, 1), a2 + hstep, voffA);
            PG8_WAIT_L(8); PG8_BAR; PG8_WAIT_L(0); PG8_MMA(0, 0, At, B0); PG8_BAR; PG8_SCHED;
            PG8_LDB(B1, 1, 1); PG8_STAGE(PG8_SB(1, 0), b3, voffB);
            PG8_BAR; PG8_WAIT_L(0); PG8_MMA(0, 1, At, B1); PG8_BAR;
            PG8_LDA(At, 1, 1); PG8_STAGE(PG8_SA(1, 0), a3, voffA);
            PG8_BAR; PG8_WAIT_L(0); PG8_MMA(1, 0, At, B0); PG8_BAR; PG8_SCHED;
            PG8_STAGE(PG8_SB(1, 1), b3 + hstep, voffB);
            PG8_WAIT_V(6); PG8_BAR; PG8_MMA(1, 1, At, B1); PG8_BAR;
            }
        }
        if constexpr (ALIGN_EPI) { if (wr == 0) PG8_BAR; }
        if constexpr (!Epi::AFTER_DRAIN) { E(acc, cur, wr, wc, fr, fq); S.done(cur); }
        if (!has_next) break;
#pragma unroll
        for (int a = 0; a < 2; ++a)
#pragma unroll
            for (int b = 0; b < 2; ++b)
#pragma unroll
                for (int m = 0; m < 4; ++m)
#pragma unroll
                    for (int n = 0; n < 2; ++n) acc[a][b][m][n] = (f32x4){0.f, 0.f, 0.f, 0.f};
        cur = nxt; cA = nA; cB = nB; ++ui;
        if constexpr (ALIGN_EPI) { if (wr == 1) PG8_BAR; }
    }
    PG8_WAIT_V(0);
    if constexpr (!ALIGN_EPI) { if (wr == 0) PG8_BAR; }
    PG8_BAR;
    if constexpr (Epi::AFTER_DRAIN) { E.fused(acc, cur, wr, wc, fr, fq, lds, wid, lane); S.done(cur); }
#undef PG8_SA
#undef PG8_SB
#undef PG8_STAGE
#undef PG8_LDA
#undef PG8_LDB
#undef PG8_MMA
#undef PG8_WAIT_V
#undef PG8_WAIT_L
#undef PG8_BAR
#undef PG8_SCHED
}
}

constexpr int NWAVES = 8;
constexpr int RING_OFF = 0, RING_BYTES = 131072;
constexpr int LDSCTL_OFF = RING_BYTES, MISC_OFF = LDSCTL_OFF + 320;
constexpr int LDS_BYTES = 163840;
constexpr int CW_Q = 8192;
constexpr int CW_BAR = 4096;
#define GAS __attribute__((address_space(1)))
#define LAS __attribute__((address_space(3)))
typedef unsigned short bf16;
typedef unsigned v4u __attribute__((ext_vector_type(4)));
typedef unsigned v2u __attribute__((ext_vector_type(2)));
typedef float f32x4 __attribute__((ext_vector_type(4)));
typedef float f32x16 __attribute__((ext_vector_type(16)));
typedef short bf16x8 __attribute__((ext_vector_type(8)));
typedef GAS unsigned gu32;
#define LDS_WAIT() asm volatile("s_waitcnt lgkmcnt(0)" ::: "memory")
#define VM_WAIT() asm volatile("s_waitcnt vmcnt(0)" ::: "memory")
__device__ __forceinline__ unsigned f2bf(float f) { unsigned u = __builtin_bit_cast(unsigned, f); return (u + 0x7fffu + ((u >> 16) & 1u)) >> 16; }
__device__ __forceinline__ unsigned pk2(float lo, float hi) { return pg8::cvt_pk_bf16(lo, hi); }
__device__ __forceinline__ float bf2f(unsigned short b) { return __builtin_bit_cast(float, (unsigned)b << 16); }
__device__ __forceinline__ float wave_sum(float v) {
#pragma unroll
    for (int o = 1; o < 64; o <<= 1) v += __shfl_xor(v, o);
    return v;
}
__device__ __forceinline__ float wave_max(float v) {
#pragma unroll
    for (int o = 1; o < 64; o <<= 1) v = fmaxf(v, __shfl_xor(v, o));
    return v;
}
#define XB_TMO      128
#define XB_XCNT(j)  (256  + 64 * (j))
#define XB_XSUB(j)  (1280 + 64 * (j))
#define XB_XGEN(j)  (2304 + 64 * (j))
#define XB_TOP      3328
#define XB_TOPGEN   3392
#define XCD_BAR_WORDS 3456
#define XB_SPIN_CAP (1u << 18)

__device__ __forceinline__ unsigned xb_ld(unsigned* p)              { return __hip_atomic_load(p, __ATOMIC_RELAXED, __HIP_MEMORY_SCOPE_AGENT); }
__device__ __forceinline__ unsigned xb_add(unsigned* p, unsigned v) { return __hip_atomic_fetch_add(p, v, __ATOMIC_RELAXED, __HIP_MEMORY_SCOPE_AGENT); }
__device__ __forceinline__ unsigned xb_xcc_id() { return (unsigned)__builtin_amdgcn_s_getreg((3 << 11) | 20) & 0xFu; }
#define XB_SPIN(cond, bar) do { unsigned _sp = 0; while (cond) { __builtin_amdgcn_s_sleep(1); \
    if ((++_sp & 255u) == 0u) { if (xb_ld(&(bar)[XB_TMO])) break; if (_sp > XB_SPIN_CAP) { atomicAdd(&(bar)[XB_TMO], 1u); break; } } } } while (0)

struct XcdBarrier {
    unsigned* bar; unsigned x;
    volatile LAS unsigned* st;
};

__device__ __forceinline__ XcdBarrier xcd_barrier_post(unsigned* bar, volatile LAS unsigned* st) {
    XcdBarrier b; b.bar = bar; b.x = xb_xcc_id(); b.st = st;
    if (threadIdx.x == 0) (void)xb_add(&bar[XB_XCNT(b.x)], 1u);
    return b;
}
__device__ __forceinline__ void xcd_barrier_complete(unsigned* bar, unsigned x, unsigned& nloc, unsigned& nx) {
    const unsigned G = gridDim.x * gridDim.y * gridDim.z;
    unsigned sum, cnt, mine, sp = 0u;
    for (;;) {
        sum = 0u; cnt = 0u; mine = 0u;
#pragma unroll
        for (unsigned j = 0; j < 16; ++j) { const unsigned c = xb_ld(&bar[XB_XCNT(j)]); sum += c; cnt += (c > 0u) ? 1u : 0u; mine = (j == x) ? c : mine; }
        if (sum == G) break;
        __builtin_amdgcn_s_sleep(1);
        if ((++sp & 255u) == 0u) { if (xb_ld(&bar[XB_TMO])) break; if (sp > XB_SPIN_CAP) { atomicAdd(&bar[XB_TMO], 1u); break; } }
    }
    nloc = mine > 0u ? mine : 1u; nx = cnt > 0u ? cnt : 1u;
}

__device__ __forceinline__ void xcd_barrier(const XcdBarrier& b) {
    asm volatile("s_waitcnt vmcnt(0)" ::: "memory");
    __syncthreads();
    if (threadIdx.x == 0) {
        unsigned* bar = b.bar;
        __builtin_amdgcn_s_waitcnt(0);
        unsigned nloc = b.st[0], nx = b.st[1];
        if (nloc == 0u) { xcd_barrier_complete(bar, b.x, nloc, nx); b.st[0] = nloc; b.st[1] = nx; }
        const unsigned old = xb_add(&bar[XB_XSUB(b.x)], 1u);
        const unsigned gen = old / nloc;
        if (old + 1u == (gen + 1u) * nloc) {
            __builtin_amdgcn_fence(__ATOMIC_RELEASE, "agent");
            asm volatile("s_waitcnt vmcnt(0)" ::: "memory");
            const unsigned og = xb_add(&bar[XB_TOP], 1u);
            const unsigned tg = og / nx;
            if (og + 1u == (tg + 1u) * nx) xb_add(&bar[XB_TOPGEN], 1u);
            else XB_SPIN(xb_ld(&bar[XB_TOPGEN]) == tg, bar);
            __builtin_amdgcn_fence(__ATOMIC_ACQUIRE, "agent");
            xb_add(&bar[XB_XGEN(b.x)], 1u);
            asm volatile("s_waitcnt vmcnt(0)" ::: "memory");
        } else {
            XB_SPIN(xb_ld(&bar[XB_XGEN(b.x)]) == gen, bar);
            __builtin_amdgcn_fence(__ATOMIC_ACQUIRE, "agent");
            asm volatile("s_waitcnt vmcnt(0)" ::: "memory");
        }
    }
    __syncthreads();
}

struct Frame {
    LAS unsigned char* lds; volatile LAS unsigned* MISC; gu32* ctl;
    int tid, lane, wave, vcu, G, bid;
    const float *xp, *xs, *cache_k, *cache_v, *cache_kidx, *state_pool; const int* page_table;
    const float *cp, *cs, *norm_w, *w_ada, *b_ada, *w_in, *qnw, *knw, *w_pool, *pool_scale, *w_out;
    float* out; unsigned char* ws;
#if TEST_MODE == 4 && P3FINE
    unsigned long long* ts; int nst;
#endif
};
#if TEST_MODE == 4 && P3FINE
#define FSTAMP() do { if (blockIdx.x == STAMP_BLK && threadIdx.x == 0) F.ts[F.nst] = __builtin_amdgcn_s_memrealtime(); ++F.nst; } while (0)
#else
#define FSTAMP() do { } while (0)
#endif

struct F3 { float x, y, z; };
__device__ __forceinline__ void p0_ada(Frame& F, int task) {
    const int lane = F.lane, w = F.wave, rl = lane & 15, kq = lane >> 4, rg = task >> 6, cg = task & 63, n0 = cg * 48, r0 = rg * 48;
    f32x4 acc[9];
#pragma unroll
    for (int i = 0; i < 9; ++i) acc[i] = (f32x4){0.f, 0.f, 0.f, 0.f};
    const float* wp = F.w_ada + (size_t)(w * 128 + 4 * kq) * 3072 + n0 + 3 * rl;
#pragma unroll
    for (int hf = 0; hf < 2; ++hf) {
        F3 bv[16]; f32x4 cv[3][4]; bool valid[3];
#pragma unroll
        for (int i4 = 0; i4 < 4; ++i4)
#pragma unroll
            for (int u = 0; u < 4; ++u) bv[i4 * 4 + u] = *(const F3*)(wp + (size_t)(16 * (4 * hf + i4) + u) * 3072);
#pragma unroll
        for (int rt = 0; rt < 3; ++rt) { const int row = r0 + 16 * rt + rl; valid[rt] = row < NR;
            const float* cptr = (row < NB ? F.cp + (size_t)row * DM : F.cs + (size_t)((valid[rt] ? row : NB) - NB) * DM) + w * 128 + 4 * kq;
#pragma unroll
            for (int i4 = 0; i4 < 4; ++i4) cv[rt][i4] = *(const f32x4*)(cptr + 16 * (4 * hf + i4)); }
#pragma unroll
        for (int rt = 0; rt < 3; ++rt)
#pragma unroll
            for (int i4 = 0; i4 < 4; ++i4)
#pragma unroll
                for (int u = 0; u < 4; ++u) { const float a = valid[rt] ? pg8::silu1(cv[rt][i4][u]) : 0.f; const F3 b = bv[i4 * 4 + u];
                    acc[3 * rt + 0] = __builtin_amdgcn_mfma_f32_16x16x4f32(a, b.x, acc[3 * rt + 0], 0, 0, 0);
                    acc[3 * rt + 1] = __builtin_amdgcn_mfma_f32_16x16x4f32(a, b.y, acc[3 * rt + 1], 0, 0, 0);
                    acc[3 * rt + 2] = __builtin_amdgcn_mfma_f32_16x16x4f32(a, b.z, acc[3 * rt + 2], 0, 0, 0); }
    }
    LAS float* red = (LAS float*)(F.lds + RING_OFF);
#pragma unroll
    for (int rt = 0; rt < 3; ++rt)
#pragma unroll
        for (int t = 0; t < 3; ++t)
#pragma unroll
            for (int e = 0; e < 4; ++e) red[(w * 48 + 16 * rt + 4 * kq + e) * 49 + 3 * rl + t] = acc[3 * rt + t][e];
    __syncthreads();
    float* ada = (float*)(F.ws + WS_ADA);
    for (int o = F.tid; o < 48 * 48; o += NWAVES * 64) { const int row = o / 48, col = o - row * 48; float s = F.b_ada[n0 + col];
#pragma unroll
        for (int ww = 0; ww < 8; ++ww) s += red[(ww * 48 + row) * 49 + col];
        if (r0 + row < NR) ada[(size_t)(r0 + row) * 3072 + n0 + col] = s; }
    __syncthreads();
}
__device__ __forceinline__ void transpose_item(const float* W, int ldn, int srccol0, int nvalid, bf16* WT, int K, int dstrow0, int k0, LAS float* scr, int lane) {
    float tv[32];
#pragma unroll
    for (int i = 0; i < 32; ++i) { const int kk = 2 * i + (lane >> 5), c = lane & 31; tv[i] = c < nvalid ? W[(size_t)(k0 + kk) * ldn + srccol0 + c] : 0.f; }
#pragma unroll
    for (int i = 0; i < 32; ++i) { const int kk = 2 * i + (lane >> 5), c = lane & 31; scr[kk * 33 + c] = tv[i]; }
    LDS_WAIT(); asm volatile("" ::: "memory");
    const int c = lane & 7;
#pragma unroll
    for (int j = 0; j < 4; ++j) { const int n = (lane >> 3) + 8 * j; const LAS float* s = scr + (8 * c) * 33 + n;
        v4u o; o.x = pk2(s[0 * 33], s[1 * 33]); o.y = pk2(s[2 * 33], s[3 * 33]); o.z = pk2(s[4 * 33], s[5 * 33]); o.w = pk2(s[6 * 33], s[7 * 33]);
        *(GAS v4u*)(WT + (size_t)(dstrow0 + n) * K + k0 + 8 * c) = o; }
    LDS_WAIT(); asm volatile("" ::: "memory");
}
__device__ __forceinline__ int win_col(int pn, int hd, int d) {
    if (pn <= 1) return CQ + (4 * pn + hd) * 64 + d;
    if (pn == 2) return hd < 2 ? CK + hd * 64 + d : CV + (hd - 2) * 64 + d;
    if (pn <= 4) return CQI + (4 * (pn - 3) + hd) * 64 + d;
    if (pn == 5) return hd == 0 ? CKI + d : ((hd == 1 && d < 8) ? CWI + d : -1);
    if (pn <= 7) return CGA + (4 * (pn - 6) + hd) * 64 + d;
    if (pn <= 9) return CU + (4 * (pn - 8) + hd) * 64 + d;
    return CGP + (4 * (pn - 10) + hd) * 64 + d;
}
__device__ __forceinline__ void p0_prologue(Frame& F) {
    LAS float* scr = (LAS float*)(F.lds + RING_OFF + F.wave * 16384);
    const int gw = F.vcu * NWAVES + F.wave, NGW = F.G * NWAVES;
    bf16* WINT = (bf16*)(F.ws + WS_WINT); bf16* WOUTT = (bf16*)(F.ws + WS_WOUTT); bf16* WPOOLT = (bf16*)(F.ws + WS_WPOOLT);
    const bool split = F.G > 192 + 16;
    if (split) { if (F.bid < 192) p0_ada(F, F.bid); }
    else { for (int task = F.bid; task < 192; task += F.G) p0_ada(F, task); }
    if (!split || F.bid >= 192) {
        const int tw0 = split ? (F.bid - 192) * NWAVES + F.wave : gw, tws = split ? (F.G - 192) * NWAVES : NGW;
        for (int it = tw0; it < 2080; it += tws) {
            if (it < 1536) { const int G = it >> 4, kb = it & 15, pn = G >> 3, bj = (G >> 2) & 1, hd = G & 3; const int src = win_col(pn, hd, 32 * bj);
                const int nvalid = src < 0 ? 0 : ((pn == 5 && hd == 1) ? 8 : 32);
                transpose_item(F.w_in, NIN, src < 0 ? 0 : src, nvalid, WINT, 1024, 32 * G, 64 * kb, scr, F.lane); }
            else if (it < 2048) { const int r = it - 1536, G = r >> 4, kb = r & 15; transpose_item(F.w_out, 1024, 32 * G, 32, WOUTT, 1024, 32 * G, 64 * kb, scr, F.lane); }
            else { const int r = it - 2048, g = r >> 3, kb = (r >> 2) & 1, G = r & 3; transpose_item(F.w_pool + (size_t)g * 16384, 128, 32 * G, 32, WPOOLT + (size_t)g * 16384, 128, 32 * G, 64 * kb, scr, F.lane); }
        }
    }
    { const int nf4 = DECB * 1792; f32x4 t4[2]; int ix[2];
#pragma unroll
      for (int k = 0; k < 2; ++k) { ix[k] = gw * 64 + F.lane + k * NGW * 64; if (ix[k] < nf4) { const int s = ix[k] / 1792, i = ix[k] - s * 1792; t4[k] = *(const f32x4*)(F.state_pool + (size_t)s * 7680 + 512 + 4 * i); } }
#pragma unroll
      for (int k = 0; k < 2; ++k) { if (ix[k] < nf4) { const int s = ix[k] / 1792, i = ix[k] - s * 1792; *(f32x4*)(F.out + O_PS + (size_t)s * 7680 + 4 * i) = t4[k]; } }
      for (int ixx = gw * 64 + F.lane + 2 * NGW * 64; ixx < nf4; ixx += NGW * 64) { const int s = ixx / 1792, i = ixx - s * 1792; *(f32x4*)(F.out + O_PS + (size_t)s * 7680 + 4 * i) = *(const f32x4*)(F.state_pool + (size_t)s * 7680 + 512 + 4 * i); } }
}

template <int N> __device__ __forceinline__ void norm_rows_load(Frame& F, const float* x0, f32x4 (&v)[N][4]) {
#pragma unroll
    for (int i = 0; i < N; ++i) { const GAS f32x4* xr = (const GAS f32x4*)(x0 + (size_t)i * DM) + F.lane;
#pragma unroll
        for (int j = 0; j < 4; ++j) v[i][j] = xr[64 * j]; }
}
template <int N, bool SAME_ADA> __device__ __forceinline__ void norm_rows_finish(Frame& F, f32x4 (&v)[N][4], const float* adarow0, int adastride, bf16* o0) {
    float s2[N];
#pragma unroll
    for (int i = 0; i < N; ++i) { s2[i] = 0.f;
#pragma unroll
        for (int j = 0; j < 4; ++j) s2[i] += (v[i][j].x * v[i][j].x + v[i][j].y * v[i][j].y) + (v[i][j].z * v[i][j].z + v[i][j].w * v[i][j].w); }
#pragma unroll
    for (int o = 1; o < 64; o <<= 1) {
#pragma unroll
        for (int i = 0; i < N; ++i) s2[i] += __shfl_xor(s2[i], o); }
#pragma unroll
    for (int j = 0; j < 4; ++j) { const int col = 4 * F.lane + 256 * j; const f32x4 nw = *(const f32x4*)(F.norm_w + col);
        f32x4 gq, sh;
        if (SAME_ADA) { sh = *(const f32x4*)(adarow0 + col); gq = nw * (*(const f32x4*)(adarow0 + 1024 + col) + 1.0f); }
#pragma unroll
        for (int i = 0; i < N; ++i) {
            if (!SAME_ADA) { const float* ar = adarow0 + (size_t)i * adastride; sh = *(const f32x4*)(ar + col); gq = nw * (*(const f32x4*)(ar + 1024 + col) + 1.0f); }
            const float rstd = 1.0f / sqrtf(s2[i] * (1.0f / DM) + EPS);
            const f32x4 o = v[i][j] * rstd * gq + sh;
            ((GAS unsigned long long*)(o0 + (size_t)i * DM))[F.lane + 64 * j] = (unsigned long long)pk2(o.x, o.y) | ((unsigned long long)pk2(o.z, o.w) << 32); } }
}
template <int N, bool SAME_ADA> __device__ __forceinline__ void norm_rows(Frame& F, const float* x0, const float* adarow0, int adastride, bf16* o0) {
    f32x4 v[N][4]; norm_rows_load<N>(F, x0, v); norm_rows_finish<N, SAME_ADA>(F, v, adarow0, adastride, o0);
}
template <int NBATCH> __device__ __forceinline__ void skinny_core(const bf16* arow, const bf16* b0, const bf16* b1, const bf16* b2, const bf16* b3, f32x4 (&acc)[4]) {
#pragma unroll
    for (int j = 0; j < 4; ++j) acc[j] = (f32x4){0.f, 0.f, 0.f, 0.f};
    bf16x8 fa[2][4], fb[2][4][4];
#define SK_LOAD(buf, kb) do { _Pragma("unroll") for (int q_ = 0; q_ < 4; ++q_) { const int ko_ = 32 * (4 * (kb) + q_); fa[buf][q_] = *(const bf16x8*)(arow + ko_); \
        fb[buf][q_][0] = *(const bf16x8*)(b0 + ko_); fb[buf][q_][1] = *(const bf16x8*)(b1 + ko_); fb[buf][q_][2] = *(const bf16x8*)(b2 + ko_); fb[buf][q_][3] = *(const bf16x8*)(b3 + ko_); } } while (0)
#define SK_MMA(buf) do { _Pragma("unroll") for (int q_ = 0; q_ < 4; ++q_) { _Pragma("unroll") for (int j_ = 0; j_ < 4; ++j_) acc[j_] = __builtin_amdgcn_mfma_f32_16x16x32_bf16(fa[buf][q_], fb[buf][q_][j_], acc[j_], 0, 0, 0); } } while (0)
    SK_LOAD(0, 0);
#pragma unroll
    for (int kb = 0; kb < NBATCH; kb += 2) {
        SK_LOAD(1, kb + 1); SK_MMA(0);
        if (kb + 2 < NBATCH) SK_LOAD(0, kb + 2);
        SK_MMA(1);
    }
#undef SK_LOAD
#undef SK_MMA
}
__device__ __forceinline__ void sample_inproj(Frame& F, int pn, int hd, int rh) {
    const int lane = F.lane, w = F.wave & 3, kh = F.wave >> 2, rl = lane & 15, kq = lane >> 4;
    const bf16* HS = (const bf16*)(F.ws + WS_HS);
    const bf16* WINT = (const bf16*)(F.ws + WS_WINT);
    const bf16* bb = WINT + (size_t)(256 * pn + 32 * hd + rl) * 1024 + 512 * kh + 8 * kq;
    f32x4 acc[4];
    skinny_core<4>(HS + (size_t)(64 * rh + 16 * w + rl) * 1024 + 512 * kh + 8 * kq, bb, bb + 16 * 1024, bb + 128 * 1024, bb + 144 * 1024, acc);
    { LAS f32x4* red = (LAS f32x4*)(F.lds + RING_OFF);
      if (kh == 1) {
#pragma unroll
          for (int j = 0; j < 4; ++j) red[(w * 4 + j) * 64 + lane] = acc[j]; }
      __syncthreads();
      if (kh == 1) return;
#pragma unroll
      for (int j = 0; j < 4; ++j) acc[j] += red[(w * 4 + j) * 64 + lane]; }
    const int sbase = 64 * rh + 16 * w + 4 * kq;
    float* out = F.out;
    if (pn <= 1 || (pn == 2 && hd < 2)) {
        const float* nwp = pn <= 1 ? F.qnw : F.knw; const float sc = pn <= 1 ? C2 : 1.0f;
#pragma unroll
        for (int e = 0; e < 4; ++e) { float ss = 0.f;
#pragma unroll
            for (int j = 0; j < 4; ++j) ss += acc[j][e] * acc[j][e];
            ss += __shfl_xor(ss, 1); ss += __shfl_xor(ss, 2); ss += __shfl_xor(ss, 4); ss += __shfl_xor(ss, 8);
            const float rstd = 1.0f / sqrtf(ss * (1.0f / 64.0f) + EPS); const int s = sbase + e; const size_t m = (size_t)(MP + s);
#pragma unroll
            for (int j = 0; j < 4; ++j) { const int d = 16 * j + rl; const float o = acc[j][e] * rstd * nwp[d] * sc;
                if (pn <= 1) ((bf16*)(F.ws + WS_Q))[m * 512 + (4 * pn + hd) * 64 + d] = (bf16)f2bf(o);
                else { out[O_KS + (size_t)s * 128 + hd * 64 + d] = o; ((bf16*)(F.ws + WS_KB))[m * 128 + hd * 64 + d] = (bf16)f2bf(o); } } }
        return;
    }
    if (pn == 5 && hd == 1) {
        if (rl < 8) {
#pragma unroll
            for (int e = 0; e < 4; ++e) { const int s = sbase + e; ((float*)(F.ws + WS_WI))[(size_t)(MP + s) * 8 + rl] = acc[0][e] * WI_SCALE; } }
        return;
    }
    bf16* dst; int ld, cb; float* fo = nullptr; int fld = 0; bool act = false;
    if (pn == 2) { dst = (bf16*)(F.ws + WS_VB); ld = 128; cb = (hd - 2) * 64; fo = out + O_VS + cb; fld = 128; }
    else if (pn <= 4) { dst = (bf16*)(F.ws + WS_QI); ld = 512; cb = (4 * (pn - 3) + hd) * 64; }
    else if (pn == 5) { dst = (bf16*)(F.ws + WS_KI); ld = 64; cb = 0; fo = out + O_KIS; fld = 64; }
    else if (pn <= 7) { dst = (bf16*)(F.ws + WS_GA); ld = 512; cb = (4 * (pn - 6) + hd) * 64; act = true; }
    else if (pn <= 9) { dst = (bf16*)(F.ws + WS_U); ld = 512; cb = (4 * (pn - 8) + hd) * 64; fo = out + O_PS + 14 * 512 + cb; fld = 15 * 512; }
    else { dst = (bf16*)(F.ws + WS_GP); ld = 512; cb = (4 * (pn - 10) + hd) * 64; act = true; }
#pragma unroll
    for (int e = 0; e < 4; ++e) { const int s = sbase + e; const size_t m = (size_t)(MP + s);
#pragma unroll
        for (int j = 0; j < 4; ++j) { const int d = 16 * j + rl; float o = acc[j][e]; if (act) o = pg8::silu1(o);
            dst[m * ld + cb + d] = (bf16)f2bf(o);
            if (fo) fo[(size_t)s * fld + d] = o; } }
}
struct P1Pre { f32x4 v[2][4][4]; };
__device__ __forceinline__ void p1_prefetch(Frame& F, P1Pre& pre) {
    const int gw = F.vcu * NWAVES + F.wave, NGW = F.G * NWAVES;
#pragma unroll
    for (int k = 0; k < 2; ++k) { const int ch = gw + k * NGW; if (ch < MP / 4) norm_rows_load<4>(F, F.xp + (size_t)(4 * ch) * DM, pre.v[k]); }
}
__device__ __forceinline__ void p1_norm(Frame& F, P1Pre& pre) {
    const float* ada = (const float*)(F.ws + WS_ADA); bf16* HB = (bf16*)(F.ws + WS_HB); bf16* HS = (bf16*)(F.ws + WS_HS);
    const int gw = F.vcu * NWAVES + F.wave, NGW = F.G * NWAVES;
#pragma unroll
    for (int k = 0; k < 2; ++k) { const int ch = gw + k * NGW; if (ch < MP / 4) { const int m = 4 * ch; norm_rows_finish<4, true>(F, pre.v[k], ada + (size_t)(m >> 11) * 3072, 0, HB + (size_t)m * DM); } }
    for (int ch = gw + 2 * NGW; ch < MP / 4 + DECB / 2; ch += NGW) {
        if (ch < MP / 4) { const int m = 4 * ch; norm_rows<4, true>(F, F.xp + (size_t)m * DM, ada + (size_t)(m >> 11) * 3072, 0, HB + (size_t)m * DM); }
        else { const int s = 2 * (ch - MP / 4); norm_rows<2, false>(F, F.xs + (size_t)s * DM, ada + (size_t)(NB + s) * 3072, 3072, HS + (size_t)s * DM); } }
}
__device__ __forceinline__ void p2_sample(Frame& F) {
    const int task = F.bid >> 1, pn = task >> 2, hd = task & 3;
    if (F.bid < 96 && !(pn == 5 && hd >= 2)) { sample_inproj(F, pn, hd, F.bid & 1); __syncthreads(); }
}

constexpr int P3_KEYS = 0;
constexpr int P3_BM = 132096;
constexpr int P3_WQ = 136192;
constexpr int P3_QI = 136704;
constexpr int P3_AI_HS = 144, P3_AI_RS = 1152;
constexpr int P3_AQ_HS = 160, P3_AQ_RS = 1408;
constexpr int P3_QL = 159232;
constexpr int P3_XM = 159232;
constexpr int P3_VW = 0, P3_VWB = 4096;

__device__ __forceinline__ float relu_s(float x) { return __builtin_amdgcn_fmed3f(x, 0.0f, __builtin_inff()); }
__device__ __forceinline__ unsigned f2key(float f) { unsigned u = __float_as_uint(f); if (f == 0.0f) u = 0u; return (u & 0x80000000u) ? ~u : (u | 0x80000000u); }
__device__ __forceinline__ float key2f(unsigned k) { return __uint_as_float((k & 0x80000000u) ? (k ^ 0x80000000u) : ~k); }

__device__ __forceinline__ unsigned half_reduce_add(unsigned v) {
    v += (unsigned)__builtin_amdgcn_update_dpp(0, (int)v, 0xB1, 0xF, 0xF, true);
    v += (unsigned)__builtin_amdgcn_update_dpp(0, (int)v, 0x4E, 0xF, 0xF, true);
    v += (unsigned)__builtin_amdgcn_update_dpp(0, (int)v, 0x141, 0xF, 0xF, true);
    v += (unsigned)__builtin_amdgcn_update_dpp(0, (int)v, 0x140, 0xF, 0xF, true);
    v += (unsigned)__builtin_amdgcn_ds_swizzle((int)v, 0x401F);
    return v;
}
__device__ __forceinline__ float probit_f(float p) {
    const float pp = p < 0.5f ? p : 1.0f - p; const float t = sqrtf(-2.0f * __logf(pp));
    const float z = t - (2.515517f + t * (0.802853f + t * 0.010328f)) * __builtin_amdgcn_rcpf(1.0f + t * (1.432788f + t * (0.189269f + t * 0.001308f)));
    return p < 0.5f ? -z : z;
}
__device__ __forceinline__ unsigned half_reduce_min(unsigned v) {
    v = min(v, (unsigned)__builtin_amdgcn_update_dpp(0, (int)v, 0xB1, 0xF, 0xF, true)); v = min(v, (unsigned)__builtin_amdgcn_update_dpp(0, (int)v, 0x4E, 0xF, 0xF, true));
    v = min(v, (unsigned)__builtin_amdgcn_update_dpp(0, (int)v, 0x141, 0xF, 0xF, true)); v = min(v, (unsigned)__builtin_amdgcn_update_dpp(0, (int)v, 0x140, 0xF, 0xF, true));
    v = min(v, (unsigned)__builtin_amdgcn_ds_swizzle((int)v, 0x401F)); return v; }
__device__ __forceinline__ unsigned half_reduce_max(unsigned v) {
    v = max(v, (unsigned)__builtin_amdgcn_update_dpp(0, (int)v, 0xB1, 0xF, 0xF, true)); v = max(v, (unsigned)__builtin_amdgcn_update_dpp(0, (int)v, 0x4E, 0xF, 0xF, true));
    v = max(v, (unsigned)__builtin_amdgcn_update_dpp(0, (int)v, 0x141, 0xF, 0xF, true)); v = max(v, (unsigned)__builtin_amdgcn_update_dpp(0, (int)v, 0x140, 0xF, 0xF, true));
    v = max(v, (unsigned)__builtin_amdgcn_ds_swizzle((int)v, 0x401F)); return v; }
__device__ __forceinline__ unsigned wave_reduce_add_u(unsigned v) {
    v += (unsigned)__builtin_amdgcn_update_dpp(0, (int)v, 0xB1, 0xF, 0xF, true); v += (unsigned)__builtin_amdgcn_update_dpp(0, (int)v, 0x4E, 0xF, 0xF, true);
    v += (unsigned)__builtin_amdgcn_update_dpp(0, (int)v, 0x141, 0xF, 0xF, true); v += (unsigned)__builtin_amdgcn_update_dpp(0, (int)v, 0x140, 0xF, 0xF, true);
    return ((unsigned)__builtin_amdgcn_readlane((int)v, 0) + (unsigned)__builtin_amdgcn_readlane((int)v, 16)) + ((unsigned)__builtin_amdgcn_readlane((int)v, 32) + (unsigned)__builtin_amdgcn_readlane((int)v, 48)); }
__device__ __forceinline__ float row16_sum(float v) {
    v += __int_as_float(__builtin_amdgcn_update_dpp(0, __float_as_int(v), 0xB1, 0xF, 0xF, true)); v += __int_as_float(__builtin_amdgcn_update_dpp(0, __float_as_int(v), 0x4E, 0xF, 0xF, true));
    v += __int_as_float(__builtin_amdgcn_update_dpp(0, __float_as_int(v), 0x141, 0xF, 0xF, true)); v += __int_as_float(__builtin_amdgcn_update_dpp(0, __float_as_int(v), 0x140, 0xF, 0xF, true));
    return v; }
__device__ __forceinline__ float kq_max(float v) {
    auto a = __builtin_amdgcn_permlane16_swap(__float_as_uint(v), __float_as_uint(v), false, false); v = fmaxf(__uint_as_float(a[0]), __uint_as_float(a[1]));
    auto b = __builtin_amdgcn_permlane32_swap(__float_as_uint(v), __float_as_uint(v), false, false); return fmaxf(__uint_as_float(b[0]), __uint_as_float(b[1])); }
__device__ __forceinline__ float kq_sum(float v) {
    auto a = __builtin_amdgcn_permlane16_swap(__float_as_uint(v), __float_as_uint(v), false, false); v = __uint_as_float(a[0]) + __uint_as_float(a[1]);
    auto b = __builtin_amdgcn_permlane32_swap(__float_as_uint(v), __float_as_uint(v), false, false); return __uint_as_float(b[0]) + __uint_as_float(b[1]); }
__device__ __forceinline__ unsigned wave_reduce_min_u(unsigned v) { v = half_reduce_min(v); return min((unsigned)__builtin_amdgcn_readlane((int)v, 0), (unsigned)__builtin_amdgcn_readlane((int)v, 32)); }
__device__ __forceinline__ unsigned wave_reduce_max_u(unsigned v) { v = half_reduce_max(v); return max((unsigned)__builtin_amdgcn_readlane((int)v, 0), (unsigned)__builtin_amdgcn_readlane((int)v, 32)); }

struct P3Pre { v4u qi[2]; v4u qq[2]; float wqv; };
__device__ __forceinline__ void p3_prefetch(Frame& F, int b, int qt, P3Pre& pre) {
    const int tid = F.tid; const size_t mb = (size_t)b * SEQ; const int t0 = 16 * qt;
    const bf16* QI = (const bf16*)(F.ws + WS_QI); const bf16* Qg = (const bf16*)(F.ws + WS_Q);
#pragma unroll
    for (int k = 0; k < 2; ++k) { const int i = tid + 512 * k, row = i >> 6, ch = i & 63;
        pre.qi[k] = *(const v4u*)(QI + (mb + t0 + row) * 512 + ch * 8); pre.qq[k] = *(const v4u*)(Qg + (mb + t0 + row) * 512 + ch * 8); }
    pre.wqv = ((const float*)(F.ws + WS_WI))[(mb + t0 + ((tid & 127) >> 3)) * 8 + (tid & 7)];
}
__device__ __forceinline__ void p3_prompt_item(Frame& F, int b, int qt, P3Pre& pre, bool has_next, int nb, int nqt) {
    int tid_o_ = F.tid; asm volatile("" : "+v"(tid_o_));
    const int tid = tid_o_, lane = tid & 63, w = F.wave, r = lane & 31, hh = lane >> 5;
    const int t0 = 16 * qt, L = t0 + 16, nkt32 = (L + 31) >> 5, nkt64 = (L + 63) >> 6;
    const size_t mb = (size_t)b * SEQ;
    LAS unsigned* bm = (LAS unsigned*)(F.lds + P3_BM);
    LAS float* wq = (LAS float*)(F.lds + P3_WQ);
    LAS unsigned* keys = (LAS unsigned*)(F.lds + P3_KEYS);
    v4u qreg[2] = {pre.qq[0], pre.qq[1]};
    if (tid < 128) wq[tid] = pre.wqv;
#pragma unroll
    for (int k = 0; k < 2; ++k) { const int i = tid + 512 * k, row = i >> 6, ch = i & 63; *(LAS v4u*)(F.lds + P3_QI + row * P3_AI_RS + (ch >> 3) * P3_AI_HS + (ch & 7) * 16) = pre.qi[k]; }
    bf16x8 bb[3][4];
    { const bf16* KI_ = (const bf16*)(F.ws + WS_KI); const int ns_ = (nkt32 - w + 7) >> 3;
      if (0 < ns_) { const bf16* kp_ = KI_ + (mb + 32 * w + r) * 64 + 8 * hh;
#pragma unroll
          for (int ks_ = 0; ks_ < 4; ++ks_) bb[0][ks_] = *(const bf16x8*)(kp_ + 16 * ks_); }
      if (1 < ns_) { const bf16* kp_ = KI_ + (mb + 32 * (w + 8) + r) * 64 + 8 * hh;
#pragma unroll
          for (int ks_ = 0; ks_ < 4; ++ks_) bb[1][ks_] = *(const bf16x8*)(kp_ + 16 * ks_); } }
    __syncthreads();
    { LAS unsigned short* ql = (LAS unsigned short*)(F.lds + P3_QL);
#pragma unroll
      for (int k = 0; k < 2; ++k) { const int i = tid + 512 * k, qq = i >> 6, d = i & 63; float s = 0.f;
#pragma unroll
          for (int h = 0; h < 8; ++h) s += wq[qq * 8 + h] * bf2f(*(const LAS unsigned short*)(F.lds + P3_QI + qq * P3_AI_RS + h * P3_AI_HS + d * 2));
          ql[qq * 64 + d] = (unsigned short)f2bf(s); } }
    __syncthreads();
    FSTAMP();
    for (int rep1_ = 0; rep1_ < REP_S1; ++rep1_) {
        const bf16* KI = (const bf16*)(F.ws + WS_KI);
        const int ns = (nkt32 - w + 7) >> 3;
#define P3_LDK(slot) do { const bf16* kp_ = KI + (mb + 32 * (w + 8 * (slot)) + r) * 64 + 8 * hh; \
        _Pragma("unroll") for (int ks_ = 0; ks_ < 4; ++ks_) bb[(slot) % 3][ks_] = *(const bf16x8*)(kp_ + 16 * ks_); } while (0)
        const int arow = (2 * ((r >> 2) & 1) + (r >> 4)) * P3_AI_RS + ((r & 3) + 4 * ((r >> 3) & 1)) * P3_AI_HS + 16 * hh;
        const LAS unsigned char* qib = F.lds + P3_QI;
        const int lq_ = 4 * ((((r & 3) + 4 * (r >> 3)) >> 1) & 3) + 2 * ((r >> 2) & 1) + (r & 1);
        const LAS unsigned char* qlb = F.lds + P3_QL + lq_ * 128 + 16 * hh;
#define P3_MM(ACC, a, s) do { _Pragma("unroll") for (int e_ = 0; e_ < 16; ++e_) ACC[e_] = 0.f; \
        _Pragma("unroll") for (int ks_ = 0; ks_ < 4; ++ks_) { const bf16x8 af_ = *(const LAS bf16x8*)(qs_ + 4 * (a) * P3_AI_RS + arow + 32 * ks_); \
            ACC = __builtin_amdgcn_mfma_f32_32x32x16_bf16(af_, bb[(s) % 3][ks_], ACC, 0, 0, 0); } } while (0)
#define P3_EPI(ACC, a, s, u_) do { _Pragma("unroll") for (int j2_ = 0; j2_ < 2; ++j2_) { const int qq_ = 4 * (a) + 2 * hh + j2_; \
        const LAS f32x4* wp_ = (const LAS f32x4*)(wq + qq_ * 8); const f32x4 w0_ = wp_[0], w1_ = wp_[1]; \
        float sc_ = accL[2 * (a) + j2_]; sc_ = fmaf(w0_[0], fabsf(ACC[8 * j2_ + 0]), sc_); sc_ = fmaf(w0_[1], fabsf(ACC[8 * j2_ + 1]), sc_); sc_ = fmaf(w0_[2], fabsf(ACC[8 * j2_ + 2]), sc_); sc_ = fmaf(w0_[3], fabsf(ACC[8 * j2_ + 3]), sc_); \
        sc_ = fmaf(w1_[0], fabsf(ACC[8 * j2_ + 4]), sc_); sc_ = fmaf(w1_[1], fabsf(ACC[8 * j2_ + 5]), sc_); sc_ = fmaf(w1_[2], fabsf(ACC[8 * j2_ + 6]), sc_); sc_ = fmaf(w1_[3], fabsf(ACC[8 * j2_ + 7]), sc_); \
        keys[qq_ * 2048 + 32 * (w + 8 * (s)) + r] = f2key(sc_); } } while (0)
#define P3_MML(ACC, s) do { _Pragma("unroll") for (int e_ = 0; e_ < 16; ++e_) ACC[e_] = 0.f; \
        _Pragma("unroll") for (int ks_ = 0; ks_ < 4; ++ks_) { bf16x8 af_ = (bf16x8){0, 0, 0, 0, 0, 0, 0, 0}; if (r < 16) af_ = *(const LAS bf16x8*)(qlb + zo_ + 32 * ks_); \
            ACC = __builtin_amdgcn_mfma_f32_32x32x16_bf16(af_, bb[(s) % 3][ks_], ACC, 0, 0, 0); } } while (0)
#pragma unroll 1
        for (int s0 = 0; s0 < ns; s0 += 3) {
#pragma unroll
            for (int u = 0; u < 3; ++u) { const int s = s0 + u;
                if (s < ns) {
                    if (s + 2 < ns) { const bf16* kp_ = KI + (mb + 32 * (w + 8 * (s + 2)) + r) * 64 + 8 * hh;
#pragma unroll
                        for (int ks_ = 0; ks_ < 4; ++ks_) bb[(u + 2) % 3][ks_] = *(const bf16x8*)(kp_ + 16 * ks_); }
                    int zo_ = 0; asm volatile("" : "+v"(zo_));
                    const LAS unsigned char* qs_ = qib + zo_;
                    f32x16 accA, accB, accL;
                    P3_MML(accL, u);
                    P3_MM(accA, 0, u); P3_MM(accB, 1, u);
                    P3_EPI(accA, 0, s, u); P3_MM(accA, 2, u);
                    P3_EPI(accB, 1, s, u); P3_MM(accB, 3, u);
                    P3_EPI(accA, 2, s, u); P3_EPI(accB, 3, s, u);
                }
            }
        }
#undef P3_MM
#undef P3_MML
#undef P3_EPI
#undef P3_LDK
    }
    __syncthreads();
    FSTAMP();
    {
#pragma unroll
      for (int k = 0; k < 2; ++k) { const int i = tid + 512 * k, row = i >> 6, ch = i & 63; *(LAS v4u*)(F.lds + P3_QI + row * P3_AQ_RS + (ch >> 3) * P3_AQ_HS + (ch & 7) * 16) = qreg[k]; } }
    bf16x8 kf0[2][2]; v4u vr0[4];
    { const int g_ = w & 1, kq4_ = w >> 1, j_ = lane & 15, kq_ = lane >> 4;
      if (kq4_ < nkt32) {
#pragma unroll
          for (int c = 0; c < 2; ++c)
#pragma unroll
              for (int ks = 0; ks < 2; ++ks) kf0[c][ks] = *(const bf16x8*)((const bf16*)(F.ws + WS_KB) + (mb + 32 * kq4_ + 16 * c + j_) * 128 + g_ * 64 + 32 * ks + 8 * kq_);
#pragma unroll
          for (int i = 0; i < 4; ++i) vr0[i] = *(const v4u*)((const bf16*)(F.ws + WS_VB) + (mb + 32 * kq4_ + 8 * i + (lane >> 3)) * 128 + g_ * 64 + (lane & 7) * 8); } }
    for (int rep2_ = 0; rep2_ < REP_S2; ++rep2_) {
        int lane_ = F.lane; asm volatile("" : "+v"(lane_));
#define lane lane_
        const int qx0 = 2 * w, tq0 = t0 + qx0;
        unsigned sel0, sel1;
        if (t0 + 16 <= 256) {
            sel0 = 0u; sel1 = 0u;
#pragma unroll
            for (int jj = 0; jj < 32; ++jj) { sel0 |= (64 * jj + lane <= tq0) ? (1u << jj) : 0u; sel1 |= (64 * jj + lane <= tq0 + 1) ? (1u << jj) : 0u; }
        } else {
            unsigned x[32], y[32];
#pragma unroll
            for (int jj = 0; jj < 32; ++jj) { const int l = 64 * jj + lane; x[jj] = (l <= tq0) ? keys[qx0 * 2048 + l] : 0u; y[jj] = (l <= tq0 + 1) ? keys[(qx0 + 1) * 2048 + l] : 0u; }
#pragma unroll
            for (int st = 0; st < 5; ++st) { const int j = 16 >> st; const unsigned m = st == 0 ? 0x0000ffffu : st == 1 ? 0x00ff00ffu : st == 2 ? 0x0f0f0f0fu : st == 3 ? 0x33333333u : 0x55555555u;
#pragma unroll
                for (int k = 0; k < 32; ++k) if (!(k & j)) { const unsigned t_ = ((x[k] >> j) ^ x[k + j]) & m; x[k] ^= t_ << j; x[k + j] ^= t_;
                    const unsigned u_ = ((y[k] >> j) ^ y[k + j]) & m; y[k] ^= u_ << j; y[k + j] ^= u_; } }
            unsigned cur0 = 0xffffffffu, gt0 = 0u, cur1 = 0xffffffffu, gt1 = 0u; int ab0 = 0, ab1 = 0;
#pragma unroll
            for (int b = 31; b >= 0; --b) { const unsigned c0 = cur0 & x[b], c1 = cur1 & y[b];
                const unsigned pk = wave_reduce_add_u((unsigned)__popc(c0) | ((unsigned)__popc(c1) << 16)); const int n0 = (int)(pk & 0xffffu), n1 = (int)(pk >> 16);
                if (ab0 + n0 >= 256) cur0 = c0; else { ab0 += n0; gt0 |= c0; cur0 &= ~x[b]; }
                if (ab1 + n1 >= 256) cur1 = c1; else { ab1 += n1; gt1 |= c1; cur1 &= ~y[b]; } }
            const unsigned pke = wave_reduce_add_u((unsigned)__popc(cur0) | ((unsigned)__popc(cur1) << 16));
            const unsigned long long lt = (1ull << lane) - 1ull;
            { int need = 256 - ab0; if ((int)(pke & 0xffffu) == need) sel0 = gt0 | cur0;
              else { sel0 = gt0;
                for (int jj = 0; jj < 32; ++jj) { const unsigned long long meq = __ballot((cur0 >> jj) & 1u);
                    if (((cur0 >> jj) & 1u) && __popcll(meq & lt) < need) sel0 |= 1u << jj;
                    const int pc_ = __popcll(meq); need = need > pc_ ? need - pc_ : 0; } } }
            { int need = 256 - ab1; if ((int)(pke >> 16) == need) sel1 = gt1 | cur1;
              else { sel1 = gt1;
                for (int jj = 0; jj < 32; ++jj) { const unsigned long long meq = __ballot((cur1 >> jj) & 1u);
                    if (((cur1 >> jj) & 1u) && __popcll(meq & lt) < need) sel1 |= 1u << jj;
                    const int pc_ = __popcll(meq); need = need > pc_ ? need - pc_ : 0; } } }
        }
#pragma unroll
        for (int jj = 0; jj < 32; ++jj) { const unsigned long long b0 = __ballot((sel0 >> jj) & 1u), b1 = __ballot((sel1 >> jj) & 1u);
            if (lane == 0) { bm[qx0 * 64 + 2 * jj] = (unsigned)b0; bm[qx0 * 64 + 2 * jj + 1] = (unsigned)(b0 >> 32); bm[(qx0 + 1) * 64 + 2 * jj] = (unsigned)b1; bm[(qx0 + 1) * 64 + 2 * jj + 1] = (unsigned)(b1 >> 32); } }
#undef lane
    }
    __syncthreads();
#if TEST_MODE
    { unsigned* dbg = (unsigned*)(F.ws + WS_DBG_BM) + (mb + t0) * 64; for (int i = tid; i < 1024; i += NWAVES * 64) dbg[i] = bm[i]; }
#endif
    FSTAMP();
    for (int rep4_ = 0; rep4_ < REP_S4; ++rep4_) {
        int l4_ = lane; asm volatile("" : "+v"(l4_));
        const int g = w & 1, kq4 = w >> 1, j = l4_ & 15, kq = l4_ >> 4;
        const bf16* Q = (const bf16*)(F.ws + WS_Q); const bf16* KB = (const bf16*)(F.ws + WS_KB); const bf16* VB = (const bf16*)(F.ws + WS_VB);
        const LAS unsigned char* qlb = F.lds + P3_QI + (j >> 2) * P3_AQ_RS + (4 * g + (j & 3)) * P3_AQ_HS + 16 * kq;
        bf16x8 qf[4][2];
#pragma unroll
        for (int rb = 0; rb < 4; ++rb)
#pragma unroll
            for (int ks = 0; ks < 2; ++ks) qf[rb][ks] = *(const LAS bf16x8*)(qlb + 4 * rb * P3_AQ_RS + 64 * ks);
        f32x4 o[4][4];
#pragma unroll
        for (int dt = 0; dt < 4; ++dt)
#pragma unroll
            for (int rb = 0; rb < 4; ++rb) o[dt][rb] = (f32x4){0.f, 0.f, 0.f, 0.f};
        float mref[4], lsum[4]; f32x4 negm[4];
#pragma unroll
        for (int rb = 0; rb < 4; ++rb) { mref[rb] = 0.f; lsum[rb] = 0.f; negm[rb] = (f32x4){0.f, 0.f, 0.f, 0.f}; }
        const int ntw = (nkt32 - kq4 + 3) >> 2;
        LAS unsigned char* vst = F.lds + P3_VW + w * (3 * P3_VWB);
        bf16x8 kf[2][2];
        const bf16* kgp = KB + (mb + j) * 128 + g * 64 + 8 * kq;
        const bf16* vgp = VB + (mb + (l4_ >> 3)) * 128 + g * 64 + (l4_ & 7) * 8;
#define P4_LOADK(dst, kt_) do { _Pragma("unroll") for (int c_ = 0; c_ < 2; ++c_) _Pragma("unroll") for (int ks_ = 0; ks_ < 2; ++ks_) dst[c_][ks_] = *(const bf16x8*)(kgp + (size_t)(32 * (kt_) + 16 * c_) * 128 + 32 * ks_); } while (0)
        const unsigned vst_u = (unsigned)(size_t)vst;
#define P4_DMAV(kt_, buf_) do { _Pragma("unroll") for (int i_ = 0; i_ < 4; ++i_) { unsigned keep_; const void* gs_ = (const void*)(vgp + (size_t)(32 * (kt_) + 8 * i_) * 128); \
        const unsigned ld_ = (unsigned)__builtin_amdgcn_readfirstlane((int)(vst_u + (buf_) * P3_VWB + i_ * 1024)); \
        asm volatile("s_mov_b32 %0, m0\n\ts_mov_b32 m0, %2\n\ts_nop 0\n\tglobal_load_lds_dwordx4 %1, off\n\ts_mov_b32 m0, %0" : "=&s"(keep_) : "v"(gs_), "s"(ld_) : "memory"); } } while (0)
        if (ntw > 0) {
#pragma unroll
            for (int c = 0; c < 2; ++c) { kf[c][0] = kf0[c][0]; kf[c][1] = kf0[c][1]; }
#pragma unroll
            for (int i = 0; i < 4; ++i) *(LAS v4u*)(vst + i * 1024 + l4_ * 16) = vr0[i]; }
        if (ntw > 1) { P4_DMAV(kq4 + 4, 1); }
        int vb_cur = 0;
#if TEST_MODE == 5
        unsigned long long tacc_[5] = {0, 0, 0, 0, 0}; unsigned long long tprev_ = __builtin_amdgcn_s_memtime();
#define TSEC(i) do { __builtin_amdgcn_sched_barrier(0); const unsigned long long tn_ = __builtin_amdgcn_s_memtime(); tacc_[i] += tn_ - tprev_; tprev_ = tn_; __builtin_amdgcn_sched_barrier(0); } while (0)
#else
#define TSEC(i) do { } while (0)
#endif
        for (int ti = 0; ti < ntw; ++ti) {
            const int kt = kq4 + 4 * ti;
            TSEC(4);
            asm volatile("s_waitcnt vmcnt(0)" ::: "memory");
            const int vb_n2 = vb_cur == 0 ? 2 : vb_cur - 1;
            if (ti + 2 < ntw) { P4_DMAV(kt + 8, vb_n2); }
            TSEC(0);
            f32x4 sa[2][4];
#pragma unroll
            for (int c = 0; c < 2; ++c)
#pragma unroll
                for (int ks = 0; ks < 2; ++ks)
#pragma unroll
                    for (int rb = 0; rb < 4; ++rb) sa[c][rb] = __builtin_amdgcn_mfma_f32_16x16x32_bf16(kf[c][ks], qf[rb][ks], ks == 0 ? negm[rb] : sa[c][rb], 0, 0, 0);
            if (ti + 1 < ntw) { P4_LOADK(kf, kt + 4); }
            TSEC(1);
            float tmax[4];
#pragma unroll
            for (int rb = 0; rb < 4; ++rb) { const int wd = (int)(bm[(4 * rb + (j >> 2)) * 64 + kt] >> (4 * kq)); float tm = -INFINITY;
#pragma unroll
                for (int c = 0; c < 2; ++c)
#pragma unroll
                    for (int e = 0; e < 4; ++e) { const unsigned keep = (unsigned)__builtin_amdgcn_sbfe(wd, 16 * c + e, 1);
                        const float v = __uint_as_float((__float_as_uint(sa[c][rb][e]) & keep) | (0xff800000u & ~keep)); sa[c][rb][e] = v; tm = fmaxf(tm, v); }
                tmax[rb] = tm; }
#pragma unroll
            for (int rb = 0; rb < 4; ++rb) tmax[rb] = kq_max(tmax[rb]);
            if (ti == 0 || __any(tmax[0] > 0.f || tmax[1] > 0.f || tmax[2] > 0.f || tmax[3] > 0.f)) {
#pragma unroll
                for (int rb = 0; rb < 4; ++rb) { const float dl = (ti == 0) ? ((tmax[rb] == -INFINITY) ? 0.f : tmax[rb]) : fmaxf(tmax[rb], 0.f); const float alpha = __builtin_amdgcn_exp2f(-dl); mref[rb] += dl; lsum[rb] *= alpha;
                    negm[rb] = (f32x4){-mref[rb], -mref[rb], -mref[rb], -mref[rb]};
#pragma unroll
                    for (int c = 0; c < 2; ++c) sa[c][rb] -= dl;
#pragma unroll
                    for (int dt = 0; dt < 4; ++dt) o[dt][rb] *= alpha; } }
            bf16x8 pf[4];
#pragma unroll
            for (int rb = 0; rb < 4; ++rb) { float ps = 0.f;
#pragma unroll
                for (int c = 0; c < 2; ++c)
#pragma unroll
                    for (int e = 0; e < 4; ++e) { const float p = __builtin_amdgcn_exp2f(sa[c][rb][e]); sa[c][rb][e] = p; ps += p; }
                lsum[rb] += ps;
                v4u pw; pw.x = pk2(sa[0][rb][0], sa[0][rb][1]); pw.y = pk2(sa[0][rb][2], sa[0][rb][3]); pw.z = pk2(sa[1][rb][0], sa[1][rb][1]); pw.w = pk2(sa[1][rb][2], sa[1][rb][3]);
                pf[rb] = __builtin_bit_cast(bf16x8, pw); }
            TSEC(2);
            { const LAS unsigned char* vb = vst + vb_cur * P3_VWB + (4 * kq + (j >> 2)) * 128 + (4 * (j & 3)) * 2;
              typedef short v4i16_t __attribute__((ext_vector_type(4)));
#pragma unroll
              for (int dt = 0; dt < 4; ++dt) {
                  const v4i16_t lo4 = __builtin_amdgcn_ds_read_tr16_b64_v4i16((LAS v4i16_t*)(vb + 32 * dt));
                  const v4i16_t hi4 = __builtin_amdgcn_ds_read_tr16_b64_v4i16((LAS v4i16_t*)(vb + 32 * dt + 16 * 128));
                  const bf16x8 vf = (bf16x8){lo4[0], lo4[1], lo4[2], lo4[3], hi4[0], hi4[1], hi4[2], hi4[3]};
#pragma unroll
                  for (int rb = 0; rb < 4; ++rb) o[dt][rb] = __builtin_amdgcn_mfma_f32_16x16x32_bf16(vf, pf[rb], o[dt][rb], 0, 0, 0); } }
            TSEC(3);
            vb_cur = vb_cur == 2 ? 0 : vb_cur + 1;
        }
#undef P4_LOADK
#if TEST_MODE == 5
        if (blockIdx.x == STAMP_BLK && threadIdx.x == 0) { unsigned* st_ = (unsigned*)(F.ws + WS_CTL + 900 * 1024); for (int i_ = 0; i_ < 5; ++i_) atomicAdd(st_ + 8 + i_, (unsigned)(tacc_[i_] >> 4)); atomicAdd(st_ + 13, (unsigned)ntw); }
#endif
#undef TSEC
#undef P4_DMAV
#pragma unroll
        for (int rb = 0; rb < 4; ++rb) lsum[rb] = kq_sum(lsum[rb]);
        if (has_next && rep4_ == REP_S4 - 1) p3_prefetch(F, nb, nqt, pre);
        const size_t mrow_m = mb + t0 + 4 * kq4 + (j >> 2); const int hd_m = 4 * g + (j & 3);
        v2u gvm[4];
#pragma unroll
        for (int dt = 0; dt < 4; ++dt) gvm[dt] = *(const v2u*)((const bf16*)(F.ws + WS_GA) + mrow_m * 512 + hd_m * 64 + 16 * dt + 4 * kq);
        __syncthreads();
        {
            LAS unsigned char* xo = F.lds + ((g * 4 + kq4) * 4) * 4096; LAS float* xm = (LAS float*)(F.lds + P3_XM) + ((g * 4 + kq4) * 4) * 32;
#pragma unroll
            for (int rb = 0; rb < 4; ++rb) {
#pragma unroll
                for (int dt = 0; dt < 4; ++dt) *(LAS f32x4*)(xo + rb * 4096 + dt * 1024 + l4_ * 16) = o[dt][rb];
                if (kq == 0) { xm[rb * 32 + j] = (lsum[rb] > 0.f) ? mref[rb] : -INFINITY; xm[rb * 32 + 16 + j] = lsum[rb]; } }
        }
        __syncthreads();
        {
            const int rb = kq4; float ms[4], ls[4]; float M = -INFINITY;
#pragma unroll
            for (int s4 = 0; s4 < 4; ++s4) { const LAS float* xm = (const LAS float*)(F.lds + P3_XM) + ((g * 4 + s4) * 4 + rb) * 32; ms[s4] = xm[j]; ls[s4] = xm[16 + j]; M = fmaxf(M, ms[s4]); }
            float Lt = 0.f; f32x4 oo[4];
#pragma unroll
            for (int dt = 0; dt < 4; ++dt) oo[dt] = (f32x4){0.f, 0.f, 0.f, 0.f};
#pragma unroll
            for (int s4 = 0; s4 < 4; ++s4) { const float sc = __builtin_amdgcn_exp2f(ms[s4] - M); Lt += ls[s4] * sc;
                const LAS unsigned char* xo = F.lds + (((g * 4 + s4) * 4) + rb) * 4096;
#pragma unroll
                for (int dt = 0; dt < 4; ++dt) oo[dt] += *(const LAS f32x4*)(xo + dt * 1024 + l4_ * 16) * sc; }
            const float inv = 1.0f / Lt;
            const size_t mrow = mrow_m; const int hd = hd_m;
            bf16* MIX = (bf16*)(F.ws + WS_MIX);
#pragma unroll
            for (int dt = 0; dt < 4; ++dt) { const int d = 16 * dt + 4 * kq; const v2u gv = gvm[dt];
                const float g0 = bf2f((unsigned short)(gv.x & 0xffffu)), g1 = bf2f((unsigned short)(gv.x >> 16)), g2 = bf2f((unsigned short)(gv.y & 0xffffu)), g3 = bf2f((unsigned short)(gv.y >> 16));
                v2u ov; ov.x = pk2(oo[dt][0] * inv * g0, oo[dt][1] * inv * g1); ov.y = pk2(oo[dt][2] * inv * g2, oo[dt][3] * inv * g3);
                *(v2u*)(MIX + mrow * 1024 + hd * 64 + d) = ov; }
        }
        if (REP_S4 > 1) __syncthreads();
    }
}

constexpr int PL_U = 0, PL_W = 40960, PL_STRIDE = 272;
template <bool SAMPLE> __device__ __forceinline__ void p3_pool_item(Frame& F, int item) {
    const int tid = F.tid, lane = F.lane, w = F.wave, j = lane & 15, kq = lane >> 4;
    const bf16* U = (const bf16*)(F.ws + WS_U); const bf16* GP = (const bf16*)(F.ws + WS_GP); const bf16* WPT = (const bf16*)(F.ws + WS_WPOOLT); bf16* MIX = (bf16*)(F.ws + WS_MIX);
    const int tokb = SAMPLE ? 0 : (item & 15) * 128;
    const size_t m0 = SAMPLE ? (size_t)MP : (size_t)(item >> 4) * SEQ + tokb;
    const int tl = 16 * w + j;
    const size_t mrow = m0 + tl;
    v4u wr_[4], ur_[5];
#define PL_LOAD(gg) do { _Pragma("unroll") for (int k_ = 0; k_ < 4; ++k_) { const int i_ = tid + 512 * k_; wr_[k_] = *(const v4u*)(WPT + (size_t)(gg) * 16384 + (i_ >> 4) * 128 + (i_ & 15) * 8); } \
        if (!SAMPLE) { _Pragma("unroll") for (int k_ = 0; k_ < 5; ++k_) { const int i_ = tid + 512 * k_; const int row_ = i_ >> 4, ch_ = i_ & 15; ur_[k_] = (v4u){0u, 0u, 0u, 0u}; \
            if (i_ < 143 * 16 && tokb - 15 + row_ >= 0) ur_[k_] = *(const v4u*)(U + (m0 - 15 + row_) * 512 + (gg) * 128 + ch_ * 8); } } } while (0)
#define PL_STORE() do { _Pragma("unroll") for (int k_ = 0; k_ < 4; ++k_) { const int i_ = tid + 512 * k_; *(LAS v4u*)(F.lds + PL_W + (i_ >> 4) * PL_STRIDE + (i_ & 15) * 16) = wr_[k_]; } \
        if (!SAMPLE) { _Pragma("unroll") for (int k_ = 0; k_ < 5; ++k_) { const int i_ = tid + 512 * k_; if (i_ < 143 * 16) *(LAS v4u*)(F.lds + PL_U + (i_ >> 4) * PL_STRIDE + (i_ & 15) * 16) = ur_[k_]; } } } while (0)
    PL_LOAD(0);
#pragma unroll
    for (int g = 0; g < 4; ++g) {
        const int win = 2 << g;
        PL_STORE();
        __syncthreads();
        if (g + 1 < 4) PL_LOAD(g + 1);
        bf16x8 df[4];
#pragma unroll
        for (int ks = 0; ks < 4; ++ks) {
            float sum[8], cur[8];
            if (!SAMPLE) {
                const LAS unsigned char* up = F.lds + PL_U + (15 + tl) * PL_STRIDE + (4 * ks + kq) * 16;
                { const v4u c = *(const LAS v4u*)up;
#pragma unroll
                  for (int u = 0; u < 4; ++u) { const unsigned x = c[u]; cur[2 * u] = bf2f((unsigned short)(x & 0xffffu)); cur[2 * u + 1] = bf2f((unsigned short)(x >> 16)); sum[2 * u] = cur[2 * u]; sum[2 * u + 1] = cur[2 * u + 1]; } }
#pragma unroll
                for (int i = 1; i < win; ++i) { const v4u c = *(const LAS v4u*)(up - i * PL_STRIDE);
#pragma unroll
                    for (int u = 0; u < 4; ++u) { const unsigned x = c[u]; sum[2 * u] += bf2f((unsigned short)(x & 0xffffu)); sum[2 * u + 1] += bf2f((unsigned short)(x >> 16)); } }
            } else {
                const int c0 = g * 128 + 32 * ks + 8 * kq;
                { const v4u c = *(const v4u*)(U + mrow * 512 + c0);
#pragma unroll
                  for (int u = 0; u < 4; ++u) { const unsigned x = c[u]; cur[2 * u] = bf2f((unsigned short)(x & 0xffffu)); cur[2 * u + 1] = bf2f((unsigned short)(x >> 16)); sum[2 * u] = cur[2 * u]; sum[2 * u + 1] = cur[2 * u + 1]; } }
#pragma unroll
                for (int i = 1; i < win; ++i) { const float* sp = F.state_pool + ((size_t)tl * 15 + (15 - i)) * 512 + c0; const f32x4 a = *(const f32x4*)sp, bq = *(const f32x4*)(sp + 4);
                    sum[0] += a[0]; sum[1] += a[1]; sum[2] += a[2]; sum[3] += a[3]; sum[4] += bq[0]; sum[5] += bq[1]; sum[6] += bq[2]; sum[7] += bq[3]; }
            }
            const int tpos = tokb + tl; const float rc = 1.0f / (float)(SAMPLE ? win : ((tpos + 1 < win) ? tpos + 1 : win));
            v4u pw; pw.x = pk2(sum[0] * rc - cur[0], sum[1] * rc - cur[1]); pw.y = pk2(sum[2] * rc - cur[2], sum[3] * rc - cur[3]);
            pw.z = pk2(sum[4] * rc - cur[4], sum[5] * rc - cur[5]); pw.w = pk2(sum[6] * rc - cur[6], sum[7] * rc - cur[7]);
            df[ks] = __builtin_bit_cast(bf16x8, pw);
        }
#pragma unroll
        for (int jt = 0; jt < 8; ++jt) {
            f32x4 acc = (f32x4){0.f, 0.f, 0.f, 0.f};
#pragma unroll
            for (int ks = 0; ks < 4; ++ks) { const bf16x8 wf = *(const LAS bf16x8*)(F.lds + PL_W + (16 * jt + j) * PL_STRIDE + (4 * ks + kq) * 16);
                acc = __builtin_amdgcn_mfma_f32_16x16x32_bf16(wf, df[ks], acc, 0, 0, 0); }
            const int col = g * 128 + 16 * jt + 4 * kq;
            const f32x4 ps = *(const f32x4*)(F.pool_scale + col); const v2u gv = *(const v2u*)(GP + mrow * 512 + col);
            const float g0 = bf2f((unsigned short)(gv.x & 0xffffu)), g1 = bf2f((unsigned short)(gv.x >> 16)), g2 = bf2f((unsigned short)(gv.y & 0xffffu)), g3 = bf2f((unsigned short)(gv.y >> 16));
            v2u ov; ov.x = pk2(acc[0] * ps[0] * g0, acc[1] * ps[1] * g1); ov.y = pk2(acc[2] * ps[2] * g2, acc[3] * ps[3] * g3);
            *(v2u*)(MIX + mrow * 1024 + 512 + col) = ov;
        }
        __syncthreads();
    }
#undef PL_LOAD
#undef PL_STORE
}

constexpr int SM_SC = 0, SM_SEL = 8448, SM_Q = 9472, SM_P = 11520, SM_RED = 19712, SM_PT = 36096;
__device__ __forceinline__ void p3_sample_item(Frame& F, int s) {
    const int tid = F.tid, lane = F.lane, w = F.wave, r = lane & 31, hh = lane >> 5;
    const size_t m = (size_t)MP + s;
    LAS float* sc = (LAS float*)(F.lds + SM_SC); LAS int* sel = (LAS int*)(F.lds + SM_SEL); LAS float* ql = (LAS float*)(F.lds + SM_Q);
    LAS float* pl = (LAS float*)(F.lds + SM_P); LAS float* red = (LAS float*)(F.lds + SM_RED); LAS int* ptl = (LAS int*)(F.lds + SM_PT);
    const bf16* QI = (const bf16*)(F.ws + WS_QI) + m * 512; const float* WIp = (const float*)(F.ws + WS_WI) + m * 8;
    const int* pt = F.page_table + s * NPG;
    ql[tid] = bf2f(((const bf16*)(F.ws + WS_Q))[m * 512 + tid]);
    if (tid < NPG) ptl[tid] = pt[tid];
    {
        bf16x8 af[4];
#pragma unroll
        for (int ks = 0; ks < 4; ++ks) { af[ks] = (bf16x8){0, 0, 0, 0, 0, 0, 0, 0}; if (r < 8) af[ks] = *(const bf16x8*)(QI + r * 64 + 16 * ks + 8 * hh); }
        float wv[4];
#pragma unroll
        for (int e = 0; e < 4; ++e) wv[e] = WIp[4 * hh + e];
        int pg[8];
#pragma unroll
        for (int it = 0; it < 8; ++it) pg[it] = pt[(w + 8 * it) >> 2];
#pragma unroll
        for (int hf = 0; hf < 2; ++hf) {
            f32x4 x0[4][4], x1[4][4];
#pragma unroll
            for (int i4 = 0; i4 < 4; ++i4) { const int kt = w + 8 * (4 * hf + i4);
                const float* kp = F.cache_kidx + ((size_t)pg[4 * hf + i4] * PAGE + (kt & 3) * 32 + r) * 64 + 8 * hh;
#pragma unroll
                for (int ks = 0; ks < 4; ++ks) { x0[i4][ks] = *(const f32x4*)(kp + 16 * ks); x1[i4][ks] = *(const f32x4*)(kp + 16 * ks + 4); } }
#pragma unroll
            for (int i4 = 0; i4 < 4; ++i4) { const int kt = w + 8 * (4 * hf + i4);
                f32x16 acc;
#pragma unroll
                for (int e = 0; e < 16; ++e) acc[e] = 0.f;
#pragma unroll
                for (int ks = 0; ks < 4; ++ks) {
                    v4u pw; pw.x = pk2(x0[i4][ks][0], x0[i4][ks][1]); pw.y = pk2(x0[i4][ks][2], x0[i4][ks][3]); pw.z = pk2(x1[i4][ks][0], x1[i4][ks][1]); pw.w = pk2(x1[i4][ks][2], x1[i4][ks][3]);
                    acc = __builtin_amdgcn_mfma_f32_32x32x16_bf16(af[ks], __builtin_bit_cast(bf16x8, pw), acc, 0, 0, 0); }
                float part = wv[0] * fmaxf(acc[0], 0.f) + wv[1] * fmaxf(acc[1], 0.f) + wv[2] * fmaxf(acc[2], 0.f) + wv[3] * fmaxf(acc[3], 0.f);
                part += __shfl_xor(part, 32);
                if (hh == 0) sc[32 * kt + r] = part; }
        }
        if (w == 0) {
            const float kv = bf2f(((const bf16*)(F.ws + WS_KI))[m * 64 + lane]); float tot = 0.f;
#pragma unroll
            for (int h = 0; h < 8; ++h) { const float d = wave_sum(bf2f(QI[h * 64 + lane]) * kv); tot += WIp[h] * fmaxf(d, 0.f); }
            if (lane == 0) sc[PAST] = tot;
        }
    }
    __syncthreads();
    if (w == 0) {
        unsigned x[32];
#pragma unroll
        for (int jj = 0; jj < 32; ++jj) x[jj] = f2key(sc[64 * jj + lane]);
        const unsigned ke = (unsigned)__builtin_amdgcn_readfirstlane((int)f2key(sc[PAST]));
#pragma unroll
        for (int st = 0; st < 5; ++st) { const int j = 16 >> st; const unsigned mk = st == 0 ? 0x0000ffffu : st == 1 ? 0x00ff00ffu : st == 2 ? 0x0f0f0f0fu : st == 3 ? 0x33333333u : 0x55555555u;
#pragma unroll
            for (int k = 0; k < 32; ++k) if (!(k & j)) { const unsigned t_ = ((x[k] >> j) ^ x[k + j]) & mk; x[k] ^= t_ << j; x[k + j] ^= t_; } }
        unsigned cur = 0xffffffffu, gt = 0u; int ab = 0; bool ecur = true, egt = false;
#pragma unroll
        for (int b = 31; b >= 0; --b) { const unsigned c0 = cur & x[b]; const bool eb = ecur && ((ke >> b) & 1u);
            const int n = (int)wave_reduce_add_u((unsigned)__popc(c0)) + (eb ? 1 : 0);
            if (ab + n >= 256) { cur = c0; ecur = eb; } else { ab += n; gt |= c0; egt = egt || eb; cur &= ~x[b]; ecur = ecur && !eb; } }
        const int neq = (int)wave_reduce_add_u((unsigned)__popc(cur)); int need = 256 - ab;
        const bool take_e = egt || (ecur && need > neq);
        const unsigned long long lt = (1ull << lane) - 1ull;
        unsigned selm = gt;
        if (neq <= need) selm |= cur;
        else {
            for (int jj = 0; jj < 32; ++jj) { const unsigned long long meq = __ballot((cur >> jj) & 1u);
                if (((cur >> jj) & 1u) && __popcll(meq & lt) < need) selm |= 1u << jj;
                const int pc_ = __popcll(meq); need = need > pc_ ? need - pc_ : 0; } }
        int pos = 0;
#pragma unroll
        for (int jj = 0; jj < 32; ++jj) { const bool take = (selm >> jj) & 1u; const unsigned long long mt = __ballot(take);
            if (take) sel[pos + __popcll(mt & lt)] = ptl[jj >> 1] * PAGE + ((64 * jj + lane) & 127);
            pos += __popcll(mt); }
        if (take_e && lane == 0) sel[pos] = -1;
    }
    __syncthreads();
    {
        const int c4 = 4 * (lane & 31), g = (lane >> 4) & 1, rp = lane >> 5;
        f32x4 kv[16], vv[16];
#pragma unroll
        for (int i = 0; i < 16; ++i) { const int pr = sel[32 * w + 2 * i + rp];
            const float* krow = pr >= 0 ? F.cache_k + (size_t)pr * 128 : F.out + O_KS + (size_t)s * 128; kv[i] = *(const f32x4*)(krow + c4); }
#pragma unroll
        for (int i = 0; i < 16; ++i) { const int pr = sel[32 * w + 2 * i + rp];
            const float* vrow = pr >= 0 ? F.cache_v + (size_t)pr * 128 : F.out + O_VS + (size_t)s * 128; vv[i] = *(const f32x4*)(vrow + c4); }
        f32x4 qv[4];
#pragma unroll
        for (int rr = 0; rr < 4; ++rr) qv[rr] = *(const LAS f32x4*)(ql + (4 * g + rr) * 64 + 4 * (lane & 15));
#pragma unroll
        for (int i = 0; i < 16; ++i) {
#pragma unroll
            for (int rr = 0; rr < 4; ++rr) { float p = (qv[rr][0] * kv[i][0] + qv[rr][1] * kv[i][1]) + (qv[rr][2] * kv[i][2] + qv[rr][3] * kv[i][3]);
                p = row16_sum(p);
                if ((lane & 15) == 0) pl[(4 * g + rr) * 256 + 32 * w + 2 * i + rp] = p; } }
        __syncthreads();
        {
            float v[4]; float mx = -INFINITY;
#pragma unroll
            for (int i = 0; i < 4; ++i) { v[i] = pl[w * 256 + lane + 64 * i]; mx = fmaxf(mx, v[i]); }
            mx = wave_max(mx); float sm = 0.f;
#pragma unroll
            for (int i = 0; i < 4; ++i) { v[i] = __builtin_amdgcn_exp2f(v[i] - mx); sm += v[i]; }
            sm = wave_sum(sm); const float inv = 1.0f / sm;
#pragma unroll
            for (int i = 0; i < 4; ++i) pl[w * 256 + lane + 64 * i] = v[i] * inv;
        }
        __syncthreads();
        f32x4 acc[4];
#pragma unroll
        for (int rr = 0; rr < 4; ++rr) acc[rr] = (f32x4){0.f, 0.f, 0.f, 0.f};
#pragma unroll
        for (int i = 0; i < 16; ++i) {
#pragma unroll
            for (int rr = 0; rr < 4; ++rr) { const float p = pl[(4 * g + rr) * 256 + 32 * w + 2 * i + rp];
                acc[rr][0] += p * vv[i][0]; acc[rr][1] += p * vv[i][1]; acc[rr][2] += p * vv[i][2]; acc[rr][3] += p * vv[i][3]; } }
#pragma unroll
        for (int rr = 0; rr < 4; ++rr) {
#pragma unroll
            for (int c = 0; c < 4; ++c) acc[rr][c] += __shfl_xor(acc[rr][c], 32);
            if (rp == 0) *(LAS f32x4*)(red + ((w * 8 + 4 * g + rr) * 64) + 4 * (lane & 15)) = acc[rr]; }
    }
    __syncthreads();
    { const int h = tid >> 6, d = tid & 63; float a = 0.f;
#pragma unroll
        for (int k8 = 0; k8 < 8; ++k8) a += red[(k8 * 8 + h) * 64 + d];
        const float gate = bf2f(((const bf16*)(F.ws + WS_GA))[m * 512 + tid]);
        ((bf16*)(F.ws + WS_MIX))[m * 1024 + tid] = (bf16)f2bf(a * gate); }
    { const int c = tid, g = c >> 7, win = 2 << g; const float un = bf2f(((const bf16*)(F.ws + WS_U))[m * 512 + c]); float sum = un;
      const float* sp = F.state_pool + (size_t)s * 15 * 512 + c;
      float hv[15];
#pragma unroll
      for (int i = 1; i < 16; ++i) hv[i - 1] = sp[(size_t)(15 - i) * 512];
#pragma unroll
      for (int i = 1; i < 16; ++i) sum += (i < win) ? hv[i - 1] : 0.f;
      ql[c] = bf2f((unsigned short)f2bf(sum / (float)win - un)); }
    __syncthreads();
    { const int col = tid, g = col >> 7, j = col & 127; const bf16* wr = (const bf16*)(F.ws + WS_WPOOLT) + (size_t)g * 16384 + j * 128;
      v4u wv4[16];
#pragma unroll
      for (int i = 0; i < 16; ++i) wv4[i] = *(const v4u*)(wr + 8 * i);
      float acc = 0.f;
#pragma unroll
      for (int i = 0; i < 16; ++i) { const LAS f32x4* dp = (const LAS f32x4*)(ql + g * 128 + 8 * i); const f32x4 d0 = dp[0], d1 = dp[1];
          acc += d0[0] * bf2f((unsigned short)(wv4[i].x & 0xffffu)) + d0[1] * bf2f((unsigned short)(wv4[i].x >> 16)) + d0[2] * bf2f((unsigned short)(wv4[i].y & 0xffffu)) + d0[3] * bf2f((unsigned short)(wv4[i].y >> 16));
          acc += d1[0] * bf2f((unsigned short)(wv4[i].z & 0xffffu)) + d1[1] * bf2f((unsigned short)(wv4[i].z >> 16)) + d1[2] * bf2f((unsigned short)(wv4[i].w & 0xffffu)) + d1[3] * bf2f((unsigned short)(wv4[i].w >> 16)); }
      const float gp = bf2f(((const bf16*)(F.ws + WS_GP))[m * 512 + col]);
      ((bf16*)(F.ws + WS_MIX))[m * 1024 + 512 + col] = (bf16)f2bf(acc * F.pool_scale[col] * gp); }
    __syncthreads();
}

__device__ __forceinline__ void p3_mixer(Frame& F) {
    P3Pre pre; int cb, cqt; bool cv;
#define P3_ITEM(i_, ok_, b_, qt_) do { if (F.G == 256) { ok_ = (i_) < 4; \
            const int idx_ = F.bid >> 3, i2_ = idx_ & 15, pi_ = i2_ + 16 * (((i_) >> 1) & 1), grp_ = pi_ >> 4, k_ = pi_ & 15; const bool light_ = idx_ < 16; \
            const int x1_ = (k_ & 7) + 16 * (k_ >> 3) + (light_ ? 0 : 8), sm_ = grp_ ? 32 + x1_ : (light_ ? k_ : 16 + k_), sum_ = grp_ ? (light_ ? 119 : 135) : (light_ ? 111 : 143); \
            b_ = F.bid & 7; qt_ = ((i_) & 1) ? sm_ : sum_ - sm_; } \
        else { const int p_ = F.bid + ((i_) >> 1) * F.G; ok_ = p_ < 512; b_ = (p_ >> 6) & 7; qt_ = ((i_) & 1) ? (p_ & 63) : 127 - (p_ & 63); } } while (0)
    P3_ITEM(0, cv, cb, cqt);
    if (cv) p3_prefetch(F, cb, cqt, pre);
#pragma unroll 1
    for (int i = 0; cv; ++i) {
        int nb, nqt; bool nv;
        P3_ITEM(i + 1, nv, nb, nqt);
        p3_prompt_item(F, cb, cqt, pre, nv, nb, nqt); __syncthreads(); FSTAMP();
        cv = nv; cb = nb; cqt = nqt;
    }
#undef P3_ITEM
    for (int x = F.bid; x < 128; x += F.G) { for (int rp_ = 0; rp_ < REP_SMP; ++rp_) { p3_sample_item(F, x); __syncthreads(); } FSTAMP(); }
    for (int x = F.bid + ((F.bid < 128) ? ((128 - F.bid + F.G - 1) / F.G) * F.G : 0); x < 256; x += F.G) { for (int rp_ = 0; rp_ < REP_POOL; ++rp_) { p3_pool_item<false>(F, x - 128); __syncthreads(); } FSTAMP(); }
}
struct P4SPre { bf16x8 fb[32]; };
__device__ __forceinline__ void p4_sample_prefetch(Frame& F, P4SPre& pre) {
    if (F.bid >= 64) return;
    const int rl = F.lane & 15, kq = F.lane >> 4, n0 = F.bid * 16;
    const bf16* bp = (const bf16*)(F.ws + WS_WOUTT) + (size_t)(n0 + rl) * 1024 + 8 * kq;
#pragma unroll
    for (int i = 0; i < 32; ++i) pre.fb[i] = *(const bf16x8*)(bp + 32 * i);
}
__device__ __forceinline__ void p4_sample_out(Frame& F, P4SPre& pre) {
    if (F.bid >= 64) return;
    const int lane = F.lane, w = F.wave, rl = lane & 15, kq = lane >> 4, n0 = F.bid * 16;
    const bf16* ap = (const bf16*)(F.ws + WS_MIX) + (size_t)(MP + 16 * w + rl) * 1024 + 8 * kq;
    const float* ada = (const float*)(F.ws + WS_ADA);
    float xv[4], gv[4];
#pragma unroll
    for (int e = 0; e < 4; ++e) { const int s = 16 * w + 4 * kq + e, n = n0 + rl; xv[e] = F.xs[(size_t)s * 1024 + n]; gv[e] = ada[(size_t)(NB + s) * 3072 + 2048 + n]; }
    f32x4 acc = (f32x4){0.f, 0.f, 0.f, 0.f};
    bf16x8 fa[32];
#pragma unroll
    for (int i = 0; i < 32; ++i) fa[i] = *(const bf16x8*)(ap + 32 * i);
#pragma unroll
    for (int i = 0; i < 32; ++i) acc = __builtin_amdgcn_mfma_f32_16x16x32_bf16(fa[i], pre.fb[i], acc, 0, 0, 0);
#pragma unroll
    for (int e = 0; e < 4; ++e) { const int s = 16 * w + 4 * kq + e, n = n0 + rl; F.out[O_YS + (size_t)s * 1024 + n] = xv[e] + gv[e] * acc[e]; }
}

struct Args { const float* in[18]; float* out; unsigned char* ws; int ph_lo, ph_hi, li, pad; };
__global__ void __launch_bounds__(NWAVES * 64, 2) mk_fwd(Args args) {
    extern __shared__ __attribute__((aligned(16))) unsigned char lds[];
    Frame F;
    F.lds = (LAS unsigned char*)lds;
    F.MISC = (volatile LAS unsigned*)(F.lds + MISC_OFF);
    F.tid = threadIdx.x; F.lane = F.tid & 63; F.wave = __builtin_amdgcn_readfirstlane(F.tid >> 6);
    F.G = gridDim.x; F.bid = blockIdx.x; { const int bx = blockIdx.x; F.vcu = (F.G % 8 == 0) ? (bx % 8) * (F.G / 8) + bx / 8 : bx; }
    F.ws = args.ws; F.out = args.out; F.ctl = (gu32*)(args.ws + WS_CTL);
    F.xp = args.in[0]; F.xs = args.in[1]; F.cache_k = args.in[2]; F.cache_v = args.in[3]; F.cache_kidx = args.in[4]; F.state_pool = args.in[5];
    F.page_table = (const int*)args.in[6]; F.cp = args.in[7]; F.cs = args.in[8]; F.norm_w = args.in[9]; F.w_ada = args.in[10]; F.b_ada = args.in[11];
    F.w_in = args.in[12]; F.qnw = args.in[13]; F.knw = args.in[14]; F.w_pool = args.in[15]; F.pool_scale = args.in[16]; F.w_out = args.in[17];
    for (int u = F.tid; u < (LDS_BYTES - LDSCTL_OFF) / 4; u += NWAVES * 64) ((LAS unsigned*)(F.lds + LDSCTL_OFF))[u] = 0u;
    __syncthreads();
    XcdBarrier bar = xcd_barrier_post((unsigned*)(F.ctl + CW_BAR) + args.li * XCD_BAR_WORDS, F.MISC + 8);
    const int lo = args.ph_lo, hi = args.ph_hi;
#if TEST_MODE == 4
    unsigned long long* ts = (unsigned long long*)(args.ws + WS_CTL + 768 * 1024); int nst = 0;
#define STAMP() do { if (blockIdx.x == STAMP_BLK && threadIdx.x == 0) ts[nst] = __builtin_amdgcn_s_memrealtime(); ++nst; } while (0)
#if P3FINE
    F.ts = ts + 16; F.nst = 0;
#endif
#else
#define STAMP() do { } while (0)
#endif
    STAMP();
#define IN(k) (lo <= (k) && (k) < hi)
#define BOTH(k) (IN(k) && IN((k) + 1))
    P1Pre p1pre;
    if (IN(0)) { for (int rp_ = 0; rp_ < REP_P0; ++rp_) { p0_prologue(F); if (rp_ + 1 < REP_P0) __syncthreads(); } STAMP(); if (IN(1)) p1_prefetch(F, p1pre); if (BOTH(0)) xcd_barrier(bar); STAMP(); }
    else if (IN(1)) p1_prefetch(F, p1pre);
    if (IN(1)) { for (int rp_ = 0; rp_ < REP_P1; ++rp_) p1_norm(F, p1pre); STAMP(); if (BOTH(1)) xcd_barrier(bar); STAMP(); }
    if (IN(2)) {
        for (int rp_ = 0; rp_ < REP_P2S; ++rp_) p2_sample(F);
        pg8::Gemm g{(const pg8::bf16_t*)(F.ws + WS_HB), (const pg8::bf16_t*)(F.ws + WS_WINT), MP, 3072, DM};
        pg8::StaticOrder S; S.init(MP, 3072, F.G, (int)blockIdx.x);
        pg8::EpiIn E{F.ws, F.out, F.qnw, F.knw};
        for (int rp_ = 0; rp_ < REP_P2G; ++rp_) pg8::gemm_phase<pg8::EpiIn, pg8::StaticOrder, true, true>(F.lds + RING_OFF, g, S, E);
        STAMP(); if (BOTH(2)) xcd_barrier(bar); STAMP();
    }
#if HAVE_P3
    P4SPre p4pre;
    if (IN(3)) { p3_mixer(F);
#if TEST_MODE == 6
        if (threadIdx.x == 0) ((unsigned long long*)(F.ws + WS_CTL + 800 * 1024))[blockIdx.x] = __builtin_amdgcn_s_memrealtime();
#endif
        STAMP(); if (IN(4)) p4_sample_prefetch(F, p4pre); if (BOTH(3)) xcd_barrier(bar); STAMP(); }
    else if (IN(4)) p4_sample_prefetch(F, p4pre);
#endif
    if (IN(4)) {
        for (int rp_ = 0; rp_ < REP_P4S; ++rp_) p4_sample_out(F, p4pre);
        pg8::Gemm g{(const pg8::bf16_t*)(F.ws + WS_MIX), (const pg8::bf16_t*)(F.ws + WS_WOUTT), MP, DM, DM};
        pg8::StaticOrder S; S.init(MP, DM, F.G, (int)blockIdx.x);
        pg8::EpiOut E{F.xp, F.out + O_YP, (const float*)(F.ws + WS_ADA)};
        for (int rp_ = 0; rp_ < REP_P4G; ++rp_) pg8::gemm_phase<pg8::EpiOut, pg8::StaticOrder, true, true>(F.lds + RING_OFF, g, S, E);
        STAMP(); STAMP();
    }
#undef IN
#undef BOTH
}

#if TEST_MODE
__global__ void __launch_bounds__(256) k_cmp(const void* a, int a_bf16, int lda, const float* ref, int ldr, int rows, int cols, float scale, int act, float* accum) {
    __shared__ float sd[256], sr[256];
    const size_t idx = (size_t)blockIdx.x * 256 + threadIdx.x; float d2 = 0.f, r2 = 0.f;
    if (idx < (size_t)rows * cols) { const size_t r = idx / cols, c = idx % cols;
        const float av = a_bf16 ? bf2f(((const bf16*)a)[r * lda + c]) : ((const float*)a)[r * lda + c];
        float rv = ref[r * ldr + c]; if (act) rv = rv / (1.f + expf(-rv)); rv *= scale;
        d2 = (av - rv) * (av - rv); r2 = rv * rv; if (!(d2 == d2)) d2 = 1e30f; }
    sd[threadIdx.x] = d2; sr[threadIdx.x] = r2; __syncthreads();
    for (int s = 128; s > 0; s >>= 1) { if ((int)threadIdx.x < s) { sd[threadIdx.x] += sd[threadIdx.x + s]; sr[threadIdx.x] += sr[threadIdx.x + s]; } __syncthreads(); }
    if (threadIdx.x == 0) { atomicAdd(accum, sd[0]); atomicAdd(accum + 1, sr[0]); }
}
__global__ void __launch_bounds__(256) k_cmp_sel(const int* SEL, const int* NSEL, const unsigned* bmdump, float* accum) {
    __shared__ float sd[256], sr[256];
    const size_t idx = (size_t)blockIdx.x * 256 + threadIdx.x; const int m = (int)(idx >> 8), i = (int)(idx & 255); float miss = 0.f, tot = 0.f;
    if (m < MP && i < NSEL[m]) { const int l = SEL[(size_t)m * 256 + i]; tot = 1.f; if (!((bmdump[(size_t)m * 64 + (l >> 5)] >> (l & 31)) & 1u)) miss = 1.f; }
    sd[threadIdx.x] = miss; sr[threadIdx.x] = tot; __syncthreads();
    for (int s = 128; s > 0; s >>= 1) { if ((int)threadIdx.x < s) { sd[threadIdx.x] += sd[threadIdx.x + s]; sr[threadIdx.x] += sr[threadIdx.x + s]; } __syncthreads(); }
    if (threadIdx.x == 0) { atomicAdd(accum, sd[0]); atomicAdd(accum + 1, sr[0]); }
}
__global__ void k_cmp_fin2(float* accum, int n, float amp) {
    float best = -1.f; int bi = 0;
    for (int k = 0; k < n; ++k) { const float rel = accum[2 * k] / fmaxf(accum[2 * k + 1], 1e-30f) / accum[32 + k]; if (rel > best) { best = rel; bi = k; } }
    accum[64] = sqrtf(amp * best); accum[65] = (float)bi;
}
__global__ void k_set(float* p, float a, float b, float c, float d, float e) { p[0] = a; p[1] = b; p[2] = c; p[3] = d; p[4] = e; }
__global__ void k_cmp_fin(float* accum, int n, float amp) {
    float best = -1.f; int bi = 0;
    for (int k = 0; k < n; ++k) { const float rel = accum[2 * k] / fmaxf(accum[2 * k + 1], 1e-30f); if (rel > best) { best = rel; bi = k; } }
    accum[64] = sqrtf(amp * best); accum[65] = (float)bi;
}
__global__ void __launch_bounds__(256) k_perturb(float* out, const float* accum) {
    const size_t offs[11] = {O_YP, O_YS, O_KP, O_VP, O_KIP, O_PP, O_KS, O_VS, O_KIS, O_PS, O_END};
    const int k = (int)accum[65] % 10; const float f = 1.0f + accum[64];
    for (size_t i = offs[k] + (size_t)blockIdx.x * 256 + threadIdx.x; i < offs[k + 1]; i += (size_t)gridDim.x * 256) out[i] *= f;
}
__global__ void __launch_bounds__(256) k_f32_to_bf16(const float* src, bf16* dst, size_t n) {
    for (size_t i = (size_t)blockIdx.x * 256 + threadIdx.x; i < n; i += (size_t)gridDim.x * 256) dst[i] = (bf16)f2bf(src[i]);
}
#endif

#if TEST_MODE == 5
__global__ void __launch_bounds__(256) k_stat(float* out, const unsigned* st, int which) {
    float v = which == 0 ? (float)st[0] : (which == 1 ? (float)st[1] / fmaxf((float)st[2], 1.f) : (which < 8 ? (float)st[3] : (which == 13 ? (float)st[13] : (float)st[which] * (16.0f / 1000.0f))));
    const float f = 1.0f + sqrtf(v * 1e-5f);
    for (size_t i = O_KS + (size_t)blockIdx.x * 256 + threadIdx.x; i < O_VS; i += (size_t)gridDim.x * 256) out[i] *= f;
}
#endif
#if TEST_MODE == 6
__global__ void __launch_bounds__(256) k_blk(float* out, const unsigned long long* tb, int sel, float scale) {
    unsigned long long mx = 0; int am = 0;
    for (int i = 0; i < 256; ++i) if (tb[i] > mx) { mx = tb[i]; am = i; }
    float us = 0.f;
    if (sel == 3) us = (float)(am >> 4); else if (sel == 4) us = (float)(am & 15);
    else { double s = 0; int n = 0; for (int i = 0; i < 256; ++i) { const bool in = sel == 1 ? i < 128 : sel == 2 ? i >= 128 : sel >= 10 && sel < 18 ? (i & 7) == sel - 10 : sel >= 20 && sel < 52 ? (i >> 3) == sel - 20 : true; if (in) { s += (double)(mx - tb[i]); ++n; } } us = (float)(s / n) * 0.01f; }
    const float f = 1.0f + sqrtf(us * scale);
    for (size_t i = O_KS + (size_t)blockIdx.x * 256 + threadIdx.x; i < O_VS; i += (size_t)gridDim.x * 256) out[i] *= f;
}
#endif
#if TEST_MODE == 4
__global__ void __launch_bounds__(256) k_time(float* out, const unsigned long long* ts, int i0, int i1, float scale) {
    const float us = (float)(ts[i1] - ts[i0]) * 0.01f; const float f = 1.0f + sqrtf(us * scale);
    for (size_t i = O_KS + (size_t)blockIdx.x * 256 + threadIdx.x; i < O_VS; i += (size_t)gridDim.x * 256) out[i] *= f;
}
#endif
extern "C" void kernel_launch(void* const* d_in, const int* in_sizes, int n_in, void* d_out, int out_size, void* d_ws, size_t ws_size, hipStream_t stream) {
    static int grid = 0;
    if (grid == 0) {
        size_t need = WS_MEGA_END;
#if TEST_MODE && TEST_MODE < 4
        need = 192 * MiB + gold::W_END * 4;
#endif
        if (n_in != 18 || out_size != (int)O_END || ws_size < need) { fprintf(stderr, "kernel_launch: unexpected sizes: n_in %d out %d ws %zu (need %zu)\n", n_in, out_size, ws_size, need); grid = -1; return; }
        int dev = 0, cus = 0, per_cu = 0;
        if (hipGetDevice(&dev) != hipSuccess || hipDeviceGetAttribute(&cus, hipDeviceAttributeMultiprocessorCount, dev) != hipSuccess) { grid = -1; return; }
        if (hipFuncSetAttribute((const void*)mk_fwd, hipFuncAttributeMaxDynamicSharedMemorySize, LDS_BYTES) != hipSuccess) { fprintf(stderr, "kernel_launch: hipFuncSetAttribute failed\n"); grid = -1; return; }
        if (hipOccupancyMaxActiveBlocksPerMultiprocessor(&per_cu, (const void*)mk_fwd, NWAVES * 64, LDS_BYTES) != hipSuccess || per_cu < 1) { fprintf(stderr, "kernel_launch: occupancy query says %d blocks/CU\n", per_cu); (void)hipGetLastError(); grid = -1; return; }
        if (cus < 64) { fprintf(stderr, "kernel_launch: needs >= 64 CUs\n"); grid = -1; return; }
        grid = cus;
    }
#if defined(FORCE_GRID)
    if (grid > FORCE_GRID) grid = FORCE_GRID;
#endif
    if (grid < 0) return;
#if TEST_MODE
    (void)hipMemsetAsync((char*)d_ws + WS_CTL, 0, CTL_ZERO_BYTES, stream);
#else
    (void)hipMemsetAsync((char*)d_ws + WS_CTL + CW_BAR * 4, 0, (CW_Q - CW_BAR + 256) * 4, stream);
#endif
    Args a{};
    for (int i = 0; i < 18; ++i) a.in[i] = (const float*)d_in[i];
    a.out = (float*)d_out; a.ws = (unsigned char*)d_ws;
#if TEST_MODE == 6
    a.ph_lo = 0; a.ph_hi = 5; a.li = 0;
    hipLaunchKernelGGL(mk_fwd, dim3(grid), dim3(NWAVES * 64), LDS_BYTES, stream, a);
    k_blk<<<16, 256, 0, stream>>>((float*)d_out, (const unsigned long long*)((char*)d_ws + WS_CTL + 800 * 1024), STATSEL, 1e-5f);
#elif TEST_MODE == 5
    a.ph_lo = 0; a.ph_hi = 5; a.li = 0;
    hipLaunchKernelGGL(mk_fwd, dim3(grid), dim3(NWAVES * 64), LDS_BYTES, stream, a);
    k_stat<<<16, 256, 0, stream>>>((float*)d_out, (const unsigned*)((char*)d_ws + WS_CTL + 900 * 1024), STATSEL);
#elif TEST_MODE == 4
    a.ph_lo = 0; a.ph_hi = 5; a.li = 0;
    hipLaunchKernelGGL(mk_fwd, dim3(grid), dim3(NWAVES * 64), LDS_BYTES, stream, a);
    k_time<<<16, 256, 0, stream>>>((float*)d_out, (const unsigned long long*)((char*)d_ws + WS_CTL + 768 * 1024), TS0, TS1, 1e-5f);
#elif TEST_MODE && TEST_MODE < 4
    {
        using namespace gold;
        const float* xp = (const float*)d_in[0]; const float* xs = (const float*)d_in[1];
        const float* cache_k = (const float*)d_in[2]; const float* cache_v = (const float*)d_in[3]; const float* cache_kidx = (const float*)d_in[4];
        const float* state_pool = (const float*)d_in[5]; const int* page_table = (const int*)d_in[6];
        const float* cp = (const float*)d_in[7]; const float* cs = (const float*)d_in[8]; const float* norm_w = (const float*)d_in[9];
        const float* w_ada = (const float*)d_in[10]; const float* b_ada = (const float*)d_in[11]; const float* w_in = (const float*)d_in[12];
        const float* qnw = (const float*)d_in[13]; const float* knw = (const float*)d_in[14]; const float* w_pool = (const float*)d_in[15];
        const float* pool_scale = (const float*)d_in[16]; const float* w_out = (const float*)d_in[17];
        float* out = (float*)d_out; float* ws = (float*)((char*)d_ws + 192 * MiB);
        float *ADA = ws + W_ADA, *H = ws + W_H, *PROJ = ws + W_PROJ, *SC = ws + W_SC, *SCS = ws + W_SCS, *MIX = ws + W_MIX, *DB = ws + W_DB, *YT = ws + W_YT;
        int *SEL = (int*)(ws + W_SEL), *NSEL = (int*)(ws + W_NSEL);
        k_ada<<<dim3(12, NR), 256, 0, stream>>>(cp, cs, w_ada, b_ada, ADA);
        k_h<<<MT / 4, 256, 0, stream>>>(xp, xs, norm_w, ADA, H);
        k_gemm<<<dim3((NIN + 127) / 128, MT / 128), 256, 0, stream>>>(H, w_in, PROJ, MT, NIN, DM, DM, NIN, NIN);
        k_post<<<MT / 4, 256, 0, stream>>>(PROJ, qnw, knw, state_pool, out);
        k_scores_p<<<dim3(SEQ / 8, NB), 256, 0, stream>>>(PROJ, SC);
        k_scores_s<<<DECB, 256, 0, stream>>>(PROJ, cache_kidx, page_table, SCS);
        k_topk<<<MT / 4, 256, 0, stream>>>(SC, SCS, SEL, NSEL);
        k_attn<<<MT / 4, 256, 0, stream>>>(PROJ, cache_k, cache_v, page_table, SEL, NSEL, MIX);
        k_pool_d<<<(MT * 512) / 256, 256, 0, stream>>>(PROJ, state_pool, DB);
        k_pool_out<<<(MT * 512) / 256, 256, 0, stream>>>(PROJ, DB, w_pool, pool_scale, MIX);
        k_gemm<<<dim3(1024 / 128, MT / 128), 256, 0, stream>>>(MIX, w_out, YT, MT, 1024, 1024, 1024, 1024, 1024);
        k_final<<<(MT * 1024) / 256, 256, 0, stream>>>(xp, xs, ADA, YT, out);
        unsigned char* mws = (unsigned char*)d_ws;
#if TEST_MODE == 1
        a.ph_lo = 0; a.ph_hi = 3; a.li = 0;
        hipLaunchKernelGGL(mk_fwd, dim3(grid), dim3(NWAVES * 64), LDS_BYTES, stream, a);
        float* accum = (float*)(mws + WS_CTL + 512 * 1024);
        struct { const void* a; int bf; int lda; int refcol; int cols; float scale; int act; } L[9] = {
            {mws + WS_Q, 1, 512, CQ, 512, C2, 0}, {mws + WS_QI, 1, 512, CQI, 512, 1.f, 0}, {mws + WS_GA, 1, 512, CGA, 512, 1.f, 1}, {mws + WS_U, 1, 512, CU, 512, 1.f, 0},
            {mws + WS_GP, 1, 512, CGP, 512, 1.f, 1}, {mws + WS_KB, 1, 128, CK, 128, 1.f, 0}, {mws + WS_VB, 1, 128, CV, 128, 1.f, 0}, {mws + WS_KI, 1, 64, CKI, 64, 1.f, 0},
            {mws + WS_WI, 0, 8, CWI, 8, 1.f, 0} };
        for (int k = 0; k < 9; ++k) k_cmp<<<(unsigned)(((size_t)MT * L[k].cols + 255) / 256), 256, 0, stream>>>(L[k].a, L[k].bf, L[k].lda, PROJ + L[k].refcol, NIN, MT, L[k].cols, L[k].scale, L[k].act, accum + 2 * k);
        k_cmp<<<(NR * 3072 + 255) / 256, 256, 0, stream>>>(mws + WS_ADA, 0, 3072, ADA, 3072, NR, 3072, 1.f, 0, accum + 18);
        k_cmp_fin<<<1, 1, 0, stream>>>(accum, 10, 5.0f);
        k_perturb<<<1024, 256, 0, stream>>>(out, accum);
#elif TEST_MODE == 3
        a.ph_lo = 0; a.ph_hi = 5; a.li = 0;
        hipLaunchKernelGGL(mk_fwd, dim3(grid), dim3(NWAVES * 64), LDS_BYTES, stream, a);
        float* accum = (float*)(mws + WS_CTL + 512 * 1024);
        const bf16* MB = (const bf16*)(mws + WS_MIX);
        k_cmp<<<(unsigned)(((size_t)MP * 512 + 255) / 256), 256, 0, stream>>>(MB, 1, 1024, MIX, 1024, MP, 512, 1.f, 0, accum + 0);
        k_cmp<<<(unsigned)(((size_t)MP * 512 + 255) / 256), 256, 0, stream>>>(MB + 512, 1, 1024, MIX + 512, 1024, MP, 512, 1.f, 0, accum + 2);
        k_cmp<<<(DECB * 512 + 255) / 256, 256, 0, stream>>>(MB + (size_t)MP * 1024, 1, 1024, MIX + (size_t)MP * 1024, 1024, DECB, 512, 1.f, 0, accum + 4);
        k_cmp<<<(DECB * 512 + 255) / 256, 256, 0, stream>>>(MB + (size_t)MP * 1024 + 512, 1, 1024, MIX + (size_t)MP * 1024 + 512, 1024, DECB, 512, 1.f, 0, accum + 6);
        k_cmp_sel<<<MP, 256, 0, stream>>>(SEL, NSEL, (const unsigned*)(mws + WS_DBG_BM), accum + 8);
        k_set<<<1, 1, 0, stream>>>(accum + 32, P3_TOL0, P3_TOL1, P3_TOL2, P3_TOL3, P3_TOL4);
        k_cmp_fin2<<<1, 1, 0, stream>>>(accum, 5, 1e-5f);
        k_perturb<<<1024, 256, 0, stream>>>(out, accum);
#elif TEST_MODE == 2
        a.ph_lo = 0; a.ph_hi = 3; a.li = 0;
        hipLaunchKernelGGL(mk_fwd, dim3(grid), dim3(NWAVES * 64), LDS_BYTES, stream, a);
        k_f32_to_bf16<<<2048, 256, 0, stream>>>(MIX, (bf16*)(mws + WS_MIX), (size_t)MT * 1024);
        a.ph_lo = 4; a.ph_hi = 5; a.li = 1;
        hipLaunchKernelGGL(mk_fwd, dim3(grid), dim3(NWAVES * 64), LDS_BYTES, stream, a);
#endif
    }
#else
    a.ph_lo = 0; a.ph_hi = 5; a.li = 0;
#if USE_COOP
    { void* kargs[] = {&a}; (void)hipLaunchCooperativeKernel((const void*)mk_fwd, dim3(grid), dim3(NWAVES * 64), kargs, LDS_BYTES, stream); }
#else
    hipLaunchKernelGGL(mk_fwd, dim3(grid), dim3(NWAVES * 64), LDS_BYTES, stream, a);
#endif
#endif
}
```

```cpp
#define TEST_MODE 0
#define HAVE_P3 1
#define REP_S1 1
#define REP_S2 1
#define REP_S4 1
#define REP_P0 1
#define REP_P1 1
#define REP_P4S 1
#define REP_P2G 1
#define REP_P4G 1
#define REP_P2S 1
#define REP_SMP 1
#define REP_POOL 1
#define STATSEL 0
#define USE_COOP 1
#define STAMP_BLK 0
#define P3FINE 0
#define TS0 0
#define TS1 1
#include <hip/hip_runtime.h>
#include <cstdio>
#include <cstdint>

constexpr int DM = 1024, NB = 8, SEQ = 2048, DECB = 128, PAST = 2048, PAGE = 128, NPG = 16;
constexpr int NIN = 2888, MP = NB * SEQ, MT = MP + DECB, NR = NB + DECB;
constexpr int CQ = 0, CK = 512, CV = 640, CQI = 768, CKI = 1280, CWI = 1344, CGA = 1352, CU = 1864, CGP = 2376;
constexpr size_t O_YP = 0, O_YS = 16777216, O_KP = 16908288, O_VP = 19005440, O_KIP = 21102592, O_PP = 22151168,
                 O_KS = 22212608, O_VS = 22228992, O_KIS = 22245376, O_PS = 22253568, O_END = 23236608;
constexpr float C2 = 0.125f * 1.4426950408889634f;
constexpr float WI_SCALE = 0.04419417382415922f;
constexpr float EPS = 1e-6f;
constexpr size_t MiB = 1u << 20;
constexpr size_t WS_CTL = 0, CTL_ZERO_BYTES = 1 * MiB;
constexpr size_t WS_ADA = 1 * MiB, WS_WINT = 3 * MiB, WS_WOUTT = 9 * MiB, WS_WPOOLT = 11 * MiB, WS_HS = 12 * MiB, WS_HB = 24 * MiB,
                 WS_Q = 56 * MiB, WS_QI = 73 * MiB, WS_GA = 90 * MiB, WS_U = 107 * MiB, WS_GP = 124 * MiB, WS_KB = 141 * MiB, WS_VB = 146 * MiB,
                 WS_KI = 151 * MiB, WS_WI = 154 * MiB, WS_MIX = 155 * MiB, WS_DBG_BM = 188 * MiB, WS_MEGA_END = 192 * MiB;
namespace pg8 {
#define PG8_LAS __attribute__((address_space(3)))
typedef unsigned short bf16_t;
typedef short bf16x8 __attribute__((ext_vector_type(8)));
typedef float f32x4 __attribute__((ext_vector_type(4)));
typedef unsigned u32x4 __attribute__((ext_vector_type(4)));
constexpr int BM = 256, BK = 64, HALF = 128, HTB = HALF * BK * 2  , STAGE_BYTES = 8 * HTB, NXCD = 8, WGM = 8;

__host__ __device__ __forceinline__ int lds_byte(int r, int c) { const int st = (r >> 4) * 2 + (c >> 5), rr = r & 15, cc = c & 31, ob = rr * 64 + cc * 2; return st * 1024 + (ob ^ (((ob >> 9) & 1) << 5)); }
__host__ __device__ __forceinline__ void stage_rc(int b, int& R, int& C) { const int st = b / 1024, sb = b % 1024, swz = sb ^ (((sb >> 9) & 1) << 5); R = (st >> 1) * 16 + swz / 64; C = (st & 1) * 32 + (swz % 64) / 2; }
__host__ __device__ __forceinline__ int perm32(int rho) { const int n = rho >> 4, i = rho & 15; return 8 * (i >> 2) + 4 * n + (i & 3); }

struct Unit { int pm, pn; };
struct Gemm { const bf16_t* A; const bf16_t* Bt; int M, N, K; };

struct StaticOrder {
    int nM, nN, nwg, G, c;
    __host__ __device__ void init(int M, int N, int G_, int c_) { nM = M / BM; nN = N / BM; nwg = nM * nN; G = G_; c = c_; }
    __host__ __device__ bool next(int i, Unit& u) const {
        const long L = (long)i * G + c; if (L >= nwg) return false;
        int wgid = (int)L; { const int q = nwg / NXCD, r = nwg % NXCD, xcd = wgid % NXCD, off = wgid / NXCD; wgid = (xcd < r ? xcd * (q + 1) : r * (q + 1) + (xcd - r) * q) + off; }
        const int nig = WGM * nN, gid = wgid / nig, fm = gid * WGM, gsz = (nM - fm) < WGM ? (nM - fm) : WGM;
        u.pm = fm + ((wgid % nig) % gsz); u.pn = (wgid % nig) / gsz; return true;
    }
    __device__ __forceinline__ void a_ready(const Unit&) const {}
    __device__ __forceinline__ void done(const Unit&) const {}
};


typedef unsigned u32x4 __attribute__((ext_vector_type(4)));
__device__ __forceinline__ unsigned cvt_pk_bf16(float lo, float hi) { unsigned r; asm volatile("v_cvt_pk_bf16_f32 %0, %1, %2" : "=v"(r) : "v"(lo), "v"(hi)); return r; }
__device__ __forceinline__ void st_bf16x8(bf16_t* p, const f32x4 a, const f32x4 b) {
    u32x4 w; w.x = cvt_pk_bf16(a[0], a[1]); w.y = cvt_pk_bf16(a[2], a[3]); w.z = cvt_pk_bf16(b[0], b[1]); w.w = cvt_pk_bf16(b[2], b[3]); *(u32x4*)p = w; }
__device__ __forceinline__ float silu1(float x) { return x * __builtin_amdgcn_rcpf(1.0f + __builtin_amdgcn_exp2f(-1.4426950408889634f * x)); }
__device__ __forceinline__ f32x4 silu4(const f32x4 v) { f32x4 r; r[0] = silu1(v[0]); r[1] = silu1(v[1]); r[2] = silu1(v[2]); r[3] = silu1(v[3]); return r; }

struct EpiIn {
    static constexpr bool PERM = true, AFTER_DRAIN = false;
    unsigned char* ws; float* out; const float* qnw; const float* knw;
    __device__ __forceinline__ void operator()(const f32x4 (&acc)[2][2][4][2], const Unit& u, int wr, int wc, int fr, int fq) const {
        const int pn = u.pn;
        if (pn == 5 && wc >= 2) return;
        const int rowb = u.pm * 256 + wr * 64 + fr, dof = 8 * fq;
        if (pn <= 1 || (pn == 2 && wc < 2)) {
            const float* nwp = pn <= 1 ? qnw : knw; const float sc = pn <= 1 ? C2 : 1.0f;
            f32x4 wv[2][2];
#pragma unroll
            for (int bj = 0; bj < 2; ++bj)
#pragma unroll
                for (int n = 0; n < 2; ++n) wv[bj][n] = *(const f32x4*)(nwp + 32 * bj + dof + 4 * n) * sc;
#pragma unroll
            for (int ai = 0; ai < 2; ++ai)
#pragma unroll
                for (int m = 0; m < 4; ++m) { const size_t row = (size_t)(rowb + ai * 128 + m * 16); float ss = 0.f;
#pragma unroll
                    for (int bj = 0; bj < 2; ++bj)
#pragma unroll
                        for (int n = 0; n < 2; ++n) { const f32x4 x = acc[ai][bj][m][n]; ss += (x[0] * x[0] + x[1] * x[1]) + (x[2] * x[2] + x[3] * x[3]); }
                    ss += __shfl_xor(ss, 16); ss += __shfl_xor(ss, 32);
                    const float rstd = 1.0f / sqrtf(ss * (1.0f / 64.0f) + EPS);
                    f32x4 o[2][2];
#pragma unroll
                    for (int bj = 0; bj < 2; ++bj)
#pragma unroll
                        for (int n = 0; n < 2; ++n) o[bj][n] = acc[ai][bj][m][n] * rstd * wv[bj][n];
                    if (pn <= 1) { bf16_t* q = (bf16_t*)(ws + WS_Q) + row * 512 + (4 * pn + wc) * 64 + dof; st_bf16x8(q, o[0][0], o[0][1]); st_bf16x8(q + 32, o[1][0], o[1][1]); }
                    else { float* ko = out + O_KP + row * 128 + wc * 64 + dof; *(f32x4*)ko = o[0][0]; *(f32x4*)(ko + 4) = o[0][1]; *(f32x4*)(ko + 32) = o[1][0]; *(f32x4*)(ko + 36) = o[1][1];
                        bf16_t* kb = (bf16_t*)(ws + WS_KB) + row * 128 + wc * 64 + dof; st_bf16x8(kb, o[0][0], o[0][1]); st_bf16x8(kb + 32, o[1][0], o[1][1]); } }
            return;
        }
        if (pn == 5 && wc == 1) {
            if (fq == 0) {
#pragma unroll
                for (int ai = 0; ai < 2; ++ai)
#pragma unroll
                    for (int m = 0; m < 4; ++m) { const size_t row = (size_t)(rowb + ai * 128 + m * 16); float* wp = (float*)(ws + WS_WI) + row * 8;
                        *(f32x4*)wp = acc[ai][0][m][0] * WI_SCALE; *(f32x4*)(wp + 4) = acc[ai][0][m][1] * WI_SCALE; } }
            return;
        }
        bf16_t* dst; int ld, cb; float* fo = nullptr; int fld = 0; bool act = false;
        if (pn == 2) { dst = (bf16_t*)(ws + WS_VB); ld = 128; cb = (wc - 2) * 64; fo = out + O_VP + cb; fld = 128; }
        else if (pn <= 4) { dst = (bf16_t*)(ws + WS_QI); ld = 512; cb = (4 * (pn - 3) + wc) * 64; }
        else if (pn == 5) { dst = (bf16_t*)(ws + WS_KI); ld = 64; cb = 0; fo = out + O_KIP; fld = 64; }
        else if (pn <= 7) { dst = (bf16_t*)(ws + WS_GA); ld = 512; cb = (4 * (pn - 6) + wc) * 64; act = true; }
        else if (pn <= 9) { dst = (bf16_t*)(ws + WS_U); ld = 512; cb = (4 * (pn - 8) + wc) * 64; }
        else { dst = (bf16_t*)(ws + WS_GP); ld = 512; cb = (4 * (pn - 10) + wc) * 64; act = true; }
        const bool is_u = (pn == 8 || pn == 9);
#pragma unroll
        for (int ai = 0; ai < 2; ++ai)
#pragma unroll
            for (int m = 0; m < 4; ++m) { const int rowi = rowb + ai * 128 + m * 16; const size_t row = (size_t)rowi;
                f32x4 o00 = acc[ai][0][m][0], o01 = acc[ai][0][m][1], o10 = acc[ai][1][m][0], o11 = acc[ai][1][m][1];
                if (act) { o00 = silu4(o00); o01 = silu4(o01); o10 = silu4(o10); o11 = silu4(o11); }
                bf16_t* d = dst + row * ld + cb + dof; st_bf16x8(d, o00, o01); st_bf16x8(d + 32, o10, o11);
                if (fo) { float* f = fo + row * fld + dof; *(f32x4*)f = o00; *(f32x4*)(f + 4) = o01; *(f32x4*)(f + 32) = o10; *(f32x4*)(f + 36) = o11; }
                if (is_u) { const int t = rowi & (SEQ - 1);
                    if (t >= SEQ - 15) { float* f = out + O_PP + ((size_t)(rowi >> 11) * 15 + (t - (SEQ - 15))) * 512 + cb + dof;
                        *(f32x4*)f = o00; *(f32x4*)(f + 4) = o01; *(f32x4*)(f + 32) = o10; *(f32x4*)(f + 36) = o11; } } }
    }
};
struct EpiOut {
    static constexpr bool PERM = true, AFTER_DRAIN = false;
    const float* x; float* y; const float* ada;
    __device__ __forceinline__ void operator()(const f32x4 (&acc)[2][2][4][2], const Unit& u, int wr, int wc, int fr, int fq) const {
        const int col0 = u.pn * 256 + wc * 32 + 8 * fq; const float* gp = ada + (size_t)(u.pm >> 3) * 3072 + 2048 + col0;
        f32x4 g[2][2];
#pragma unroll
        for (int bj = 0; bj < 2; ++bj)
#pragma unroll
            for (int n = 0; n < 2; ++n) g[bj][n] = *(const f32x4*)(gp + 128 * bj + 4 * n);
#pragma unroll
        for (int ai = 0; ai < 2; ++ai)
#pragma unroll
            for (int m = 0; m < 4; ++m) { const size_t off = (size_t)(u.pm * 256 + ai * 128 + wr * 64 + m * 16 + fr) * 1024 + col0;
#pragma unroll
                for (int bj = 0; bj < 2; ++bj)
#pragma unroll
                    for (int n = 0; n < 2; ++n) { const f32x4 xv = *(const f32x4*)(x + off + 128 * bj + 4 * n); *(f32x4*)(y + off + 128 * bj + 4 * n) = xv + g[bj][n] * acc[ai][bj][m][n]; } }
    }
};
template <class Epi, class Sched, bool ALIGN_EPI = false, bool SP2 = false>
__device__ __forceinline__ void gemm_phase(PG8_LAS unsigned char* lds, const Gemm g, const Sched& S, const Epi& E) {
    const int tid = threadIdx.x, wid = __builtin_amdgcn_readfirstlane(tid >> 6), lane = tid & 63, wr = wid >> 2, wc = wid & 3, fr = lane & 15, fq = lane >> 4;
    const int K = g.K, nt = K / BK;
    unsigned voffA[2], voffB[2];
#pragma unroll
    for (int i = 0; i < 2; ++i) { int R, C; stage_rc(tid * 16 + i * 8192, R, C); const int Rb = Epi::PERM ? ((R & ~31) + perm32(R & 31)) : R;
        voffA[i] = (unsigned)(R * K + C) * 2u; voffB[i] = (unsigned)(Rb * K + C) * 2u; }
    const size_t kstep = (size_t)(BK * 2);
    const size_t hstep = (size_t)HALF * K * 2;
    const size_t tstep = 2 * hstep;
    const unsigned ldsw = (unsigned)wid * 1024u;
    const int aoff = lds_byte(wr * 64 + fr, fq * 8), boff = lds_byte(wc * 32 + fr, fq * 8);
#define PG8_SA(b, h) (((b) * 2 + (h)) * HTB)
#define PG8_SB(b, h) ((4 + (b) * 2 + (h)) * HTB)
#define PG8_STAGE(bufoff, gbase, voff) do { _Pragma("unroll") for (int _i = 0; _i < 2; ++_i) \
        __builtin_amdgcn_global_load_lds((const unsigned*)((const char*)(gbase) + (voff)[_i]), (PG8_LAS unsigned*)(lds + (bufoff) + ldsw + _i * 8192), 16, 0, 0); } while (0)
#define PG8_LDA(dst, b, h) do { _Pragma("unroll") for (int m = 0; m < 4; ++m) _Pragma("unroll") for (int k = 0; k < 2; ++k) dst[m][k] = *(const PG8_LAS bf16x8*)(lds + PG8_SA(b, h) + aoff + m * 2048 + k * 1024); } while (0)
#define PG8_LDB(dst, b, h) do { _Pragma("unroll") for (int n = 0; n < 2; ++n) _Pragma("unroll") for (int k = 0; k < 2; ++k) dst[n][k] = *(const PG8_LAS bf16x8*)(lds + PG8_SB(b, h) + boff + n * 2048 + k * 1024); } while (0)
#define PG8_MMA(ai, bj, At, Bt) do { __builtin_amdgcn_s_setprio(1); _Pragma("unroll") for (int m = 0; m < 4; ++m) _Pragma("unroll") for (int n = 0; n < 2; ++n) _Pragma("unroll") for (int k = 0; k < 2; ++k) \
        acc[ai][bj][m][n] = __builtin_amdgcn_mfma_f32_16x16x32_bf16(Bt[n][k], At[m][k], acc[ai][bj][m][n], 0, 0, 0); __builtin_amdgcn_s_setprio(0); } while (0)
#define PG8_WAIT_V(n) asm volatile("s_waitcnt vmcnt(" #n ")" ::: "memory")
#define PG8_WAIT_L(n) asm volatile("s_waitcnt lgkmcnt(" #n ")" ::: "memory")
#define PG8_BAR __builtin_amdgcn_s_barrier()
#define PG8_SCHED __builtin_amdgcn_sched_barrier(0)
    Unit cur, nxt; int ui = 0;
    if (!S.next(0, cur)) return;
    f32x4 acc[2][2][4][2];
#pragma unroll
    for (int a = 0; a < 2; ++a)
#pragma unroll
        for (int b = 0; b < 2; ++b)
#pragma unroll
            for (int m = 0; m < 4; ++m)
#pragma unroll
                for (int n = 0; n < 2; ++n) acc[a][b][m][n] = (f32x4){0.f, 0.f, 0.f, 0.f};
    bf16x8 At[4][2], B0[2][2], B1[2][2];
    const char* cA = (const char*)g.A + (size_t)cur.pm * tstep; const char* cB = (const char*)g.Bt + (size_t)cur.pn * tstep;
    S.a_ready(cur);
    if constexpr (SP2) {
        PG8_STAGE(PG8_SB(0, 0), cB, voffB); PG8_STAGE(PG8_SB(0, 1), cB + hstep, voffB); PG8_STAGE(PG8_SA(0, 0), cA, voffA); PG8_STAGE(PG8_SA(0, 1), cA + hstep, voffA);
        if (wr == 1) PG8_BAR;
        PG8_WAIT_V(2); PG8_BAR;
        PG8_STAGE(PG8_SB(1, 0), cB + kstep, voffB); PG8_STAGE(PG8_SA(1, 0), cA + kstep, voffA); PG8_STAGE(PG8_SB(1, 1), cB + hstep + kstep, voffB);
        PG8_WAIT_V(6); PG8_BAR;
    } else {
        PG8_STAGE(PG8_SB(0, 0), cB, voffB); PG8_STAGE(PG8_SA(0, 0), cA, voffA); PG8_STAGE(PG8_SB(0, 1), cB + hstep, voffB); PG8_STAGE(PG8_SA(0, 1), cA + hstep, voffA);
        if (wr == 1) PG8_BAR;
        PG8_WAIT_V(4); PG8_BAR;
        PG8_STAGE(PG8_SB(1, 0), cB + kstep, voffB); PG8_STAGE(PG8_SA(1, 0), cA + kstep, voffA); PG8_STAGE(PG8_SB(1, 1), cB + hstep + kstep, voffB);
        PG8_WAIT_V(6); PG8_BAR;
    }
    for (;;) {
        const bool has_next = S.next(ui + 1, nxt);
        const char* nA = has_next ? (const char*)g.A + (size_t)nxt.pm * tstep : cA; const char* nB = has_next ? (const char*)g.Bt + (size_t)nxt.pn * tstep : cB;
        for (int t = 0; t < nt; t += 2) {
            const bool last = (t == nt - 2);
            const char* a1 = cA + (size_t)(t + 1) * kstep;
            const char* a2 = last ? nA : cA + (size_t)(t + 2) * kstep; const char* b2 = last ? nB : cB + (size_t)(t + 2) * kstep;
            const char* a3 = a2 + kstep; const char* b3 = b2 + kstep;
            if (last && has_next) S.a_ready(nxt);
            if constexpr (SP2) {
            PG8_LDB(B0, 0, 0); PG8_LDB(B1, 0, 1); PG8_SCHED; PG8_LDA(At, 0, 0); PG8_STAGE(PG8_SA(1, 1), a1 + hstep, voffA);
            PG8_WAIT_V(8); PG8_WAIT_L(0); PG8_BAR; PG8_MMA(0, 0, At, B0); PG8_MMA(0, 1, At, B1); PG8_BAR; PG8_SCHED;
            PG8_LDA(At, 0, 1); PG8_STAGE(PG8_SB(0, 0), b2, voffB); PG8_STAGE(PG8_SB(0, 1), b2 + hstep, voffB); PG8_STAGE(PG8_SA(0, 0), a2, voffA);
            PG8_WAIT_V(8); PG8_WAIT_L(0); PG8_BAR; PG8_MMA(1, 0, At, B0); PG8_MMA(1, 1, At, B1); PG8_BAR; PG8_SCHED;
            PG8_LDB(B0, 1, 0); PG8_LDB(B1, 1, 1); PG8_SCHED; PG8_LDA(At, 1, 0); PG8_STAGE(PG8_SA(0, 1), a2 + hstep, voffA);
            PG8_WAIT_V(8); PG8_WAIT_L(0); PG8_BAR; PG8_MMA(0, 0, At, B0); PG8_MMA(0, 1, At, B1); PG8_BAR; PG8_SCHED;
            PG8_LDA(At, 1, 1); PG8_STAGE(PG8_SB(1, 0), b3, voffB); PG8_STAGE(PG8_SB(1, 1), b3 + hstep, voffB); PG8_STAGE(PG8_SA(1, 0), a3, voffA);
            PG8_WAIT_V(8); PG8_WAIT_L(0); PG8_BAR; PG8_MMA(1, 0, At, B0); PG8_MMA(1, 1, At, B1); PG8_BAR; PG8_SCHED;
            } else {
            PG8_LDB(B0, 0, 0); PG8_SCHED; PG8_LDA(At, 0, 0); PG8_STAGE(PG8_SA(1, 1), a1 + hstep, voffA);
            PG8_WAIT_L(8); PG8_BAR; PG8_WAIT_L(0); PG8_MMA(0, 0, At, B0); PG8_BAR; PG8_SCHED;
            PG8_LDB(B1, 0, 1); PG8_STAGE(PG8_SB(0, 0), b2, voffB);
            PG8_BAR; PG8_WAIT_L(0); PG8_MMA(0, 1, At, B1); PG8_BAR;
            PG8_LDA(At, 0, 1); PG8_STAGE(PG8_SA(0, 0), a2, voffA);
            PG8_BAR; PG8_WAIT_L(0); PG8_MMA(1, 0, At, B0); PG8_BAR; PG8_SCHED;
            PG8_STAGE(PG8_SB(0, 1), b2 + hstep, voffB);
            PG8_WAIT_V(6); PG8_BAR; PG8_MMA(1, 1, At, B1); PG8_BAR;
            PG8_LDB(B0, 1, 0); PG8_SCHED; PG8_LDA(At, 1, 0); PG8_STAGE(PG8_SA(0, 1), a2 + hstep, voffA);
            PG8_WAIT_L(8); PG8_BAR; PG8_WAIT_L(0); PG8_MMA(0, 0, At, B0); PG8_BAR; PG8_SCHED;
            PG8_LDB(B1, 1, 1); PG8_STAGE(PG8_SB(1, 0), b3, voffB);
            PG8_BAR; PG8_WAIT_L(0); PG8_MMA(0, 1, At, B1); PG8_BAR;
            PG8_LDA(At, 1, 1); PG8_STAGE(PG8_SA(1, 0), a3, voffA);
            PG8_BAR; PG8_WAIT_L(0); PG8_MMA(1, 0, At, B0); PG8_BAR; PG8_SCHED;
            PG8_STAGE(PG8_SB(1, 1), b3 + hstep, voffB);
            PG8_WAIT_V(6); PG8_BAR; PG8_MMA(1, 1, At, B1); PG8_BAR;
            }
        }
        if constexpr (ALIGN_EPI) { if (wr == 0) PG8_BAR; }
        if constexpr (!Epi::AFTER_DRAIN) { E(acc, cur, wr, wc, fr, fq); S.done(cur); }
        if (!has_next) break;
#pragma unroll
        for (int a = 0; a < 2; ++a)
#pragma unroll
            for (int b = 0; b < 2; ++b)
#pragma unroll
                for (int m = 0; m < 4; ++m)
#pragma unroll
                    for (int n = 0; n < 2; ++n) acc[a][b][m][n] = (f32x4){0.f, 0.f, 0.f, 0.f};
        cur = nxt; cA = nA; cB = nB; ++ui;
        if constexpr (ALIGN_EPI) { if (wr == 1) PG8_BAR; }
    }
    PG8_WAIT_V(0);
    if constexpr (!ALIGN_EPI) { if (wr == 0) PG8_BAR; }
    PG8_BAR;
    if constexpr (Epi::AFTER_DRAIN) { E.fused(acc, cur, wr, wc, fr, fq, lds, wid, lane); S.done(cur); }
#undef PG8_SA
#undef PG8_SB
#undef PG8_STAGE
#undef PG8_LDA
#undef PG8_LDB
#undef PG8_MMA
#undef PG8_WAIT_V
#undef PG8_WAIT_L
#undef PG8_BAR
#undef PG8_SCHED
}
}

constexpr int NWAVES = 8;
constexpr int RING_OFF = 0, RING_BYTES = 131072;
constexpr int LDSCTL_OFF = RING_BYTES, MISC_OFF = LDSCTL_OFF + 320;
constexpr int LDS_BYTES = 163840;
constexpr int CW_Q = 8192;
constexpr int CW_BAR = 4096;
#define GAS __attribute__((address_space(1)))
#define LAS __attribute__((address_space(3)))
typedef unsigned short bf16;
typedef unsigned v4u __attribute__((ext_vector_type(4)));
typedef unsigned v2u __attribute__((ext_vector_type(2)));
typedef float f32x4 __attribute__((ext_vector_type(4)));
typedef float f32x16 __attribute__((ext_vector_type(16)));
typedef short bf16x8 __attribute__((ext_vector_type(8)));
typedef GAS unsigned gu32;
#define LDS_WAIT() asm volatile("s_waitcnt lgkmcnt(0)" ::: "memory")
#define VM_WAIT() asm volatile("s_waitcnt vmcnt(0)" ::: "memory")
__device__ __forceinline__ unsigned f2bf(float f) { unsigned u = __builtin_bit_cast(unsigned, f); return (u + 0x7fffu + ((u >> 16) & 1u)) >> 16; }
__device__ __forceinline__ unsigned pk2(float lo, float hi) { return pg8::cvt_pk_bf16(lo, hi); }
__device__ __forceinline__ float bf2f(unsigned short b) { return __builtin_bit_cast(float, (unsigned)b << 16); }
__device__ __forceinline__ float wave_sum(float v) {
#pragma unroll
    for (int o = 1; o < 64; o <<= 1) v += __shfl_xor(v, o);
    return v;
}
__device__ __forceinline__ float wave_max(float v) {
#pragma unroll
    for (int o = 1; o < 64; o <<= 1) v = fmaxf(v, __shfl_xor(v, o));
    return v;
}
#define XB_TMO      128
#define XB_XCNT(j)  (256  + 64 * (j))
#define XB_XSUB(j)  (1280 + 64 * (j))
#define XB_XGEN(j)  (2304 + 64 * (j))
#define XB_TOP      3328
#define XB_TOPGEN   3392
#define XCD_BAR_WORDS 3456
#define XB_SPIN_CAP (1u << 18)

__device__ __forceinline__ unsigned xb_ld(unsigned* p)              { return __hip_atomic_load(p, __ATOMIC_RELAXED, __HIP_MEMORY_SCOPE_AGENT); }
__device__ __forceinline__ unsigned xb_add(unsigned* p, unsigned v) { return __hip_atomic_fetch_add(p, v, __ATOMIC_RELAXED, __HIP_MEMORY_SCOPE_AGENT); }
__device__ __forceinline__ unsigned xb_xcc_id() { return (unsigned)__builtin_amdgcn_s_getreg((3 << 11) | 20) & 0xFu; }
#define XB_SPIN(cond, bar) do { unsigned _sp = 0; while (cond) { __builtin_amdgcn_s_sleep(1); \
    if ((++_sp & 255u) == 0u) { if (xb_ld(&(bar)[XB_TMO])) break; if (_sp > XB_SPIN_CAP) { atomicAdd(&(bar)[XB_TMO], 1u); break; } } } } while (0)

struct XcdBarrier {
    unsigned* bar; unsigned x;
    volatile LAS unsigned* st;
};

__device__ __forceinline__ XcdBarrier xcd_barrier_post(unsigned* bar, volatile LAS unsigned* st) {
    XcdBarrier b; b.bar = bar; b.x = xb_xcc_id(); b.st = st;
    if (threadIdx.x == 0) (void)xb_add(&bar[XB_XCNT(b.x)], 1u);
    return b;
}
__device__ __forceinline__ void xcd_barrier_complete(unsigned* bar, unsigned x, unsigned& nloc, unsigned& nx) {
    const unsigned G = gridDim.x * gridDim.y * gridDim.z;
    unsigned sum, cnt, mine, sp = 0u;
    for (;;) {
        sum = 0u; cnt = 0u; mine = 0u;
#pragma unroll
        for (unsigned j = 0; j < 16; ++j) { const unsigned c = xb_ld(&bar[XB_XCNT(j)]); sum += c; cnt += (c > 0u) ? 1u : 0u; mine = (j == x) ? c : mine; }
        if (sum == G) break;
        __builtin_amdgcn_s_sleep(1);
        if ((++sp & 255u) == 0u) { if (xb_ld(&bar[XB_TMO])) break; if (sp > XB_SPIN_CAP) { atomicAdd(&bar[XB_TMO], 1u); break; } }
    }
    nloc = mine > 0u ? mine : 1u; nx = cnt > 0u ? cnt : 1u;
}

__device__ __forceinline__ void xcd_barrier(const XcdBarrier& b) {
    asm volatile("s_waitcnt vmcnt(0)" ::: "memory");
    __syncthreads();
    if (threadIdx.x == 0) {
        unsigned* bar = b.bar;
        __builtin_amdgcn_s_waitcnt(0);
        unsigned nloc = b.st[0], nx = b.st[1];
        if (nloc == 0u) { xcd_barrier_complete(bar, b.x, nloc, nx); b.st[0] = nloc; b.st[1] = nx; }
        const unsigned old = xb_add(&bar[XB_XSUB(b.x)], 1u);
        const unsigned gen = old / nloc;
        if (old + 1u == (gen + 1u) * nloc) {
            __builtin_amdgcn_fence(__ATOMIC_RELEASE, "agent");
            asm volatile("s_waitcnt vmcnt(0)" ::: "memory");
            const unsigned og = xb_add(&bar[XB_TOP], 1u);
            const unsigned tg = og / nx;
            if (og + 1u == (tg + 1u) * nx) xb_add(&bar[XB_TOPGEN], 1u);
            else XB_SPIN(xb_ld(&bar[XB_TOPGEN]) == tg, bar);
            __builtin_amdgcn_fence(__ATOMIC_ACQUIRE, "agent");
            xb_add(&bar[XB_XGEN(b.x)], 1u);
            asm volatile("s_waitcnt vmcnt(0)" ::: "memory");
        } else {
            XB_SPIN(xb_ld(&bar[XB_XGEN(b.x)]) == gen, bar);
            __builtin_amdgcn_fence(__ATOMIC_ACQUIRE, "agent");
            asm volatile("s_waitcnt vmcnt(0)" ::: "memory");
        }
    }
    __syncthreads();
}

struct Frame {
    LAS unsigned char* lds; volatile LAS unsigned* MISC; gu32* ctl;
    int tid, lane, wave, vcu, G, bid;
    const float *xp, *xs, *cache_k, *cache_v, *cache_kidx, *state_pool; const int* page_table;
    const float *cp, *cs, *norm_w, *w_ada, *b_ada, *w_in, *qnw, *knw, *w_pool, *pool_scale, *w_out;
    float* out; unsigned char* ws;
#if TEST_MODE == 4 && P3FINE
    unsigned long long* ts; int nst;
#endif
};
#if TEST_MODE == 4 && P3FINE
#define FSTAMP() do { if (blockIdx.x == STAMP_BLK && threadIdx.x == 0) F.ts[F.nst] = __builtin_amdgcn_s_memrealtime(); ++F.nst; } while (0)
#else
#define FSTAMP() do { } while (0)
#endif

struct F3 { float x, y, z; };
__device__ __forceinline__ void split8(const float (&x)[8], bf16x8& hi, bf16x8& lo) {
    unsigned h[4], l[4];
#pragma unroll
    for (int p = 0; p < 4; ++p) { h[p] = pk2(x[2 * p], x[2 * p + 1]);
        l[p] = pk2(x[2 * p] - __uint_as_float(h[p] << 16), x[2 * p + 1] - __uint_as_float(h[p] & 0xffff0000u)); }
    v4u hv, lv; hv.x = h[0]; hv.y = h[1]; hv.z = h[2]; hv.w = h[3]; lv.x = l[0]; lv.y = l[1]; lv.z = l[2]; lv.w = l[3];
    hi = __builtin_bit_cast(bf16x8, hv); lo = __builtin_bit_cast(bf16x8, lv);
}
__device__ __forceinline__ void p0_ada(Frame& F, int task) {
    const int lane = F.lane, w = F.wave, rl = lane & 15, kq = lane >> 4, rg = task >> 6, cg = task & 63, n0 = cg * 48, r0 = rg * 48;
    f32x4 acc[9];
#pragma unroll
    for (int i = 0; i < 9; ++i) acc[i] = (f32x4){0.f, 0.f, 0.f, 0.f};
    const float* wp = F.w_ada + (size_t)(w * 128 + 8 * kq) * 3072 + n0 + 3 * rl;
#pragma unroll
    for (int hf = 0; hf < 2; ++hf) {
        F3 bv[2][8]; f32x4 cv[3][2][2]; bool valid[3];
#pragma unroll
        for (int i2 = 0; i2 < 2; ++i2)
#pragma unroll
            for (int j = 0; j < 8; ++j) bv[i2][j] = *(const F3*)(wp + (size_t)(32 * (2 * hf + i2) + j) * 3072);
#pragma unroll
        for (int rt = 0; rt < 3; ++rt) { const int row = r0 + 16 * rt + rl; valid[rt] = row < NR;
            const float* cptr = (row < NB ? F.cp + (size_t)row * DM : F.cs + (size_t)((valid[rt] ? row : NB) - NB) * DM) + w * 128 + 8 * kq;
#pragma unroll
            for (int i2 = 0; i2 < 2; ++i2) { cv[rt][i2][0] = *(const f32x4*)(cptr + 32 * (2 * hf + i2)); cv[rt][i2][1] = *(const f32x4*)(cptr + 32 * (2 * hf + i2) + 4); } }
#pragma unroll
        for (int i2 = 0; i2 < 2; ++i2) {
            bf16x8 bh[3], bl[3];
            { float x[8];
#pragma unroll
              for (int j = 0; j < 8; ++j) x[j] = bv[i2][j].x;
              split8(x, bh[0], bl[0]);
#pragma unroll
              for (int j = 0; j < 8; ++j) x[j] = bv[i2][j].y;
              split8(x, bh[1], bl[1]);
#pragma unroll
              for (int j = 0; j < 8; ++j) x[j] = bv[i2][j].z;
              split8(x, bh[2], bl[2]); }
#pragma unroll
            for (int rt = 0; rt < 3; ++rt) { float a[8];
#pragma unroll
                for (int j = 0; j < 8; ++j) a[j] = valid[rt] ? pg8::silu1(cv[rt][i2][j >> 2][j & 3]) : 0.f;
                bf16x8 ah, al; split8(a, ah, al);
#pragma unroll
                for (int t = 0; t < 3; ++t) {
                    acc[3 * rt + t] = __builtin_amdgcn_mfma_f32_16x16x32_bf16(ah, bh[t], acc[3 * rt + t], 0, 0, 0);
                    acc[3 * rt + t] = __builtin_amdgcn_mfma_f32_16x16x32_bf16(ah, bl[t], acc[3 * rt + t], 0, 0, 0);
                    acc[3 * rt + t] = __builtin_amdgcn_mfma_f32_16x16x32_bf16(al, bh[t], acc[3 * rt + t], 0, 0, 0); } }
        }
    }
    LAS float* red = (LAS float*)(F.lds + RING_OFF);
#pragma unroll
    for (int rt = 0; rt < 3; ++rt)
#pragma unroll
        for (int t = 0; t < 3; ++t)
#pragma unroll
            for (int e = 0; e < 4; ++e) red[(w * 48 + 16 * rt + 4 * kq + e) * 49 + 3 * rl + t] = acc[3 * rt + t][e];
    __syncthreads();
    float* ada = (float*)(F.ws + WS_ADA);
    for (int o = F.tid; o < 48 * 48; o += NWAVES * 64) { const int row = o / 48, col = o - row * 48; float s = F.b_ada[n0 + col];
#pragma unroll
        for (int ww = 0; ww < 8; ++ww) s += red[(ww * 48 + row) * 49 + col];
        if (r0 + row < NR) ada[(size_t)(r0 + row) * 3072 + n0 + col] = s; }
    __syncthreads();
}
__device__ __forceinline__ void transpose_item(const float* W, int ldn, int srccol0, int nvalid, bf16* WT, int K, int dstrow0, int k0, LAS float* scr, int lane) {
    float tv[32];
#pragma unroll
    for (int i = 0; i < 32; ++i) { const int kk = 2 * i + (lane >> 5), c = lane & 31; tv[i] = c < nvalid ? W[(size_t)(k0 + kk) * ldn + srccol0 + c] : 0.f; }
#pragma unroll
    for (int i = 0; i < 32; ++i) { const int kk = 2 * i + (lane >> 5), c = lane & 31; scr[kk * 33 + c] = tv[i]; }
    LDS_WAIT(); asm volatile("" ::: "memory");
    const int c = lane & 7;
#pragma unroll
    for (int j = 0; j < 4; ++j) { const int n = (lane >> 3) + 8 * j; const LAS float* s = scr + (8 * c) * 33 + n;
        v4u o; o.x = pk2(s[0 * 33], s[1 * 33]); o.y = pk2(s[2 * 33], s[3 * 33]); o.z = pk2(s[4 * 33], s[5 * 33]); o.w = pk2(s[6 * 33], s[7 * 33]);
        *(GAS v4u*)(WT + (size_t)(dstrow0 + n) * K + k0 + 8 * c) = o; }
    LDS_WAIT(); asm volatile("" ::: "memory");
}
__device__ __forceinline__ int win_col(int pn, int hd, int d) {
    if (pn <= 1) return CQ + (4 * pn + hd) * 64 + d;
    if (pn == 2) return hd < 2 ? CK + hd * 64 + d : CV + (hd - 2) * 64 + d;
    if (pn <= 4) return CQI + (4 * (pn - 3) + hd) * 64 + d;
    if (pn == 5) return hd == 0 ? CKI + d : ((hd == 1 && d < 8) ? CWI + d : -1);
    if (pn <= 7) return CGA + (4 * (pn - 6) + hd) * 64 + d;
    if (pn <= 9) return CU + (4 * (pn - 8) + hd) * 64 + d;
    return CGP + (4 * (pn - 10) + hd) * 64 + d;
}
__device__ __forceinline__ void p0_prologue(Frame& F) {
    LAS float* scr = (LAS float*)(F.lds + RING_OFF + F.wave * 16384);
    const int gw = F.vcu * NWAVES + F.wave, NGW = F.G * NWAVES;
    bf16* WINT = (bf16*)(F.ws + WS_WINT); bf16* WOUTT = (bf16*)(F.ws + WS_WOUTT); bf16* WPOOLT = (bf16*)(F.ws + WS_WPOOLT);
    const bool split = F.G > 192 + 16;
    if (split) { if (F.bid < 192) p0_ada(F, F.bid); }
    else { for (int task = F.bid; task < 192; task += F.G) p0_ada(F, task); }
    if (!split || F.bid >= 192) {
        const int tw0 = split ? (F.bid - 192) * NWAVES + F.wave : gw, tws = split ? (F.G - 192) * NWAVES : NGW;
        for (int it = tw0; it < 2080; it += tws) {
            if (it < 1536) { const int G = it >> 4, kb = it & 15, pn = G >> 3, bj = (G >> 2) & 1, hd = G & 3; const int src = win_col(pn, hd, 32 * bj);
                const int nvalid = src < 0 ? 0 : ((pn == 5 && hd == 1) ? 8 : 32);
                transpose_item(F.w_in, NIN, src < 0 ? 0 : src, nvalid, WINT, 1024, 32 * G, 64 * kb, scr, F.lane); }
            else if (it < 2048) { const int r = it - 1536, G = r >> 4, kb = r & 15; transpose_item(F.w_out, 1024, 32 * G, 32, WOUTT, 1024, 32 * G, 64 * kb, scr, F.lane); }
            else { const int r = it - 2048, g = r >> 3, kb = (r >> 2) & 1, G = r & 3; transpose_item(F.w_pool + (size_t)g * 16384, 128, 32 * G, 32, WPOOLT + (size_t)g * 16384, 128, 32 * G, 64 * kb, scr, F.lane); }
        }
    }
    { const int nf4 = DECB * 1792; f32x4 t4[2]; int ix[2];
#pragma unroll
      for (int k = 0; k < 2; ++k) { ix[k] = gw * 64 + F.lane + k * NGW * 64; if (ix[k] < nf4) { const int s = ix[k] / 1792, i = ix[k] - s * 1792; t4[k] = *(const f32x4*)(F.state_pool + (size_t)s * 7680 + 512 + 4 * i); } }
#pragma unroll
      for (int k = 0; k < 2; ++k) { if (ix[k] < nf4) { const int s = ix[k] / 1792, i = ix[k] - s * 1792; *(f32x4*)(F.out + O_PS + (size_t)s * 7680 + 4 * i) = t4[k]; } }
      for (int ixx = gw * 64 + F.lane + 2 * NGW * 64; ixx < nf4; ixx += NGW * 64) { const int s = ixx / 1792, i = ixx - s * 1792; *(f32x4*)(F.out + O_PS + (size_t)s * 7680 + 4 * i) = *(const f32x4*)(F.state_pool + (size_t)s * 7680 + 512 + 4 * i); } }
}

template <int N> __device__ __forceinline__ void norm_rows_load(Frame& F, const float* x0, f32x4 (&v)[N][4]) {
#pragma unroll
    for (int i = 0; i < N; ++i) { const GAS f32x4* xr = (const GAS f32x4*)(x0 + (size_t)i * DM) + F.lane;
#pragma unroll
        for (int j = 0; j < 4; ++j) v[i][j] = xr[64 * j]; }
}
template <int N, bool SAME_ADA> __device__ __forceinline__ void norm_rows_finish(Frame& F, f32x4 (&v)[N][4], const float* adarow0, int adastride, bf16* o0) {
    float s2[N];
#pragma unroll
    for (int i = 0; i < N; ++i) { s2[i] = 0.f;
#pragma unroll
        for (int j = 0; j < 4; ++j) s2[i] += (v[i][j].x * v[i][j].x + v[i][j].y * v[i][j].y) + (v[i][j].z * v[i][j].z + v[i][j].w * v[i][j].w); }
#pragma unroll
    for (int o = 1; o < 64; o <<= 1) {
#pragma unroll
        for (int i = 0; i < N; ++i) s2[i] += __shfl_xor(s2[i], o); }
#pragma unroll
    for (int j = 0; j < 4; ++j) { const int col = 4 * F.lane + 256 * j; const f32x4 nw = *(const f32x4*)(F.norm_w + col);
        f32x4 gq, sh;
        if (SAME_ADA) { sh = *(const f32x4*)(adarow0 + col); gq = nw * (*(const f32x4*)(adarow0 + 1024 + col) + 1.0f); }
#pragma unroll
        for (int i = 0; i < N; ++i) {
            if (!SAME_ADA) { const float* ar = adarow0 + (size_t)i * adastride; sh = *(const f32x4*)(ar + col); gq = nw * (*(const f32x4*)(ar + 1024 + col) + 1.0f); }
            const float rstd = 1.0f / sqrtf(s2[i] * (1.0f / DM) + EPS);
            const f32x4 o = v[i][j] * rstd * gq + sh;
            ((GAS unsigned long long*)(o0 + (size_t)i * DM))[F.lane + 64 * j] = (unsigned long long)pk2(o.x, o.y) | ((unsigned long long)pk2(o.z, o.w) << 32); } }
}
template <int N, bool SAME_ADA> __device__ __forceinline__ void norm_rows(Frame& F, const float* x0, const float* adarow0, int adastride, bf16* o0) {
    f32x4 v[N][4]; norm_rows_load<N>(F, x0, v); norm_rows_finish<N, SAME_ADA>(F, v, adarow0, adastride, o0);
}
template <int NBATCH> __device__ __forceinline__ void skinny_core(const bf16* arow, const bf16* b0, const bf16* b1, const bf16* b2, const bf16* b3, f32x4 (&acc)[4]) {
#pragma unroll
    for (int j = 0; j < 4; ++j) acc[j] = (f32x4){0.f, 0.f, 0.f, 0.f};
    bf16x8 fa[2][4], fb[2][4][4];
#define SK_LOAD(buf, kb) do { _Pragma("unroll") for (int q_ = 0; q_ < 4; ++q_) { const int ko_ = 32 * (4 * (kb) + q_); fa[buf][q_] = *(const bf16x8*)(arow + ko_); \
        fb[buf][q_][0] = *(const bf16x8*)(b0 + ko_); fb[buf][q_][1] = *(const bf16x8*)(b1 + ko_); fb[buf][q_][2] = *(const bf16x8*)(b2 + ko_); fb[buf][q_][3] = *(const bf16x8*)(b3 + ko_); } } while (0)
#define SK_MMA(buf) do { _Pragma("unroll") for (int q_ = 0; q_ < 4; ++q_) { _Pragma("unroll") for (int j_ = 0; j_ < 4; ++j_) acc[j_] = __builtin_amdgcn_mfma_f32_16x16x32_bf16(fa[buf][q_], fb[buf][q_][j_], acc[j_], 0, 0, 0); } } while (0)
    SK_LOAD(0, 0);
#pragma unroll
    for (int kb = 0; kb < NBATCH; kb += 2) {
        SK_LOAD(1, kb + 1); SK_MMA(0);
        if (kb + 2 < NBATCH) SK_LOAD(0, kb + 2);
        SK_MMA(1);
    }
#undef SK_LOAD
#undef SK_MMA
}
__device__ __forceinline__ void sample_inproj(Frame& F, int pn, int hd, int rh) {
    const int lane = F.lane, w = F.wave & 3, kh = F.wave >> 2, rl = lane & 15, kq = lane >> 4;
    const bf16* HS = (const bf16*)(F.ws + WS_HS);
    const bf16* WINT = (const bf16*)(F.ws + WS_WINT);
    const bf16* bb = WINT + (size_t)(256 * pn + 32 * hd + rl) * 1024 + 512 * kh + 8 * kq;
    f32x4 acc[4];
    skinny_core<4>(HS + (size_t)(64 * rh + 16 * w + rl) * 1024 + 512 * kh + 8 * kq, bb, bb + 16 * 1024, bb + 128 * 1024, bb + 144 * 1024, acc);
    { LAS f32x4* red = (LAS f32x4*)(F.lds + RING_OFF);
      if (kh == 1) {
#pragma unroll
          for (int j = 0; j < 4; ++j) red[(w * 4 + j) * 64 + lane] = acc[j]; }
      __syncthreads();
      if (kh == 1) return;
#pragma unroll
      for (int j = 0; j < 4; ++j) acc[j] += red[(w * 4 + j) * 64 + lane]; }
    const int sbase = 64 * rh + 16 * w + 4 * kq;
    float* out = F.out;
    if (pn <= 1 || (pn == 2 && hd < 2)) {
        const float* nwp = pn <= 1 ? F.qnw : F.knw; const float sc = pn <= 1 ? C2 : 1.0f;
#pragma unroll
        for (int e = 0; e < 4; ++e) { float ss = 0.f;
#pragma unroll
            for (int j = 0; j < 4; ++j) ss += acc[j][e] * acc[j][e];
            ss += __shfl_xor(ss, 1); ss += __shfl_xor(ss, 2); ss += __shfl_xor(ss, 4); ss += __shfl_xor(ss, 8);
            const float rstd = 1.0f / sqrtf(ss * (1.0f / 64.0f) + EPS); const int s = sbase + e; const size_t m = (size_t)(MP + s);
#pragma unroll
            for (int j = 0; j < 4; ++j) { const int d = 16 * j + rl; const float o = acc[j][e] * rstd * nwp[d] * sc;
                if (pn <= 1) ((bf16*)(F.ws + WS_Q))[m * 512 + (4 * pn + hd) * 64 + d] = (bf16)f2bf(o);
                else { out[O_KS + (size_t)s * 128 + hd * 64 + d] = o; ((bf16*)(F.ws + WS_KB))[m * 128 + hd * 64 + d] = (bf16)f2bf(o); } } }
        return;
    }
    if (pn == 5 && hd == 1) {
        if (rl < 8) {
#pragma unroll
            for (int e = 0; e < 4; ++e) { const int s = sbase + e; ((float*)(F.ws + WS_WI))[(size_t)(MP + s) * 8 + rl] = acc[0][e] * WI_SCALE; } }
        return;
    }
    bf16* dst; int ld, cb; float* fo = nullptr; int fld = 0; bool act = false;
    if (pn == 2) { dst = (bf16*)(F.ws + WS_VB); ld = 128; cb = (hd - 2) * 64; fo = out + O_VS + cb; fld = 128; }
    else if (pn <= 4) { dst = (bf16*)(F.ws + WS_QI); ld = 512; cb = (4 * (pn - 3) + hd) * 64; }
    else if (pn == 5) { dst = (bf16*)(F.ws + WS_KI); ld = 64; cb = 0; fo = out + O_KIS; fld = 64; }
    else if (pn <= 7) { dst = (bf16*)(F.ws + WS_GA); ld = 512; cb = (4 * (pn - 6) + hd) * 64; act = true; }
    else if (pn <= 9) { dst = (bf16*)(F.ws + WS_U); ld = 512; cb = (4 * (pn - 8) + hd) * 64; fo = out + O_PS + 14 * 512 + cb; fld = 15 * 512; }
    else { dst = (bf16*)(F.ws + WS_GP); ld = 512; cb = (4 * (pn - 10) + hd) * 64; act = true; }
#pragma unroll
    for (int e = 0; e < 4; ++e) { const int s = sbase + e; const size_t m = (size_t)(MP + s);
#pragma unroll
        for (int j = 0; j < 4; ++j) { const int d = 16 * j + rl; float o = acc[j][e]; if (act) o = pg8::silu1(o);
            dst[m * ld + cb + d] = (bf16)f2bf(o);
            if (fo) fo[(size_t)s * fld + d] = o; } }
}
struct P1Pre { f32x4 v[2][4][4]; };
__device__ __forceinline__ void p1_prefetch(Frame& F, P1Pre& pre) {
    const int gw = F.vcu * NWAVES + F.wave, NGW = F.G * NWAVES;
#pragma unroll
    for (int k = 0; k < 2; ++k) { const int ch = gw + k * NGW; if (ch < MP / 4) norm_rows_load<4>(F, F.xp + (size_t)(4 * ch) * DM, pre.v[k]); }
}
__device__ __forceinline__ void p1_norm(Frame& F, P1Pre& pre) {
    const float* ada = (const float*)(F.ws + WS_ADA); bf16* HB = (bf16*)(F.ws + WS_HB); bf16* HS = (bf16*)(F.ws + WS_HS);
    const int gw = F.vcu * NWAVES + F.wave, NGW = F.G * NWAVES;
#pragma unroll
    for (int k = 0; k < 2; ++k) { const int ch = gw + k * NGW; if (ch < MP / 4) { const int m = 4 * ch; norm_rows_finish<4, true>(F, pre.v[k], ada + (size_t)(m >> 11) * 3072, 0, HB + (size_t)m * DM); } }
    for (int ch = gw + 2 * NGW; ch < MP / 4 + DECB / 2; ch += NGW) {
        if (ch < MP / 4) { const int m = 4 * ch; norm_rows<4, true>(F, F.xp + (size_t)m * DM, ada + (size_t)(m >> 11) * 3072, 0, HB + (size_t)m * DM); }
        else { const int s = 2 * (ch - MP / 4); norm_rows<2, false>(F, F.xs + (size_t)s * DM, ada + (size_t)(NB + s) * 3072, 3072, HS + (size_t)s * DM); } }
}
__device__ __forceinline__ void p2_sample(Frame& F) {
    const int task = F.bid >> 1, pn = task >> 2, hd = task & 3;
    if (F.bid < 96 && !(pn == 5 && hd >= 2)) { sample_inproj(F, pn, hd, F.bid & 1); __syncthreads(); }
}

constexpr int P3_KEYS = 0;
constexpr int P3_BM = 132096;
constexpr int P3_WQ = 136192;
constexpr int P3_QI = 136704;
constexpr int P3_AI_HS = 144, P3_AI_RS = 1152;
constexpr int P3_AQ_HS = 160, P3_AQ_RS = 1408;
constexpr int P3_QL = 159232;
constexpr int P3_XM = 159232;
constexpr int P3_VW = 0, P3_VWB = 4096;

__device__ __forceinline__ float relu_s(float x) { return __builtin_amdgcn_fmed3f(x, 0.0f, __builtin_inff()); }
__device__ __forceinline__ unsigned f2key(float f) { unsigned u = __float_as_uint(f); if (f == 0.0f) u = 0u; return (u & 0x80000000u) ? ~u : (u | 0x80000000u); }
__device__ __forceinline__ float key2f(unsigned k) { return __uint_as_float((k & 0x80000000u) ? (k ^ 0x80000000u) : ~k); }

__device__ __forceinline__ unsigned half_reduce_add(unsigned v) {
    v += (unsigned)__builtin_amdgcn_update_dpp(0, (int)v, 0xB1, 0xF, 0xF, true);
    v += (unsigned)__builtin_amdgcn_update_dpp(0, (int)v, 0x4E, 0xF, 0xF, true);
    v += (unsigned)__builtin_amdgcn_update_dpp(0, (int)v, 0x141, 0xF, 0xF, true);
    v += (unsigned)__builtin_amdgcn_update_dpp(0, (int)v, 0x140, 0xF, 0xF, true);
    v += (unsigned)__builtin_amdgcn_ds_swizzle((int)v, 0x401F);
    return v;
}
__device__ __forceinline__ float probit_f(float p) {
    const float pp = p < 0.5f ? p : 1.0f - p; const float t = sqrtf(-2.0f * __logf(pp));
    const float z = t - (2.515517f + t * (0.802853f + t * 0.010328f)) * __builtin_amdgcn_rcpf(1.0f + t * (1.432788f + t * (0.189269f + t * 0.001308f)));
    return p < 0.5f ? -z : z;
}
__device__ __forceinline__ unsigned half_reduce_min(unsigned v) {
    v = min(v, (unsigned)__builtin_amdgcn_update_dpp(0, (int)v, 0xB1, 0xF, 0xF, true)); v = min(v, (unsigned)__builtin_amdgcn_update_dpp(0, (int)v, 0x4E, 0xF, 0xF, true));
    v = min(v, (unsigned)__builtin_amdgcn_update_dpp(0, (int)v, 0x141, 0xF, 0xF, true)); v = min(v, (unsigned)__builtin_amdgcn_update_dpp(0, (int)v, 0x140, 0xF, 0xF, true));
    v = min(v, (unsigned)__builtin_amdgcn_ds_swizzle((int)v, 0x401F)); return v; }
__device__ __forceinline__ unsigned half_reduce_max(unsigned v) {
    v = max(v, (unsigned)__builtin_amdgcn_update_dpp(0, (int)v, 0xB1, 0xF, 0xF, true)); v = max(v, (unsigned)__builtin_amdgcn_update_dpp(0, (int)v, 0x4E, 0xF, 0xF, true));
    v = max(v, (unsigned)__builtin_amdgcn_update_dpp(0, (int)v, 0x141, 0xF, 0xF, true)); v = max(v, (unsigned)__builtin_amdgcn_update_dpp(0, (int)v, 0x140, 0xF, 0xF, true));
    v = max(v, (unsigned)__builtin_amdgcn_ds_swizzle((int)v, 0x401F)); return v; }
__device__ __forceinline__ unsigned wave_reduce_add_u(unsigned v) {
    v += (unsigned)__builtin_amdgcn_update_dpp(0, (int)v, 0xB1, 0xF, 0xF, true); v += (unsigned)__builtin_amdgcn_update_dpp(0, (int)v, 0x4E, 0xF, 0xF, true);
    v += (unsigned)__builtin_amdgcn_update_dpp(0, (int)v, 0x141, 0xF, 0xF, true); v += (unsigned)__builtin_amdgcn_update_dpp(0, (int)v, 0x140, 0xF, 0xF, true);
    return ((unsigned)__builtin_amdgcn_readlane((int)v, 0) + (unsigned)__builtin_amdgcn_readlane((int)v, 16)) + ((unsigned)__builtin_amdgcn_readlane((int)v, 32) + (unsigned)__builtin_amdgcn_readlane((int)v, 48)); }
__device__ __forceinline__ float row16_sum(float v) {
    v += __int_as_float(__builtin_amdgcn_update_dpp(0, __float_as_int(v), 0xB1, 0xF, 0xF, true)); v += __int_as_float(__builtin_amdgcn_update_dpp(0, __float_as_int(v), 0x4E, 0xF, 0xF, true));
    v += __int_as_float(__builtin_amdgcn_update_dpp(0, __float_as_int(v), 0x141, 0xF, 0xF, true)); v += __int_as_float(__builtin_amdgcn_update_dpp(0, __float_as_int(v), 0x140, 0xF, 0xF, true));
    return v; }
__device__ __forceinline__ float kq_max(float v) {
    auto a = __builtin_amdgcn_permlane16_swap(__float_as_uint(v), __float_as_uint(v), false, false); v = fmaxf(__uint_as_float(a[0]), __uint_as_float(a[1]));
    auto b = __builtin_amdgcn_permlane32_swap(__float_as_uint(v), __float_as_uint(v), false, false); return fmaxf(__uint_as_float(b[0]), __uint_as_float(b[1])); }
__device__ __forceinline__ float kq_sum(float v) {
    auto a = __builtin_amdgcn_permlane16_swap(__float_as_uint(v), __float_as_uint(v), false, false); v = __uint_as_float(a[0]) + __uint_as_float(a[1]);
    auto b = __builtin_amdgcn_permlane32_swap(__float_as_uint(v), __float_as_uint(v), false, false); return __uint_as_float(b[0]) + __uint_as_float(b[1]); }
__device__ __forceinline__ unsigned wave_reduce_min_u(unsigned v) { v = half_reduce_min(v); return min((unsigned)__builtin_amdgcn_readlane((int)v, 0), (unsigned)__builtin_amdgcn_readlane((int)v, 32)); }
__device__ __forceinline__ unsigned wave_reduce_max_u(unsigned v) { v = half_reduce_max(v); return max((unsigned)__builtin_amdgcn_readlane((int)v, 0), (unsigned)__builtin_amdgcn_readlane((int)v, 32)); }

struct P3Pre { v4u qi[2]; v4u qq[2]; float wqv; };
__device__ __forceinline__ void p3_prefetch(Frame& F, int b, int qt, P3Pre& pre) {
    const int tid = F.tid; const size_t mb = (size_t)b * SEQ; const int t0 = 16 * qt;
    const bf16* QI = (const bf16*)(F.ws + WS_QI); const bf16* Qg = (const bf16*)(F.ws + WS_Q);
#pragma unroll
    for (int k = 0; k < 2; ++k) { const int i = tid + 512 * k, row = i >> 6, ch = i & 63;
        pre.qi[k] = *(const v4u*)(QI + (mb + t0 + row) * 512 + ch * 8); pre.qq[k] = *(const v4u*)(Qg + (mb + t0 + row) * 512 + ch * 8); }
    pre.wqv = ((const float*)(F.ws + WS_WI))[(mb + t0 + ((tid & 127) >> 3)) * 8 + (tid & 7)];
}
__device__ __forceinline__ void p3_prompt_item(Frame& F, int b, int qt, P3Pre& pre, bool has_next, int nb, int nqt) {
    int tid_o_ = F.tid; asm volatile("" : "+v"(tid_o_));
    const int tid = tid_o_, lane = tid & 63, w = F.wave, r = lane & 31, hh = lane >> 5;
    const int t0 = 16 * qt, L = t0 + 16, nkt32 = (L + 31) >> 5, nkt64 = (L + 63) >> 6;
    const size_t mb = (size_t)b * SEQ;
    LAS unsigned* bm = (LAS unsigned*)(F.lds + P3_BM);
    LAS float* wq = (LAS float*)(F.lds + P3_WQ);
    LAS unsigned* keys = (LAS unsigned*)(F.lds + P3_KEYS);
    v4u qreg[2] = {pre.qq[0], pre.qq[1]};
    if (tid < 128) wq[tid] = pre.wqv;
#pragma unroll
    for (int k = 0; k < 2; ++k) { const int i = tid + 512 * k, row = i >> 6, ch = i & 63; *(LAS v4u*)(F.lds + P3_QI + row * P3_AI_RS + (ch >> 3) * P3_AI_HS + (ch & 7) * 16) = pre.qi[k]; }
    bf16x8 bb[3][4];
    { const bf16* KI_ = (const bf16*)(F.ws + WS_KI); const int ns_ = (nkt32 - w + 7) >> 3;
      if (0 < ns_) { const bf16* kp_ = KI_ + (mb + 32 * w + r) * 64 + 8 * hh;
#pragma unroll
          for (int ks_ = 0; ks_ < 4; ++ks_) bb[0][ks_] = *(const bf16x8*)(kp_ + 16 * ks_); }
      if (1 < ns_) { const bf16* kp_ = KI_ + (mb + 32 * (w + 8) + r) * 64 + 8 * hh;
#pragma unroll
          for (int ks_ = 0; ks_ < 4; ++ks_) bb[1][ks_] = *(const bf16x8*)(kp_ + 16 * ks_); } }
    __syncthreads();
    { LAS unsigned short* ql = (LAS unsigned short*)(F.lds + P3_QL);
#pragma unroll
      for (int k = 0; k < 2; ++k) { const int i = tid + 512 * k, qq = i >> 6, d = i & 63; float s = 0.f;
#pragma unroll
          for (int h = 0; h < 8; ++h) s += wq[qq * 8 + h] * bf2f(*(const LAS unsigned short*)(F.lds + P3_QI + qq * P3_AI_RS + h * P3_AI_HS + d * 2));
          ql[qq * 64 + d] = (unsigned short)f2bf(s); } }
    __syncthreads();
    FSTAMP();
    for (int rep1_ = 0; rep1_ < REP_S1; ++rep1_) {
        const bf16* KI = (const bf16*)(F.ws + WS_KI);
        const int ns = (nkt32 - w + 7) >> 3;
#define P3_LDK(slot) do { const bf16* kp_ = KI + (mb + 32 * (w + 8 * (slot)) + r) * 64 + 8 * hh; \
        _Pragma("unroll") for (int ks_ = 0; ks_ < 4; ++ks_) bb[(slot) % 3][ks_] = *(const bf16x8*)(kp_ + 16 * ks_); } while (0)
        const int arow = (2 * ((r >> 2) & 1) + (r >> 4)) * P3_AI_RS + ((r & 3) + 4 * ((r >> 3) & 1)) * P3_AI_HS + 16 * hh;
        const LAS unsigned char* qib = F.lds + P3_QI;
        const int lq_ = 4 * ((((r & 3) + 4 * (r >> 3)) >> 1) & 3) + 2 * ((r >> 2) & 1) + (r & 1);
        const LAS unsigned char* qlb = F.lds + P3_QL + lq_ * 128 + 16 * hh;
#define P3_MM(ACC, a, s) do { _Pragma("unroll") for (int e_ = 0; e_ < 16; ++e_) ACC[e_] = 0.f; \
        _Pragma("unroll") for (int ks_ = 0; ks_ < 4; ++ks_) { const bf16x8 af_ = *(const LAS bf16x8*)(qs_ + 4 * (a) * P3_AI_RS + arow + 32 * ks_); \
            ACC = __builtin_amdgcn_mfma_f32_32x32x16_bf16(af_, bb[(s) % 3][ks_], ACC, 0, 0, 0); } } while (0)
#define P3_EPI(ACC, a, s, u_) do { _Pragma("unroll") for (int j2_ = 0; j2_ < 2; ++j2_) { const int qq_ = 4 * (a) + 2 * hh + j2_; \
        const LAS f32x4* wp_ = (const LAS f32x4*)(wq + qq_ * 8); const f32x4 w0_ = wp_[0], w1_ = wp_[1]; \
        float sc_ = accL[2 * (a) + j2_]; sc_ = fmaf(w0_[0], fabsf(ACC[8 * j2_ + 0]), sc_); sc_ = fmaf(w0_[1], fabsf(ACC[8 * j2_ + 1]), sc_); sc_ = fmaf(w0_[2], fabsf(ACC[8 * j2_ + 2]), sc_); sc_ = fmaf(w0_[3], fabsf(ACC[8 * j2_ + 3]), sc_); \
        sc_ = fmaf(w1_[0], fabsf(ACC[8 * j2_ + 4]), sc_); sc_ = fmaf(w1_[1], fabsf(ACC[8 * j2_ + 5]), sc_); sc_ = fmaf(w1_[2], fabsf(ACC[8 * j2_ + 6]), sc_); sc_ = fmaf(w1_[3], fabsf(ACC[8 * j2_ + 7]), sc_); \
        keys[qq_ * 2048 + 32 * (w + 8 * (s)) + r] = f2key(sc_); } } while (0)
#define P3_MML(ACC, s) do { _Pragma("unroll") for (int e_ = 0; e_ < 16; ++e_) ACC[e_] = 0.f; \
        _Pragma("unroll") for (int ks_ = 0; ks_ < 4; ++ks_) { bf16x8 af_ = (bf16x8){0, 0, 0, 0, 0, 0, 0, 0}; if (r < 16) af_ = *(const LAS bf16x8*)(qlb + zo_ + 32 * ks_); \
            ACC = __builtin_amdgcn_mfma_f32_32x32x16_bf16(af_, bb[(s) % 3][ks_], ACC, 0, 0, 0); } } while (0)
#pragma unroll 1
        for (int s0 = 0; s0 < ns; s0 += 3) {
#pragma unroll
            for (int u = 0; u < 3; ++u) { const int s = s0 + u;
                if (s < ns) {
                    if (s + 2 < ns) { const bf16* kp_ = KI + (mb + 32 * (w + 8 * (s + 2)) + r) * 64 + 8 * hh;
#pragma unroll
                        for (int ks_ = 0; ks_ < 4; ++ks_) bb[(u + 2) % 3][ks_] = *(const bf16x8*)(kp_ + 16 * ks_); }
                    int zo_ = 0; asm volatile("" : "+v"(zo_));
                    const LAS unsigned char* qs_ = qib + zo_;
                    f32x16 accA, accB, accL;
                    P3_MML(accL, u);
                    P3_MM(accA, 0, u); P3_MM(accB, 1, u);
                    P3_EPI(accA, 0, s, u); P3_MM(accA, 2, u);
                    P3_EPI(accB, 1, s, u); P3_MM(accB, 3, u);
                    P3_EPI(accA, 2, s, u); P3_EPI(accB, 3, s, u);
                }
            }
        }
#undef P3_MM
#undef P3_MML
#undef P3_EPI
#undef P3_LDK
    }
    __syncthreads();
    FSTAMP();
    {
#pragma unroll
      for (int k = 0; k < 2; ++k) { const int i = tid + 512 * k, row = i >> 6, ch = i & 63; *(LAS v4u*)(F.lds + P3_QI + row * P3_AQ_RS + (ch >> 3) * P3_AQ_HS + (ch & 7) * 16) = qreg[k]; } }
    bf16x8 kf0[2][2]; v4u vr0[4];
    { const int g_ = w & 1, kq4_ = w >> 1, j_ = lane & 15, kq_ = lane >> 4;
      if (kq4_ < nkt32) {
#pragma unroll
          for (int c = 0; c < 2; ++c)
#pragma unroll
              for (int ks = 0; ks < 2; ++ks) kf0[c][ks] = *(const bf16x8*)((const bf16*)(F.ws + WS_KB) + (mb + 32 * kq4_ + 16 * c + j_) * 128 + g_ * 64 + 32 * ks + 8 * kq_);
#pragma unroll
          for (int i = 0; i < 4; ++i) vr0[i] = *(const v4u*)((const bf16*)(F.ws + WS_VB) + (mb + 32 * kq4_ + 8 * i + (lane >> 3)) * 128 + g_ * 64 + (lane & 7) * 8); } }
    for (int rep2_ = 0; rep2_ < REP_S2; ++rep2_) {
        int lane_ = F.lane; asm volatile("" : "+v"(lane_));
#define lane lane_
        const int qx0 = 2 * w, tq0 = t0 + qx0;
        unsigned sel0, sel1;
        if (t0 + 16 <= 256) {
            sel0 = 0u; sel1 = 0u;
#pragma unroll
            for (int jj = 0; jj < 32; ++jj) { sel0 |= (64 * jj + lane <= tq0) ? (1u << jj) : 0u; sel1 |= (64 * jj + lane <= tq0 + 1) ? (1u << jj) : 0u; }
        } else {
            unsigned x[32], y[32];
#pragma unroll
            for (int jj = 0; jj < 32; ++jj) { const int l = 64 * jj + lane; x[jj] = (l <= tq0) ? keys[qx0 * 2048 + l] : 0u; y[jj] = (l <= tq0 + 1) ? keys[(qx0 + 1) * 2048 + l] : 0u; }
#pragma unroll
            for (int st = 0; st < 5; ++st) { const int j = 16 >> st; const unsigned m = st == 0 ? 0x0000ffffu : st == 1 ? 0x00ff00ffu : st == 2 ? 0x0f0f0f0fu : st == 3 ? 0x33333333u : 0x55555555u;
#pragma unroll
                for (int k = 0; k < 32; ++k) if (!(k & j)) { const unsigned t_ = ((x[k] >> j) ^ x[k + j]) & m; x[k] ^= t_ << j; x[k + j] ^= t_;
                    const unsigned u_ = ((y[k] >> j) ^ y[k + j]) & m; y[k] ^= u_ << j; y[k + j] ^= u_; } }
            unsigned cur0 = 0xffffffffu, gt0 = 0u, cur1 = 0xffffffffu, gt1 = 0u; int ab0 = 0, ab1 = 0;
#pragma unroll
            for (int b = 31; b >= 0; --b) { const unsigned c0 = cur0 & x[b], c1 = cur1 & y[b];
                const unsigned pk = wave_reduce_add_u((unsigned)__popc(c0) | ((unsigned)__popc(c1) << 16)); const int n0 = (int)(pk & 0xffffu), n1 = (int)(pk >> 16);
                if (ab0 + n0 >= 256) cur0 = c0; else { ab0 += n0; gt0 |= c0; cur0 &= ~x[b]; }
                if (ab1 + n1 >= 256) cur1 = c1; else { ab1 += n1; gt1 |= c1; cur1 &= ~y[b]; } }
            const unsigned pke = wave_reduce_add_u((unsigned)__popc(cur0) | ((unsigned)__popc(cur1) << 16));
            const unsigned long long lt = (1ull << lane) - 1ull;
            { int need = 256 - ab0; if ((int)(pke & 0xffffu) == need) sel0 = gt0 | cur0;
              else { sel0 = gt0;
                for (int jj = 0; jj < 32; ++jj) { const unsigned long long meq = __ballot((cur0 >> jj) & 1u);
                    if (((cur0 >> jj) & 1u) && __popcll(meq & lt) < need) sel0 |= 1u << jj;
                    const int pc_ = __popcll(meq); need = need > pc_ ? need - pc_ : 0; } } }
            { int need = 256 - ab1; if ((int)(pke >> 16) == need) sel1 = gt1 | cur1;
              else { sel1 = gt1;
                for (int jj = 0; jj < 32; ++jj) { const unsigned long long meq = __ballot((cur1 >> jj) & 1u);
                    if (((cur1 >> jj) & 1u) && __popcll(meq & lt) < need) sel1 |= 1u << jj;
                    const int pc_ = __popcll(meq); need = need > pc_ ? need - pc_ : 0; } } }
        }
#pragma unroll
        for (int jj = 0; jj < 32; ++jj) { const unsigned long long b0 = __ballot((sel0 >> jj) & 1u), b1 = __ballot((sel1 >> jj) & 1u);
            if (lane == 0) { bm[qx0 * 64 + 2 * jj] = (unsigned)b0; bm[qx0 * 64 + 2 * jj + 1] = (unsigned)(b0 >> 32); bm[(qx0 + 1) * 64 + 2 * jj] = (unsigned)b1; bm[(qx0 + 1) * 64 + 2 * jj + 1] = (unsigned)(b1 >> 32); } }
#undef lane
    }
    __syncthreads();
#if TEST_MODE
    { unsigned* dbg = (unsigned*)(F.ws + WS_DBG_BM) + (mb + t0) * 64; for (int i = tid; i < 1024; i += NWAVES * 64) dbg[i] = bm[i]; }
#endif
    FSTAMP();
    for (int rep4_ = 0; rep4_ < REP_S4; ++rep4_) {
        int l4_ = lane; asm volatile("" : "+v"(l4_));
        const int g = w & 1, kq4 = w >> 1, j = l4_ & 15, kq = l4_ >> 4;
        const bf16* Q = (const bf16*)(F.ws + WS_Q); const bf16* KB = (const bf16*)(F.ws + WS_KB); const bf16* VB = (const bf16*)(F.ws + WS_VB);
        const LAS unsigned char* qlb = F.lds + P3_QI + (j >> 2) * P3_AQ_RS + (4 * g + (j & 3)) * P3_AQ_HS + 16 * kq;
        bf16x8 qf[4][2];
#pragma unroll
        for (int rb = 0; rb < 4; ++rb)
#pragma unroll
            for (int ks = 0; ks < 2; ++ks) qf[rb][ks] = *(const LAS bf16x8*)(qlb + 4 * rb * P3_AQ_RS + 64 * ks);
        f32x4 o[4][4];
#pragma unroll
        for (int dt = 0; dt < 4; ++dt)
#pragma unroll
            for (int rb = 0; rb < 4; ++rb) o[dt][rb] = (f32x4){0.f, 0.f, 0.f, 0.f};
        float mref[4], lsum[4]; f32x4 negm[4];
#pragma unroll
        for (int rb = 0; rb < 4; ++rb) { mref[rb] = 0.f; lsum[rb] = 0.f; negm[rb] = (f32x4){0.f, 0.f, 0.f, 0.f}; }
        const int ntw = (nkt32 - kq4 + 3) >> 2;
        LAS unsigned char* vst = F.lds + P3_VW + w * (3 * P3_VWB);
        bf16x8 kf[2][2];
        const bf16* kgp = KB + (mb + j) * 128 + g * 64 + 8 * kq;
        const bf16* vgp = VB + (mb + (l4_ >> 3)) * 128 + g * 64 + (l4_ & 7) * 8;
#define P4_LOADK(dst, kt_) do { _Pragma("unroll") for (int c_ = 0; c_ < 2; ++c_) _Pragma("unroll") for (int ks_ = 0; ks_ < 2; ++ks_) dst[c_][ks_] = *(const bf16x8*)(kgp + (size_t)(32 * (kt_) + 16 * c_) * 128 + 32 * ks_); } while (0)
        const unsigned vst_u = (unsigned)(size_t)vst;
#define P4_DMAV(kt_, buf_) do { _Pragma("unroll") for (int i_ = 0; i_ < 4; ++i_) { unsigned keep_; const void* gs_ = (const void*)(vgp + (size_t)(32 * (kt_) + 8 * i_) * 128); \
        const unsigned ld_ = (unsigned)__builtin_amdgcn_readfirstlane((int)(vst_u + (buf_) * P3_VWB + i_ * 1024)); \
        asm volatile("s_mov_b32 %0, m0\n\ts_mov_b32 m0, %2\n\ts_nop 0\n\tglobal_load_lds_dwordx4 %1, off\n\ts_mov_b32 m0, %0" : "=&s"(keep_) : "v"(gs_), "s"(ld_) : "memory"); } } while (0)
        if (ntw > 0) {
#pragma unroll
            for (int c = 0; c < 2; ++c) { kf[c][0] = kf0[c][0]; kf[c][1] = kf0[c][1]; }
#pragma unroll
            for (int i = 0; i < 4; ++i) *(LAS v4u*)(vst + i * 1024 + l4_ * 16) = vr0[i]; }
        if (ntw > 1) { P4_DMAV(kq4 + 4, 1); }
        int vb_cur = 0;
#if TEST_MODE == 5
        unsigned long long tacc_[5] = {0, 0, 0, 0, 0}; unsigned long long tprev_ = __builtin_amdgcn_s_memtime();
#define TSEC(i) do { __builtin_amdgcn_sched_barrier(0); const unsigned long long tn_ = __builtin_amdgcn_s_memtime(); tacc_[i] += tn_ - tprev_; tprev_ = tn_; __builtin_amdgcn_sched_barrier(0); } while (0)
#else
#define TSEC(i) do { } while (0)
#endif
        for (int ti = 0; ti < ntw; ++ti) {
            const int kt = kq4 + 4 * ti;
            TSEC(4);
            asm volatile("s_waitcnt vmcnt(0)" ::: "memory");
            const int vb_n2 = vb_cur == 0 ? 2 : vb_cur - 1;
            if (ti + 2 < ntw) { P4_DMAV(kt + 8, vb_n2); }
            TSEC(0);
            f32x4 sa[2][4];
#pragma unroll
            for (int c = 0; c < 2; ++c)
#pragma unroll
                for (int ks = 0; ks < 2; ++ks)
#pragma unroll
                    for (int rb = 0; rb < 4; ++rb) sa[c][rb] = __builtin_amdgcn_mfma_f32_16x16x32_bf16(kf[c][ks], qf[rb][ks], ks == 0 ? negm[rb] : sa[c][rb], 0, 0, 0);
            if (ti + 1 < ntw) { P4_LOADK(kf, kt + 4); }
            TSEC(1);
            float tmax[4];
#pragma unroll
            for (int rb = 0; rb < 4; ++rb) { const int wd = (int)(bm[(4 * rb + (j >> 2)) * 64 + kt] >> (4 * kq)); float tm = -INFINITY;
#pragma unroll
                for (int c = 0; c < 2; ++c)
#pragma unroll
                    for (int e = 0; e < 4; ++e) { const unsigned keep = (unsigned)__builtin_amdgcn_sbfe(wd, 16 * c + e, 1);
                        const float v = __uint_as_float((__float_as_uint(sa[c][rb][e]) & keep) | (0xff800000u & ~keep)); sa[c][rb][e] = v; tm = fmaxf(tm, v); }
                tmax[rb] = tm; }
#pragma unroll
            for (int rb = 0; rb < 4; ++rb) tmax[rb] = kq_max(tmax[rb]);
            if (ti == 0 || __any(tmax[0] > 0.f || tmax[1] > 0.f || tmax[2] > 0.f || tmax[3] > 0.f)) {
#pragma unroll
                for (int rb = 0; rb < 4; ++rb) { const float dl = (ti == 0) ? ((tmax[rb] == -INFINITY) ? 0.f : tmax[rb]) : fmaxf(tmax[rb], 0.f); const float alpha = __builtin_amdgcn_exp2f(-dl); mref[rb] += dl; lsum[rb] *= alpha;
                    negm[rb] = (f32x4){-mref[rb], -mref[rb], -mref[rb], -mref[rb]};
#pragma unroll
                    for (int c = 0; c < 2; ++c) sa[c][rb] -= dl;
#pragma unroll
                    for (int dt = 0; dt < 4; ++dt) o[dt][rb] *= alpha; } }
            bf16x8 pf[4];
#pragma unroll
            for (int rb = 0; rb < 4; ++rb) { float ps = 0.f;
#pragma unroll
                for (int c = 0; c < 2; ++c)
#pragma unroll
                    for (int e = 0; e < 4; ++e) { const float p = __builtin_amdgcn_exp2f(sa[c][rb][e]); sa[c][rb][e] = p; ps += p; }
                lsum[rb] += ps;
                v4u pw; pw.x = pk2(sa[0][rb][0], sa[0][rb][1]); pw.y = pk2(sa[0][rb][2], sa[0][rb][3]); pw.z = pk2(sa[1][rb][0], sa[1][rb][1]); pw.w = pk2(sa[1][rb][2], sa[1][rb][3]);
                pf[rb] = __builtin_bit_cast(bf16x8, pw); }
            TSEC(2);
            { const LAS unsigned char* vb = vst + vb_cur * P3_VWB + (4 * kq + (j >> 2)) * 128 + (4 * (j & 3)) * 2;
              typedef short v4i16_t __attribute__((ext_vector_type(4)));
#pragma unroll
              for (int dt = 0; dt < 4; ++dt) {
                  const v4i16_t lo4 = __builtin_amdgcn_ds_read_tr16_b64_v4i16((LAS v4i16_t*)(vb + 32 * dt));
                  const v4i16_t hi4 = __builtin_amdgcn_ds_read_tr16_b64_v4i16((LAS v4i16_t*)(vb + 32 * dt + 16 * 128));
                  const bf16x8 vf = (bf16x8){lo4[0], lo4[1], lo4[2], lo4[3], hi4[0], hi4[1], hi4[2], hi4[3]};
#pragma unroll
                  for (int rb = 0; rb < 4; ++rb) o[dt][rb] = __builtin_amdgcn_mfma_f32_16x16x32_bf16(vf, pf[rb], o[dt][rb], 0, 0, 0); } }
            TSEC(3);
            vb_cur = vb_cur == 2 ? 0 : vb_cur + 1;
        }
#undef P4_LOADK
#if TEST_MODE == 5
        if (blockIdx.x == STAMP_BLK && threadIdx.x == 0) { unsigned* st_ = (unsigned*)(F.ws + WS_CTL + 900 * 1024); for (int i_ = 0; i_ < 5; ++i_) atomicAdd(st_ + 8 + i_, (unsigned)(tacc_[i_] >> 4)); atomicAdd(st_ + 13, (unsigned)ntw); }
#endif
#undef TSEC
#undef P4_DMAV
#pragma unroll
        for (int rb = 0; rb < 4; ++rb) lsum[rb] = kq_sum(lsum[rb]);
        if (has_next && rep4_ == REP_S4 - 1) p3_prefetch(F, nb, nqt, pre);
        const size_t mrow_m = mb + t0 + 4 * kq4 + (j >> 2); const int hd_m = 4 * g + (j & 3);
        v2u gvm[4];
#pragma unroll
        for (int dt = 0; dt < 4; ++dt) gvm[dt] = *(const v2u*)((const bf16*)(F.ws + WS_GA) + mrow_m * 512 + hd_m * 64 + 16 * dt + 4 * kq);
        __syncthreads();
        {
            LAS unsigned char* xo = F.lds + ((g * 4 + kq4) * 4) * 4096; LAS float* xm = (LAS float*)(F.lds + P3_XM) + ((g * 4 + kq4) * 4) * 32;
#pragma unroll
            for (int rb = 0; rb < 4; ++rb) {
#pragma unroll
                for (int dt = 0; dt < 4; ++dt) *(LAS f32x4*)(xo + rb * 4096 + dt * 1024 + l4_ * 16) = o[dt][rb];
                if (kq == 0) { xm[rb * 32 + j] = (lsum[rb] > 0.f) ? mref[rb] : -INFINITY; xm[rb * 32 + 16 + j] = lsum[rb]; } }
        }
        __syncthreads();
        {
            const int rb = kq4; float ms[4], ls[4]; float M = -INFINITY;
#pragma unroll
            for (int s4 = 0; s4 < 4; ++s4) { const LAS float* xm = (const LAS float*)(F.lds + P3_XM) + ((g * 4 + s4) * 4 + rb) * 32; ms[s4] = xm[j]; ls[s4] = xm[16 + j]; M = fmaxf(M, ms[s4]); }
            float Lt = 0.f; f32x4 oo[4];
#pragma unroll
            for (int dt = 0; dt < 4; ++dt) oo[dt] = (f32x4){0.f, 0.f, 0.f, 0.f};
#pragma unroll
            for (int s4 = 0; s4 < 4; ++s4) { const float sc = __builtin_amdgcn_exp2f(ms[s4] - M); Lt += ls[s4] * sc;
                const LAS unsigned char* xo = F.lds + (((g * 4 + s4) * 4) + rb) * 4096;
#pragma unroll
                for (int dt = 0; dt < 4; ++dt) oo[dt] += *(const LAS f32x4*)(xo + dt * 1024 + l4_ * 16) * sc; }
            const float inv = 1.0f / Lt;
            const size_t mrow = mrow_m; const int hd = hd_m;
            bf16* MIX = (bf16*)(F.ws + WS_MIX);
#pragma unroll
            for (int dt = 0; dt < 4; ++dt) { const int d = 16 * dt + 4 * kq; const v2u gv = gvm[dt];
                const float g0 = bf2f((unsigned short)(gv.x & 0xffffu)), g1 = bf2f((unsigned short)(gv.x >> 16)), g2 = bf2f((unsigned short)(gv.y & 0xffffu)), g3 = bf2f((unsigned short)(gv.y >> 16));
                v2u ov; ov.x = pk2(oo[dt][0] * inv * g0, oo[dt][1] * inv * g1); ov.y = pk2(oo[dt][2] * inv * g2, oo[dt][3] * inv * g3);
                *(v2u*)(MIX + mrow * 1024 + hd * 64 + d) = ov; }
        }
        if (REP_S4 > 1) __syncthreads();
    }
}

constexpr int PL_U = 0, PL_W = 40960, PL_STRIDE = 272;
template <bool SAMPLE> __device__ __forceinline__ void p3_pool_item(Frame& F, int item) {
    const int tid = F.tid, lane = F.lane, w = F.wave, j = lane & 15, kq = lane >> 4;
    const bf16* U = (const bf16*)(F.ws + WS_U); const bf16* GP = (const bf16*)(F.ws + WS_GP); const bf16* WPT = (const bf16*)(F.ws + WS_WPOOLT); bf16* MIX = (bf16*)(F.ws + WS_MIX);
    const int tokb = SAMPLE ? 0 : (item & 15) * 128;
    const size_t m0 = SAMPLE ? (size_t)MP : (size_t)(item >> 4) * SEQ + tokb;
    const int tl = 16 * w + j;
    const size_t mrow = m0 + tl;
    v4u wr_[4], ur_[5];
#define PL_LOAD(gg) do { _Pragma("unroll") for (int k_ = 0; k_ < 4; ++k_) { const int i_ = tid + 512 * k_; wr_[k_] = *(const v4u*)(WPT + (size_t)(gg) * 16384 + (i_ >> 4) * 128 + (i_ & 15) * 8); } \
        if (!SAMPLE) { _Pragma("unroll") for (int k_ = 0; k_ < 5; ++k_) { const int i_ = tid + 512 * k_; const int row_ = i_ >> 4, ch_ = i_ & 15; ur_[k_] = (v4u){0u, 0u, 0u, 0u}; \
            if (i_ < 143 * 16 && tokb - 15 + row_ >= 0) ur_[k_] = *(const v4u*)(U + (m0 - 15 + row_) * 512 + (gg) * 128 + ch_ * 8); } } } while (0)
#define PL_STORE() do { _Pragma("unroll") for (int k_ = 0; k_ < 4; ++k_) { const int i_ = tid + 512 * k_; *(LAS v4u*)(F.lds + PL_W + (i_ >> 4) * PL_STRIDE + (i_ & 15) * 16) = wr_[k_]; } \
        if (!SAMPLE) { _Pragma("unroll") for (int k_ = 0; k_ < 5; ++k_) { const int i_ = tid + 512 * k_; if (i_ < 143 * 16) *(LAS v4u*)(F.lds + PL_U + (i_ >> 4) * PL_STRIDE + (i_ & 15) * 16) = ur_[k_]; } } } while (0)
    PL_LOAD(0);
#pragma unroll
    for (int g = 0; g < 4; ++g) {
        const int win = 2 << g;
        PL_STORE();
        __syncthreads();
        if (g + 1 < 4) PL_LOAD(g + 1);
        bf16x8 df[4];
#pragma unroll
        for (int ks = 0; ks < 4; ++ks) {
            float sum[8], cur[8];
            if (!SAMPLE) {
                const LAS unsigned char* up = F.lds + PL_U + (15 + tl) * PL_STRIDE + (4 * ks + kq) * 16;
                { const v4u c = *(const LAS v4u*)up;
#pragma unroll
                  for (int u = 0; u < 4; ++u) { const unsigned x = c[u]; cur[2 * u] = bf2f((unsigned short)(x & 0xffffu)); cur[2 * u + 1] = bf2f((unsigned short)(x >> 16)); sum[2 * u] = cur[2 * u]; sum[2 * u + 1] = cur[2 * u + 1]; } }
#pragma unroll
                for (int i = 1; i < win; ++i) { const v4u c = *(const LAS v4u*)(up - i * PL_STRIDE);
#pragma unroll
                    for (int u = 0; u < 4; ++u) { const unsigned x = c[u]; sum[2 * u] += bf2f((unsigned short)(x & 0xffffu)); sum[2 * u + 1] += bf2f((unsigned short)(x >> 16)); } }
            } else {
                const int c0 = g * 128 + 32 * ks + 8 * kq;
                { const v4u c = *(const v4u*)(U + mrow * 512 + c0);
#pragma unroll
                  for (int u = 0; u < 4; ++u) { const unsigned x = c[u]; cur[2 * u] = bf2f((unsigned short)(x & 0xffffu)); cur[2 * u + 1] = bf2f((unsigned short)(x >> 16)); sum[2 * u] = cur[2 * u]; sum[2 * u + 1] = cur[2 * u + 1]; } }
#pragma unroll
                for (int i = 1; i < win; ++i) { const float* sp = F.state_pool + ((size_t)tl * 15 + (15 - i)) * 512 + c0; const f32x4 a = *(const f32x4*)sp, bq = *(const f32x4*)(sp + 4);
                    sum[0] += a[0]; sum[1] += a[1]; sum[2] += a[2]; sum[3] += a[3]; sum[4] += bq[0]; sum[5] += bq[1]; sum[6] += bq[2]; sum[7] += bq[3]; }
            }
            const int tpos = tokb + tl; const float rc = 1.0f / (float)(SAMPLE ? win : ((tpos + 1 < win) ? tpos + 1 : win));
            v4u pw; pw.x = pk2(sum[0] * rc - cur[0], sum[1] * rc - cur[1]); pw.y = pk2(sum[2] * rc - cur[2], sum[3] * rc - cur[3]);
            pw.z = pk2(sum[4] * rc - cur[4], sum[5] * rc - cur[5]); pw.w = pk2(sum[6] * rc - cur[6], sum[7] * rc - cur[7]);
            df[ks] = __builtin_bit_cast(bf16x8, pw);
        }
#pragma unroll
        for (int jt = 0; jt < 8; ++jt) {
            f32x4 acc = (f32x4){0.f, 0.f, 0.f, 0.f};
#pragma unroll
            for (int ks = 0; ks < 4; ++ks) { const bf16x8 wf = *(const LAS bf16x8*)(F.lds + PL_W + (16 * jt + j) * PL_STRIDE + (4 * ks + kq) * 16);
                acc = __builtin_amdgcn_mfma_f32_16x16x32_bf16(wf, df[ks], acc, 0, 0, 0); }
            const int col = g * 128 + 16 * jt + 4 * kq;
            const f32x4 ps = *(const f32x4*)(F.pool_scale + col); const v2u gv = *(const v2u*)(GP + mrow * 512 + col);
            const float g0 = bf2f((unsigned short)(gv.x & 0xffffu)), g1 = bf2f((unsigned short)(gv.x >> 16)), g2 = bf2f((unsigned short)(gv.y & 0xffffu)), g3 = bf2f((unsigned short)(gv.y >> 16));
            v2u ov; ov.x = pk2(acc[0] * ps[0] * g0, acc[1] * ps[1] * g1); ov.y = pk2(acc[2] * ps[2] * g2, acc[3] * ps[3] * g3);
            *(v2u*)(MIX + mrow * 1024 + 512 + col) = ov;
        }
        __syncthreads();
    }
#undef PL_LOAD
#undef PL_STORE
}

constexpr int SM_SC = 0, SM_SEL = 8448, SM_Q = 9472, SM_P = 11520, SM_RED = 19712, SM_PT = 36096;
__device__ __forceinline__ void p3_sample_item(Frame& F, int s) {
    const int tid = F.tid, lane = F.lane, w = F.wave, r = lane & 31, hh = lane >> 5;
    const size_t m = (size_t)MP + s;
    LAS float* sc = (LAS float*)(F.lds + SM_SC); LAS int* sel = (LAS int*)(F.lds + SM_SEL); LAS float* ql = (LAS float*)(F.lds + SM_Q);
    LAS float* pl = (LAS float*)(F.lds + SM_P); LAS float* red = (LAS float*)(F.lds + SM_RED); LAS int* ptl = (LAS int*)(F.lds + SM_PT);
    const bf16* QI = (const bf16*)(F.ws + WS_QI) + m * 512; const float* WIp = (const float*)(F.ws + WS_WI) + m * 8;
    const int* pt = F.page_table + s * NPG;
    ql[tid] = bf2f(((const bf16*)(F.ws + WS_Q))[m * 512 + tid]);
    if (tid < NPG) ptl[tid] = pt[tid];
    {
        bf16x8 af[4];
#pragma unroll
        for (int ks = 0; ks < 4; ++ks) { af[ks] = (bf16x8){0, 0, 0, 0, 0, 0, 0, 0}; if (r < 8) af[ks] = *(const bf16x8*)(QI + r * 64 + 16 * ks + 8 * hh); }
        float wv[4];
#pragma unroll
        for (int e = 0; e < 4; ++e) wv[e] = WIp[4 * hh + e];
        int pg[8];
#pragma unroll
        for (int it = 0; it < 8; ++it) pg[it] = pt[(w + 8 * it) >> 2];
#pragma unroll
        for (int hf = 0; hf < 2; ++hf) {
            f32x4 x0[4][4], x1[4][4];
#pragma unroll
            for (int i4 = 0; i4 < 4; ++i4) { const int kt = w + 8 * (4 * hf + i4);
                const float* kp = F.cache_kidx + ((size_t)pg[4 * hf + i4] * PAGE + (kt & 3) * 32 + r) * 64 + 8 * hh;
#pragma unroll
                for (int ks = 0; ks < 4; ++ks) { x0[i4][ks] = *(const f32x4*)(kp + 16 * ks); x1[i4][ks] = *(const f32x4*)(kp + 16 * ks + 4); } }
#pragma unroll
            for (int i4 = 0; i4 < 4; ++i4) { const int kt = w + 8 * (4 * hf + i4);
                f32x16 acc;
#pragma unroll
                for (int e = 0; e < 16; ++e) acc[e] = 0.f;
#pragma unroll
                for (int ks = 0; ks < 4; ++ks) {
                    v4u pw; pw.x = pk2(x0[i4][ks][0], x0[i4][ks][1]); pw.y = pk2(x0[i4][ks][2], x0[i4][ks][3]); pw.z = pk2(x1[i4][ks][0], x1[i4][ks][1]); pw.w = pk2(x1[i4][ks][2], x1[i4][ks][3]);
                    acc = __builtin_amdgcn_mfma_f32_32x32x16_bf16(af[ks], __builtin_bit_cast(bf16x8, pw), acc, 0, 0, 0); }
                float part = wv[0] * fmaxf(acc[0], 0.f) + wv[1] * fmaxf(acc[1], 0.f) + wv[2] * fmaxf(acc[2], 0.f) + wv[3] * fmaxf(acc[3], 0.f);
                part += __shfl_xor(part, 32);
                if (hh == 0) sc[32 * kt + r] = part; }
        }
        if (w == 0) {
            const float kv = bf2f(((const bf16*)(F.ws + WS_KI))[m * 64 + lane]); float tot = 0.f;
#pragma unroll
            for (int h = 0; h < 8; ++h) { const float d = wave_sum(bf2f(QI[h * 64 + lane]) * kv); tot += WIp[h] * fmaxf(d, 0.f); }
            if (lane == 0) sc[PAST] = tot;
        }
    }
    __syncthreads();
    if (w == 0) {
        unsigned x[32];
#pragma unroll
        for (int jj = 0; jj < 32; ++jj) x[jj] = f2key(sc[64 * jj + lane]);
        const unsigned ke = (unsigned)__builtin_amdgcn_readfirstlane((int)f2key(sc[PAST]));
#pragma unroll
        for (int st = 0; st < 5; ++st) { const int j = 16 >> st; const unsigned mk = st == 0 ? 0x0000ffffu : st == 1 ? 0x00ff00ffu : st == 2 ? 0x0f0f0f0fu : st == 3 ? 0x33333333u : 0x55555555u;
#pragma unroll
            for (int k = 0; k < 32; ++k) if (!(k & j)) { const unsigned t_ = ((x[k] >> j) ^ x[k + j]) & mk; x[k] ^= t_ << j; x[k + j] ^= t_; } }
        unsigned cur = 0xffffffffu, gt = 0u; int ab = 0; bool ecur = true, egt = false;
#pragma unroll
        for (int b = 31; b >= 0; --b) { const unsigned c0 = cur & x[b]; const bool eb = ecur && ((ke >> b) & 1u);
            const int n = (int)wave_reduce_add_u((unsigned)__popc(c0)) + (eb ? 1 : 0);
            if (ab + n >= 256) { cur = c0; ecur = eb; } else { ab += n; gt |= c0; egt = egt || eb; cur &= ~x[b]; ecur = ecur && !eb; } }
        const int neq = (int)wave_reduce_add_u((unsigned)__popc(cur)); int need = 256 - ab;
        const bool take_e = egt || (ecur && need > neq);
        const unsigned long long lt = (1ull << lane) - 1ull;
        unsigned selm = gt;
        if (neq <= need) selm |= cur;
        else {
            for (int jj = 0; jj < 32; ++jj) { const unsigned long long meq = __ballot((cur >> jj) & 1u);
                if (((cur >> jj) & 1u) && __popcll(meq & lt) < need) selm |= 1u << jj;
                const int pc_ = __popcll(meq); need = need > pc_ ? need - pc_ : 0; } }
        int pos = 0;
#pragma unroll
        for (int jj = 0; jj < 32; ++jj) { const bool take = (selm >> jj) & 1u; const unsigned long long mt = __ballot(take);
            if (take) sel[pos + __popcll(mt & lt)] = ptl[jj >> 1] * PAGE + ((64 * jj + lane) & 127);
            pos += __popcll(mt); }
        if (take_e && lane == 0) sel[pos] = -1;
    }
    __syncthreads();
    {
        const int c4 = 4 * (lane & 31), g = (lane >> 4) & 1, rp = lane >> 5;
        f32x4 kv[16], vv[16];
#pragma unroll
        for (int i = 0; i < 16; ++i) { const int pr = sel[32 * w + 2 * i + rp];
            const float* krow = pr >= 0 ? F.cache_k + (size_t)pr * 128 : F.out + O_KS + (size_t)s * 128; kv[i] = *(const f32x4*)(krow + c4); }
#pragma unroll
        for (int i = 0; i < 16; ++i) { const int pr = sel[32 * w + 2 * i + rp];
            const float* vrow = pr >= 0 ? F.cache_v + (size_t)pr * 128 : F.out + O_VS + (size_t)s * 128; vv[i] = *(const f32x4*)(vrow + c4); }
        f32x4 qv[4];
#pragma unroll
        for (int rr = 0; rr < 4; ++rr) qv[rr] = *(const LAS f32x4*)(ql + (4 * g + rr) * 64 + 4 * (lane & 15));
#pragma unroll
        for (int i = 0; i < 16; ++i) {
#pragma unroll
            for (int rr = 0; rr < 4; ++rr) { float p = (qv[rr][0] * kv[i][0] + qv[rr][1] * kv[i][1]) + (qv[rr][2] * kv[i][2] + qv[rr][3] * kv[i][3]);
                p = row16_sum(p);
                if ((lane & 15) == 0) pl[(4 * g + rr) * 256 + 32 * w + 2 * i + rp] = p; } }
        __syncthreads();
        {
            float v[4]; float mx = -INFINITY;
#pragma unroll
            for (int i = 0; i < 4; ++i) { v[i] = pl[w * 256 + lane + 64 * i]; mx = fmaxf(mx, v[i]); }
            mx = wave_max(mx); float sm = 0.f;
#pragma unroll
            for (int i = 0; i < 4; ++i) { v[i] = __builtin_amdgcn_exp2f(v[i] - mx); sm += v[i]; }
            sm = wave_sum(sm); const float inv = 1.0f / sm;
#pragma unroll
            for (int i = 0; i < 4; ++i) pl[w * 256 + lane + 64 * i] = v[i] * inv;
        }
        __syncthreads();
        f32x4 acc[4];
#pragma unroll
        for (int rr = 0; rr < 4; ++rr) acc[rr] = (f32x4){0.f, 0.f, 0.f, 0.f};
#pragma unroll
        for (int i = 0; i < 16; ++i) {
#pragma unroll
            for (int rr = 0; rr < 4; ++rr) { const float p = pl[(4 * g + rr) * 256 + 32 * w + 2 * i + rp];
                acc[rr][0] += p * vv[i][0]; acc[rr][1] += p * vv[i][1]; acc[rr][2] += p * vv[i][2]; acc[rr][3] += p * vv[i][3]; } }
#pragma unroll
        for (int rr = 0; rr < 4; ++rr) {
#pragma unroll
            for (int c = 0; c < 4; ++c) acc[rr][c] += __shfl_xor(acc[rr][c], 32);
            if (rp == 0) *(LAS f32x4*)(red + ((w * 8 + 4 * g + rr) * 64) + 4 * (lane & 15)) = acc[rr]; }
    }
    __syncthreads();
    { const int h = tid >> 6, d = tid & 63; float a = 0.f;
#pragma unroll
        for (int k8 = 0; k8 < 8; ++k8) a += red[(k8 * 8 + h) * 64 + d];
        const float gate = bf2f(((const bf16*)(F.ws + WS_GA))[m * 512 + tid]);
        ((bf16*)(F.ws + WS_MIX))[m * 1024 + tid] = (bf16)f2bf(a * gate); }
    { const int c = tid, g = c >> 7, win = 2 << g; const float un = bf2f(((const bf16*)(F.ws + WS_U))[m * 512 + c]); float sum = un;
      const float* sp = F.state_pool + (size_t)s * 15 * 512 + c;
      float hv[15];
#pragma unroll
      for (int i = 1; i < 16; ++i) hv[i - 1] = sp[(size_t)(15 - i) * 512];
#pragma unroll
      for (int i = 1; i < 16; ++i) sum += (i < win) ? hv[i - 1] : 0.f;
      ql[c] = bf2f((unsigned short)f2bf(sum / (float)win - un)); }
    __syncthreads();
    { const int col = tid, g = col >> 7, j = col & 127; const bf16* wr = (const bf16*)(F.ws + WS_WPOOLT) + (size_t)g * 16384 + j * 128;
      v4u wv4[16];
#pragma unroll
      for (int i = 0; i < 16; ++i) wv4[i] = *(const v4u*)(wr + 8 * i);
      float acc = 0.f;
#pragma unroll
      for (int i = 0; i < 16; ++i) { const LAS f32x4* dp = (const LAS f32x4*)(ql + g * 128 + 8 * i); const f32x4 d0 = dp[0], d1 = dp[1];
          acc += d0[0] * bf2f((unsigned short)(wv4[i].x & 0xffffu)) + d0[1] * bf2f((unsigned short)(wv4[i].x >> 16)) + d0[2] * bf2f((unsigned short)(wv4[i].y & 0xffffu)) + d0[3] * bf2f((unsigned short)(wv4[i].y >> 16));
          acc += d1[0] * bf2f((unsigned short)(wv4[i].z & 0xffffu)) + d1[1] * bf2f((unsigned short)(wv4[i].z >> 16)) + d1[2] * bf2f((unsigned short)(wv4[i].w & 0xffffu)) + d1[3] * bf2f((unsigned short)(wv4[i].w >> 16)); }
      const float gp = bf2f(((const bf16*)(F.ws + WS_GP))[m * 512 + col]);
      ((bf16*)(F.ws + WS_MIX))[m * 1024 + 512 + col] = (bf16)f2bf(acc * F.pool_scale[col] * gp); }
    __syncthreads();
}

__device__ __forceinline__ void p3_mixer(Frame& F) {
    P3Pre pre; int cb, cqt; bool cv;
#define P3_ITEM(i_, ok_, b_, qt_) do { if (F.G == 256) { ok_ = (i_) < 4; \
            const int idx_ = F.bid >> 3, i2_ = idx_ & 15, pi_ = i2_ + 16 * (((i_) >> 1) & 1), grp_ = pi_ >> 4, k_ = pi_ & 15; const bool light_ = idx_ < 16; \
            const int x1_ = (k_ & 7) + 16 * (k_ >> 3) + (light_ ? 0 : 8), sm_ = grp_ ? 32 + x1_ : (light_ ? k_ : 16 + k_), sum_ = grp_ ? (light_ ? 119 : 135) : (light_ ? 111 : 143); \
            b_ = F.bid & 7; qt_ = ((i_) & 1) ? sm_ : sum_ - sm_; } \
        else { const int p_ = F.bid + ((i_) >> 1) * F.G; ok_ = p_ < 512; b_ = (p_ >> 6) & 7; qt_ = ((i_) & 1) ? (p_ & 63) : 127 - (p_ & 63); } } while (0)
    P3_ITEM(0, cv, cb, cqt);
    if (cv) p3_prefetch(F, cb, cqt, pre);
#pragma unroll 1
    for (int i = 0; cv; ++i) {
        int nb, nqt; bool nv;
        P3_ITEM(i + 1, nv, nb, nqt);
        p3_prompt_item(F, cb, cqt, pre, nv, nb, nqt); __syncthreads(); FSTAMP();
        cv = nv; cb = nb; cqt = nqt;
    }
#undef P3_ITEM
    for (int x = F.bid; x < 128; x += F.G) { for (int rp_ = 0; rp_ < REP_SMP; ++rp_) { p3_sample_item(F, x); __syncthreads(); } FSTAMP(); }
    for (int x = F.bid + ((F.bid < 128) ? ((128 - F.bid + F.G - 1) / F.G) * F.G : 0); x < 256; x += F.G) { for (int rp_ = 0; rp_ < REP_POOL; ++rp_) { p3_pool_item<false>(F, x - 128); __syncthreads(); } FSTAMP(); }
}
struct P4SPre { bf16x8 fb[32]; };
__device__ __forceinline__ void p4_sample_prefetch(Frame& F, P4SPre& pre) {
    if (F.bid >= 64) return;
    const int rl = F.lane & 15, kq = F.lane >> 4, n0 = F.bid * 16;
    const bf16* bp = (const bf16*)(F.ws + WS_WOUTT) + (size_t)(n0 + rl) * 1024 + 8 * kq;
#pragma unroll
    for (int i = 0; i < 32; ++i) pre.fb[i] = *(const bf16x8*)(bp + 32 * i);
}
__device__ __forceinline__ void p4_sample_out(Frame& F, P4SPre& pre) {
    if (F.bid >= 64) return;
    const int lane = F.lane, w = F.wave, rl = lane & 15, kq = lane >> 4, n0 = F.bid * 16;
    const bf16* ap = (const bf16*)(F.ws + WS_MIX) + (size_t)(MP + 16 * w + rl) * 1024 + 8 * kq;
    const float* ada = (const float*)(F.ws + WS_ADA);
    float xv[4], gv[4];
#pragma unroll
    for (int e = 0; e < 4; ++e) { const int s = 16 * w + 4 * kq + e, n = n0 + rl; xv[e] = F.xs[(size_t)s * 1024 + n]; gv[e] = ada[(size_t)(NB + s) * 3072 + 2048 + n]; }
    f32x4 acc = (f32x4){0.f, 0.f, 0.f, 0.f};
    bf16x8 fa[32];
#pragma unroll
    for (int i = 0; i < 32; ++i) fa[i] = *(const bf16x8*)(ap + 32 * i);
#pragma unroll
    for (int i = 0; i < 32; ++i) acc = __builtin_amdgcn_mfma_f32_16x16x32_bf16(fa[i], pre.fb[i], acc, 0, 0, 0);
#pragma unroll
    for (int e = 0; e < 4; ++e) { const int s = 16 * w + 4 * kq + e, n = n0 + rl; F.out[O_YS + (size_t)s * 1024 + n] = xv[e] + gv[e] * acc[e]; }
}

struct Args { const float* in[18]; float* out; unsigned char* ws; int ph_lo, ph_hi, li, pad; };
__global__ void __launch_bounds__(NWAVES * 64, 2) mk_fwd(Args args) {
    extern __shared__ __attribute__((aligned(16))) unsigned char lds[];
    Frame F;
    F.lds = (LAS unsigned char*)lds;
    F.MISC = (volatile LAS unsigned*)(F.lds + MISC_OFF);
    F.tid = threadIdx.x; F.lane = F.tid & 63; F.wave = __builtin_amdgcn_readfirstlane(F.tid >> 6);
    F.G = gridDim.x; F.bid = blockIdx.x; { const int bx = blockIdx.x; F.vcu = (F.G % 8 == 0) ? (bx % 8) * (F.G / 8) + bx / 8 : bx; }
    F.ws = args.ws; F.out = args.out; F.ctl = (gu32*)(args.ws + WS_CTL);
    F.xp = args.in[0]; F.xs = args.in[1]; F.cache_k = args.in[2]; F.cache_v = args.in[3]; F.cache_kidx = args.in[4]; F.state_pool = args.in[5];
    F.page_table = (const int*)args.in[6]; F.cp = args.in[7]; F.cs = args.in[8]; F.norm_w = args.in[9]; F.w_ada = args.in[10]; F.b_ada = args.in[11];
    F.w_in = args.in[12]; F.qnw = args.in[13]; F.knw = args.in[14]; F.w_pool = args.in[15]; F.pool_scale = args.in[16]; F.w_out = args.in[17];
    for (int u = F.tid; u < (LDS_BYTES - LDSCTL_OFF) / 4; u += NWAVES * 64) ((LAS unsigned*)(F.lds + LDSCTL_OFF))[u] = 0u;
    __syncthreads();
    XcdBarrier bar = xcd_barrier_post((unsigned*)(F.ctl + CW_BAR) + args.li * XCD_BAR_WORDS, F.MISC + 8);
    const int lo = args.ph_lo, hi = args.ph_hi;
#if TEST_MODE == 4
    unsigned long long* ts = (unsigned long long*)(args.ws + WS_CTL + 768 * 1024); int nst = 0;
#define STAMP() do { if (blockIdx.x == STAMP_BLK && threadIdx.x == 0) ts[nst] = __builtin_amdgcn_s_memrealtime(); ++nst; } while (0)
#if P3FINE
    F.ts = ts + 16; F.nst = 0;
#endif
#else
#define STAMP() do { } while (0)
#endif
    STAMP();
#define IN(k) (lo <= (k) && (k) < hi)
#define BOTH(k) (IN(k) && IN((k) + 1))
    P1Pre p1pre;
    if (IN(0)) { for (int rp_ = 0; rp_ < REP_P0; ++rp_) { p0_prologue(F); if (rp_ + 1 < REP_P0) __syncthreads(); }
#if TEST_MODE == 6 && BSITE == 1
        if (threadIdx.x == 0) ((unsigned long long*)(F.ws + WS_CTL + 800 * 1024))[blockIdx.x] = __builtin_amdgcn_s_memrealtime();
#endif
        STAMP(); if (IN(1)) p1_prefetch(F, p1pre); if (BOTH(0)) xcd_barrier(bar); STAMP(); }
    else if (IN(1)) p1_prefetch(F, p1pre);
    if (IN(1)) { for (int rp_ = 0; rp_ < REP_P1; ++rp_) p1_norm(F, p1pre); STAMP(); if (BOTH(1)) xcd_barrier(bar); STAMP(); }
    if (IN(2)) {
        for (int rp_ = 0; rp_ < REP_P2S; ++rp_) p2_sample(F);
        pg8::Gemm g{(const pg8::bf16_t*)(F.ws + WS_HB), (const pg8::bf16_t*)(F.ws + WS_WINT), MP, 3072, DM};
        pg8::StaticOrder S; S.init(MP, 3072, F.G, (int)blockIdx.x);
        pg8::EpiIn E{F.ws, F.out, F.qnw, F.knw};
        for (int rp_ = 0; rp_ < REP_P2G; ++rp_) pg8::gemm_phase<pg8::EpiIn, pg8::StaticOrder, true, true>(F.lds + RING_OFF, g, S, E);
        STAMP(); if (BOTH(2)) xcd_barrier(bar); STAMP();
    }
#if HAVE_P3
    P4SPre p4pre;
    if (IN(3)) { p3_mixer(F);
#if TEST_MODE == 6 && BSITE == 0
        if (threadIdx.x == 0) ((unsigned long long*)(F.ws + WS_CTL + 800 * 1024))[blockIdx.x] = __builtin_amdgcn_s_memrealtime();
#endif
        STAMP(); if (IN(4)) p4_sample_prefetch(F, p4pre); if (BOTH(3)) xcd_barrier(bar); STAMP(); }
    else if (IN(4)) p4_sample_prefetch(F, p4pre);
#endif
    if (IN(4)) {
        for (int rp_ = 0; rp_ < REP_P4S; ++rp_) p4_sample_out(F, p4pre);
        pg8::Gemm g{(const pg8::bf16_t*)(F.ws + WS_MIX), (const pg8::bf16_t*)(F.ws + WS_WOUTT), MP, DM, DM};
        pg8::StaticOrder S; S.init(MP, DM, F.G, (int)blockIdx.x);
        pg8::EpiOut E{F.xp, F.out + O_YP, (const float*)(F.ws + WS_ADA)};
        for (int rp_ = 0; rp_ < REP_P4G; ++rp_) pg8::gemm_phase<pg8::EpiOut, pg8::StaticOrder, true, true>(F.lds + RING_OFF, g, S, E);
        STAMP(); STAMP();
    }
#undef IN
#undef BOTH
}

#if TEST_MODE
__global__ void __launch_bounds__(256) k_cmp(const void* a, int a_bf16, int lda, const float* ref, int ldr, int rows, int cols, float scale, int act, float* accum) {
    __shared__ float sd[256], sr[256];
    const size_t idx = (size_t)blockIdx.x * 256 + threadIdx.x; float d2 = 0.f, r2 = 0.f;
    if (idx < (size_t)rows * cols) { const size_t r = idx / cols, c = idx % cols;
        const float av = a_bf16 ? bf2f(((const bf16*)a)[r * lda + c]) : ((const float*)a)[r * lda + c];
        float rv = ref[r * ldr + c]; if (act) rv = rv / (1.f + expf(-rv)); rv *= scale;
        d2 = (av - rv) * (av - rv); r2 = rv * rv; if (!(d2 == d2)) d2 = 1e30f; }
    sd[threadIdx.x] = d2; sr[threadIdx.x] = r2; __syncthreads();
    for (int s = 128; s > 0; s >>= 1) { if ((int)threadIdx.x < s) { sd[threadIdx.x] += sd[threadIdx.x + s]; sr[threadIdx.x] += sr[threadIdx.x + s]; } __syncthreads(); }
    if (threadIdx.x == 0) { atomicAdd(accum, sd[0]); atomicAdd(accum + 1, sr[0]); }
}
__global__ void __launch_bounds__(256) k_cmp_sel(const int* SEL, const int* NSEL, const unsigned* bmdump, float* accum) {
    __shared__ float sd[256], sr[256];
    const size_t idx = (size_t)blockIdx.x * 256 + threadIdx.x; const int m = (int)(idx >> 8), i = (int)(idx & 255); float miss = 0.f, tot = 0.f;
    if (m < MP && i < NSEL[m]) { const int l = SEL[(size_t)m * 256 + i]; tot = 1.f; if (!((bmdump[(size_t)m * 64 + (l >> 5)] >> (l & 31)) & 1u)) miss = 1.f; }
    sd[threadIdx.x] = miss; sr[threadIdx.x] = tot; __syncthreads();
    for (int s = 128; s > 0; s >>= 1) { if ((int)threadIdx.x < s) { sd[threadIdx.x] += sd[threadIdx.x + s]; sr[threadIdx.x] += sr[threadIdx.x + s]; } __syncthreads(); }
    if (threadIdx.x == 0) { atomicAdd(accum, sd[0]); atomicAdd(accum + 1, sr[0]); }
}
__global__ void k_cmp_fin2(float* accum, int n, float amp) {
    float best = -1.f; int bi = 0;
    for (int k = 0; k < n; ++k) { const float rel = accum[2 * k] / fmaxf(accum[2 * k + 1], 1e-30f) / accum[32 + k]; if (rel > best) { best = rel; bi = k; } }
    accum[64] = sqrtf(amp * best); accum[65] = (float)bi;
}
__global__ void k_set(float* p, float a, float b, float c, float d, float e) { p[0] = a; p[1] = b; p[2] = c; p[3] = d; p[4] = e; }
__global__ void k_cmp_fin(float* accum, int n, float amp) {
    float best = -1.f; int bi = 0;
    for (int k = 0; k < n; ++k) { const float rel = accum[2 * k] / fmaxf(accum[2 * k + 1], 1e-30f); if (rel > best) { best = rel; bi = k; } }
    accum[64] = sqrtf(amp * best); accum[65] = (float)bi;
}
__global__ void __launch_bounds__(256) k_perturb(float* out, const float* accum) {
    const size_t offs[11] = {O_YP, O_YS, O_KP, O_VP, O_KIP, O_PP, O_KS, O_VS, O_KIS, O_PS, O_END};
    const int k = (int)accum[65] % 10; const float f = 1.0f + accum[64];
    for (size_t i = offs[k] + (size_t)blockIdx.x * 256 + threadIdx.x; i < offs[k + 1]; i += (size_t)gridDim.x * 256) out[i] *= f;
}
__global__ void __launch_bounds__(256) k_f32_to_bf16(const float* src, bf16* dst, size_t n) {
    for (size_t i = (size_t)blockIdx.x * 256 + threadIdx.x; i < n; i += (size_t)gridDim.x * 256) dst[i] = (bf16)f2bf(src[i]);
}
#endif

#if TEST_MODE == 5
__global__ void __launch_bounds__(256) k_stat(float* out, const unsigned* st, int which) {
    float v = which == 0 ? (float)st[0] : (which == 1 ? (float)st[1] / fmaxf((float)st[2], 1.f) : (which < 8 ? (float)st[3] : (which == 13 ? (float)st[13] : (float)st[which] * (16.0f / 1000.0f))));
    const float f = 1.0f + sqrtf(v * 1e-5f);
    for (size_t i = O_KS + (size_t)blockIdx.x * 256 + threadIdx.x; i < O_VS; i += (size_t)gridDim.x * 256) out[i] *= f;
}
#endif
#if TEST_MODE == 6
__global__ void __launch_bounds__(256) k_blk(float* out, const unsigned long long* tb, int sel, float scale) {
    unsigned long long mx = 0; int am = 0;
    for (int i = 0; i < 256; ++i) if (tb[i] > mx) { mx = tb[i]; am = i; }
    float us = 0.f;
    if (sel == 3) us = (float)(am >> 4); else if (sel == 4) us = (float)(am & 15);
    else { double s = 0; int n = 0; for (int i = 0; i < 256; ++i) { const bool in = sel == 1 ? i < 128 : sel == 2 ? i >= 128 : sel >= 10 && sel < 18 ? (i & 7) == sel - 10 : sel >= 20 && sel < 52 ? (i >> 3) == sel - 20 : true; if (in) { s += (double)(mx - tb[i]); ++n; } } us = (float)(s / n) * 0.01f; }
    const float f = 1.0f + sqrtf(us * scale);
    for (size_t i = O_KS + (size_t)blockIdx.x * 256 + threadIdx.x; i < O_VS; i += (size_t)gridDim.x * 256) out[i] *= f;
}
#endif
#if TEST_MODE == 4
__global__ void __launch_bounds__(256) k_time(float* out, const unsigned long long* ts, int i0, int i1, float scale) {
    const float us = (float)(ts[i1] - ts[i0]) * 0.01f; const float f = 1.0f + sqrtf(us * scale);
    for (size_t i = O_KS + (size_t)blockIdx.x * 256 + threadIdx.x; i < O_VS; i += (size_t)gridDim.x * 256) out[i] *= f;
}
#endif
extern "C" void kernel_launch(void* const* d_in, const int* in_sizes, int n_in, void* d_out, int out_size, void* d_ws, size_t ws_size, hipStream_t stream) {
    static int grid = 0;
    if (grid == 0) {
        size_t need = WS_MEGA_END;
#if TEST_MODE && TEST_MODE < 4
        need = 192 * MiB + gold::W_END * 4;
#endif
        if (n_in != 18 || out_size != (int)O_END || ws_size < need) { fprintf(stderr, "kernel_launch: unexpected sizes: n_in %d out %d ws %zu (need %zu)\n", n_in, out_size, ws_size, need); grid = -1; return; }
        int dev = 0, cus = 0, per_cu = 0;
        if (hipGetDevice(&dev) != hipSuccess || hipDeviceGetAttribute(&cus, hipDeviceAttributeMultiprocessorCount, dev) != hipSuccess) { grid = -1; return; }
        if (hipFuncSetAttribute((const void*)mk_fwd, hipFuncAttributeMaxDynamicSharedMemorySize, LDS_BYTES) != hipSuccess) { fprintf(stderr, "kernel_launch: hipFuncSetAttribute failed\n"); grid = -1; return; }
        if (hipOccupancyMaxActiveBlocksPerMultiprocessor(&per_cu, (const void*)mk_fwd, NWAVES * 64, LDS_BYTES) != hipSuccess || per_cu < 1) { fprintf(stderr, "kernel_launch: occupancy query says %d blocks/CU\n", per_cu); (void)hipGetLastError(); grid = -1; return; }
        if (cus < 64) { fprintf(stderr, "kernel_launch: needs >= 64 CUs\n"); grid = -1; return; }
        grid = cus;
    }
#if defined(FORCE_GRID)
    if (grid > FORCE_GRID) grid = FORCE_GRID;
#endif
    if (grid < 0) return;
#if TEST_MODE
    (void)hipMemsetAsync((char*)d_ws + WS_CTL, 0, CTL_ZERO_BYTES, stream);
#else
    (void)hipMemsetAsync((char*)d_ws + WS_CTL + CW_BAR * 4, 0, (CW_Q - CW_BAR + 256) * 4, stream);
#endif
    Args a{};
    for (int i = 0; i < 18; ++i) a.in[i] = (const float*)d_in[i];
    a.out = (float*)d_out; a.ws = (unsigned char*)d_ws;
#if TEST_MODE == 6
    a.ph_lo = 0; a.ph_hi = 5; a.li = 0;
    hipLaunchKernelGGL(mk_fwd, dim3(grid), dim3(NWAVES * 64), LDS_BYTES, stream, a);
    k_blk<<<16, 256, 0, stream>>>((float*)d_out, (const unsigned long long*)((char*)d_ws + WS_CTL + 800 * 1024), STATSEL, 1e-5f);
#elif TEST_MODE == 5
    a.ph_lo = 0; a.ph_hi = 5; a.li = 0;
    hipLaunchKernelGGL(mk_fwd, dim3(grid), dim3(NWAVES * 64), LDS_BYTES, stream, a);
    k_stat<<<16, 256, 0, stream>>>((float*)d_out, (const unsigned*)((char*)d_ws + WS_CTL + 900 * 1024), STATSEL);
#elif TEST_MODE == 4
    a.ph_lo = 0; a.ph_hi = 5; a.li = 0;
    hipLaunchKernelGGL(mk_fwd, dim3(grid), dim3(NWAVES * 64), LDS_BYTES, stream, a);
    k_time<<<16, 256, 0, stream>>>((float*)d_out, (const unsigned long long*)((char*)d_ws + WS_CTL + 768 * 1024), TS0, TS1, 1e-5f);
#elif TEST_MODE && TEST_MODE < 4
    {
        using namespace gold;
        const float* xp = (const float*)d_in[0]; const float* xs = (const float*)d_in[1];
        const float* cache_k = (const float*)d_in[2]; const float* cache_v = (const float*)d_in[3]; const float* cache_kidx = (const float*)d_in[4];
        const float* state_pool = (const float*)d_in[5]; const int* page_table = (const int*)d_in[6];
        const float* cp = (const float*)d_in[7]; const float* cs = (const float*)d_in[8]; const float* norm_w = (const float*)d_in[9];
        const float* w_ada = (const float*)d_in[10]; const float* b_ada = (const float*)d_in[11]; const float* w_in = (const float*)d_in[12];
        const float* qnw = (const float*)d_in[13]; const float* knw = (const float*)d_in[14]; const float* w_pool = (const float*)d_in[15];
        const float* pool_scale = (const float*)d_in[16]; const float* w_out = (const float*)d_in[17];
        float* out = (float*)d_out; float* ws = (float*)((char*)d_ws + 192 * MiB);
        float *ADA = ws + W_ADA, *H = ws + W_H, *PROJ = ws + W_PROJ, *SC = ws + W_SC, *SCS = ws + W_SCS, *MIX = ws + W_MIX, *DB = ws + W_DB, *YT = ws + W_YT;
        int *SEL = (int*)(ws + W_SEL), *NSEL = (int*)(ws + W_NSEL);
        k_ada<<<dim3(12, NR), 256, 0, stream>>>(cp, cs, w_ada, b_ada, ADA);
        k_h<<<MT / 4, 256, 0, stream>>>(xp, xs, norm_w, ADA, H);
        k_gemm<<<dim3((NIN + 127) / 128, MT / 128), 256, 0, stream>>>(H, w_in, PROJ, MT, NIN, DM, DM, NIN, NIN);
        k_post<<<MT / 4, 256, 0, stream>>>(PROJ, qnw, knw, state_pool, out);
        k_scores_p<<<dim3(SEQ / 8, NB), 256, 0, stream>>>(PROJ, SC);
        k_scores_s<<<DECB, 256, 0, stream>>>(PROJ, cache_kidx, page_table, SCS);
        k_topk<<<MT / 4, 256, 0, stream>>>(SC, SCS, SEL, NSEL);
        k_attn<<<MT / 4, 256, 0, stream>>>(PROJ, cache_k, cache_v, page_table, SEL, NSEL, MIX);
        k_pool_d<<<(MT * 512) / 256, 256, 0, stream>>>(PROJ, state_pool, DB);
        k_pool_out<<<(MT * 512) / 256, 256, 0, stream>>>(PROJ, DB, w_pool, pool_scale, MIX);
        k_gemm<<<dim3(1024 / 128, MT / 128), 256, 0, stream>>>(MIX, w_out, YT, MT, 1024, 1024, 1024, 1024, 1024);
        k_final<<<(MT * 1024) / 256, 256, 0, stream>>>(xp, xs, ADA, YT, out);
        unsigned char* mws = (unsigned char*)d_ws;
#if TEST_MODE == 1
        a.ph_lo = 0; a.ph_hi = 3; a.li = 0;
        hipLaunchKernelGGL(mk_fwd, dim3(grid), dim3(NWAVES * 64), LDS_BYTES, stream, a);
        float* accum = (float*)(mws + WS_CTL + 512 * 1024);
        struct { const void* a; int bf; int lda; int refcol; int cols; float scale; int act; } L[9] = {
            {mws + WS_Q, 1, 512, CQ, 512, C2, 0}, {mws + WS_QI, 1, 512, CQI, 512, 1.f, 0}, {mws + WS_GA, 1, 512, CGA, 512, 1.f, 1}, {mws + WS_U, 1, 512, CU, 512, 1.f, 0},
            {mws + WS_GP, 1, 512, CGP, 512, 1.f, 1}, {mws + WS_KB, 1, 128, CK, 128, 1.f, 0}, {mws + WS_VB, 1, 128, CV, 128, 1.f, 0}, {mws + WS_KI, 1, 64, CKI, 64, 1.f, 0},
            {mws + WS_WI, 0, 8, CWI, 8, 1.f, 0} };
        for (int k = 0; k < 9; ++k) k_cmp<<<(unsigned)(((size_t)MT * L[k].cols + 255) / 256), 256, 0, stream>>>(L[k].a, L[k].bf, L[k].lda, PROJ + L[k].refcol, NIN, MT, L[k].cols, L[k].scale, L[k].act, accum + 2 * k);
        k_cmp<<<(NR * 3072 + 255) / 256, 256, 0, stream>>>(mws + WS_ADA, 0, 3072, ADA, 3072, NR, 3072, 1.f, 0, accum + 18);
        k_cmp_fin<<<1, 1, 0, stream>>>(accum, 10, 5.0f);
        k_perturb<<<1024, 256, 0, stream>>>(out, accum);
#elif TEST_MODE == 3
        a.ph_lo = 0; a.ph_hi = 5; a.li = 0;
        hipLaunchKernelGGL(mk_fwd, dim3(grid), dim3(NWAVES * 64), LDS_BYTES, stream, a);
        float* accum = (float*)(mws + WS_CTL + 512 * 1024);
        const bf16* MB = (const bf16*)(mws + WS_MIX);
        k_cmp<<<(unsigned)(((size_t)MP * 512 + 255) / 256), 256, 0, stream>>>(MB, 1, 1024, MIX, 1024, MP, 512, 1.f, 0, accum + 0);
        k_cmp<<<(unsigned)(((size_t)MP * 512 + 255) / 256), 256, 0, stream>>>(MB + 512, 1, 1024, MIX + 512, 1024, MP, 512, 1.f, 0, accum + 2);
        k_cmp<<<(DECB * 512 + 255) / 256, 256, 0, stream>>>(MB + (size_t)MP * 1024, 1, 1024, MIX + (size_t)MP * 1024, 1024, DECB, 512, 1.f, 0, accum + 4);
        k_cmp<<<(DECB * 512 + 255) / 256, 256, 0, stream>>>(MB + (size_t)MP * 1024 + 512, 1, 1024, MIX + (size_t)MP * 1024 + 512, 1024, DECB, 512, 1.f, 0, accum + 6);
        k_cmp_sel<<<MP, 256, 0, stream>>>(SEL, NSEL, (const unsigned*)(mws + WS_DBG_BM), accum + 8);
        k_set<<<1, 1, 0, stream>>>(accum + 32, P3_TOL0, P3_TOL1, P3_TOL2, P3_TOL3, P3_TOL4);
        k_cmp_fin2<<<1, 1, 0, stream>>>(accum, 5, 1e-5f);
        k_perturb<<<1024, 256, 0, stream>>>(out, accum);
#elif TEST_MODE == 2
        a.ph_lo = 0; a.ph_hi = 3; a.li = 0;
        hipLaunchKernelGGL(mk_fwd, dim3(grid), dim3(NWAVES * 64), LDS_BYTES, stream, a);
        k_f32_to_bf16<<<2048, 256, 0, stream>>>(MIX, (bf16*)(mws + WS_MIX), (size_t)MT * 1024);
        a.ph_lo = 4; a.ph_hi = 5; a.li = 1;
        hipLaunchKernelGGL(mk_fwd, dim3(grid), dim3(NWAVES * 64), LDS_BYTES, stream, a);
#endif
    }
#else
    a.ph_lo = 0; a.ph_hi = 5; a.li = 0;
#if USE_COOP
    { void* kargs[] = {&a}; (void)hipLaunchCooperativeKernel((const void*)mk_fwd, dim3(grid), dim3(NWAVES * 64), kargs, LDS_BYTES, stream); }
#else
    hipLaunchKernelGGL(mk_fwd, dim3(grid), dim3(NWAVES * 64), LDS_BYTES, stream, a);
#endif
#endif
}
```

```cpp
#define TEST_MODE 0
#define HAVE_P3 1
#define REP_S1 1
#define REP_S2 1
#define REP_S4 1
#define REP_P0 1
#define REP_P1 1
#define REP_P4S 1
#define REP_P2G 1
#define REP_P4G 1
#define REP_P2S 1
#define REP_SMP 1
#define REP_POOL 1
#define STATSEL 0
#define USE_COOP 1
#define STAMP_BLK 0
#define P3FINE 0
#define TS0 0
#define TS1 1
#include <hip/hip_runtime.h>
#include <cstdio>
#include <cstdint>

constexpr int DM = 1024, NB = 8, SEQ = 2048, DECB = 128, PAST = 2048, PAGE = 128, NPG = 16;
constexpr int NIN = 2888, MP = NB * SEQ, MT = MP + DECB, NR = NB + DECB;
constexpr int CQ = 0, CK = 512, CV = 640, CQI = 768, CKI = 1280, CWI = 1344, CGA = 1352, CU = 1864, CGP = 2376;
constexpr size_t O_YP = 0, O_YS = 16777216, O_KP = 16908288, O_VP = 19005440, O_KIP = 21102592, O_PP = 22151168,
                 O_KS = 22212608, O_VS = 22228992, O_KIS = 22245376, O_PS = 22253568, O_END = 23236608;
constexpr float C2 = 0.125f * 1.4426950408889634f;
constexpr float WI_SCALE = 0.04419417382415922f;
constexpr float EPS = 1e-6f;
constexpr size_t MiB = 1u << 20;
constexpr size_t WS_CTL = 0, CTL_ZERO_BYTES = 1 * MiB;
constexpr size_t WS_ADA = 1 * MiB, WS_WINT = 3 * MiB, WS_WOUTT = 9 * MiB, WS_WPOOLT = 11 * MiB, WS_HS = 12 * MiB, WS_HB = 24 * MiB,
                 WS_Q = 56 * MiB, WS_QI = 73 * MiB, WS_GA = 90 * MiB, WS_U = 107 * MiB, WS_GP = 124 * MiB, WS_KB = 141 * MiB, WS_VB = 146 * MiB,
                 WS_KI = 151 * MiB, WS_WI = 154 * MiB, WS_MIX = 155 * MiB, WS_DBG_BM = 188 * MiB, WS_MEGA_END = 192 * MiB;
namespace pg8 {
#define PG8_LAS __attribute__((address_space(3)))
typedef unsigned short bf16_t;
typedef short bf16x8 __attribute__((ext_vector_type(8)));
typedef float f32x4 __attribute__((ext_vector_type(4)));
typedef unsigned u32x4 __attribute__((ext_vector_type(4)));
constexpr int BM = 256, BK = 64, HALF = 128, HTB = HALF * BK * 2  , STAGE_BYTES = 8 * HTB, NXCD = 8, WGM = 8;

__host__ __device__ __forceinline__ int lds_byte(int r, int c) { const int st = (r >> 4) * 2 + (c >> 5), rr = r & 15, cc = c & 31, ob = rr * 64 + cc * 2; return st * 1024 + (ob ^ (((ob >> 9) & 1) << 5)); }
__host__ __device__ __forceinline__ void stage_rc(int b, int& R, int& C) { const int st = b / 1024, sb = b % 1024, swz = sb ^ (((sb >> 9) & 1) << 5); R = (st >> 1) * 16 + swz / 64; C = (st & 1) * 32 + (swz % 64) / 2; }
__host__ __device__ __forceinline__ int perm32(int rho) { const int n = rho >> 4, i = rho & 15; return 8 * (i >> 2) + 4 * n + (i & 3); }

struct Unit { int pm, pn; };
struct Gemm { const bf16_t* A; const bf16_t* Bt; int M, N, K; };

struct StaticOrder {
    int nM, nN, nwg, G, c;
    __host__ __device__ void init(int M, int N, int G_, int c_) { nM = M / BM; nN = N / BM; nwg = nM * nN; G = G_; c = c_; }
    __host__ __device__ bool next(int i, Unit& u) const {
        const long L = (long)i * G + c; if (L >= nwg) return false;
        int wgid = (int)L; { const int q = nwg / NXCD, r = nwg % NXCD, xcd = wgid % NXCD, off = wgid / NXCD; wgid = (xcd < r ? xcd * (q + 1) : r * (q + 1) + (xcd - r) * q) + off; }
        const int nig = WGM * nN, gid = wgid / nig, fm = gid * WGM, gsz = (nM - fm) < WGM ? (nM - fm) : WGM;
        u.pm = fm + ((wgid % nig) % gsz); u.pn = (wgid % nig) / gsz; return true;
    }
    __device__ __forceinline__ void a_ready(const Unit&) const {}
    __device__ __forceinline__ void done(const Unit&) const {}
};


typedef unsigned u32x4 __attribute__((ext_vector_type(4)));
__device__ __forceinline__ unsigned cvt_pk_bf16(float lo, float hi) { unsigned r; asm volatile("v_cvt_pk_bf16_f32 %0, %1, %2" : "=v"(r) : "v"(lo), "v"(hi)); return r; }
__device__ __forceinline__ void st_bf16x8(bf16_t* p, const f32x4 a, const f32x4 b) {
    u32x4 w; w.x = cvt_pk_bf16(a[0], a[1]); w.y = cvt_pk_bf16(a[2], a[3]); w.z = cvt_pk_bf16(b[0], b[1]); w.w = cvt_pk_bf16(b[2], b[3]); *(u32x4*)p = w; }
__device__ __forceinline__ float silu1(float x) { return x * __builtin_amdgcn_rcpf(1.0f + __builtin_amdgcn_exp2f(-1.4426950408889634f * x)); }
__device__ __forceinline__ f32x4 silu4(const f32x4 v) { f32x4 r; r[0] = silu1(v[0]); r[1] = silu1(v[1]); r[2] = silu1(v[2]); r[3] = silu1(v[3]); return r; }

struct EpiIn {
    static constexpr bool PERM = true, AFTER_DRAIN = false;
    unsigned char* ws; float* out; const float* qnw; const float* knw;
    __device__ __forceinline__ void operator()(const f32x4 (&acc)[2][2][4][2], const Unit& u, int wr, int wc, int fr, int fq) const {
        const int pn = u.pn;
        if (pn == 5 && wc >= 2) return;
        const int rowb = u.pm * 256 + wr * 64 + fr, dof = 8 * fq;
        if (pn <= 1 || (pn == 2 && wc < 2)) {
            const float* nwp = pn <= 1 ? qnw : knw; const float sc = pn <= 1 ? C2 : 1.0f;
            f32x4 wv[2][2];
#pragma unroll
            for (int bj = 0; bj < 2; ++bj)
#pragma unroll
                for (int n = 0; n < 2; ++n) wv[bj][n] = *(const f32x4*)(nwp + 32 * bj + dof + 4 * n) * sc;
#pragma unroll
            for (int ai = 0; ai < 2; ++ai)
#pragma unroll
                for (int m = 0; m < 4; ++m) { const size_t row = (size_t)(rowb + ai * 128 + m * 16); float ss = 0.f;
#pragma unroll
                    for (int bj = 0; bj < 2; ++bj)
#pragma unroll
                        for (int n = 0; n < 2; ++n) { const f32x4 x = acc[ai][bj][m][n]; ss += (x[0] * x[0] + x[1] * x[1]) + (x[2] * x[2] + x[3] * x[3]); }
                    ss += __shfl_xor(ss, 16); ss += __shfl_xor(ss, 32);
                    const float rstd = 1.0f / sqrtf(ss * (1.0f / 64.0f) + EPS);
                    f32x4 o[2][2];
#pragma unroll
                    for (int bj = 0; bj < 2; ++bj)
#pragma unroll
                        for (int n = 0; n < 2; ++n) o[bj][n] = acc[ai][bj][m][n] * rstd * wv[bj][n];
                    if (pn <= 1) { bf16_t* q = (bf16_t*)(ws + WS_Q) + row * 512 + (4 * pn + wc) * 64 + dof; st_bf16x8(q, o[0][0], o[0][1]); st_bf16x8(q + 32, o[1][0], o[1][1]); }
                    else { float* ko = out + O_KP + row * 128 + wc * 64 + dof; *(f32x4*)ko = o[0][0]; *(f32x4*)(ko + 4) = o[0][1]; *(f32x4*)(ko + 32) = o[1][0]; *(f32x4*)(ko + 36) = o[1][1];
                        bf16_t* kb = (bf16_t*)(ws + WS_KB) + row * 128 + wc * 64 + dof; st_bf16x8(kb, o[0][0], o[0][1]); st_bf16x8(kb + 32, o[1][0], o[1][1]); } }
            return;
        }
        if (pn == 5 && wc == 1) {
            if (fq == 0) {
#pragma unroll
                for (int ai = 0; ai < 2; ++ai)
#pragma unroll
                    for (int m = 0; m < 4; ++m) { const size_t row = (size_t)(rowb + ai * 128 + m * 16); float* wp = (float*)(ws + WS_WI) + row * 8;
                        *(f32x4*)wp = acc[ai][0][m][0] * WI_SCALE; *(f32x4*)(wp + 4) = acc[ai][0][m][1] * WI_SCALE; } }
            return;
        }
        bf16_t* dst; int ld, cb; float* fo = nullptr; int fld = 0; bool act = false;
        if (pn == 2) { dst = (bf16_t*)(ws + WS_VB); ld = 128; cb = (wc - 2) * 64; fo = out + O_VP + cb; fld = 128; }
        else if (pn <= 4) { dst = (bf16_t*)(ws + WS_QI); ld = 512; cb = (4 * (pn - 3) + wc) * 64; }
        else if (pn == 5) { dst = (bf16_t*)(ws + WS_KI); ld = 64; cb = 0; fo = out + O_KIP; fld = 64; }
        else if (pn <= 7) { dst = (bf16_t*)(ws + WS_GA); ld = 512; cb = (4 * (pn - 6) + wc) * 64; act = true; }
        else if (pn <= 9) { dst = (bf16_t*)(ws + WS_U); ld = 512; cb = (4 * (pn - 8) + wc) * 64; }
        else { dst = (bf16_t*)(ws + WS_GP); ld = 512; cb = (4 * (pn - 10) + wc) * 64; act = true; }
        const bool is_u = (pn == 8 || pn == 9);
#pragma unroll
        for (int ai = 0; ai < 2; ++ai)
#pragma unroll
            for (int m = 0; m < 4; ++m) { const int rowi = rowb + ai * 128 + m * 16; const size_t row = (size_t)rowi;
                f32x4 o00 = acc[ai][0][m][0], o01 = acc[ai][0][m][1], o10 = acc[ai][1][m][0], o11 = acc[ai][1][m][1];
                if (act) { o00 = silu4(o00); o01 = silu4(o01); o10 = silu4(o10); o11 = silu4(o11); }
                bf16_t* d = dst + row * ld + cb + dof; st_bf16x8(d, o00, o01); st_bf16x8(d + 32, o10, o11);
                if (fo) { float* f = fo + row * fld + dof; *(f32x4*)f = o00; *(f32x4*)(f + 4) = o01; *(f32x4*)(f + 32) = o10; *(f32x4*)(f + 36) = o11; }
                if (is_u) { const int t = rowi & (SEQ - 1);
                    if (t >= SEQ - 15) { float* f = out + O_PP + ((size_t)(rowi >> 11) * 15 + (t - (SEQ - 15))) * 512 + cb + dof;
                        *(f32x4*)f = o00; *(f32x4*)(f + 4) = o01; *(f32x4*)(f + 32) = o10; *(f32x4*)(f + 36) = o11; } } }
    }
};
struct EpiOut {
    static constexpr bool PERM = true, AFTER_DRAIN = false;
    const float* x; float* y; const float* ada;
    __device__ __forceinline__ void operator()(const f32x4 (&acc)[2][2][4][2], const Unit& u, int wr, int wc, int fr, int fq) const {
        const int col0 = u.pn * 256 + wc * 32 + 8 * fq; const float* gp = ada + (size_t)(u.pm >> 3) * 3072 + 2048 + col0;
        f32x4 g[2][2];
#pragma unroll
        for (int bj = 0; bj < 2; ++bj)
#pragma unroll
            for (int n = 0; n < 2; ++n) g[bj][n] = *(const f32x4*)(gp + 128 * bj + 4 * n);
#pragma unroll
        for (int ai = 0; ai < 2; ++ai)
#pragma unroll
            for (int m = 0; m < 4; ++m) { const size_t off = (size_t)(u.pm * 256 + ai * 128 + wr * 64 + m * 16 + fr) * 1024 + col0;
#pragma unroll
                for (int bj = 0; bj < 2; ++bj)
#pragma unroll
                    for (int n = 0; n < 2; ++n) { const f32x4 xv = *(const f32x4*)(x + off + 128 * bj + 4 * n); *(f32x4*)(y + off + 128 * bj + 4 * n) = xv + g[bj][n] * acc[ai][bj][m][n]; } }
    }
};
template <class Epi, class Sched, bool ALIGN_EPI = false, bool SP2 = false>
__device__ __forceinline__ void gemm_phase(PG8_LAS unsigned char* lds, const Gemm g, const Sched& S, const Epi& E) {
    const int tid = threadIdx.x, wid = __builtin_amdgcn_readfirstlane(tid >> 6), lane = tid & 63, wr = wid >> 2, wc = wid & 3, fr = lane & 15, fq = lane >> 4;
    const int K = g.K, nt = K / BK;
    unsigned voffA[2], voffB[2];
#pragma unroll
    for (int i = 0; i < 2; ++i) { int R, C; stage_rc(tid * 16 + i * 8192, R, C); const int Rb = Epi::PERM ? ((R & ~31) + perm32(R & 31)) : R;
        voffA[i] = (unsigned)(R * K + C) * 2u; voffB[i] = (unsigned)(Rb * K + C) * 2u; }
    const size_t kstep = (size_t)(BK * 2);
    const size_t hstep = (size_t)HALF * K * 2;
    const size_t tstep = 2 * hstep;
    const unsigned ldsw = (unsigned)wid * 1024u;
    const int aoff = lds_byte(wr * 64 + fr, fq * 8), boff = lds_byte(wc * 32 + fr, fq * 8);
#define PG8_SA(b, h) (((b) * 2 + (h)) * HTB)
#define PG8_SB(b, h) ((4 + (b) * 2 + (h)) * HTB)
#define PG8_STAGE(bufoff, gbase, voff) do { _Pragma("unroll") for (int _i = 0; _i < 2; ++_i) \
        __builtin_amdgcn_global_load_lds((const unsigned*)((const char*)(gbase) + (voff)[_i]), (PG8_LAS unsigned*)(lds + (bufoff) + ldsw + _i * 8192), 16, 0, 0); } while (0)
#define PG8_LDA(dst, b, h) do { _Pragma("unroll") for (int m = 0; m < 4; ++m) _Pragma("unroll") for (int k = 0; k < 2; ++k) dst[m][k] = *(const PG8_LAS bf16x8*)(lds + PG8_SA(b, h) + aoff + m * 2048 + k * 1024); } while (0)
#define PG8_LDB(dst, b, h) do { _Pragma("unroll") for (int n = 0; n < 2; ++n) _Pragma("unroll") for (int k = 0; k < 2; ++k) dst[n][k] = *(const PG8_LAS bf16x8*)(lds + PG8_SB(b, h) + boff + n * 2048 + k * 1024); } while (0)
#define PG8_MMA(ai, bj, At, Bt) do { __builtin_amdgcn_s_setprio(1); _Pragma("unroll") for (int m = 0; m < 4; ++m) _Pragma("unroll") for (int n = 0; n < 2; ++n) _Pragma("unroll") for (int k = 0; k < 2; ++k) \
        acc[ai][bj][m][n] = __builtin_amdgcn_mfma_f32_16x16x32_bf16(Bt[n][k], At[m][k], acc[ai][bj][m][n], 0, 0, 0); __builtin_amdgcn_s_setprio(0); } while (0)
#define PG8_WAIT_V(n) asm volatile("s_waitcnt vmcnt(" #n ")" ::: "memory")
#define PG8_WAIT_L(n) asm volatile("s_waitcnt lgkmcnt(" #n ")" ::: "memory")
#define PG8_BAR __builtin_amdgcn_s_barrier()
#define PG8_SCHED __builtin_amdgcn_sched_barrier(0)
    Unit cur, nxt; int ui = 0;
    if (!S.next(0, cur)) return;
    f32x4 acc[2][2][4][2];
#pragma unroll
    for (int a = 0; a < 2; ++a)
#pragma unroll
        for (int b = 0; b < 2; ++b)
#pragma unroll
            for (int m = 0; m < 4; ++m)
#pragma unroll
                for (int n = 0; n < 2; ++n) acc[a][b][m][n] = (f32x4){0.f, 0.f, 0.f, 0.f};
    bf16x8 At[4][2], B0[2][2], B1[2][2];
    const char* cA = (const char*)g.A + (size_t)cur.pm * tstep; const char* cB = (const char*)g.Bt + (size_t)cur.pn * tstep;
    S.a_ready(cur);
    if constexpr (SP2) {
        PG8_STAGE(PG8_SB(0, 0), cB, voffB); PG8_STAGE(PG8_SB(0, 1), cB + hstep, voffB); PG8_STAGE(PG8_SA(0, 0), cA, voffA); PG8_STAGE(PG8_SA(0, 1), cA + hstep, voffA);
        if (wr == 1) PG8_BAR;
        PG8_WAIT_V(2); PG8_BAR;
        PG8_STAGE(PG8_SB(1, 0), cB + kstep, voffB); PG8_STAGE(PG8_SA(1, 0), cA + kstep, voffA); PG8_STAGE(PG8_SB(1, 1), cB + hstep + kstep, voffB);
        PG8_WAIT_V(6); PG8_BAR;
    } else {
        PG8_STAGE(PG8_SB(0, 0), cB, voffB); PG8_STAGE(PG8_SA(0, 0), cA, voffA); PG8_STAGE(PG8_SB(0, 1), cB + hstep, voffB); PG8_STAGE(PG8_SA(0, 1), cA + hstep, voffA);
        if (wr == 1) PG8_BAR;
        PG8_WAIT_V(4); PG8_BAR;
        PG8_STAGE(PG8_SB(1, 0), cB + kstep, voffB); PG8_STAGE(PG8_SA(1, 0), cA + kstep, voffA); PG8_STAGE(PG8_SB(1, 1), cB + hstep + kstep, voffB);
        PG8_WAIT_V(6); PG8_BAR;
    }
    for (;;) {
        const bool has_next = S.next(ui + 1, nxt);
        const char* nA = has_next ? (const char*)g.A + (size_t)nxt.pm * tstep : cA; const char* nB = has_next ? (const char*)g.Bt + (size_t)nxt.pn * tstep : cB;
        for (int t = 0; t < nt; t += 2) {
            const bool last = (t == nt - 2);
            const char* a1 = cA + (size_t)(t + 1) * kstep;
            const char* a2 = last ? nA : cA + (size_t)(t + 2) * kstep; const char* b2 = last ? nB : cB + (size_t)(t + 2) * kstep;
            const char* a3 = a2 + kstep; const char* b3 = b2 + kstep;
            if (last && has_next) S.a_ready(nxt);
            if constexpr (SP2) {
            PG8_LDB(B0, 0, 0); PG8_LDB(B1, 0, 1); PG8_SCHED; PG8_LDA(At, 0, 0); PG8_STAGE(PG8_SA(1, 1), a1 + hstep, voffA);
            PG8_WAIT_V(8); PG8_WAIT_L(0); PG8_BAR; PG8_MMA(0, 0, At, B0); PG8_MMA(0, 1, At, B1); PG8_BAR; PG8_SCHED;
            PG8_LDA(At, 0, 1); PG8_STAGE(PG8_SB(0, 0), b2, voffB); PG8_STAGE(PG8_SB(0, 1), b2 + hstep, voffB); PG8_STAGE(PG8_SA(0, 0), a2, voffA);
            PG8_WAIT_V(8); PG8_WAIT_L(0); PG8_BAR; PG8_MMA(1, 0, At, B0); PG8_MMA(1, 1, At, B1); PG8_BAR; PG8_SCHED;
            PG8_LDB(B0, 1, 0); PG8_LDB(B1, 1, 1); PG8_SCHED; PG8_LDA(At, 1, 0); PG8_STAGE(PG8_SA(0, 1), a2 + hstep, voffA);
            PG8_WAIT_V(8); PG8_WAIT_L(0); PG8_BAR; PG8_MMA(0, 0, At, B0); PG8_MMA(0, 1, At, B1); PG8_BAR; PG8_SCHED;
            PG8_LDA(At, 1, 1); PG8_STAGE(PG8_SB(1, 0), b3, voffB); PG8_STAGE(PG8_SB(1, 1), b3 + hstep, voffB); PG8_STAGE(PG8_SA(1, 0), a3, voffA);
            PG8_WAIT_V(8); PG8_WAIT_L(0); PG8_BAR; PG8_MMA(1, 0, At, B0); PG8_MMA(1, 1, At, B1); PG8_BAR; PG8_SCHED;
            } else {
            PG8_LDB(B0, 0, 0); PG8_SCHED; PG8_LDA(At, 0, 0); PG8_STAGE(PG8_SA(1, 1), a1 + hstep, voffA);
            PG8_WAIT_L(8); PG8_BAR; PG8_WAIT_L(0); PG8_MMA(0, 0, At, B0); PG8_BAR; PG8_SCHED;
            PG8_LDB(B1, 0, 1); PG8_STAGE(PG8_SB(0, 0), b2, voffB);
            PG8_BAR; PG8_WAIT_L(0); PG8_MMA(0, 1, At, B1); PG8_BAR;
            PG8_LDA(At, 0, 1); PG8_STAGE(PG8_SA(0, 0), a2, voffA);
            PG8_BAR; PG8_WAIT_L(0); PG8_MMA(1, 0, At, B0); PG8_BAR; PG8_SCHED;
            PG8_STAGE(PG8_SB(0, 1), b2 + hstep, voffB);
            PG8_WAIT_V(6); PG8_BAR; PG8_MMA(1, 1, At, B1); PG8_BAR;
            PG8_LDB(B0, 1, 0); PG8_SCHED; PG8_LDA(At, 1, 0); PG8_STAGE(PG8_SA(0, 1), a2 + hstep, voffA);
            PG8_WAIT_L(8); PG8_BAR; PG8_WAIT_L(0); PG8_MMA(0, 0, At, B0); PG8_BAR; PG8_SCHED;
            PG8_LDB(B1, 1, 1); PG8_STAGE(PG8_SB(1, 0), b3, voffB);
            PG8_BAR; PG8_WAIT_L(0); PG8_MMA(0, 1, At, B1); PG8_BAR;
            PG8_LDA(At, 1, 1); PG8_STAGE(PG8_SA(1, 0), a3, voffA);
            PG8_BAR; PG8_WAIT_L(0); PG8_MMA(1, 0, At, B0); PG8_BAR; PG8_SCHED;
            PG8_STAGE(PG8_SB(1, 1), b3 + hstep, voffB);
            PG8_WAIT_V(6); PG8_BAR; PG8_MMA(1, 1, At, B1); PG8_BAR;
            }
        }
        if constexpr (ALIGN_EPI) { if (wr == 0) PG8_BAR; }
        if constexpr (!Epi::AFTER_DRAIN) { E(acc, cur, wr, wc, fr, fq); S.done(cur); }
        if (!has_next) break;
#pragma unroll
        for (int a = 0; a < 2; ++a)
#pragma unroll
            for (int b = 0; b < 2; ++b)
#pragma unroll
                for (int m = 0; m < 4; ++m)
#pragma unroll
                    for (int n = 0; n < 2; ++n) acc[a][b][m][n] = (f32x4){0.f, 0.f, 0.f, 0.f};
        cur = nxt; cA = nA; cB = nB; ++ui;
        if constexpr (ALIGN_EPI) { if (wr == 1) PG8_BAR; }
    }
    PG8_WAIT_V(0);
    if constexpr (!ALIGN_EPI) { if (wr == 0) PG8_BAR; }
    PG8_BAR;
    if constexpr (Epi::AFTER_DRAIN) { E.fused(acc, cur, wr, wc, fr, fq, lds, wid, lane); S.done(cur); }
#undef PG8_SA
#undef PG8_SB
#undef PG8_STAGE
#undef PG8_LDA
#undef PG8_LDB
#undef PG8_MMA
#undef PG8_WAIT_V
#undef PG8_WAIT_L
#undef PG8_BAR
#undef PG8_SCHED
}
}

constexpr int NWAVES = 8;
constexpr int RING_OFF = 0, RING_BYTES = 131072;
constexpr int LDSCTL_OFF = RING_BYTES, MISC_OFF = LDSCTL_OFF + 320;
constexpr int LDS_BYTES = 163840;
constexpr int CW_Q = 8192;
constexpr int CW_BAR = 4096;
#define GAS __attribute__((address_space(1)))
#define LAS __attribute__((address_space(3)))
typedef unsigned short bf16;
typedef unsigned v4u __attribute__((ext_vector_type(4)));
typedef unsigned v2u __attribute__((ext_vector_type(2)));
typedef float f32x4 __attribute__((ext_vector_type(4)));
typedef float f32x16 __attribute__((ext_vector_type(16)));
typedef short bf16x8 __attribute__((ext_vector_type(8)));
typedef GAS unsigned gu32;
#define LDS_WAIT() asm volatile("s_waitcnt lgkmcnt(0)" ::: "memory")
#define VM_WAIT() asm volatile("s_waitcnt vmcnt(0)" ::: "memory")
__device__ __forceinline__ unsigned f2bf(float f) { unsigned u = __builtin_bit_cast(unsigned, f); return (u + 0x7fffu + ((u >> 16) & 1u)) >> 16; }
__device__ __forceinline__ unsigned pk2(float lo, float hi) { return pg8::cvt_pk_bf16(lo, hi); }
__device__ __forceinline__ float bf2f(unsigned short b) { return __builtin_bit_cast(float, (unsigned)b << 16); }
__device__ __forceinline__ float wave_sum(float v) {
#pragma unroll
    for (int o = 1; o < 64; o <<= 1) v += __shfl_xor(v, o);
    return v;
}
__device__ __forceinline__ float wave_max(float v) {
#pragma unroll
    for (int o = 1; o < 64; o <<= 1) v = fmaxf(v, __shfl_xor(v, o));
    return v;
}
#define XB_TMO      128
#define XB_XCNT(j)  (256  + 64 * (j))
#define XB_XSUB(j)  (1280 + 64 * (j))
#define XB_XGEN(j)  (2304 + 64 * (j))
#define XB_TOP      3328
#define XB_TOPGEN   3392
#define XCD_BAR_WORDS 3456
#define XB_SPIN_CAP (1u << 18)

__device__ __forceinline__ unsigned xb_ld(unsigned* p)              { return __hip_atomic_load(p, __ATOMIC_RELAXED, __HIP_MEMORY_SCOPE_AGENT); }
__device__ __forceinline__ unsigned xb_add(unsigned* p, unsigned v) { return __hip_atomic_fetch_add(p, v, __ATOMIC_RELAXED, __HIP_MEMORY_SCOPE_AGENT); }
__device__ __forceinline__ unsigned xb_xcc_id() { return (unsigned)__builtin_amdgcn_s_getreg((3 << 11) | 20) & 0xFu; }
#define XB_SPIN(cond, bar) do { unsigned _sp = 0; while (cond) { __builtin_amdgcn_s_sleep(1); \
    if ((++_sp & 255u) == 0u) { if (xb_ld(&(bar)[XB_TMO])) break; if (_sp > XB_SPIN_CAP) { atomicAdd(&(bar)[XB_TMO], 1u); break; } } } } while (0)

struct XcdBarrier {
    unsigned* bar; unsigned x;
    volatile LAS unsigned* st;
};

__device__ __forceinline__ XcdBarrier xcd_barrier_post(unsigned* bar, volatile LAS unsigned* st) {
    XcdBarrier b; b.bar = bar; b.x = xb_xcc_id(); b.st = st;
    if (threadIdx.x == 0) (void)xb_add(&bar[XB_XCNT(b.x)], 1u);
    return b;
}
__device__ __forceinline__ void xcd_barrier_complete(unsigned* bar, unsigned x, unsigned& nloc, unsigned& nx) {
    const unsigned G = gridDim.x * gridDim.y * gridDim.z;
    unsigned sum, cnt, mine, sp = 0u;
    for (;;) {
        sum = 0u; cnt = 0u; mine = 0u;
#pragma unroll
        for (unsigned j = 0; j < 16; ++j) { const unsigned c = xb_ld(&bar[XB_XCNT(j)]); sum += c; cnt += (c > 0u) ? 1u : 0u; mine = (j == x) ? c : mine; }
        if (sum == G) break;
        __builtin_amdgcn_s_sleep(1);
        if ((++sp & 255u) == 0u) { if (xb_ld(&bar[XB_TMO])) break; if (sp > XB_SPIN_CAP) { atomicAdd(&bar[XB_TMO], 1u); break; } }
    }
    nloc = mine > 0u ? mine : 1u; nx = cnt > 0u ? cnt : 1u;
}

__device__ __forceinline__ void xcd_barrier(const XcdBarrier& b) {
    asm volatile("s_waitcnt vmcnt(0)" ::: "memory");
    __syncthreads();
    if (threadIdx.x == 0) {
        unsigned* bar = b.bar;
        __builtin_amdgcn_s_waitcnt(0);
        unsigned nloc = b.st[0], nx = b.st[1];
        if (nloc == 0u) { xcd_barrier_complete(bar, b.x, nloc, nx); b.st[0] = nloc; b.st[1] = nx; }
        const unsigned old = xb_add(&bar[XB_XSUB(b.x)], 1u);
        const unsigned gen = old / nloc;
        if (old + 1u == (gen + 1u) * nloc) {
            __builtin_amdgcn_fence(__ATOMIC_RELEASE, "agent");
            asm volatile("s_waitcnt vmcnt(0)" ::: "memory");
            const unsigned og = xb_add(&bar[XB_TOP], 1u);
            const unsigned tg = og / nx;
            if (og + 1u == (tg + 1u) * nx) xb_add(&bar[XB_TOPGEN], 1u);
            else XB_SPIN(xb_ld(&bar[XB_TOPGEN]) == tg, bar);
            __builtin_amdgcn_fence(__ATOMIC_ACQUIRE, "agent");
            xb_add(&bar[XB_XGEN(b.x)], 1u);
            asm volatile("s_waitcnt vmcnt(0)" ::: "memory");
        } else {
            XB_SPIN(xb_ld(&bar[XB_XGEN(b.x)]) == gen, bar);
            __builtin_amdgcn_fence(__ATOMIC_ACQUIRE, "agent");
            asm volatile("s_waitcnt vmcnt(0)" ::: "memory");
        }
    }
    __syncthreads();
}

struct Frame {
    LAS unsigned char* lds; volatile LAS unsigned* MISC; gu32* ctl;
    int tid, lane, wave, vcu, G, bid;
    const float *xp, *xs, *cache_k, *cache_v, *cache_kidx, *state_pool; const int* page_table;
    const float *cp, *cs, *norm_w, *w_ada, *b_ada, *w_in, *qnw, *knw, *w_pool, *pool_scale, *w_out;
    float* out; unsigned char* ws;
#if TEST_MODE == 4 && P3FINE
    unsigned long long* ts; int nst;
#endif
};
#if TEST_MODE == 4 && P3FINE
#define FSTAMP() do { if (blockIdx.x == STAMP_BLK && threadIdx.x == 0) F.ts[F.nst] = __builtin_amdgcn_s_memrealtime(); ++F.nst; } while (0)
#else
#define FSTAMP() do { } while (0)
#endif

struct F3 { float x, y, z; };
__device__ __forceinline__ void split8(const float (&x)[8], bf16x8& hi, bf16x8& lo) {
    unsigned h[4], l[4];
#pragma unroll
    for (int p = 0; p < 4; ++p) { h[p] = pk2(x[2 * p], x[2 * p + 1]);
        l[p] = pk2(x[2 * p] - __uint_as_float(h[p] << 16), x[2 * p + 1] - __uint_as_float(h[p] & 0xffff0000u)); }
    v4u hv, lv; hv.x = h[0]; hv.y = h[1]; hv.z = h[2]; hv.w = h[3]; lv.x = l[0]; lv.y = l[1]; lv.z = l[2]; lv.w = l[3];
    hi = __builtin_bit_cast(bf16x8, hv); lo = __builtin_bit_cast(bf16x8, lv);
}
__device__ __forceinline__ void p0_ada(Frame& F, int task) {
    const int lane = F.lane, w = F.wave, rl = lane & 15, kq = lane >> 4, rg = task >> 6, cg = task & 63, n0 = cg * 48, r0 = rg * 48;
    f32x4 acc[9];
#pragma unroll
    for (int i = 0; i < 9; ++i) acc[i] = (f32x4){0.f, 0.f, 0.f, 0.f};
    const float* wp = F.w_ada + (size_t)(w * 128 + 8 * kq) * 3072 + n0 + 3 * rl;
#pragma unroll
    for (int hf = 0; hf < 2; ++hf) {
        F3 bv[2][8]; f32x4 cv[3][2][2]; bool valid[3];
#pragma unroll
        for (int i2 = 0; i2 < 2; ++i2)
#pragma unroll
            for (int j = 0; j < 8; ++j) bv[i2][j] = *(const F3*)(wp + (size_t)(32 * (2 * hf + i2) + j) * 3072);
#pragma unroll
        for (int rt = 0; rt < 3; ++rt) { const int row = r0 + 16 * rt + rl; valid[rt] = row < NR;
            const float* cptr = (row < NB ? F.cp + (size_t)row * DM : F.cs + (size_t)((valid[rt] ? row : NB) - NB) * DM) + w * 128 + 8 * kq;
#pragma unroll
            for (int i2 = 0; i2 < 2; ++i2) { cv[rt][i2][0] = *(const f32x4*)(cptr + 32 * (2 * hf + i2)); cv[rt][i2][1] = *(const f32x4*)(cptr + 32 * (2 * hf + i2) + 4); } }
#pragma unroll
        for (int i2 = 0; i2 < 2; ++i2) {
            bf16x8 bh[3], bl[3];
            { float x[8];
#pragma unroll
              for (int j = 0; j < 8; ++j) x[j] = bv[i2][j].x;
              split8(x, bh[0], bl[0]);
#pragma unroll
              for (int j = 0; j < 8; ++j) x[j] = bv[i2][j].y;
              split8(x, bh[1], bl[1]);
#pragma unroll
              for (int j = 0; j < 8; ++j) x[j] = bv[i2][j].z;
              split8(x, bh[2], bl[2]); }
#pragma unroll
            for (int rt = 0; rt < 3; ++rt) { float a[8];
#pragma unroll
                for (int j = 0; j < 8; ++j) a[j] = valid[rt] ? pg8::silu1(cv[rt][i2][j >> 2][j & 3]) : 0.f;
                bf16x8 ah, al; split8(a, ah, al);
#pragma unroll
                for (int t = 0; t < 3; ++t) {
                    acc[3 * rt + t] = __builtin_amdgcn_mfma_f32_16x16x32_bf16(ah, bh[t], acc[3 * rt + t], 0, 0, 0);
                    acc[3 * rt + t] = __builtin_amdgcn_mfma_f32_16x16x32_bf16(ah, bl[t], acc[3 * rt + t], 0, 0, 0);
                    acc[3 * rt + t] = __builtin_amdgcn_mfma_f32_16x16x32_bf16(al, bh[t], acc[3 * rt + t], 0, 0, 0); } }
        }
    }
    LAS float* red = (LAS float*)(F.lds + RING_OFF);
#pragma unroll
    for (int rt = 0; rt < 3; ++rt)
#pragma unroll
        for (int t = 0; t < 3; ++t)
#pragma unroll
            for (int e = 0; e < 4; ++e) red[(w * 48 + 16 * rt + 4 * kq + e) * 49 + 3 * rl + t] = acc[3 * rt + t][e];
    __syncthreads();
    float* ada = (float*)(F.ws + WS_ADA);
    for (int o = F.tid; o < 48 * 48; o += NWAVES * 64) { const int row = o / 48, col = o - row * 48; float s = F.b_ada[n0 + col];
#pragma unroll
        for (int ww = 0; ww < 8; ++ww) s += red[(ww * 48 + row) * 49 + col];
        if (r0 + row < NR) ada[(size_t)(r0 + row) * 3072 + n0 + col] = s; }
    __syncthreads();
}
__device__ __forceinline__ void transpose_item(const float* W, int ldn, int srccol0, int nvalid, bf16* WT, int K, int dstrow0, int k0, LAS float* scr, int lane) {
    float tv[32];
#pragma unroll
    for (int i = 0; i < 32; ++i) { const int kk = 2 * i + (lane >> 5), c = lane & 31; tv[i] = c < nvalid ? W[(size_t)(k0 + kk) * ldn + srccol0 + c] : 0.f; }
#pragma unroll
    for (int i = 0; i < 32; ++i) { const int kk = 2 * i + (lane >> 5), c = lane & 31; scr[kk * 33 + c] = tv[i]; }
    LDS_WAIT(); asm volatile("" ::: "memory");
    const int c = lane & 7;
#pragma unroll
    for (int j = 0; j < 4; ++j) { const int n = (lane >> 3) + 8 * j; const LAS float* s = scr + (8 * c) * 33 + n;
        v4u o; o.x = pk2(s[0 * 33], s[1 * 33]); o.y = pk2(s[2 * 33], s[3 * 33]); o.z = pk2(s[4 * 33], s[5 * 33]); o.w = pk2(s[6 * 33], s[7 * 33]);
        *(GAS v4u*)(WT + (size_t)(dstrow0 + n) * K + k0 + 8 * c) = o; }
    LDS_WAIT(); asm volatile("" ::: "memory");
}
__device__ __forceinline__ int win_col(int pn, int hd, int d) {
    if (pn <= 1) return CQ + (4 * pn + hd) * 64 + d;
    if (pn == 2) return hd < 2 ? CK + hd * 64 + d : CV + (hd - 2) * 64 + d;
    if (pn <= 4) return CQI + (4 * (pn - 3) + hd) * 64 + d;
    if (pn == 5) return hd == 0 ? CKI + d : ((hd == 1 && d < 8) ? CWI + d : -1);
    if (pn <= 7) return CGA + (4 * (pn - 6) + hd) * 64 + d;
    if (pn <= 9) return CU + (4 * (pn - 8) + hd) * 64 + d;
    return CGP + (4 * (pn - 10) + hd) * 64 + d;
}
__device__ __forceinline__ void p0_prologue(Frame& F) {
    LAS float* scr = (LAS float*)(F.lds + RING_OFF + F.wave * 16384);
    const int gw = F.vcu * NWAVES + F.wave, NGW = F.G * NWAVES;
    bf16* WINT = (bf16*)(F.ws + WS_WINT); bf16* WOUTT = (bf16*)(F.ws + WS_WOUTT); bf16* WPOOLT = (bf16*)(F.ws + WS_WPOOLT);
    const bool split = F.G > 192 + 16;
    if (split) { if (F.bid < 192) p0_ada(F, F.bid); }
    else { for (int task = F.bid; task < 192; task += F.G) p0_ada(F, task); }
    if (!split || F.bid >= 192) {
        const int tw0 = split ? (F.bid - 192) * NWAVES + F.wave : gw, tws = split ? (F.G - 192) * NWAVES : NGW;
        for (int it = tw0; it < (split ? 2048 : 2080); it += tws) {
            if (it < 1536) { const int G = it >> 4, kb = it & 15, pn = G >> 3, bj = (G >> 2) & 1, hd = G & 3; const int src = win_col(pn, hd, 32 * bj);
                const int nvalid = src < 0 ? 0 : ((pn == 5 && hd == 1) ? 8 : 32);
                transpose_item(F.w_in, NIN, src < 0 ? 0 : src, nvalid, WINT, 1024, 32 * G, 64 * kb, scr, F.lane); }
            else if (it < 2048) { const int r = it - 1536, G = r >> 4, kb = r & 15; transpose_item(F.w_out, 1024, 32 * G, 32, WOUTT, 1024, 32 * G, 64 * kb, scr, F.lane); }
            else { const int r = it - 2048, g = r >> 3, kb = (r >> 2) & 1, G = r & 3; transpose_item(F.w_pool + (size_t)g * 16384, 128, 32 * G, 32, WPOOLT + (size_t)g * 16384, 128, 32 * G, 64 * kb, scr, F.lane); }
        }
    }
    { const int nf4 = DECB * 1792; f32x4 t4[2]; int ix[2];
#pragma unroll
      for (int k = 0; k < 2; ++k) { ix[k] = gw * 64 + F.lane + k * NGW * 64; if (ix[k] < nf4) { const int s = ix[k] / 1792, i = ix[k] - s * 1792; t4[k] = *(const f32x4*)(F.state_pool + (size_t)s * 7680 + 512 + 4 * i); } }
#pragma unroll
      for (int k = 0; k < 2; ++k) { if (ix[k] < nf4) { const int s = ix[k] / 1792, i = ix[k] - s * 1792; *(f32x4*)(F.out + O_PS + (size_t)s * 7680 + 4 * i) = t4[k]; } }
      for (int ixx = gw * 64 + F.lane + 2 * NGW * 64; ixx < nf4; ixx += NGW * 64) { const int s = ixx / 1792, i = ixx - s * 1792; *(f32x4*)(F.out + O_PS + (size_t)s * 7680 + 4 * i) = *(const f32x4*)(F.state_pool + (size_t)s * 7680 + 512 + 4 * i); } }
}

template <int N> __device__ __forceinline__ void norm_rows_load(Frame& F, const float* x0, f32x4 (&v)[N][4]) {
#pragma unroll
    for (int i = 0; i < N; ++i) { const GAS f32x4* xr = (const GAS f32x4*)(x0 + (size_t)i * DM) + F.lane;
#pragma unroll
        for (int j = 0; j < 4; ++j) v[i][j] = xr[64 * j]; }
}
template <int N, bool SAME_ADA> __device__ __forceinline__ void norm_rows_finish(Frame& F, f32x4 (&v)[N][4], const float* adarow0, int adastride, bf16* o0) {
    float s2[N];
#pragma unroll
    for (int i = 0; i < N; ++i) { s2[i] = 0.f;
#pragma unroll
        for (int j = 0; j < 4; ++j) s2[i] += (v[i][j].x * v[i][j].x + v[i][j].y * v[i][j].y) + (v[i][j].z * v[i][j].z + v[i][j].w * v[i][j].w); }
#pragma unroll
    for (int o = 1; o < 64; o <<= 1) {
#pragma unroll
        for (int i = 0; i < N; ++i) s2[i] += __shfl_xor(s2[i], o); }
#pragma unroll
    for (int j = 0; j < 4; ++j) { const int col = 4 * F.lane + 256 * j; const f32x4 nw = *(const f32x4*)(F.norm_w + col);
        f32x4 gq, sh;
        if (SAME_ADA) { sh = *(const f32x4*)(adarow0 + col); gq = nw * (*(const f32x4*)(adarow0 + 1024 + col) + 1.0f); }
#pragma unroll
        for (int i = 0; i < N; ++i) {
            if (!SAME_ADA) { const float* ar = adarow0 + (size_t)i * adastride; sh = *(const f32x4*)(ar + col); gq = nw * (*(const f32x4*)(ar + 1024 + col) + 1.0f); }
            const float rstd = 1.0f / sqrtf(s2[i] * (1.0f / DM) + EPS);
            const f32x4 o = v[i][j] * rstd * gq + sh;
            ((GAS unsigned long long*)(o0 + (size_t)i * DM))[F.lane + 64 * j] = (unsigned long long)pk2(o.x, o.y) | ((unsigned long long)pk2(o.z, o.w) << 32); } }
}
template <int N, bool SAME_ADA> __device__ __forceinline__ void norm_rows(Frame& F, const float* x0, const float* adarow0, int adastride, bf16* o0) {
    f32x4 v[N][4]; norm_rows_load<N>(F, x0, v); norm_rows_finish<N, SAME_ADA>(F, v, adarow0, adastride, o0);
}
template <int NBATCH> __device__ __forceinline__ void skinny_core(const bf16* arow, const bf16* b0, const bf16* b1, const bf16* b2, const bf16* b3, f32x4 (&acc)[4]) {
#pragma unroll
    for (int j = 0; j < 4; ++j) acc[j] = (f32x4){0.f, 0.f, 0.f, 0.f};
    bf16x8 fa[2][4], fb[2][4][4];
#define SK_LOAD(buf, kb) do { _Pragma("unroll") for (int q_ = 0; q_ < 4; ++q_) { const int ko_ = 32 * (4 * (kb) + q_); fa[buf][q_] = *(const bf16x8*)(arow + ko_); \
        fb[buf][q_][0] = *(const bf16x8*)(b0 + ko_); fb[buf][q_][1] = *(const bf16x8*)(b1 + ko_); fb[buf][q_][2] = *(const bf16x8*)(b2 + ko_); fb[buf][q_][3] = *(const bf16x8*)(b3 + ko_); } } while (0)
#define SK_MMA(buf) do { _Pragma("unroll") for (int q_ = 0; q_ < 4; ++q_) { _Pragma("unroll") for (int j_ = 0; j_ < 4; ++j_) acc[j_] = __builtin_amdgcn_mfma_f32_16x16x32_bf16(fa[buf][q_], fb[buf][q_][j_], acc[j_], 0, 0, 0); } } while (0)
    SK_LOAD(0, 0);
#pragma unroll
    for (int kb = 0; kb < NBATCH; kb += 2) {
        SK_LOAD(1, kb + 1); SK_MMA(0);
        if (kb + 2 < NBATCH) SK_LOAD(0, kb + 2);
        SK_MMA(1);
    }
#undef SK_LOAD
#undef SK_MMA
}
__device__ __forceinline__ void sample_inproj(Frame& F, int pn, int hd, int rh) {
    const int lane = F.lane, w = F.wave & 3, kh = F.wave >> 2, rl = lane & 15, kq = lane >> 4;
    const bf16* HS = (const bf16*)(F.ws + WS_HS);
    const bf16* WINT = (const bf16*)(F.ws + WS_WINT);
    const bf16* bb = WINT + (size_t)(256 * pn + 32 * hd + rl) * 1024 + 512 * kh + 8 * kq;
    f32x4 acc[4];
    skinny_core<4>(HS + (size_t)(64 * rh + 16 * w + rl) * 1024 + 512 * kh + 8 * kq, bb, bb + 16 * 1024, bb + 128 * 1024, bb + 144 * 1024, acc);
    { LAS f32x4* red = (LAS f32x4*)(F.lds + RING_OFF);
      if (kh == 1) {
#pragma unroll
          for (int j = 0; j < 4; ++j) red[(w * 4 + j) * 64 + lane] = acc[j]; }
      __syncthreads();
      if (kh == 1) return;
#pragma unroll
      for (int j = 0; j < 4; ++j) acc[j] += red[(w * 4 + j) * 64 + lane]; }
    const int sbase = 64 * rh + 16 * w + 4 * kq;
    float* out = F.out;
    if (pn <= 1 || (pn == 2 && hd < 2)) {
        const float* nwp = pn <= 1 ? F.qnw : F.knw; const float sc = pn <= 1 ? C2 : 1.0f;
#pragma unroll
        for (int e = 0; e < 4; ++e) { float ss = 0.f;
#pragma unroll
            for (int j = 0; j < 4; ++j) ss += acc[j][e] * acc[j][e];
            ss += __shfl_xor(ss, 1); ss += __shfl_xor(ss, 2); ss += __shfl_xor(ss, 4); ss += __shfl_xor(ss, 8);
            const float rstd = 1.0f / sqrtf(ss * (1.0f / 64.0f) + EPS); const int s = sbase + e; const size_t m = (size_t)(MP + s);
#pragma unroll
            for (int j = 0; j < 4; ++j) { const int d = 16 * j + rl; const float o = acc[j][e] * rstd * nwp[d] * sc;
                if (pn <= 1) ((bf16*)(F.ws + WS_Q))[m * 512 + (4 * pn + hd) * 64 + d] = (bf16)f2bf(o);
                else { out[O_KS + (size_t)s * 128 + hd * 64 + d] = o; ((bf16*)(F.ws + WS_KB))[m * 128 + hd * 64 + d] = (bf16)f2bf(o); } } }
        return;
    }
    if (pn == 5 && hd == 1) {
        if (rl < 8) {
#pragma unroll
            for (int e = 0; e < 4; ++e) { const int s = sbase + e; ((float*)(F.ws + WS_WI))[(size_t)(MP + s) * 8 + rl] = acc[0][e] * WI_SCALE; } }
        return;
    }
    bf16* dst; int ld, cb; float* fo = nullptr; int fld = 0; bool act = false;
    if (pn == 2) { dst = (bf16*)(F.ws + WS_VB); ld = 128; cb = (hd - 2) * 64; fo = out + O_VS + cb; fld = 128; }
    else if (pn <= 4) { dst = (bf16*)(F.ws + WS_QI); ld = 512; cb = (4 * (pn - 3) + hd) * 64; }
    else if (pn == 5) { dst = (bf16*)(F.ws + WS_KI); ld = 64; cb = 0; fo = out + O_KIS; fld = 64; }
    else if (pn <= 7) { dst = (bf16*)(F.ws + WS_GA); ld = 512; cb = (4 * (pn - 6) + hd) * 64; act = true; }
    else if (pn <= 9) { dst = (bf16*)(F.ws + WS_U); ld = 512; cb = (4 * (pn - 8) + hd) * 64; fo = out + O_PS + 14 * 512 + cb; fld = 15 * 512; }
    else { dst = (bf16*)(F.ws + WS_GP); ld = 512; cb = (4 * (pn - 10) + hd) * 64; act = true; }
#pragma unroll
    for (int e = 0; e < 4; ++e) { const int s = sbase + e; const size_t m = (size_t)(MP + s);
#pragma unroll
        for (int j = 0; j < 4; ++j) { const int d = 16 * j + rl; float o = acc[j][e]; if (act) o = pg8::silu1(o);
            dst[m * ld + cb + d] = (bf16)f2bf(o);
            if (fo) fo[(size_t)s * fld + d] = o; } }
}
struct P1Pre { f32x4 v[2][4][4]; };
__device__ __forceinline__ void p1_prefetch(Frame& F, P1Pre& pre) {
    const int gw = F.vcu * NWAVES + F.wave, NGW = F.G * NWAVES;
#pragma unroll
    for (int k = 0; k < 2; ++k) { const int ch = gw + k * NGW; if (ch < MP / 4) norm_rows_load<4>(F, F.xp + (size_t)(4 * ch) * DM, pre.v[k]); }
}
__device__ __forceinline__ void p1_norm(Frame& F, P1Pre& pre) {
    const float* ada = (const float*)(F.ws + WS_ADA); bf16* HB = (bf16*)(F.ws + WS_HB); bf16* HS = (bf16*)(F.ws + WS_HS);
    const int gw = F.vcu * NWAVES + F.wave, NGW = F.G * NWAVES;
#pragma unroll
    for (int k = 0; k < 2; ++k) { const int ch = gw + k * NGW; if (ch < MP / 4) { const int m = 4 * ch; norm_rows_finish<4, true>(F, pre.v[k], ada + (size_t)(m >> 11) * 3072, 0, HB + (size_t)m * DM); } }
    for (int ch = gw + 2 * NGW; ch < MP / 4 + DECB / 2; ch += NGW) {
        if (ch < MP / 4) { const int m = 4 * ch; norm_rows<4, true>(F, F.xp + (size_t)m * DM, ada + (size_t)(m >> 11) * 3072, 0, HB + (size_t)m * DM); }
        else { const int s = 2 * (ch - MP / 4); norm_rows<2, false>(F, F.xs + (size_t)s * DM, ada + (size_t)(NB + s) * 3072, 3072, HS + (size_t)s * DM); } }
}
__device__ __forceinline__ void p2_sample(Frame& F) {
    const int task = F.bid >> 1, pn = task >> 2, hd = task & 3;
    if (F.bid < 96 && !(pn == 5 && hd >= 2)) { sample_inproj(F, pn, hd, F.bid & 1); __syncthreads(); }
    if (F.G > 192 + 16 && F.bid >= F.G - 32 && F.wave == 0) {
        const int r = F.bid - (F.G - 32), g = r >> 3, kb = (r >> 2) & 1, G = r & 3;
        transpose_item(F.w_pool + (size_t)g * 16384, 128, 32 * G, 32, (bf16*)(F.ws + WS_WPOOLT) + (size_t)g * 16384, 128, 32 * G, 64 * kb, (LAS float*)(F.lds + RING_OFF), F.lane);
    }
    if (F.G > 192 + 16 && F.bid >= F.G - 32) __syncthreads();
}

constexpr int P3_KEYS = 0;
constexpr int P3_BM = 132096;
constexpr int P3_WQ = 136192;
constexpr int P3_QI = 136704;
constexpr int P3_AI_HS = 144, P3_AI_RS = 1152;
constexpr int P3_AQ_HS = 160, P3_AQ_RS = 1408;
constexpr int P3_QL = 159232;
constexpr int P3_XM = 159232;
constexpr int P3_VW = 0, P3_VWB = 4096;

__device__ __forceinline__ float relu_s(float x) { return __builtin_amdgcn_fmed3f(x, 0.0f, __builtin_inff()); }
__device__ __forceinline__ unsigned f2key(float f) { unsigned u = __float_as_uint(f); if (f == 0.0f) u = 0u; return (u & 0x80000000u) ? ~u : (u | 0x80000000u); }
__device__ __forceinline__ float key2f(unsigned k) { return __uint_as_float((k & 0x80000000u) ? (k ^ 0x80000000u) : ~k); }

__device__ __forceinline__ unsigned half_reduce_add(unsigned v) {
    v += (unsigned)__builtin_amdgcn_update_dpp(0, (int)v, 0xB1, 0xF, 0xF, true);
    v += (unsigned)__builtin_amdgcn_update_dpp(0, (int)v, 0x4E, 0xF, 0xF, true);
    v += (unsigned)__builtin_amdgcn_update_dpp(0, (int)v, 0x141, 0xF, 0xF, true);
    v += (unsigned)__builtin_amdgcn_update_dpp(0, (int)v, 0x140, 0xF, 0xF, true);
    v += (unsigned)__builtin_amdgcn_ds_swizzle((int)v, 0x401F);
    return v;
}
__device__ __forceinline__ float probit_f(float p) {
    const float pp = p < 0.5f ? p : 1.0f - p; const float t = sqrtf(-2.0f * __logf(pp));
    const float z = t - (2.515517f + t * (0.802853f + t * 0.010328f)) * __builtin_amdgcn_rcpf(1.0f + t * (1.432788f + t * (0.189269f + t * 0.001308f)));
    return p < 0.5f ? -z : z;
}
__device__ __forceinline__ unsigned half_reduce_min(unsigned v) {
    v = min(v, (unsigned)__builtin_amdgcn_update_dpp(0, (int)v, 0xB1, 0xF, 0xF, true)); v = min(v, (unsigned)__builtin_amdgcn_update_dpp(0, (int)v, 0x4E, 0xF, 0xF, true));
    v = min(v, (unsigned)__builtin_amdgcn_update_dpp(0, (int)v, 0x141, 0xF, 0xF, true)); v = min(v, (unsigned)__builtin_amdgcn_update_dpp(0, (int)v, 0x140, 0xF, 0xF, true));
    v = min(v, (unsigned)__builtin_amdgcn_ds_swizzle((int)v, 0x401F)); return v; }
__device__ __forceinline__ unsigned half_reduce_max(unsigned v) {
    v = max(v, (unsigned)__builtin_amdgcn_update_dpp(0, (int)v, 0xB1, 0xF, 0xF, true)); v = max(v, (unsigned)__builtin_amdgcn_update_dpp(0, (int)v, 0x4E, 0xF, 0xF, true));
    v = max(v, (unsigned)__builtin_amdgcn_update_dpp(0, (int)v, 0x141, 0xF, 0xF, true)); v = max(v, (unsigned)__builtin_amdgcn_update_dpp(0, (int)v, 0x140, 0xF, 0xF, true));
    v = max(v, (unsigned)__builtin_amdgcn_ds_swizzle((int)v, 0x401F)); return v; }
__device__ __forceinline__ unsigned wave_reduce_add_u(unsigned v) {
    v += (unsigned)__builtin_amdgcn_update_dpp(0, (int)v, 0xB1, 0xF, 0xF, true); v += (unsigned)__builtin_amdgcn_update_dpp(0, (int)v, 0x4E, 0xF, 0xF, true);
    v += (unsigned)__builtin_amdgcn_update_dpp(0, (int)v, 0x141, 0xF, 0xF, true); v += (unsigned)__builtin_amdgcn_update_dpp(0, (int)v, 0x140, 0xF, 0xF, true);
    return ((unsigned)__builtin_amdgcn_readlane((int)v, 0) + (unsigned)__builtin_amdgcn_readlane((int)v, 16)) + ((unsigned)__builtin_amdgcn_readlane((int)v, 32) + (unsigned)__builtin_amdgcn_readlane((int)v, 48)); }
__device__ __forceinline__ float row16_sum(float v) {
    v += __int_as_float(__builtin_amdgcn_update_dpp(0, __float_as_int(v), 0xB1, 0xF, 0xF, true)); v += __int_as_float(__builtin_amdgcn_update_dpp(0, __float_as_int(v), 0x4E, 0xF, 0xF, true));
    v += __int_as_float(__builtin_amdgcn_update_dpp(0, __float_as_int(v), 0x141, 0xF, 0xF, true)); v += __int_as_float(__builtin_amdgcn_update_dpp(0, __float_as_int(v), 0x140, 0xF, 0xF, true));
    return v; }
__device__ __forceinline__ float kq_max(float v) {
    auto a = __builtin_amdgcn_permlane16_swap(__float_as_uint(v), __float_as_uint(v), false, false); v = fmaxf(__uint_as_float(a[0]), __uint_as_float(a[1]));
    auto b = __builtin_amdgcn_permlane32_swap(__float_as_uint(v), __float_as_uint(v), false, false); return fmaxf(__uint_as_float(b[0]), __uint_as_float(b[1])); }
__device__ __forceinline__ float kq_sum(float v) {
    auto a = __builtin_amdgcn_permlane16_swap(__float_as_uint(v), __float_as_uint(v), false, false); v = __uint_as_float(a[0]) + __uint_as_float(a[1]);
    auto b = __builtin_amdgcn_permlane32_swap(__float_as_uint(v), __float_as_uint(v), false, false); return __uint_as_float(b[0]) + __uint_as_float(b[1]); }
__device__ __forceinline__ unsigned wave_reduce_min_u(unsigned v) { v = half_reduce_min(v); return min((unsigned)__builtin_amdgcn_readlane((int)v, 0), (unsigned)__builtin_amdgcn_readlane((int)v, 32)); }
__device__ __forceinline__ unsigned wave_reduce_max_u(unsigned v) { v = half_reduce_max(v); return max((unsigned)__builtin_amdgcn_readlane((int)v, 0), (unsigned)__builtin_amdgcn_readlane((int)v, 32)); }

struct P3Pre { v4u qi[2]; v4u qq[2]; float wqv; };
__device__ __forceinline__ void p3_prefetch(Frame& F, int b, int qt, P3Pre& pre) {
    const int tid = F.tid; const size_t mb = (size_t)b * SEQ; const int t0 = 16 * qt;
    const bf16* QI = (const bf16*)(F.ws + WS_QI); const bf16* Qg = (const bf16*)(F.ws + WS_Q);
#pragma unroll
    for (int k = 0; k < 2; ++k) { const int i = tid + 512 * k, row = i >> 6, ch = i & 63;
        pre.qi[k] = *(const v4u*)(QI + (mb + t0 + row) * 512 + ch * 8); pre.qq[k] = *(const v4u*)(Qg + (mb + t0 + row) * 512 + ch * 8); }
    pre.wqv = ((const float*)(F.ws + WS_WI))[(mb + t0 + ((tid & 127) >> 3)) * 8 + (tid & 7)];
}
__device__ __forceinline__ void p3_prompt_item(Frame& F, int b, int qt, P3Pre& pre, bool has_next, int nb, int nqt) {
    int tid_o_ = F.tid; asm volatile("" : "+v"(tid_o_));
    const int tid = tid_o_, lane = tid & 63, w = F.wave, r = lane & 31, hh = lane >> 5;
    const int t0 = 16 * qt, L = t0 + 16, nkt32 = (L + 31) >> 5, nkt64 = (L + 63) >> 6;
    const size_t mb = (size_t)b * SEQ;
    LAS unsigned* bm = (LAS unsigned*)(F.lds + P3_BM);
    LAS float* wq = (LAS float*)(F.lds + P3_WQ);
    LAS unsigned* keys = (LAS unsigned*)(F.lds + P3_KEYS);
    v4u qreg[2] = {pre.qq[0], pre.qq[1]};
    if (tid < 128) wq[tid] = pre.wqv;
#pragma unroll
    for (int k = 0; k < 2; ++k) { const int i = tid + 512 * k, row = i >> 6, ch = i & 63; *(LAS v4u*)(F.lds + P3_QI + row * P3_AI_RS + (ch >> 3) * P3_AI_HS + (ch & 7) * 16) = pre.qi[k]; }
    bf16x8 bb[3][4];
    { const bf16* KI_ = (const bf16*)(F.ws + WS_KI); const int ns_ = (nkt32 - w + 7) >> 3;
      if (0 < ns_) { const bf16* kp_ = KI_ + (mb + 32 * w + r) * 64 + 8 * hh;
#pragma unroll
          for (int ks_ = 0; ks_ < 4; ++ks_) bb[0][ks_] = *(const bf16x8*)(kp_ + 16 * ks_); }
      if (1 < ns_) { const bf16* kp_ = KI_ + (mb + 32 * (w + 8) + r) * 64 + 8 * hh;
#pragma unroll
          for (int ks_ = 0; ks_ < 4; ++ks_) bb[1][ks_] = *(const bf16x8*)(kp_ + 16 * ks_); } }
    __syncthreads();
    { LAS unsigned short* ql = (LAS unsigned short*)(F.lds + P3_QL);
#pragma unroll
      for (int k = 0; k < 2; ++k) { const int i = tid + 512 * k, qq = i >> 6, d = i & 63; float s = 0.f;
#pragma unroll
          for (int h = 0; h < 8; ++h) s += wq[qq * 8 + h] * bf2f(*(const LAS unsigned short*)(F.lds + P3_QI + qq * P3_AI_RS + h * P3_AI_HS + d * 2));
          ql[qq * 64 + d] = (unsigned short)f2bf(s); } }
    __syncthreads();
    FSTAMP();
    for (int rep1_ = 0; rep1_ < REP_S1; ++rep1_) {
        const bf16* KI = (const bf16*)(F.ws + WS_KI);
        const int ns = (nkt32 - w + 7) >> 3;
#define P3_LDK(slot) do { const bf16* kp_ = KI + (mb + 32 * (w + 8 * (slot)) + r) * 64 + 8 * hh; \
        _Pragma("unroll") for (int ks_ = 0; ks_ < 4; ++ks_) bb[(slot) % 3][ks_] = *(const bf16x8*)(kp_ + 16 * ks_); } while (0)
        const int arow = (2 * ((r >> 2) & 1) + (r >> 4)) * P3_AI_RS + ((r & 3) + 4 * ((r >> 3) & 1)) * P3_AI_HS + 16 * hh;
        const LAS unsigned char* qib = F.lds + P3_QI;
        const int lq_ = 4 * ((((r & 3) + 4 * (r >> 3)) >> 1) & 3) + 2 * ((r >> 2) & 1) + (r & 1);
        const LAS unsigned char* qlb = F.lds + P3_QL + lq_ * 128 + 16 * hh;
#define P3_MM(ACC, a, s) do { _Pragma("unroll") for (int e_ = 0; e_ < 16; ++e_) ACC[e_] = 0.f; \
        _Pragma("unroll") for (int ks_ = 0; ks_ < 4; ++ks_) { const bf16x8 af_ = *(const LAS bf16x8*)(qs_ + 4 * (a) * P3_AI_RS + arow + 32 * ks_); \
            ACC = __builtin_amdgcn_mfma_f32_32x32x16_bf16(af_, bb[(s) % 3][ks_], ACC, 0, 0, 0); } } while (0)
#define P3_EPI(ACC, a, s, u_) do { _Pragma("unroll") for (int j2_ = 0; j2_ < 2; ++j2_) { const int qq_ = 4 * (a) + 2 * hh + j2_; \
        const LAS f32x4* wp_ = (const LAS f32x4*)(wq + qq_ * 8); const f32x4 w0_ = wp_[0], w1_ = wp_[1]; \
        float sc_ = accL[2 * (a) + j2_]; sc_ = fmaf(w0_[0], fabsf(ACC[8 * j2_ + 0]), sc_); sc_ = fmaf(w0_[1], fabsf(ACC[8 * j2_ + 1]), sc_); sc_ = fmaf(w0_[2], fabsf(ACC[8 * j2_ + 2]), sc_); sc_ = fmaf(w0_[3], fabsf(ACC[8 * j2_ + 3]), sc_); \
        sc_ = fmaf(w1_[0], fabsf(ACC[8 * j2_ + 4]), sc_); sc_ = fmaf(w1_[1], fabsf(ACC[8 * j2_ + 5]), sc_); sc_ = fmaf(w1_[2], fabsf(ACC[8 * j2_ + 6]), sc_); sc_ = fmaf(w1_[3], fabsf(ACC[8 * j2_ + 7]), sc_); \
        keys[qq_ * 2048 + 32 * (w + 8 * (s)) + r] = f2key(sc_); } } while (0)
#define P3_MML(ACC, s) do { _Pragma("unroll") for (int e_ = 0; e_ < 16; ++e_) ACC[e_] = 0.f; \
        _Pragma("unroll") for (int ks_ = 0; ks_ < 4; ++ks_) { bf16x8 af_ = (bf16x8){0, 0, 0, 0, 0, 0, 0, 0}; if (r < 16) af_ = *(const LAS bf16x8*)(qlb + zo_ + 32 * ks_); \
            ACC = __builtin_amdgcn_mfma_f32_32x32x16_bf16(af_, bb[(s) % 3][ks_], ACC, 0, 0, 0); } } while (0)
#pragma unroll 1
        for (int s0 = 0; s0 < ns; s0 += 3) {
#pragma unroll
            for (int u = 0; u < 3; ++u) { const int s = s0 + u;
                if (s < ns) {
                    if (s + 2 < ns) { const bf16* kp_ = KI + (mb + 32 * (w + 8 * (s + 2)) + r) * 64 + 8 * hh;
#pragma unroll
                        for (int ks_ = 0; ks_ < 4; ++ks_) bb[(u + 2) % 3][ks_] = *(const bf16x8*)(kp_ + 16 * ks_); }
                    int zo_ = 0; asm volatile("" : "+v"(zo_));
                    const LAS unsigned char* qs_ = qib + zo_;
                    f32x16 accA, accB, accL;
                    P3_MML(accL, u);
                    P3_MM(accA, 0, u); P3_MM(accB, 1, u);
                    P3_EPI(accA, 0, s, u); P3_MM(accA, 2, u);
                    P3_EPI(accB, 1, s, u); P3_MM(accB, 3, u);
                    P3_EPI(accA, 2, s, u); P3_EPI(accB, 3, s, u);
                }
            }
        }
#undef P3_MM
#undef P3_MML
#undef P3_EPI
#undef P3_LDK
    }
    __syncthreads();
    FSTAMP();
    {
#pragma unroll
      for (int k = 0; k < 2; ++k) { const int i = tid + 512 * k, row = i >> 6, ch = i & 63; *(LAS v4u*)(F.lds + P3_QI + row * P3_AQ_RS + (ch >> 3) * P3_AQ_HS + (ch & 7) * 16) = qreg[k]; } }
    bf16x8 kf0[2][2]; v4u vr0[4];
    { const int g_ = w & 1, kq4_ = w >> 1, j_ = lane & 15, kq_ = lane >> 4;
      if (kq4_ < nkt32) {
#pragma unroll
          for (int c = 0; c < 2; ++c)
#pragma unroll
              for (int ks = 0; ks < 2; ++ks) kf0[c][ks] = *(const bf16x8*)((const bf16*)(F.ws + WS_KB) + (mb + 32 * kq4_ + 16 * c + j_) * 128 + g_ * 64 + 32 * ks + 8 * kq_);
#pragma unroll
          for (int i = 0; i < 4; ++i) vr0[i] = *(const v4u*)((const bf16*)(F.ws + WS_VB) + (mb + 32 * kq4_ + 8 * i + (lane >> 3)) * 128 + g_ * 64 + (lane & 7) * 8); } }
    for (int rep2_ = 0; rep2_ < REP_S2; ++rep2_) {
        int lane_ = F.lane; asm volatile("" : "+v"(lane_));
#define lane lane_
        const int qx0 = 2 * w, tq0 = t0 + qx0;
        unsigned sel0, sel1;
        if (t0 + 16 <= 256) {
            sel0 = 0u; sel1 = 0u;
#pragma unroll
            for (int jj = 0; jj < 32; ++jj) { sel0 |= (64 * jj + lane <= tq0) ? (1u << jj) : 0u; sel1 |= (64 * jj + lane <= tq0 + 1) ? (1u << jj) : 0u; }
        } else {
            unsigned x[32], y[32];
#pragma unroll
            for (int jj = 0; jj < 32; ++jj) { const int l = 64 * jj + lane; x[jj] = (l <= tq0) ? keys[qx0 * 2048 + l] : 0u; y[jj] = (l <= tq0 + 1) ? keys[(qx0 + 1) * 2048 + l] : 0u; }
#pragma unroll
            for (int st = 0; st < 5; ++st) { const int j = 16 >> st; const unsigned m = st == 0 ? 0x0000ffffu : st == 1 ? 0x00ff00ffu : st == 2 ? 0x0f0f0f0fu : st == 3 ? 0x33333333u : 0x55555555u;
#pragma unroll
                for (int k = 0; k < 32; ++k) if (!(k & j)) { const unsigned t_ = ((x[k] >> j) ^ x[k + j]) & m; x[k] ^= t_ << j; x[k + j] ^= t_;
                    const unsigned u_ = ((y[k] >> j) ^ y[k + j]) & m; y[k] ^= u_ << j; y[k + j] ^= u_; } }
            unsigned cur0 = 0xffffffffu, gt0 = 0u, cur1 = 0xffffffffu, gt1 = 0u; int ab0 = 0, ab1 = 0;
#pragma unroll
            for (int b = 31; b >= 0; --b) { const unsigned c0 = cur0 & x[b], c1 = cur1 & y[b];
                const unsigned pk = wave_reduce_add_u((unsigned)__popc(c0) | ((unsigned)__popc(c1) << 16)); const int n0 = (int)(pk & 0xffffu), n1 = (int)(pk >> 16);
                if (ab0 + n0 >= 256) cur0 = c0; else { ab0 += n0; gt0 |= c0; cur0 &= ~x[b]; }
                if (ab1 + n1 >= 256) cur1 = c1; else { ab1 += n1; gt1 |= c1; cur1 &= ~y[b]; } }
            const unsigned pke = wave_reduce_add_u((unsigned)__popc(cur0) | ((unsigned)__popc(cur1) << 16));
            const unsigned long long lt = (1ull << lane) - 1ull;
            { int need = 256 - ab0; if ((int)(pke & 0xffffu) == need) sel0 = gt0 | cur0;
              else { sel0 = gt0;
                for (int jj = 0; jj < 32; ++jj) { const unsigned long long meq = __ballot((cur0 >> jj) & 1u);
                    if (((cur0 >> jj) & 1u) && __popcll(meq & lt) < need) sel0 |= 1u << jj;
                    const int pc_ = __popcll(meq); need = need > pc_ ? need - pc_ : 0; } } }
            { int need = 256 - ab1; if ((int)(pke >> 16) == need) sel1 = gt1 | cur1;
              else { sel1 = gt1;
                for (int jj = 0; jj < 32; ++jj) { const unsigned long long meq = __ballot((cur1 >> jj) & 1u);
                    if (((cur1 >> jj) & 1u) && __popcll(meq & lt) < need) sel1 |= 1u << jj;
                    const int pc_ = __popcll(meq); need = need > pc_ ? need - pc_ : 0; } } }
        }
#pragma unroll
        for (int jj = 0; jj < 32; ++jj) { const unsigned long long b0 = __ballot((sel0 >> jj) & 1u), b1 = __ballot((sel1 >> jj) & 1u);
            if (lane == 0) { bm[qx0 * 64 + 2 * jj] = (unsigned)b0; bm[qx0 * 64 + 2 * jj + 1] = (unsigned)(b0 >> 32); bm[(qx0 + 1) * 64 + 2 * jj] = (unsigned)b1; bm[(qx0 + 1) * 64 + 2 * jj + 1] = (unsigned)(b1 >> 32); } }
#undef lane
    }
    __syncthreads();
#if TEST_MODE
    { unsigned* dbg = (unsigned*)(F.ws + WS_DBG_BM) + (mb + t0) * 64; for (int i = tid; i < 1024; i += NWAVES * 64) dbg[i] = bm[i]; }
#endif
    FSTAMP();
    for (int rep4_ = 0; rep4_ < REP_S4; ++rep4_) {
        int l4_ = lane; asm volatile("" : "+v"(l4_));
        const int g = w & 1, kq4 = w >> 1, j = l4_ & 15, kq = l4_ >> 4;
        const bf16* Q = (const bf16*)(F.ws + WS_Q); const bf16* KB = (const bf16*)(F.ws + WS_KB); const bf16* VB = (const bf16*)(F.ws + WS_VB);
        const LAS unsigned char* qlb = F.lds + P3_QI + (j >> 2) * P3_AQ_RS + (4 * g + (j & 3)) * P3_AQ_HS + 16 * kq;
        bf16x8 qf[4][2];
#pragma unroll
        for (int rb = 0; rb < 4; ++rb)
#pragma unroll
            for (int ks = 0; ks < 2; ++ks) qf[rb][ks] = *(const LAS bf16x8*)(qlb + 4 * rb * P3_AQ_RS + 64 * ks);
        f32x4 o[4][4];
#pragma unroll
        for (int dt = 0; dt < 4; ++dt)
#pragma unroll
            for (int rb = 0; rb < 4; ++rb) o[dt][rb] = (f32x4){0.f, 0.f, 0.f, 0.f};
        float mref[4], lsum[4]; f32x4 negm[4];
#pragma unroll
        for (int rb = 0; rb < 4; ++rb) { mref[rb] = 0.f; lsum[rb] = 0.f; negm[rb] = (f32x4){0.f, 0.f, 0.f, 0.f}; }
        const int ntw = (nkt32 - kq4 + 3) >> 2;
        LAS unsigned char* vst = F.lds + P3_VW + w * (3 * P3_VWB);
        bf16x8 kf[2][2];
        const bf16* kgp = KB + (mb + j) * 128 + g * 64 + 8 * kq;
        const bf16* vgp = VB + (mb + (l4_ >> 3)) * 128 + g * 64 + (l4_ & 7) * 8;
#define P4_LOADK(dst, kt_) do { _Pragma("unroll") for (int c_ = 0; c_ < 2; ++c_) _Pragma("unroll") for (int ks_ = 0; ks_ < 2; ++ks_) dst[c_][ks_] = *(const bf16x8*)(kgp + (size_t)(32 * (kt_) + 16 * c_) * 128 + 32 * ks_); } while (0)
        const unsigned vst_u = (unsigned)(size_t)vst;
#define P4_DMAV(kt_, buf_) do { _Pragma("unroll") for (int i_ = 0; i_ < 4; ++i_) { unsigned keep_; const void* gs_ = (const void*)(vgp + (size_t)(32 * (kt_) + 8 * i_) * 128); \
        const unsigned ld_ = (unsigned)__builtin_amdgcn_readfirstlane((int)(vst_u + (buf_) * P3_VWB + i_ * 1024)); \
        asm volatile("s_mov_b32 %0, m0\n\ts_mov_b32 m0, %2\n\ts_nop 0\n\tglobal_load_lds_dwordx4 %1, off\n\ts_mov_b32 m0, %0" : "=&s"(keep_) : "v"(gs_), "s"(ld_) : "memory"); } } while (0)
        if (ntw > 0) {
#pragma unroll
            for (int c = 0; c < 2; ++c) { kf[c][0] = kf0[c][0]; kf[c][1] = kf0[c][1]; }
#pragma unroll
            for (int i = 0; i < 4; ++i) *(LAS v4u*)(vst + i * 1024 + l4_ * 16) = vr0[i]; }
        if (ntw > 1) { P4_DMAV(kq4 + 4, 1); }
        int vb_cur = 0;
#if TEST_MODE == 5
        unsigned long long tacc_[5] = {0, 0, 0, 0, 0}; unsigned long long tprev_ = __builtin_amdgcn_s_memtime();
#define TSEC(i) do { __builtin_amdgcn_sched_barrier(0); const unsigned long long tn_ = __builtin_amdgcn_s_memtime(); tacc_[i] += tn_ - tprev_; tprev_ = tn_; __builtin_amdgcn_sched_barrier(0); } while (0)
#else
#define TSEC(i) do { } while (0)
#endif
        for (int ti = 0; ti < ntw; ++ti) {
            const int kt = kq4 + 4 * ti;
            TSEC(4);
            asm volatile("s_waitcnt vmcnt(0)" ::: "memory");
            const int vb_n2 = vb_cur == 0 ? 2 : vb_cur - 1;
            if (ti + 2 < ntw) { P4_DMAV(kt + 8, vb_n2); }
            TSEC(0);
            f32x4 sa[2][4];
#pragma unroll
            for (int c = 0; c < 2; ++c)
#pragma unroll
                for (int ks = 0; ks < 2; ++ks)
#pragma unroll
                    for (int rb = 0; rb < 4; ++rb) sa[c][rb] = __builtin_amdgcn_mfma_f32_16x16x32_bf16(kf[c][ks], qf[rb][ks], ks == 0 ? negm[rb] : sa[c][rb], 0, 0, 0);
            if (ti + 1 < ntw) { P4_LOADK(kf, kt + 4); }
            TSEC(1);
            float tmax[4];
#pragma unroll
            for (int rb = 0; rb < 4; ++rb) { const int wd = (int)(bm[(4 * rb + (j >> 2)) * 64 + kt] >> (4 * kq)); float tm = -INFINITY;
#pragma unroll
                for (int c = 0; c < 2; ++c)
#pragma unroll
                    for (int e = 0; e < 4; ++e) { const unsigned keep = (unsigned)__builtin_amdgcn_sbfe(wd, 16 * c + e, 1);
                        const float v = __uint_as_float((__float_as_uint(sa[c][rb][e]) & keep) | (0xff800000u & ~keep)); sa[c][rb][e] = v; tm = fmaxf(tm, v); }
                tmax[rb] = tm; }
#pragma unroll
            for (int rb = 0; rb < 4; ++rb) tmax[rb] = kq_max(tmax[rb]);
            if (ti == 0 || __any(tmax[0] > 0.f || tmax[1] > 0.f || tmax[2] > 0.f || tmax[3] > 0.f)) {
#pragma unroll
                for (int rb = 0; rb < 4; ++rb) { const float dl = (ti == 0) ? ((tmax[rb] == -INFINITY) ? 0.f : tmax[rb]) : fmaxf(tmax[rb], 0.f); const float alpha = __builtin_amdgcn_exp2f(-dl); mref[rb] += dl; lsum[rb] *= alpha;
                    negm[rb] = (f32x4){-mref[rb], -mref[rb], -mref[rb], -mref[rb]};
#pragma unroll
                    for (int c = 0; c < 2; ++c) sa[c][rb] -= dl;
#pragma unroll
                    for (int dt = 0; dt < 4; ++dt) o[dt][rb] *= alpha; } }
            bf16x8 pf[4];
#pragma unroll
            for (int rb = 0; rb < 4; ++rb) { float ps = 0.f;
#pragma unroll
                for (int c = 0; c < 2; ++c)
#pragma unroll
                    for (int e = 0; e < 4; ++e) { const float p = __builtin_amdgcn_exp2f(sa[c][rb][e]); sa[c][rb][e] = p; ps += p; }
                lsum[rb] += ps;
                v4u pw; pw.x = pk2(sa[0][rb][0], sa[0][rb][1]); pw.y = pk2(sa[0][rb][2], sa[0][rb][3]); pw.z = pk2(sa[1][rb][0], sa[1][rb][1]); pw.w = pk2(sa[1][rb][2], sa[1][rb][3]);
                pf[rb] = __builtin_bit_cast(bf16x8, pw); }
            TSEC(2);
            { const LAS unsigned char* vb = vst + vb_cur * P3_VWB + (4 * kq + (j >> 2)) * 128 + (4 * (j & 3)) * 2;
              typedef short v4i16_t __attribute__((ext_vector_type(4)));
#pragma unroll
              for (int dt = 0; dt < 4; ++dt) {
                  const v4i16_t lo4 = __builtin_amdgcn_ds_read_tr16_b64_v4i16((LAS v4i16_t*)(vb + 32 * dt));
                  const v4i16_t hi4 = __builtin_amdgcn_ds_read_tr16_b64_v4i16((LAS v4i16_t*)(vb + 32 * dt + 16 * 128));
                  const bf16x8 vf = (bf16x8){lo4[0], lo4[1], lo4[2], lo4[3], hi4[0], hi4[1], hi4[2], hi4[3]};
#pragma unroll
                  for (int rb = 0; rb < 4; ++rb) o[dt][rb] = __builtin_amdgcn_mfma_f32_16x16x32_bf16(vf, pf[rb], o[dt][rb], 0, 0, 0); } }
            TSEC(3);
            vb_cur = vb_cur == 2 ? 0 : vb_cur + 1;
        }
#undef P4_LOADK
#if TEST_MODE == 5
        if (blockIdx.x == STAMP_BLK && threadIdx.x == 0) { unsigned* st_ = (unsigned*)(F.ws + WS_CTL + 900 * 1024); for (int i_ = 0; i_ < 5; ++i_) atomicAdd(st_ + 8 + i_, (unsigned)(tacc_[i_] >> 4)); atomicAdd(st_ + 13, (unsigned)ntw); }
#endif
#undef TSEC
#undef P4_DMAV
#pragma unroll
        for (int rb = 0; rb < 4; ++rb) lsum[rb] = kq_sum(lsum[rb]);
        if (has_next && rep4_ == REP_S4 - 1) p3_prefetch(F, nb, nqt, pre);
        const size_t mrow_m = mb + t0 + 4 * kq4 + (j >> 2); const int hd_m = 4 * g + (j & 3);
        v2u gvm[4];
#pragma unroll
        for (int dt = 0; dt < 4; ++dt) gvm[dt] = *(const v2u*)((const bf16*)(F.ws + WS_GA) + mrow_m * 512 + hd_m * 64 + 16 * dt + 4 * kq);
        __syncthreads();
        {
            LAS unsigned char* xo = F.lds + ((g * 4 + kq4) * 4) * 4096; LAS float* xm = (LAS float*)(F.lds + P3_XM) + ((g * 4 + kq4) * 4) * 32;
#pragma unroll
            for (int rb = 0; rb < 4; ++rb) {
#pragma unroll
                for (int dt = 0; dt < 4; ++dt) *(LAS f32x4*)(xo + rb * 4096 + dt * 1024 + l4_ * 16) = o[dt][rb];
                if (kq == 0) { xm[rb * 32 + j] = (lsum[rb] > 0.f) ? mref[rb] : -INFINITY; xm[rb * 32 + 16 + j] = lsum[rb]; } }
        }
        __syncthreads();
        {
            const int rb = kq4; float ms[4], ls[4]; float M = -INFINITY;
#pragma unroll
            for (int s4 = 0; s4 < 4; ++s4) { const LAS float* xm = (const LAS float*)(F.lds + P3_XM) + ((g * 4 + s4) * 4 + rb) * 32; ms[s4] = xm[j]; ls[s4] = xm[16 + j]; M = fmaxf(M, ms[s4]); }
            float Lt = 0.f; f32x4 oo[4];
#pragma unroll
            for (int dt = 0; dt < 4; ++dt) oo[dt] = (f32x4){0.f, 0.f, 0.f, 0.f};
#pragma unroll
            for (int s4 = 0; s4 < 4; ++s4) { const float sc = __builtin_amdgcn_exp2f(ms[s4] - M); Lt += ls[s4] * sc;
                const LAS unsigned char* xo = F.lds + (((g * 4 + s4) * 4) + rb) * 4096;
#pragma unroll
                for (int dt = 0; dt < 4; ++dt) oo[dt] += *(const LAS f32x4*)(xo + dt * 1024 + l4_ * 16) * sc; }
            const float inv = 1.0f / Lt;
            const size_t mrow = mrow_m; const int hd = hd_m;
            bf16* MIX = (bf16*)(F.ws + WS_MIX);
#pragma unroll
            for (int dt = 0; dt < 4; ++dt) { const int d = 16 * dt + 4 * kq; const v2u gv = gvm[dt];
                const float g0 = bf2f((unsigned short)(gv.x & 0xffffu)), g1 = bf2f((unsigned short)(gv.x >> 16)), g2 = bf2f((unsigned short)(gv.y & 0xffffu)), g3 = bf2f((unsigned short)(gv.y >> 16));
                v2u ov; ov.x = pk2(oo[dt][0] * inv * g0, oo[dt][1] * inv * g1); ov.y = pk2(oo[dt][2] * inv * g2, oo[dt][3] * inv * g3);
                *(v2u*)(MIX + mrow * 1024 + hd * 64 + d) = ov; }
        }
        if (REP_S4 > 1) __syncthreads();
    }
}

constexpr int PL_U = 0, PL_W = 40960, PL_STRIDE = 272;
template <bool SAMPLE> __device__ __forceinline__ void p3_pool_item(Frame& F, int item) {
    const int tid = F.tid, lane = F.lane, w = F.wave, j = lane & 15, kq = lane >> 4;
    const bf16* U = (const bf16*)(F.ws + WS_U); const bf16* GP = (const bf16*)(F.ws + WS_GP); const bf16* WPT = (const bf16*)(F.ws + WS_WPOOLT); bf16* MIX = (bf16*)(F.ws + WS_MIX);
    const int tokb = SAMPLE ? 0 : (item & 15) * 128;
    const size_t m0 = SAMPLE ? (size_t)MP : (size_t)(item >> 4) * SEQ + tokb;
    const int tl = 16 * w + j;
    const size_t mrow = m0 + tl;
    v4u wr_[4], ur_[5];
#define PL_LOAD(gg) do { _Pragma("unroll") for (int k_ = 0; k_ < 4; ++k_) { const int i_ = tid + 512 * k_; wr_[k_] = *(const v4u*)(WPT + (size_t)(gg) * 16384 + (i_ >> 4) * 128 + (i_ & 15) * 8); } \
        if (!SAMPLE) { _Pragma("unroll") for (int k_ = 0; k_ < 5; ++k_) { const int i_ = tid + 512 * k_; const int row_ = i_ >> 4, ch_ = i_ & 15; ur_[k_] = (v4u){0u, 0u, 0u, 0u}; \
            if (i_ < 143 * 16 && tokb - 15 + row_ >= 0) ur_[k_] = *(const v4u*)(U + (m0 - 15 + row_) * 512 + (gg) * 128 + ch_ * 8); } } } while (0)
#define PL_STORE() do { _Pragma("unroll") for (int k_ = 0; k_ < 4; ++k_) { const int i_ = tid + 512 * k_; *(LAS v4u*)(F.lds + PL_W + (i_ >> 4) * PL_STRIDE + (i_ & 15) * 16) = wr_[k_]; } \
        if (!SAMPLE) { _Pragma("unroll") for (int k_ = 0; k_ < 5; ++k_) { const int i_ = tid + 512 * k_; if (i_ < 143 * 16) *(LAS v4u*)(F.lds + PL_U + (i_ >> 4) * PL_STRIDE + (i_ & 15) * 16) = ur_[k_]; } } } while (0)
    PL_LOAD(0);
#pragma unroll
    for (int g = 0; g < 4; ++g) {
        const int win = 2 << g;
        PL_STORE();
        __syncthreads();
        if (g + 1 < 4) PL_LOAD(g + 1);
        bf16x8 df[4];
#pragma unroll
        for (int ks = 0; ks < 4; ++ks) {
            float sum[8], cur[8];
            if (!SAMPLE) {
                const LAS unsigned char* up = F.lds + PL_U + (15 + tl) * PL_STRIDE + (4 * ks + kq) * 16;
                { const v4u c = *(const LAS v4u*)up;
#pragma unroll
                  for (int u = 0; u < 4; ++u) { const unsigned x = c[u]; cur[2 * u] = bf2f((unsigned short)(x & 0xffffu)); cur[2 * u + 1] = bf2f((unsigned short)(x >> 16)); sum[2 * u] = cur[2 * u]; sum[2 * u + 1] = cur[2 * u + 1]; } }
#pragma unroll
                for (int i = 1; i < win; ++i) { const v4u c = *(const LAS v4u*)(up - i * PL_STRIDE);
#pragma unroll
                    for (int u = 0; u < 4; ++u) { const unsigned x = c[u]; sum[2 * u] += bf2f((unsigned short)(x & 0xffffu)); sum[2 * u + 1] += bf2f((unsigned short)(x >> 16)); } }
            } else {
                const int c0 = g * 128 + 32 * ks + 8 * kq;
                { const v4u c = *(const v4u*)(U + mrow * 512 + c0);
#pragma unroll
                  for (int u = 0; u < 4; ++u) { const unsigned x = c[u]; cur[2 * u] = bf2f((unsigned short)(x & 0xffffu)); cur[2 * u + 1] = bf2f((unsigned short)(x >> 16)); sum[2 * u] = cur[2 * u]; sum[2 * u + 1] = cur[2 * u + 1]; } }
#pragma unroll
                for (int i = 1; i < win; ++i) { const float* sp = F.state_pool + ((size_t)tl * 15 + (15 - i)) * 512 + c0; const f32x4 a = *(const f32x4*)sp, bq = *(const f32x4*)(sp + 4);
                    sum[0] += a[0]; sum[1] += a[1]; sum[2] += a[2]; sum[3] += a[3]; sum[4] += bq[0]; sum[5] += bq[1]; sum[6] += bq[2]; sum[7] += bq[3]; }
            }
            const int tpos = tokb + tl; const float rc = 1.0f / (float)(SAMPLE ? win : ((tpos + 1 < win) ? tpos + 1 : win));
            v4u pw; pw.x = pk2(sum[0] * rc - cur[0], sum[1] * rc - cur[1]); pw.y = pk2(sum[2] * rc - cur[2], sum[3] * rc - cur[3]);
            pw.z = pk2(sum[4] * rc - cur[4], sum[5] * rc - cur[5]); pw.w = pk2(sum[6] * rc - cur[6], sum[7] * rc - cur[7]);
            df[ks] = __builtin_bit_cast(bf16x8, pw);
        }
#pragma unroll
        for (int jt = 0; jt < 8; ++jt) {
            f32x4 acc = (f32x4){0.f, 0.f, 0.f, 0.f};
#pragma unroll
            for (int ks = 0; ks < 4; ++ks) { const bf16x8 wf = *(const LAS bf16x8*)(F.lds + PL_W + (16 * jt + j) * PL_STRIDE + (4 * ks + kq) * 16);
                acc = __builtin_amdgcn_mfma_f32_16x16x32_bf16(wf, df[ks], acc, 0, 0, 0); }
            const int col = g * 128 + 16 * jt + 4 * kq;
            const f32x4 ps = *(const f32x4*)(F.pool_scale + col); const v2u gv = *(const v2u*)(GP + mrow * 512 + col);
            const float g0 = bf2f((unsigned short)(gv.x & 0xffffu)), g1 = bf2f((unsigned short)(gv.x >> 16)), g2 = bf2f((unsigned short)(gv.y & 0xffffu)), g3 = bf2f((unsigned short)(gv.y >> 16));
            v2u ov; ov.x = pk2(acc[0] * ps[0] * g0, acc[1] * ps[1] * g1); ov.y = pk2(acc[2] * ps[2] * g2, acc[3] * ps[3] * g3);
            *(v2u*)(MIX + mrow * 1024 + 512 + col) = ov;
        }
        __syncthreads();
    }
#undef PL_LOAD
#undef PL_STORE
}

constexpr int SM_SC = 0, SM_SEL = 8448, SM_Q = 9472, SM_P = 11520, SM_RED = 19712, SM_PT = 36096;
__device__ __forceinline__ void p3_sample_item(Frame& F, int s) {
    const int tid = F.tid, lane = F.lane, w = F.wave, r = lane & 31, hh = lane >> 5;
    const size_t m = (size_t)MP + s;
    LAS float* sc = (LAS float*)(F.lds + SM_SC); LAS int* sel = (LAS int*)(F.lds + SM_SEL); LAS float* ql = (LAS float*)(F.lds + SM_Q);
    LAS float* pl = (LAS float*)(F.lds + SM_P); LAS float* red = (LAS float*)(F.lds + SM_RED); LAS int* ptl = (LAS int*)(F.lds + SM_PT);
    const bf16* QI = (const bf16*)(F.ws + WS_QI) + m * 512; const float* WIp = (const float*)(F.ws + WS_WI) + m * 8;
    const int* pt = F.page_table + s * NPG;
    ql[tid] = bf2f(((const bf16*)(F.ws + WS_Q))[m * 512 + tid]);
    if (tid < NPG) ptl[tid] = pt[tid];
    {
        bf16x8 af[4];
#pragma unroll
        for (int ks = 0; ks < 4; ++ks) { af[ks] = (bf16x8){0, 0, 0, 0, 0, 0, 0, 0}; if (r < 8) af[ks] = *(const bf16x8*)(QI + r * 64 + 16 * ks + 8 * hh); }
        float wv[4];
#pragma unroll
        for (int e = 0; e < 4; ++e) wv[e] = WIp[4 * hh + e];
        int pg[8];
#pragma unroll
        for (int it = 0; it < 8; ++it) pg[it] = pt[(w + 8 * it) >> 2];
#pragma unroll
        for (int hf = 0; hf < 2; ++hf) {
            f32x4 x0[4][4], x1[4][4];
#pragma unroll
            for (int i4 = 0; i4 < 4; ++i4) { const int kt = w + 8 * (4 * hf + i4);
                const float* kp = F.cache_kidx + ((size_t)pg[4 * hf + i4] * PAGE + (kt & 3) * 32 + r) * 64 + 8 * hh;
#pragma unroll
                for (int ks = 0; ks < 4; ++ks) { x0[i4][ks] = *(const f32x4*)(kp + 16 * ks); x1[i4][ks] = *(const f32x4*)(kp + 16 * ks + 4); } }
#pragma unroll
            for (int i4 = 0; i4 < 4; ++i4) { const int kt = w + 8 * (4 * hf + i4);
                f32x16 acc;
#pragma unroll
                for (int e = 0; e < 16; ++e) acc[e] = 0.f;
#pragma unroll
                for (int ks = 0; ks < 4; ++ks) {
                    v4u pw; pw.x = pk2(x0[i4][ks][0], x0[i4][ks][1]); pw.y = pk2(x0[i4][ks][2], x0[i4][ks][3]); pw.z = pk2(x1[i4][ks][0], x1[i4][ks][1]); pw.w = pk2(x1[i4][ks][2], x1[i4][ks][3]);
                    acc = __builtin_amdgcn_mfma_f32_32x32x16_bf16(af[ks], __builtin_bit_cast(bf16x8, pw), acc, 0, 0, 0); }
                float part = wv[0] * fmaxf(acc[0], 0.f) + wv[1] * fmaxf(acc[1], 0.f) + wv[2] * fmaxf(acc[2], 0.f) + wv[3] * fmaxf(acc[3], 0.f);
                part += __shfl_xor(part, 32);
                if (hh == 0) sc[32 * kt + r] = part; }
        }
        if (w == 0) {
            const float kv = bf2f(((const bf16*)(F.ws + WS_KI))[m * 64 + lane]); float tot = 0.f;
#pragma unroll
            for (int h = 0; h < 8; ++h) { const float d = wave_sum(bf2f(QI[h * 64 + lane]) * kv); tot += WIp[h] * fmaxf(d, 0.f); }
            if (lane == 0) sc[PAST] = tot;
        }
    }
    __syncthreads();
    if (w == 0) {
        unsigned x[32];
#pragma unroll
        for (int jj = 0; jj < 32; ++jj) x[jj] = f2key(sc[64 * jj + lane]);
        const unsigned ke = (unsigned)__builtin_amdgcn_readfirstlane((int)f2key(sc[PAST]));
#pragma unroll
        for (int st = 0; st < 5; ++st) { const int j = 16 >> st; const unsigned mk = st == 0 ? 0x0000ffffu : st == 1 ? 0x00ff00ffu : st == 2 ? 0x0f0f0f0fu : st == 3 ? 0x33333333u : 0x55555555u;
#pragma unroll
            for (int k = 0; k < 32; ++k) if (!(k & j)) { const unsigned t_ = ((x[k] >> j) ^ x[k + j]) & mk; x[k] ^= t_ << j; x[k + j] ^= t_; } }
        unsigned cur = 0xffffffffu, gt = 0u; int ab = 0; bool ecur = true, egt = false;
#pragma unroll
        for (int b = 31; b >= 0; --b) { const unsigned c0 = cur & x[b]; const bool eb = ecur && ((ke >> b) & 1u);
            const int n = (int)wave_reduce_add_u((unsigned)__popc(c0)) + (eb ? 1 : 0);
            if (ab + n >= 256) { cur = c0; ecur = eb; } else { ab += n; gt |= c0; egt = egt || eb; cur &= ~x[b]; ecur = ecur && !eb; } }
        const int neq = (int)wave_reduce_add_u((unsigned)__popc(cur)); int need = 256 - ab;
        const bool take_e = egt || (ecur && need > neq);
        const unsigned long long lt = (1ull << lane) - 1ull;
        unsigned selm = gt;
        if (neq <= need) selm |= cur;
        else {
            for (int jj = 0; jj < 32; ++jj) { const unsigned long long meq = __ballot((cur >> jj) & 1u);
                if (((cur >> jj) & 1u) && __popcll(meq & lt) < need) selm |= 1u << jj;
                const int pc_ = __popcll(meq); need = need > pc_ ? need - pc_ : 0; } }
        int pos = 0;
#pragma unroll
        for (int jj = 0; jj < 32; ++jj) { const bool take = (selm >> jj) & 1u; const unsigned long long mt = __ballot(take);
            if (take) sel[pos + __popcll(mt & lt)] = ptl[jj >> 1] * PAGE + ((64 * jj + lane) & 127);
            pos += __popcll(mt); }
        if (take_e && lane == 0) sel[pos] = -1;
    }
    __syncthreads();
    {
        const int c4 = 4 * (lane & 31), g = (lane >> 4) & 1, rp = lane >> 5;
        f32x4 kv[16], vv[16];
#pragma unroll
        for (int i = 0; i < 16; ++i) { const int pr = sel[32 * w + 2 * i + rp];
            const float* krow = pr >= 0 ? F.cache_k + (size_t)pr * 128 : F.out + O_KS + (size_t)s * 128; kv[i] = *(const f32x4*)(krow + c4); }
#pragma unroll
        for (int i = 0; i < 16; ++i) { const int pr = sel[32 * w + 2 * i + rp];
            const float* vrow = pr >= 0 ? F.cache_v + (size_t)pr * 128 : F.out + O_VS + (size_t)s * 128; vv[i] = *(const f32x4*)(vrow + c4); }
        f32x4 qv[4];
#pragma unroll
        for (int rr = 0; rr < 4; ++rr) qv[rr] = *(const LAS f32x4*)(ql + (4 * g + rr) * 64 + 4 * (lane & 15));
#pragma unroll
        for (int i = 0; i < 16; ++i) {
#pragma unroll
            for (int rr = 0; rr < 4; ++rr) { float p = (qv[rr][0] * kv[i][0] + qv[rr][1] * kv[i][1]) + (qv[rr][2] * kv[i][2] + qv[rr][3] * kv[i][3]);
                p = row16_sum(p);
                if ((lane & 15) == 0) pl[(4 * g + rr) * 256 + 32 * w + 2 * i + rp] = p; } }
        __syncthreads();
        {
            float v[4]; float mx = -INFINITY;
#pragma unroll
            for (int i = 0; i < 4; ++i) { v[i] = pl[w * 256 + lane + 64 * i]; mx = fmaxf(mx, v[i]); }
            mx = wave_max(mx); float sm = 0.f;
#pragma unroll
            for (int i = 0; i < 4; ++i) { v[i] = __builtin_amdgcn_exp2f(v[i] - mx); sm += v[i]; }
            sm = wave_sum(sm); const float inv = 1.0f / sm;
#pragma unroll
            for (int i = 0; i < 4; ++i) pl[w * 256 + lane + 64 * i] = v[i] * inv;
        }
        __syncthreads();
        f32x4 acc[4];
#pragma unroll
        for (int rr = 0; rr < 4; ++rr) acc[rr] = (f32x4){0.f, 0.f, 0.f, 0.f};
#pragma unroll
        for (int i = 0; i < 16; ++i) {
#pragma unroll
            for (int rr = 0; rr < 4; ++rr) { const float p = pl[(4 * g + rr) * 256 + 32 * w + 2 * i + rp];
                acc[rr][0] += p * vv[i][0]; acc[rr][1] += p * vv[i][1]; acc[rr][2] += p * vv[i][2]; acc[rr][3] += p * vv[i][3]; } }
#pragma unroll
        for (int rr = 0; rr < 4; ++rr) {
#pragma unroll
            for (int c = 0; c < 4; ++c) acc[rr][c] += __shfl_xor(acc[rr][c], 32);
            if (rp == 0) *(LAS f32x4*)(red + ((w * 8 + 4 * g + rr) * 64) + 4 * (lane & 15)) = acc[rr]; }
    }
    __syncthreads();
    { const int h = tid >> 6, d = tid & 63; float a = 0.f;
#pragma unroll
        for (int k8 = 0; k8 < 8; ++k8) a += red[(k8 * 8 + h) * 64 + d];
        const float gate = bf2f(((const bf16*)(F.ws + WS_GA))[m * 512 + tid]);
        ((bf16*)(F.ws + WS_MIX))[m * 1024 + tid] = (bf16)f2bf(a * gate); }
    { const int c = tid, g = c >> 7, win = 2 << g; const float un = bf2f(((const bf16*)(F.ws + WS_U))[m * 512 + c]); float sum = un;
      const float* sp = F.state_pool + (size_t)s * 15 * 512 + c;
      float hv[15];
#pragma unroll
      for (int i = 1; i < 16; ++i) hv[i - 1] = sp[(size_t)(15 - i) * 512];
#pragma unroll
      for (int i = 1; i < 16; ++i) sum += (i < win) ? hv[i - 1] : 0.f;
      ql[c] = bf2f((unsigned short)f2bf(sum / (float)win - un)); }
    __syncthreads();
    { const int col = tid, g = col >> 7, j = col & 127; const bf16* wr = (const bf16*)(F.ws + WS_WPOOLT) + (size_t)g * 16384 + j * 128;
      v4u wv4[16];
#pragma unroll
      for (int i = 0; i < 16; ++i) wv4[i] = *(const v4u*)(wr + 8 * i);
      float acc = 0.f;
#pragma unroll
      for (int i = 0; i < 16; ++i) { const LAS f32x4* dp = (const LAS f32x4*)(ql + g * 128 + 8 * i); const f32x4 d0 = dp[0], d1 = dp[1];
          acc += d0[0] * bf2f((unsigned short)(wv4[i].x & 0xffffu)) + d0[1] * bf2f((unsigned short)(wv4[i].x >> 16)) + d0[2] * bf2f((unsigned short)(wv4[i].y & 0xffffu)) + d0[3] * bf2f((unsigned short)(wv4[i].y >> 16));
          acc += d1[0] * bf2f((unsigned short)(wv4[i].z & 0xffffu)) + d1[1] * bf2f((unsigned short)(wv4[i].z >> 16)) + d1[2] * bf2f((unsigned short)(wv4[i].w & 0xffffu)) + d1[3] * bf2f((unsigned short)(wv4[i].w >> 16)); }
      const float gp = bf2f(((const bf16*)(F.ws + WS_GP))[m * 512 + col]);
      ((bf16*)(F.ws + WS_MIX))[m * 1024 + 512 + col] = (bf16)f2bf(acc * F.pool_scale[col] * gp); }
    __syncthreads();
}

__device__ __forceinline__ void p3_mixer(Frame& F) {
    P3Pre pre; int cb, cqt; bool cv;
#define P3_ITEM(i_, ok_, b_, qt_) do { if (F.G == 256) { ok_ = (i_) < 4; \
            const int idx_ = F.bid >> 3, i2_ = idx_ & 15, pi_ = i2_ + 16 * (((i_) >> 1) & 1), grp_ = pi_ >> 4, k_ = pi_ & 15; const bool light_ = idx_ < 16; \
            const int x1_ = (k_ & 7) + 16 * (k_ >> 3) + (light_ ? 0 : 8), sm_ = grp_ ? 32 + x1_ : (light_ ? k_ : 16 + k_), sum_ = grp_ ? (light_ ? 119 : 135) : (light_ ? 111 : 143); \
            b_ = F.bid & 7; qt_ = ((i_) & 1) ? sm_ : sum_ - sm_; } \
        else { const int p_ = F.bid + ((i_) >> 1) * F.G; ok_ = p_ < 512; b_ = (p_ >> 6) & 7; qt_ = ((i_) & 1) ? (p_ & 63) : 127 - (p_ & 63); } } while (0)
    P3_ITEM(0, cv, cb, cqt);
    if (cv) p3_prefetch(F, cb, cqt, pre);
#pragma unroll 1
    for (int i = 0; cv; ++i) {
        int nb, nqt; bool nv;
        P3_ITEM(i + 1, nv, nb, nqt);
        p3_prompt_item(F, cb, cqt, pre, nv, nb, nqt); __syncthreads(); FSTAMP();
        cv = nv; cb = nb; cqt = nqt;
    }
#undef P3_ITEM
    for (int x = F.bid; x < 128; x += F.G) { for (int rp_ = 0; rp_ < REP_SMP; ++rp_) { p3_sample_item(F, x); __syncthreads(); } FSTAMP(); }
    for (int x = F.bid + ((F.bid < 128) ? ((128 - F.bid + F.G - 1) / F.G) * F.G : 0); x < 256; x += F.G) { for (int rp_ = 0; rp_ < REP_POOL; ++rp_) { p3_pool_item<false>(F, x - 128); __syncthreads(); } FSTAMP(); }
}
struct P4SPre { bf16x8 fb[32]; };
__device__ __forceinline__ void p4_sample_prefetch(Frame& F, P4SPre& pre) {
    if (F.bid >= 64) return;
    const int rl = F.lane & 15, kq = F.lane >> 4, n0 = F.bid * 16;
    const bf16* bp = (const bf16*)(F.ws + WS_WOUTT) + (size_t)(n0 + rl) * 1024 + 8 * kq;
#pragma unroll
    for (int i = 0; i < 32; ++i) pre.fb[i] = *(const bf16x8*)(bp + 32 * i);
}
__device__ __forceinline__ void p4_sample_out(Frame& F, P4SPre& pre) {
    if (F.bid >= 64) return;
    const int lane = F.lane, w = F.wave, rl = lane & 15, kq = lane >> 4, n0 = F.bid * 16;
    const bf16* ap = (const bf16*)(F.ws + WS_MIX) + (size_t)(MP + 16 * w + rl) * 1024 + 8 * kq;
    const float* ada = (const float*)(F.ws + WS_ADA);
    float xv[4], gv[4];
#pragma unroll
    for (int e = 0; e < 4; ++e) { const int s = 16 * w + 4 * kq + e, n = n0 + rl; xv[e] = F.xs[(size_t)s * 1024 + n]; gv[e] = ada[(size_t)(NB + s) * 3072 + 2048 + n]; }
    f32x4 acc = (f32x4){0.f, 0.f, 0.f, 0.f};
    bf16x8 fa[32];
#pragma unroll
    for (int i = 0; i < 32; ++i) fa[i] = *(const bf16x8*)(ap + 32 * i);
#pragma unroll
    for (int i = 0; i < 32; ++i) acc = __builtin_amdgcn_mfma_f32_16x16x32_bf16(fa[i], pre.fb[i], acc, 0, 0, 0);
#pragma unroll
    for (int e = 0; e < 4; ++e) { const int s = 16 * w + 4 * kq + e, n = n0 + rl; F.out[O_YS + (size_t)s * 1024 + n] = xv[e] + gv[e] * acc[e]; }
}

struct Args { const float* in[18]; float* out; unsigned char* ws; int ph_lo, ph_hi, li, pad; };
__global__ void __launch_bounds__(NWAVES * 64, 2) mk_fwd(Args args) {
    extern __shared__ __attribute__((aligned(16))) unsigned char lds[];
    Frame F;
    F.lds = (LAS unsigned char*)lds;
    F.MISC = (volatile LAS unsigned*)(F.lds + MISC_OFF);
    F.tid = threadIdx.x; F.lane = F.tid & 63; F.wave = __builtin_amdgcn_readfirstlane(F.tid >> 6);
    F.G = gridDim.x; F.bid = blockIdx.x; { const int bx = blockIdx.x; F.vcu = (F.G % 8 == 0) ? (bx % 8) * (F.G / 8) + bx / 8 : bx; }
    F.ws = args.ws; F.out = args.out; F.ctl = (gu32*)(args.ws + WS_CTL);
    F.xp = args.in[0]; F.xs = args.in[1]; F.cache_k = args.in[2]; F.cache_v = args.in[3]; F.cache_kidx = args.in[4]; F.state_pool = args.in[5];
    F.page_table = (const int*)args.in[6]; F.cp = args.in[7]; F.cs = args.in[8]; F.norm_w = args.in[9]; F.w_ada = args.in[10]; F.b_ada = args.in[11];
    F.w_in = args.in[12]; F.qnw = args.in[13]; F.knw = args.in[14]; F.w_pool = args.in[15]; F.pool_scale = args.in[16]; F.w_out = args.in[17];
    for (int u = F.tid; u < (LDS_BYTES - LDSCTL_OFF) / 4; u += NWAVES * 64) ((LAS unsigned*)(F.lds + LDSCTL_OFF))[u] = 0u;
    __syncthreads();
    XcdBarrier bar = xcd_barrier_post((unsigned*)(F.ctl + CW_BAR) + args.li * XCD_BAR_WORDS, F.MISC + 8);
    const int lo = args.ph_lo, hi = args.ph_hi;
#if TEST_MODE == 4
    unsigned long long* ts = (unsigned long long*)(args.ws + WS_CTL + 768 * 1024); int nst = 0;
#define STAMP() do { if (blockIdx.x == STAMP_BLK && threadIdx.x == 0) ts[nst] = __builtin_amdgcn_s_memrealtime(); ++nst; } while (0)
#if P3FINE
    F.ts = ts + 16; F.nst = 0;
#endif
#else
#define STAMP() do { } while (0)
#endif
    STAMP();
#define IN(k) (lo <= (k) && (k) < hi)
#define BOTH(k) (IN(k) && IN((k) + 1))
    P1Pre p1pre;
    if (IN(0)) { for (int rp_ = 0; rp_ < REP_P0; ++rp_) { p0_prologue(F); if (rp_ + 1 < REP_P0) __syncthreads(); }
#if TEST_MODE == 6 && BSITE == 1
        if (threadIdx.x == 0) ((unsigned long long*)(F.ws + WS_CTL + 800 * 1024))[blockIdx.x] = __builtin_amdgcn_s_memrealtime();
#endif
        STAMP(); if (IN(1)) p1_prefetch(F, p1pre); if (BOTH(0)) xcd_barrier(bar); STAMP(); }
    else if (IN(1)) p1_prefetch(F, p1pre);
    if (IN(1)) { for (int rp_ = 0; rp_ < REP_P1; ++rp_) p1_norm(F, p1pre); STAMP(); if (BOTH(1)) xcd_barrier(bar); STAMP(); }
    if (IN(2)) {
        for (int rp_ = 0; rp_ < REP_P2S; ++rp_) p2_sample(F);
        pg8::Gemm g{(const pg8::bf16_t*)(F.ws + WS_HB), (const pg8::bf16_t*)(F.ws + WS_WINT), MP, 3072, DM};
        pg8::StaticOrder S; S.init(MP, 3072, F.G, (int)blockIdx.x);
        pg8::EpiIn E{F.ws, F.out, F.qnw, F.knw};
        for (int rp_ = 0; rp_ < REP_P2G; ++rp_) pg8::gemm_phase<pg8::EpiIn, pg8::StaticOrder, true, true>(F.lds + RING_OFF, g, S, E);
        STAMP(); if (BOTH(2)) xcd_barrier(bar); STAMP();
    }
#if HAVE_P3
    P4SPre p4pre;
    if (IN(3)) { p3_mixer(F);
#if TEST_MODE == 6 && BSITE == 0
        if (threadIdx.x == 0) ((unsigned long long*)(F.ws + WS_CTL + 800 * 1024))[blockIdx.x] = __builtin_amdgcn_s_memrealtime();
#endif
        STAMP(); if (IN(4)) p4_sample_prefetch(F, p4pre); if (BOTH(3)) xcd_barrier(bar); STAMP(); }
    else if (IN(4)) p4_sample_prefetch(F, p4pre);
#endif
    if (IN(4)) {
        for (int rp_ = 0; rp_ < REP_P4S; ++rp_) p4_sample_out(F, p4pre);
        pg8::Gemm g{(const pg8::bf16_t*)(F.ws + WS_MIX), (const pg8::bf16_t*)(F.ws + WS_WOUTT), MP, DM, DM};
        pg8::StaticOrder S; S.init(MP, DM, F.G, (int)blockIdx.x);
        pg8::EpiOut E{F.xp, F.out + O_YP, (const float*)(F.ws + WS_ADA)};
        for (int rp_ = 0; rp_ < REP_P4G; ++rp_) pg8::gemm_phase<pg8::EpiOut, pg8::StaticOrder, true, true>(F.lds + RING_OFF, g, S, E);
        STAMP(); STAMP();
    }
#undef IN
#undef BOTH
}

#if TEST_MODE
__global__ void __launch_bounds__(256) k_cmp(const void* a, int a_bf16, int lda, const float* ref, int ldr, int rows, int cols, float scale, int act, float* accum) {
    __shared__ float sd[256], sr[256];
    const size_t idx = (size_t)blockIdx.x * 256 + threadIdx.x; float d2 = 0.f, r2 = 0.f;
    if (idx < (size_t)rows * cols) { const size_t r = idx / cols, c = idx % cols;
        const float av = a_bf16 ? bf2f(((const bf16*)a)[r * lda + c]) : ((const float*)a)[r * lda + c];
        float rv = ref[r * ldr + c]; if (act) rv = rv / (1.f + expf(-rv)); rv *= scale;
        d2 = (av - rv) * (av - rv); r2 = rv * rv; if (!(d2 == d2)) d2 = 1e30f; }
    sd[threadIdx.x] = d2; sr[threadIdx.x] = r2; __syncthreads();
    for (int s = 128; s > 0; s >>= 1) { if ((int)threadIdx.x < s) { sd[threadIdx.x] += sd[threadIdx.x + s]; sr[threadIdx.x] += sr[threadIdx.x + s]; } __syncthreads(); }
    if (threadIdx.x == 0) { atomicAdd(accum, sd[0]); atomicAdd(accum + 1, sr[0]); }
}
__global__ void __launch_bounds__(256) k_cmp_sel(const int* SEL, const int* NSEL, const unsigned* bmdump, float* accum) {
    __shared__ float sd[256], sr[256];
    const size_t idx = (size_t)blockIdx.x * 256 + threadIdx.x; const int m = (int)(idx >> 8), i = (int)(idx & 255); float miss = 0.f, tot = 0.f;
    if (m < MP && i < NSEL[m]) { const int l = SEL[(size_t)m * 256 + i]; tot = 1.f; if (!((bmdump[(size_t)m * 64 + (l >> 5)] >> (l & 31)) & 1u)) miss = 1.f; }
    sd[threadIdx.x] = miss; sr[threadIdx.x] = tot; __syncthreads();
    for (int s = 128; s > 0; s >>= 1) { if ((int)threadIdx.x < s) { sd[threadIdx.x] += sd[threadIdx.x + s]; sr[threadIdx.x] += sr[threadIdx.x + s]; } __syncthreads(); }
    if (threadIdx.x == 0) { atomicAdd(accum, sd[0]); atomicAdd(accum + 1, sr[0]); }
}
__global__ void k_cmp_fin2(float* accum, int n, float amp) {
    float best = -1.f; int bi = 0;
    for (int k = 0; k < n; ++k) { const float rel = accum[2 * k] / fmaxf(accum[2 * k + 1], 1e-30f) / accum[32 + k]; if (rel > best) { best = rel; bi = k; } }
    accum[64] = sqrtf(amp * best); accum[65] = (float)bi;
}
__global__ void k_set(float* p, float a, float b, float c, float d, float e) { p[0] = a; p[1] = b; p[2] = c; p[3] = d; p[4] = e; }
__global__ void k_cmp_fin(float* accum, int n, float amp) {
    float best = -1.f; int bi = 0;
    for (int k = 0; k < n; ++k) { const float rel = accum[2 * k] / fmaxf(accum[2 * k + 1], 1e-30f); if (rel > best) { best = rel; bi = k; } }
    accum[64] = sqrtf(amp * best); accum[65] = (float)bi;
}
__global__ void __launch_bounds__(256) k_perturb(float* out, const float* accum) {
    const size_t offs[11] = {O_YP, O_YS, O_KP, O_VP, O_KIP, O_PP, O_KS, O_VS, O_KIS, O_PS, O_END};
    const int k = (int)accum[65] % 10; const float f = 1.0f + accum[64];
    for (size_t i = offs[k] + (size_t)blockIdx.x * 256 + threadIdx.x; i < offs[k + 1]; i += (size_t)gridDim.x * 256) out[i] *= f;
}
__global__ void __launch_bounds__(256) k_f32_to_bf16(const float* src, bf16* dst, size_t n) {
    for (size_t i = (size_t)blockIdx.x * 256 + threadIdx.x; i < n; i += (size_t)gridDim.x * 256) dst[i] = (bf16)f2bf(src[i]);
}
#endif

#if TEST_MODE == 5
__global__ void __launch_bounds__(256) k_stat(float* out, const unsigned* st, int which) {
    float v = which == 0 ? (float)st[0] : (which == 1 ? (float)st[1] / fmaxf((float)st[2], 1.f) : (which < 8 ? (float)st[3] : (which == 13 ? (float)st[13] : (float)st[which] * (16.0f / 1000.0f))));
    const float f = 1.0f + sqrtf(v * 1e-5f);
    for (size_t i = O_KS + (size_t)blockIdx.x * 256 + threadIdx.x; i < O_VS; i += (size_t)gridDim.x * 256) out[i] *= f;
}
#endif
#if TEST_MODE == 6
__global__ void __launch_bounds__(256) k_blk(float* out, const unsigned long long* tb, int sel, float scale) {
    unsigned long long mx = 0; int am = 0;
    for (int i = 0; i < 256; ++i) if (tb[i] > mx) { mx = tb[i]; am = i; }
    float us = 0.f;
    if (sel == 3) us = (float)(am >> 4); else if (sel == 4) us = (float)(am & 15);
    else { double s = 0; int n = 0; for (int i = 0; i < 256; ++i) { const bool in = sel == 1 ? i < 128 : sel == 2 ? i >= 128 : sel >= 10 && sel < 18 ? (i & 7) == sel - 10 : sel >= 20 && sel < 52 ? (i >> 3) == sel - 20 : true; if (in) { s += (double)(mx - tb[i]); ++n; } } us = (float)(s / n) * 0.01f; }
    const float f = 1.0f + sqrtf(us * scale);
    for (size_t i = O_KS + (size_t)blockIdx.x * 256 + threadIdx.x; i < O_VS; i += (size_t)gridDim.x * 256) out[i] *= f;
}
#endif
#if TEST_MODE == 4
__global__ void __launch_bounds__(256) k_time(float* out, const unsigned long long* ts, int i0, int i1, float scale) {
    const float us = (float)(ts[i1] - ts[i0]) * 0.01f; const float f = 1.0f + sqrtf(us * scale);
    for (size_t i = O_KS + (size_t)blockIdx.x * 256 + threadIdx.x; i < O_VS; i += (size_t)gridDim.x * 256) out[i] *= f;
}
#endif
extern "C" void kernel_launch(void* const* d_in, const int* in_sizes, int n_in, void* d_out, int out_size, void* d_ws, size_t ws_size, hipStream_t stream) {
    static int grid = 0;
    if (grid == 0) {
        size_t need = WS_MEGA_END;
#if TEST_MODE && TEST_MODE < 4
        need = 192 * MiB + gold::W_END * 4;
#endif
        if (n_in != 18 || out_size != (int)O_END || ws_size < need) { fprintf(stderr, "kernel_launch: unexpected sizes: n_in %d out %d ws %zu (need %zu)\n", n_in, out_size, ws_size, need); grid = -1; return; }
        int dev = 0, cus = 0, per_cu = 0;
        if (hipGetDevice(&dev) != hipSuccess || hipDeviceGetAttribute(&cus, hipDeviceAttributeMultiprocessorCount, dev) != hipSuccess) { grid = -1; return; }
        if (hipFuncSetAttribute((const void*)mk_fwd, hipFuncAttributeMaxDynamicSharedMemorySize, LDS_BYTES) != hipSuccess) { fprintf(stderr, "kernel_launch: hipFuncSetAttribute failed\n"); grid = -1; return; }
        if (hipOccupancyMaxActiveBlocksPerMultiprocessor(&per_cu, (const void*)mk_fwd, NWAVES * 64, LDS_BYTES) != hipSuccess || per_cu < 1) { fprintf(stderr, "kernel_launch: occupancy query says %d blocks/CU\n", per_cu); (void)hipGetLastError(); grid = -1; return; }
        if (cus < 64) { fprintf(stderr, "kernel_launch: needs >= 64 CUs\n"); grid = -1; return; }
        grid = cus;
    }
#if defined(FORCE_GRID)
    if (grid > FORCE_GRID) grid = FORCE_GRID;
#endif
    if (grid < 0) return;
#if TEST_MODE
    (void)hipMemsetAsync((char*)d_ws + WS_CTL, 0, CTL_ZERO_BYTES, stream);
#else
    (void)hipMemsetAsync((char*)d_ws + WS_CTL + CW_BAR * 4, 0, (CW_Q - CW_BAR + 256) * 4, stream);
#endif
    Args a{};
    for (int i = 0; i < 18; ++i) a.in[i] = (const float*)d_in[i];
    a.out = (float*)d_out; a.ws = (unsigned char*)d_ws;
#if TEST_MODE == 6
    a.ph_lo = 0; a.ph_hi = 5; a.li = 0;
    hipLaunchKernelGGL(mk_fwd, dim3(grid), dim3(NWAVES * 64), LDS_BYTES, stream, a);
    k_blk<<<16, 256, 0, stream>>>((float*)d_out, (const unsigned long long*)((char*)d_ws + WS_CTL + 800 * 1024), STATSEL, 1e-5f);
#elif TEST_MODE == 5
    a.ph_lo = 0; a.ph_hi = 5; a.li = 0;
    hipLaunchKernelGGL(mk_fwd, dim3(grid), dim3(NWAVES * 64), LDS_BYTES, stream, a);
    k_stat<<<16, 256, 0, stream>>>((float*)d_out, (const unsigned*)((char*)d_ws + WS_CTL + 900 * 1024), STATSEL);
#elif TEST_MODE == 4
    a.ph_lo = 0; a.ph_hi = 5; a.li = 0;
    hipLaunchKernelGGL(mk_fwd, dim3(grid), dim3(NWAVES * 64), LDS_BYTES, stream, a);
    k_time<<<16, 256, 0, stream>>>((float*)d_out, (const unsigned long long*)((char*)d_ws + WS_CTL + 768 * 1024), TS0, TS1, 1e-5f);
#elif TEST_MODE && TEST_MODE < 4
    {
        using namespace gold;
        const float* xp = (const float*)d_in[0]; const float* xs = (const float*)d_in[1];
        const float* cache_k = (const float*)d_in[2]; const float* cache_v = (const float*)d_in[3]; const float* cache_kidx = (const float*)d_in[4];
        const float* state_pool = (const float*)d_in[5]; const int* page_table = (const int*)d_in[6];
        const float* cp = (const float*)d_in[7]; const float* cs = (const float*)d_in[8]; const float* norm_w = (const float*)d_in[9];
        const float* w_ada = (const float*)d_in[10]; const float* b_ada = (const float*)d_in[11]; const float* w_in = (const float*)d_in[12];
        const float* qnw = (const float*)d_in[13]; const float* knw = (const float*)d_in[14]; const float* w_pool = (const float*)d_in[15];
        const float* pool_scale = (const float*)d_in[16]; const float* w_out = (const float*)d_in[17];
        float* out = (float*)d_out; float* ws = (float*)((char*)d_ws + 192 * MiB);
        float *ADA = ws + W_ADA, *H = ws + W_H, *PROJ = ws + W_PROJ, *SC = ws + W_SC, *SCS = ws + W_SCS, *MIX = ws + W_MIX, *DB = ws + W_DB, *YT = ws + W_YT;
        int *SEL = (int*)(ws + W_SEL), *NSEL = (int*)(ws + W_NSEL);
        k_ada<<<dim3(12, NR), 256, 0, stream>>>(cp, cs, w_ada, b_ada, ADA);
        k_h<<<MT / 4, 256, 0, stream>>>(xp, xs, norm_w, ADA, H);
        k_gemm<<<dim3((NIN + 127) / 128, MT / 128), 256, 0, stream>>>(H, w_in, PROJ, MT, NIN, DM, DM, NIN, NIN);
        k_post<<<MT / 4, 256, 0, stream>>>(PROJ, qnw, knw, state_pool, out);
        k_scores_p<<<dim3(SEQ / 8, NB), 256, 0, stream>>>(PROJ, SC);
        k_scores_s<<<DECB, 256, 0, stream>>>(PROJ, cache_kidx, page_table, SCS);
        k_topk<<<MT / 4, 256, 0, stream>>>(SC, SCS, SEL, NSEL);
        k_attn<<<MT / 4, 256, 0, stream>>>(PROJ, cache_k, cache_v, page_table, SEL, NSEL, MIX);
        k_pool_d<<<(MT * 512) / 256, 256, 0, stream>>>(PROJ, state_pool, DB);
        k_pool_out<<<(MT * 512) / 256, 256, 0, stream>>>(PROJ, DB, w_pool, pool_scale, MIX);
        k_gemm<<<dim3(1024 / 128, MT / 128), 256, 0, stream>>>(MIX, w_out, YT, MT, 1024, 1024, 1024, 1024, 1024);
        k_final<<<(MT * 1024) / 256, 256, 0, stream>>>(xp, xs, ADA, YT, out);
        unsigned char* mws = (unsigned char*)d_ws;
#if TEST_MODE == 1
        a.ph_lo = 0; a.ph_hi = 3; a.li = 0;
        hipLaunchKernelGGL(mk_fwd, dim3(grid), dim3(NWAVES * 64), LDS_BYTES, stream, a);
        float* accum = (float*)(mws + WS_CTL + 512 * 1024);
        struct { const void* a; int bf; int lda; int refcol; int cols; float scale; int act; } L[9] = {
            {mws + WS_Q, 1, 512, CQ, 512, C2, 0}, {mws + WS_QI, 1, 512, CQI, 512, 1.f, 0}, {mws + WS_GA, 1, 512, CGA, 512, 1.f, 1}, {mws + WS_U, 1, 512, CU, 512, 1.f, 0},
            {mws + WS_GP, 1, 512, CGP, 512, 1.f, 1}, {mws + WS_KB, 1, 128, CK, 128, 1.f, 0}, {mws + WS_VB, 1, 128, CV, 128, 1.f, 0}, {mws + WS_KI, 1, 64, CKI, 64, 1.f, 0},
            {mws + WS_WI, 0, 8, CWI, 8, 1.f, 0} };
        for (int k = 0; k < 9; ++k) k_cmp<<<(unsigned)(((size_t)MT * L[k].cols + 255) / 256), 256, 0, stream>>>(L[k].a, L[k].bf, L[k].lda, PROJ + L[k].refcol, NIN, MT, L[k].cols, L[k].scale, L[k].act, accum + 2 * k);
        k_cmp<<<(NR * 3072 + 255) / 256, 256, 0, stream>>>(mws + WS_ADA, 0, 3072, ADA, 3072, NR, 3072, 1.f, 0, accum + 18);
        k_cmp_fin<<<1, 1, 0, stream>>>(accum, 10, 5.0f);
        k_perturb<<<1024, 256, 0, stream>>>(out, accum);
#elif TEST_MODE == 3
        a.ph_lo = 0; a.ph_hi = 5; a.li = 0;
        hipLaunchKernelGGL(mk_fwd, dim3(grid), dim3(NWAVES * 64), LDS_BYTES, stream, a);
        float* accum = (float*)(mws + WS_CTL + 512 * 1024);
        const bf16* MB = (const bf16*)(mws + WS_MIX);
        k_cmp<<<(unsigned)(((size_t)MP * 512 + 255) / 256), 256, 0, stream>>>(MB, 1, 1024, MIX, 1024, MP, 512, 1.f, 0, accum + 0);
        k_cmp<<<(unsigned)(((size_t)MP * 512 + 255) / 256), 256, 0, stream>>>(MB + 512, 1, 1024, MIX + 512, 1024, MP, 512, 1.f, 0, accum + 2);
        k_cmp<<<(DECB * 512 + 255) / 256, 256, 0, stream>>>(MB + (size_t)MP * 1024, 1, 1024, MIX + (size_t)MP * 1024, 1024, DECB, 512, 1.f, 0, accum + 4);
        k_cmp<<<(DECB * 512 + 255) / 256, 256, 0, stream>>>(MB + (size_t)MP * 1024 + 512, 1, 1024, MIX + (size_t)MP * 1024 + 512, 1024, DECB, 512, 1.f, 0, accum + 6);
        k_cmp_sel<<<MP, 256, 0, stream>>>(SEL, NSEL, (const unsigned*)(mws + WS_DBG_BM), accum + 8);
        k_set<<<1, 1, 0, stream>>>(accum + 32, P3_TOL0, P3_TOL1, P3_TOL2, P3_TOL3, P3_TOL4);
        k_cmp_fin2<<<1, 1, 0, stream>>>(accum, 5, 1e-5f);
        k_perturb<<<1024, 256, 0, stream>>>(out, accum);
#elif TEST_MODE == 2
        a.ph_lo = 0; a.ph_hi = 3; a.li = 0;
        hipLaunchKernelGGL(mk_fwd, dim3(grid), dim3(NWAVES * 64), LDS_BYTES, stream, a);
        k_f32_to_bf16<<<2048, 256, 0, stream>>>(MIX, (bf16*)(mws + WS_MIX), (size_t)MT * 1024);
        a.ph_lo = 4; a.ph_hi = 5; a.li = 1;
        hipLaunchKernelGGL(mk_fwd, dim3(grid), dim3(NWAVES * 64), LDS_BYTES, stream, a);
#endif
    }
#else
    a.ph_lo = 0; a.ph_hi = 5; a.li = 0;
#if USE_COOP
    { void* kargs[] = {&a}; (void)hipLaunchCooperativeKernel((const void*)mk_fwd, dim3(grid), dim3(NWAVES * 64), kargs, LDS_BYTES, stream); }
#else
    hipLaunchKernelGGL(mk_fwd, dim3(grid), dim3(NWAVES * 64), LDS_BYTES, stream, a);
#endif
#endif
}
```
